# Optimizing an MI355X kernel written in HIP

```python
import jax, jax.numpy as jnp
from jax import lax
import numpy as np

D_MODEL = 2048
BATCH = 4
SEQ = 4096
DEPTH = 4

CHUNK = 64
PLE_DIM = 256
A_HEADS = 8
A_HEAD_DIM = 128
A_WIDTH = A_HEADS * A_HEAD_DIM
B_HEADS = 8
B_HEAD_DIM = 128
B_WIDTH = B_HEADS * B_HEAD_DIM
IDX_HEADS = 16
IDX_DIM = 64
TOPK_MAX = 256
QBLOCK = 128
ROPE_THETA = 10000.0
D_FF = ((8 * D_MODEL // 3 + 255) // 256) * 256
ALPHA = (2 * DEPTH) ** 0.25
BETA = (8 * DEPTH) ** -0.25
LN_EPS = 1e-5
RMS_EPS = 1e-6
MASK_VALUE = -1e30
ATTN_SCALE = B_HEAD_DIM ** -0.5
IDX_SCALE = (IDX_HEADS * IDX_DIM) ** -0.5
IN_SPLITS = (A_WIDTH, A_WIDTH, A_WIDTH, A_WIDTH,
             B_WIDTH, B_WIDTH, B_WIDTH,
             IDX_HEADS * IDX_DIM, IDX_DIM, IDX_HEADS,
             D_MODEL, D_MODEL)
IN_WIDTH = sum(IN_SPLITS)

kernel_name = "hgrn2_dsa_gated_hybrid_deepnorm"


def layer_norm(x, g, b):
    xf = x.astype(jnp.float32)
    mu = jnp.mean(xf, axis=-1, keepdims=True)
    xc = xf - mu
    var = jnp.mean(xc * xc, axis=-1, keepdims=True)
    return (xc * lax.rsqrt(var + LN_EPS) * g.astype(jnp.float32) + b.astype(jnp.float32)).astype(x.dtype)


def rope_tables(positions, dim):
    half = dim // 2
    inv_freq = ROPE_THETA ** (-jnp.arange(half, dtype=jnp.float32) / half)
    ang = positions.astype(jnp.float32)[..., None] * inv_freq
    return jnp.cos(ang), jnp.sin(ang)


def apply_rope(x, cos, sin):
    half = x.shape[-1] // 2
    xf = x.astype(jnp.float32)
    x1, x2 = xf[..., :half], xf[..., half:]
    return jnp.concatenate([x1 * cos - x2 * sin, x1 * sin + x2 * cos], axis=-1).astype(x.dtype)


def hgrn2_mixer(q, f_pre, i_in, g, lb, norm_g):
    f32 = jnp.float32
    bsz, seq, _ = q.shape
    n_chunks = seq // CHUNK
    f_pre = f_pre.astype(f32)
    lb = lb.astype(f32)
    log_f = jax.nn.log_sigmoid(f_pre) + jnp.log1p(lb * jnp.exp(-f_pre))
    k = (1.0 - lb) * jax.nn.sigmoid(-f_pre)
    qf = jax.nn.silu(q.astype(f32))

    def to_chunks(t):
        return t.reshape(bsz, n_chunks, CHUNK, A_HEADS, A_HEAD_DIM).transpose(1, 0, 3, 2, 4)

    xs = (to_chunks(qf), to_chunks(k), to_chunks(i_in.astype(f32)), to_chunks(log_f))
    causal = jnp.tril(jnp.ones((CHUNK, CHUNK), dtype=bool))

    def step(state, inp):
        qc, kc, vc, gc = inp
        cum = jnp.cumsum(gc, axis=2)
        o_inter = jnp.einsum('bhtk,bhkv->bhtv', qc * jnp.exp(cum), state)
        diff = cum[:, :, :, None, :] - cum[:, :, None, :, :]
        decay = jnp.exp(jnp.where(causal[:, :, None], diff, MASK_VALUE))
        scores = jnp.einsum('bhtk,bhsk,bhtsk->bhts', qc, kc, decay)
        o = o_inter + jnp.einsum('bhts,bhsv->bhtv', scores, vc)
        last = cum[:, :, -1:, :]
        new_state = jnp.exp(last[:, :, 0, :])[..., None] * state + \
            jnp.einsum('bhsk,bhsv->bhkv', kc * jnp.exp(last - cum), vc)
        return new_state, o

    state0 = jnp.zeros((bsz, A_HEADS, A_HEAD_DIM, A_HEAD_DIM), f32)
    _, o = lax.scan(step, state0, xs)
    o = o.transpose(1, 0, 3, 2, 4).reshape(bsz, seq, A_HEADS, A_HEAD_DIM)
    o = o * lax.rsqrt(jnp.mean(o * o, axis=-1, keepdims=True) + RMS_EPS) * norm_g.astype(f32)
    gate = jax.nn.silu(g.astype(f32)).reshape(bsz, seq, A_HEADS, A_HEAD_DIM)
    return (o * gate).reshape(bsz, seq, A_WIDTH).astype(q.dtype)


def dsa_mixer(q, k, v, q_idx, k_idx, w_idx, cos_h, sin_h, cos_i, sin_i, kn_g, kn_b):
    f32 = jnp.float32
    bsz, seq, _ = q.shape
    topk = min(TOPK_MAX, seq // 4)
    n_blocks = seq // QBLOCK
    q = apply_rope(q.reshape(bsz, seq, B_HEADS, B_HEAD_DIM), cos_h[:, :, None], sin_h[:, :, None])
    k = apply_rope(k.reshape(bsz, seq, B_HEADS, B_HEAD_DIM), cos_h[:, :, None], sin_h[:, :, None])
    v = v.reshape(bsz, seq, B_HEADS, B_HEAD_DIM)
    q_idx = apply_rope(q_idx.reshape(bsz, seq, IDX_HEADS, IDX_DIM),
                       cos_i[:, :, None], sin_i[:, :, None]).astype(f32)
    k_idx = apply_rope(layer_norm(k_idx, kn_g, kn_b), cos_i, sin_i).astype(f32)
    w_idx = w_idx.astype(f32) * IDX_SCALE
    key_chunk = jnp.arange(seq) // CHUNK
    gather = jax.vmap(lambda t, idx: t[idx])

    def to_blocks(t):
        return t.reshape(bsz, n_blocks, QBLOCK, *t.shape[2:]).swapaxes(0, 1)

    def one_block(blk):
        qb, qib, wib, start = blk
        q_chunk = (start + jnp.arange(QBLOCK)) // CHUNK
        rel = jax.nn.relu(jnp.einsum('bqhd,bsd->bqhs', qib, k_idx))
        score = jnp.einsum('bqh,bqhs->bqs', wib, rel)
        score = jnp.where(key_chunk[None, None, :] <= q_chunk[None, :, None], score, MASK_VALUE)
        _, sel = lax.top_k(score, topk)
        ks = gather(k, sel)
        vs = gather(v, sel)
        valid = key_chunk[sel] <= q_chunk[None, :, None]
        logits = jnp.einsum('bqhd,bqkhd->bqhk', qb, ks).astype(f32) * ATTN_SCALE
        logits = jnp.where(valid[:, :, None, :], logits, MASK_VALUE)
        probs = jax.nn.softmax(logits, axis=-1).astype(vs.dtype)
        return jnp.einsum('bqhk,bqkhd->bqhd', probs, vs)

    starts = jnp.arange(n_blocks, dtype=jnp.int32) * QBLOCK
    out = lax.map(one_block, (to_blocks(q), to_blocks(q_idx), to_blocks(w_idx), starts))
    return out.swapaxes(0, 1).reshape(bsz, seq, B_WIDTH)


def setup_inputs(seed: int = 0) -> dict:
    key = jax.random.key(seed)
    ks = jax.random.split(key, 24)
    f32 = jnp.float32

    def normal(k, shape, scale):
        return jax.random.normal(k, shape, f32) * scale

    def gain(k, shape):
        return 1.0 + 0.01 * jax.random.normal(k, shape, f32)

    def bias(k, shape):
        return 0.01 * jax.random.normal(k, shape, f32)

    x = normal(ks[0], (BATCH, SEQ, D_MODEL), 1.0)
    p = normal(ks[1], (DEPTH, BATCH, SEQ, PLE_DIM), 1.0)
    offsets = jax.random.randint(ks[2], (BATCH, 1), 0, 64, dtype=jnp.int32) * CHUNK
    positions = (offsets + jnp.arange(SEQ, dtype=jnp.int32)[None, :]).astype(jnp.int32)
    return {
        "x": x,
        "p": p,
        "positions": positions,
        "w_in": normal(ks[3], (DEPTH, D_MODEL, IN_WIDTH), D_MODEL ** -0.5),
        "w_branch_a": normal(ks[4], (DEPTH, A_WIDTH, D_MODEL), A_WIDTH ** -0.5),
        "w_branch_b": normal(ks[5], (DEPTH, B_WIDTH, D_MODEL), B_WIDTH ** -0.5),
        "w_out": normal(ks[6], (DEPTH, D_MODEL, D_MODEL), BETA * D_MODEL ** -0.5),
        "hgrn_lower_bounds": normal(ks[7], (DEPTH, A_WIDTH), 0.1),
        "hgrn_norm_g": gain(ks[8], (DEPTH, A_HEAD_DIM)),
        "idx_k_norm_g": gain(ks[9], (DEPTH, IDX_DIM)),
        "idx_k_norm_b": bias(ks[10], (DEPTH, IDX_DIM)),
        "ln_mix_g": gain(ks[11], (DEPTH, D_MODEL)),
        "ln_mix_b": bias(ks[12], (DEPTH, D_MODEL)),
        "w_ffn_gate": normal(ks[13], (DEPTH, D_MODEL, D_FF), D_MODEL ** -0.5),
        "w_ffn_up": normal(ks[14], (DEPTH, D_MODEL, D_FF), D_MODEL ** -0.5),
        "w_ffn_down": normal(ks[15], (DEPTH, D_FF, D_MODEL), BETA * D_FF ** -0.5),
        "ln_ffn_g": gain(ks[16], (DEPTH, D_MODEL)),
        "ln_ffn_b": bias(ks[17], (DEPTH, D_MODEL)),
        "w_ple_gate": normal(ks[18], (DEPTH, D_MODEL, D_MODEL), D_MODEL ** -0.5),
        "w_ple_proj": normal(ks[19], (DEPTH, PLE_DIM, D_MODEL), BETA * PLE_DIM ** -0.5),
        "ln_ple_g": gain(ks[20], (DEPTH, D_MODEL)),
        "ln_ple_b": bias(ks[21], (DEPTH, D_MODEL)),
    }


def reference(x, p, positions, w_in, w_branch_a, w_branch_b, w_out, hgrn_lower_bounds,
              hgrn_norm_g, idx_k_norm_g, idx_k_norm_b, ln_mix_g, ln_mix_b,
              w_ffn_gate, w_ffn_up, w_ffn_down, ln_ffn_g, ln_ffn_b,
              w_ple_gate, w_ple_proj, ln_ple_g, ln_ple_b):
    cos_h, sin_h = rope_tables(positions, B_HEAD_DIM)
    cos_i, sin_i = rope_tables(positions, IDX_DIM)
    lb_sm = jax.nn.softmax(hgrn_lower_bounds.astype(jnp.float32), axis=0)
    lower_bounds = jnp.cumsum(lb_sm, axis=0) - lb_sm[0]
    split_at = np.cumsum(IN_SPLITS)[:-1].tolist()
    for layer in range(DEPTH):
        (a_q, a_f, a_i, a_g, b_q, b_k, b_v, i_q, i_k, i_w, gate_a, gate_b) = \
            jnp.split(x @ w_in[layer], split_at, axis=-1)
        y_a = hgrn2_mixer(a_q, a_f, a_i, a_g, lower_bounds[layer], hgrn_norm_g[layer])
        y_b = dsa_mixer(b_q, b_k, b_v, i_q, i_k, i_w, cos_h, sin_h, cos_i, sin_i,
                        idx_k_norm_g[layer], idx_k_norm_b[layer])
        merged = jax.nn.sigmoid(gate_a) * (y_a @ w_branch_a[layer]) + \
            jax.nn.sigmoid(gate_b) * (y_b @ w_branch_b[layer])
        x = layer_norm(ALPHA * x + merged @ w_out[layer], ln_mix_g[layer], ln_mix_b[layer])
        ffn = (jax.nn.silu(x @ w_ffn_gate[layer]) * (x @ w_ffn_up[layer])) @ w_ffn_down[layer]
        x = layer_norm(ALPHA * x + ffn, ln_ffn_g[layer], ln_ffn_b[layer])
        ple = jax.nn.sigmoid(x @ w_ple_gate[layer]) * (p[layer] @ w_ple_proj[layer])
        x = layer_norm(ALPHA * x + ple, ln_ple_g[layer], ln_ple_b[layer])
    return x
```

```cpp
#include <hip/hip_runtime.h>
#include <cstdio>
#include <cstdint>

constexpr int DM = 2048, NBATCH = 4, SEQ = 4096, TOK = NBATCH * SEQ, DEPTH = 4, CHUNK = 64, PLE = 256;
constexpr int AH = 8, AD = 128, AW = 1024, BH = 8, BD = 128, BW = 1024, IH = 16, IDIM = 64, TOPK = 256;
constexpr int DFF = 5632, INW = 12368, INP = 12544;
constexpr float ALPHA = 1.6817928305074290861f;
constexpr float LN_EPS = 1e-5f, RMS_EPS = 1e-6f;
constexpr float ATTN_SCALE = 0.088388347648318440f;
constexpr float IDX_SCALE = 0.03125f;

typedef unsigned short bf16_t;
__device__ __forceinline__ float bf2f(bf16_t b) { return __uint_as_float(((unsigned)b) << 16); }
__device__ __forceinline__ bf16_t f2bf(float f) { unsigned u = __float_as_uint(f); u += 0x7FFFu + ((u >> 16) & 1u); return (bf16_t)(u >> 16); }
__device__ __forceinline__ float sigmoid_f(float x) { return __builtin_amdgcn_rcpf(1.0f + __expf(-x)); }
__device__ __forceinline__ float silu_f(float x) { return x * sigmoid_f(x); }

__device__ __forceinline__ int tid_() { int t = (int)threadIdx.x; asm volatile("" : "+v"(t)); return t; }
__device__ __forceinline__ int bid_() { int b = (int)blockIdx.x; asm volatile("" : "+s"(b)); return b; }
__device__ __forceinline__ int nblk_() { int g = (int)gridDim.x; asm volatile("" : "+s"(g)); return g; }

template <class T> __device__ __forceinline__ T* as_global(T* p) { return (T*)(__attribute__((address_space(1))) T*)p; }

constexpr size_t MiB = 1048576;
constexpr size_t WS_CTL  = 0;
constexpr size_t WS_LB   = WS_CTL + 65536;
constexpr size_t WS_COSH = 1 * MiB;
constexpr size_t WS_SINH = WS_COSH + 4 * MiB;
constexpr size_t WS_COSI = WS_SINH + 4 * MiB;
constexpr size_t WS_SINI = WS_COSI + 2 * MiB;
constexpr size_t WS_WIN  = WS_SINI + 2 * MiB;
constexpr size_t WS_WA   = WS_WIN + 49 * MiB;
constexpr size_t WS_WB   = WS_WA + 4 * MiB;
constexpr size_t WS_WO   = WS_WB + 4 * MiB;
constexpr size_t WS_WGU  = WS_WO + 8 * MiB;
constexpr size_t WS_WDN  = WS_WGU + 44 * MiB;
constexpr size_t WS_WPG  = WS_WDN + 22 * MiB;
constexpr size_t WS_WPP  = WS_WPG + 8 * MiB;
constexpr size_t WS_X32  = WS_WPP + 1 * MiB;
constexpr size_t WS_XB   = WS_X32 + 128 * MiB;
constexpr size_t WS_XPRE = WS_XB + 64 * MiB;
constexpr size_t WS_R1   = WS_XPRE + 130 * MiB;
constexpr size_t WS_QA   = WS_R1;
constexpr size_t WS_LF   = WS_QA + 32 * MiB;
constexpr size_t WS_KA   = WS_LF + 64 * MiB;
constexpr size_t WS_VA   = WS_KA + 32 * MiB;
constexpr size_t WS_GA   = WS_VA + 32 * MiB;
constexpr size_t WS_QB   = WS_GA + 32 * MiB;
constexpr size_t WS_KB   = WS_QB + 32 * MiB;
constexpr size_t WS_VB   = WS_KB + 32 * MiB;
constexpr size_t WS_QI   = WS_VB + 32 * MiB;
constexpr size_t WS_SGA  = WS_QI + 32 * MiB;
constexpr size_t WS_SGB  = WS_SGA + 64 * MiB;
constexpr size_t WS_IKW  = WS_SGB + 64 * MiB;
constexpr size_t WS_H    = WS_R1;
constexpr size_t WS_PP   = WS_R1 + 176 * MiB;
constexpr size_t WS_R2   = WS_IKW + 8 * MiB;
constexpr size_t WS_LT   = WS_R2;
constexpr size_t WS_MG   = WS_R2;
constexpr size_t WS_PT   = WS_LT + 128 * MiB;
constexpr size_t WS_DEC  = WS_PT + 64 * MiB;
constexpr size_t WS_MASK = WS_DEC + 1 * MiB;
constexpr size_t WS_YA   = WS_MASK + 8 * MiB;
constexpr size_t WS_YB   = WS_YA + 32 * MiB;
constexpr size_t WS_KI   = WS_YB + 32 * MiB;
constexpr size_t WS_WI   = WS_KI + 2 * MiB;
constexpr size_t WS_PB   = WS_WI + 1 * MiB;
constexpr size_t WS_END  = WS_PB + 8 * MiB;
static_assert(WS_END < 1360000000ull, "workspace budget");
constexpr size_t SCORE_B = (size_t)4096 * 2080;

namespace pg8 {
#define PG8_LAS __attribute__((address_space(3)))
typedef unsigned short bf16_t;
typedef short bf16x8 __attribute__((ext_vector_type(8)));
typedef float f32x4 __attribute__((ext_vector_type(4)));
typedef unsigned u32x4 __attribute__((ext_vector_type(4)));
constexpr int BM = 256, BK = 64, HALF = 128, HTB = HALF * BK * 2  , STAGE_BYTES = 8 * HTB, NXCD = 8, WGM = 8;

__host__ __device__ __forceinline__ int lds_byte(int r, int c) { const int st = (r >> 4) * 2 + (c >> 5), rr = r & 15, cc = c & 31, ob = rr * 64 + cc * 2; return st * 1024 + (ob ^ (((ob >> 9) & 1) << 5)); }
__host__ __device__ __forceinline__ void stage_rc(int b, int& R, int& C) { const int st = b / 1024, sb = b % 1024, swz = sb ^ (((sb >> 9) & 1) << 5); R = (st >> 1) * 16 + swz / 64; C = (st & 1) * 32 + (swz % 64) / 2; }
__host__ __device__ __forceinline__ int perm32(int rho) { const int n = rho >> 4, i = rho & 15; return 8 * (i >> 2) + 4 * n + (i & 3); }

struct Unit { int pm, pn; };
struct Gemm { const bf16_t* A; const bf16_t* Bt; int M, N, K; };

struct StaticOrder {
    int nM, nN, nwg, G, c;
    __host__ __device__ void init(int M, int N, int G_, int c_) { nM = M / BM; nN = N / BM; nwg = nM * nN; G = G_; c = c_; }
    __host__ __device__ bool next(int i, Unit& u) const {
        const long L = (long)i * G + c; if (L >= nwg) return false;
        int wgid = (int)L; { const int q = nwg / NXCD, r = nwg % NXCD, xcd = wgid % NXCD, off = wgid / NXCD; wgid = (xcd < r ? xcd * (q + 1) : r * (q + 1) + (xcd - r) * q) + off; }
        const int nig = WGM * nN, gid = wgid / nig, fm = gid * WGM, gsz = (nM - fm) < WGM ? (nM - fm) : WGM;
        u.pm = fm + ((wgid % nig) % gsz); u.pn = (wgid % nig) / gsz; return true;
    }
    __device__ __forceinline__ void a_ready(const Unit&) const {}
    __device__ __forceinline__ void done(const Unit&) const {}
};

typedef float pk_f32x2 __attribute__((ext_vector_type(2)));
typedef __bf16 pk_bf16x2 __attribute__((ext_vector_type(2)));
__device__ __forceinline__ unsigned cvt_pk_bf16(float lo, float hi) { const pk_f32x2 v = {lo, hi}; const pk_bf16x2 b = __builtin_convertvector(v, pk_bf16x2); return __builtin_bit_cast(unsigned, b); }
typedef unsigned u32x2 __attribute__((ext_vector_type(2)));
__device__ __forceinline__ u32x4 pack8(const f32x4 a, const f32x4 b) { u32x4 w; w.x = cvt_pk_bf16(a[0], a[1]); w.y = cvt_pk_bf16(a[2], a[3]); w.z = cvt_pk_bf16(b[0], b[1]); w.w = cvt_pk_bf16(b[2], b[3]); return w; }
__device__ __forceinline__ void unpack8(const u32x4 w, f32x4& a, f32x4& b) {
    a[0] = __uint_as_float(w.x << 16); a[1] = __uint_as_float(w.x & 0xffff0000u); a[2] = __uint_as_float(w.y << 16); a[3] = __uint_as_float(w.y & 0xffff0000u);
    b[0] = __uint_as_float(w.z << 16); b[1] = __uint_as_float(w.z & 0xffff0000u); b[2] = __uint_as_float(w.w << 16); b[3] = __uint_as_float(w.w & 0xffff0000u); }
__device__ __forceinline__ float sigm(float x) { return __builtin_amdgcn_rcpf(1.0f + __expf(-x)); }
__device__ __forceinline__ f32x4 sigm4(const f32x4 x) { f32x4 r; r[0] = sigm(x[0]); r[1] = sigm(x[1]); r[2] = sigm(x[2]); r[3] = sigm(x[3]); return r; }
__device__ __forceinline__ f32x4 silu4(const f32x4 x) { return x * sigm4(x); }

#define PG8_GAS __attribute__((address_space(1)))
struct EpiIn {
    static constexpr bool PERM = true, AFTER_DRAIN = false;
    unsigned char* ws0; int layer;
    __device__ __forceinline__ void operator()(const f32x4 (&acc)[2][2][4][2], const Unit& u, int wr, int wc, int fr, int fq) const {
        unsigned char* wsq = ws0; asm volatile("" : "+s"(wsq)); PG8_GAS unsigned char* const ws = (PG8_GAS unsigned char*)wsq;
        const int pn = u.pn, row0 = u.pm * BM + wr * 64 + fr, cw = wc * 32 + 8 * fq;
        PG8_GAS bf16_t* const QA = (PG8_GAS bf16_t*)(ws + WS_QA); PG8_GAS bf16_t* const KA = (PG8_GAS bf16_t*)(ws + WS_KA); PG8_GAS bf16_t* const VA = (PG8_GAS bf16_t*)(ws + WS_VA); PG8_GAS bf16_t* const GA = (PG8_GAS bf16_t*)(ws + WS_GA);
        PG8_GAS bf16_t* const QB = (PG8_GAS bf16_t*)(ws + WS_QB); PG8_GAS bf16_t* const KB = (PG8_GAS bf16_t*)(ws + WS_KB); PG8_GAS bf16_t* const VB = (PG8_GAS bf16_t*)(ws + WS_VB); PG8_GAS bf16_t* const QI = (PG8_GAS bf16_t*)(ws + WS_QI);
        PG8_GAS bf16_t* const SGA = (PG8_GAS bf16_t*)(ws + WS_SGA); PG8_GAS bf16_t* const SGB = (PG8_GAS bf16_t*)(ws + WS_SGB); PG8_GAS float* const LF = (PG8_GAS float*)(ws + WS_LF); PG8_GAS float* const IKW = (PG8_GAS float*)(ws + WS_IKW);
        const PG8_GAS float* const lb = (const PG8_GAS float*)(ws + WS_LB) + layer * 1024; const PG8_GAS float* const cosh = (const PG8_GAS float*)(ws + WS_COSH); const PG8_GAS float* const sinh = (const PG8_GAS float*)(ws + WS_SINH);
        const PG8_GAS float* const cosi = (const PG8_GAS float*)(ws + WS_COSI); const PG8_GAS float* const sini = (const PG8_GAS float*)(ws + WS_SINI);
        if (pn < 32) {
            const int seg = pn >> 2, cb = (pn & 3) * 256;
            if (seg == 4 || seg == 5) {
                PG8_GAS bf16_t* O = (seg == 4) ? QB : KB; const int head = (pn & 3) * 2 + (wc >> 1), i0 = (wc & 1) * 32 + 8 * fq;
#pragma unroll
                for (int ai = 0; ai < 2; ++ai)
#pragma unroll
                    for (int m = 0; m < 4; ++m) { const int row = row0 + ai * HALF + m * 16;
                        const PG8_GAS float* cp = cosh + (size_t)row * 64 + i0; const PG8_GAS float* sp = sinh + (size_t)row * 64 + i0;
                        const f32x4 c0 = *(const PG8_GAS f32x4*)cp, c1 = *(const PG8_GAS f32x4*)(cp + 4), s0 = *(const PG8_GAS f32x4*)sp, s1 = *(const PG8_GAS f32x4*)(sp + 4);
                        const f32x4 xa = acc[ai][0][m][0], xb = acc[ai][0][m][1], ya = acc[ai][1][m][0], yb = acc[ai][1][m][1];
                        PG8_GAS bf16_t* rp = O + (size_t)row * 1024 + head * 128 + i0;
                        *(PG8_GAS u32x4*)rp = pack8(xa * c0 - ya * s0, xb * c1 - yb * s1);
                        *(PG8_GAS u32x4*)(rp + 64) = pack8(xa * s0 + ya * c0, xb * s1 + yb * c1); asm volatile("" ::: "memory"); }
            } else if (seg == 7) {
                const int head = (pn & 3) * 4 + wc, i0 = 8 * fq;
#pragma unroll
                for (int ai = 0; ai < 2; ++ai)
#pragma unroll
                    for (int m = 0; m < 4; ++m) { const int row = row0 + ai * HALF + m * 16;
                        const PG8_GAS float* cp = cosi + (size_t)row * 32 + i0; const PG8_GAS float* sp = sini + (size_t)row * 32 + i0;
                        const f32x4 c0 = *(const PG8_GAS f32x4*)cp, c1 = *(const PG8_GAS f32x4*)(cp + 4), s0 = *(const PG8_GAS f32x4*)sp, s1 = *(const PG8_GAS f32x4*)(sp + 4);
                        const f32x4 xa = acc[ai][0][m][0], xb = acc[ai][0][m][1], ya = acc[ai][1][m][0], yb = acc[ai][1][m][1];
                        PG8_GAS bf16_t* rp = QI + (size_t)row * 1024 + head * 64 + i0;
                        *(PG8_GAS u32x4*)rp = pack8(xa * c0 - ya * s0, xb * c1 - yb * s1);
                        *(PG8_GAS u32x4*)(rp + 32) = pack8(xa * s0 + ya * c0, xb * s1 + yb * c1); asm volatile("" ::: "memory"); }
            } else if (seg == 1) {
#pragma unroll
                for (int bj = 0; bj < 2; ++bj) { const int col = cb + bj * HALF + cw;
                    const f32x4 l0 = *(const PG8_GAS f32x4*)(lb + col), l1 = *(const PG8_GAS f32x4*)(lb + col + 4);
#pragma unroll
                    for (int ai = 0; ai < 2; ++ai)
#pragma unroll
                        for (int m = 0; m < 4; ++m) { const int row = row0 + ai * HALF + m * 16; f32x4 lf[2], kk[2];
#pragma unroll
                            for (int n = 0; n < 2; ++n) { const f32x4 x = acc[ai][bj][m][n]; const f32x4 lv = n ? l1 : l0;
#pragma unroll
                                for (int j = 0; j < 4; ++j) { const float xe = fminf(fmaxf(x[j], -80.f), 80.f), e = __expf(-xe), r = __builtin_amdgcn_rcpf(1.0f + e);
                                    const float om = 1.0f - lv[j]; lf[n][j] = logf(lv[j] + om * r); kk[n][j] = om * (e * r); } }
                            PG8_GAS float* lp = LF + (size_t)row * 1024 + col; *(PG8_GAS f32x4*)lp = lf[0]; *(PG8_GAS f32x4*)(lp + 4) = lf[1];
                            *(PG8_GAS u32x4*)(KA + (size_t)row * 1024 + col) = pack8(kk[0], kk[1]); asm volatile("" ::: "memory"); } }
            } else {
                PG8_GAS bf16_t* O = (seg == 0) ? QA : (seg == 2) ? VA : (seg == 3) ? GA : VB; const bool act = (seg == 0 || seg == 3);
#pragma unroll
                for (int ai = 0; ai < 2; ++ai)
#pragma unroll
                    for (int m = 0; m < 4; ++m) { const int row = row0 + ai * HALF + m * 16;
#pragma unroll
                        for (int bj = 0; bj < 2; ++bj) { f32x4 v0 = acc[ai][bj][m][0], v1 = acc[ai][bj][m][1];
                            if (act) { v0 = silu4(v0); v1 = silu4(v1); }
                            *(PG8_GAS u32x4*)(O + (size_t)row * 1024 + cb + bj * HALF + cw) = pack8(v0, v1); } }
            }
        } else if (pn < 48) {
            PG8_GAS bf16_t* O = (pn < 40) ? SGA : SGB; const int cb = ((pn - 32) & 7) * 256;
#pragma unroll
            for (int ai = 0; ai < 2; ++ai)
#pragma unroll
                for (int m = 0; m < 4; ++m) { const int row = row0 + ai * HALF + m * 16;
#pragma unroll
                    for (int bj = 0; bj < 2; ++bj)
                        *(PG8_GAS u32x4*)(O + (size_t)row * DM + cb + bj * HALF + cw) = pack8(sigm4(acc[ai][bj][m][0]), sigm4(acc[ai][bj][m][1])); }
        } else {
#pragma unroll
            for (int ai = 0; ai < 2; ++ai)
#pragma unroll
                for (int m = 0; m < 4; ++m) { PG8_GAS float* p = IKW + (size_t)(row0 + ai * HALF + m * 16) * 128 + cw; *(PG8_GAS f32x4*)p = acc[ai][0][m][0]; *(PG8_GAS f32x4*)(p + 4) = acc[ai][0][m][1]; }
        }
    }
};
struct EpiGateA {
    static constexpr bool PERM = true, AFTER_DRAIN = false;
    unsigned char* ws;
    __device__ __forceinline__ void operator()(const f32x4 (&acc)[2][2][4][2], const Unit& u, int wr, int wc, int fr, int fq) const {
        unsigned char* const wg = as_global(ws); const bf16_t* const SG = (const bf16_t*)(wg + WS_SGA); float* const AF = (float*)(wg + WS_XPRE);
        const int row0 = u.pm * BM + wr * 64 + fr, col0 = u.pn * BM + wc * 32 + 8 * fq;
#pragma unroll
        for (int ai = 0; ai < 2; ++ai)
#pragma unroll
            for (int m = 0; m < 4; ++m) { const size_t off = (size_t)(row0 + ai * HALF + m * 16) * DM + col0;
#pragma unroll
                for (int bj = 0; bj < 2; ++bj) { f32x4 g0, g1; unpack8(*(const u32x4*)(SG + off + bj * HALF), g0, g1);
                    float* p = AF + off + bj * HALF; *(f32x4*)p = g0 * acc[ai][bj][m][0]; *(f32x4*)(p + 4) = g1 * acc[ai][bj][m][1]; } asm volatile("" ::: "memory"); }
    }
};
struct EpiGateB {
    static constexpr bool PERM = true, AFTER_DRAIN = false;
    unsigned char* ws;
    __device__ __forceinline__ void operator()(const f32x4 (&acc)[2][2][4][2], const Unit& u, int wr, int wc, int fr, int fq) const {
        unsigned char* const wg = as_global(ws); const bf16_t* const SG = (const bf16_t*)(wg + WS_SGB); const float* const AF = (const float*)(wg + WS_XPRE); bf16_t* const MG = (bf16_t*)(wg + WS_MG);
        const int row0 = u.pm * BM + wr * 64 + fr, col0 = u.pn * BM + wc * 32 + 8 * fq;
#pragma unroll
        for (int ai = 0; ai < 2; ++ai)
#pragma unroll
            for (int m = 0; m < 4; ++m) { const size_t off = (size_t)(row0 + ai * HALF + m * 16) * DM + col0;
#pragma unroll
                for (int bj = 0; bj < 2; ++bj) { f32x4 g0, g1; unpack8(*(const u32x4*)(SG + off + bj * HALF), g0, g1);
                    const float* p = AF + off + bj * HALF; const f32x4 a0 = *(const f32x4*)p, a1 = *(const f32x4*)(p + 4);
                    *(u32x4*)(MG + off + bj * HALF) = pack8(a0 + g0 * acc[ai][bj][m][0], a1 + g1 * acc[ai][bj][m][1]); } asm volatile("" ::: "memory"); }
    }
};
struct EpiRes {
    static constexpr bool PERM = true, AFTER_DRAIN = false;
    const float* X; unsigned char* ws;
    __device__ __forceinline__ void operator()(const f32x4 (&acc)[2][2][4][2], const Unit& u, int wr, int wc, int fr, int fq) const {
        float* const XP = (float*)(as_global(ws) + WS_XPRE); const float* const Xg = as_global(X);
        const int row0 = u.pm * BM + wr * 64 + fr, col0 = u.pn * BM + wc * 32 + 8 * fq;
#pragma unroll
        for (int ai = 0; ai < 2; ++ai)
#pragma unroll
            for (int m = 0; m < 4; ++m) { const size_t off = (size_t)(row0 + ai * HALF + m * 16) * DM + col0;
#pragma unroll
                for (int bj = 0; bj < 2; ++bj) { const float* xp = Xg + off + bj * HALF; const f32x4 x0 = *(const f32x4*)xp, x1 = *(const f32x4*)(xp + 4);
                    float* p = XP + off + bj * HALF; *(f32x4*)p = x0 * ALPHA + acc[ai][bj][m][0]; *(f32x4*)(p + 4) = x1 * ALPHA + acc[ai][bj][m][1]; } asm volatile("" ::: "memory"); }
    }
};
struct EpiSwiGLU {
    static constexpr bool PERM = true, AFTER_DRAIN = false;
    unsigned char* ws;
    __device__ __forceinline__ void operator()(const f32x4 (&acc)[2][2][4][2], const Unit& u, int wr, int wc, int fr, int fq) const {
        bf16_t* const H = (bf16_t*)(as_global(ws) + WS_H);
        const int row0 = u.pm * BM + wr * 64 + fr, col0 = u.pn * HALF + wc * 32 + 8 * fq;
#pragma unroll
        for (int ai = 0; ai < 2; ++ai)
#pragma unroll
            for (int m = 0; m < 4; ++m)
                *(u32x4*)(H + (size_t)(row0 + ai * HALF + m * 16) * DFF + col0) = pack8(silu4(acc[ai][0][m][0]) * acc[ai][1][m][0], silu4(acc[ai][0][m][1]) * acc[ai][1][m][1]);
    }
};
struct EpiF32P {
    static constexpr bool PERM = true, AFTER_DRAIN = false;
    unsigned char* ws;
    __device__ __forceinline__ void operator()(const f32x4 (&acc)[2][2][4][2], const Unit& u, int wr, int wc, int fr, int fq) const {
        float* const C = (float*)(as_global(ws) + WS_PP);
        const int row0 = u.pm * BM + wr * 64 + fr, col0 = u.pn * BM + wc * 32 + 8 * fq;
#pragma unroll
        for (int ai = 0; ai < 2; ++ai)
#pragma unroll
            for (int m = 0; m < 4; ++m) { const size_t off = (size_t)(row0 + ai * HALF + m * 16) * DM + col0;
#pragma unroll
                for (int bj = 0; bj < 2; ++bj) { float* p = C + off + bj * HALF; *(f32x4*)p = acc[ai][bj][m][0]; *(f32x4*)(p + 4) = acc[ai][bj][m][1]; } }
    }
};
struct EpiPle {
    static constexpr bool PERM = true, AFTER_DRAIN = false;
    unsigned char* ws;
    __device__ __forceinline__ void operator()(const f32x4 (&acc)[2][2][4][2], const Unit& u, int wr, int wc, int fr, int fq) const {
        const float* const X = (const float*)(ws + WS_X32); const float* const PP = (const float*)(ws + WS_PP); float* const XP = (float*)(as_global(ws) + WS_XPRE); const float* const Xg = as_global(X);
        const int row0 = u.pm * BM + wr * 64 + fr, col0 = u.pn * BM + wc * 32 + 8 * fq;
#pragma unroll
        for (int ai = 0; ai < 2; ++ai)
#pragma unroll
            for (int m = 0; m < 4; ++m) { const size_t off = (size_t)(row0 + ai * HALF + m * 16) * DM + col0;
#pragma unroll
                for (int bj = 0; bj < 2; ++bj) { const float* xp = Xg + off + bj * HALF; const f32x4 x0 = *(const f32x4*)xp, x1 = *(const f32x4*)(xp + 4);
                    const float* pp = PP + off + bj * HALF; const f32x4 p0 = *(const f32x4*)pp, p1 = *(const f32x4*)(pp + 4);
                    float* p = XP + off + bj * HALF; *(f32x4*)p = x0 * ALPHA + sigm4(acc[ai][bj][m][0]) * p0; *(f32x4*)(p + 4) = x1 * ALPHA + sigm4(acc[ai][bj][m][1]) * p1; } asm volatile("" ::: "memory"); }
    }
};

struct EpiRawTest {
    static constexpr bool PERM = true, AFTER_DRAIN = false;
    unsigned char* ws;
    __device__ __forceinline__ void operator()(const f32x4 (&acc)[2][2][4][2], const Unit& u, int wr, int wc, int fr, int fq) const {
        bf16_t* const H = (bf16_t*)(as_global(ws) + WS_H);
        const int row0 = u.pm * BM + wr * 64 + fr, col0 = u.pn * HALF + wc * 32 + 8 * fq;
#pragma unroll
        for (int ai = 0; ai < 2; ++ai)
#pragma unroll
            for (int m = 0; m < 4; ++m)
                *(u32x4*)(H + (size_t)(row0 + ai * HALF + m * 16) * 6272 + col0) = pack8(acc[ai][0][m][0] + acc[ai][1][m][0], acc[ai][0][m][1] + acc[ai][1][m][1]);
    }
};
template <class Epi, class Sched, bool ALIGN_EPI = false, bool SP2 = false>
__device__ __forceinline__ void gemm_phase(PG8_LAS unsigned char* lds, const Gemm g, const Sched& S, const Epi& E) {
    const int tid = tid_(), wid = __builtin_amdgcn_readfirstlane(tid >> 6), lane = tid & 63, wr = wid >> 2, wc = wid & 3, fr = lane & 15, fq = lane >> 4;
    int Kq = g.K; asm volatile("" : "+s"(Kq)); const int K = Kq, nt = K / BK;
    unsigned voffA[2], voffB[2];
#pragma unroll
    for (int i = 0; i < 2; ++i) { int R, C; stage_rc(tid * 16 + i * 8192, R, C); const int Rb = Epi::PERM ? ((R & ~31) + perm32(R & 31)) : R;
        voffA[i] = (unsigned)(R * K + C) * 2u; voffB[i] = (unsigned)(Rb * K + C) * 2u; }
    const size_t kstep = (size_t)(BK * 2);
    const size_t hstep = (size_t)HALF * K * 2;
    const size_t tstep = 2 * hstep;
    const unsigned ldsw = (unsigned)wid * 1024u;
    const int aoff = lds_byte(wr * 64 + fr, fq * 8), boff = lds_byte(wc * 32 + fr, fq * 8);
#define PG8_SA(b, h) (((b) * 2 + (h)) * HTB)
#define PG8_SB(b, h) ((4 + (b) * 2 + (h)) * HTB)
#define PG8_STAGE(bufoff, gbase, voff) do { _Pragma("unroll") for (int _i = 0; _i < 2; ++_i) \
        __builtin_amdgcn_global_load_lds((const unsigned*)((const char*)(gbase) + (voff)[_i]), (PG8_LAS unsigned*)(lds + (bufoff) + ldsw + _i * 8192), 16, 0, 0); } while (0)
#define PG8_LDA(dst, b, h) do { _Pragma("unroll") for (int m = 0; m < 4; ++m) _Pragma("unroll") for (int k = 0; k < 2; ++k) dst[m][k] = *(const PG8_LAS bf16x8*)(lds + PG8_SA(b, h) + aoff + m * 2048 + k * 1024); } while (0)
#define PG8_LDB(dst, b, h) do { _Pragma("unroll") for (int n = 0; n < 2; ++n) _Pragma("unroll") for (int k = 0; k < 2; ++k) dst[n][k] = *(const PG8_LAS bf16x8*)(lds + PG8_SB(b, h) + boff + n * 2048 + k * 1024); } while (0)
#define PG8_MMA(ai, bj, At, Bt) do { __builtin_amdgcn_s_setprio(1); _Pragma("unroll") for (int m = 0; m < 4; ++m) _Pragma("unroll") for (int n = 0; n < 2; ++n) _Pragma("unroll") for (int k = 0; k < 2; ++k) \
        acc[ai][bj][m][n] = __builtin_amdgcn_mfma_f32_16x16x32_bf16(Bt[n][k], At[m][k], acc[ai][bj][m][n], 0, 0, 0); __builtin_amdgcn_s_setprio(0); } while (0)
#define PG8_WAIT_V(n) asm volatile("s_waitcnt vmcnt(" #n ")" ::: "memory")
#define PG8_WAIT_L(n) asm volatile("s_waitcnt lgkmcnt(" #n ")" ::: "memory")
#define PG8_BAR __builtin_amdgcn_s_barrier()
#define PG8_SCHED __builtin_amdgcn_sched_barrier(0)
    Unit cur, nxt; int ui = 0;
    if (!S.next(0, cur)) return;
    f32x4 acc[2][2][4][2];
#pragma unroll
    for (int a = 0; a < 2; ++a)
#pragma unroll
        for (int b = 0; b < 2; ++b)
#pragma unroll
            for (int m = 0; m < 4; ++m)
#pragma unroll
                for (int n = 0; n < 2; ++n) acc[a][b][m][n] = (f32x4){0.f, 0.f, 0.f, 0.f};
    bf16x8 At[4][2], B0[2][2], B1[2][2];
    const char* cA = (const char*)g.A + (size_t)cur.pm * tstep; const char* cB = (const char*)g.Bt + (size_t)cur.pn * tstep;
    S.a_ready(cur);
    if constexpr (SP2) {
        PG8_STAGE(PG8_SB(0, 0), cB, voffB); PG8_STAGE(PG8_SB(0, 1), cB + hstep, voffB); PG8_STAGE(PG8_SA(0, 0), cA, voffA); PG8_STAGE(PG8_SA(0, 1), cA + hstep, voffA);
        if (wr == 1) PG8_BAR;
        PG8_WAIT_V(2); PG8_BAR;
        PG8_STAGE(PG8_SB(1, 0), cB + kstep, voffB); PG8_STAGE(PG8_SA(1, 0), cA + kstep, voffA); PG8_STAGE(PG8_SB(1, 1), cB + hstep + kstep, voffB);
        PG8_WAIT_V(6); PG8_BAR;
    } else {
        PG8_STAGE(PG8_SB(0, 0), cB, voffB); PG8_STAGE(PG8_SA(0, 0), cA, voffA); PG8_STAGE(PG8_SB(0, 1), cB + hstep, voffB); PG8_STAGE(PG8_SA(0, 1), cA + hstep, voffA);
        if (wr == 1) PG8_BAR;
        PG8_WAIT_V(4); PG8_BAR;
        PG8_STAGE(PG8_SB(1, 0), cB + kstep, voffB); PG8_STAGE(PG8_SA(1, 0), cA + kstep, voffA); PG8_STAGE(PG8_SB(1, 1), cB + hstep + kstep, voffB);
        PG8_WAIT_V(6); PG8_BAR;
    }
    for (;;) {
        const bool has_next = S.next(ui + 1, nxt);
        const char* nA = has_next ? (const char*)g.A + (size_t)nxt.pm * tstep : cA; const char* nB = has_next ? (const char*)g.Bt + (size_t)nxt.pn * tstep : cB;
        for (int t = 0; t < nt; t += 2) {
            const bool last = (t == nt - 2);
            const char* a1 = cA + (size_t)(t + 1) * kstep;
            const char* a2 = last ? nA : cA + (size_t)(t + 2) * kstep; const char* b2 = last ? nB : cB + (size_t)(t + 2) * kstep;
            const char* a3 = a2 + kstep; const char* b3 = b2 + kstep;
            if (last && has_next) S.a_ready(nxt);
            if constexpr (SP2) {
            PG8_LDB(B0, 0, 0); PG8_LDB(B1, 0, 1); PG8_SCHED; PG8_LDA(At, 0, 0); PG8_STAGE(PG8_SA(1, 1), a1 + hstep, voffA);
            PG8_WAIT_V(8); PG8_WAIT_L(0); PG8_BAR; PG8_MMA(0, 0, At, B0); PG8_MMA(0, 1, At, B1); PG8_BAR; PG8_SCHED;
            PG8_LDA(At, 0, 1); PG8_STAGE(PG8_SB(0, 0), b2, voffB); PG8_STAGE(PG8_SB(0, 1), b2 + hstep, voffB); PG8_STAGE(PG8_SA(0, 0), a2, voffA);
            PG8_WAIT_V(8); PG8_WAIT_L(0); PG8_BAR; PG8_MMA(1, 0, At, B0); PG8_MMA(1, 1, At, B1); PG8_BAR; PG8_SCHED;
            PG8_LDB(B0, 1, 0); PG8_LDB(B1, 1, 1); PG8_SCHED; PG8_LDA(At, 1, 0); PG8_STAGE(PG8_SA(0, 1), a2 + hstep, voffA);
            PG8_WAIT_V(8); PG8_WAIT_L(0); PG8_BAR; PG8_MMA(0, 0, At, B0); PG8_MMA(0, 1, At, B1); PG8_BAR; PG8_SCHED;
            PG8_LDA(At, 1, 1); PG8_STAGE(PG8_SB(1, 0), b3, voffB); PG8_STAGE(PG8_SB(1, 1), b3 + hstep, voffB); PG8_STAGE(PG8_SA(1, 0), a3, voffA);
            PG8_WAIT_V(8); PG8_WAIT_L(0); PG8_BAR; PG8_MMA(1, 0, At, B0); PG8_MMA(1, 1, At, B1); PG8_BAR; PG8_SCHED;
            } else {
            PG8_LDB(B0, 0, 0); PG8_SCHED; PG8_LDA(At, 0, 0); PG8_STAGE(PG8_SA(1, 1), a1 + hstep, voffA);
            PG8_WAIT_L(8); PG8_BAR; PG8_WAIT_L(0); PG8_MMA(0, 0, At, B0); PG8_BAR; PG8_SCHED;
            PG8_LDB(B1, 0, 1); PG8_STAGE(PG8_SB(0, 0), b2, voffB);
            PG8_BAR; PG8_WAIT_L(0); PG8_MMA(0, 1, At, B1); PG8_BAR;
            PG8_LDA(At, 0, 1); PG8_STAGE(PG8_SA(0, 0), a2, voffA);
            PG8_BAR; PG8_WAIT_L(0); PG8_MMA(1, 0, At, B0); PG8_BAR; PG8_SCHED;
            PG8_STAGE(PG8_SB(0, 1), b2 + hstep, voffB);
            PG8_WAIT_V(6); PG8_BAR; PG8_MMA(1, 1, At, B1); PG8_BAR;
            PG8_LDB(B0, 1, 0); PG8_SCHED; PG8_LDA(At, 1, 0); PG8_STAGE(PG8_SA(0, 1), a2 + hstep, voffA);
            PG8_WAIT_L(8); PG8_BAR; PG8_WAIT_L(0); PG8_MMA(0, 0, At, B0); PG8_BAR; PG8_SCHED;
            PG8_LDB(B1, 1, 1); PG8_STAGE(PG8_SB(1, 0), b3, voffB);
            PG8_BAR; PG8_WAIT_L(0); PG8_MMA(0, 1, At, B1); PG8_BAR;
            PG8_LDA(At, 1, 1); PG8_STAGE(PG8_SA(1, 0), a3, voffA);
            PG8_BAR; PG8_WAIT_L(0); PG8_MMA(1, 0, At, B0); PG8_BAR; PG8_SCHED;
            PG8_STAGE(PG8_SB(1, 1), b3 + hstep, voffB);
            PG8_WAIT_V(6); PG8_BAR; PG8_MMA(1, 1, At, B1); PG8_BAR;
            }
        }
        if constexpr (ALIGN_EPI) { if (wr == 0) PG8_BAR; }
        if constexpr (!Epi::AFTER_DRAIN) { E(acc, cur, wr, wc, fr, fq); S.done(cur); }
        if (!has_next) break;
#pragma unroll
        for (int a = 0; a < 2; ++a)
#pragma unroll
            for (int b = 0; b < 2; ++b)
#pragma unroll
                for (int m = 0; m < 4; ++m)
#pragma unroll
                    for (int n = 0; n < 2; ++n) acc[a][b][m][n] = (f32x4){0.f, 0.f, 0.f, 0.f};
        cur = nxt; cA = nA; cB = nB; ++ui;
        if constexpr (ALIGN_EPI) { if (wr == 1) PG8_BAR; }
    }
    PG8_WAIT_V(0);
    if constexpr (!ALIGN_EPI) { if (wr == 0) PG8_BAR; }
    PG8_BAR;
    if constexpr (Epi::AFTER_DRAIN) { E.fused(acc, cur, wr, wc, fr, fq, lds, wid, lane); S.done(cur); }
#undef PG8_SA
#undef PG8_SB
#undef PG8_STAGE
#undef PG8_LDA
#undef PG8_LDB
#undef PG8_MMA
#undef PG8_WAIT_V
#undef PG8_WAIT_L
#undef PG8_BAR
#undef PG8_SCHED
}
}
#define XB_TMO      128
#define XB_XCNT(j)  (256  + 64 * (j))
#define XB_XSUB(j)  (1280 + 64 * (j))
#define XB_XGEN(j)  (2304 + 64 * (j))
#define XB_TOP      3328
#define XB_TOPGEN   3392
#define XCD_BAR_WORDS 3456
#define XB_SPIN_CAP (1u << 18)
#define LAS __attribute__((address_space(3)))

__device__ __forceinline__ unsigned xb_ld(unsigned* p)              { return __hip_atomic_load(p, __ATOMIC_RELAXED, __HIP_MEMORY_SCOPE_AGENT); }
__device__ __forceinline__ unsigned xb_add(unsigned* p, unsigned v) { return __hip_atomic_fetch_add(p, v, __ATOMIC_RELAXED, __HIP_MEMORY_SCOPE_AGENT); }
__device__ __forceinline__ unsigned xb_xcc_id() { return (unsigned)__builtin_amdgcn_s_getreg((3 << 11) | 20) & 0xFu; }
#define XB_SPIN(cond, bar) do { unsigned _sp = 0; while (cond) { __builtin_amdgcn_s_sleep(1); \
    if ((++_sp & 255u) == 0u) { if (xb_ld(&(bar)[XB_TMO])) break; if (_sp > XB_SPIN_CAP) { atomicAdd(&(bar)[XB_TMO], 1u); break; } } } } while (0)

struct XcdBarrier {
    unsigned* bar; unsigned x;
    volatile LAS unsigned* st;
};

__device__ __forceinline__ XcdBarrier xcd_barrier_post(unsigned* bar, volatile LAS unsigned* st) {
    XcdBarrier b; b.bar = bar; b.x = xb_xcc_id(); b.st = st;
    if (threadIdx.x == 0) (void)xb_add(&bar[XB_XCNT(b.x)], 1u);
    return b;
}
__device__ __forceinline__ void xcd_barrier_complete(unsigned* bar, unsigned x, unsigned& nloc, unsigned& nx) {
    const unsigned G = gridDim.x * gridDim.y * gridDim.z;
    unsigned sum, cnt, mine, sp = 0u;
    for (;;) {
        sum = 0u; cnt = 0u; mine = 0u;
#pragma unroll
        for (unsigned j = 0; j < 16; ++j) { const unsigned c = xb_ld(&bar[XB_XCNT(j)]); sum += c; cnt += (c > 0u) ? 1u : 0u; mine = (j == x) ? c : mine; }
        if (sum == G) break;
        __builtin_amdgcn_s_sleep(1);
        if ((++sp & 255u) == 0u) { if (xb_ld(&bar[XB_TMO])) break; if (sp > XB_SPIN_CAP) { atomicAdd(&bar[XB_TMO], 1u); break; } }
    }
    nloc = mine > 0u ? mine : 1u; nx = cnt > 0u ? cnt : 1u;
}

__device__ __forceinline__ void xcd_barrier(const XcdBarrier& b) {
    asm volatile("s_waitcnt vmcnt(0)" ::: "memory");
    __syncthreads();
    if (threadIdx.x == 0) {
        unsigned* bar = b.bar;
        __builtin_amdgcn_s_waitcnt(0);
        const unsigned bx = xb_xcc_id();
        unsigned nloc = b.st[0], nx = b.st[1];
        if (nloc == 0u) { xcd_barrier_complete(bar, bx, nloc, nx); b.st[0] = nloc; b.st[1] = nx; }
        const unsigned old = xb_add(&bar[XB_XSUB(bx)], 1u);
        const unsigned gen = old / nloc;
        if (old + 1u == (gen + 1u) * nloc) {
            __builtin_amdgcn_fence(__ATOMIC_RELEASE, "agent");
            asm volatile("s_waitcnt vmcnt(0)" ::: "memory");
            const unsigned og = xb_add(&bar[XB_TOP], 1u);
            const unsigned tg = og / nx;
            if (og + 1u == (tg + 1u) * nx) xb_add(&bar[XB_TOPGEN], 1u);
            else XB_SPIN(xb_ld(&bar[XB_TOPGEN]) == tg, bar);
            __builtin_amdgcn_fence(__ATOMIC_ACQUIRE, "agent");
            xb_add(&bar[XB_XGEN(bx)], 1u);
            asm volatile("s_waitcnt vmcnt(0)" ::: "memory");
        } else {
            XB_SPIN(xb_ld(&bar[XB_XGEN(bx)]) == gen, bar);
            __builtin_amdgcn_fence(__ATOMIC_ACQUIRE, "agent");
            asm volatile("s_waitcnt vmcnt(0)" ::: "memory");
        }
    }
    __syncthreads();
}

struct Params {
    const float* x; const float* p; const int* pos;
    const float *w_in, *w_a, *w_b, *w_out, *lbraw, *hnorm_g, *ikn_g, *ikn_b, *lnm_g, *lnm_b, *w_fg, *w_fu, *w_fd, *lnf_g, *lnf_b, *w_pg, *w_pp, *lnp_g, *lnp_b;
    float* out; unsigned char* ws;
    double invf_h[64]; double invf_i[32];
    int ph_lo, ph_hi;
};
typedef const __attribute__((address_space(4))) Params* KP;
__device__ __forceinline__ KP kparams() { KP p = (KP)__builtin_amdgcn_kernarg_segment_ptr(); asm volatile("" : "+s"(p)); return p; }
constexpr int NPH_LAYER = 14, NPH = DEPTH * NPH_LAYER;
constexpr int LDS_BYTES = 131072 + 1024;
constexpr int MISC_OFF = 131072;

__device__ __forceinline__ int wsrc_col_in(int n) {
    const int tile = n >> 8, t = n & 255;
    if (tile < 16) return n;
    if (tile < 24) { const int bj = t >> 7, u = t & 127, head = u >> 6, i = u & 63; return tile * 256 + 128 * head + 64 * bj + i; }
    if (tile < 28) return n;
    if (tile < 32) { const int bj = t >> 7, u = t & 127, head = u >> 5, i = u & 31; return tile * 256 + 64 * head + 32 * bj + i; }
    if (tile < 40) return 8272 + (n - 32 * 256);
    if (tile < 48) return 10320 + (n - 40 * 256);
    return t < 80 ? 8192 + t : -1;
}
template <int KIND>
__device__ __forceinline__ void wconv_tile(const float* src, const float* src2, int nsrc, int K, bf16_t* dst, int n0, int k0, LAS float* tile) {
    const int tid = tid_(), nn = tid & 31, kk0 = tid >> 5;
    int c; const float* s = src;
    if (KIND == 0) c = n0 + nn;
    else if (KIND == 1) c = wsrc_col_in(n0 + nn);
    else { const int n = n0 + nn, tl = n >> 8, t = n & 255; c = tl * 128 + (t & 127); if (t >= 128) s = src2; }
#pragma unroll
    for (int r = 0; r < 8; ++r) { const int kk = kk0 + 16 * r; tile[kk * 33 + nn] = (c >= 0) ? s[(size_t)(k0 + kk) * nsrc + c] : 0.f; }
    __syncthreads();
    const int n = tid >> 4, k8 = (tid & 15) * 8;
    pg8::f32x4 a, b;
#pragma unroll
    for (int j = 0; j < 4; ++j) { a[j] = tile[(k8 + j) * 33 + n]; b[j] = tile[(k8 + 4 + j) * 33 + n]; }
    *(pg8::u32x4*)(dst + (size_t)(n0 + n) * K + k0 + k8) = pg8::pack8(a, b);
    __syncthreads();
}
template <int KIND>
__device__ __forceinline__ void wconv_job(const float* src, const float* src2, int nsrc, int K, bf16_t* dst, int ndst, LAS float* tile, int& tcount) {
    const int kt = K / 128, ntiles = (ndst / 32) * kt;
    const int G = nblk_(); int first = (bid_() - tcount % G + G) % G;
    for (int t = first; t < ntiles; t += G) wconv_tile<KIND>(src, src2, nsrc, K, dst, (t / kt) * 32, (t % kt) * 128, tile);
    tcount += ntiles;
}
__device__ __forceinline__ void phase_wconv(KP P, int layer, LAS float* tile) {
    unsigned char* ws = as_global(P->ws); int tc = 0;
    wconv_job<1>(as_global(P->w_in) + (size_t)layer * DM * INW, nullptr, INW, DM, (bf16_t*)(ws + WS_WIN), INP, tile, tc);
    wconv_job<0>(as_global(P->w_a) + (size_t)layer * AW * DM, nullptr, DM, AW, (bf16_t*)(ws + WS_WA), DM, tile, tc);
    wconv_job<0>(as_global(P->w_b) + (size_t)layer * BW * DM, nullptr, DM, BW, (bf16_t*)(ws + WS_WB), DM, tile, tc);
    wconv_job<0>(as_global(P->w_out) + (size_t)layer * DM * DM, nullptr, DM, DM, (bf16_t*)(ws + WS_WO), DM, tile, tc);
    wconv_job<2>(as_global(P->w_fg) + (size_t)layer * DM * DFF, as_global(P->w_fu) + (size_t)layer * DM * DFF, DFF, DM, (bf16_t*)(ws + WS_WGU), 2 * DFF, tile, tc);
    wconv_job<0>(as_global(P->w_fd) + (size_t)layer * DFF * DM, nullptr, DM, DFF, (bf16_t*)(ws + WS_WDN), DM, tile, tc);
    wconv_job<0>(as_global(P->w_pg) + (size_t)layer * DM * DM, nullptr, DM, DM, (bf16_t*)(ws + WS_WPG), DM, tile, tc);
    wconv_job<0>(as_global(P->w_pp) + (size_t)layer * PLE * DM, nullptr, DM, PLE, (bf16_t*)(ws + WS_WPP), DM, tile, tc);
    const float* ps = as_global(P->p) + (size_t)layer * TOK * PLE; bf16_t* pb = (bf16_t*)(ws + WS_PB);
    for (size_t i = ((size_t)bid_() * 512 + tid_()) * 8; i < (size_t)TOK * PLE; i += (size_t)nblk_() * 512 * 8)
        *(pg8::u32x4*)(pb + i) = pg8::pack8(*(const pg8::f32x4*)(ps + i), *(const pg8::f32x4*)(ps + i + 4));
}
__device__ __forceinline__ void phase_prologue(KP P) {
    unsigned char* ws = as_global(P->ws); const size_t gtid = (size_t)bid_() * 512 + tid_(), gsz = (size_t)nblk_() * 512;
    bf16_t* xb = (bf16_t*)(ws + WS_XB); const float* xin = as_global(P->x); const int* posg = as_global(P->pos); const float* lbr = as_global(P->lbraw);
    for (size_t i = gtid * 8; i < (size_t)TOK * DM; i += gsz * 8) *(pg8::u32x4*)(xb + i) = pg8::pack8(*(const pg8::f32x4*)(xin + i), *(const pg8::f32x4*)(xin + i + 4));
    float* ch = (float*)(ws + WS_COSH); float* sh = (float*)(ws + WS_SINH); float* ci = (float*)(ws + WS_COSI); float* si = (float*)(ws + WS_SINI);
    for (size_t i = gtid; i < (size_t)TOK * 64; i += gsz) { const int t = (int)(i >> 6), j = (int)(i & 63); const double rev = (double)posg[t] * P->invf_h[j]; const float fr = (float)(rev - rint(rev));
        ch[i] = __builtin_amdgcn_cosf(fr); sh[i] = __builtin_amdgcn_sinf(fr); }
    for (size_t i = gtid; i < (size_t)TOK * 32; i += gsz) { const int t = (int)(i >> 5), j = (int)(i & 31); const double rev = (double)posg[t] * P->invf_i[j]; const float fr = (float)(rev - rint(rev));
        ci[i] = __builtin_amdgcn_cosf(fr); si[i] = __builtin_amdgcn_sinf(fr); }
    float* lb = (float*)(ws + WS_LB);
    for (size_t c = gtid; c < 1024; c += gsz) { float v[4], mx = -1e30f; for (int l = 0; l < 4; ++l) { v[l] = lbr[l * 1024 + c]; mx = fmaxf(mx, v[l]); }
        float s = 0.f; for (int l = 0; l < 4; ++l) { v[l] = expf(v[l] - mx); s += v[l]; }
        float cum = 0.f; const float inv = 1.0f / s; for (int l = 0; l < 4; ++l) { cum += v[l] * inv; lb[l * 1024 + c] = cum - v[0] * inv; } }
}
__device__ __forceinline__ void phase_ln(const float* XP, float* X32, bf16_t* XB, const float* g, const float* b) {
    const int tid = tid_(), wave = tid >> 6, lane = tid & 63, nb8 = nblk_() * 8;
    for (int row = bid_() * 8 + wave; row < TOK; row += nb8) {
        const float* xp = XP + (size_t)row * DM; pg8::f32x4 v[8]; float s = 0.f;
#pragma unroll
        for (int c = 0; c < 8; ++c) { v[c] = *(const pg8::f32x4*)(xp + c * 256 + lane * 4); s += (v[c][0] + v[c][1]) + (v[c][2] + v[c][3]); }
#pragma unroll
        for (int o = 32; o >= 1; o >>= 1) s += __shfl_xor(s, o);
        const float mean = s * (1.0f / DM); float q = 0.f;
#pragma unroll
        for (int c = 0; c < 8; ++c) { v[c] = v[c] - mean; q += (v[c][0] * v[c][0] + v[c][1] * v[c][1]) + (v[c][2] * v[c][2] + v[c][3] * v[c][3]); }
#pragma unroll
        for (int o = 32; o >= 1; o >>= 1) q += __shfl_xor(q, o);
        const float rstd = 1.0f / sqrtf(q * (1.0f / DM) + LN_EPS);
#pragma unroll
        for (int c = 0; c < 8; ++c) { const int col = c * 256 + lane * 4; const pg8::f32x4 gg = *(const pg8::f32x4*)(g + col), bb = *(const pg8::f32x4*)(b + col);
            const pg8::f32x4 y = v[c] * rstd * gg + bb; *(pg8::f32x4*)(X32 + (size_t)row * DM + col) = y;
            pg8::u32x2 w; w.x = pg8::cvt_pk_bf16(y[0], y[1]); w.y = pg8::cvt_pk_bf16(y[2], y[3]); *(pg8::u32x2*)(XB + (size_t)row * DM + col) = w; }
    }
}
__device__ __forceinline__ void phase_ikprep(KP P, int layer) {
    unsigned char* ws = as_global(P->ws); const float* ikw = (const float*)(ws + WS_IKW); bf16_t* ki = (bf16_t*)(ws + WS_KI); float* wi = (float*)(ws + WS_WI);
    const float* ci = (const float*)(ws + WS_COSI); const float* si = (const float*)(ws + WS_SINI);
    const int tid = tid_(), wave = tid >> 6, lane = tid & 63, nb8 = nblk_() * 8;
    const float g = as_global(P->ikn_g)[layer * 64 + lane], b = as_global(P->ikn_b)[layer * 64 + lane];
    for (int t = bid_() * 8 + wave; t < TOK; t += nb8) {
        const float x = ikw[(size_t)t * 128 + lane]; float s = x;
#pragma unroll
        for (int o = 32; o >= 1; o >>= 1) s += __shfl_xor(s, o);
        const float mean = s * (1.0f / 64.0f), xc = x - mean; float q = xc * xc;
#pragma unroll
        for (int o = 32; o >= 1; o >>= 1) q += __shfl_xor(q, o);
        const float y = xc * (1.0f / sqrtf(q * (1.0f / 64.0f) + LN_EPS)) * g + b;
        const float other = __shfl_xor(y, 32); const int j = lane & 31; const float c = ci[(size_t)t * 32 + j], sn = si[(size_t)t * 32 + j];
        const float r = (lane < 32) ? (y * c - other * sn) : (other * sn + y * c);
        ki[(size_t)t * 64 + lane] = f2bf(r);
        if (lane < 16) wi[(size_t)t * 16 + lane] = ikw[(size_t)t * 128 + 64 + lane] * IDX_SCALE;
    }
}
__device__ __forceinline__ void phase_select(KP P, LAS unsigned char* lds) {
    unsigned char* ws = as_global(P->ws); const float* S = (const float*)(ws + WS_XPRE); unsigned long long* MASK = (unsigned long long*)(ws + WS_MASK);
    const int tid = tid_(), wave = tid >> 6, lane = tid & 63, nb8 = nblk_() * 8;
    for (int q = bid_() * 8 + wave; q < TOK; q += nb8) {
        const int b = q >> 12, s = q & 4095, c = s >> 6, nw = c + 1;
        unsigned long long myword = 0ull;
        if (nw <= TOPK / 64) { myword = (lane < nw) ? ~0ull : 0ull; }
        else {
            const float* row = S + (size_t)b * SCORE_B + (size_t)2048 * c * (c + 1) + (size_t)(s & 63) * (nw * 64);
            unsigned u[64];
#pragma unroll
            for (int j = 0; j < 64; ++j) { unsigned v = 0u; if (j < nw) { const unsigned bits = __float_as_uint(row[j * 64 + lane]); v = (bits & 0x80000000u) ? ~bits : (bits | 0x80000000u); } u[j] = v; }
            unsigned prefix = 0u;
            for (int bit = 31; bit >= 0; --bit) { const unsigned cand = prefix | (1u << bit); int cnt = 0;
#pragma unroll
                for (int j8 = 0; j8 < 8; ++j8) if (j8 * 8 < nw) {
#pragma unroll
                    for (int jj = 0; jj < 8; ++jj) cnt += __popcll(__ballot(u[j8 * 8 + jj] >= cand)); }
                if (cnt >= TOPK) prefix = cand; }
            LAS unsigned long long* sm = (LAS unsigned long long*)lds + wave * 64;
#pragma unroll
            for (int j = 0; j < 64; ++j) { const unsigned long long w = __ballot(u[j] >= prefix); if (lane == 0) sm[j] = w; }
            myword = sm[lane];
        }
        MASK[(size_t)q * 64 + lane] = myword;
    }
}

__global__ __launch_bounds__(128) void k_hgrn_naive(const bf16_t* QA, const bf16_t* KA, const bf16_t* VA, const bf16_t* GA, const float* LF, const float* norm_g, bf16_t* YA) {
    const int bh = blockIdx.x, b = bh >> 3, h = bh & 7, v = threadIdx.x;
    __shared__ float sf[16][128], sk[16][128], sq[16][128]; __shared__ float red[2];
    float S[128];
#pragma unroll
    for (int k = 0; k < 128; ++k) S[k] = 0.f;
    const float ng = norm_g[v];
    for (int t0 = 0; t0 < SEQ; t0 += 16) {
        for (int i = 0; i < 16; ++i) { const size_t idx = ((size_t)(b * SEQ + t0 + i)) * 1024 + h * 128 + v; sf[i][v] = expf(LF[idx]); sk[i][v] = bf2f(KA[idx]); sq[i][v] = bf2f(QA[idx]); }
        __syncthreads();
        for (int i = 0; i < 16; ++i) { const size_t idx = ((size_t)(b * SEQ + t0 + i)) * 1024 + h * 128 + v; const float vt = bf2f(VA[idx]); float o = 0.f;
#pragma unroll
            for (int k = 0; k < 128; ++k) { S[k] = sf[i][k] * S[k] + sk[i][k] * vt; o += S[k] * sq[i][k]; }
            float ss = o * o;
#pragma unroll
            for (int m = 32; m >= 1; m >>= 1) ss += __shfl_xor(ss, m);
            if ((v & 63) == 0) red[v >> 6] = ss;
            __syncthreads();
            const float tot = red[0] + red[1];
            const float y = o * (1.0f / sqrtf(tot * (1.0f / 128.0f) + RMS_EPS)) * ng * bf2f(GA[idx]);
            YA[idx] = f2bf(y);
            __syncthreads(); }
    }
}
__global__ __launch_bounds__(256) void k_idx_naive(const bf16_t* QI, const bf16_t* KI, const float* WI, float* S) {
    const int q = blockIdx.x, b = q >> 12, s = q & 4095, c = s >> 6, nw = c + 1, nk = nw * 64;
    if (nw <= TOPK / 64) return;
    __shared__ float qs[1024]; __shared__ float wsh[16];
    for (int i = threadIdx.x; i < 1024; i += 256) qs[i] = bf2f(QI[(size_t)q * 1024 + i]);
    if (threadIdx.x < 16) wsh[threadIdx.x] = WI[(size_t)q * 16 + threadIdx.x];
    __syncthreads();
    float* row = S + (size_t)b * SCORE_B + (size_t)2048 * c * (c + 1) + (size_t)(s & 63) * nk;
    for (int key = threadIdx.x; key < nk; key += 256) {
        float kf[64]; const bf16_t* kp = KI + ((size_t)b * SEQ + key) * 64;
#pragma unroll
        for (int d = 0; d < 64; ++d) kf[d] = bf2f(kp[d]);
        float sc = 0.f;
        for (int h = 0; h < 16; ++h) { float dot = 0.f;
#pragma unroll
            for (int d = 0; d < 64; ++d) dot += qs[h * 64 + d] * kf[d];
            sc += wsh[h] * fmaxf(dot, 0.f); }
        row[key] = sc;
    }
}
__global__ __launch_bounds__(512) void k_attn_naive(const bf16_t* QB, const bf16_t* KB, const bf16_t* VB, const unsigned long long* MASK, bf16_t* YB) {
    const int q = blockIdx.x, b = q >> 12, s = q & 4095, nw = (s >> 6) + 1, h = threadIdx.x >> 6, lane = threadIdx.x & 63;
    __shared__ float qs[8][128]; __shared__ int keys[8][320]; __shared__ float lg[8][320];
    qs[h][lane] = bf2f(QB[(size_t)q * 1024 + h * 128 + lane]); qs[h][lane + 64] = bf2f(QB[(size_t)q * 1024 + h * 128 + 64 + lane]);
    __syncthreads();
    int cnt = 0;
    for (int j = 0; j < nw; ++j) { const unsigned long long w = MASK[(size_t)q * 64 + j]; const bool on = (w >> lane) & 1ull; const int key = j * 64 + lane;
        if (on) { const bf16_t* kp = KB + ((size_t)b * SEQ + key) * 1024 + h * 128; float dot = 0.f;
            for (int d = 0; d < 128; ++d) dot += qs[h][d] * bf2f(kp[d]);
            const int pos = cnt + __popcll(w & ((1ull << lane) - 1ull));
            if (pos < 320) { keys[h][pos] = key; lg[h][pos] = dot * ATTN_SCALE; } }
        cnt += __popcll(w); }
    if (cnt > 320) cnt = 320;
    __syncthreads();
    float mx = -1e30f; for (int e = lane; e < cnt; e += 64) mx = fmaxf(mx, lg[h][e]);
#pragma unroll
    for (int m = 32; m >= 1; m >>= 1) mx = fmaxf(mx, __shfl_xor(mx, m));
    float sum = 0.f; for (int e = lane; e < cnt; e += 64) { const float pe = expf(lg[h][e] - mx); lg[h][e] = pe; sum += pe; }
#pragma unroll
    for (int m = 32; m >= 1; m >>= 1) sum += __shfl_xor(sum, m);
    __syncthreads();
    float a0 = 0.f, a1 = 0.f;
    for (int e = 0; e < cnt; ++e) { const float pe = lg[h][e]; const bf16_t* vp = VB + ((size_t)b * SEQ + keys[h][e]) * 1024 + h * 128 + 2 * lane; a0 += pe * bf2f(vp[0]); a1 += pe * bf2f(vp[1]); }
    const float inv = 1.0f / sum;
    YB[(size_t)q * 1024 + h * 128 + 2 * lane] = f2bf(a0 * inv); YB[(size_t)q * 1024 + h * 128 + 2 * lane + 1] = f2bf(a1 * inv);
}

__global__ __launch_bounds__(256) void k_dump(const unsigned char* ws, int which, float* out) {
    for (size_t i = (size_t)blockIdx.x * 256 + threadIdx.x; i < (size_t)TOK * DM; i += (size_t)gridDim.x * 256) {
        const size_t t = i / DM, c = i % DM; float v = 0.f;
        if (which == 0) { v = bf2f(((const bf16_t*)(ws + WS_MG))[i]) + ((const float*)(ws + WS_PP))[i]; }
        else if (which == 1) { const size_t j = t * 1024 + (c & 1023);
            v = bf2f(((const bf16_t*)(ws + WS_QA))[j]) + bf2f(((const bf16_t*)(ws + WS_KA))[j]) + bf2f(((const bf16_t*)(ws + WS_VA))[j]) + bf2f(((const bf16_t*)(ws + WS_GA))[j])
              + bf2f(((const bf16_t*)(ws + WS_QB))[j]) + bf2f(((const bf16_t*)(ws + WS_KB))[j]) + bf2f(((const bf16_t*)(ws + WS_VB))[j]) + bf2f(((const bf16_t*)(ws + WS_QI))[j])
              + ((const float*)(ws + WS_LF))[j] + bf2f(((const bf16_t*)(ws + WS_SGA))[i]) + bf2f(((const bf16_t*)(ws + WS_SGB))[i]) + ((const float*)(ws + WS_IKW))[t * 128 + (c & 127)]; }
        else if (which == 2) { const size_t j = t * 1024 + (c & 1023); v = (c < 1024) ? bf2f(((const bf16_t*)(ws + WS_YA))[j]) : bf2f(((const bf16_t*)(ws + WS_YB))[j]); }
        else if (which == 3) { v = ((const float*)(ws + WS_XPRE))[i]; }
        else if (which == 4) { v = ((const float*)(ws + WS_X32))[i]; }
        else if (which == 5) { v = bf2f(((const bf16_t*)(ws + WS_H))[t * DFF + c]) + bf2f(((const bf16_t*)(ws + WS_H))[t * DFF + 2048 + c]) + bf2f(((const bf16_t*)(ws + WS_H))[t * DFF + 3584 + c]); }
        else if (which == 6) { const unsigned long long m = ((const unsigned long long*)(ws + WS_MASK))[t * 64 + (c & 63)]; v = (float)__popcll(m) + (float)(unsigned)(m % 1000003ull) * 1e-3f; }
        else if (which == 7) { v = bf2f(((const bf16_t*)(ws + WS_WIN))[i % ((size_t)INP * DM)]) + bf2f(((const bf16_t*)(ws + WS_WGU))[(i * 7) % ((size_t)2 * DFF * DM)]) + bf2f(((const bf16_t*)(ws + WS_WDN))[(i * 3) % ((size_t)DFF * DM)]); }
        else if (which == 8) { v = bf2f(((const bf16_t*)(ws + WS_XB))[i]) + ((const float*)(ws + WS_COSH))[i % ((size_t)TOK * 64)] + ((const float*)(ws + WS_SINI))[i % ((size_t)TOK * 32)] + ((const float*)(ws + WS_LB))[i % 4096]; }
        else if (which == 9) { v = bf2f(((const bf16_t*)(ws + WS_H))[t * 6272 + c]) + bf2f(((const bf16_t*)(ws + WS_H))[t * 6272 + 2048 + c]) + bf2f(((const bf16_t*)(ws + WS_H))[t * 6272 + 4096 + c]) + bf2f(((const bf16_t*)(ws + WS_H))[t * 6272 + 4224 + c]); }
        else if (which == 10) { const size_t j = t * 1024 + (c & 1023); v = bf2f(((const bf16_t*)(ws + WS_QA))[j]) + bf2f(((const bf16_t*)(ws + WS_VA))[j]) + bf2f(((const bf16_t*)(ws + WS_GA))[j]) + bf2f(((const bf16_t*)(ws + WS_VB))[j]) + bf2f(((const bf16_t*)(ws + WS_SGA))[i]) + bf2f(((const bf16_t*)(ws + WS_SGB))[i]); }
        else if (which == 11) { const size_t j = t * 1024 + (c & 1023); v = bf2f(((const bf16_t*)(ws + WS_QB))[j]) + bf2f(((const bf16_t*)(ws + WS_KB))[j]) + bf2f(((const bf16_t*)(ws + WS_QI))[j]); }
        else if (which == 12) { const size_t j = t * 1024 + (c & 1023); v = ((const float*)(ws + WS_LF))[j] + bf2f(((const bf16_t*)(ws + WS_KA))[j]); }
        else if (which == 14) { v = ((const float*)(ws + WS_IKW))[t * 128 + (c & 127)]; }
        else if (which == 15) { const size_t j = t * 1024 + (c & 1023); v = bf2f(((const bf16_t*)(ws + WS_QA))[j]) + bf2f(((const bf16_t*)(ws + WS_GA))[j]); }
        else if (which == 16) { v = bf2f(((const bf16_t*)(ws + WS_SGA))[i]) + bf2f(((const bf16_t*)(ws + WS_SGB))[i]); }
        else if (which == 17) { const size_t j = t * 1024 + (c & 1023); v = bf2f(((const bf16_t*)(ws + WS_VA))[j]) + bf2f(((const bf16_t*)(ws + WS_VB))[j]); }
        out[i] = v;
    }
}
#ifndef OPT_HGRN
#define OPT_HGRN 0
#endif
#ifndef OPT_IDX
#define OPT_IDX 0
#endif
#ifndef OPT_ATT
#define OPT_ATT 0
#endif
#ifndef PHM
#define PHM 0x3fff
#endif
#ifndef ONE_LAUNCH
#define ONE_LAUNCH 0
#endif

__global__ void __launch_bounds__(512, 2) mega(Params P_unused) {
    extern __shared__ __attribute__((aligned(16))) unsigned char lds[];
    LAS unsigned char* L = (LAS unsigned char*)lds;
    volatile LAS unsigned* misc = (volatile LAS unsigned*)(L + MISC_OFF);
    if (threadIdx.x < 4) misc[threadIdx.x] = 0u;
    __syncthreads();
    int lo, hi; unsigned char* ws0; { KP P0 = kparams(); lo = P0->ph_lo; hi = P0->ph_hi; ws0 = as_global(P0->ws); }
    XcdBarrier bar; bar.bar = (unsigned*)(ws0 + WS_CTL); bar.x = 0; bar.st = misc;
    if (hi - lo > 1) bar = xcd_barrier_post((unsigned*)(ws0 + WS_CTL), misc);
#define WSP(T_, off) ((T_*)(ws + (off)))
#define WSL KP P = kparams(); unsigned char* ws = as_global(P->ws); const int G = nblk_(), bid = bid_(); (void)G; (void)bid

    for (int layer = 0; layer < DEPTH; ++layer) {
        const int base = layer * NPH_LAYER;
#define IN(k) (((PHM >> (k)) & 1) && lo <= base + (k) && base + (k) < hi)
#define SEAM(k) do { if (base + (k) + 1 < hi) xcd_barrier(bar); } while (0)
        if (IN(0)) { WSL; if (layer == 0) phase_prologue(P); phase_wconv(P, layer, (LAS float*)L); SEAM(0); }
        if (IN(1)) { WSL;
            pg8::Gemm g{WSP(const bf16_t, WS_XB), WSP(const bf16_t, WS_WIN), TOK, INP, DM}; pg8::StaticOrder S; S.init(TOK, INP, G, bid);
#ifdef RAWTEST
            pg8::EpiRawTest E{ws};
            pg8::gemm_phase<pg8::EpiRawTest, pg8::StaticOrder, true, true>(L, g, S, E); SEAM(1);
#else
            pg8::EpiIn E{ws, layer};
            pg8::gemm_phase<pg8::EpiIn, pg8::StaticOrder, true, true>(L, g, S, E); SEAM(1);
#endif
        }
        if (IN(2)) { WSL; phase_ikprep(P, layer); SEAM(2); }
        if (IN(3)) { WSL; SEAM(3); }
        if (IN(4)) { WSL; phase_select(P, L); SEAM(4); }
        if (IN(5)) { WSL; SEAM(5); }
        if (IN(6)) { WSL;
            { pg8::Gemm g{WSP(const bf16_t, WS_YA), WSP(const bf16_t, WS_WA), TOK, DM, AW}; pg8::StaticOrder S; S.init(TOK, DM, G, bid);
              pg8::EpiGateA E{ws}; pg8::gemm_phase<pg8::EpiGateA, pg8::StaticOrder, true, true>(L, g, S, E); }
            { pg8::Gemm g{WSP(const bf16_t, WS_YB), WSP(const bf16_t, WS_WB), TOK, DM, BW}; pg8::StaticOrder S; S.init(TOK, DM, G, bid);
              pg8::EpiGateB E{ws}; pg8::gemm_phase<pg8::EpiGateB, pg8::StaticOrder, true, true>(L, g, S, E); }
            { pg8::Gemm g{WSP(const bf16_t, WS_PB), WSP(const bf16_t, WS_WPP), TOK, DM, PLE}; pg8::StaticOrder S; S.init(TOK, DM, G, bid);
              pg8::EpiF32P E{ws}; pg8::gemm_phase<pg8::EpiF32P, pg8::StaticOrder, true, true>(L, g, S, E); }
            SEAM(6);
        }
        if (IN(7)) { WSL;
            pg8::Gemm g{WSP(const bf16_t, WS_MG), WSP(const bf16_t, WS_WO), TOK, DM, DM}; pg8::StaticOrder S; S.init(TOK, DM, G, bid);
            pg8::EpiRes E{layer == 0 ? as_global(P->x) : WSP(const float, WS_X32), ws}; pg8::gemm_phase<pg8::EpiRes, pg8::StaticOrder, true, true>(L, g, S, E); SEAM(7);
        }
        if (IN(8)) { WSL; phase_ln(WSP(const float, WS_XPRE), WSP(float, WS_X32), WSP(bf16_t, WS_XB), as_global(P->lnm_g) + layer * DM, as_global(P->lnm_b) + layer * DM); SEAM(8); }
        if (IN(9)) { WSL;
            pg8::Gemm g{WSP(const bf16_t, WS_XB), WSP(const bf16_t, WS_WGU), TOK, 2 * DFF, DM}; pg8::StaticOrder S; S.init(TOK, 2 * DFF, G, bid);
            pg8::EpiSwiGLU E{ws}; pg8::gemm_phase<pg8::EpiSwiGLU, pg8::StaticOrder, true, true>(L, g, S, E); SEAM(9);
        }
        if (IN(10)) { WSL;
            pg8::Gemm g{WSP(const bf16_t, WS_H), WSP(const bf16_t, WS_WDN), TOK, DM, DFF}; pg8::StaticOrder S; S.init(TOK, DM, G, bid);
            pg8::EpiRes E{WSP(const float, WS_X32), ws}; pg8::gemm_phase<pg8::EpiRes, pg8::StaticOrder, true, true>(L, g, S, E); SEAM(10);
        }
        if (IN(11)) { WSL; phase_ln(WSP(const float, WS_XPRE), WSP(float, WS_X32), WSP(bf16_t, WS_XB), as_global(P->lnf_g) + layer * DM, as_global(P->lnf_b) + layer * DM); SEAM(11); }
        if (IN(12)) { WSL;
            pg8::Gemm g{WSP(const bf16_t, WS_XB), WSP(const bf16_t, WS_WPG), TOK, DM, DM}; pg8::StaticOrder S; S.init(TOK, DM, G, bid);
            pg8::EpiPle E{ws}; pg8::gemm_phase<pg8::EpiPle, pg8::StaticOrder, true, true>(L, g, S, E); SEAM(12);
        }
        if (IN(13)) { WSL; phase_ln(WSP(const float, WS_XPRE), layer == DEPTH - 1 ? as_global(P->out) : WSP(float, WS_X32), WSP(bf16_t, WS_XB), as_global(P->lnp_g) + layer * DM, as_global(P->lnp_b) + layer * DM); SEAM(13); }
#undef IN
#undef SEAM
    }
}

extern "C" void kernel_launch(void* const* d_in, const int* in_sizes, int n_in, void* d_out, int out_size, void* d_ws, size_t ws_size, hipStream_t stream) {
    static int grid = 0;
    if (grid == 0) {
        if (n_in != 22 || out_size != TOK * DM || ws_size < WS_END) { fprintf(stderr, "kernel_launch: unexpected shapes: n_in %d out %d ws %zu (need %zu)\n", n_in, out_size, ws_size, (size_t)WS_END); grid = -1; return; }
        int dev = 0, cus = 0, per_cu = 0;
        if (hipGetDevice(&dev) != hipSuccess || hipDeviceGetAttribute(&cus, hipDeviceAttributeMultiprocessorCount, dev) != hipSuccess) { grid = -1; return; }
        if (hipFuncSetAttribute((const void*)mega, hipFuncAttributeMaxDynamicSharedMemorySize, LDS_BYTES) != hipSuccess) { fprintf(stderr, "kernel_launch: hipFuncSetAttribute failed\n"); grid = -1; return; }
        if (hipOccupancyMaxActiveBlocksPerMultiprocessor(&per_cu, (const void*)mega, 512, LDS_BYTES) != hipSuccess || per_cu < 1) { fprintf(stderr, "kernel_launch: occupancy query says %d\n", per_cu); (void)hipGetLastError(); }
        grid = cus;
    }
    if (grid < 0) return;
    (void)hipMemsetAsync((char*)d_ws + WS_CTL, 0, 65536, stream);
    Params P{};
    P.x = (const float*)d_in[0]; P.p = (const float*)d_in[1]; P.pos = (const int*)d_in[2];
    P.w_in = (const float*)d_in[3]; P.w_a = (const float*)d_in[4]; P.w_b = (const float*)d_in[5]; P.w_out = (const float*)d_in[6];
    P.lbraw = (const float*)d_in[7]; P.hnorm_g = (const float*)d_in[8]; P.ikn_g = (const float*)d_in[9]; P.ikn_b = (const float*)d_in[10];
    P.lnm_g = (const float*)d_in[11]; P.lnm_b = (const float*)d_in[12]; P.w_fg = (const float*)d_in[13]; P.w_fu = (const float*)d_in[14]; P.w_fd = (const float*)d_in[15];
    P.lnf_g = (const float*)d_in[16]; P.lnf_b = (const float*)d_in[17]; P.w_pg = (const float*)d_in[18]; P.w_pp = (const float*)d_in[19];
    P.lnp_g = (const float*)d_in[20]; P.lnp_b = (const float*)d_in[21];
    P.out = (float*)d_out; P.ws = (unsigned char*)d_ws;
    for (int j = 0; j < 64; ++j) P.invf_h[j] = pow(10000.0, -(double)j / 64.0) / 6.283185307179586476925286766559;
    for (int j = 0; j < 32; ++j) P.invf_i[j] = pow(10000.0, -(double)j / 32.0) / 6.283185307179586476925286766559;
#if ONE_LAUNCH
    P.ph_lo = 0; P.ph_hi = NPH;
    hipLaunchKernelGGL(mega, dim3(grid), dim3(512), LDS_BYTES, stream, P);
#elif defined(SEQ_TEST)
    { const int seq[] = SEQ_TEST; for (int i = 0; i < (int)(sizeof(seq) / sizeof(int)); ++i) { P.ph_lo = seq[i]; P.ph_hi = seq[i] + 1; hipLaunchKernelGGL(mega, dim3(grid), dim3(512), LDS_BYTES, stream, P); }
      hipLaunchKernelGGL(k_dump, dim3(4096), dim3(256), 0, stream, (const unsigned char*)d_ws, DUMP_WHICH, (float*)d_out); }
#else
    unsigned char* ws = (unsigned char*)d_ws;
    for (int layer = 0; layer < DEPTH; ++layer)
        for (int k = 0; k < NPH_LAYER; ++k) {
            P.ph_lo = layer * NPH_LAYER + k; P.ph_hi = P.ph_lo + 1;
            bool run_mega = true;
#if !OPT_HGRN
            if (k == 3) hipLaunchKernelGGL(k_hgrn_naive, dim3(32), dim3(128), 0, stream, (const bf16_t*)(ws + WS_QA), (const bf16_t*)(ws + WS_KA), (const bf16_t*)(ws + WS_VA), (const bf16_t*)(ws + WS_GA),
                                           (const float*)(ws + WS_LF), P.hnorm_g + layer * 128, (bf16_t*)(ws + WS_YA));
#endif
#if !OPT_IDX
            if (k == 3) hipLaunchKernelGGL(k_idx_naive, dim3(TOK), dim3(256), 0, stream, (const bf16_t*)(ws + WS_QI), (const bf16_t*)(ws + WS_KI), (const float*)(ws + WS_WI), (float*)(ws + WS_XPRE));
#endif
#if !OPT_ATT
            if (k == 5) hipLaunchKernelGGL(k_attn_naive, dim3(TOK), dim3(512), 0, stream, (const bf16_t*)(ws + WS_QB), (const bf16_t*)(ws + WS_KB), (const bf16_t*)(ws + WS_VB),
                                           (const unsigned long long*)(ws + WS_MASK), (bf16_t*)(ws + WS_YB));
#endif
#if !OPT_HGRN && !OPT_IDX
            if (k == 3) run_mega = false;
#endif
#if !OPT_ATT
            if (k == 5) run_mega = false;
#endif
            if (run_mega) hipLaunchKernelGGL(mega, dim3(grid), dim3(512), LDS_BYTES, stream, P);
#ifdef DUMP_AT
            if (layer * NPH_LAYER + k == DUMP_AT) { hipLaunchKernelGGL(k_dump, dim3(4096), dim3(256), 0, stream, (const unsigned char*)ws, DUMP_WHICH, (float*)d_out); return; }
#endif
        }
#endif
    const hipError_t le = hipPeekAtLastError();
    if (le != hipSuccess) fprintf(stderr, "kernel_launch: launch failed: %s\n", hipGetErrorName(le));
}
```

```cpp
#include <hip/hip_runtime.h>
#include <cstdio>
#include <cstdint>

constexpr int DM = 2048, NBATCH = 4, SEQ = 4096, TOK = NBATCH * SEQ, DEPTH = 4, CHUNK = 64, PLE = 256;
constexpr int AH = 8, AD = 128, AW = 1024, BH = 8, BD = 128, BW = 1024, IH = 16, IDIM = 64, TOPK = 256;
constexpr int DFF = 5632, INW = 12368, INP = 12544;
constexpr float ALPHA = 1.6817928305074290861f;
constexpr float LN_EPS = 1e-5f, RMS_EPS = 1e-6f;
constexpr float ATTN_SCALE = 0.088388347648318440f;
constexpr float IDX_SCALE = 0.03125f;

typedef unsigned short bf16_t;
__device__ __forceinline__ float bf2f(bf16_t b) { return __uint_as_float(((unsigned)b) << 16); }
__device__ __forceinline__ bf16_t f2bf(float f) { unsigned u = __float_as_uint(f); u += 0x7FFFu + ((u >> 16) & 1u); return (bf16_t)(u >> 16); }
__device__ __forceinline__ float sigmoid_f(float x) { return __builtin_amdgcn_rcpf(1.0f + __expf(-x)); }
__device__ __forceinline__ float silu_f(float x) { return x * sigmoid_f(x); }

__device__ __forceinline__ int tid_() { int t = (int)threadIdx.x; asm volatile("" : "+v"(t)); return t; }
__device__ __forceinline__ int bid_() { int b = (int)blockIdx.x; asm volatile("" : "+s"(b)); return b; }
__device__ __forceinline__ int nblk_() { int g = (int)gridDim.x; asm volatile("" : "+s"(g)); return g; }

template <class T> __device__ __forceinline__ T* as_global(T* p) { return (T*)(__attribute__((address_space(1))) T*)p; }

constexpr size_t MiB = 1048576;
constexpr size_t WS_CTL  = 0;
constexpr size_t WS_LB   = WS_CTL + 65536;
constexpr size_t WS_COSH = 1 * MiB;
constexpr size_t WS_SINH = WS_COSH + 4 * MiB;
constexpr size_t WS_COSI = WS_SINH + 4 * MiB;
constexpr size_t WS_SINI = WS_COSI + 2 * MiB;
constexpr size_t WS_WIN  = WS_SINI + 2 * MiB;
constexpr size_t WS_WA   = WS_WIN + 49 * MiB;
constexpr size_t WS_WB   = WS_WA + 4 * MiB;
constexpr size_t WS_WO   = WS_WB + 4 * MiB;
constexpr size_t WS_WGU  = WS_WO + 8 * MiB;
constexpr size_t WS_WDN  = WS_WGU + 44 * MiB;
constexpr size_t WS_WPG  = WS_WDN + 22 * MiB;
constexpr size_t WS_WPP  = WS_WPG + 8 * MiB;
constexpr size_t WS_X32  = WS_WPP + 1 * MiB;
constexpr size_t WS_XB   = WS_X32 + 128 * MiB;
constexpr size_t WS_XPRE = WS_XB + 64 * MiB;
constexpr size_t WS_R1   = WS_XPRE + 130 * MiB;
constexpr size_t WS_QA   = WS_R1;
constexpr size_t WS_LF   = WS_QA + 32 * MiB;
constexpr size_t WS_KA   = WS_LF + 64 * MiB;
constexpr size_t WS_VA   = WS_KA + 32 * MiB;
constexpr size_t WS_GA   = WS_VA + 32 * MiB;
constexpr size_t WS_QB   = WS_GA + 32 * MiB;
constexpr size_t WS_KB   = WS_QB + 32 * MiB;
constexpr size_t WS_VB   = WS_KB + 32 * MiB;
constexpr size_t WS_QI   = WS_VB + 32 * MiB;
constexpr size_t WS_SGA  = WS_QI + 32 * MiB;
constexpr size_t WS_SGB  = WS_SGA + 64 * MiB;
constexpr size_t WS_IKW  = WS_SGB + 64 * MiB;
constexpr size_t WS_H    = WS_R1;
constexpr size_t WS_PP   = WS_R1 + 176 * MiB;
constexpr size_t WS_R2   = WS_IKW + 8 * MiB;
constexpr size_t WS_LT   = WS_R2;
constexpr size_t WS_MG   = WS_R2;
constexpr size_t WS_PT   = WS_LT + 128 * MiB;
constexpr size_t WS_DEC  = WS_PT + 64 * MiB;
constexpr size_t WS_MASK = WS_DEC + 1 * MiB;
constexpr size_t WS_YA   = WS_MASK + 8 * MiB;
constexpr size_t WS_YB   = WS_YA + 32 * MiB;
constexpr size_t WS_KI   = WS_YB + 32 * MiB;
constexpr size_t WS_WI   = WS_KI + 2 * MiB;
constexpr size_t WS_PB   = WS_WI + 1 * MiB;
constexpr size_t WS_END  = WS_PB + 8 * MiB;
static_assert(WS_END < 1360000000ull, "workspace budget");
constexpr size_t SCORE_B = (size_t)4096 * 2080;

namespace pg8 {
#define PG8_LAS __attribute__((address_space(3)))
typedef unsigned short bf16_t;
typedef short bf16x8 __attribute__((ext_vector_type(8)));
typedef float f32x4 __attribute__((ext_vector_type(4)));
typedef unsigned u32x4 __attribute__((ext_vector_type(4)));
constexpr int BM = 256, BK = 64, HALF = 128, HTB = HALF * BK * 2  , STAGE_BYTES = 8 * HTB, NXCD = 8, WGM = 8;

__host__ __device__ __forceinline__ int lds_byte(int r, int c) { const int st = (r >> 4) * 2 + (c >> 5), rr = r & 15, cc = c & 31, ob = rr * 64 + cc * 2; return st * 1024 + (ob ^ (((ob >> 9) & 1) << 5)); }
__host__ __device__ __forceinline__ void stage_rc(int b, int& R, int& C) { const int st = b / 1024, sb = b % 1024, swz = sb ^ (((sb >> 9) & 1) << 5); R = (st >> 1) * 16 + swz / 64; C = (st & 1) * 32 + (swz % 64) / 2; }
__host__ __device__ __forceinline__ int perm32(int rho) { const int n = rho >> 4, i = rho & 15; return 8 * (i >> 2) + 4 * n + (i & 3); }

struct Unit { int pm, pn; };
struct Gemm { const bf16_t* A; const bf16_t* Bt; int M, N, K; };

struct StaticOrder {
    int nM, nN, nwg, G, c;
    __host__ __device__ void init(int M, int N, int G_, int c_) { nM = M / BM; nN = N / BM; nwg = nM * nN; G = G_; c = c_; }
    __host__ __device__ bool next(int i, Unit& u) const {
        const long L = (long)i * G + c; if (L >= nwg) return false;
        int wgid = (int)L; { const int q = nwg / NXCD, r = nwg % NXCD, xcd = wgid % NXCD, off = wgid / NXCD; wgid = (xcd < r ? xcd * (q + 1) : r * (q + 1) + (xcd - r) * q) + off; }
        const int nig = WGM * nN, gid = wgid / nig, fm = gid * WGM, gsz = (nM - fm) < WGM ? (nM - fm) : WGM;
        u.pm = fm + ((wgid % nig) % gsz); u.pn = (wgid % nig) / gsz; return true;
    }
    __device__ __forceinline__ void a_ready(const Unit&) const {}
    __device__ __forceinline__ void done(const Unit&) const {}
};

typedef float pk_f32x2 __attribute__((ext_vector_type(2)));
typedef __bf16 pk_bf16x2 __attribute__((ext_vector_type(2)));
__device__ __forceinline__ unsigned cvt_pk_bf16(float lo, float hi) { const pk_f32x2 v = {lo, hi}; const pk_bf16x2 b = __builtin_convertvector(v, pk_bf16x2); return __builtin_bit_cast(unsigned, b); }
typedef unsigned u32x2 __attribute__((ext_vector_type(2)));
__device__ __forceinline__ u32x4 pack8(const f32x4 a, const f32x4 b) { u32x4 w; w.x = cvt_pk_bf16(a[0], a[1]); w.y = cvt_pk_bf16(a[2], a[3]); w.z = cvt_pk_bf16(b[0], b[1]); w.w = cvt_pk_bf16(b[2], b[3]); return w; }
__device__ __forceinline__ void unpack8(const u32x4 w, f32x4& a, f32x4& b) {
    a[0] = __uint_as_float(w.x << 16); a[1] = __uint_as_float(w.x & 0xffff0000u); a[2] = __uint_as_float(w.y << 16); a[3] = __uint_as_float(w.y & 0xffff0000u);
    b[0] = __uint_as_float(w.z << 16); b[1] = __uint_as_float(w.z & 0xffff0000u); b[2] = __uint_as_float(w.w << 16); b[3] = __uint_as_float(w.w & 0xffff0000u); }
__device__ __forceinline__ float sigm(float x) { return __builtin_amdgcn_rcpf(1.0f + __expf(-x)); }
__device__ __forceinline__ f32x4 sigm4(const f32x4 x) { f32x4 r; r[0] = sigm(x[0]); r[1] = sigm(x[1]); r[2] = sigm(x[2]); r[3] = sigm(x[3]); return r; }
__device__ __forceinline__ f32x4 silu4(const f32x4 x) { return x * sigm4(x); }

#define PG8_GAS __attribute__((address_space(1)))
struct EpiIn {
    static constexpr bool PERM = true, AFTER_DRAIN = false;
    unsigned char* ws0; int layer;
    __device__ __forceinline__ void operator()(const f32x4 (&acc)[2][2][4][2], const Unit& u, int wr, int wc, int fr, int fq) const {
        unsigned char* wsq = ws0; asm volatile("" : "+s"(wsq)); PG8_GAS unsigned char* const ws = (PG8_GAS unsigned char*)wsq;
        const int pn = u.pn, row0 = u.pm * BM + wr * 64 + fr, cw = wc * 32 + 8 * fq;
        PG8_GAS bf16_t* const QA = (PG8_GAS bf16_t*)(ws + WS_QA); PG8_GAS bf16_t* const KA = (PG8_GAS bf16_t*)(ws + WS_KA); PG8_GAS bf16_t* const VA = (PG8_GAS bf16_t*)(ws + WS_VA); PG8_GAS bf16_t* const GA = (PG8_GAS bf16_t*)(ws + WS_GA);
        PG8_GAS bf16_t* const QB = (PG8_GAS bf16_t*)(ws + WS_QB); PG8_GAS bf16_t* const KB = (PG8_GAS bf16_t*)(ws + WS_KB); PG8_GAS bf16_t* const VB = (PG8_GAS bf16_t*)(ws + WS_VB); PG8_GAS bf16_t* const QI = (PG8_GAS bf16_t*)(ws + WS_QI);
        PG8_GAS bf16_t* const SGA = (PG8_GAS bf16_t*)(ws + WS_SGA); PG8_GAS bf16_t* const SGB = (PG8_GAS bf16_t*)(ws + WS_SGB); PG8_GAS float* const LF = (PG8_GAS float*)(ws + WS_LF); PG8_GAS float* const IKW = (PG8_GAS float*)(ws + WS_IKW);
        const PG8_GAS float* const lb = (const PG8_GAS float*)(ws + WS_LB) + layer * 1024; const PG8_GAS float* const cosh = (const PG8_GAS float*)(ws + WS_COSH); const PG8_GAS float* const sinh = (const PG8_GAS float*)(ws + WS_SINH);
        const PG8_GAS float* const cosi = (const PG8_GAS float*)(ws + WS_COSI); const PG8_GAS float* const sini = (const PG8_GAS float*)(ws + WS_SINI);
        if (pn < 32) {
            const int seg = pn >> 2, cb = (pn & 3) * 256;
            if (seg == 4 || seg == 5) {
                PG8_GAS bf16_t* O = (seg == 4) ? QB : KB; const int head = (pn & 3) * 2 + (wc >> 1), i0 = (wc & 1) * 32 + 8 * fq;
#pragma unroll
                for (int ai = 0; ai < 2; ++ai)
#pragma unroll
                    for (int m = 0; m < 4; ++m) { const int row = row0 + ai * HALF + m * 16;
                        const PG8_GAS float* cp = cosh + (size_t)row * 64 + i0; const PG8_GAS float* sp = sinh + (size_t)row * 64 + i0;
                        const f32x4 c0 = *(const PG8_GAS f32x4*)cp, c1 = *(const PG8_GAS f32x4*)(cp + 4), s0 = *(const PG8_GAS f32x4*)sp, s1 = *(const PG8_GAS f32x4*)(sp + 4);
                        const f32x4 xa = acc[ai][0][m][0], xb = acc[ai][0][m][1], ya = acc[ai][1][m][0], yb = acc[ai][1][m][1];
                        PG8_GAS bf16_t* rp = O + (size_t)row * 1024 + head * 128 + i0;
                        *(PG8_GAS u32x4*)rp = pack8(xa * c0 - ya * s0, xb * c1 - yb * s1);
                        *(PG8_GAS u32x4*)(rp + 64) = pack8(xa * s0 + ya * c0, xb * s1 + yb * c1); asm volatile("" ::: "memory"); }
            } else if (seg == 7) {
                const int head = (pn & 3) * 4 + wc, i0 = 8 * fq;
#pragma unroll
                for (int ai = 0; ai < 2; ++ai)
#pragma unroll
                    for (int m = 0; m < 4; ++m) { const int row = row0 + ai * HALF + m * 16;
                        const PG8_GAS float* cp = cosi + (size_t)row * 32 + i0; const PG8_GAS float* sp = sini + (size_t)row * 32 + i0;
                        const f32x4 c0 = *(const PG8_GAS f32x4*)cp, c1 = *(const PG8_GAS f32x4*)(cp + 4), s0 = *(const PG8_GAS f32x4*)sp, s1 = *(const PG8_GAS f32x4*)(sp + 4);
                        const f32x4 xa = acc[ai][0][m][0], xb = acc[ai][0][m][1], ya = acc[ai][1][m][0], yb = acc[ai][1][m][1];
                        PG8_GAS bf16_t* rp = QI + (size_t)row * 1024 + head * 64 + i0;
                        *(PG8_GAS u32x4*)rp = pack8(xa * c0 - ya * s0, xb * c1 - yb * s1);
                        *(PG8_GAS u32x4*)(rp + 32) = pack8(xa * s0 + ya * c0, xb * s1 + yb * c1); asm volatile("" ::: "memory"); }
            } else if (seg == 1) {
#pragma unroll
                for (int bj = 0; bj < 2; ++bj) { const int col = cb + bj * HALF + cw;
                    const f32x4 l0 = *(const PG8_GAS f32x4*)(lb + col), l1 = *(const PG8_GAS f32x4*)(lb + col + 4);
#pragma unroll
                    for (int ai = 0; ai < 2; ++ai)
#pragma unroll
                        for (int m = 0; m < 4; ++m) { const int row = row0 + ai * HALF + m * 16; f32x4 lf[2], kk[2];
#pragma unroll
                            for (int n = 0; n < 2; ++n) { const f32x4 x = acc[ai][bj][m][n]; const f32x4 lv = n ? l1 : l0;
#pragma unroll
                                for (int j = 0; j < 4; ++j) { const float xe = fminf(fmaxf(x[j], -80.f), 80.f), e = __expf(-xe), r = __builtin_amdgcn_rcpf(1.0f + e);
                                    const float om = 1.0f - lv[j]; lf[n][j] = logf(lv[j] + om * r); kk[n][j] = om * (e * r); } }
                            PG8_GAS float* lp = LF + (size_t)row * 1024 + col; *(PG8_GAS f32x4*)lp = lf[0]; *(PG8_GAS f32x4*)(lp + 4) = lf[1];
                            *(PG8_GAS u32x4*)(KA + (size_t)row * 1024 + col) = pack8(kk[0], kk[1]); asm volatile("" ::: "memory"); } }
            } else {
                PG8_GAS bf16_t* O = (seg == 0) ? QA : (seg == 2) ? VA : (seg == 3) ? GA : VB; const bool act = (seg == 0 || seg == 3);
#pragma unroll
                for (int ai = 0; ai < 2; ++ai)
#pragma unroll
                    for (int m = 0; m < 4; ++m) { const int row = row0 + ai * HALF + m * 16;
#pragma unroll
                        for (int bj = 0; bj < 2; ++bj) { f32x4 v0 = acc[ai][bj][m][0], v1 = acc[ai][bj][m][1];
                            if (act) { v0 = silu4(v0); v1 = silu4(v1); }
                            *(PG8_GAS u32x4*)(O + (size_t)row * 1024 + cb + bj * HALF + cw) = pack8(v0, v1); } }
            }
        } else if (pn < 48) {
            PG8_GAS bf16_t* O = (pn < 40) ? SGA : SGB; const int cb = ((pn - 32) & 7) * 256;
#pragma unroll
            for (int ai = 0; ai < 2; ++ai)
#pragma unroll
                for (int m = 0; m < 4; ++m) { const int row = row0 + ai * HALF + m * 16;
#pragma unroll
                    for (int bj = 0; bj < 2; ++bj)
                        *(PG8_GAS u32x4*)(O + (size_t)row * DM + cb + bj * HALF + cw) = pack8(sigm4(acc[ai][bj][m][0]), sigm4(acc[ai][bj][m][1])); }
        } else {
#pragma unroll
            for (int ai = 0; ai < 2; ++ai)
#pragma unroll
                for (int m = 0; m < 4; ++m) { PG8_GAS float* p = IKW + (size_t)(row0 + ai * HALF + m * 16) * 128 + cw; *(PG8_GAS f32x4*)p = acc[ai][0][m][0]; *(PG8_GAS f32x4*)(p + 4) = acc[ai][0][m][1]; }
        }
    }
};
struct EpiGateA {
    static constexpr bool PERM = true, AFTER_DRAIN = false;
    unsigned char* ws;
    __device__ __forceinline__ void operator()(const f32x4 (&acc)[2][2][4][2], const Unit& u, int wr, int wc, int fr, int fq) const {
        unsigned char* const wg = as_global(ws); const bf16_t* const SG = (const bf16_t*)(wg + WS_SGA); float* const AF = (float*)(wg + WS_XPRE);
        const int row0 = u.pm * BM + wr * 64 + fr, col0 = u.pn * BM + wc * 32 + 8 * fq;
#pragma unroll
        for (int ai = 0; ai < 2; ++ai)
#pragma unroll
            for (int m = 0; m < 4; ++m) { const size_t off = (size_t)(row0 + ai * HALF + m * 16) * DM + col0;
#pragma unroll
                for (int bj = 0; bj < 2; ++bj) { f32x4 g0, g1; unpack8(*(const u32x4*)(SG + off + bj * HALF), g0, g1);
                    float* p = AF + off + bj * HALF; *(f32x4*)p = g0 * acc[ai][bj][m][0]; *(f32x4*)(p + 4) = g1 * acc[ai][bj][m][1]; } asm volatile("" ::: "memory"); }
    }
};
struct EpiGateB {
    static constexpr bool PERM = true, AFTER_DRAIN = false;
    unsigned char* ws;
    __device__ __forceinline__ void operator()(const f32x4 (&acc)[2][2][4][2], const Unit& u, int wr, int wc, int fr, int fq) const {
        unsigned char* const wg = as_global(ws); const bf16_t* const SG = (const bf16_t*)(wg + WS_SGB); const float* const AF = (const float*)(wg + WS_XPRE); bf16_t* const MG = (bf16_t*)(wg + WS_MG);
        const int row0 = u.pm * BM + wr * 64 + fr, col0 = u.pn * BM + wc * 32 + 8 * fq;
#pragma unroll
        for (int ai = 0; ai < 2; ++ai)
#pragma unroll
            for (int m = 0; m < 4; ++m) { const size_t off = (size_t)(row0 + ai * HALF + m * 16) * DM + col0;
#pragma unroll
                for (int bj = 0; bj < 2; ++bj) { f32x4 g0, g1; unpack8(*(const u32x4*)(SG + off + bj * HALF), g0, g1);
                    const float* p = AF + off + bj * HALF; const f32x4 a0 = *(const f32x4*)p, a1 = *(const f32x4*)(p + 4);
                    *(u32x4*)(MG + off + bj * HALF) = pack8(a0 + g0 * acc[ai][bj][m][0], a1 + g1 * acc[ai][bj][m][1]); } asm volatile("" ::: "memory"); }
    }
};
struct EpiRes {
    static constexpr bool PERM = true, AFTER_DRAIN = false;
    const float* X; unsigned char* ws;
    __device__ __forceinline__ void operator()(const f32x4 (&acc)[2][2][4][2], const Unit& u, int wr, int wc, int fr, int fq) const {
        float* const XP = (float*)(as_global(ws) + WS_XPRE); const float* const Xg = as_global(X);
        const int row0 = u.pm * BM + wr * 64 + fr, col0 = u.pn * BM + wc * 32 + 8 * fq;
#pragma unroll
        for (int ai = 0; ai < 2; ++ai)
#pragma unroll
            for (int m = 0; m < 4; ++m) { const size_t off = (size_t)(row0 + ai * HALF + m * 16) * DM + col0;
#pragma unroll
                for (int bj = 0; bj < 2; ++bj) { const float* xp = Xg + off + bj * HALF; const f32x4 x0 = *(const f32x4*)xp, x1 = *(const f32x4*)(xp + 4);
                    float* p = XP + off + bj * HALF; *(f32x4*)p = x0 * ALPHA + acc[ai][bj][m][0]; *(f32x4*)(p + 4) = x1 * ALPHA + acc[ai][bj][m][1]; } asm volatile("" ::: "memory"); }
    }
};
struct EpiSwiGLU {
    static constexpr bool PERM = true, AFTER_DRAIN = false;
    unsigned char* ws;
    __device__ __forceinline__ void operator()(const f32x4 (&acc)[2][2][4][2], const Unit& u, int wr, int wc, int fr, int fq) const {
        bf16_t* const H = (bf16_t*)(as_global(ws) + WS_H);
        const int row0 = u.pm * BM + wr * 64 + fr, col0 = u.pn * HALF + wc * 32 + 8 * fq;
#pragma unroll
        for (int ai = 0; ai < 2; ++ai)
#pragma unroll
            for (int m = 0; m < 4; ++m)
                *(u32x4*)(H + (size_t)(row0 + ai * HALF + m * 16) * DFF + col0) = pack8(silu4(acc[ai][0][m][0]) * acc[ai][1][m][0], silu4(acc[ai][0][m][1]) * acc[ai][1][m][1]);
    }
};
struct EpiF32P {
    static constexpr bool PERM = true, AFTER_DRAIN = false;
    unsigned char* ws;
    __device__ __forceinline__ void operator()(const f32x4 (&acc)[2][2][4][2], const Unit& u, int wr, int wc, int fr, int fq) const {
        float* const C = (float*)(as_global(ws) + WS_PP);
        const int row0 = u.pm * BM + wr * 64 + fr, col0 = u.pn * BM + wc * 32 + 8 * fq;
#pragma unroll
        for (int ai = 0; ai < 2; ++ai)
#pragma unroll
            for (int m = 0; m < 4; ++m) { const size_t off = (size_t)(row0 + ai * HALF + m * 16) * DM + col0;
#pragma unroll
                for (int bj = 0; bj < 2; ++bj) { float* p = C + off + bj * HALF; *(f32x4*)p = acc[ai][bj][m][0]; *(f32x4*)(p + 4) = acc[ai][bj][m][1]; } }
    }
};
struct EpiPle {
    static constexpr bool PERM = true, AFTER_DRAIN = false;
    unsigned char* ws;
    __device__ __forceinline__ void operator()(const f32x4 (&acc)[2][2][4][2], const Unit& u, int wr, int wc, int fr, int fq) const {
        const float* const X = (const float*)(ws + WS_X32); const float* const PP = (const float*)(ws + WS_PP); float* const XP = (float*)(as_global(ws) + WS_XPRE); const float* const Xg = as_global(X);
        const int row0 = u.pm * BM + wr * 64 + fr, col0 = u.pn * BM + wc * 32 + 8 * fq;
#pragma unroll
        for (int ai = 0; ai < 2; ++ai)
#pragma unroll
            for (int m = 0; m < 4; ++m) { const size_t off = (size_t)(row0 + ai * HALF + m * 16) * DM + col0;
#pragma unroll
                for (int bj = 0; bj < 2; ++bj) { const float* xp = Xg + off + bj * HALF; const f32x4 x0 = *(const f32x4*)xp, x1 = *(const f32x4*)(xp + 4);
                    const float* pp = PP + off + bj * HALF; const f32x4 p0 = *(const f32x4*)pp, p1 = *(const f32x4*)(pp + 4);
                    float* p = XP + off + bj * HALF; *(f32x4*)p = x0 * ALPHA + sigm4(acc[ai][bj][m][0]) * p0; *(f32x4*)(p + 4) = x1 * ALPHA + sigm4(acc[ai][bj][m][1]) * p1; } asm volatile("" ::: "memory"); }
    }
};

struct EpiRawTest {
    static constexpr bool PERM = true, AFTER_DRAIN = false;
    unsigned char* ws;
    __device__ __forceinline__ void operator()(const f32x4 (&acc)[2][2][4][2], const Unit& u, int wr, int wc, int fr, int fq) const {
        bf16_t* const H = (bf16_t*)(as_global(ws) + WS_H);
        const int row0 = u.pm * BM + wr * 64 + fr, col0 = u.pn * HALF + wc * 32 + 8 * fq;
#pragma unroll
        for (int ai = 0; ai < 2; ++ai)
#pragma unroll
            for (int m = 0; m < 4; ++m)
                *(u32x4*)(H + (size_t)(row0 + ai * HALF + m * 16) * 6272 + col0) = pack8(acc[ai][0][m][0] + acc[ai][1][m][0], acc[ai][0][m][1] + acc[ai][1][m][1]);
    }
};
template <class Epi, class Sched, bool ALIGN_EPI = false, bool SP2 = false>
__device__ __forceinline__ void gemm_phase(PG8_LAS unsigned char* lds, const Gemm g, const Sched& S, const Epi& E) {
    const int tid = tid_(), wid = __builtin_amdgcn_readfirstlane(tid >> 6), lane = tid & 63, wr = wid >> 2, wc = wid & 3, fr = lane & 15, fq = lane >> 4;
    int Kq = g.K; asm volatile("" : "+s"(Kq)); const int K = Kq, nt = K / BK;
    unsigned voffA[2], voffB[2];
#pragma unroll
    for (int i = 0; i < 2; ++i) { int R, C; stage_rc(tid * 16 + i * 8192, R, C); const int Rb = Epi::PERM ? ((R & ~31) + perm32(R & 31)) : R;
        voffA[i] = (unsigned)(R * K + C) * 2u; voffB[i] = (unsigned)(Rb * K + C) * 2u; }
    const size_t kstep = (size_t)(BK * 2);
    const size_t hstep = (size_t)HALF * K * 2;
    const size_t tstep = 2 * hstep;
    const unsigned ldsw = (unsigned)wid * 1024u;
    const int aoff = lds_byte(wr * 64 + fr, fq * 8), boff = lds_byte(wc * 32 + fr, fq * 8);
#define PG8_SA(b, h) (((b) * 2 + (h)) * HTB)
#define PG8_SB(b, h) ((4 + (b) * 2 + (h)) * HTB)
#define PG8_STAGE(bufoff, gbase, voff) do { _Pragma("unroll") for (int _i = 0; _i < 2; ++_i) \
        __builtin_amdgcn_global_load_lds((const unsigned*)((const char*)(gbase) + (voff)[_i]), (PG8_LAS unsigned*)(lds + (bufoff) + ldsw + _i * 8192), 16, 0, 0); } while (0)
#define PG8_LDA(dst, b, h) do { _Pragma("unroll") for (int m = 0; m < 4; ++m) _Pragma("unroll") for (int k = 0; k < 2; ++k) dst[m][k] = *(const PG8_LAS bf16x8*)(lds + PG8_SA(b, h) + aoff + m * 2048 + k * 1024); } while (0)
#define PG8_LDB(dst, b, h) do { _Pragma("unroll") for (int n = 0; n < 2; ++n) _Pragma("unroll") for (int k = 0; k < 2; ++k) dst[n][k] = *(const PG8_LAS bf16x8*)(lds + PG8_SB(b, h) + boff + n * 2048 + k * 1024); } while (0)
#define PG8_MMA(ai, bj, At, Bt) do { __builtin_amdgcn_s_setprio(1); _Pragma("unroll") for (int m = 0; m < 4; ++m) _Pragma("unroll") for (int n = 0; n < 2; ++n) _Pragma("unroll") for (int k = 0; k < 2; ++k) \
        acc[ai][bj][m][n] = __builtin_amdgcn_mfma_f32_16x16x32_bf16(Bt[n][k], At[m][k], acc[ai][bj][m][n], 0, 0, 0); __builtin_amdgcn_s_setprio(0); } while (0)
#define PG8_WAIT_V(n) asm volatile("s_waitcnt vmcnt(" #n ")" ::: "memory")
#define PG8_WAIT_L(n) asm volatile("s_waitcnt lgkmcnt(" #n ")" ::: "memory")
#define PG8_BAR __builtin_amdgcn_s_barrier()
#define PG8_SCHED __builtin_amdgcn_sched_barrier(0)
    Unit cur, nxt; int ui = 0;
    if (!S.next(0, cur)) return;
    f32x4 acc[2][2][4][2];
#pragma unroll
    for (int a = 0; a < 2; ++a)
#pragma unroll
        for (int b = 0; b < 2; ++b)
#pragma unroll
            for (int m = 0; m < 4; ++m)
#pragma unroll
                for (int n = 0; n < 2; ++n) acc[a][b][m][n] = (f32x4){0.f, 0.f, 0.f, 0.f};
    bf16x8 At[4][2], B0[2][2], B1[2][2];
    const char* cA = (const char*)g.A + (size_t)cur.pm * tstep; const char* cB = (const char*)g.Bt + (size_t)cur.pn * tstep;
    S.a_ready(cur);
    if constexpr (SP2) {
        PG8_STAGE(PG8_SB(0, 0), cB, voffB); PG8_STAGE(PG8_SB(0, 1), cB + hstep, voffB); PG8_STAGE(PG8_SA(0, 0), cA, voffA); PG8_STAGE(PG8_SA(0, 1), cA + hstep, voffA);
        if (wr == 1) PG8_BAR;
        PG8_WAIT_V(2); PG8_BAR;
        PG8_STAGE(PG8_SB(1, 0), cB + kstep, voffB); PG8_STAGE(PG8_SA(1, 0), cA + kstep, voffA); PG8_STAGE(PG8_SB(1, 1), cB + hstep + kstep, voffB);
        PG8_WAIT_V(6); PG8_BAR;
    } else {
        PG8_STAGE(PG8_SB(0, 0), cB, voffB); PG8_STAGE(PG8_SA(0, 0), cA, voffA); PG8_STAGE(PG8_SB(0, 1), cB + hstep, voffB); PG8_STAGE(PG8_SA(0, 1), cA + hstep, voffA);
        if (wr == 1) PG8_BAR;
        PG8_WAIT_V(4); PG8_BAR;
        PG8_STAGE(PG8_SB(1, 0), cB + kstep, voffB); PG8_STAGE(PG8_SA(1, 0), cA + kstep, voffA); PG8_STAGE(PG8_SB(1, 1), cB + hstep + kstep, voffB);
        PG8_WAIT_V(6); PG8_BAR;
    }
    for (;;) {
        const bool has_next = S.next(ui + 1, nxt);
        const char* nA = has_next ? (const char*)g.A + (size_t)nxt.pm * tstep : cA; const char* nB = has_next ? (const char*)g.Bt + (size_t)nxt.pn * tstep : cB;
        for (int t = 0; t < nt; t += 2) {
            const bool last = (t == nt - 2);
            const char* a1 = cA + (size_t)(t + 1) * kstep;
            const char* a2 = last ? nA : cA + (size_t)(t + 2) * kstep; const char* b2 = last ? nB : cB + (size_t)(t + 2) * kstep;
            const char* a3 = a2 + kstep; const char* b3 = b2 + kstep;
            if (last && has_next) S.a_ready(nxt);
            if constexpr (SP2) {
            PG8_LDB(B0, 0, 0); PG8_LDB(B1, 0, 1); PG8_SCHED; PG8_LDA(At, 0, 0); PG8_STAGE(PG8_SA(1, 1), a1 + hstep, voffA);
            PG8_WAIT_V(8); PG8_WAIT_L(0); PG8_BAR; PG8_MMA(0, 0, At, B0); PG8_MMA(0, 1, At, B1); PG8_BAR; PG8_SCHED;
            PG8_LDA(At, 0, 1); PG8_STAGE(PG8_SB(0, 0), b2, voffB); PG8_STAGE(PG8_SB(0, 1), b2 + hstep, voffB); PG8_STAGE(PG8_SA(0, 0), a2, voffA);
            PG8_WAIT_V(8); PG8_WAIT_L(0); PG8_BAR; PG8_MMA(1, 0, At, B0); PG8_MMA(1, 1, At, B1); PG8_BAR; PG8_SCHED;
            PG8_LDB(B0, 1, 0); PG8_LDB(B1, 1, 1); PG8_SCHED; PG8_LDA(At, 1, 0); PG8_STAGE(PG8_SA(0, 1), a2 + hstep, voffA);
            PG8_WAIT_V(8); PG8_WAIT_L(0); PG8_BAR; PG8_MMA(0, 0, At, B0); PG8_MMA(0, 1, At, B1); PG8_BAR; PG8_SCHED;
            PG8_LDA(At, 1, 1); PG8_STAGE(PG8_SB(1, 0), b3, voffB); PG8_STAGE(PG8_SB(1, 1), b3 + hstep, voffB); PG8_STAGE(PG8_SA(1, 0), a3, voffA);
            PG8_WAIT_V(8); PG8_WAIT_L(0); PG8_BAR; PG8_MMA(1, 0, At, B0); PG8_MMA(1, 1, At, B1); PG8_BAR; PG8_SCHED;
            } else {
            PG8_LDB(B0, 0, 0); PG8_SCHED; PG8_LDA(At, 0, 0); PG8_STAGE(PG8_SA(1, 1), a1 + hstep, voffA);
            PG8_WAIT_L(8); PG8_BAR; PG8_WAIT_L(0); PG8_MMA(0, 0, At, B0); PG8_BAR; PG8_SCHED;
            PG8_LDB(B1, 0, 1); PG8_STAGE(PG8_SB(0, 0), b2, voffB);
            PG8_BAR; PG8_WAIT_L(0); PG8_MMA(0, 1, At, B1); PG8_BAR;
            PG8_LDA(At, 0, 1); PG8_STAGE(PG8_SA(0, 0), a2, voffA);
            PG8_BAR; PG8_WAIT_L(0); PG8_MMA(1, 0, At, B0); PG8_BAR; PG8_SCHED;
            PG8_STAGE(PG8_SB(0, 1), b2 + hstep, voffB);
            PG8_WAIT_V(6); PG8_BAR; PG8_MMA(1, 1, At, B1); PG8_BAR;
            PG8_LDB(B0, 1, 0); PG8_SCHED; PG8_LDA(At, 1, 0); PG8_STAGE(PG8_SA(0, 1), a2 + hstep, voffA);
            PG8_WAIT_L(8); PG8_BAR; PG8_WAIT_L(0); PG8_MMA(0, 0, At, B0); PG8_BAR; PG8_SCHED;
            PG8_LDB(B1, 1, 1); PG8_STAGE(PG8_SB(1, 0), b3, voffB);
            PG8_BAR; PG8_WAIT_L(0); PG8_MMA(0, 1, At, B1); PG8_BAR;
            PG8_LDA(At, 1, 1); PG8_STAGE(PG8_SA(1, 0), a3, voffA);
            PG8_BAR; PG8_WAIT_L(0); PG8_MMA(1, 0, At, B0); PG8_BAR; PG8_SCHED;
            PG8_STAGE(PG8_SB(1, 1), b3 + hstep, voffB);
            PG8_WAIT_V(6); PG8_BAR; PG8_MMA(1, 1, At, B1); PG8_BAR;
            }
        }
        if constexpr (ALIGN_EPI) { if (wr == 0) PG8_BAR; }
        if constexpr (!Epi::AFTER_DRAIN) { E(acc, cur, wr, wc, fr, fq); S.done(cur); }
        if (!has_next) break;
#pragma unroll
        for (int a = 0; a < 2; ++a)
#pragma unroll
            for (int b = 0; b < 2; ++b)
#pragma unroll
                for (int m = 0; m < 4; ++m)
#pragma unroll
                    for (int n = 0; n < 2; ++n) acc[a][b][m][n] = (f32x4){0.f, 0.f, 0.f, 0.f};
        cur = nxt; cA = nA; cB = nB; ++ui;
        if constexpr (ALIGN_EPI) { if (wr == 1) PG8_BAR; }
    }
    PG8_WAIT_V(0);
    if constexpr (!ALIGN_EPI) { if (wr == 0) PG8_BAR; }
    PG8_BAR;
    if constexpr (Epi::AFTER_DRAIN) { E.fused(acc, cur, wr, wc, fr, fq, lds, wid, lane); S.done(cur); }
#undef PG8_SA
#undef PG8_SB
#undef PG8_STAGE
#undef PG8_LDA
#undef PG8_LDB
#undef PG8_MMA
#undef PG8_WAIT_V
#undef PG8_WAIT_L
#undef PG8_BAR
#undef PG8_SCHED
}
}
#define XB_TMO      128
#define XB_XCNT(j)  (256  + 64 * (j))
#define XB_XSUB(j)  (1280 + 64 * (j))
#define XB_XGEN(j)  (2304 + 64 * (j))
#define XB_TOP      3328
#define XB_TOPGEN   3392
#define XCD_BAR_WORDS 3456
#define XB_SPIN_CAP (1u << 18)
#define LAS __attribute__((address_space(3)))

__device__ __forceinline__ unsigned xb_ld(unsigned* p)              { return __hip_atomic_load(p, __ATOMIC_RELAXED, __HIP_MEMORY_SCOPE_AGENT); }
__device__ __forceinline__ unsigned xb_add(unsigned* p, unsigned v) { return __hip_atomic_fetch_add(p, v, __ATOMIC_RELAXED, __HIP_MEMORY_SCOPE_AGENT); }
__device__ __forceinline__ unsigned xb_xcc_id() { return (unsigned)__builtin_amdgcn_s_getreg((3 << 11) | 20) & 0xFu; }
#define XB_SPIN(cond, bar) do { unsigned _sp = 0; while (cond) { __builtin_amdgcn_s_sleep(1); \
    if ((++_sp & 255u) == 0u) { if (xb_ld(&(bar)[XB_TMO])) break; if (_sp > XB_SPIN_CAP) { atomicAdd(&(bar)[XB_TMO], 1u); break; } } } } while (0)

struct XcdBarrier {
    unsigned* bar; unsigned x;
    volatile LAS unsigned* st;
};

__device__ __forceinline__ XcdBarrier xcd_barrier_post(unsigned* bar, volatile LAS unsigned* st) {
    XcdBarrier b; b.bar = bar; b.x = xb_xcc_id(); b.st = st;
    if (threadIdx.x == 0) (void)xb_add(&bar[XB_XCNT(b.x)], 1u);
    return b;
}
__device__ __forceinline__ void xcd_barrier_complete(unsigned* bar, unsigned x, unsigned& nloc, unsigned& nx) {
    const unsigned G = gridDim.x * gridDim.y * gridDim.z;
    unsigned sum, cnt, mine, sp = 0u;
    for (;;) {
        sum = 0u; cnt = 0u; mine = 0u;
#pragma unroll
        for (unsigned j = 0; j < 16; ++j) { const unsigned c = xb_ld(&bar[XB_XCNT(j)]); sum += c; cnt += (c > 0u) ? 1u : 0u; mine = (j == x) ? c : mine; }
        if (sum == G) break;
        __builtin_amdgcn_s_sleep(1);
        if ((++sp & 255u) == 0u) { if (xb_ld(&bar[XB_TMO])) break; if (sp > XB_SPIN_CAP) { atomicAdd(&bar[XB_TMO], 1u); break; } }
    }
    nloc = mine > 0u ? mine : 1u; nx = cnt > 0u ? cnt : 1u;
}

__device__ __forceinline__ void xcd_barrier(const XcdBarrier& b) {
    asm volatile("s_waitcnt vmcnt(0)" ::: "memory");
    __syncthreads();
    if (threadIdx.x == 0) {
        unsigned* bar = b.bar;
        __builtin_amdgcn_s_waitcnt(0);
        const unsigned bx = xb_xcc_id();
        unsigned nloc = b.st[0], nx = b.st[1];
        if (nloc == 0u) { xcd_barrier_complete(bar, bx, nloc, nx); b.st[0] = nloc; b.st[1] = nx; }
        const unsigned old = xb_add(&bar[XB_XSUB(bx)], 1u);
        const unsigned gen = old / nloc;
        if (old + 1u == (gen + 1u) * nloc) {
            __builtin_amdgcn_fence(__ATOMIC_RELEASE, "agent");
            asm volatile("s_waitcnt vmcnt(0)" ::: "memory");
            const unsigned og = xb_add(&bar[XB_TOP], 1u);
            const unsigned tg = og / nx;
            if (og + 1u == (tg + 1u) * nx) xb_add(&bar[XB_TOPGEN], 1u);
            else XB_SPIN(xb_ld(&bar[XB_TOPGEN]) == tg, bar);
            __builtin_amdgcn_fence(__ATOMIC_ACQUIRE, "agent");
            xb_add(&bar[XB_XGEN(bx)], 1u);
            asm volatile("s_waitcnt vmcnt(0)" ::: "memory");
        } else {
            XB_SPIN(xb_ld(&bar[XB_XGEN(bx)]) == gen, bar);
            __builtin_amdgcn_fence(__ATOMIC_ACQUIRE, "agent");
            asm volatile("s_waitcnt vmcnt(0)" ::: "memory");
        }
    }
    __syncthreads();
}

struct Params {
    const float* x; const float* p; const int* pos;
    const float *w_in, *w_a, *w_b, *w_out, *lbraw, *hnorm_g, *ikn_g, *ikn_b, *lnm_g, *lnm_b, *w_fg, *w_fu, *w_fd, *lnf_g, *lnf_b, *w_pg, *w_pp, *lnp_g, *lnp_b;
    float* out; unsigned char* ws;
    double invf_h[64]; double invf_i[32];
    int ph_lo, ph_hi;
};
typedef const __attribute__((address_space(4))) Params* KP;
__device__ __forceinline__ KP kparams() { KP p = (KP)__builtin_amdgcn_kernarg_segment_ptr(); asm volatile("" : "+s"(p)); return p; }
constexpr int NPH_LAYER = 14, NPH = DEPTH * NPH_LAYER;
constexpr int LDS_BYTES = 131072 + 1024;
constexpr int MISC_OFF = 131072;

__device__ __forceinline__ int wsrc_col_in(int n) {
    const int tile = n >> 8, t = n & 255;
    if (tile < 16) return n;
    if (tile < 24) { const int bj = t >> 7, u = t & 127, head = u >> 6, i = u & 63; return tile * 256 + 128 * head + 64 * bj + i; }
    if (tile < 28) return n;
    if (tile < 32) { const int bj = t >> 7, u = t & 127, head = u >> 5, i = u & 31; return tile * 256 + 64 * head + 32 * bj + i; }
    if (tile < 40) return 8272 + (n - 32 * 256);
    if (tile < 48) return 10320 + (n - 40 * 256);
    return t < 80 ? 8192 + t : -1;
}
template <int KIND>
__device__ __forceinline__ void wconv_tile(const float* src, const float* src2, int nsrc, int K, bf16_t* dst, int n0, int k0, LAS float* tile) {
    const int tid = tid_(), nn = tid & 31, kk0 = tid >> 5;
    int c; const float* s = src;
    if (KIND == 0) c = n0 + nn;
    else if (KIND == 1) c = wsrc_col_in(n0 + nn);
    else { const int n = n0 + nn, tl = n >> 8, t = n & 255; c = tl * 128 + (t & 127); if (t >= 128) s = src2; }
#pragma unroll
    for (int r = 0; r < 8; ++r) { const int kk = kk0 + 16 * r; tile[kk * 33 + nn] = (c >= 0) ? s[(size_t)(k0 + kk) * nsrc + c] : 0.f; }
    __syncthreads();
    const int n = tid >> 4, k8 = (tid & 15) * 8;
    pg8::f32x4 a, b;
#pragma unroll
    for (int j = 0; j < 4; ++j) { a[j] = tile[(k8 + j) * 33 + n]; b[j] = tile[(k8 + 4 + j) * 33 + n]; }
    *(pg8::u32x4*)(dst + (size_t)(n0 + n) * K + k0 + k8) = pg8::pack8(a, b);
    __syncthreads();
}
template <int KIND>
__device__ __forceinline__ void wconv_job(const float* src, const float* src2, int nsrc, int K, bf16_t* dst, int ndst, LAS float* tile, int& tcount) {
    const int kt = K / 128, ntiles = (ndst / 32) * kt;
    const int G = nblk_(); int first = (bid_() - tcount % G + G) % G;
    for (int t = first; t < ntiles; t += G) wconv_tile<KIND>(src, src2, nsrc, K, dst, (t / kt) * 32, (t % kt) * 128, tile);
    tcount += ntiles;
}
__device__ __forceinline__ void phase_wconv(KP P, int layer, LAS float* tile) {
    unsigned char* ws = as_global(P->ws); int tc = 0;
    wconv_job<1>(as_global(P->w_in) + (size_t)layer * DM * INW, nullptr, INW, DM, (bf16_t*)(ws + WS_WIN), INP, tile, tc);
    wconv_job<0>(as_global(P->w_a) + (size_t)layer * AW * DM, nullptr, DM, AW, (bf16_t*)(ws + WS_WA), DM, tile, tc);
    wconv_job<0>(as_global(P->w_b) + (size_t)layer * BW * DM, nullptr, DM, BW, (bf16_t*)(ws + WS_WB), DM, tile, tc);
    wconv_job<0>(as_global(P->w_out) + (size_t)layer * DM * DM, nullptr, DM, DM, (bf16_t*)(ws + WS_WO), DM, tile, tc);
    wconv_job<2>(as_global(P->w_fg) + (size_t)layer * DM * DFF, as_global(P->w_fu) + (size_t)layer * DM * DFF, DFF, DM, (bf16_t*)(ws + WS_WGU), 2 * DFF, tile, tc);
    wconv_job<0>(as_global(P->w_fd) + (size_t)layer * DFF * DM, nullptr, DM, DFF, (bf16_t*)(ws + WS_WDN), DM, tile, tc);
    wconv_job<0>(as_global(P->w_pg) + (size_t)layer * DM * DM, nullptr, DM, DM, (bf16_t*)(ws + WS_WPG), DM, tile, tc);
    wconv_job<0>(as_global(P->w_pp) + (size_t)layer * PLE * DM, nullptr, DM, PLE, (bf16_t*)(ws + WS_WPP), DM, tile, tc);
    const float* ps = as_global(P->p) + (size_t)layer * TOK * PLE; bf16_t* pb = (bf16_t*)(ws + WS_PB);
    for (size_t i = ((size_t)bid_() * 512 + tid_()) * 8; i < (size_t)TOK * PLE; i += (size_t)nblk_() * 512 * 8)
        *(pg8::u32x4*)(pb + i) = pg8::pack8(*(const pg8::f32x4*)(ps + i), *(const pg8::f32x4*)(ps + i + 4));
}
__device__ __forceinline__ void phase_prologue(KP P) {
    unsigned char* ws = as_global(P->ws); const size_t gtid = (size_t)bid_() * 512 + tid_(), gsz = (size_t)nblk_() * 512;
    bf16_t* xb = (bf16_t*)(ws + WS_XB); const float* xin = as_global(P->x); const int* posg = as_global(P->pos); const float* lbr = as_global(P->lbraw);
    for (size_t i = gtid * 8; i < (size_t)TOK * DM; i += gsz * 8) *(pg8::u32x4*)(xb + i) = pg8::pack8(*(const pg8::f32x4*)(xin + i), *(const pg8::f32x4*)(xin + i + 4));
    float* ch = (float*)(ws + WS_COSH); float* sh = (float*)(ws + WS_SINH); float* ci = (float*)(ws + WS_COSI); float* si = (float*)(ws + WS_SINI);
    for (size_t i = gtid; i < (size_t)TOK * 64; i += gsz) { const int t = (int)(i >> 6), j = (int)(i & 63); const double rev = (double)posg[t] * P->invf_h[j]; const float fr = (float)(rev - rint(rev));
        ch[i] = __builtin_amdgcn_cosf(fr); sh[i] = __builtin_amdgcn_sinf(fr); }
    for (size_t i = gtid; i < (size_t)TOK * 32; i += gsz) { const int t = (int)(i >> 5), j = (int)(i & 31); const double rev = (double)posg[t] * P->invf_i[j]; const float fr = (float)(rev - rint(rev));
        ci[i] = __builtin_amdgcn_cosf(fr); si[i] = __builtin_amdgcn_sinf(fr); }
    float* lb = (float*)(ws + WS_LB);
    for (size_t c = gtid; c < 1024; c += gsz) { float v[4], mx = -1e30f; for (int l = 0; l < 4; ++l) { v[l] = lbr[l * 1024 + c]; mx = fmaxf(mx, v[l]); }
        float s = 0.f; for (int l = 0; l < 4; ++l) { v[l] = expf(v[l] - mx); s += v[l]; }
        float cum = 0.f; const float inv = 1.0f / s; for (int l = 0; l < 4; ++l) { cum += v[l] * inv; lb[l * 1024 + c] = cum - v[0] * inv; } }
}
__device__ __forceinline__ void phase_ln(const float* XP, float* X32, bf16_t* XB, const float* g, const float* b) {
    const int tid = tid_(), wave = tid >> 6, lane = tid & 63, nb8 = nblk_() * 8;
    for (int row = bid_() * 8 + wave; row < TOK; row += nb8) {
        const float* xp = XP + (size_t)row * DM; pg8::f32x4 v[8]; float s = 0.f;
#pragma unroll
        for (int c = 0; c < 8; ++c) { v[c] = *(const pg8::f32x4*)(xp + c * 256 + lane * 4); s += (v[c][0] + v[c][1]) + (v[c][2] + v[c][3]); }
#pragma unroll
        for (int o = 32; o >= 1; o >>= 1) s += __shfl_xor(s, o);
        const float mean = s * (1.0f / DM); float q = 0.f;
#pragma unroll
        for (int c = 0; c < 8; ++c) { v[c] = v[c] - mean; q += (v[c][0] * v[c][0] + v[c][1] * v[c][1]) + (v[c][2] * v[c][2] + v[c][3] * v[c][3]); }
#pragma unroll
        for (int o = 32; o >= 1; o >>= 1) q += __shfl_xor(q, o);
        const float rstd = 1.0f / sqrtf(q * (1.0f / DM) + LN_EPS);
#pragma unroll
        for (int c = 0; c < 8; ++c) { const int col = c * 256 + lane * 4; const pg8::f32x4 gg = *(const pg8::f32x4*)(g + col), bb = *(const pg8::f32x4*)(b + col);
            const pg8::f32x4 y = v[c] * rstd * gg + bb; *(pg8::f32x4*)(X32 + (size_t)row * DM + col) = y;
            pg8::u32x2 w; w.x = pg8::cvt_pk_bf16(y[0], y[1]); w.y = pg8::cvt_pk_bf16(y[2], y[3]); *(pg8::u32x2*)(XB + (size_t)row * DM + col) = w; }
    }
}
__device__ __forceinline__ void phase_ikprep(KP P, int layer) {
    unsigned char* ws = as_global(P->ws); const float* ikw = (const float*)(ws + WS_IKW); bf16_t* ki = (bf16_t*)(ws + WS_KI); float* wi = (float*)(ws + WS_WI);
    const float* ci = (const float*)(ws + WS_COSI); const float* si = (const float*)(ws + WS_SINI);
    const int tid = tid_(), wave = tid >> 6, lane = tid & 63, nb8 = nblk_() * 8;
    const float g = as_global(P->ikn_g)[layer * 64 + lane], b = as_global(P->ikn_b)[layer * 64 + lane];
    for (int t = bid_() * 8 + wave; t < TOK; t += nb8) {
        const float x = ikw[(size_t)t * 128 + lane]; float s = x;
#pragma unroll
        for (int o = 32; o >= 1; o >>= 1) s += __shfl_xor(s, o);
        const float mean = s * (1.0f / 64.0f), xc = x - mean; float q = xc * xc;
#pragma unroll
        for (int o = 32; o >= 1; o >>= 1) q += __shfl_xor(q, o);
        const float y = xc * (1.0f / sqrtf(q * (1.0f / 64.0f) + LN_EPS)) * g + b;
        const float other = __shfl_xor(y, 32); const int j = lane & 31; const float c = ci[(size_t)t * 32 + j], sn = si[(size_t)t * 32 + j];
        const float r = (lane < 32) ? (y * c - other * sn) : (other * sn + y * c);
        ki[(size_t)t * 64 + lane] = f2bf(r);
        if (lane < 16) wi[(size_t)t * 16 + lane] = ikw[(size_t)t * 128 + 64 + lane] * IDX_SCALE;
    }
}
__device__ __forceinline__ void phase_select(KP P, LAS unsigned char* lds) {
    unsigned char* ws = as_global(P->ws); const float* S = (const float*)(ws + WS_XPRE); unsigned long long* MASK = (unsigned long long*)(ws + WS_MASK);
    const int tid = tid_(), wave = tid >> 6, lane = tid & 63, nb8 = nblk_() * 8;
    for (int q = bid_() * 8 + wave; q < TOK; q += nb8) {
        const int b = q >> 12, s = q & 4095, c = s >> 6, nw = c + 1;
        unsigned long long myword = 0ull;
        if (nw <= TOPK / 64) { myword = (lane < nw) ? ~0ull : 0ull; }
        else {
            const float* row = S + (size_t)b * SCORE_B + (size_t)2048 * c * (c + 1) + (size_t)(s & 63) * (nw * 64);
            unsigned u[64];
#pragma unroll
            for (int j = 0; j < 64; ++j) { unsigned v = 0u; if (j < nw) { const unsigned bits = __float_as_uint(row[j * 64 + lane]); v = (bits & 0x80000000u) ? ~bits : (bits | 0x80000000u); } u[j] = v; }
            unsigned prefix = 0u;
            for (int bit = 31; bit >= 0; --bit) { const unsigned cand = prefix | (1u << bit); int cnt = 0;
#pragma unroll
                for (int j8 = 0; j8 < 8; ++j8) if (j8 * 8 < nw) {
#pragma unroll
                    for (int jj = 0; jj < 8; ++jj) cnt += __popcll(__ballot(u[j8 * 8 + jj] >= cand)); }
                if (cnt >= TOPK) prefix = cand; }
            LAS unsigned long long* sm = (LAS unsigned long long*)lds + wave * 64;
#pragma unroll
            for (int j = 0; j < 64; ++j) { const unsigned long long w = __ballot(u[j] >= prefix); if (lane == 0) sm[j] = w; }
            myword = sm[lane];
        }
        MASK[(size_t)q * 64 + lane] = myword;
    }
}

__device__ __forceinline__ void phase_hgrn_naive(KP P, int layer, LAS unsigned char* lds) {
    unsigned char* ws = as_global(P->ws);
    const bf16_t* QA = (const bf16_t*)(ws + WS_QA); const bf16_t* KA = (const bf16_t*)(ws + WS_KA); const bf16_t* VA = (const bf16_t*)(ws + WS_VA); const bf16_t* GA = (const bf16_t*)(ws + WS_GA);
    const float* LF = (const float*)(ws + WS_LF); bf16_t* YA = (bf16_t*)(ws + WS_YA);
    const int tid = tid_(), bh = bid_(), b = bh >> 3, h = bh & 7, v = tid & 127; const bool act = (bh < 32) && (tid < 128);
    if (bh >= 32) return;
    LAS float* sf = (LAS float*)lds; LAS float* sk = sf + 16 * 128; LAS float* sq = sk + 16 * 128; LAS float* red = sq + 16 * 128;
    float S[128];
#pragma unroll
    for (int k = 0; k < 128; ++k) S[k] = 0.f;
    const float ng = as_global(P->hnorm_g)[layer * 128 + v];
    for (int t0 = 0; t0 < SEQ; t0 += 16) {
        if (act) for (int i = 0; i < 16; ++i) { const size_t idx = ((size_t)(b * SEQ + t0 + i)) * 1024 + h * 128 + v; sf[i * 128 + v] = expf(LF[idx]); sk[i * 128 + v] = bf2f(KA[idx]); sq[i * 128 + v] = bf2f(QA[idx]); }
        __syncthreads();
        for (int i = 0; i < 16; ++i) { const size_t idx = ((size_t)(b * SEQ + t0 + i)) * 1024 + h * 128 + v; float o = 0.f;
            if (act) { const float vt = bf2f(VA[idx]);
#pragma unroll
                for (int k = 0; k < 128; ++k) { S[k] = sf[i * 128 + k] * S[k] + sk[i * 128 + k] * vt; o += S[k] * sq[i * 128 + k]; } }
            float ss = o * o;
#pragma unroll
            for (int m = 32; m >= 1; m >>= 1) ss += __shfl_xor(ss, m);
            if (act && (v & 63) == 0) red[v >> 6] = ss;
            __syncthreads();
            if (act) { const float tot = red[0] + red[1]; YA[idx] = f2bf(o * (1.0f / sqrtf(tot * (1.0f / 128.0f) + RMS_EPS)) * ng * bf2f(GA[idx])); }
            __syncthreads(); }
    }
}
__device__ __forceinline__ void phase_idx_naive(KP P, LAS unsigned char* lds) {
    unsigned char* ws = as_global(P->ws);
    const bf16_t* QI = (const bf16_t*)(ws + WS_QI); const bf16_t* KI = (const bf16_t*)(ws + WS_KI); const float* WI = (const float*)(ws + WS_WI); float* Sc = (float*)(ws + WS_XPRE);
    const int tid = tid_(), G = nblk_();
    LAS float* qs = (LAS float*)lds; LAS float* wsh = qs + 1024;
    for (int q = bid_(); q < TOK; q += G) {
        const int b = q >> 12, s = q & 4095, c = s >> 6, nw = c + 1, nk = nw * 64;
        if (nw <= TOPK / 64) continue;
        __syncthreads();
        for (int i = tid; i < 1024; i += 512) qs[i] = bf2f(QI[(size_t)q * 1024 + i]);
        if (tid < 16) wsh[tid] = WI[(size_t)q * 16 + tid];
        __syncthreads();
        float* row = Sc + (size_t)b * SCORE_B + (size_t)2048 * c * (c + 1) + (size_t)(s & 63) * nk;
        for (int key = tid; key < nk; key += 512) {
            float kf[64]; const pg8::u32x4* kp = (const pg8::u32x4*)(KI + ((size_t)b * SEQ + key) * 64);
#pragma unroll
            for (int d8 = 0; d8 < 8; ++d8) { const pg8::u32x4 w = kp[d8]; pg8::f32x4 a, bb; pg8::unpack8(w, a, bb);
#pragma unroll
                for (int j = 0; j < 4; ++j) { kf[d8 * 8 + j] = a[j]; kf[d8 * 8 + 4 + j] = bb[j]; } }
            float sc = 0.f;
            for (int h = 0; h < 16; ++h) { float dot = 0.f;
#pragma unroll
                for (int d = 0; d < 64; ++d) dot += qs[h * 64 + d] * kf[d];
                sc += wsh[h] * fmaxf(dot, 0.f); }
            row[key] = sc;
        }
    }
}
__device__ __forceinline__ void phase_attn_naive(KP P, LAS unsigned char* lds) {
    unsigned char* ws = as_global(P->ws);
    const bf16_t* QB = (const bf16_t*)(ws + WS_QB); const bf16_t* KB = (const bf16_t*)(ws + WS_KB); const bf16_t* VB = (const bf16_t*)(ws + WS_VB);
    const unsigned long long* MASK = (const unsigned long long*)(ws + WS_MASK); bf16_t* YB = (bf16_t*)(ws + WS_YB);
    const int tid = tid_(), h = tid >> 6, lane = tid & 63, G = nblk_();
    LAS float* qs = (LAS float*)lds + h * 128; LAS int* keys = (LAS int*)((LAS float*)lds + 1024) + h * 320; LAS float* lg = (LAS float*)lds + 1024 + 8 * 320 + h * 320;
    for (int q = bid_(); q < TOK; q += G) {
        const int b = q >> 12, s = q & 4095, nw = (s >> 6) + 1;
        qs[lane] = bf2f(QB[(size_t)q * 1024 + h * 128 + lane]); qs[lane + 64] = bf2f(QB[(size_t)q * 1024 + h * 128 + 64 + lane]);
        int cnt = 0;
        for (int j = 0; j < nw; ++j) { const unsigned long long w = MASK[(size_t)q * 64 + j]; const bool on = (w >> lane) & 1ull; const int key = j * 64 + lane;
            if (on) { const pg8::u32x4* kp = (const pg8::u32x4*)(KB + ((size_t)b * SEQ + key) * 1024 + h * 128); float dot = 0.f;
                for (int d8 = 0; d8 < 16; ++d8) { pg8::f32x4 a, bb; pg8::unpack8(kp[d8], a, bb);
#pragma unroll
                    for (int j2 = 0; j2 < 4; ++j2) dot += qs[d8 * 8 + j2] * a[j2] + qs[d8 * 8 + 4 + j2] * bb[j2]; }
                const int pos = cnt + __popcll(w & ((1ull << lane) - 1ull));
                if (pos < 320) { keys[pos] = key; lg[pos] = dot * ATTN_SCALE; } }
            cnt += __popcll(w); }
        if (cnt > 320) cnt = 320;
        float mx = -1e30f; for (int e = lane; e < cnt; e += 64) mx = fmaxf(mx, lg[e]);
#pragma unroll
        for (int m = 32; m >= 1; m >>= 1) mx = fmaxf(mx, __shfl_xor(mx, m));
        float sum = 0.f; for (int e = lane; e < cnt; e += 64) { const float pe = expf(lg[e] - mx); lg[e] = pe; sum += pe; }
#pragma unroll
        for (int m = 32; m >= 1; m >>= 1) sum += __shfl_xor(sum, m);
        float a0 = 0.f, a1 = 0.f;
        for (int e = 0; e < cnt; ++e) { const float pe = lg[e]; const bf16_t* vp = VB + ((size_t)b * SEQ + keys[e]) * 1024 + h * 128 + 2 * lane; a0 += pe * bf2f(vp[0]); a1 += pe * bf2f(vp[1]); }
        const float inv = 1.0f / sum;
        *(unsigned*)(YB + (size_t)q * 1024 + h * 128 + 2 * lane) = pg8::cvt_pk_bf16(a0 * inv, a1 * inv);
    }
}

__global__ __launch_bounds__(128) void k_hgrn_naive(const bf16_t* QA, const bf16_t* KA, const bf16_t* VA, const bf16_t* GA, const float* LF, const float* norm_g, bf16_t* YA) {
    const int bh = blockIdx.x, b = bh >> 3, h = bh & 7, v = threadIdx.x;
    __shared__ float sf[16][128], sk[16][128], sq[16][128]; __shared__ float red[2];
    float S[128];
#pragma unroll
    for (int k = 0; k < 128; ++k) S[k] = 0.f;
    const float ng = norm_g[v];
    for (int t0 = 0; t0 < SEQ; t0 += 16) {
        for (int i = 0; i < 16; ++i) { const size_t idx = ((size_t)(b * SEQ + t0 + i)) * 1024 + h * 128 + v; sf[i][v] = expf(LF[idx]); sk[i][v] = bf2f(KA[idx]); sq[i][v] = bf2f(QA[idx]); }
        __syncthreads();
        for (int i = 0; i < 16; ++i) { const size_t idx = ((size_t)(b * SEQ + t0 + i)) * 1024 + h * 128 + v; const float vt = bf2f(VA[idx]); float o = 0.f;
#pragma unroll
            for (int k = 0; k < 128; ++k) { S[k] = sf[i][k] * S[k] + sk[i][k] * vt; o += S[k] * sq[i][k]; }
            float ss = o * o;
#pragma unroll
            for (int m = 32; m >= 1; m >>= 1) ss += __shfl_xor(ss, m);
            if ((v & 63) == 0) red[v >> 6] = ss;
            __syncthreads();
            const float tot = red[0] + red[1];
            const float y = o * (1.0f / sqrtf(tot * (1.0f / 128.0f) + RMS_EPS)) * ng * bf2f(GA[idx]);
            YA[idx] = f2bf(y);
            __syncthreads(); }
    }
}
__global__ __launch_bounds__(256) void k_idx_naive(const bf16_t* QI, const bf16_t* KI, const float* WI, float* S) {
    const int q = blockIdx.x, b = q >> 12, s = q & 4095, c = s >> 6, nw = c + 1, nk = nw * 64;
    if (nw <= TOPK / 64) return;
    __shared__ float qs[1024]; __shared__ float wsh[16];
    for (int i = threadIdx.x; i < 1024; i += 256) qs[i] = bf2f(QI[(size_t)q * 1024 + i]);
    if (threadIdx.x < 16) wsh[threadIdx.x] = WI[(size_t)q * 16 + threadIdx.x];
    __syncthreads();
    float* row = S + (size_t)b * SCORE_B + (size_t)2048 * c * (c + 1) + (size_t)(s & 63) * nk;
    for (int key = threadIdx.x; key < nk; key += 256) {
        float kf[64]; const bf16_t* kp = KI + ((size_t)b * SEQ + key) * 64;
#pragma unroll
        for (int d = 0; d < 64; ++d) kf[d] = bf2f(kp[d]);
        float sc = 0.f;
        for (int h = 0; h < 16; ++h) { float dot = 0.f;
#pragma unroll
            for (int d = 0; d < 64; ++d) dot += qs[h * 64 + d] * kf[d];
            sc += wsh[h] * fmaxf(dot, 0.f); }
        row[key] = sc;
    }
}
__global__ __launch_bounds__(512) void k_attn_naive(const bf16_t* QB, const bf16_t* KB, const bf16_t* VB, const unsigned long long* MASK, bf16_t* YB) {
    const int q = blockIdx.x, b = q >> 12, s = q & 4095, nw = (s >> 6) + 1, h = threadIdx.x >> 6, lane = threadIdx.x & 63;
    __shared__ float qs[8][128]; __shared__ int keys[8][320]; __shared__ float lg[8][320];
    qs[h][lane] = bf2f(QB[(size_t)q * 1024 + h * 128 + lane]); qs[h][lane + 64] = bf2f(QB[(size_t)q * 1024 + h * 128 + 64 + lane]);
    __syncthreads();
    int cnt = 0;
    for (int j = 0; j < nw; ++j) { const unsigned long long w = MASK[(size_t)q * 64 + j]; const bool on = (w >> lane) & 1ull; const int key = j * 64 + lane;
        if (on) { const bf16_t* kp = KB + ((size_t)b * SEQ + key) * 1024 + h * 128; float dot = 0.f;
            for (int d = 0; d < 128; ++d) dot += qs[h][d] * bf2f(kp[d]);
            const int pos = cnt + __popcll(w & ((1ull << lane) - 1ull));
            if (pos < 320) { keys[h][pos] = key; lg[h][pos] = dot * ATTN_SCALE; } }
        cnt += __popcll(w); }
    if (cnt > 320) cnt = 320;
    __syncthreads();
    float mx = -1e30f; for (int e = lane; e < cnt; e += 64) mx = fmaxf(mx, lg[h][e]);
#pragma unroll
    for (int m = 32; m >= 1; m >>= 1) mx = fmaxf(mx, __shfl_xor(mx, m));
    float sum = 0.f; for (int e = lane; e < cnt; e += 64) { const float pe = expf(lg[h][e] - mx); lg[h][e] = pe; sum += pe; }
#pragma unroll
    for (int m = 32; m >= 1; m >>= 1) sum += __shfl_xor(sum, m);
    __syncthreads();
    float a0 = 0.f, a1 = 0.f;
    for (int e = 0; e < cnt; ++e) { const float pe = lg[h][e]; const bf16_t* vp = VB + ((size_t)b * SEQ + keys[h][e]) * 1024 + h * 128 + 2 * lane; a0 += pe * bf2f(vp[0]); a1 += pe * bf2f(vp[1]); }
    const float inv = 1.0f / sum;
    YB[(size_t)q * 1024 + h * 128 + 2 * lane] = f2bf(a0 * inv); YB[(size_t)q * 1024 + h * 128 + 2 * lane + 1] = f2bf(a1 * inv);
}

__global__ __launch_bounds__(256) void k_dump(const unsigned char* ws, int which, float* out) {
    for (size_t i = (size_t)blockIdx.x * 256 + threadIdx.x; i < (size_t)TOK * DM; i += (size_t)gridDim.x * 256) {
        const size_t t = i / DM, c = i % DM; float v = 0.f;
        if (which == 0) { v = bf2f(((const bf16_t*)(ws + WS_MG))[i]) + ((const float*)(ws + WS_PP))[i]; }
        else if (which == 1) { const size_t j = t * 1024 + (c & 1023);
            v = bf2f(((const bf16_t*)(ws + WS_QA))[j]) + bf2f(((const bf16_t*)(ws + WS_KA))[j]) + bf2f(((const bf16_t*)(ws + WS_VA))[j]) + bf2f(((const bf16_t*)(ws + WS_GA))[j])
              + bf2f(((const bf16_t*)(ws + WS_QB))[j]) + bf2f(((const bf16_t*)(ws + WS_KB))[j]) + bf2f(((const bf16_t*)(ws + WS_VB))[j]) + bf2f(((const bf16_t*)(ws + WS_QI))[j])
              + ((const float*)(ws + WS_LF))[j] + bf2f(((const bf16_t*)(ws + WS_SGA))[i]) + bf2f(((const bf16_t*)(ws + WS_SGB))[i]) + ((const float*)(ws + WS_IKW))[t * 128 + (c & 127)]; }
        else if (which == 2) { const size_t j = t * 1024 + (c & 1023); v = (c < 1024) ? bf2f(((const bf16_t*)(ws + WS_YA))[j]) : bf2f(((const bf16_t*)(ws + WS_YB))[j]); }
        else if (which == 3) { v = ((const float*)(ws + WS_XPRE))[i]; }
        else if (which == 4) { v = ((const float*)(ws + WS_X32))[i]; }
        else if (which == 5) { v = bf2f(((const bf16_t*)(ws + WS_H))[t * DFF + c]) + bf2f(((const bf16_t*)(ws + WS_H))[t * DFF + 2048 + c]) + bf2f(((const bf16_t*)(ws + WS_H))[t * DFF + 3584 + c]); }
        else if (which == 6) { const unsigned long long m = ((const unsigned long long*)(ws + WS_MASK))[t * 64 + (c & 63)]; v = (float)__popcll(m) + (float)(unsigned)(m % 1000003ull) * 1e-3f; }
        else if (which == 7) { v = bf2f(((const bf16_t*)(ws + WS_WIN))[i % ((size_t)INP * DM)]) + bf2f(((const bf16_t*)(ws + WS_WGU))[(i * 7) % ((size_t)2 * DFF * DM)]) + bf2f(((const bf16_t*)(ws + WS_WDN))[(i * 3) % ((size_t)DFF * DM)]); }
        else if (which == 8) { v = bf2f(((const bf16_t*)(ws + WS_XB))[i]) + ((const float*)(ws + WS_COSH))[i % ((size_t)TOK * 64)] + ((const float*)(ws + WS_SINI))[i % ((size_t)TOK * 32)] + ((const float*)(ws + WS_LB))[i % 4096]; }
        else if (which == 9) { v = bf2f(((const bf16_t*)(ws + WS_H))[t * 6272 + c]) + bf2f(((const bf16_t*)(ws + WS_H))[t * 6272 + 2048 + c]) + bf2f(((const bf16_t*)(ws + WS_H))[t * 6272 + 4096 + c]) + bf2f(((const bf16_t*)(ws + WS_H))[t * 6272 + 4224 + c]); }
        else if (which == 10) { const size_t j = t * 1024 + (c & 1023); v = bf2f(((const bf16_t*)(ws + WS_QA))[j]) + bf2f(((const bf16_t*)(ws + WS_VA))[j]) + bf2f(((const bf16_t*)(ws + WS_GA))[j]) + bf2f(((const bf16_t*)(ws + WS_VB))[j]) + bf2f(((const bf16_t*)(ws + WS_SGA))[i]) + bf2f(((const bf16_t*)(ws + WS_SGB))[i]); }
        else if (which == 11) { const size_t j = t * 1024 + (c & 1023); v = bf2f(((const bf16_t*)(ws + WS_QB))[j]) + bf2f(((const bf16_t*)(ws + WS_KB))[j]) + bf2f(((const bf16_t*)(ws + WS_QI))[j]); }
        else if (which == 12) { const size_t j = t * 1024 + (c & 1023); v = ((const float*)(ws + WS_LF))[j] + bf2f(((const bf16_t*)(ws + WS_KA))[j]); }
        else if (which == 14) { v = ((const float*)(ws + WS_IKW))[t * 128 + (c & 127)]; }
        else if (which == 15) { const size_t j = t * 1024 + (c & 1023); v = bf2f(((const bf16_t*)(ws + WS_QA))[j]) + bf2f(((const bf16_t*)(ws + WS_GA))[j]); }
        else if (which == 16) { v = bf2f(((const bf16_t*)(ws + WS_SGA))[i]) + bf2f(((const bf16_t*)(ws + WS_SGB))[i]); }
        else if (which == 17) { const size_t j = t * 1024 + (c & 1023); v = bf2f(((const bf16_t*)(ws + WS_VA))[j]) + bf2f(((const bf16_t*)(ws + WS_VB))[j]); }
        out[i] = v;
    }
}
#ifndef OPT_HGRN
#define OPT_HGRN 0
#endif
#ifndef OPT_IDX
#define OPT_IDX 0
#endif
#ifndef OPT_ATT
#define OPT_ATT 0
#endif
#ifndef PHM
#define PHM 0x3fff
#endif
#ifndef ONE_LAUNCH
#define ONE_LAUNCH 1
#endif

__global__ void __launch_bounds__(512, 2) mega(Params P_unused) {
    extern __shared__ __attribute__((aligned(16))) unsigned char lds[];
    LAS unsigned char* L = (LAS unsigned char*)lds;
    volatile LAS unsigned* misc = (volatile LAS unsigned*)(L + MISC_OFF);
    if (threadIdx.x < 4) misc[threadIdx.x] = 0u;
    __syncthreads();
    int lo, hi; unsigned char* ws0; { KP P0 = kparams(); lo = P0->ph_lo; hi = P0->ph_hi; ws0 = as_global(P0->ws); }
    XcdBarrier bar; bar.bar = (unsigned*)(ws0 + WS_CTL); bar.x = 0; bar.st = misc;
    if (hi - lo > 1) bar = xcd_barrier_post((unsigned*)(ws0 + WS_CTL), misc);
#define WSP(T_, off) ((T_*)(ws + (off)))
#define WSL KP P = kparams(); unsigned char* ws = as_global(P->ws); const int G = nblk_(), bid = bid_(); (void)G; (void)bid

    for (int layer = 0; layer < DEPTH; ++layer) {
        const int base = layer * NPH_LAYER;
#define IN(k) (((PHM >> (k)) & 1) && lo <= base + (k) && base + (k) < hi)
#define SEAM(k) do { if (base + (k) + 1 < hi) xcd_barrier(bar); } while (0)
        if (IN(0)) { WSL; if (layer == 0) phase_prologue(P); phase_wconv(P, layer, (LAS float*)L); SEAM(0); }
        if (IN(1)) { WSL;
            pg8::Gemm g{WSP(const bf16_t, WS_XB), WSP(const bf16_t, WS_WIN), TOK, INP, DM}; pg8::StaticOrder S; S.init(TOK, INP, G, bid);
#ifdef RAWTEST
            pg8::EpiRawTest E{ws};
            pg8::gemm_phase<pg8::EpiRawTest, pg8::StaticOrder, true, true>(L, g, S, E); SEAM(1);
#else
            pg8::EpiIn E{ws, layer};
            pg8::gemm_phase<pg8::EpiIn, pg8::StaticOrder, true, true>(L, g, S, E); SEAM(1);
#endif
        }
        if (IN(2)) { WSL; phase_ikprep(P, layer); SEAM(2); }
        if (IN(3)) { WSL;
#if !OPT_HGRN
            phase_hgrn_naive(P, layer, L); __syncthreads();
#endif
#if !OPT_IDX
            phase_idx_naive(P, L);
#endif
            SEAM(3); }
        if (IN(4)) { WSL; phase_select(P, L); SEAM(4); }
        if (IN(5)) { WSL;
#if !OPT_ATT
            phase_attn_naive(P, L);
#endif
            SEAM(5); }
        if (IN(6)) { WSL;
            { pg8::Gemm g{WSP(const bf16_t, WS_YA), WSP(const bf16_t, WS_WA), TOK, DM, AW}; pg8::StaticOrder S; S.init(TOK, DM, G, bid);
              pg8::EpiGateA E{ws}; pg8::gemm_phase<pg8::EpiGateA, pg8::StaticOrder, true, true>(L, g, S, E); }
            { pg8::Gemm g{WSP(const bf16_t, WS_YB), WSP(const bf16_t, WS_WB), TOK, DM, BW}; pg8::StaticOrder S; S.init(TOK, DM, G, bid);
              pg8::EpiGateB E{ws}; pg8::gemm_phase<pg8::EpiGateB, pg8::StaticOrder, true, true>(L, g, S, E); }
            { pg8::Gemm g{WSP(const bf16_t, WS_PB), WSP(const bf16_t, WS_WPP), TOK, DM, PLE}; pg8::StaticOrder S; S.init(TOK, DM, G, bid);
              pg8::EpiF32P E{ws}; pg8::gemm_phase<pg8::EpiF32P, pg8::StaticOrder, true, true>(L, g, S, E); }
            SEAM(6);
        }
        if (IN(7)) { WSL;
            pg8::Gemm g{WSP(const bf16_t, WS_MG), WSP(const bf16_t, WS_WO), TOK, DM, DM}; pg8::StaticOrder S; S.init(TOK, DM, G, bid);
            pg8::EpiRes E{layer == 0 ? as_global(P->x) : WSP(const float, WS_X32), ws}; pg8::gemm_phase<pg8::EpiRes, pg8::StaticOrder, true, true>(L, g, S, E); SEAM(7);
        }
        if (IN(8)) { WSL; phase_ln(WSP(const float, WS_XPRE), WSP(float, WS_X32), WSP(bf16_t, WS_XB), as_global(P->lnm_g) + layer * DM, as_global(P->lnm_b) + layer * DM); SEAM(8); }
        if (IN(9)) { WSL;
            pg8::Gemm g{WSP(const bf16_t, WS_XB), WSP(const bf16_t, WS_WGU), TOK, 2 * DFF, DM}; pg8::StaticOrder S; S.init(TOK, 2 * DFF, G, bid);
            pg8::EpiSwiGLU E{ws}; pg8::gemm_phase<pg8::EpiSwiGLU, pg8::StaticOrder, true, true>(L, g, S, E); SEAM(9);
        }
        if (IN(10)) { WSL;
            pg8::Gemm g{WSP(const bf16_t, WS_H), WSP(const bf16_t, WS_WDN), TOK, DM, DFF}; pg8::StaticOrder S; S.init(TOK, DM, G, bid);
            pg8::EpiRes E{WSP(const float, WS_X32), ws}; pg8::gemm_phase<pg8::EpiRes, pg8::StaticOrder, true, true>(L, g, S, E); SEAM(10);
        }
        if (IN(11)) { WSL; phase_ln(WSP(const float, WS_XPRE), WSP(float, WS_X32), WSP(bf16_t, WS_XB), as_global(P->lnf_g) + layer * DM, as_global(P->lnf_b) + layer * DM); SEAM(11); }
        if (IN(12)) { WSL;
            pg8::Gemm g{WSP(const bf16_t, WS_XB), WSP(const bf16_t, WS_WPG), TOK, DM, DM}; pg8::StaticOrder S; S.init(TOK, DM, G, bid);
            pg8::EpiPle E{ws}; pg8::gemm_phase<pg8::EpiPle, pg8::StaticOrder, true, true>(L, g, S, E); SEAM(12);
        }
        if (IN(13)) { WSL; phase_ln(WSP(const float, WS_XPRE), layer == DEPTH - 1 ? as_global(P->out) : WSP(float, WS_X32), WSP(bf16_t, WS_XB), as_global(P->lnp_g) + layer * DM, as_global(P->lnp_b) + layer * DM); SEAM(13); }
#undef IN
#undef SEAM
    }
}

extern "C" void kernel_launch(void* const* d_in, const int* in_sizes, int n_in, void* d_out, int out_size, void* d_ws, size_t ws_size, hipStream_t stream) {
    static int grid = 0;
    if (grid == 0) {
        if (n_in != 22 || out_size != TOK * DM || ws_size < WS_END) { fprintf(stderr, "kernel_launch: unexpected shapes: n_in %d out %d ws %zu (need %zu)\n", n_in, out_size, ws_size, (size_t)WS_END); grid = -1; return; }
        int dev = 0, cus = 0, per_cu = 0;
        if (hipGetDevice(&dev) != hipSuccess || hipDeviceGetAttribute(&cus, hipDeviceAttributeMultiprocessorCount, dev) != hipSuccess) { grid = -1; return; }
        if (hipFuncSetAttribute((const void*)mega, hipFuncAttributeMaxDynamicSharedMemorySize, LDS_BYTES) != hipSuccess) { fprintf(stderr, "kernel_launch: hipFuncSetAttribute failed\n"); grid = -1; return; }
        if (hipOccupancyMaxActiveBlocksPerMultiprocessor(&per_cu, (const void*)mega, 512, LDS_BYTES) != hipSuccess || per_cu < 1) { fprintf(stderr, "kernel_launch: occupancy query says %d\n", per_cu); (void)hipGetLastError(); }
        grid = cus;
    }
    if (grid < 0) return;
    (void)hipMemsetAsync((char*)d_ws + WS_CTL, 0, 65536, stream);
    Params P{};
    P.x = (const float*)d_in[0]; P.p = (const float*)d_in[1]; P.pos = (const int*)d_in[2];
    P.w_in = (const float*)d_in[3]; P.w_a = (const float*)d_in[4]; P.w_b = (const float*)d_in[5]; P.w_out = (const float*)d_in[6];
    P.lbraw = (const float*)d_in[7]; P.hnorm_g = (const float*)d_in[8]; P.ikn_g = (const float*)d_in[9]; P.ikn_b = (const float*)d_in[10];
    P.lnm_g = (const float*)d_in[11]; P.lnm_b = (const float*)d_in[12]; P.w_fg = (const float*)d_in[13]; P.w_fu = (const float*)d_in[14]; P.w_fd = (const float*)d_in[15];
    P.lnf_g = (const float*)d_in[16]; P.lnf_b = (const float*)d_in[17]; P.w_pg = (const float*)d_in[18]; P.w_pp = (const float*)d_in[19];
    P.lnp_g = (const float*)d_in[20]; P.lnp_b = (const float*)d_in[21];
    P.out = (float*)d_out; P.ws = (unsigned char*)d_ws;
    for (int j = 0; j < 64; ++j) P.invf_h[j] = pow(10000.0, -(double)j / 64.0) / 6.283185307179586476925286766559;
    for (int j = 0; j < 32; ++j) P.invf_i[j] = pow(10000.0, -(double)j / 32.0) / 6.283185307179586476925286766559;
#if ONE_LAUNCH
    P.ph_lo = 0; P.ph_hi = NPH;
    hipLaunchKernelGGL(mega, dim3(grid), dim3(512), LDS_BYTES, stream, P);
#elif defined(SEQ_TEST)
    { const int seq[] = SEQ_TEST; for (int i = 0; i < (int)(sizeof(seq) / sizeof(int)); ++i) { P.ph_lo = seq[i]; P.ph_hi = seq[i] + 1; hipLaunchKernelGGL(mega, dim3(grid), dim3(512), LDS_BYTES, stream, P); }
      hipLaunchKernelGGL(k_dump, dim3(4096), dim3(256), 0, stream, (const unsigned char*)d_ws, DUMP_WHICH, (float*)d_out); }
#else
    unsigned char* ws = (unsigned char*)d_ws;
    for (int layer = 0; layer < DEPTH; ++layer)
        for (int k = 0; k < NPH_LAYER; ++k) {
            P.ph_lo = layer * NPH_LAYER + k; P.ph_hi = P.ph_lo + 1;
            bool run_mega = true;
#if !OPT_HGRN
            if (k == 3) hipLaunchKernelGGL(k_hgrn_naive, dim3(32), dim3(128), 0, stream, (const bf16_t*)(ws + WS_QA), (const bf16_t*)(ws + WS_KA), (const bf16_t*)(ws + WS_VA), (const bf16_t*)(ws + WS_GA),
                                           (const float*)(ws + WS_LF), P.hnorm_g + layer * 128, (bf16_t*)(ws + WS_YA));
#endif
#if !OPT_IDX
            if (k == 3) hipLaunchKernelGGL(k_idx_naive, dim3(TOK), dim3(256), 0, stream, (const bf16_t*)(ws + WS_QI), (const bf16_t*)(ws + WS_KI), (const float*)(ws + WS_WI), (float*)(ws + WS_XPRE));
#endif
#if !OPT_ATT
            if (k == 5) hipLaunchKernelGGL(k_attn_naive, dim3(TOK), dim3(512), 0, stream, (const bf16_t*)(ws + WS_QB), (const bf16_t*)(ws + WS_KB), (const bf16_t*)(ws + WS_VB),
                                           (const unsigned long long*)(ws + WS_MASK), (bf16_t*)(ws + WS_YB));
#endif
#if !OPT_HGRN && !OPT_IDX
            if (k == 3) run_mega = false;
#endif
#if !OPT_ATT
            if (k == 5) run_mega = false;
#endif
            if (run_mega) hipLaunchKernelGGL(mega, dim3(grid), dim3(512), LDS_BYTES, stream, P);
#ifdef DUMP_AT
            if (layer * NPH_LAYER + k == DUMP_AT) { hipLaunchKernelGGL(k_dump, dim3(4096), dim3(256), 0, stream, (const unsigned char*)ws, DUMP_WHICH, (float*)d_out); return; }
#endif
        }
#endif
    const hipError_t le = hipPeekAtLastError();
    if (le != hipSuccess) fprintf(stderr, "kernel_launch: launch failed: %s\n", hipGetErrorName(le));
}
```

```cpp
#include <hip/hip_runtime.h>
#include <cstdio>
#include <cstdint>

constexpr int DM = 2048, NBATCH = 4, SEQ = 4096, TOK = NBATCH * SEQ, DEPTH = 4, CHUNK = 64, PLE = 256;
constexpr int AH = 8, AD = 128, AW = 1024, BH = 8, BD = 128, BW = 1024, IH = 16, IDIM = 64, TOPK = 256;
constexpr int DFF = 5632, INW = 12368, INP = 12544;
constexpr float ALPHA = 1.6817928305074290861f;
constexpr float LN_EPS = 1e-5f, RMS_EPS = 1e-6f;
constexpr float ATTN_SCALE = 0.088388347648318440f;
constexpr float IDX_SCALE = 0.03125f;

typedef unsigned short bf16_t;
__device__ __forceinline__ float bf2f(bf16_t b) { return __uint_as_float(((unsigned)b) << 16); }
__device__ __forceinline__ bf16_t f2bf(float f) { unsigned u = __float_as_uint(f); u += 0x7FFFu + ((u >> 16) & 1u); return (bf16_t)(u >> 16); }
__device__ __forceinline__ float sigmoid_f(float x) { return __builtin_amdgcn_rcpf(1.0f + __expf(-x)); }
__device__ __forceinline__ float silu_f(float x) { return x * sigmoid_f(x); }

__device__ __forceinline__ int tid_() { int t = (int)threadIdx.x; asm volatile("" : "+v"(t)); return t; }
__device__ __forceinline__ int bid_() { int b = (int)blockIdx.x; asm volatile("" : "+s"(b)); return b; }
__device__ __forceinline__ int nblk_() { int g = (int)gridDim.x; asm volatile("" : "+s"(g)); return g; }

template <class T> __device__ __forceinline__ T* as_global(T* p) { return (T*)(__attribute__((address_space(1))) T*)p; }

constexpr size_t MiB = 1048576;
constexpr size_t WS_CTL  = 0;
constexpr size_t WS_LB   = WS_CTL + 65536;
constexpr size_t WS_COSH = 1 * MiB;
constexpr size_t WS_SINH = WS_COSH + 4 * MiB;
constexpr size_t WS_COSI = WS_SINH + 4 * MiB;
constexpr size_t WS_SINI = WS_COSI + 2 * MiB;
constexpr size_t WS_WIN  = WS_SINI + 2 * MiB;
constexpr size_t WS_WA   = WS_WIN + 49 * MiB;
constexpr size_t WS_WB   = WS_WA + 4 * MiB;
constexpr size_t WS_WO   = WS_WB + 4 * MiB;
constexpr size_t WS_WGU  = WS_WO + 8 * MiB;
constexpr size_t WS_WDN  = WS_WGU + 44 * MiB;
constexpr size_t WS_WPG  = WS_WDN + 22 * MiB;
constexpr size_t WS_WPP  = WS_WPG + 8 * MiB;
constexpr size_t WS_X32  = WS_WPP + 1 * MiB;
constexpr size_t WS_XB   = WS_X32 + 128 * MiB;
constexpr size_t WS_XPRE = WS_XB + 64 * MiB;
constexpr size_t WS_R1   = WS_XPRE + 130 * MiB;
constexpr size_t WS_QA   = WS_R1;
constexpr size_t WS_LF   = WS_QA + 32 * MiB;
constexpr size_t WS_KA   = WS_LF + 64 * MiB;
constexpr size_t WS_VA   = WS_KA + 32 * MiB;
constexpr size_t WS_GA   = WS_VA + 32 * MiB;
constexpr size_t WS_QB   = WS_GA + 32 * MiB;
constexpr size_t WS_KB   = WS_QB + 32 * MiB;
constexpr size_t WS_VB   = WS_KB + 32 * MiB;
constexpr size_t WS_QI   = WS_VB + 32 * MiB;
constexpr size_t WS_SGA  = WS_QI + 32 * MiB;
constexpr size_t WS_SGB  = WS_SGA + 64 * MiB;
constexpr size_t WS_IKW  = WS_SGB + 64 * MiB;
constexpr size_t WS_H    = WS_R1;
constexpr size_t WS_PP   = WS_R1 + 176 * MiB;
constexpr size_t WS_R2   = WS_IKW + 8 * MiB;
constexpr size_t WS_LT   = WS_R2;
constexpr size_t WS_MG   = WS_R2;
constexpr size_t WS_PT   = WS_LT + 128 * MiB;
constexpr size_t WS_DEC  = WS_PT + 64 * MiB;
constexpr size_t WS_MASK = WS_DEC + 1 * MiB;
constexpr size_t WS_YA   = WS_MASK + 8 * MiB;
constexpr size_t WS_YB   = WS_YA + 32 * MiB;
constexpr size_t WS_KI   = WS_YB + 32 * MiB;
constexpr size_t WS_WI   = WS_KI + 2 * MiB;
constexpr size_t WS_PB   = WS_WI + 1 * MiB;
constexpr size_t WS_END  = WS_PB + 8 * MiB;
static_assert(WS_END < 1360000000ull, "workspace budget");
constexpr size_t SCORE_B = (size_t)4096 * 2080;

namespace pg8 {
#define PG8_LAS __attribute__((address_space(3)))
typedef unsigned short bf16_t;
typedef short bf16x8 __attribute__((ext_vector_type(8)));
typedef float f32x4 __attribute__((ext_vector_type(4)));
typedef unsigned u32x4 __attribute__((ext_vector_type(4)));
constexpr int BM = 256, BK = 64, HALF = 128, HTB = HALF * BK * 2  , STAGE_BYTES = 8 * HTB, NXCD = 8, WGM = 8;

__host__ __device__ __forceinline__ int lds_byte(int r, int c) { const int st = (r >> 4) * 2 + (c >> 5), rr = r & 15, cc = c & 31, ob = rr * 64 + cc * 2; return st * 1024 + (ob ^ (((ob >> 9) & 1) << 5)); }
__host__ __device__ __forceinline__ void stage_rc(int b, int& R, int& C) { const int st = b / 1024, sb = b % 1024, swz = sb ^ (((sb >> 9) & 1) << 5); R = (st >> 1) * 16 + swz / 64; C = (st & 1) * 32 + (swz % 64) / 2; }
__host__ __device__ __forceinline__ int perm32(int rho) { const int n = rho >> 4, i = rho & 15; return 8 * (i >> 2) + 4 * n + (i & 3); }

struct Unit { int pm, pn; };
struct Gemm { const bf16_t* A; const bf16_t* Bt; int M, N, K; };

struct StaticOrder {
    int nM, nN, nwg, G, c;
    __host__ __device__ void init(int M, int N, int G_, int c_) { nM = M / BM; nN = N / BM; nwg = nM * nN; G = G_; c = c_; }
    __host__ __device__ bool next(int i, Unit& u) const {
        const long L = (long)i * G + c; if (L >= nwg) return false;
        int wgid = (int)L; { const int q = nwg / NXCD, r = nwg % NXCD, xcd = wgid % NXCD, off = wgid / NXCD; wgid = (xcd < r ? xcd * (q + 1) : r * (q + 1) + (xcd - r) * q) + off; }
        const int nig = WGM * nN, gid = wgid / nig, fm = gid * WGM, gsz = (nM - fm) < WGM ? (nM - fm) : WGM;
        u.pm = fm + ((wgid % nig) % gsz); u.pn = (wgid % nig) / gsz; return true;
    }
    __device__ __forceinline__ void a_ready(const Unit&) const {}
    __device__ __forceinline__ void done(const Unit&) const {}
};

typedef float pk_f32x2 __attribute__((ext_vector_type(2)));
typedef __bf16 pk_bf16x2 __attribute__((ext_vector_type(2)));
__device__ __forceinline__ unsigned cvt_pk_bf16(float lo, float hi) { const pk_f32x2 v = {lo, hi}; const pk_bf16x2 b = __builtin_convertvector(v, pk_bf16x2); return __builtin_bit_cast(unsigned, b); }
typedef unsigned u32x2 __attribute__((ext_vector_type(2)));
__device__ __forceinline__ u32x4 pack8(const f32x4 a, const f32x4 b) { u32x4 w; w.x = cvt_pk_bf16(a[0], a[1]); w.y = cvt_pk_bf16(a[2], a[3]); w.z = cvt_pk_bf16(b[0], b[1]); w.w = cvt_pk_bf16(b[2], b[3]); return w; }
__device__ __forceinline__ void unpack8(const u32x4 w, f32x4& a, f32x4& b) {
    a[0] = __uint_as_float(w.x << 16); a[1] = __uint_as_float(w.x & 0xffff0000u); a[2] = __uint_as_float(w.y << 16); a[3] = __uint_as_float(w.y & 0xffff0000u);
    b[0] = __uint_as_float(w.z << 16); b[1] = __uint_as_float(w.z & 0xffff0000u); b[2] = __uint_as_float(w.w << 16); b[3] = __uint_as_float(w.w & 0xffff0000u); }
__device__ __forceinline__ float sigm(float x) { return __builtin_amdgcn_rcpf(1.0f + __expf(-x)); }
__device__ __forceinline__ f32x4 sigm4(const f32x4 x) { f32x4 r; r[0] = sigm(x[0]); r[1] = sigm(x[1]); r[2] = sigm(x[2]); r[3] = sigm(x[3]); return r; }
__device__ __forceinline__ f32x4 silu4(const f32x4 x) { return x * sigm4(x); }

#define PG8_GAS __attribute__((address_space(1)))
struct EpiIn {
    static constexpr bool PERM = true, AFTER_DRAIN = false;
    unsigned char* ws0; int layer;
    __device__ __forceinline__ void operator()(const f32x4 (&acc)[2][2][4][2], const Unit& u, int wr, int wc, int fr, int fq) const {
        unsigned char* wsq = ws0; asm volatile("" : "+s"(wsq)); PG8_GAS unsigned char* const ws = (PG8_GAS unsigned char*)wsq;
        const int pn = u.pn, row0 = u.pm * BM + wr * 64 + fr, cw = wc * 32 + 8 * fq;
        PG8_GAS bf16_t* const QA = (PG8_GAS bf16_t*)(ws + WS_QA); PG8_GAS bf16_t* const KA = (PG8_GAS bf16_t*)(ws + WS_KA); PG8_GAS bf16_t* const VA = (PG8_GAS bf16_t*)(ws + WS_VA); PG8_GAS bf16_t* const GA = (PG8_GAS bf16_t*)(ws + WS_GA);
        PG8_GAS bf16_t* const QB = (PG8_GAS bf16_t*)(ws + WS_QB); PG8_GAS bf16_t* const KB = (PG8_GAS bf16_t*)(ws + WS_KB); PG8_GAS bf16_t* const VB = (PG8_GAS bf16_t*)(ws + WS_VB); PG8_GAS bf16_t* const QI = (PG8_GAS bf16_t*)(ws + WS_QI);
        PG8_GAS bf16_t* const SGA = (PG8_GAS bf16_t*)(ws + WS_SGA); PG8_GAS bf16_t* const SGB = (PG8_GAS bf16_t*)(ws + WS_SGB); PG8_GAS float* const LF = (PG8_GAS float*)(ws + WS_LF); PG8_GAS float* const IKW = (PG8_GAS float*)(ws + WS_IKW);
        const PG8_GAS float* const lb = (const PG8_GAS float*)(ws + WS_LB) + layer * 1024; const PG8_GAS float* const cosh = (const PG8_GAS float*)(ws + WS_COSH); const PG8_GAS float* const sinh = (const PG8_GAS float*)(ws + WS_SINH);
        const PG8_GAS float* const cosi = (const PG8_GAS float*)(ws + WS_COSI); const PG8_GAS float* const sini = (const PG8_GAS float*)(ws + WS_SINI);
        if (pn < 32) {
            const int seg = pn >> 2, cb = (pn & 3) * 256;
            if (seg == 4 || seg == 5) {
                PG8_GAS bf16_t* O = (seg == 4) ? QB : KB; const int head = (pn & 3) * 2 + (wc >> 1), i0 = (wc & 1) * 32 + 8 * fq;
#pragma unroll
                for (int ai = 0; ai < 2; ++ai)
#pragma unroll
                    for (int m = 0; m < 4; ++m) { const int row = row0 + ai * HALF + m * 16;
                        const PG8_GAS float* cp = cosh + (size_t)row * 64 + i0; const PG8_GAS float* sp = sinh + (size_t)row * 64 + i0;
                        const f32x4 c0 = *(const PG8_GAS f32x4*)cp, c1 = *(const PG8_GAS f32x4*)(cp + 4), s0 = *(const PG8_GAS f32x4*)sp, s1 = *(const PG8_GAS f32x4*)(sp + 4);
                        const f32x4 xa = acc[ai][0][m][0], xb = acc[ai][0][m][1], ya = acc[ai][1][m][0], yb = acc[ai][1][m][1];
                        PG8_GAS bf16_t* rp = O + (size_t)row * 1024 + head * 128 + i0;
                        *(PG8_GAS u32x4*)rp = pack8(xa * c0 - ya * s0, xb * c1 - yb * s1);
                        *(PG8_GAS u32x4*)(rp + 64) = pack8(xa * s0 + ya * c0, xb * s1 + yb * c1); asm volatile("" ::: "memory"); }
            } else if (seg == 7) {
                const int head = (pn & 3) * 4 + wc, i0 = 8 * fq;
#pragma unroll
                for (int ai = 0; ai < 2; ++ai)
#pragma unroll
                    for (int m = 0; m < 4; ++m) { const int row = row0 + ai * HALF + m * 16;
                        const PG8_GAS float* cp = cosi + (size_t)row * 32 + i0; const PG8_GAS float* sp = sini + (size_t)row * 32 + i0;
                        const f32x4 c0 = *(const PG8_GAS f32x4*)cp, c1 = *(const PG8_GAS f32x4*)(cp + 4), s0 = *(const PG8_GAS f32x4*)sp, s1 = *(const PG8_GAS f32x4*)(sp + 4);
                        const f32x4 xa = acc[ai][0][m][0], xb = acc[ai][0][m][1], ya = acc[ai][1][m][0], yb = acc[ai][1][m][1];
                        PG8_GAS bf16_t* rp = QI + (size_t)row * 1024 + head * 64 + i0;
                        *(PG8_GAS u32x4*)rp = pack8(xa * c0 - ya * s0, xb * c1 - yb * s1);
                        *(PG8_GAS u32x4*)(rp + 32) = pack8(xa * s0 + ya * c0, xb * s1 + yb * c1); asm volatile("" ::: "memory"); }
            } else if (seg == 1) {
#pragma unroll
                for (int bj = 0; bj < 2; ++bj) { const int col = cb + bj * HALF + cw;
                    const f32x4 l0 = *(const PG8_GAS f32x4*)(lb + col), l1 = *(const PG8_GAS f32x4*)(lb + col + 4);
#pragma unroll
                    for (int ai = 0; ai < 2; ++ai)
#pragma unroll
                        for (int m = 0; m < 4; ++m) { const int row = row0 + ai * HALF + m * 16; f32x4 lf[2], kk[2];
#pragma unroll
                            for (int n = 0; n < 2; ++n) { const f32x4 x = acc[ai][bj][m][n]; const f32x4 lv = n ? l1 : l0;
#pragma unroll
                                for (int j = 0; j < 4; ++j) { const float xe = fminf(fmaxf(x[j], -80.f), 80.f), e = __expf(-xe), r = __builtin_amdgcn_rcpf(1.0f + e);
                                    const float om = 1.0f - lv[j]; lf[n][j] = logf(lv[j] + om * r); kk[n][j] = om * (e * r); } }
                            PG8_GAS float* lp = LF + (size_t)row * 1024 + col; *(PG8_GAS f32x4*)lp = lf[0]; *(PG8_GAS f32x4*)(lp + 4) = lf[1];
                            *(PG8_GAS u32x4*)(KA + (size_t)row * 1024 + col) = pack8(kk[0], kk[1]); asm volatile("" ::: "memory"); } }
            } else {
                PG8_GAS bf16_t* O = (seg == 0) ? QA : (seg == 2) ? VA : (seg == 3) ? GA : VB; const bool act = (seg == 0 || seg == 3);
#pragma unroll
                for (int ai = 0; ai < 2; ++ai)
#pragma unroll
                    for (int m = 0; m < 4; ++m) { const int row = row0 + ai * HALF + m * 16;
#pragma unroll
                        for (int bj = 0; bj < 2; ++bj) { f32x4 v0 = acc[ai][bj][m][0], v1 = acc[ai][bj][m][1];
                            if (act) { v0 = silu4(v0); v1 = silu4(v1); }
                            *(PG8_GAS u32x4*)(O + (size_t)row * 1024 + cb + bj * HALF + cw) = pack8(v0, v1); } }
            }
        } else if (pn < 48) {
            PG8_GAS bf16_t* O = (pn < 40) ? SGA : SGB; const int cb = ((pn - 32) & 7) * 256;
#pragma unroll
            for (int ai = 0; ai < 2; ++ai)
#pragma unroll
                for (int m = 0; m < 4; ++m) { const int row = row0 + ai * HALF + m * 16;
#pragma unroll
                    for (int bj = 0; bj < 2; ++bj)
                        *(PG8_GAS u32x4*)(O + (size_t)row * DM + cb + bj * HALF + cw) = pack8(sigm4(acc[ai][bj][m][0]), sigm4(acc[ai][bj][m][1])); }
        } else {
#pragma unroll
            for (int ai = 0; ai < 2; ++ai)
#pragma unroll
                for (int m = 0; m < 4; ++m) { PG8_GAS float* p = IKW + (size_t)(row0 + ai * HALF + m * 16) * 128 + cw; *(PG8_GAS f32x4*)p = acc[ai][0][m][0]; *(PG8_GAS f32x4*)(p + 4) = acc[ai][0][m][1]; }
        }
    }
};
struct EpiGateA {
    static constexpr bool PERM = true, AFTER_DRAIN = false;
    unsigned char* ws;
    __device__ __forceinline__ void operator()(const f32x4 (&acc)[2][2][4][2], const Unit& u, int wr, int wc, int fr, int fq) const {
        unsigned char* const wg = as_global(ws); const bf16_t* const SG = (const bf16_t*)(wg + WS_SGA); float* const AF = (float*)(wg + WS_XPRE);
        const int row0 = u.pm * BM + wr * 64 + fr, col0 = u.pn * BM + wc * 32 + 8 * fq;
#pragma unroll
        for (int ai = 0; ai < 2; ++ai)
#pragma unroll
            for (int m = 0; m < 4; ++m) { const size_t off = (size_t)(row0 + ai * HALF + m * 16) * DM + col0;
#pragma unroll
                for (int bj = 0; bj < 2; ++bj) { f32x4 g0, g1; unpack8(*(const u32x4*)(SG + off + bj * HALF), g0, g1);
                    float* p = AF + off + bj * HALF; *(f32x4*)p = g0 * acc[ai][bj][m][0]; *(f32x4*)(p + 4) = g1 * acc[ai][bj][m][1]; } asm volatile("" ::: "memory"); }
    }
};
struct EpiGateB {
    static constexpr bool PERM = true, AFTER_DRAIN = false;
    unsigned char* ws;
    __device__ __forceinline__ void operator()(const f32x4 (&acc)[2][2][4][2], const Unit& u, int wr, int wc, int fr, int fq) const {
        unsigned char* const wg = as_global(ws); const bf16_t* const SG = (const bf16_t*)(wg + WS_SGB); const float* const AF = (const float*)(wg + WS_XPRE); bf16_t* const MG = (bf16_t*)(wg + WS_MG);
        const int row0 = u.pm * BM + wr * 64 + fr, col0 = u.pn * BM + wc * 32 + 8 * fq;
#pragma unroll
        for (int ai = 0; ai < 2; ++ai)
#pragma unroll
            for (int m = 0; m < 4; ++m) { const size_t off = (size_t)(row0 + ai * HALF + m * 16) * DM + col0;
#pragma unroll
                for (int bj = 0; bj < 2; ++bj) { f32x4 g0, g1; unpack8(*(const u32x4*)(SG + off + bj * HALF), g0, g1);
                    const float* p = AF + off + bj * HALF; const f32x4 a0 = *(const f32x4*)p, a1 = *(const f32x4*)(p + 4);
                    *(u32x4*)(MG + off + bj * HALF) = pack8(a0 + g0 * acc[ai][bj][m][0], a1 + g1 * acc[ai][bj][m][1]); } asm volatile("" ::: "memory"); }
    }
};
struct EpiRes {
    static constexpr bool PERM = true, AFTER_DRAIN = false;
    const float* X; unsigned char* ws;
    __device__ __forceinline__ void operator()(const f32x4 (&acc)[2][2][4][2], const Unit& u, int wr, int wc, int fr, int fq) const {
        float* const XP = (float*)(as_global(ws) + WS_XPRE); const float* const Xg = as_global(X);
        const int row0 = u.pm * BM + wr * 64 + fr, col0 = u.pn * BM + wc * 32 + 8 * fq;
#pragma unroll
        for (int ai = 0; ai < 2; ++ai)
#pragma unroll
            for (int m = 0; m < 4; ++m) { const size_t off = (size_t)(row0 + ai * HALF + m * 16) * DM + col0;
#pragma unroll
                for (int bj = 0; bj < 2; ++bj) { const float* xp = Xg + off + bj * HALF; const f32x4 x0 = *(const f32x4*)xp, x1 = *(const f32x4*)(xp + 4);
                    float* p = XP + off + bj * HALF; *(f32x4*)p = x0 * ALPHA + acc[ai][bj][m][0]; *(f32x4*)(p + 4) = x1 * ALPHA + acc[ai][bj][m][1]; } asm volatile("" ::: "memory"); }
    }
};
struct EpiSwiGLU {
    static constexpr bool PERM = true, AFTER_DRAIN = false;
    unsigned char* ws;
    __device__ __forceinline__ void operator()(const f32x4 (&acc)[2][2][4][2], const Unit& u, int wr, int wc, int fr, int fq) const {
        bf16_t* const H = (bf16_t*)(as_global(ws) + WS_H);
        const int row0 = u.pm * BM + wr * 64 + fr, col0 = u.pn * HALF + wc * 32 + 8 * fq;
#pragma unroll
        for (int ai = 0; ai < 2; ++ai)
#pragma unroll
            for (int m = 0; m < 4; ++m)
                *(u32x4*)(H + (size_t)(row0 + ai * HALF + m * 16) * DFF + col0) = pack8(silu4(acc[ai][0][m][0]) * acc[ai][1][m][0], silu4(acc[ai][0][m][1]) * acc[ai][1][m][1]);
    }
};
struct EpiF32P {
    static constexpr bool PERM = true, AFTER_DRAIN = false;
    unsigned char* ws;
    __device__ __forceinline__ void operator()(const f32x4 (&acc)[2][2][4][2], const Unit& u, int wr, int wc, int fr, int fq) const {
        float* const C = (float*)(as_global(ws) + WS_PP);
        const int row0 = u.pm * BM + wr * 64 + fr, col0 = u.pn * BM + wc * 32 + 8 * fq;
#pragma unroll
        for (int ai = 0; ai < 2; ++ai)
#pragma unroll
            for (int m = 0; m < 4; ++m) { const size_t off = (size_t)(row0 + ai * HALF + m * 16) * DM + col0;
#pragma unroll
                for (int bj = 0; bj < 2; ++bj) { float* p = C + off + bj * HALF; *(f32x4*)p = acc[ai][bj][m][0]; *(f32x4*)(p + 4) = acc[ai][bj][m][1]; } }
    }
};
struct EpiPle {
    static constexpr bool PERM = true, AFTER_DRAIN = false;
    unsigned char* ws;
    __device__ __forceinline__ void operator()(const f32x4 (&acc)[2][2][4][2], const Unit& u, int wr, int wc, int fr, int fq) const {
        const float* const X = (const float*)(ws + WS_X32); const float* const PP = (const float*)(ws + WS_PP); float* const XP = (float*)(as_global(ws) + WS_XPRE); const float* const Xg = as_global(X);
        const int row0 = u.pm * BM + wr * 64 + fr, col0 = u.pn * BM + wc * 32 + 8 * fq;
#pragma unroll
        for (int ai = 0; ai < 2; ++ai)
#pragma unroll
            for (int m = 0; m < 4; ++m) { const size_t off = (size_t)(row0 + ai * HALF + m * 16) * DM + col0;
#pragma unroll
                for (int bj = 0; bj < 2; ++bj) { const float* xp = Xg + off + bj * HALF; const f32x4 x0 = *(const f32x4*)xp, x1 = *(const f32x4*)(xp + 4);
                    const float* pp = PP + off + bj * HALF; const f32x4 p0 = *(const f32x4*)pp, p1 = *(const f32x4*)(pp + 4);
                    float* p = XP + off + bj * HALF; *(f32x4*)p = x0 * ALPHA + sigm4(acc[ai][bj][m][0]) * p0; *(f32x4*)(p + 4) = x1 * ALPHA + sigm4(acc[ai][bj][m][1]) * p1; } asm volatile("" ::: "memory"); }
    }
};

struct EpiRawTest {
    static constexpr bool PERM = true, AFTER_DRAIN = false;
    unsigned char* ws;
    __device__ __forceinline__ void operator()(const f32x4 (&acc)[2][2][4][2], const Unit& u, int wr, int wc, int fr, int fq) const {
        bf16_t* const H = (bf16_t*)(as_global(ws) + WS_H);
        const int row0 = u.pm * BM + wr * 64 + fr, col0 = u.pn * HALF + wc * 32 + 8 * fq;
#pragma unroll
        for (int ai = 0; ai < 2; ++ai)
#pragma unroll
            for (int m = 0; m < 4; ++m)
                *(u32x4*)(H + (size_t)(row0 + ai * HALF + m * 16) * 6272 + col0) = pack8(acc[ai][0][m][0] + acc[ai][1][m][0], acc[ai][0][m][1] + acc[ai][1][m][1]);
    }
};
template <class Epi, class Sched, bool ALIGN_EPI = false, bool SP2 = false>
__device__ __forceinline__ void gemm_phase(PG8_LAS unsigned char* lds, const Gemm g, const Sched& S, const Epi& E) {
    const int tid = tid_(), wid = __builtin_amdgcn_readfirstlane(tid >> 6), lane = tid & 63, wr = wid >> 2, wc = wid & 3, fr = lane & 15, fq = lane >> 4;
    int Kq = g.K; asm volatile("" : "+s"(Kq)); const int K = Kq, nt = K / BK;
    unsigned voffA[2], voffB[2];
#pragma unroll
    for (int i = 0; i < 2; ++i) { int R, C; stage_rc(tid * 16 + i * 8192, R, C); const int Rb = Epi::PERM ? ((R & ~31) + perm32(R & 31)) : R;
        voffA[i] = (unsigned)(R * K + C) * 2u; voffB[i] = (unsigned)(Rb * K + C) * 2u; }
    const size_t kstep = (size_t)(BK * 2);
    const size_t hstep = (size_t)HALF * K * 2;
    const size_t tstep = 2 * hstep;
    const unsigned ldsw = (unsigned)wid * 1024u;
    const int aoff = lds_byte(wr * 64 + fr, fq * 8), boff = lds_byte(wc * 32 + fr, fq * 8);
#define PG8_SA(b, h) (((b) * 2 + (h)) * HTB)
#define PG8_SB(b, h) ((4 + (b) * 2 + (h)) * HTB)
#define PG8_STAGE(bufoff, gbase, voff) do { _Pragma("unroll") for (int _i = 0; _i < 2; ++_i) \
        __builtin_amdgcn_global_load_lds((const unsigned*)((const char*)(gbase) + (voff)[_i]), (PG8_LAS unsigned*)(lds + (bufoff) + ldsw + _i * 8192), 16, 0, 0); } while (0)
#define PG8_LDA(dst, b, h) do { _Pragma("unroll") for (int m = 0; m < 4; ++m) _Pragma("unroll") for (int k = 0; k < 2; ++k) dst[m][k] = *(const PG8_LAS bf16x8*)(lds + PG8_SA(b, h) + aoff + m * 2048 + k * 1024); } while (0)
#define PG8_LDB(dst, b, h) do { _Pragma("unroll") for (int n = 0; n < 2; ++n) _Pragma("unroll") for (int k = 0; k < 2; ++k) dst[n][k] = *(const PG8_LAS bf16x8*)(lds + PG8_SB(b, h) + boff + n * 2048 + k * 1024); } while (0)
#define PG8_MMA(ai, bj, At, Bt) do { __builtin_amdgcn_s_setprio(1); _Pragma("unroll") for (int m = 0; m < 4; ++m) _Pragma("unroll") for (int n = 0; n < 2; ++n) _Pragma("unroll") for (int k = 0; k < 2; ++k) \
        acc[ai][bj][m][n] = __builtin_amdgcn_mfma_f32_16x16x32_bf16(Bt[n][k], At[m][k], acc[ai][bj][m][n], 0, 0, 0); __builtin_amdgcn_s_setprio(0); } while (0)
#define PG8_WAIT_V(n) asm volatile("s_waitcnt vmcnt(" #n ")" ::: "memory")
#define PG8_WAIT_L(n) asm volatile("s_waitcnt lgkmcnt(" #n ")" ::: "memory")
#define PG8_BAR __builtin_amdgcn_s_barrier()
#define PG8_SCHED __builtin_amdgcn_sched_barrier(0)
    Unit cur, nxt; int ui = 0;
    if (!S.next(0, cur)) return;
    f32x4 acc[2][2][4][2];
#pragma unroll
    for (int a = 0; a < 2; ++a)
#pragma unroll
        for (int b = 0; b < 2; ++b)
#pragma unroll
            for (int m = 0; m < 4; ++m)
#pragma unroll
                for (int n = 0; n < 2; ++n) acc[a][b][m][n] = (f32x4){0.f, 0.f, 0.f, 0.f};
    bf16x8 At[4][2], B0[2][2], B1[2][2];
    const char* cA = (const char*)g.A + (size_t)cur.pm * tstep; const char* cB = (const char*)g.Bt + (size_t)cur.pn * tstep;
    S.a_ready(cur);
    if constexpr (SP2) {
        PG8_STAGE(PG8_SB(0, 0), cB, voffB); PG8_STAGE(PG8_SB(0, 1), cB + hstep, voffB); PG8_STAGE(PG8_SA(0, 0), cA, voffA); PG8_STAGE(PG8_SA(0, 1), cA + hstep, voffA);
        if (wr == 1) PG8_BAR;
        PG8_WAIT_V(2); PG8_BAR;
        PG8_STAGE(PG8_SB(1, 0), cB + kstep, voffB); PG8_STAGE(PG8_SA(1, 0), cA + kstep, voffA); PG8_STAGE(PG8_SB(1, 1), cB + hstep + kstep, voffB);
        PG8_WAIT_V(6); PG8_BAR;
    } else {
        PG8_STAGE(PG8_SB(0, 0), cB, voffB); PG8_STAGE(PG8_SA(0, 0), cA, voffA); PG8_STAGE(PG8_SB(0, 1), cB + hstep, voffB); PG8_STAGE(PG8_SA(0, 1), cA + hstep, voffA);
        if (wr == 1) PG8_BAR;
        PG8_WAIT_V(4); PG8_BAR;
        PG8_STAGE(PG8_SB(1, 0), cB + kstep, voffB); PG8_STAGE(PG8_SA(1, 0), cA + kstep, voffA); PG8_STAGE(PG8_SB(1, 1), cB + hstep + kstep, voffB);
        PG8_WAIT_V(6); PG8_BAR;
    }
    for (;;) {
        const bool has_next = S.next(ui + 1, nxt);
        const char* nA = has_next ? (const char*)g.A + (size_t)nxt.pm * tstep : cA; const char* nB = has_next ? (const char*)g.Bt + (size_t)nxt.pn * tstep : cB;
        for (int t = 0; t < nt; t += 2) {
            const bool last = (t == nt - 2);
            const char* a1 = cA + (size_t)(t + 1) * kstep;
            const char* a2 = last ? nA : cA + (size_t)(t + 2) * kstep; const char* b2 = last ? nB : cB + (size_t)(t + 2) * kstep;
            const char* a3 = a2 + kstep; const char* b3 = b2 + kstep;
            if (last && has_next) S.a_ready(nxt);
            if constexpr (SP2) {
            PG8_LDB(B0, 0, 0); PG8_LDB(B1, 0, 1); PG8_SCHED; PG8_LDA(At, 0, 0); PG8_STAGE(PG8_SA(1, 1), a1 + hstep, voffA);
            PG8_WAIT_V(8); PG8_WAIT_L(0); PG8_BAR; PG8_MMA(0, 0, At, B0); PG8_MMA(0, 1, At, B1); PG8_BAR; PG8_SCHED;
            PG8_LDA(At, 0, 1); PG8_STAGE(PG8_SB(0, 0), b2, voffB); PG8_STAGE(PG8_SB(0, 1), b2 + hstep, voffB); PG8_STAGE(PG8_SA(0, 0), a2, voffA);
            PG8_WAIT_V(8); PG8_WAIT_L(0); PG8_BAR; PG8_MMA(1, 0, At, B0); PG8_MMA(1, 1, At, B1); PG8_BAR; PG8_SCHED;
            PG8_LDB(B0, 1, 0); PG8_LDB(B1, 1, 1); PG8_SCHED; PG8_LDA(At, 1, 0); PG8_STAGE(PG8_SA(0, 1), a2 + hstep, voffA);
            PG8_WAIT_V(8); PG8_WAIT_L(0); PG8_BAR; PG8_MMA(0, 0, At, B0); PG8_MMA(0, 1, At, B1); PG8_BAR; PG8_SCHED;
            PG8_LDA(At, 1, 1); PG8_STAGE(PG8_SB(1, 0), b3, voffB); PG8_STAGE(PG8_SB(1, 1), b3 + hstep, voffB); PG8_STAGE(PG8_SA(1, 0), a3, voffA);
            PG8_WAIT_V(8); PG8_WAIT_L(0); PG8_BAR; PG8_MMA(1, 0, At, B0); PG8_MMA(1, 1, At, B1); PG8_BAR; PG8_SCHED;
            } else {
            PG8_LDB(B0, 0, 0); PG8_SCHED; PG8_LDA(At, 0, 0); PG8_STAGE(PG8_SA(1, 1), a1 + hstep, voffA);
            PG8_WAIT_L(8); PG8_BAR; PG8_WAIT_L(0); PG8_MMA(0, 0, At, B0); PG8_BAR; PG8_SCHED;
            PG8_LDB(B1, 0, 1); PG8_STAGE(PG8_SB(0, 0), b2, voffB);
            PG8_BAR; PG8_WAIT_L(0); PG8_MMA(0, 1, At, B1); PG8_BAR;
            PG8_LDA(At, 0, 1); PG8_STAGE(PG8_SA(0, 0), a2, voffA);
            PG8_BAR; PG8_WAIT_L(0); PG8_MMA(1, 0, At, B0); PG8_BAR; PG8_SCHED;
            PG8_STAGE(PG8_SB(0, 1), b2 + hstep, voffB);
            PG8_WAIT_V(6); PG8_BAR; PG8_MMA(1, 1, At, B1); PG8_BAR;
            PG8_LDB(B0, 1, 0); PG8_SCHED; PG8_LDA(At, 1, 0); PG8_STAGE(PG8_SA(0, 1), a2 + hstep, voffA);
            PG8_WAIT_L(8); PG8_BAR; PG8_WAIT_L(0); PG8_MMA(0, 0, At, B0); PG8_BAR; PG8_SCHED;
            PG8_LDB(B1, 1, 1); PG8_STAGE(PG8_SB(1, 0), b3, voffB);
            PG8_BAR; PG8_WAIT_L(0); PG8_MMA(0, 1, At, B1); PG8_BAR;
            PG8_LDA(At, 1, 1); PG8_STAGE(PG8_SA(1, 0), a3, voffA);
            PG8_BAR; PG8_WAIT_L(0); PG8_MMA(1, 0, At, B0); PG8_BAR; PG8_SCHED;
            PG8_STAGE(PG8_SB(1, 1), b3 + hstep, voffB);
            PG8_WAIT_V(6); PG8_BAR; PG8_MMA(1, 1, At, B1); PG8_BAR;
            }
        }
        if constexpr (ALIGN_EPI) { if (wr == 0) PG8_BAR; }
        if constexpr (!Epi::AFTER_DRAIN) { E(acc, cur, wr, wc, fr, fq); S.done(cur); }
        if (!has_next) break;
#pragma unroll
        for (int a = 0; a < 2; ++a)
#pragma unroll
            for (int b = 0; b < 2; ++b)
#pragma unroll
                for (int m = 0; m < 4; ++m)
#pragma unroll
                    for (int n = 0; n < 2; ++n) acc[a][b][m][n] = (f32x4){0.f, 0.f, 0.f, 0.f};
        cur = nxt; cA = nA; cB = nB; ++ui;
        if constexpr (ALIGN_EPI) { if (wr == 1) PG8_BAR; }
    }
    PG8_WAIT_V(0);
    if constexpr (!ALIGN_EPI) { if (wr == 0) PG8_BAR; }
    PG8_BAR;
    if constexpr (Epi::AFTER_DRAIN) { E.fused(acc, cur, wr, wc, fr, fq, lds, wid, lane); S.done(cur); }
#undef PG8_SA
#undef PG8_SB
#undef PG8_STAGE
#undef PG8_LDA
#undef PG8_LDB
#undef PG8_MMA
#undef PG8_WAIT_V
#undef PG8_WAIT_L
#undef PG8_BAR
#undef PG8_SCHED
}
}
#define XB_TMO      128
#define XB_XCNT(j)  (256  + 64 * (j))
#define XB_XSUB(j)  (1280 + 64 * (j))
#define XB_XGEN(j)  (2304 + 64 * (j))
#define XB_TOP      3328
#define XB_TOPGEN   3392
#define XCD_BAR_WORDS 3456
#define XB_SPIN_CAP (1u << 18)
#define LAS __attribute__((address_space(3)))

__device__ __forceinline__ unsigned xb_ld(unsigned* p)              { return __hip_atomic_load(p, __ATOMIC_RELAXED, __HIP_MEMORY_SCOPE_AGENT); }
__device__ __forceinline__ unsigned xb_add(unsigned* p, unsigned v) { return __hip_atomic_fetch_add(p, v, __ATOMIC_RELAXED, __HIP_MEMORY_SCOPE_AGENT); }
__device__ __forceinline__ unsigned xb_xcc_id() { return (unsigned)__builtin_amdgcn_s_getreg((3 << 11) | 20) & 0xFu; }
#define XB_SPIN(cond, bar) do { unsigned _sp = 0; while (cond) { __builtin_amdgcn_s_sleep(1); \
    if ((++_sp & 255u) == 0u) { if (xb_ld(&(bar)[XB_TMO])) break; if (_sp > XB_SPIN_CAP) { atomicAdd(&(bar)[XB_TMO], 1u); break; } } } } while (0)

struct XcdBarrier {
    unsigned* bar; unsigned x;
    volatile LAS unsigned* st;
};

__device__ __forceinline__ XcdBarrier xcd_barrier_post(unsigned* bar, volatile LAS unsigned* st) {
    XcdBarrier b; b.bar = bar; b.x = xb_xcc_id(); b.st = st;
    if (threadIdx.x == 0) (void)xb_add(&bar[XB_XCNT(b.x)], 1u);
    return b;
}
__device__ __forceinline__ void xcd_barrier_complete(unsigned* bar, unsigned x, unsigned& nloc, unsigned& nx) {
    const unsigned G = gridDim.x * gridDim.y * gridDim.z;
    unsigned sum, cnt, mine, sp = 0u;
    for (;;) {
        sum = 0u; cnt = 0u; mine = 0u;
#pragma unroll
        for (unsigned j = 0; j < 16; ++j) { const unsigned c = xb_ld(&bar[XB_XCNT(j)]); sum += c; cnt += (c > 0u) ? 1u : 0u; mine = (j == x) ? c : mine; }
        if (sum == G) break;
        __builtin_amdgcn_s_sleep(1);
        if ((++sp & 255u) == 0u) { if (xb_ld(&bar[XB_TMO])) break; if (sp > XB_SPIN_CAP) { atomicAdd(&bar[XB_TMO], 1u); break; } }
    }
    nloc = mine > 0u ? mine : 1u; nx = cnt > 0u ? cnt : 1u;
}

__device__ __forceinline__ void xcd_barrier(const XcdBarrier& b) {
    asm volatile("s_waitcnt vmcnt(0)" ::: "memory");
    __syncthreads();
    if (threadIdx.x == 0) {
        unsigned* bar = b.bar;
        __builtin_amdgcn_s_waitcnt(0);
        const unsigned bx = xb_xcc_id();
        unsigned nloc = b.st[0], nx = b.st[1];
        if (nloc == 0u) { xcd_barrier_complete(bar, bx, nloc, nx); b.st[0] = nloc; b.st[1] = nx; }
        const unsigned old = xb_add(&bar[XB_XSUB(bx)], 1u);
        const unsigned gen = old / nloc;
        if (old + 1u == (gen + 1u) * nloc) {
            __builtin_amdgcn_fence(__ATOMIC_RELEASE, "agent");
            asm volatile("s_waitcnt vmcnt(0)" ::: "memory");
            const unsigned og = xb_add(&bar[XB_TOP], 1u);
            const unsigned tg = og / nx;
            if (og + 1u == (tg + 1u) * nx) xb_add(&bar[XB_TOPGEN], 1u);
            else XB_SPIN(xb_ld(&bar[XB_TOPGEN]) == tg, bar);
            __builtin_amdgcn_fence(__ATOMIC_ACQUIRE, "agent");
            xb_add(&bar[XB_XGEN(bx)], 1u);
            asm volatile("s_waitcnt vmcnt(0)" ::: "memory");
        } else {
            XB_SPIN(xb_ld(&bar[XB_XGEN(bx)]) == gen, bar);
            __builtin_amdgcn_fence(__ATOMIC_ACQUIRE, "agent");
            asm volatile("s_waitcnt vmcnt(0)" ::: "memory");
        }
    }
    __syncthreads();
}

struct Params {
    const float* x; const float* p; const int* pos;
    const float *w_in, *w_a, *w_b, *w_out, *lbraw, *hnorm_g, *ikn_g, *ikn_b, *lnm_g, *lnm_b, *w_fg, *w_fu, *w_fd, *lnf_g, *lnf_b, *w_pg, *w_pp, *lnp_g, *lnp_b;
    float* out; unsigned char* ws;
    double invf_h[64]; double invf_i[32];
    int ph_lo, ph_hi;
};
typedef const __attribute__((address_space(4))) Params* KP;
__device__ __forceinline__ KP kparams() { KP p = (KP)__builtin_amdgcn_kernarg_segment_ptr(); asm volatile("" : "+s"(p)); return p; }
constexpr int NPH_LAYER = 14, NPH = DEPTH * NPH_LAYER;
constexpr int LDS_BYTES = 131072 + 1024;
constexpr int MISC_OFF = 131072;

__device__ __forceinline__ int wsrc_col_in(int n) {
    const int tile = n >> 8, t = n & 255;
    if (tile < 16) return n;
    if (tile < 24) { const int bj = t >> 7, u = t & 127, head = u >> 6, i = u & 63; return tile * 256 + 128 * head + 64 * bj + i; }
    if (tile < 28) return n;
    if (tile < 32) { const int bj = t >> 7, u = t & 127, head = u >> 5, i = u & 31; return tile * 256 + 64 * head + 32 * bj + i; }
    if (tile < 40) return 8272 + (n - 32 * 256);
    if (tile < 48) return 10320 + (n - 40 * 256);
    return t < 80 ? 8192 + t : -1;
}
template <int KIND>
__device__ __forceinline__ void wconv_tile(const float* src, const float* src2, int nsrc, int K, bf16_t* dst, int n0, int k0, LAS float* tile) {
    const int tid = tid_(), nn = tid & 31, kk0 = tid >> 5;
    int c; const float* s = src;
    if (KIND == 0) c = n0 + nn;
    else if (KIND == 1) c = wsrc_col_in(n0 + nn);
    else { const int n = n0 + nn, tl = n >> 8, t = n & 255; c = tl * 128 + (t & 127); if (t >= 128) s = src2; }
#pragma unroll
    for (int r = 0; r < 8; ++r) { const int kk = kk0 + 16 * r; tile[kk * 33 + nn] = (c >= 0) ? s[(size_t)(k0 + kk) * nsrc + c] : 0.f; }
    __syncthreads();
    const int n = tid >> 4, k8 = (tid & 15) * 8;
    pg8::f32x4 a, b;
#pragma unroll
    for (int j = 0; j < 4; ++j) { a[j] = tile[(k8 + j) * 33 + n]; b[j] = tile[(k8 + 4 + j) * 33 + n]; }
    *(pg8::u32x4*)(dst + (size_t)(n0 + n) * K + k0 + k8) = pg8::pack8(a, b);
    __syncthreads();
}
template <int KIND>
__device__ __forceinline__ void wconv_job(const float* src, const float* src2, int nsrc, int K, bf16_t* dst, int ndst, LAS float* tile, int& tcount) {
    const int kt = K / 128, ntiles = (ndst / 32) * kt;
    const int G = nblk_(); int first = (bid_() - tcount % G + G) % G;
    for (int t = first; t < ntiles; t += G) wconv_tile<KIND>(src, src2, nsrc, K, dst, (t / kt) * 32, (t % kt) * 128, tile);
    tcount += ntiles;
}
__device__ __forceinline__ void phase_wconv(KP P, int layer, LAS float* tile) {
    unsigned char* ws = as_global(P->ws); int tc = 0;
    wconv_job<1>(as_global(P->w_in) + (size_t)layer * DM * INW, nullptr, INW, DM, (bf16_t*)(ws + WS_WIN), INP, tile, tc);
    wconv_job<0>(as_global(P->w_a) + (size_t)layer * AW * DM, nullptr, DM, AW, (bf16_t*)(ws + WS_WA), DM, tile, tc);
    wconv_job<0>(as_global(P->w_b) + (size_t)layer * BW * DM, nullptr, DM, BW, (bf16_t*)(ws + WS_WB), DM, tile, tc);
    wconv_job<0>(as_global(P->w_out) + (size_t)layer * DM * DM, nullptr, DM, DM, (bf16_t*)(ws + WS_WO), DM, tile, tc);
    wconv_job<2>(as_global(P->w_fg) + (size_t)layer * DM * DFF, as_global(P->w_fu) + (size_t)layer * DM * DFF, DFF, DM, (bf16_t*)(ws + WS_WGU), 2 * DFF, tile, tc);
    wconv_job<0>(as_global(P->w_fd) + (size_t)layer * DFF * DM, nullptr, DM, DFF, (bf16_t*)(ws + WS_WDN), DM, tile, tc);
    wconv_job<0>(as_global(P->w_pg) + (size_t)layer * DM * DM, nullptr, DM, DM, (bf16_t*)(ws + WS_WPG), DM, tile, tc);
    wconv_job<0>(as_global(P->w_pp) + (size_t)layer * PLE * DM, nullptr, DM, PLE, (bf16_t*)(ws + WS_WPP), DM, tile, tc);
    const float* ps = as_global(P->p) + (size_t)layer * TOK * PLE; bf16_t* pb = (bf16_t*)(ws + WS_PB);
    for (size_t i = ((size_t)bid_() * 512 + tid_()) * 8; i < (size_t)TOK * PLE; i += (size_t)nblk_() * 512 * 8)
        *(pg8::u32x4*)(pb + i) = pg8::pack8(*(const pg8::f32x4*)(ps + i), *(const pg8::f32x4*)(ps + i + 4));
}
__device__ __forceinline__ void phase_prologue(KP P) {
    unsigned char* ws = as_global(P->ws); const size_t gtid = (size_t)bid_() * 512 + tid_(), gsz = (size_t)nblk_() * 512;
    bf16_t* xb = (bf16_t*)(ws + WS_XB); const float* xin = as_global(P->x); const int* posg = as_global(P->pos); const float* lbr = as_global(P->lbraw);
    for (size_t i = gtid * 8; i < (size_t)TOK * DM; i += gsz * 8) *(pg8::u32x4*)(xb + i) = pg8::pack8(*(const pg8::f32x4*)(xin + i), *(const pg8::f32x4*)(xin + i + 4));
    float* ch = (float*)(ws + WS_COSH); float* sh = (float*)(ws + WS_SINH); float* ci = (float*)(ws + WS_COSI); float* si = (float*)(ws + WS_SINI);
    for (size_t i = gtid; i < (size_t)TOK * 64; i += gsz) { const int t = (int)(i >> 6), j = (int)(i & 63); const double rev = (double)posg[t] * P->invf_h[j]; const float fr = (float)(rev - rint(rev));
        ch[i] = __builtin_amdgcn_cosf(fr); sh[i] = __builtin_amdgcn_sinf(fr); }
    for (size_t i = gtid; i < (size_t)TOK * 32; i += gsz) { const int t = (int)(i >> 5), j = (int)(i & 31); const double rev = (double)posg[t] * P->invf_i[j]; const float fr = (float)(rev - rint(rev));
        ci[i] = __builtin_amdgcn_cosf(fr); si[i] = __builtin_amdgcn_sinf(fr); }
    float* lb = (float*)(ws + WS_LB);
    for (size_t c = gtid; c < 1024; c += gsz) { float v[4], mx = -1e30f; for (int l = 0; l < 4; ++l) { v[l] = lbr[l * 1024 + c]; mx = fmaxf(mx, v[l]); }
        float s = 0.f; for (int l = 0; l < 4; ++l) { v[l] = expf(v[l] - mx); s += v[l]; }
        float cum = 0.f; const float inv = 1.0f / s; for (int l = 0; l < 4; ++l) { cum += v[l] * inv; lb[l * 1024 + c] = cum - v[0] * inv; } }
}
__device__ __forceinline__ void phase_ln(const float* XP, float* X32, bf16_t* XB, const float* g, const float* b) {
    const int tid = tid_(), wave = tid >> 6, lane = tid & 63, nb8 = nblk_() * 8;
    for (int row = bid_() * 8 + wave; row < TOK; row += nb8) {
        const float* xp = XP + (size_t)row * DM; pg8::f32x4 v[8]; float s = 0.f;
#pragma unroll
        for (int c = 0; c < 8; ++c) { v[c] = *(const pg8::f32x4*)(xp + c * 256 + lane * 4); s += (v[c][0] + v[c][1]) + (v[c][2] + v[c][3]); }
#pragma unroll
        for (int o = 32; o >= 1; o >>= 1) s += __shfl_xor(s, o);
        const float mean = s * (1.0f / DM); float q = 0.f;
#pragma unroll
        for (int c = 0; c < 8; ++c) { v[c] = v[c] - mean; q += (v[c][0] * v[c][0] + v[c][1] * v[c][1]) + (v[c][2] * v[c][2] + v[c][3] * v[c][3]); }
#pragma unroll
        for (int o = 32; o >= 1; o >>= 1) q += __shfl_xor(q, o);
        const float rstd = 1.0f / sqrtf(q * (1.0f / DM) + LN_EPS);
#pragma unroll
        for (int c = 0; c < 8; ++c) { const int col = c * 256 + lane * 4; const pg8::f32x4 gg = *(const pg8::f32x4*)(g + col), bb = *(const pg8::f32x4*)(b + col);
            const pg8::f32x4 y = v[c] * rstd * gg + bb; *(pg8::f32x4*)(X32 + (size_t)row * DM + col) = y;
            pg8::u32x2 w; w.x = pg8::cvt_pk_bf16(y[0], y[1]); w.y = pg8::cvt_pk_bf16(y[2], y[3]); *(pg8::u32x2*)(XB + (size_t)row * DM + col) = w; }
    }
}
__device__ __forceinline__ void phase_ikprep(KP P, int layer) {
    unsigned char* ws = as_global(P->ws); const float* ikw = (const float*)(ws + WS_IKW); bf16_t* ki = (bf16_t*)(ws + WS_KI); float* wi = (float*)(ws + WS_WI);
    const float* ci = (const float*)(ws + WS_COSI); const float* si = (const float*)(ws + WS_SINI);
    const int tid = tid_(), wave = tid >> 6, lane = tid & 63, nb8 = nblk_() * 8;
    const float g = as_global(P->ikn_g)[layer * 64 + lane], b = as_global(P->ikn_b)[layer * 64 + lane];
    for (int t = bid_() * 8 + wave; t < TOK; t += nb8) {
        const float x = ikw[(size_t)t * 128 + lane]; float s = x;
#pragma unroll
        for (int o = 32; o >= 1; o >>= 1) s += __shfl_xor(s, o);
        const float mean = s * (1.0f / 64.0f), xc = x - mean; float q = xc * xc;
#pragma unroll
        for (int o = 32; o >= 1; o >>= 1) q += __shfl_xor(q, o);
        const float y = xc * (1.0f / sqrtf(q * (1.0f / 64.0f) + LN_EPS)) * g + b;
        const float other = __shfl_xor(y, 32); const int j = lane & 31; const float c = ci[(size_t)t * 32 + j], sn = si[(size_t)t * 32 + j];
        const float r = (lane < 32) ? (y * c - other * sn) : (other * sn + y * c);
        ki[(size_t)t * 64 + lane] = f2bf(r);
        if (lane < 16) wi[(size_t)t * 16 + lane] = ikw[(size_t)t * 128 + 64 + lane] * IDX_SCALE;
    }
}
typedef short bf16x8_t __attribute__((ext_vector_type(8)));
typedef short bf16x4_t __attribute__((ext_vector_type(4)));
typedef float f32x16_t __attribute__((ext_vector_type(16)));
constexpr int CUM_LD = 132;
constexpr int OPK_LD = 136;
constexpr int OPS_LD = 72;

__device__ __forceinline__ void hgrn_scan_cum(const float* LF, int tok0, int h, LAS float* cum, LAS float* tot, int tid) {
    const int k = tid & 127, qd = tid >> 7; float v[16];
#pragma unroll
    for (int i = 0; i < 16; ++i) v[i] = LF[(size_t)(tok0 + qd * 16 + i) * 1024 + h * 128 + k];
    float run = 0.f;
#pragma unroll
    for (int i = 0; i < 16; ++i) { run += v[i]; v[i] = run; }
    tot[qd * 128 + k] = run;
    __syncthreads();
    float off = 0.f;
#pragma unroll
    for (int q = 0; q < 3; ++q) off += (q < qd) ? tot[q * 128 + k] : 0.f;
#pragma unroll
    for (int i = 0; i < 16; ++i) cum[(qd * 16 + i) * CUM_LD + k] = v[i] + off;
    __syncthreads();
}

__device__ __forceinline__ void phase_hgrn_h1(KP P, LAS unsigned char* lds) {
    unsigned char* ws = as_global(P->ws);
    const bf16_t* KA = (const bf16_t*)(ws + WS_KA); const bf16_t* VA = (const bf16_t*)(ws + WS_VA); const float* LF = (const float*)(ws + WS_LF);
    float* LT = (float*)(ws + WS_LT); float* DEC = (float*)(ws + WS_DEC);
    const int tid = tid_(), lane = tid & 63, wave = tid >> 6, r = lane & 31, hh = lane >> 5, G = nblk_();
    LAS float* cum = (LAS float*)lds; LAS float* tot = cum + 64 * CUM_LD;
    LAS bf16_t* kdT = (LAS bf16_t*)(tot + 512); LAS bf16_t* vT = kdT + 128 * OPS_LD;
    for (int unit = bid_(); unit < NBATCH * AH * 64; unit += G) {
        const int c = unit & 63, h = (unit >> 6) & 7, b = unit >> 9, tok0 = b * SEQ + c * 64;
        hgrn_scan_cum(LF, tok0, h, cum, tot, tid);
#pragma unroll
        for (int it = 0; it < 8; ++it) { const int idx = tid + 512 * it, k = idx & 127, sp = idx >> 7, s = 2 * sp;
            const float last = cum[63 * CUM_LD + k];
            const size_t g0 = (size_t)(tok0 + s) * 1024 + h * 128 + k;
            const float k0 = bf2f(KA[g0]) * __expf(last - cum[s * CUM_LD + k]), k1 = bf2f(KA[g0 + 1024]) * __expf(last - cum[(s + 1) * CUM_LD + k]);
            *(LAS unsigned*)(kdT + k * OPS_LD + s) = pg8::cvt_pk_bf16(k0, k1);
            *(LAS unsigned*)(vT + k * OPS_LD + s) = (unsigned)VA[g0] | ((unsigned)VA[g0 + 1024] << 16); }
        if (tid < 128) DEC[(size_t)unit * 128 + tid] = __expf(cum[63 * CUM_LD + tid]);
        __syncthreads();
        const int mb = wave >> 1, nb0 = (wave & 1) * 2;
        f32x16_t acc[2];
#pragma unroll
        for (int n = 0; n < 2; ++n)
#pragma unroll
            for (int i = 0; i < 16; ++i) acc[n][i] = 0.f;
#pragma unroll
        for (int ks = 0; ks < 4; ++ks) { const bf16x8_t a = *(const LAS bf16x8_t*)(kdT + (32 * mb + r) * OPS_LD + 16 * ks + 8 * hh);
#pragma unroll
            for (int n = 0; n < 2; ++n) { const bf16x8_t bb = *(const LAS bf16x8_t*)(vT + (32 * (nb0 + n) + r) * OPS_LD + 16 * ks + 8 * hh);
                acc[n] = __builtin_amdgcn_mfma_f32_32x32x16_bf16(a, bb, acc[n], 0, 0, 0); } }
#pragma unroll
        for (int n = 0; n < 2; ++n) { float* dst = LT + (size_t)unit * 16384 + (size_t)(32 * (nb0 + n) + r) * 128 + 32 * mb + 4 * hh;
#pragma unroll
            for (int g = 0; g < 4; ++g) { pg8::f32x4 o; o[0] = acc[n][4 * g]; o[1] = acc[n][4 * g + 1]; o[2] = acc[n][4 * g + 2]; o[3] = acc[n][4 * g + 3]; *(pg8::f32x4*)(dst + 8 * g) = o; } }
        __syncthreads();
    }
}

__device__ __forceinline__ void phase_hgrn_h2(KP P) {
    unsigned char* ws = as_global(P->ws);
    const float* LT = (const float*)(ws + WS_LT); const float* DEC = (const float*)(ws + WS_DEC); bf16_t* PT = (bf16_t*)(ws + WS_PT);
    const int tid = tid_(), G = nblk_();
    for (int quad = bid_() * 512 + tid; quad < NBATCH * AH * 4096; quad += G * 512) {
        const int bh = quad >> 12, rem = quad & 4095, v = rem >> 5, k0 = (rem & 31) * 4;
        const size_t e0 = (size_t)bh * 64 * 16384 + (size_t)v * 128 + k0; const size_t d0 = (size_t)bh * 64 * 128 + k0;
        pg8::f32x4 S = {0.f, 0.f, 0.f, 0.f};
        for (int c0 = 0; c0 < 64; c0 += 8) { pg8::f32x4 Lc[8], Dc[8];
#pragma unroll
            for (int j = 0; j < 8; ++j) { Lc[j] = *(const pg8::f32x4*)(LT + e0 + (size_t)(c0 + j) * 16384); Dc[j] = *(const pg8::f32x4*)(DEC + d0 + (size_t)(c0 + j) * 128); }
#pragma unroll
            for (int j = 0; j < 8; ++j) { pg8::u32x2 w; w.x = pg8::cvt_pk_bf16(S[0], S[1]); w.y = pg8::cvt_pk_bf16(S[2], S[3]);
                *(pg8::u32x2*)(PT + e0 + (size_t)(c0 + j) * 16384) = w; S = Dc[j] * S + Lc[j]; } }
    }
}

__device__ __forceinline__ void phase_hgrn_h3(KP P, int layer, LAS unsigned char* lds) {
    unsigned char* ws = as_global(P->ws);
    const bf16_t* QA = (const bf16_t*)(ws + WS_QA); const bf16_t* KA = (const bf16_t*)(ws + WS_KA); const bf16_t* VA = (const bf16_t*)(ws + WS_VA); const bf16_t* GA = (const bf16_t*)(ws + WS_GA);
    const float* LF = (const float*)(ws + WS_LF); const bf16_t* PT = (const bf16_t*)(ws + WS_PT); bf16_t* YA = (bf16_t*)(ws + WS_YA);
    const float* ng = as_global(P->hnorm_g) + layer * 128;
    const int tid = tid_(), lane = tid & 63, wave = tid >> 6, r = lane & 31, hh = lane >> 5, G = nblk_();
    LAS float* cum = (LAS float*)lds; LAS float* tot = cum + 64 * CUM_LD; LAS float* ssq = tot + 512;
    LAS bf16_t* qd = (LAS bf16_t*)(ssq + 256); LAS bf16_t* qs = qd + 64 * OPK_LD; LAS bf16_t* ks = qs + 64 * OPK_LD; LAS bf16_t* vT = ks + 64 * OPK_LD;
    for (int unit = bid_(); unit < NBATCH * AH * 64; unit += G) {
        const int c = unit & 63, h = (unit >> 6) & 7, b = unit >> 9, tok0 = b * SEQ + c * 64;
        hgrn_scan_cum(LF, tok0, h, cum, tot, tid);
#pragma unroll
        for (int it = 0; it < 8; ++it) { const int idx = tid + 512 * it, kp = (idx & 63) * 2, t = idx >> 6;
            const size_t g0 = (size_t)(tok0 + t) * 1024 + h * 128 + kp;
            const unsigned qw = *(const unsigned*)(QA + g0), kw = *(const unsigned*)(KA + g0);
            const float c0 = cum[t * CUM_LD + kp], c1 = cum[t * CUM_LD + kp + 1], r0 = cum[31 * CUM_LD + kp], r1 = cum[31 * CUM_LD + kp + 1];
            const float q0 = __uint_as_float(qw << 16), q1 = __uint_as_float(qw & 0xffff0000u), k0 = __uint_as_float(kw << 16), k1 = __uint_as_float(kw & 0xffff0000u);
            *(LAS unsigned*)(qd + t * OPK_LD + kp) = pg8::cvt_pk_bf16(q0 * __expf(c0), q1 * __expf(c1));
            *(LAS unsigned*)(qs + t * OPK_LD + kp) = pg8::cvt_pk_bf16(q0 * __expf(c0 - r0), q1 * __expf(c1 - r1));
            *(LAS unsigned*)(ks + t * OPK_LD + kp) = pg8::cvt_pk_bf16(k0 * __expf(r0 - c0), k1 * __expf(r1 - c1)); }
#pragma unroll
        for (int it = 0; it < 8; ++it) { const int idx = tid + 512 * it, v = idx & 127, sp = idx >> 7, s = 2 * sp;
            const size_t g0 = (size_t)(tok0 + s) * 1024 + h * 128 + v;
            *(LAS unsigned*)(vT + v * OPS_LD + s) = (unsigned)VA[g0] | ((unsigned)VA[g0 + 1024] << 16); }
        __syncthreads();
        const int mb = wave >> 1, tb = wave & 1;
        f32x16_t acc;
#pragma unroll
        for (int i = 0; i < 16; ++i) acc[i] = 0.f;
        { const bf16_t* prow = PT + (size_t)unit * 16384 + (size_t)(32 * mb + r) * 128 + 8 * hh;
#pragma unroll
          for (int k8 = 0; k8 < 8; ++k8) { const bf16x8_t a = *(const bf16x8_t*)(prow + 16 * k8); const bf16x8_t bq = *(const LAS bf16x8_t*)(qd + (32 * tb + r) * OPK_LD + 16 * k8 + 8 * hh);
              acc = __builtin_amdgcn_mfma_f32_32x32x16_bf16(a, bq, acc, 0, 0, 0); } }
#pragma unroll
        for (int sb = 0; sb < 2; ++sb) if (sb <= tb) {
            f32x16_t sc;
#pragma unroll
            for (int i = 0; i < 16; ++i) sc[i] = 0.f;
#pragma unroll
            for (int k8 = 0; k8 < 8; ++k8) { const bf16x8_t a = *(const LAS bf16x8_t*)(ks + (32 * sb + r) * OPK_LD + 16 * k8 + 8 * hh); const bf16x8_t bq = *(const LAS bf16x8_t*)(qs + (32 * tb + r) * OPK_LD + 16 * k8 + 8 * hh);
                sc = __builtin_amdgcn_mfma_f32_32x32x16_bf16(a, bq, sc, 0, 0, 0); }
            if (sb == tb) {
#pragma unroll
                for (int i = 0; i < 16; ++i) { const int sl = 8 * (i >> 2) + 4 * hh + (i & 3); sc[i] = (sl <= r) ? sc[i] : 0.f; } }
#pragma unroll
            for (int u = 0; u < 2; ++u) {
                pg8::u32x4 pw; pw.x = pg8::cvt_pk_bf16(sc[8 * u], sc[8 * u + 1]); pw.y = pg8::cvt_pk_bf16(sc[8 * u + 2], sc[8 * u + 3]); pw.z = pg8::cvt_pk_bf16(sc[8 * u + 4], sc[8 * u + 5]); pw.w = pg8::cvt_pk_bf16(sc[8 * u + 6], sc[8 * u + 7]);
                const bf16x8_t pb = __builtin_bit_cast(bf16x8_t, pw);
                const LAS bf16_t* vrow = vT + (32 * mb + r) * OPS_LD + 32 * sb + 16 * u + 4 * hh;
                const bf16x4_t lo = *(const LAS bf16x4_t*)vrow, hi4 = *(const LAS bf16x4_t*)(vrow + 8);
                const bf16x8_t va = {lo[0], lo[1], lo[2], lo[3], hi4[0], hi4[1], hi4[2], hi4[3]};
                acc = __builtin_amdgcn_mfma_f32_32x32x16_bf16(va, pb, acc, 0, 0, 0); }
        }
        float ss = 0.f;
#pragma unroll
        for (int i = 0; i < 16; ++i) ss += acc[i] * acc[i];
        ss += __shfl_xor(ss, 32);
        if (hh == 0) ssq[mb * 64 + 32 * tb + r] = ss;
        __syncthreads();
        const int t = 32 * tb + r;
        const float tot2 = (ssq[t] + ssq[64 + t]) + (ssq[128 + t] + ssq[192 + t]);
        const float rs = 1.0f / sqrtf(tot2 * (1.0f / 128.0f) + RMS_EPS);
        const size_t orow = (size_t)(tok0 + t) * 1024 + h * 128;
#pragma unroll
        for (int g = 0; g < 4; ++g) { const int v0 = 32 * mb + 8 * g + 4 * hh;
            const pg8::u32x2 gw = *(const pg8::u32x2*)(GA + orow + v0); const pg8::f32x4 nv = *(const pg8::f32x4*)(ng + v0);
            const float y0 = acc[4 * g] * rs * nv[0] * __uint_as_float(gw.x << 16), y1 = acc[4 * g + 1] * rs * nv[1] * __uint_as_float(gw.x & 0xffff0000u);
            const float y2 = acc[4 * g + 2] * rs * nv[2] * __uint_as_float(gw.y << 16), y3 = acc[4 * g + 3] * rs * nv[3] * __uint_as_float(gw.y & 0xffff0000u);
            pg8::u32x2 w; w.x = pg8::cvt_pk_bf16(y0, y1); w.y = pg8::cvt_pk_bf16(y2, y3); *(pg8::u32x2*)(YA + orow + v0) = w; }
        __syncthreads();
    }
}
__device__ __forceinline__ void phase_select(KP P, LAS unsigned char* lds) {
    unsigned char* ws = as_global(P->ws); const float* S = (const float*)(ws + WS_XPRE); unsigned long long* MASK = (unsigned long long*)(ws + WS_MASK);
    const int tid = tid_(), wave = tid >> 6, lane = tid & 63, nb8 = nblk_() * 8;
    for (int q = bid_() * 8 + wave; q < TOK; q += nb8) {
        const int b = q >> 12, s = q & 4095, c = s >> 6, nw = c + 1;
        unsigned long long myword = 0ull;
        if (nw <= TOPK / 64) { myword = (lane < nw) ? ~0ull : 0ull; }
        else {
            const float* row = S + (size_t)b * SCORE_B + (size_t)2048 * c * (c + 1) + (size_t)(s & 63) * (nw * 64);
            unsigned u[64];
#pragma unroll
            for (int j = 0; j < 64; ++j) { unsigned v = 0u; if (j < nw) { const unsigned bits = __float_as_uint(row[j * 64 + lane]); v = (bits & 0x80000000u) ? ~bits : (bits | 0x80000000u); } u[j] = v; }
            unsigned prefix = 0u;
            for (int bit = 31; bit >= 0; --bit) { const unsigned cand = prefix | (1u << bit); int cnt = 0;
#pragma unroll
                for (int j8 = 0; j8 < 8; ++j8) if (j8 * 8 < nw) {
#pragma unroll
                    for (int jj = 0; jj < 8; ++jj) cnt += __popcll(__ballot(u[j8 * 8 + jj] >= cand)); }
                if (cnt >= TOPK) prefix = cand; }
            LAS unsigned long long* sm = (LAS unsigned long long*)lds + wave * 64;
#pragma unroll
            for (int j = 0; j < 64; ++j) { const unsigned long long w = __ballot(u[j] >= prefix); if (lane == 0) sm[j] = w; }
            myword = sm[lane];
        }
        MASK[(size_t)q * 64 + lane] = myword;
    }
}

__device__ __forceinline__ void phase_hgrn_naive(KP P, int layer, LAS unsigned char* lds) {
    unsigned char* ws = as_global(P->ws);
    const bf16_t* QA = (const bf16_t*)(ws + WS_QA); const bf16_t* KA = (const bf16_t*)(ws + WS_KA); const bf16_t* VA = (const bf16_t*)(ws + WS_VA); const bf16_t* GA = (const bf16_t*)(ws + WS_GA);
    const float* LF = (const float*)(ws + WS_LF); bf16_t* YA = (bf16_t*)(ws + WS_YA);
    const int tid = tid_(), bh = bid_(), b = bh >> 3, h = bh & 7, v = tid & 127; const bool act = (bh < 32) && (tid < 128);
    if (bh >= 32) return;
    LAS float* sf = (LAS float*)lds; LAS float* sk = sf + 16 * 128; LAS float* sq = sk + 16 * 128; LAS float* red = sq + 16 * 128;
    float S[128];
#pragma unroll
    for (int k = 0; k < 128; ++k) S[k] = 0.f;
    const float ng = as_global(P->hnorm_g)[layer * 128 + v];
    for (int t0 = 0; t0 < SEQ; t0 += 16) {
        if (act) for (int i = 0; i < 16; ++i) { const size_t idx = ((size_t)(b * SEQ + t0 + i)) * 1024 + h * 128 + v; sf[i * 128 + v] = expf(LF[idx]); sk[i * 128 + v] = bf2f(KA[idx]); sq[i * 128 + v] = bf2f(QA[idx]); }
        __syncthreads();
        for (int i = 0; i < 16; ++i) { const size_t idx = ((size_t)(b * SEQ + t0 + i)) * 1024 + h * 128 + v; float o = 0.f;
            if (act) { const float vt = bf2f(VA[idx]);
#pragma unroll
                for (int k = 0; k < 128; ++k) { S[k] = sf[i * 128 + k] * S[k] + sk[i * 128 + k] * vt; o += S[k] * sq[i * 128 + k]; } }
            float ss = o * o;
#pragma unroll
            for (int m = 32; m >= 1; m >>= 1) ss += __shfl_xor(ss, m);
            if (act && (v & 63) == 0) red[v >> 6] = ss;
            __syncthreads();
            if (act) { const float tot = red[0] + red[1]; YA[idx] = f2bf(o * (1.0f / sqrtf(tot * (1.0f / 128.0f) + RMS_EPS)) * ng * bf2f(GA[idx])); }
            __syncthreads(); }
    }
}
__device__ __forceinline__ void phase_idx_naive(KP P, LAS unsigned char* lds) {
    unsigned char* ws = as_global(P->ws);
    const bf16_t* QI = (const bf16_t*)(ws + WS_QI); const bf16_t* KI = (const bf16_t*)(ws + WS_KI); const float* WI = (const float*)(ws + WS_WI); float* Sc = (float*)(ws + WS_XPRE);
    const int tid = tid_(), G = nblk_();
    LAS float* qs = (LAS float*)lds; LAS float* wsh = qs + 1024;
    for (int q = bid_(); q < TOK; q += G) {
        const int b = q >> 12, s = q & 4095, c = s >> 6, nw = c + 1, nk = nw * 64;
        if (nw <= TOPK / 64) continue;
        __syncthreads();
        for (int i = tid; i < 1024; i += 512) qs[i] = bf2f(QI[(size_t)q * 1024 + i]);
        if (tid < 16) wsh[tid] = WI[(size_t)q * 16 + tid];
        __syncthreads();
        float* row = Sc + (size_t)b * SCORE_B + (size_t)2048 * c * (c + 1) + (size_t)(s & 63) * nk;
        for (int key = tid; key < nk; key += 512) {
            float kf[64]; const pg8::u32x4* kp = (const pg8::u32x4*)(KI + ((size_t)b * SEQ + key) * 64);
#pragma unroll
            for (int d8 = 0; d8 < 8; ++d8) { const pg8::u32x4 w = kp[d8]; pg8::f32x4 a, bb; pg8::unpack8(w, a, bb);
#pragma unroll
                for (int j = 0; j < 4; ++j) { kf[d8 * 8 + j] = a[j]; kf[d8 * 8 + 4 + j] = bb[j]; } }
            float sc = 0.f;
            for (int h = 0; h < 16; ++h) { float dot = 0.f;
#pragma unroll
                for (int d = 0; d < 64; ++d) dot += qs[h * 64 + d] * kf[d];
                sc += wsh[h] * fmaxf(dot, 0.f); }
            row[key] = sc;
        }
    }
}
__device__ __forceinline__ void phase_attn_naive(KP P, LAS unsigned char* lds) {
    unsigned char* ws = as_global(P->ws);
    const bf16_t* QB = (const bf16_t*)(ws + WS_QB); const bf16_t* KB = (const bf16_t*)(ws + WS_KB); const bf16_t* VB = (const bf16_t*)(ws + WS_VB);
    const unsigned long long* MASK = (const unsigned long long*)(ws + WS_MASK); bf16_t* YB = (bf16_t*)(ws + WS_YB);
    const int tid = tid_(), h = tid >> 6, lane = tid & 63, G = nblk_();
    LAS float* qs = (LAS float*)lds + h * 128; LAS int* keys = (LAS int*)((LAS float*)lds + 1024) + h * 320; LAS float* lg = (LAS float*)lds + 1024 + 8 * 320 + h * 320;
    for (int q = bid_(); q < TOK; q += G) {
        const int b = q >> 12, s = q & 4095, nw = (s >> 6) + 1;
        qs[lane] = bf2f(QB[(size_t)q * 1024 + h * 128 + lane]); qs[lane + 64] = bf2f(QB[(size_t)q * 1024 + h * 128 + 64 + lane]);
        int cnt = 0;
        for (int j = 0; j < nw; ++j) { const unsigned long long w = MASK[(size_t)q * 64 + j]; const bool on = (w >> lane) & 1ull; const int key = j * 64 + lane;
            if (on) { const pg8::u32x4* kp = (const pg8::u32x4*)(KB + ((size_t)b * SEQ + key) * 1024 + h * 128); float dot = 0.f;
                for (int d8 = 0; d8 < 16; ++d8) { pg8::f32x4 a, bb; pg8::unpack8(kp[d8], a, bb);
#pragma unroll
                    for (int j2 = 0; j2 < 4; ++j2) dot += qs[d8 * 8 + j2] * a[j2] + qs[d8 * 8 + 4 + j2] * bb[j2]; }
                const int pos = cnt + __popcll(w & ((1ull << lane) - 1ull));
                if (pos < 320) { keys[pos] = key; lg[pos] = dot * ATTN_SCALE; } }
            cnt += __popcll(w); }
        if (cnt > 320) cnt = 320;
        float mx = -1e30f; for (int e = lane; e < cnt; e += 64) mx = fmaxf(mx, lg[e]);
#pragma unroll
        for (int m = 32; m >= 1; m >>= 1) mx = fmaxf(mx, __shfl_xor(mx, m));
        float sum = 0.f; for (int e = lane; e < cnt; e += 64) { const float pe = expf(lg[e] - mx); lg[e] = pe; sum += pe; }
#pragma unroll
        for (int m = 32; m >= 1; m >>= 1) sum += __shfl_xor(sum, m);
        float a0 = 0.f, a1 = 0.f;
        for (int e = 0; e < cnt; ++e) { const float pe = lg[e]; const bf16_t* vp = VB + ((size_t)b * SEQ + keys[e]) * 1024 + h * 128 + 2 * lane; a0 += pe * bf2f(vp[0]); a1 += pe * bf2f(vp[1]); }
        const float inv = 1.0f / sum;
        *(unsigned*)(YB + (size_t)q * 1024 + h * 128 + 2 * lane) = pg8::cvt_pk_bf16(a0 * inv, a1 * inv);
    }
}

__global__ __launch_bounds__(128) void k_hgrn_naive(const bf16_t* QA, const bf16_t* KA, const bf16_t* VA, const bf16_t* GA, const float* LF, const float* norm_g, bf16_t* YA) {
    const int bh = blockIdx.x, b = bh >> 3, h = bh & 7, v = threadIdx.x;
    __shared__ float sf[16][128], sk[16][128], sq[16][128]; __shared__ float red[2];
    float S[128];
#pragma unroll
    for (int k = 0; k < 128; ++k) S[k] = 0.f;
    const float ng = norm_g[v];
    for (int t0 = 0; t0 < SEQ; t0 += 16) {
        for (int i = 0; i < 16; ++i) { const size_t idx = ((size_t)(b * SEQ + t0 + i)) * 1024 + h * 128 + v; sf[i][v] = expf(LF[idx]); sk[i][v] = bf2f(KA[idx]); sq[i][v] = bf2f(QA[idx]); }
        __syncthreads();
        for (int i = 0; i < 16; ++i) { const size_t idx = ((size_t)(b * SEQ + t0 + i)) * 1024 + h * 128 + v; const float vt = bf2f(VA[idx]); float o = 0.f;
#pragma unroll
            for (int k = 0; k < 128; ++k) { S[k] = sf[i][k] * S[k] + sk[i][k] * vt; o += S[k] * sq[i][k]; }
            float ss = o * o;
#pragma unroll
            for (int m = 32; m >= 1; m >>= 1) ss += __shfl_xor(ss, m);
            if ((v & 63) == 0) red[v >> 6] = ss;
            __syncthreads();
            const float tot = red[0] + red[1];
            const float y = o * (1.0f / sqrtf(tot * (1.0f / 128.0f) + RMS_EPS)) * ng * bf2f(GA[idx]);
            YA[idx] = f2bf(y);
            __syncthreads(); }
    }
}
__global__ __launch_bounds__(256) void k_idx_naive(const bf16_t* QI, const bf16_t* KI, const float* WI, float* S) {
    const int q = blockIdx.x, b = q >> 12, s = q & 4095, c = s >> 6, nw = c + 1, nk = nw * 64;
    if (nw <= TOPK / 64) return;
    __shared__ float qs[1024]; __shared__ float wsh[16];
    for (int i = threadIdx.x; i < 1024; i += 256) qs[i] = bf2f(QI[(size_t)q * 1024 + i]);
    if (threadIdx.x < 16) wsh[threadIdx.x] = WI[(size_t)q * 16 + threadIdx.x];
    __syncthreads();
    float* row = S + (size_t)b * SCORE_B + (size_t)2048 * c * (c + 1) + (size_t)(s & 63) * nk;
    for (int key = threadIdx.x; key < nk; key += 256) {
        float kf[64]; const bf16_t* kp = KI + ((size_t)b * SEQ + key) * 64;
#pragma unroll
        for (int d = 0; d < 64; ++d) kf[d] = bf2f(kp[d]);
        float sc = 0.f;
        for (int h = 0; h < 16; ++h) { float dot = 0.f;
#pragma unroll
            for (int d = 0; d < 64; ++d) dot += qs[h * 64 + d] * kf[d];
            sc += wsh[h] * fmaxf(dot, 0.f); }
        row[key] = sc;
    }
}
__global__ __launch_bounds__(512) void k_attn_naive(const bf16_t* QB, const bf16_t* KB, const bf16_t* VB, const unsigned long long* MASK, bf16_t* YB) {
    const int q = blockIdx.x, b = q >> 12, s = q & 4095, nw = (s >> 6) + 1, h = threadIdx.x >> 6, lane = threadIdx.x & 63;
    __shared__ float qs[8][128]; __shared__ int keys[8][320]; __shared__ float lg[8][320];
    qs[h][lane] = bf2f(QB[(size_t)q * 1024 + h * 128 + lane]); qs[h][lane + 64] = bf2f(QB[(size_t)q * 1024 + h * 128 + 64 + lane]);
    __syncthreads();
    int cnt = 0;
    for (int j = 0; j < nw; ++j) { const unsigned long long w = MASK[(size_t)q * 64 + j]; const bool on = (w >> lane) & 1ull; const int key = j * 64 + lane;
        if (on) { const bf16_t* kp = KB + ((size_t)b * SEQ + key) * 1024 + h * 128; float dot = 0.f;
            for (int d = 0; d < 128; ++d) dot += qs[h][d] * bf2f(kp[d]);
            const int pos = cnt + __popcll(w & ((1ull << lane) - 1ull));
            if (pos < 320) { keys[h][pos] = key; lg[h][pos] = dot * ATTN_SCALE; } }
        cnt += __popcll(w); }
    if (cnt > 320) cnt = 320;
    __syncthreads();
    float mx = -1e30f; for (int e = lane; e < cnt; e += 64) mx = fmaxf(mx, lg[h][e]);
#pragma unroll
    for (int m = 32; m >= 1; m >>= 1) mx = fmaxf(mx, __shfl_xor(mx, m));
    float sum = 0.f; for (int e = lane; e < cnt; e += 64) { const float pe = expf(lg[h][e] - mx); lg[h][e] = pe; sum += pe; }
#pragma unroll
    for (int m = 32; m >= 1; m >>= 1) sum += __shfl_xor(sum, m);
    __syncthreads();
    float a0 = 0.f, a1 = 0.f;
    for (int e = 0; e < cnt; ++e) { const float pe = lg[h][e]; const bf16_t* vp = VB + ((size_t)b * SEQ + keys[h][e]) * 1024 + h * 128 + 2 * lane; a0 += pe * bf2f(vp[0]); a1 += pe * bf2f(vp[1]); }
    const float inv = 1.0f / sum;
    YB[(size_t)q * 1024 + h * 128 + 2 * lane] = f2bf(a0 * inv); YB[(size_t)q * 1024 + h * 128 + 2 * lane + 1] = f2bf(a1 * inv);
}

__global__ __launch_bounds__(256) void k_dump(const unsigned char* ws, int which, float* out) {
    for (size_t i = (size_t)blockIdx.x * 256 + threadIdx.x; i < (size_t)TOK * DM; i += (size_t)gridDim.x * 256) {
        const size_t t = i / DM, c = i % DM; float v = 0.f;
        if (which == 0) { v = bf2f(((const bf16_t*)(ws + WS_MG))[i]) + ((const float*)(ws + WS_PP))[i]; }
        else if (which == 1) { const size_t j = t * 1024 + (c & 1023);
            v = bf2f(((const bf16_t*)(ws + WS_QA))[j]) + bf2f(((const bf16_t*)(ws + WS_KA))[j]) + bf2f(((const bf16_t*)(ws + WS_VA))[j]) + bf2f(((const bf16_t*)(ws + WS_GA))[j])
              + bf2f(((const bf16_t*)(ws + WS_QB))[j]) + bf2f(((const bf16_t*)(ws + WS_KB))[j]) + bf2f(((const bf16_t*)(ws + WS_VB))[j]) + bf2f(((const bf16_t*)(ws + WS_QI))[j])
              + ((const float*)(ws + WS_LF))[j] + bf2f(((const bf16_t*)(ws + WS_SGA))[i]) + bf2f(((const bf16_t*)(ws + WS_SGB))[i]) + ((const float*)(ws + WS_IKW))[t * 128 + (c & 127)]; }
        else if (which == 2) { const size_t j = t * 1024 + (c & 1023); v = (c < 1024) ? bf2f(((const bf16_t*)(ws + WS_YA))[j]) : bf2f(((const bf16_t*)(ws + WS_YB))[j]); }
        else if (which == 3) { v = ((const float*)(ws + WS_XPRE))[i]; }
        else if (which == 4) { v = ((const float*)(ws + WS_X32))[i]; }
        else if (which == 5) { v = bf2f(((const bf16_t*)(ws + WS_H))[t * DFF + c]) + bf2f(((const bf16_t*)(ws + WS_H))[t * DFF + 2048 + c]) + bf2f(((const bf16_t*)(ws + WS_H))[t * DFF + 3584 + c]); }
        else if (which == 6) { const unsigned long long m = ((const unsigned long long*)(ws + WS_MASK))[t * 64 + (c & 63)]; v = (float)__popcll(m) + (float)(unsigned)(m % 1000003ull) * 1e-3f; }
        else if (which == 7) { v = bf2f(((const bf16_t*)(ws + WS_WIN))[i % ((size_t)INP * DM)]) + bf2f(((const bf16_t*)(ws + WS_WGU))[(i * 7) % ((size_t)2 * DFF * DM)]) + bf2f(((const bf16_t*)(ws + WS_WDN))[(i * 3) % ((size_t)DFF * DM)]); }
        else if (which == 8) { v = bf2f(((const bf16_t*)(ws + WS_XB))[i]) + ((const float*)(ws + WS_COSH))[i % ((size_t)TOK * 64)] + ((const float*)(ws + WS_SINI))[i % ((size_t)TOK * 32)] + ((const float*)(ws + WS_LB))[i % 4096]; }
        else if (which == 9) { v = bf2f(((const bf16_t*)(ws + WS_H))[t * 6272 + c]) + bf2f(((const bf16_t*)(ws + WS_H))[t * 6272 + 2048 + c]) + bf2f(((const bf16_t*)(ws + WS_H))[t * 6272 + 4096 + c]) + bf2f(((const bf16_t*)(ws + WS_H))[t * 6272 + 4224 + c]); }
        else if (which == 10) { const size_t j = t * 1024 + (c & 1023); v = bf2f(((const bf16_t*)(ws + WS_QA))[j]) + bf2f(((const bf16_t*)(ws + WS_VA))[j]) + bf2f(((const bf16_t*)(ws + WS_GA))[j]) + bf2f(((const bf16_t*)(ws + WS_VB))[j]) + bf2f(((const bf16_t*)(ws + WS_SGA))[i]) + bf2f(((const bf16_t*)(ws + WS_SGB))[i]); }
        else if (which == 11) { const size_t j = t * 1024 + (c & 1023); v = bf2f(((const bf16_t*)(ws + WS_QB))[j]) + bf2f(((const bf16_t*)(ws + WS_KB))[j]) + bf2f(((const bf16_t*)(ws + WS_QI))[j]); }
        else if (which == 12) { const size_t j = t * 1024 + (c & 1023); v = ((const float*)(ws + WS_LF))[j] + bf2f(((const bf16_t*)(ws + WS_KA))[j]); }
        else if (which == 14) { v = ((const float*)(ws + WS_IKW))[t * 128 + (c & 127)]; }
        else if (which == 15) { const size_t j = t * 1024 + (c & 1023); v = bf2f(((const bf16_t*)(ws + WS_QA))[j]) + bf2f(((const bf16_t*)(ws + WS_GA))[j]); }
        else if (which == 16) { v = bf2f(((const bf16_t*)(ws + WS_SGA))[i]) + bf2f(((const bf16_t*)(ws + WS_SGB))[i]); }
        else if (which == 17) { const size_t j = t * 1024 + (c & 1023); v = bf2f(((const bf16_t*)(ws + WS_VA))[j]) + bf2f(((const bf16_t*)(ws + WS_VB))[j]); }
        out[i] = v;
    }
}
#ifndef OPT_HGRN
#define OPT_HGRN 1
#endif
#ifndef OPT_IDX
#define OPT_IDX 0
#endif
#ifndef OPT_ATT
#define OPT_ATT 0
#endif
#ifndef PHM
#define PHM 0x3fff
#endif
#ifndef ONE_LAUNCH
#define ONE_LAUNCH 1
#endif

__global__ void __launch_bounds__(512, 2) mega(Params P_unused) {
    extern __shared__ __attribute__((aligned(16))) unsigned char lds[];
    LAS unsigned char* L = (LAS unsigned char*)lds;
    volatile LAS unsigned* misc = (volatile LAS unsigned*)(L + MISC_OFF);
    if (threadIdx.x < 4) misc[threadIdx.x] = 0u;
    __syncthreads();
    int lo, hi; unsigned char* ws0; { KP P0 = kparams(); lo = P0->ph_lo; hi = P0->ph_hi; ws0 = as_global(P0->ws); }
    XcdBarrier bar; bar.bar = (unsigned*)(ws0 + WS_CTL); bar.x = 0; bar.st = misc;
    if (hi - lo > 1) bar = xcd_barrier_post((unsigned*)(ws0 + WS_CTL), misc);
#define WSP(T_, off) ((T_*)(ws + (off)))
#define WSL KP P = kparams(); unsigned char* ws = as_global(P->ws); const int G = nblk_(), bid = bid_(); (void)G; (void)bid

    for (int layer = 0; layer < DEPTH; ++layer) {
        const int base = layer * NPH_LAYER;
#define IN(k) (((PHM >> (k)) & 1) && lo <= base + (k) && base + (k) < hi)
#define SEAM(k) do { if (base + (k) + 1 < hi) xcd_barrier(bar); } while (0)
        if (IN(0)) { WSL; if (layer == 0) phase_prologue(P); phase_wconv(P, layer, (LAS float*)L); SEAM(0); }
        if (IN(1)) { WSL;
            pg8::Gemm g{WSP(const bf16_t, WS_XB), WSP(const bf16_t, WS_WIN), TOK, INP, DM}; pg8::StaticOrder S; S.init(TOK, INP, G, bid);
#ifdef RAWTEST
            pg8::EpiRawTest E{ws};
            pg8::gemm_phase<pg8::EpiRawTest, pg8::StaticOrder, true, true>(L, g, S, E); SEAM(1);
#else
            pg8::EpiIn E{ws, layer};
            pg8::gemm_phase<pg8::EpiIn, pg8::StaticOrder, true, true>(L, g, S, E); SEAM(1);
#endif
        }
        if (IN(2)) { WSL; phase_ikprep(P, layer);
#if OPT_HGRN
            phase_hgrn_h1(P, L);
#endif
            SEAM(2); }
        if (IN(3)) { WSL;
#if !OPT_HGRN
            phase_hgrn_naive(P, layer, L); __syncthreads();
#else
            phase_hgrn_h2(P);
#endif
#if !OPT_IDX
            phase_idx_naive(P, L);
#endif
            SEAM(3); }
        if (IN(4)) { WSL; phase_select(P, L);
#if OPT_HGRN
            __syncthreads(); phase_hgrn_h3(P, layer, L);
#endif
            SEAM(4); }
        if (IN(5)) { WSL;
#if !OPT_ATT
            phase_attn_naive(P, L);
#endif
            SEAM(5); }
        if (IN(6)) { WSL;
            { pg8::Gemm g{WSP(const bf16_t, WS_YA), WSP(const bf16_t, WS_WA), TOK, DM, AW}; pg8::StaticOrder S; S.init(TOK, DM, G, bid);
              pg8::EpiGateA E{ws}; pg8::gemm_phase<pg8::EpiGateA, pg8::StaticOrder, true, true>(L, g, S, E); }
            { pg8::Gemm g{WSP(const bf16_t, WS_YB), WSP(const bf16_t, WS_WB), TOK, DM, BW}; pg8::StaticOrder S; S.init(TOK, DM, G, bid);
              pg8::EpiGateB E{ws}; pg8::gemm_phase<pg8::EpiGateB, pg8::StaticOrder, true, true>(L, g, S, E); }
            { pg8::Gemm g{WSP(const bf16_t, WS_PB), WSP(const bf16_t, WS_WPP), TOK, DM, PLE}; pg8::StaticOrder S; S.init(TOK, DM, G, bid);
              pg8::EpiF32P E{ws}; pg8::gemm_phase<pg8::EpiF32P, pg8::StaticOrder, true, true>(L, g, S, E); }
            SEAM(6);
        }
        if (IN(7)) { WSL;
            pg8::Gemm g{WSP(const bf16_t, WS_MG), WSP(const bf16_t, WS_WO), TOK, DM, DM}; pg8::StaticOrder S; S.init(TOK, DM, G, bid);
            pg8::EpiRes E{layer == 0 ? as_global(P->x) : WSP(const float, WS_X32), ws}; pg8::gemm_phase<pg8::EpiRes, pg8::StaticOrder, true, true>(L, g, S, E); SEAM(7);
        }
        if (IN(8)) { WSL; phase_ln(WSP(const float, WS_XPRE), WSP(float, WS_X32), WSP(bf16_t, WS_XB), as_global(P->lnm_g) + layer * DM, as_global(P->lnm_b) + layer * DM); SEAM(8); }
        if (IN(9)) { WSL;
            pg8::Gemm g{WSP(const bf16_t, WS_XB), WSP(const bf16_t, WS_WGU), TOK, 2 * DFF, DM}; pg8::StaticOrder S; S.init(TOK, 2 * DFF, G, bid);
            pg8::EpiSwiGLU E{ws}; pg8::gemm_phase<pg8::EpiSwiGLU, pg8::StaticOrder, true, true>(L, g, S, E); SEAM(9);
        }
        if (IN(10)) { WSL;
            pg8::Gemm g{WSP(const bf16_t, WS_H), WSP(const bf16_t, WS_WDN), TOK, DM, DFF}; pg8::StaticOrder S; S.init(TOK, DM, G, bid);
            pg8::EpiRes E{WSP(const float, WS_X32), ws}; pg8::gemm_phase<pg8::EpiRes, pg8::StaticOrder, true, true>(L, g, S, E); SEAM(10);
        }
        if (IN(11)) { WSL; phase_ln(WSP(const float, WS_XPRE), WSP(float, WS_X32), WSP(bf16_t, WS_XB), as_global(P->lnf_g) + layer * DM, as_global(P->lnf_b) + layer * DM); SEAM(11); }
        if (IN(12)) { WSL;
            pg8::Gemm g{WSP(const bf16_t, WS_XB), WSP(const bf16_t, WS_WPG), TOK, DM, DM}; pg8::StaticOrder S; S.init(TOK, DM, G, bid);
            pg8::EpiPle E{ws}; pg8::gemm_phase<pg8::EpiPle, pg8::StaticOrder, true, true>(L, g, S, E); SEAM(12);
        }
        if (IN(13)) { WSL; phase_ln(WSP(const float, WS_XPRE), layer == DEPTH - 1 ? as_global(P->out) : WSP(float, WS_X32), WSP(bf16_t, WS_XB), as_global(P->lnp_g) + layer * DM, as_global(P->lnp_b) + layer * DM); SEAM(13); }
#undef IN
#undef SEAM
    }
}

extern "C" void kernel_launch(void* const* d_in, const int* in_sizes, int n_in, void* d_out, int out_size, void* d_ws, size_t ws_size, hipStream_t stream) {
    static int grid = 0;
    if (grid == 0) {
        if (n_in != 22 || out_size != TOK * DM || ws_size < WS_END) { fprintf(stderr, "kernel_launch: unexpected shapes: n_in %d out %d ws %zu (need %zu)\n", n_in, out_size, ws_size, (size_t)WS_END); grid = -1; return; }
        int dev = 0, cus = 0, per_cu = 0;
        if (hipGetDevice(&dev) != hipSuccess || hipDeviceGetAttribute(&cus, hipDeviceAttributeMultiprocessorCount, dev) != hipSuccess) { grid = -1; return; }
        if (hipFuncSetAttribute((const void*)mega, hipFuncAttributeMaxDynamicSharedMemorySize, LDS_BYTES) != hipSuccess) { fprintf(stderr, "kernel_launch: hipFuncSetAttribute failed\n"); grid = -1; return; }
        if (hipOccupancyMaxActiveBlocksPerMultiprocessor(&per_cu, (const void*)mega, 512, LDS_BYTES) != hipSuccess || per_cu < 1) { fprintf(stderr, "kernel_launch: occupancy query says %d\n", per_cu); (void)hipGetLastError(); }
        grid = cus;
    }
    if (grid < 0) return;
    (void)hipMemsetAsync((char*)d_ws + WS_CTL, 0, 65536, stream);
    Params P{};
    P.x = (const float*)d_in[0]; P.p = (const float*)d_in[1]; P.pos = (const int*)d_in[2];
    P.w_in = (const float*)d_in[3]; P.w_a = (const float*)d_in[4]; P.w_b = (const float*)d_in[5]; P.w_out = (const float*)d_in[6];
    P.lbraw = (const float*)d_in[7]; P.hnorm_g = (const float*)d_in[8]; P.ikn_g = (const float*)d_in[9]; P.ikn_b = (const float*)d_in[10];
    P.lnm_g = (const float*)d_in[11]; P.lnm_b = (const float*)d_in[12]; P.w_fg = (const float*)d_in[13]; P.w_fu = (const float*)d_in[14]; P.w_fd = (const float*)d_in[15];
    P.lnf_g = (const float*)d_in[16]; P.lnf_b = (const float*)d_in[17]; P.w_pg = (const float*)d_in[18]; P.w_pp = (const float*)d_in[19];
    P.lnp_g = (const float*)d_in[20]; P.lnp_b = (const float*)d_in[21];
    P.out = (float*)d_out; P.ws = (unsigned char*)d_ws;
    for (int j = 0; j < 64; ++j) P.invf_h[j] = pow(10000.0, -(double)j / 64.0) / 6.283185307179586476925286766559;
    for (int j = 0; j < 32; ++j) P.invf_i[j] = pow(10000.0, -(double)j / 32.0) / 6.283185307179586476925286766559;
#if ONE_LAUNCH
    P.ph_lo = 0; P.ph_hi = NPH;
    hipLaunchKernelGGL(mega, dim3(grid), dim3(512), LDS_BYTES, stream, P);
#elif defined(SEQ_TEST)
    { const int seq[] = SEQ_TEST; for (int i = 0; i < (int)(sizeof(seq) / sizeof(int)); ++i) { P.ph_lo = seq[i]; P.ph_hi = seq[i] + 1; hipLaunchKernelGGL(mega, dim3(grid), dim3(512), LDS_BYTES, stream, P); }
      hipLaunchKernelGGL(k_dump, dim3(4096), dim3(256), 0, stream, (const unsigned char*)d_ws, DUMP_WHICH, (float*)d_out); }
#else
    unsigned char* ws = (unsigned char*)d_ws;
    for (int layer = 0; layer < DEPTH; ++layer)
        for (int k = 0; k < NPH_LAYER; ++k) {
            P.ph_lo = layer * NPH_LAYER + k; P.ph_hi = P.ph_lo + 1;
            bool run_mega = true;
#if !OPT_HGRN
            if (k == 3) hipLaunchKernelGGL(k_hgrn_naive, dim3(32), dim3(128), 0, stream, (const bf16_t*)(ws + WS_QA), (const bf16_t*)(ws + WS_KA), (const bf16_t*)(ws + WS_VA), (const bf16_t*)(ws + WS_GA),
                                           (const float*)(ws + WS_LF), P.hnorm_g + layer * 128, (bf16_t*)(ws + WS_YA));
#endif
#if !OPT_IDX
            if (k == 3) hipLaunchKernelGGL(k_idx_naive, dim3(TOK), dim3(256), 0, stream, (const bf16_t*)(ws + WS_QI), (const bf16_t*)(ws + WS_KI), (const float*)(ws + WS_WI), (float*)(ws + WS_XPRE));
#endif
#if !OPT_ATT
            if (k == 5) hipLaunchKernelGGL(k_attn_naive, dim3(TOK), dim3(512), 0, stream, (const bf16_t*)(ws + WS_QB), (const bf16_t*)(ws + WS_KB), (const bf16_t*)(ws + WS_VB),
                                           (const unsigned long long*)(ws + WS_MASK), (bf16_t*)(ws + WS_YB));
#endif
#if !OPT_HGRN && !OPT_IDX
            if (k == 3) run_mega = false;
#endif
#if !OPT_ATT
            if (k == 5) run_mega = false;
#endif
            if (run_mega) hipLaunchKernelGGL(mega, dim3(grid), dim3(512), LDS_BYTES, stream, P);
#ifdef DUMP_AT
            if (layer * NPH_LAYER + k == DUMP_AT) { hipLaunchKernelGGL(k_dump, dim3(4096), dim3(256), 0, stream, (const unsigned char*)ws, DUMP_WHICH, (float*)d_out); return; }
#endif
        }
#endif
    const hipError_t le = hipPeekAtLastError();
    if (le != hipSuccess) fprintf(stderr, "kernel_launch: launch failed: %s\n", hipGetErrorName(le));
}
```

```cpp
#include <hip/hip_runtime.h>
#include <cstdio>
#include <cstdint>

constexpr int DM = 2048, NBATCH = 4, SEQ = 4096, TOK = NBATCH * SEQ, DEPTH = 4, CHUNK = 64, PLE = 256;
constexpr int AH = 8, AD = 128, AW = 1024, BH = 8, BD = 128, BW = 1024, IH = 16, IDIM = 64, TOPK = 256;
constexpr int DFF = 5632, INW = 12368, INP = 12544;
constexpr float ALPHA = 1.6817928305074290861f;
constexpr float LN_EPS = 1e-5f, RMS_EPS = 1e-6f;
constexpr float ATTN_SCALE = 0.088388347648318440f;
constexpr float IDX_SCALE = 0.03125f;

typedef unsigned short bf16_t;
__device__ __forceinline__ float bf2f(bf16_t b) { return __uint_as_float(((unsigned)b) << 16); }
__device__ __forceinline__ bf16_t f2bf(float f) { unsigned u = __float_as_uint(f); u += 0x7FFFu + ((u >> 16) & 1u); return (bf16_t)(u >> 16); }
__device__ __forceinline__ float sigmoid_f(float x) { return __builtin_amdgcn_rcpf(1.0f + __expf(-x)); }
__device__ __forceinline__ float silu_f(float x) { return x * sigmoid_f(x); }

__device__ __forceinline__ int tid_() { int t = (int)threadIdx.x; asm volatile("" : "+v"(t)); return t; }
__device__ __forceinline__ int bid_() { int b = (int)blockIdx.x; asm volatile("" : "+s"(b)); return b; }
__device__ __forceinline__ int nblk_() { int g = (int)gridDim.x; asm volatile("" : "+s"(g)); return g; }

template <class T> __device__ __forceinline__ T* as_global(T* p) { return (T*)(__attribute__((address_space(1))) T*)p; }

constexpr size_t MiB = 1048576;
constexpr size_t WS_CTL  = 0;
constexpr size_t WS_LB   = WS_CTL + 65536;
constexpr size_t WS_COSH = 1 * MiB;
constexpr size_t WS_SINH = WS_COSH + 4 * MiB;
constexpr size_t WS_COSI = WS_SINH + 4 * MiB;
constexpr size_t WS_SINI = WS_COSI + 2 * MiB;
constexpr size_t WS_WIN  = WS_SINI + 2 * MiB;
constexpr size_t WS_WA   = WS_WIN + 49 * MiB;
constexpr size_t WS_WB   = WS_WA + 4 * MiB;
constexpr size_t WS_WO   = WS_WB + 4 * MiB;
constexpr size_t WS_WGU  = WS_WO + 8 * MiB;
constexpr size_t WS_WDN  = WS_WGU + 44 * MiB;
constexpr size_t WS_WPG  = WS_WDN + 22 * MiB;
constexpr size_t WS_WPP  = WS_WPG + 8 * MiB;
constexpr size_t WS_X32  = WS_WPP + 1 * MiB;
constexpr size_t WS_XB   = WS_X32 + 128 * MiB;
constexpr size_t WS_XPRE = WS_XB + 64 * MiB;
constexpr size_t WS_R1   = WS_XPRE + 130 * MiB;
constexpr size_t WS_QA   = WS_R1;
constexpr size_t WS_LF   = WS_QA + 32 * MiB;
constexpr size_t WS_KA   = WS_LF + 64 * MiB;
constexpr size_t WS_VA   = WS_KA + 32 * MiB;
constexpr size_t WS_GA   = WS_VA + 32 * MiB;
constexpr size_t WS_QB   = WS_GA + 32 * MiB;
constexpr size_t WS_KB   = WS_QB + 32 * MiB;
constexpr size_t WS_VB   = WS_KB + 32 * MiB;
constexpr size_t WS_QI   = WS_VB + 32 * MiB;
constexpr size_t WS_SGA  = WS_QI + 32 * MiB;
constexpr size_t WS_SGB  = WS_SGA + 64 * MiB;
constexpr size_t WS_IKW  = WS_SGB + 64 * MiB;
constexpr size_t WS_H    = WS_R1;
constexpr size_t WS_PP   = WS_R1 + 176 * MiB;
constexpr size_t WS_R2   = WS_IKW + 8 * MiB;
constexpr size_t WS_LT   = WS_R2;
constexpr size_t WS_MG   = WS_R2;
constexpr size_t WS_PT   = WS_LT + 128 * MiB;
constexpr size_t WS_DEC  = WS_PT + 64 * MiB;
constexpr size_t WS_MASK = WS_DEC + 1 * MiB;
constexpr size_t WS_YA   = WS_MASK + 8 * MiB;
constexpr size_t WS_YB   = WS_YA + 32 * MiB;
constexpr size_t WS_KI   = WS_YB + 32 * MiB;
constexpr size_t WS_WI   = WS_KI + 2 * MiB;
constexpr size_t WS_PB   = WS_WI + 1 * MiB;
constexpr size_t WS_END  = WS_PB + 8 * MiB;
static_assert(WS_END < 1360000000ull, "workspace budget");
constexpr size_t SCORE_B = (size_t)4096 * 2080;

namespace pg8 {
#define PG8_LAS __attribute__((address_space(3)))
typedef unsigned short bf16_t;
typedef short bf16x8 __attribute__((ext_vector_type(8)));
typedef float f32x4 __attribute__((ext_vector_type(4)));
typedef unsigned u32x4 __attribute__((ext_vector_type(4)));
constexpr int BM = 256, BK = 64, HALF = 128, HTB = HALF * BK * 2  , STAGE_BYTES = 8 * HTB, NXCD = 8, WGM = 8;

__host__ __device__ __forceinline__ int lds_byte(int r, int c) { const int st = (r >> 4) * 2 + (c >> 5), rr = r & 15, cc = c & 31, ob = rr * 64 + cc * 2; return st * 1024 + (ob ^ (((ob >> 9) & 1) << 5)); }
__host__ __device__ __forceinline__ void stage_rc(int b, int& R, int& C) { const int st = b / 1024, sb = b % 1024, swz = sb ^ (((sb >> 9) & 1) << 5); R = (st >> 1) * 16 + swz / 64; C = (st & 1) * 32 + (swz % 64) / 2; }
__host__ __device__ __forceinline__ int perm32(int rho) { const int n = rho >> 4, i = rho & 15; return 8 * (i >> 2) + 4 * n + (i & 3); }

struct Unit { int pm, pn; };
struct Gemm { const bf16_t* A; const bf16_t* Bt; int M, N, K; };

struct StaticOrder {
    int nM, nN, nwg, G, c;
    __host__ __device__ void init(int M, int N, int G_, int c_) { nM = M / BM; nN = N / BM; nwg = nM * nN; G = G_; c = c_; }
    __host__ __device__ bool next(int i, Unit& u) const {
        const long L = (long)i * G + c; if (L >= nwg) return false;
        int wgid = (int)L; { const int q = nwg / NXCD, r = nwg % NXCD, xcd = wgid % NXCD, off = wgid / NXCD; wgid = (xcd < r ? xcd * (q + 1) : r * (q + 1) + (xcd - r) * q) + off; }
        const int nig = WGM * nN, gid = wgid / nig, fm = gid * WGM, gsz = (nM - fm) < WGM ? (nM - fm) : WGM;
        u.pm = fm + ((wgid % nig) % gsz); u.pn = (wgid % nig) / gsz; return true;
    }
    __device__ __forceinline__ void a_ready(const Unit&) const {}
    __device__ __forceinline__ void done(const Unit&) const {}
};

typedef float pk_f32x2 __attribute__((ext_vector_type(2)));
typedef __bf16 pk_bf16x2 __attribute__((ext_vector_type(2)));
__device__ __forceinline__ unsigned cvt_pk_bf16(float lo, float hi) { const pk_f32x2 v = {lo, hi}; const pk_bf16x2 b = __builtin_convertvector(v, pk_bf16x2); return __builtin_bit_cast(unsigned, b); }
typedef unsigned u32x2 __attribute__((ext_vector_type(2)));
__device__ __forceinline__ u32x4 pack8(const f32x4 a, const f32x4 b) { u32x4 w; w.x = cvt_pk_bf16(a[0], a[1]); w.y = cvt_pk_bf16(a[2], a[3]); w.z = cvt_pk_bf16(b[0], b[1]); w.w = cvt_pk_bf16(b[2], b[3]); return w; }
__device__ __forceinline__ void unpack8(const u32x4 w, f32x4& a, f32x4& b) {
    a[0] = __uint_as_float(w.x << 16); a[1] = __uint_as_float(w.x & 0xffff0000u); a[2] = __uint_as_float(w.y << 16); a[3] = __uint_as_float(w.y & 0xffff0000u);
    b[0] = __uint_as_float(w.z << 16); b[1] = __uint_as_float(w.z & 0xffff0000u); b[2] = __uint_as_float(w.w << 16); b[3] = __uint_as_float(w.w & 0xffff0000u); }
__device__ __forceinline__ float sigm(float x) { return __builtin_amdgcn_rcpf(1.0f + __expf(-x)); }
__device__ __forceinline__ f32x4 sigm4(const f32x4 x) { f32x4 r; r[0] = sigm(x[0]); r[1] = sigm(x[1]); r[2] = sigm(x[2]); r[3] = sigm(x[3]); return r; }
__device__ __forceinline__ f32x4 silu4(const f32x4 x) { return x * sigm4(x); }

#define PG8_GAS __attribute__((address_space(1)))
struct EpiIn {
    static constexpr bool PERM = true, AFTER_DRAIN = false;
    unsigned char* ws0; int layer;
    __device__ __forceinline__ void operator()(const f32x4 (&acc)[2][2][4][2], const Unit& u, int wr, int wc, int fr, int fq) const {
        unsigned char* wsq = ws0; asm volatile("" : "+s"(wsq)); PG8_GAS unsigned char* const ws = (PG8_GAS unsigned char*)wsq;
        const int pn = u.pn, row0 = u.pm * BM + wr * 64 + fr, cw = wc * 32 + 8 * fq;
        PG8_GAS bf16_t* const QA = (PG8_GAS bf16_t*)(ws + WS_QA); PG8_GAS bf16_t* const KA = (PG8_GAS bf16_t*)(ws + WS_KA); PG8_GAS bf16_t* const VA = (PG8_GAS bf16_t*)(ws + WS_VA); PG8_GAS bf16_t* const GA = (PG8_GAS bf16_t*)(ws + WS_GA);
        PG8_GAS bf16_t* const QB = (PG8_GAS bf16_t*)(ws + WS_QB); PG8_GAS bf16_t* const KB = (PG8_GAS bf16_t*)(ws + WS_KB); PG8_GAS bf16_t* const VB = (PG8_GAS bf16_t*)(ws + WS_VB); PG8_GAS bf16_t* const QI = (PG8_GAS bf16_t*)(ws + WS_QI);
        PG8_GAS bf16_t* const SGA = (PG8_GAS bf16_t*)(ws + WS_SGA); PG8_GAS bf16_t* const SGB = (PG8_GAS bf16_t*)(ws + WS_SGB); PG8_GAS float* const LF = (PG8_GAS float*)(ws + WS_LF); PG8_GAS float* const IKW = (PG8_GAS float*)(ws + WS_IKW);
        const PG8_GAS float* const lb = (const PG8_GAS float*)(ws + WS_LB) + layer * 1024; const PG8_GAS float* const cosh = (const PG8_GAS float*)(ws + WS_COSH); const PG8_GAS float* const sinh = (const PG8_GAS float*)(ws + WS_SINH);
        const PG8_GAS float* const cosi = (const PG8_GAS float*)(ws + WS_COSI); const PG8_GAS float* const sini = (const PG8_GAS float*)(ws + WS_SINI);
        if (pn < 32) {
            const int seg = pn >> 2, cb = (pn & 3) * 256;
            if (seg == 4 || seg == 5) {
                PG8_GAS bf16_t* O = (seg == 4) ? QB : KB; const int head = (pn & 3) * 2 + (wc >> 1), i0 = (wc & 1) * 32 + 8 * fq;
#pragma unroll
                for (int ai = 0; ai < 2; ++ai)
#pragma unroll
                    for (int m = 0; m < 4; ++m) { const int row = row0 + ai * HALF + m * 16;
                        const PG8_GAS float* cp = cosh + (size_t)row * 64 + i0; const PG8_GAS float* sp = sinh + (size_t)row * 64 + i0;
                        const f32x4 c0 = *(const PG8_GAS f32x4*)cp, c1 = *(const PG8_GAS f32x4*)(cp + 4), s0 = *(const PG8_GAS f32x4*)sp, s1 = *(const PG8_GAS f32x4*)(sp + 4);
                        const f32x4 xa = acc[ai][0][m][0], xb = acc[ai][0][m][1], ya = acc[ai][1][m][0], yb = acc[ai][1][m][1];
                        PG8_GAS bf16_t* rp = O + (size_t)row * 1024 + head * 128 + i0;
                        *(PG8_GAS u32x4*)rp = pack8(xa * c0 - ya * s0, xb * c1 - yb * s1);
                        *(PG8_GAS u32x4*)(rp + 64) = pack8(xa * s0 + ya * c0, xb * s1 + yb * c1); asm volatile("" ::: "memory"); }
            } else if (seg == 7) {
                const int head = (pn & 3) * 4 + wc, i0 = 8 * fq;
#pragma unroll
                for (int ai = 0; ai < 2; ++ai)
#pragma unroll
                    for (int m = 0; m < 4; ++m) { const int row = row0 + ai * HALF + m * 16;
                        const PG8_GAS float* cp = cosi + (size_t)row * 32 + i0; const PG8_GAS float* sp = sini + (size_t)row * 32 + i0;
                        const f32x4 c0 = *(const PG8_GAS f32x4*)cp, c1 = *(const PG8_GAS f32x4*)(cp + 4), s0 = *(const PG8_GAS f32x4*)sp, s1 = *(const PG8_GAS f32x4*)(sp + 4);
                        const f32x4 xa = acc[ai][0][m][0], xb = acc[ai][0][m][1], ya = acc[ai][1][m][0], yb = acc[ai][1][m][1];
                        PG8_GAS bf16_t* rp = QI + (size_t)row * 1024 + head * 64 + i0;
                        *(PG8_GAS u32x4*)rp = pack8(xa * c0 - ya * s0, xb * c1 - yb * s1);
                        *(PG8_GAS u32x4*)(rp + 32) = pack8(xa * s0 + ya * c0, xb * s1 + yb * c1); asm volatile("" ::: "memory"); }
            } else if (seg == 1) {
#pragma unroll
                for (int bj = 0; bj < 2; ++bj) { const int col = cb + bj * HALF + cw;
                    const f32x4 l0 = *(const PG8_GAS f32x4*)(lb + col), l1 = *(const PG8_GAS f32x4*)(lb + col + 4);
#pragma unroll
                    for (int ai = 0; ai < 2; ++ai)
#pragma unroll
                        for (int m = 0; m < 4; ++m) { const int row = row0 + ai * HALF + m * 16; f32x4 lf[2], kk[2];
#pragma unroll
                            for (int n = 0; n < 2; ++n) { const f32x4 x = acc[ai][bj][m][n]; const f32x4 lv = n ? l1 : l0;
#pragma unroll
                                for (int j = 0; j < 4; ++j) { const float xe = fminf(fmaxf(x[j], -80.f), 80.f), e = __expf(-xe), r = __builtin_amdgcn_rcpf(1.0f + e);
                                    const float om = 1.0f - lv[j]; lf[n][j] = logf(lv[j] + om * r); kk[n][j] = om * (e * r); } }
                            PG8_GAS float* lp = LF + (size_t)row * 1024 + col; *(PG8_GAS f32x4*)lp = lf[0]; *(PG8_GAS f32x4*)(lp + 4) = lf[1];
                            *(PG8_GAS u32x4*)(KA + (size_t)row * 1024 + col) = pack8(kk[0], kk[1]); asm volatile("" ::: "memory"); } }
            } else {
                PG8_GAS bf16_t* O = (seg == 0) ? QA : (seg == 2) ? VA : (seg == 3) ? GA : VB; const bool act = (seg == 0 || seg == 3);
#pragma unroll
                for (int ai = 0; ai < 2; ++ai)
#pragma unroll
                    for (int m = 0; m < 4; ++m) { const int row = row0 + ai * HALF + m * 16;
#pragma unroll
                        for (int bj = 0; bj < 2; ++bj) { f32x4 v0 = acc[ai][bj][m][0], v1 = acc[ai][bj][m][1];
                            if (act) { v0 = silu4(v0); v1 = silu4(v1); }
                            *(PG8_GAS u32x4*)(O + (size_t)row * 1024 + cb + bj * HALF + cw) = pack8(v0, v1); } }
            }
        } else if (pn < 48) {
            PG8_GAS bf16_t* O = (pn < 40) ? SGA : SGB; const int cb = ((pn - 32) & 7) * 256;
#pragma unroll
            for (int ai = 0; ai < 2; ++ai)
#pragma unroll
                for (int m = 0; m < 4; ++m) { const int row = row0 + ai * HALF + m * 16;
#pragma unroll
                    for (int bj = 0; bj < 2; ++bj)
                        *(PG8_GAS u32x4*)(O + (size_t)row * DM + cb + bj * HALF + cw) = pack8(sigm4(acc[ai][bj][m][0]), sigm4(acc[ai][bj][m][1])); }
        } else {
#pragma unroll
            for (int ai = 0; ai < 2; ++ai)
#pragma unroll
                for (int m = 0; m < 4; ++m) { PG8_GAS float* p = IKW + (size_t)(row0 + ai * HALF + m * 16) * 128 + cw; *(PG8_GAS f32x4*)p = acc[ai][0][m][0]; *(PG8_GAS f32x4*)(p + 4) = acc[ai][0][m][1]; }
        }
    }
};
struct EpiGateA {
    static constexpr bool PERM = true, AFTER_DRAIN = false;
    unsigned char* ws;
    __device__ __forceinline__ void operator()(const f32x4 (&acc)[2][2][4][2], const Unit& u, int wr, int wc, int fr, int fq) const {
        unsigned char* const wg = as_global(ws); const bf16_t* const SG = (const bf16_t*)(wg + WS_SGA); float* const AF = (float*)(wg + WS_XPRE);
        const int row0 = u.pm * BM + wr * 64 + fr, col0 = u.pn * BM + wc * 32 + 8 * fq;
#pragma unroll
        for (int ai = 0; ai < 2; ++ai)
#pragma unroll
            for (int m = 0; m < 4; ++m) { const size_t off = (size_t)(row0 + ai * HALF + m * 16) * DM + col0;
#pragma unroll
                for (int bj = 0; bj < 2; ++bj) { f32x4 g0, g1; unpack8(*(const u32x4*)(SG + off + bj * HALF), g0, g1);
                    float* p = AF + off + bj * HALF; *(f32x4*)p = g0 * acc[ai][bj][m][0]; *(f32x4*)(p + 4) = g1 * acc[ai][bj][m][1]; } asm volatile("" ::: "memory"); }
    }
};
struct EpiGateB {
    static constexpr bool PERM = true, AFTER_DRAIN = false;
    unsigned char* ws;
    __device__ __forceinline__ void operator()(const f32x4 (&acc)[2][2][4][2], const Unit& u, int wr, int wc, int fr, int fq) const {
        unsigned char* const wg = as_global(ws); const bf16_t* const SG = (const bf16_t*)(wg + WS_SGB); const float* const AF = (const float*)(wg + WS_XPRE); bf16_t* const MG = (bf16_t*)(wg + WS_MG);
        const int row0 = u.pm * BM + wr * 64 + fr, col0 = u.pn * BM + wc * 32 + 8 * fq;
#pragma unroll
        for (int ai = 0; ai < 2; ++ai)
#pragma unroll
            for (int m = 0; m < 4; ++m) { const size_t off = (size_t)(row0 + ai * HALF + m * 16) * DM + col0;
#pragma unroll
                for (int bj = 0; bj < 2; ++bj) { f32x4 g0, g1; unpack8(*(const u32x4*)(SG + off + bj * HALF), g0, g1);
                    const float* p = AF + off + bj * HALF; const f32x4 a0 = *(const f32x4*)p, a1 = *(const f32x4*)(p + 4);
                    *(u32x4*)(MG + off + bj * HALF) = pack8(a0 + g0 * acc[ai][bj][m][0], a1 + g1 * acc[ai][bj][m][1]); } asm volatile("" ::: "memory"); }
    }
};
struct EpiRes {
    static constexpr bool PERM = true, AFTER_DRAIN = false;
    const float* X; unsigned char* ws;
    __device__ __forceinline__ void operator()(const f32x4 (&acc)[2][2][4][2], const Unit& u, int wr, int wc, int fr, int fq) const {
        float* const XP = (float*)(as_global(ws) + WS_XPRE); const float* const Xg = as_global(X);
        const int row0 = u.pm * BM + wr * 64 + fr, col0 = u.pn * BM + wc * 32 + 8 * fq;
#pragma unroll
        for (int ai = 0; ai < 2; ++ai)
#pragma unroll
            for (int m = 0; m < 4; ++m) { const size_t off = (size_t)(row0 + ai * HALF + m * 16) * DM + col0;
#pragma unroll
                for (int bj = 0; bj < 2; ++bj) { const float* xp = Xg + off + bj * HALF; const f32x4 x0 = *(const f32x4*)xp, x1 = *(const f32x4*)(xp + 4);
                    float* p = XP + off + bj * HALF; *(f32x4*)p = x0 * ALPHA + acc[ai][bj][m][0]; *(f32x4*)(p + 4) = x1 * ALPHA + acc[ai][bj][m][1]; } asm volatile("" ::: "memory"); }
    }
};
struct EpiSwiGLU {
    static constexpr bool PERM = true, AFTER_DRAIN = false;
    unsigned char* ws;
    __device__ __forceinline__ void operator()(const f32x4 (&acc)[2][2][4][2], const Unit& u, int wr, int wc, int fr, int fq) const {
        bf16_t* const H = (bf16_t*)(as_global(ws) + WS_H);
        const int row0 = u.pm * BM + wr * 64 + fr, col0 = u.pn * HALF + wc * 32 + 8 * fq;
#pragma unroll
        for (int ai = 0; ai < 2; ++ai)
#pragma unroll
            for (int m = 0; m < 4; ++m)
                *(u32x4*)(H + (size_t)(row0 + ai * HALF + m * 16) * DFF + col0) = pack8(silu4(acc[ai][0][m][0]) * acc[ai][1][m][0], silu4(acc[ai][0][m][1]) * acc[ai][1][m][1]);
    }
};
struct EpiF32P {
    static constexpr bool PERM = true, AFTER_DRAIN = false;
    unsigned char* ws;
    __device__ __forceinline__ void operator()(const f32x4 (&acc)[2][2][4][2], const Unit& u, int wr, int wc, int fr, int fq) const {
        float* const C = (float*)(as_global(ws) + WS_PP);
        const int row0 = u.pm * BM + wr * 64 + fr, col0 = u.pn * BM + wc * 32 + 8 * fq;
#pragma unroll
        for (int ai = 0; ai < 2; ++ai)
#pragma unroll
            for (int m = 0; m < 4; ++m) { const size_t off = (size_t)(row0 + ai * HALF + m * 16) * DM + col0;
#pragma unroll
                for (int bj = 0; bj < 2; ++bj) { float* p = C + off + bj * HALF; *(f32x4*)p = acc[ai][bj][m][0]; *(f32x4*)(p + 4) = acc[ai][bj][m][1]; } }
    }
};
struct EpiPle {
    static constexpr bool PERM = true, AFTER_DRAIN = false;
    unsigned char* ws;
    __device__ __forceinline__ void operator()(const f32x4 (&acc)[2][2][4][2], const Unit& u, int wr, int wc, int fr, int fq) const {
        const float* const X = (const float*)(ws + WS_X32); const float* const PP = (const float*)(ws + WS_PP); float* const XP = (float*)(as_global(ws) + WS_XPRE); const float* const Xg = as_global(X);
        const int row0 = u.pm * BM + wr * 64 + fr, col0 = u.pn * BM + wc * 32 + 8 * fq;
#pragma unroll
        for (int ai = 0; ai < 2; ++ai)
#pragma unroll
            for (int m = 0; m < 4; ++m) { const size_t off = (size_t)(row0 + ai * HALF + m * 16) * DM + col0;
#pragma unroll
                for (int bj = 0; bj < 2; ++bj) { const float* xp = Xg + off + bj * HALF; const f32x4 x0 = *(const f32x4*)xp, x1 = *(const f32x4*)(xp + 4);
                    const float* pp = PP + off + bj * HALF; const f32x4 p0 = *(const f32x4*)pp, p1 = *(const f32x4*)(pp + 4);
                    float* p = XP + off + bj * HALF; *(f32x4*)p = x0 * ALPHA + sigm4(acc[ai][bj][m][0]) * p0; *(f32x4*)(p + 4) = x1 * ALPHA + sigm4(acc[ai][bj][m][1]) * p1; } asm volatile("" ::: "memory"); }
    }
};

struct EpiRawTest {
    static constexpr bool PERM = true, AFTER_DRAIN = false;
    unsigned char* ws;
    __device__ __forceinline__ void operator()(const f32x4 (&acc)[2][2][4][2], const Unit& u, int wr, int wc, int fr, int fq) const {
        bf16_t* const H = (bf16_t*)(as_global(ws) + WS_H);
        const int row0 = u.pm * BM + wr * 64 + fr, col0 = u.pn * HALF + wc * 32 + 8 * fq;
#pragma unroll
        for (int ai = 0; ai < 2; ++ai)
#pragma unroll
            for (int m = 0; m < 4; ++m)
                *(u32x4*)(H + (size_t)(row0 + ai * HALF + m * 16) * 6272 + col0) = pack8(acc[ai][0][m][0] + acc[ai][1][m][0], acc[ai][0][m][1] + acc[ai][1][m][1]);
    }
};
template <class Epi, class Sched, bool ALIGN_EPI = false, bool SP2 = false>
__device__ __forceinline__ void gemm_phase(PG8_LAS unsigned char* lds, const Gemm g, const Sched& S, const Epi& E) {
    const int tid = tid_(), wid = __builtin_amdgcn_readfirstlane(tid >> 6), lane = tid & 63, wr = wid >> 2, wc = wid & 3, fr = lane & 15, fq = lane >> 4;
    int Kq = g.K; asm volatile("" : "+s"(Kq)); const int K = Kq, nt = K / BK;
    unsigned voffA[2], voffB[2];
#pragma unroll
    for (int i = 0; i < 2; ++i) { int R, C; stage_rc(tid * 16 + i * 8192, R, C); const int Rb = Epi::PERM ? ((R & ~31) + perm32(R & 31)) : R;
        voffA[i] = (unsigned)(R * K + C) * 2u; voffB[i] = (unsigned)(Rb * K + C) * 2u; }
    const size_t kstep = (size_t)(BK * 2);
    const size_t hstep = (size_t)HALF * K * 2;
    const size_t tstep = 2 * hstep;
    const unsigned ldsw = (unsigned)wid * 1024u;
    const int aoff = lds_byte(wr * 64 + fr, fq * 8), boff = lds_byte(wc * 32 + fr, fq * 8);
#define PG8_SA(b, h) (((b) * 2 + (h)) * HTB)
#define PG8_SB(b, h) ((4 + (b) * 2 + (h)) * HTB)
#define PG8_STAGE(bufoff, gbase, voff) do { _Pragma("unroll") for (int _i = 0; _i < 2; ++_i) \
        __builtin_amdgcn_global_load_lds((const unsigned*)((const char*)(gbase) + (voff)[_i]), (PG8_LAS unsigned*)(lds + (bufoff) + ldsw + _i * 8192), 16, 0, 0); } while (0)
#define PG8_LDA(dst, b, h) do { _Pragma("unroll") for (int m = 0; m < 4; ++m) _Pragma("unroll") for (int k = 0; k < 2; ++k) dst[m][k] = *(const PG8_LAS bf16x8*)(lds + PG8_SA(b, h) + aoff + m * 2048 + k * 1024); } while (0)
#define PG8_LDB(dst, b, h) do { _Pragma("unroll") for (int n = 0; n < 2; ++n) _Pragma("unroll") for (int k = 0; k < 2; ++k) dst[n][k] = *(const PG8_LAS bf16x8*)(lds + PG8_SB(b, h) + boff + n * 2048 + k * 1024); } while (0)
#define PG8_MMA(ai, bj, At, Bt) do { __builtin_amdgcn_s_setprio(1); _Pragma("unroll") for (int m = 0; m < 4; ++m) _Pragma("unroll") for (int n = 0; n < 2; ++n) _Pragma("unroll") for (int k = 0; k < 2; ++k) \
        acc[ai][bj][m][n] = __builtin_amdgcn_mfma_f32_16x16x32_bf16(Bt[n][k], At[m][k], acc[ai][bj][m][n], 0, 0, 0); __builtin_amdgcn_s_setprio(0); } while (0)
#define PG8_WAIT_V(n) asm volatile("s_waitcnt vmcnt(" #n ")" ::: "memory")
#define PG8_WAIT_L(n) asm volatile("s_waitcnt lgkmcnt(" #n ")" ::: "memory")
#define PG8_BAR __builtin_amdgcn_s_barrier()
#define PG8_SCHED __builtin_amdgcn_sched_barrier(0)
    Unit cur, nxt; int ui = 0;
    if (!S.next(0, cur)) return;
    f32x4 acc[2][2][4][2];
#pragma unroll
    for (int a = 0; a < 2; ++a)
#pragma unroll
        for (int b = 0; b < 2; ++b)
#pragma unroll
            for (int m = 0; m < 4; ++m)
#pragma unroll
                for (int n = 0; n < 2; ++n) acc[a][b][m][n] = (f32x4){0.f, 0.f, 0.f, 0.f};
    bf16x8 At[4][2], B0[2][2], B1[2][2];
    const char* cA = (const char*)g.A + (size_t)cur.pm * tstep; const char* cB = (const char*)g.Bt + (size_t)cur.pn * tstep;
    S.a_ready(cur);
    if constexpr (SP2) {
        PG8_STAGE(PG8_SB(0, 0), cB, voffB); PG8_STAGE(PG8_SB(0, 1), cB + hstep, voffB); PG8_STAGE(PG8_SA(0, 0), cA, voffA); PG8_STAGE(PG8_SA(0, 1), cA + hstep, voffA);
        if (wr == 1) PG8_BAR;
        PG8_WAIT_V(2); PG8_BAR;
        PG8_STAGE(PG8_SB(1, 0), cB + kstep, voffB); PG8_STAGE(PG8_SA(1, 0), cA + kstep, voffA); PG8_STAGE(PG8_SB(1, 1), cB + hstep + kstep, voffB);
        PG8_WAIT_V(6); PG8_BAR;
    } else {
        PG8_STAGE(PG8_SB(0, 0), cB, voffB); PG8_STAGE(PG8_SA(0, 0), cA, voffA); PG8_STAGE(PG8_SB(0, 1), cB + hstep, voffB); PG8_STAGE(PG8_SA(0, 1), cA + hstep, voffA);
        if (wr == 1) PG8_BAR;
        PG8_WAIT_V(4); PG8_BAR;
        PG8_STAGE(PG8_SB(1, 0), cB + kstep, voffB); PG8_STAGE(PG8_SA(1, 0), cA + kstep, voffA); PG8_STAGE(PG8_SB(1, 1), cB + hstep + kstep, voffB);
        PG8_WAIT_V(6); PG8_BAR;
    }
    for (;;) {
        const bool has_next = S.next(ui + 1, nxt);
        const char* nA = has_next ? (const char*)g.A + (size_t)nxt.pm * tstep : cA; const char* nB = has_next ? (const char*)g.Bt + (size_t)nxt.pn * tstep : cB;
        for (int t = 0; t < nt; t += 2) {
            const bool last = (t == nt - 2);
            const char* a1 = cA + (size_t)(t + 1) * kstep;
            const char* a2 = last ? nA : cA + (size_t)(t + 2) * kstep; const char* b2 = last ? nB : cB + (size_t)(t + 2) * kstep;
            const char* a3 = a2 + kstep; const char* b3 = b2 + kstep;
            if (last && has_next) S.a_ready(nxt);
            if constexpr (SP2) {
            PG8_LDB(B0, 0, 0); PG8_LDB(B1, 0, 1); PG8_SCHED; PG8_LDA(At, 0, 0); PG8_STAGE(PG8_SA(1, 1), a1 + hstep, voffA);
            PG8_WAIT_V(8); PG8_WAIT_L(0); PG8_BAR; PG8_MMA(0, 0, At, B0); PG8_MMA(0, 1, At, B1); PG8_BAR; PG8_SCHED;
            PG8_LDA(At, 0, 1); PG8_STAGE(PG8_SB(0, 0), b2, voffB); PG8_STAGE(PG8_SB(0, 1), b2 + hstep, voffB); PG8_STAGE(PG8_SA(0, 0), a2, voffA);
            PG8_WAIT_V(8); PG8_WAIT_L(0); PG8_BAR; PG8_MMA(1, 0, At, B0); PG8_MMA(1, 1, At, B1); PG8_BAR; PG8_SCHED;
            PG8_LDB(B0, 1, 0); PG8_LDB(B1, 1, 1); PG8_SCHED; PG8_LDA(At, 1, 0); PG8_STAGE(PG8_SA(0, 1), a2 + hstep, voffA);
            PG8_WAIT_V(8); PG8_WAIT_L(0); PG8_BAR; PG8_MMA(0, 0, At, B0); PG8_MMA(0, 1, At, B1); PG8_BAR; PG8_SCHED;
            PG8_LDA(At, 1, 1); PG8_STAGE(PG8_SB(1, 0), b3, voffB); PG8_STAGE(PG8_SB(1, 1), b3 + hstep, voffB); PG8_STAGE(PG8_SA(1, 0), a3, voffA);
            PG8_WAIT_V(8); PG8_WAIT_L(0); PG8_BAR; PG8_MMA(1, 0, At, B0); PG8_MMA(1, 1, At, B1); PG8_BAR; PG8_SCHED;
            } else {
            PG8_LDB(B0, 0, 0); PG8_SCHED; PG8_LDA(At, 0, 0); PG8_STAGE(PG8_SA(1, 1), a1 + hstep, voffA);
            PG8_WAIT_L(8); PG8_BAR; PG8_WAIT_L(0); PG8_MMA(0, 0, At, B0); PG8_BAR; PG8_SCHED;
            PG8_LDB(B1, 0, 1); PG8_STAGE(PG8_SB(0, 0), b2, voffB);
            PG8_BAR; PG8_WAIT_L(0); PG8_MMA(0, 1, At, B1); PG8_BAR;
            PG8_LDA(At, 0, 1); PG8_STAGE(PG8_SA(0, 0), a2, voffA);
            PG8_BAR; PG8_WAIT_L(0); PG8_MMA(1, 0, At, B0); PG8_BAR; PG8_SCHED;
            PG8_STAGE(PG8_SB(0, 1), b2 + hstep, voffB);
            PG8_WAIT_V(6); PG8_BAR; PG8_MMA(1, 1, At, B1); PG8_BAR;
            PG8_LDB(B0, 1, 0); PG8_SCHED; PG8_LDA(At, 1, 0); PG8_STAGE(PG8_SA(0, 1), a2 + hstep, voffA);
            PG8_WAIT_L(8); PG8_BAR; PG8_WAIT_L(0); PG8_MMA(0, 0, At, B0); PG8_BAR; PG8_SCHED;
            PG8_LDB(B1, 1, 1); PG8_STAGE(PG8_SB(1, 0), b3, voffB);
            PG8_BAR; PG8_WAIT_L(0); PG8_MMA(0, 1, At, B1); PG8_BAR;
            PG8_LDA(At, 1, 1); PG8_STAGE(PG8_SA(1, 0), a3, voffA);
            PG8_BAR; PG8_WAIT_L(0); PG8_MMA(1, 0, At, B0); PG8_BAR; PG8_SCHED;
            PG8_STAGE(PG8_SB(1, 1), b3 + hstep, voffB);
            PG8_WAIT_V(6); PG8_BAR; PG8_MMA(1, 1, At, B1); PG8_BAR;
            }
        }
        if constexpr (ALIGN_EPI) { if (wr == 0) PG8_BAR; }
        if constexpr (!Epi::AFTER_DRAIN) { E(acc, cur, wr, wc, fr, fq); S.done(cur); }
        if (!has_next) break;
#pragma unroll
        for (int a = 0; a < 2; ++a)
#pragma unroll
            for (int b = 0; b < 2; ++b)
#pragma unroll
                for (int m = 0; m < 4; ++m)
#pragma unroll
                    for (int n = 0; n < 2; ++n) acc[a][b][m][n] = (f32x4){0.f, 0.f, 0.f, 0.f};
        cur = nxt; cA = nA; cB = nB; ++ui;
        if constexpr (ALIGN_EPI) { if (wr == 1) PG8_BAR; }
    }
    PG8_WAIT_V(0);
    if constexpr (!ALIGN_EPI) { if (wr == 0) PG8_BAR; }
    PG8_BAR;
    if constexpr (Epi::AFTER_DRAIN) { E.fused(acc, cur, wr, wc, fr, fq, lds, wid, lane); S.done(cur); }
#undef PG8_SA
#undef PG8_SB
#undef PG8_STAGE
#undef PG8_LDA
#undef PG8_LDB
#undef PG8_MMA
#undef PG8_WAIT_V
#undef PG8_WAIT_L
#undef PG8_BAR
#undef PG8_SCHED
}
}
#define XB_TMO      128
#define XB_XCNT(j)  (256  + 64 * (j))
#define XB_XSUB(j)  (1280 + 64 * (j))
#define XB_XGEN(j)  (2304 + 64 * (j))
#define XB_TOP      3328
#define XB_TOPGEN   3392
#define XCD_BAR_WORDS 3456
#define XB_SPIN_CAP (1u << 18)
#define LAS __attribute__((address_space(3)))

__device__ __forceinline__ unsigned xb_ld(unsigned* p)              { return __hip_atomic_load(p, __ATOMIC_RELAXED, __HIP_MEMORY_SCOPE_AGENT); }
__device__ __forceinline__ unsigned xb_add(unsigned* p, unsigned v) { return __hip_atomic_fetch_add(p, v, __ATOMIC_RELAXED, __HIP_MEMORY_SCOPE_AGENT); }
__device__ __forceinline__ unsigned xb_xcc_id() { return (unsigned)__builtin_amdgcn_s_getreg((3 << 11) | 20) & 0xFu; }
#define XB_SPIN(cond, bar) do { unsigned _sp = 0; while (cond) { __builtin_amdgcn_s_sleep(1); \
    if ((++_sp & 255u) == 0u) { if (xb_ld(&(bar)[XB_TMO])) break; if (_sp > XB_SPIN_CAP) { atomicAdd(&(bar)[XB_TMO], 1u); break; } } } } while (0)

struct XcdBarrier {
    unsigned* bar; unsigned x;
    volatile LAS unsigned* st;
};

__device__ __forceinline__ XcdBarrier xcd_barrier_post(unsigned* bar, volatile LAS unsigned* st) {
    XcdBarrier b; b.bar = bar; b.x = xb_xcc_id(); b.st = st;
    if (threadIdx.x == 0) (void)xb_add(&bar[XB_XCNT(b.x)], 1u);
    return b;
}
__device__ __forceinline__ void xcd_barrier_complete(unsigned* bar, unsigned x, unsigned& nloc, unsigned& nx) {
    const unsigned G = gridDim.x * gridDim.y * gridDim.z;
    unsigned sum, cnt, mine, sp = 0u;
    for (;;) {
        sum = 0u; cnt = 0u; mine = 0u;
#pragma unroll
        for (unsigned j = 0; j < 16; ++j) { const unsigned c = xb_ld(&bar[XB_XCNT(j)]); sum += c; cnt += (c > 0u) ? 1u : 0u; mine = (j == x) ? c : mine; }
        if (sum == G) break;
        __builtin_amdgcn_s_sleep(1);
        if ((++sp & 255u) == 0u) { if (xb_ld(&bar[XB_TMO])) break; if (sp > XB_SPIN_CAP) { atomicAdd(&bar[XB_TMO], 1u); break; } }
    }
    nloc = mine > 0u ? mine : 1u; nx = cnt > 0u ? cnt : 1u;
}

__device__ __forceinline__ void xcd_barrier(const XcdBarrier& b) {
    asm volatile("s_waitcnt vmcnt(0)" ::: "memory");
    __syncthreads();
    if (threadIdx.x == 0) {
        unsigned* bar = b.bar;
        __builtin_amdgcn_s_waitcnt(0);
        const unsigned bx = xb_xcc_id();
        unsigned nloc = b.st[0], nx = b.st[1];
        if (nloc == 0u) { xcd_barrier_complete(bar, bx, nloc, nx); b.st[0] = nloc; b.st[1] = nx; }
        const unsigned old = xb_add(&bar[XB_XSUB(bx)], 1u);
        const unsigned gen = old / nloc;
        if (old + 1u == (gen + 1u) * nloc) {
            __builtin_amdgcn_fence(__ATOMIC_RELEASE, "agent");
            asm volatile("s_waitcnt vmcnt(0)" ::: "memory");
            const unsigned og = xb_add(&bar[XB_TOP], 1u);
            const unsigned tg = og / nx;
            if (og + 1u == (tg + 1u) * nx) xb_add(&bar[XB_TOPGEN], 1u);
            else XB_SPIN(xb_ld(&bar[XB_TOPGEN]) == tg, bar);
            __builtin_amdgcn_fence(__ATOMIC_ACQUIRE, "agent");
            xb_add(&bar[XB_XGEN(bx)], 1u);
            asm volatile("s_waitcnt vmcnt(0)" ::: "memory");
        } else {
            XB_SPIN(xb_ld(&bar[XB_XGEN(bx)]) == gen, bar);
            __builtin_amdgcn_fence(__ATOMIC_ACQUIRE, "agent");
            asm volatile("s_waitcnt vmcnt(0)" ::: "memory");
        }
    }
    __syncthreads();
}

struct Params {
    const float* x; const float* p; const int* pos;
    const float *w_in, *w_a, *w_b, *w_out, *lbraw, *hnorm_g, *ikn_g, *ikn_b, *lnm_g, *lnm_b, *w_fg, *w_fu, *w_fd, *lnf_g, *lnf_b, *w_pg, *w_pp, *lnp_g, *lnp_b;
    float* out; unsigned char* ws;
    double invf_h[64]; double invf_i[32];
    int ph_lo, ph_hi;
};
typedef const __attribute__((address_space(4))) Params* KP;
__device__ __forceinline__ KP kparams() { KP p = (KP)__builtin_amdgcn_kernarg_segment_ptr(); asm volatile("" : "+s"(p)); return p; }
constexpr int NPH_LAYER = 14, NPH = DEPTH * NPH_LAYER;
constexpr int LDS_BYTES = 131072 + 1024;
constexpr int MISC_OFF = 131072;

__device__ __forceinline__ int wsrc_col_in(int n) {
    const int tile = n >> 8, t = n & 255;
    if (tile < 16) return n;
    if (tile < 24) { const int bj = t >> 7, u = t & 127, head = u >> 6, i = u & 63; return tile * 256 + 128 * head + 64 * bj + i; }
    if (tile < 28) return n;
    if (tile < 32) { const int bj = t >> 7, u = t & 127, head = u >> 5, i = u & 31; return tile * 256 + 64 * head + 32 * bj + i; }
    if (tile < 40) return 8272 + (n - 32 * 256);
    if (tile < 48) return 10320 + (n - 40 * 256);
    return t < 80 ? 8192 + t : -1;
}
template <int KIND>
__device__ __forceinline__ void wconv_tile(const float* src, const float* src2, int nsrc, int K, bf16_t* dst, int n0, int k0, LAS float* tile) {
    const int tid = tid_(), nn = tid & 31, kk0 = tid >> 5;
    int c; const float* s = src;
    if (KIND == 0) c = n0 + nn;
    else if (KIND == 1) c = wsrc_col_in(n0 + nn);
    else { const int n = n0 + nn, tl = n >> 8, t = n & 255; c = tl * 128 + (t & 127); if (t >= 128) s = src2; }
#pragma unroll
    for (int r = 0; r < 8; ++r) { const int kk = kk0 + 16 * r; tile[kk * 33 + nn] = (c >= 0) ? s[(size_t)(k0 + kk) * nsrc + c] : 0.f; }
    __syncthreads();
    const int n = tid >> 4, k8 = (tid & 15) * 8;
    pg8::f32x4 a, b;
#pragma unroll
    for (int j = 0; j < 4; ++j) { a[j] = tile[(k8 + j) * 33 + n]; b[j] = tile[(k8 + 4 + j) * 33 + n]; }
    *(pg8::u32x4*)(dst + (size_t)(n0 + n) * K + k0 + k8) = pg8::pack8(a, b);
    __syncthreads();
}
template <int KIND>
__device__ __forceinline__ void wconv_job(const float* src, const float* src2, int nsrc, int K, bf16_t* dst, int ndst, LAS float* tile, int& tcount) {
    const int kt = K / 128, ntiles = (ndst / 32) * kt;
    const int G = nblk_(); int first = (bid_() - tcount % G + G) % G;
    for (int t = first; t < ntiles; t += G) wconv_tile<KIND>(src, src2, nsrc, K, dst, (t / kt) * 32, (t % kt) * 128, tile);
    tcount += ntiles;
}
__device__ __forceinline__ void phase_wconv(KP P, int layer, LAS float* tile) {
    unsigned char* ws = as_global(P->ws); int tc = 0;
    wconv_job<1>(as_global(P->w_in) + (size_t)layer * DM * INW, nullptr, INW, DM, (bf16_t*)(ws + WS_WIN), INP, tile, tc);
    wconv_job<0>(as_global(P->w_a) + (size_t)layer * AW * DM, nullptr, DM, AW, (bf16_t*)(ws + WS_WA), DM, tile, tc);
    wconv_job<0>(as_global(P->w_b) + (size_t)layer * BW * DM, nullptr, DM, BW, (bf16_t*)(ws + WS_WB), DM, tile, tc);
    wconv_job<0>(as_global(P->w_out) + (size_t)layer * DM * DM, nullptr, DM, DM, (bf16_t*)(ws + WS_WO), DM, tile, tc);
    wconv_job<2>(as_global(P->w_fg) + (size_t)layer * DM * DFF, as_global(P->w_fu) + (size_t)layer * DM * DFF, DFF, DM, (bf16_t*)(ws + WS_WGU), 2 * DFF, tile, tc);
    wconv_job<0>(as_global(P->w_fd) + (size_t)layer * DFF * DM, nullptr, DM, DFF, (bf16_t*)(ws + WS_WDN), DM, tile, tc);
    wconv_job<0>(as_global(P->w_pg) + (size_t)layer * DM * DM, nullptr, DM, DM, (bf16_t*)(ws + WS_WPG), DM, tile, tc);
    wconv_job<0>(as_global(P->w_pp) + (size_t)layer * PLE * DM, nullptr, DM, PLE, (bf16_t*)(ws + WS_WPP), DM, tile, tc);
    const float* ps = as_global(P->p) + (size_t)layer * TOK * PLE; bf16_t* pb = (bf16_t*)(ws + WS_PB);
    for (size_t i = ((size_t)bid_() * 512 + tid_()) * 8; i < (size_t)TOK * PLE; i += (size_t)nblk_() * 512 * 8)
        *(pg8::u32x4*)(pb + i) = pg8::pack8(*(const pg8::f32x4*)(ps + i), *(const pg8::f32x4*)(ps + i + 4));
}
__device__ __forceinline__ void phase_prologue(KP P) {
    unsigned char* ws = as_global(P->ws); const size_t gtid = (size_t)bid_() * 512 + tid_(), gsz = (size_t)nblk_() * 512;
    bf16_t* xb = (bf16_t*)(ws + WS_XB); const float* xin = as_global(P->x); const int* posg = as_global(P->pos); const float* lbr = as_global(P->lbraw);
    for (size_t i = gtid * 8; i < (size_t)TOK * DM; i += gsz * 8) *(pg8::u32x4*)(xb + i) = pg8::pack8(*(const pg8::f32x4*)(xin + i), *(const pg8::f32x4*)(xin + i + 4));
    float* ch = (float*)(ws + WS_COSH); float* sh = (float*)(ws + WS_SINH); float* ci = (float*)(ws + WS_COSI); float* si = (float*)(ws + WS_SINI);
    for (size_t i = gtid; i < (size_t)TOK * 64; i += gsz) { const int t = (int)(i >> 6), j = (int)(i & 63); const double rev = (double)posg[t] * P->invf_h[j]; const float fr = (float)(rev - rint(rev));
        ch[i] = __builtin_amdgcn_cosf(fr); sh[i] = __builtin_amdgcn_sinf(fr); }
    for (size_t i = gtid; i < (size_t)TOK * 32; i += gsz) { const int t = (int)(i >> 5), j = (int)(i & 31); const double rev = (double)posg[t] * P->invf_i[j]; const float fr = (float)(rev - rint(rev));
        ci[i] = __builtin_amdgcn_cosf(fr); si[i] = __builtin_amdgcn_sinf(fr); }
    float* lb = (float*)(ws + WS_LB);
    for (size_t c = gtid; c < 1024; c += gsz) { float v[4], mx = -1e30f; for (int l = 0; l < 4; ++l) { v[l] = lbr[l * 1024 + c]; mx = fmaxf(mx, v[l]); }
        float s = 0.f; for (int l = 0; l < 4; ++l) { v[l] = expf(v[l] - mx); s += v[l]; }
        float cum = 0.f; const float inv = 1.0f / s; for (int l = 0; l < 4; ++l) { cum += v[l] * inv; lb[l * 1024 + c] = cum - v[0] * inv; } }
}
__device__ __forceinline__ void phase_ln(const float* XP, float* X32, bf16_t* XB, const float* g, const float* b) {
    const int tid = tid_(), wave = tid >> 6, lane = tid & 63, nb8 = nblk_() * 8;
    for (int row = bid_() * 8 + wave; row < TOK; row += nb8) {
        const float* xp = XP + (size_t)row * DM; pg8::f32x4 v[8]; float s = 0.f;
#pragma unroll
        for (int c = 0; c < 8; ++c) { v[c] = *(const pg8::f32x4*)(xp + c * 256 + lane * 4); s += (v[c][0] + v[c][1]) + (v[c][2] + v[c][3]); }
#pragma unroll
        for (int o = 32; o >= 1; o >>= 1) s += __shfl_xor(s, o);
        const float mean = s * (1.0f / DM); float q = 0.f;
#pragma unroll
        for (int c = 0; c < 8; ++c) { v[c] = v[c] - mean; q += (v[c][0] * v[c][0] + v[c][1] * v[c][1]) + (v[c][2] * v[c][2] + v[c][3] * v[c][3]); }
#pragma unroll
        for (int o = 32; o >= 1; o >>= 1) q += __shfl_xor(q, o);
        const float rstd = 1.0f / sqrtf(q * (1.0f / DM) + LN_EPS);
#pragma unroll
        for (int c = 0; c < 8; ++c) { const int col = c * 256 + lane * 4; const pg8::f32x4 gg = *(const pg8::f32x4*)(g + col), bb = *(const pg8::f32x4*)(b + col);
            const pg8::f32x4 y = v[c] * rstd * gg + bb; *(pg8::f32x4*)(X32 + (size_t)row * DM + col) = y;
            pg8::u32x2 w; w.x = pg8::cvt_pk_bf16(y[0], y[1]); w.y = pg8::cvt_pk_bf16(y[2], y[3]); *(pg8::u32x2*)(XB + (size_t)row * DM + col) = w; }
    }
}
__device__ __forceinline__ void phase_ikprep(KP P, int layer) {
    unsigned char* ws = as_global(P->ws); const float* ikw = (const float*)(ws + WS_IKW); bf16_t* ki = (bf16_t*)(ws + WS_KI); float* wi = (float*)(ws + WS_WI);
    const float* ci = (const float*)(ws + WS_COSI); const float* si = (const float*)(ws + WS_SINI);
    const int tid = tid_(), wave = tid >> 6, lane = tid & 63, nb8 = nblk_() * 8;
    const float g = as_global(P->ikn_g)[layer * 64 + lane], b = as_global(P->ikn_b)[layer * 64 + lane];
    for (int t = bid_() * 8 + wave; t < TOK; t += nb8) {
        const float x = ikw[(size_t)t * 128 + lane]; float s = x;
#pragma unroll
        for (int o = 32; o >= 1; o >>= 1) s += __shfl_xor(s, o);
        const float mean = s * (1.0f / 64.0f), xc = x - mean; float q = xc * xc;
#pragma unroll
        for (int o = 32; o >= 1; o >>= 1) q += __shfl_xor(q, o);
        const float y = xc * (1.0f / sqrtf(q * (1.0f / 64.0f) + LN_EPS)) * g + b;
        const float other = __shfl_xor(y, 32); const int j = lane & 31; const float c = ci[(size_t)t * 32 + j], sn = si[(size_t)t * 32 + j];
        const float r = (lane < 32) ? (y * c - other * sn) : (other * sn + y * c);
        ki[(size_t)t * 64 + lane] = f2bf(r);
        if (lane < 16) wi[(size_t)t * 16 + lane] = ikw[(size_t)t * 128 + 64 + lane] * IDX_SCALE;
    }
}
typedef short bf16x8_t __attribute__((ext_vector_type(8)));
typedef short bf16x4_t __attribute__((ext_vector_type(4)));
typedef float f32x16_t __attribute__((ext_vector_type(16)));
constexpr int CUM_LD = 132;
constexpr int OPK_LD = 136;
constexpr int OPS_LD = 72;

__device__ __forceinline__ void hgrn_scan_cum(const float* LF, int tok0, int h, LAS float* cum, LAS float* tot, int tid) {
    const int k = tid & 127, qd = tid >> 7; float v[16];
#pragma unroll
    for (int i = 0; i < 16; ++i) v[i] = LF[(size_t)(tok0 + qd * 16 + i) * 1024 + h * 128 + k];
    float run = 0.f;
#pragma unroll
    for (int i = 0; i < 16; ++i) { run += v[i]; v[i] = run; }
    tot[qd * 128 + k] = run;
    __syncthreads();
    float off = 0.f;
#pragma unroll
    for (int q = 0; q < 3; ++q) off += (q < qd) ? tot[q * 128 + k] : 0.f;
#pragma unroll
    for (int i = 0; i < 16; ++i) cum[(qd * 16 + i) * CUM_LD + k] = v[i] + off;
    __syncthreads();
}

__device__ __forceinline__ void phase_hgrn_h1(KP P, LAS unsigned char* lds) {
    unsigned char* ws = as_global(P->ws);
    const bf16_t* KA = (const bf16_t*)(ws + WS_KA); const bf16_t* VA = (const bf16_t*)(ws + WS_VA); const float* LF = (const float*)(ws + WS_LF);
    float* LT = (float*)(ws + WS_LT); float* DEC = (float*)(ws + WS_DEC);
    const int tid = tid_(), lane = tid & 63, wave = tid >> 6, r = lane & 31, hh = lane >> 5, G = nblk_();
    LAS float* cum = (LAS float*)lds; LAS float* tot = cum + 64 * CUM_LD;
    LAS bf16_t* kdT = (LAS bf16_t*)(tot + 512); LAS bf16_t* vT = kdT + 128 * OPS_LD;
    for (int unit = bid_(); unit < NBATCH * AH * 64; unit += G) {
        const int c = unit & 63, h = (unit >> 6) & 7, b = unit >> 9, tok0 = b * SEQ + c * 64;
        hgrn_scan_cum(LF, tok0, h, cum, tot, tid);
#pragma unroll
        for (int it = 0; it < 8; ++it) { const int idx = tid + 512 * it, k = idx & 127, sp = idx >> 7, s = 2 * sp;
            const float last = cum[63 * CUM_LD + k];
            const size_t g0 = (size_t)(tok0 + s) * 1024 + h * 128 + k;
            const float k0 = bf2f(KA[g0]) * __expf(last - cum[s * CUM_LD + k]), k1 = bf2f(KA[g0 + 1024]) * __expf(last - cum[(s + 1) * CUM_LD + k]);
            *(LAS unsigned*)(kdT + k * OPS_LD + s) = pg8::cvt_pk_bf16(k0, k1);
            *(LAS unsigned*)(vT + k * OPS_LD + s) = (unsigned)VA[g0] | ((unsigned)VA[g0 + 1024] << 16); }
        if (tid < 128) DEC[(size_t)unit * 128 + tid] = __expf(cum[63 * CUM_LD + tid]);
        __syncthreads();
        const int mb = wave >> 1, nb0 = (wave & 1) * 2;
        f32x16_t acc[2];
#pragma unroll
        for (int n = 0; n < 2; ++n)
#pragma unroll
            for (int i = 0; i < 16; ++i) acc[n][i] = 0.f;
#pragma unroll
        for (int ks = 0; ks < 4; ++ks) { const bf16x8_t a = *(const LAS bf16x8_t*)(kdT + (32 * mb + r) * OPS_LD + 16 * ks + 8 * hh);
#pragma unroll
            for (int n = 0; n < 2; ++n) { const bf16x8_t bb = *(const LAS bf16x8_t*)(vT + (32 * (nb0 + n) + r) * OPS_LD + 16 * ks + 8 * hh);
                acc[n] = __builtin_amdgcn_mfma_f32_32x32x16_bf16(a, bb, acc[n], 0, 0, 0); } }
#pragma unroll
        for (int n = 0; n < 2; ++n) { float* dst = LT + (size_t)unit * 16384 + (size_t)(32 * (nb0 + n) + r) * 128 + 32 * mb + 4 * hh;
#pragma unroll
            for (int g = 0; g < 4; ++g) { pg8::f32x4 o; o[0] = acc[n][4 * g]; o[1] = acc[n][4 * g + 1]; o[2] = acc[n][4 * g + 2]; o[3] = acc[n][4 * g + 3]; *(pg8::f32x4*)(dst + 8 * g) = o; } }
        __syncthreads();
    }
}

__device__ __forceinline__ void phase_hgrn_h2(KP P) {
    unsigned char* ws = as_global(P->ws);
    const float* LT = (const float*)(ws + WS_LT); const float* DEC = (const float*)(ws + WS_DEC); bf16_t* PT = (bf16_t*)(ws + WS_PT);
    const int tid = tid_(), G = nblk_();
    for (int quad = bid_() * 512 + tid; quad < NBATCH * AH * 4096; quad += G * 512) {
        const int bh = quad >> 12, rem = quad & 4095, v = rem >> 5, k0 = (rem & 31) * 4;
        const size_t e0 = (size_t)bh * 64 * 16384 + (size_t)v * 128 + k0; const size_t d0 = (size_t)bh * 64 * 128 + k0;
        pg8::f32x4 S = {0.f, 0.f, 0.f, 0.f};
        for (int c0 = 0; c0 < 64; c0 += 8) { pg8::f32x4 Lc[8], Dc[8];
#pragma unroll
            for (int j = 0; j < 8; ++j) { Lc[j] = *(const pg8::f32x4*)(LT + e0 + (size_t)(c0 + j) * 16384); Dc[j] = *(const pg8::f32x4*)(DEC + d0 + (size_t)(c0 + j) * 128); }
#pragma unroll
            for (int j = 0; j < 8; ++j) { pg8::u32x2 w; w.x = pg8::cvt_pk_bf16(S[0], S[1]); w.y = pg8::cvt_pk_bf16(S[2], S[3]);
                *(pg8::u32x2*)(PT + e0 + (size_t)(c0 + j) * 16384) = w; S = Dc[j] * S + Lc[j]; } }
    }
}

__device__ __forceinline__ void phase_hgrn_h3(KP P, int layer, LAS unsigned char* lds) {
    unsigned char* ws = as_global(P->ws);
    const bf16_t* QA = (const bf16_t*)(ws + WS_QA); const bf16_t* KA = (const bf16_t*)(ws + WS_KA); const bf16_t* VA = (const bf16_t*)(ws + WS_VA); const bf16_t* GA = (const bf16_t*)(ws + WS_GA);
    const float* LF = (const float*)(ws + WS_LF); const bf16_t* PT = (const bf16_t*)(ws + WS_PT); bf16_t* YA = (bf16_t*)(ws + WS_YA);
    const float* ng = as_global(P->hnorm_g) + layer * 128;
    const int tid = tid_(), lane = tid & 63, wave = tid >> 6, r = lane & 31, hh = lane >> 5, G = nblk_();
    LAS float* cum = (LAS float*)lds; LAS float* tot = cum + 64 * CUM_LD; LAS float* ssq = tot + 512;
    LAS bf16_t* qd = (LAS bf16_t*)(ssq + 256); LAS bf16_t* qs = qd + 64 * OPK_LD; LAS bf16_t* ks = qs + 64 * OPK_LD; LAS bf16_t* vT = ks + 64 * OPK_LD;
    for (int unit = bid_(); unit < NBATCH * AH * 64; unit += G) {
        const int c = unit & 63, h = (unit >> 6) & 7, b = unit >> 9, tok0 = b * SEQ + c * 64;
        hgrn_scan_cum(LF, tok0, h, cum, tot, tid);
#pragma unroll
        for (int it = 0; it < 8; ++it) { const int idx = tid + 512 * it, kp = (idx & 63) * 2, t = idx >> 6;
            const size_t g0 = (size_t)(tok0 + t) * 1024 + h * 128 + kp;
            const unsigned qw = *(const unsigned*)(QA + g0), kw = *(const unsigned*)(KA + g0);
            const float c0 = cum[t * CUM_LD + kp], c1 = cum[t * CUM_LD + kp + 1], r0 = cum[31 * CUM_LD + kp], r1 = cum[31 * CUM_LD + kp + 1];
            const float q0 = __uint_as_float(qw << 16), q1 = __uint_as_float(qw & 0xffff0000u), k0 = __uint_as_float(kw << 16), k1 = __uint_as_float(kw & 0xffff0000u);
            *(LAS unsigned*)(qd + t * OPK_LD + kp) = pg8::cvt_pk_bf16(q0 * __expf(c0), q1 * __expf(c1));
            *(LAS unsigned*)(qs + t * OPK_LD + kp) = pg8::cvt_pk_bf16(q0 * __expf(c0 - r0), q1 * __expf(c1 - r1));
            *(LAS unsigned*)(ks + t * OPK_LD + kp) = pg8::cvt_pk_bf16(k0 * __expf(r0 - c0), k1 * __expf(r1 - c1)); }
#pragma unroll
        for (int it = 0; it < 8; ++it) { const int idx = tid + 512 * it, v = idx & 127, sp = idx >> 7, s = 2 * sp;
            const size_t g0 = (size_t)(tok0 + s) * 1024 + h * 128 + v;
            *(LAS unsigned*)(vT + v * OPS_LD + s) = (unsigned)VA[g0] | ((unsigned)VA[g0 + 1024] << 16); }
        __syncthreads();
        const int mb = wave >> 1, tb = wave & 1;
        f32x16_t acc;
#pragma unroll
        for (int i = 0; i < 16; ++i) acc[i] = 0.f;
        { const bf16_t* prow = PT + (size_t)unit * 16384 + (size_t)(32 * mb + r) * 128 + 8 * hh;
#pragma unroll
          for (int k8 = 0; k8 < 8; ++k8) { const bf16x8_t a = *(const bf16x8_t*)(prow + 16 * k8); const bf16x8_t bq = *(const LAS bf16x8_t*)(qd + (32 * tb + r) * OPK_LD + 16 * k8 + 8 * hh);
              acc = __builtin_amdgcn_mfma_f32_32x32x16_bf16(a, bq, acc, 0, 0, 0); } }
#pragma unroll
        for (int sb = 0; sb < 2; ++sb) if (sb <= tb) {
            f32x16_t sc;
#pragma unroll
            for (int i = 0; i < 16; ++i) sc[i] = 0.f;
#pragma unroll
            for (int k8 = 0; k8 < 8; ++k8) { const bf16x8_t a = *(const LAS bf16x8_t*)(ks + (32 * sb + r) * OPK_LD + 16 * k8 + 8 * hh); const bf16x8_t bq = *(const LAS bf16x8_t*)(qs + (32 * tb + r) * OPK_LD + 16 * k8 + 8 * hh);
                sc = __builtin_amdgcn_mfma_f32_32x32x16_bf16(a, bq, sc, 0, 0, 0); }
            if (sb == tb) {
#pragma unroll
                for (int i = 0; i < 16; ++i) { const int sl = 8 * (i >> 2) + 4 * hh + (i & 3); sc[i] = (sl <= r) ? sc[i] : 0.f; } }
#pragma unroll
            for (int u = 0; u < 2; ++u) {
                pg8::u32x4 pw; pw.x = pg8::cvt_pk_bf16(sc[8 * u], sc[8 * u + 1]); pw.y = pg8::cvt_pk_bf16(sc[8 * u + 2], sc[8 * u + 3]); pw.z = pg8::cvt_pk_bf16(sc[8 * u + 4], sc[8 * u + 5]); pw.w = pg8::cvt_pk_bf16(sc[8 * u + 6], sc[8 * u + 7]);
                const bf16x8_t pb = __builtin_bit_cast(bf16x8_t, pw);
                const LAS bf16_t* vrow = vT + (32 * mb + r) * OPS_LD + 32 * sb + 16 * u + 4 * hh;
                const bf16x4_t lo = *(const LAS bf16x4_t*)vrow, hi4 = *(const LAS bf16x4_t*)(vrow + 8);
                const bf16x8_t va = {lo[0], lo[1], lo[2], lo[3], hi4[0], hi4[1], hi4[2], hi4[3]};
                acc = __builtin_amdgcn_mfma_f32_32x32x16_bf16(va, pb, acc, 0, 0, 0); }
        }
        float ss = 0.f;
#pragma unroll
        for (int i = 0; i < 16; ++i) ss += acc[i] * acc[i];
        ss += __shfl_xor(ss, 32);
        if (hh == 0) ssq[mb * 64 + 32 * tb + r] = ss;
        __syncthreads();
        const int t = 32 * tb + r;
        const float tot2 = (ssq[t] + ssq[64 + t]) + (ssq[128 + t] + ssq[192 + t]);
        const float rs = 1.0f / sqrtf(tot2 * (1.0f / 128.0f) + RMS_EPS);
        const size_t orow = (size_t)(tok0 + t) * 1024 + h * 128;
#pragma unroll
        for (int g = 0; g < 4; ++g) { const int v0 = 32 * mb + 8 * g + 4 * hh;
            const pg8::u32x2 gw = *(const pg8::u32x2*)(GA + orow + v0); const pg8::f32x4 nv = *(const pg8::f32x4*)(ng + v0);
            const float y0 = acc[4 * g] * rs * nv[0] * __uint_as_float(gw.x << 16), y1 = acc[4 * g + 1] * rs * nv[1] * __uint_as_float(gw.x & 0xffff0000u);
            const float y2 = acc[4 * g + 2] * rs * nv[2] * __uint_as_float(gw.y << 16), y3 = acc[4 * g + 3] * rs * nv[3] * __uint_as_float(gw.y & 0xffff0000u);
            pg8::u32x2 w; w.x = pg8::cvt_pk_bf16(y0, y1); w.y = pg8::cvt_pk_bf16(y2, y3); *(pg8::u32x2*)(YA + orow + v0) = w; }
        __syncthreads();
    }
}
namespace at {
constexpr int D = 128, NW = 8, QBLK = 32, KVBLK = 64, LDQ = 1024, LDK = 1024;
constexpr float SCALE = ATTN_SCALE, THR = 8.f;
constexpr size_t SHM_V = KVBLK * D * 2, SHM_K = KVBLK * D * 2, SHM_ATTN = 2 * SHM_V + 2 * SHM_K + NW * 64 * 4;
using bf16x8 = __attribute__((ext_vector_type(8))) short;
using s16x4  = __attribute__((ext_vector_type(4))) short;
using f32x16 = __attribute__((ext_vector_type(16))) float;
using u32x4  = __attribute__((ext_vector_type(4))) unsigned;
#define AT_KSWZ(row, colB) ((row) * 256 + ((colB) ^ (((row) & 7) << 4)))
#define AT_SBAR() __builtin_amdgcn_sched_barrier(0)
__device__ __forceinline__ int crow(int r, int hi) { return (r & 3) + 8 * (r >> 2) + 4 * hi; }
__device__ __forceinline__ unsigned cvtpk(float lo, float hi) { return pg8::cvt_pk_bf16(lo, hi); }

__device__ __forceinline__ void partialSM(f32x16& p0, f32x16& p1, float& m_reg, float& mn, float& alpha) {
  constexpr float C = SCALE * 1.4426950408889634f;
  float pmax = p0[0];
#pragma unroll
  for (int r = 1; r < 16; ++r) pmax = fmaxf(pmax, p0[r]);
#pragma unroll
  for (int r = 0; r < 16; ++r) pmax = fmaxf(pmax, p1[r]);
  { auto rr = __builtin_amdgcn_permlane32_swap(__float_as_uint(pmax), __float_as_uint(pmax), false, false);
    pmax = fmaxf(__uint_as_float(rr[0]), __uint_as_float(rr[1])); }
  if (__builtin_expect(__all(pmax - m_reg <= THR / SCALE), 1)) { mn = m_reg; alpha = 1.f; }
  else { mn = fmaxf(m_reg, pmax); alpha = __builtin_amdgcn_exp2f((m_reg - mn) * C); m_reg = mn; }
  float mnC = -mn * C;
#pragma unroll
  for (int r = 0; r < 16; ++r) p0[r] = fmaf(p0[r], C, mnC);
#pragma unroll
  for (int r = 0; r < 16; ++r) p1[r] = fmaf(p1[r], C, mnC);
#pragma unroll
  for (int r = 0; r < 16; ++r) p0[r] = __builtin_amdgcn_exp2f(p0[r]);
}
__device__ __forceinline__ void finishSM(f32x16& p0, f32x16& p1, float alpha, float& l_reg, int mlo, int mhi, bf16x8& pa0, bf16x8& pa1, bf16x8& pa2, bf16x8& pa3) {
#pragma unroll
  for (int r = 0; r < 16; ++r) p1[r] = __builtin_amdgcn_exp2f(p1[r]);
#pragma unroll
  for (int r = 0; r < 16; ++r) { const int bit = (r & 3) + 8 * (r >> 2);
    p0[r] = __uint_as_float(__float_as_uint(p0[r]) & (unsigned)__builtin_amdgcn_sbfe(mlo, bit, 1));
    p1[r] = __uint_as_float(__float_as_uint(p1[r]) & (unsigned)__builtin_amdgcn_sbfe(mhi, bit, 1)); }
  float ps = 0;
#pragma unroll
  for (int r = 0; r < 16; ++r) ps += p0[r];
#pragma unroll
  for (int r = 0; r < 16; ++r) ps += p1[r];
  { auto rr = __builtin_amdgcn_permlane32_swap(__float_as_uint(ps), __float_as_uint(ps), false, false);
    ps = __uint_as_float(rr[0]) + __uint_as_float(rr[1]); }
  l_reg = l_reg * alpha + ps;
#define AT_PK4(P, BASE, OUT) do { unsigned a0 = cvtpk(P[BASE + 0], P[BASE + 1]), a1 = cvtpk(P[BASE + 2], P[BASE + 3]);   \
    unsigned b0 = cvtpk(P[BASE + 4], P[BASE + 5]), b1 = cvtpk(P[BASE + 6], P[BASE + 7]);                              \
    auto r0 = __builtin_amdgcn_permlane32_swap(a0, b0, false, false); auto r1 = __builtin_amdgcn_permlane32_swap(a1, b1, false, false); \
    u32x4 w = {r0[0], r1[0], r0[1], r1[1]}; OUT = *reinterpret_cast<bf16x8*>(&w); } while (0)
  AT_PK4(p0, 0, pa0); AT_PK4(p0, 8, pa1); AT_PK4(p1, 0, pa2); AT_PK4(p1, 8, pa3);
#undef AT_PK4
}
__device__ __forceinline__ void qkt(f32x16& p0, f32x16& p1, const LAS char* Ks, const bf16x8* qr, int r32, int hi) {
  p0 = f32x16{}; p1 = f32x16{};
#pragma unroll
  for (int d0 = 0; d0 < 8; ++d0) { int cb = (d0 * 16 + hi * 8) * 2;
    bf16x8 b0 = *reinterpret_cast<const LAS bf16x8*>(Ks + AT_KSWZ(r32, cb));
    bf16x8 b1 = *reinterpret_cast<const LAS bf16x8*>(Ks + AT_KSWZ(32 + r32, cb));
    p0 = __builtin_amdgcn_mfma_f32_32x32x16_bf16(b0, qr[d0], p0, 0, 0, 0);
    p1 = __builtin_amdgcn_mfma_f32_32x32x16_bf16(b1, qr[d0], p1, 0, 0, 0); }
}
__device__ __forceinline__ int v_st(int k, int c) { const int kk = (k & ~0xC) | ((k & 4) << 1) | ((k & 8) >> 1); return ((kk >> 3) * 4 + (c >> 5)) * 512 + ((kk & 7) * 32 + (c & 31)) * 2; }
__device__ __forceinline__ int v_rd_base(int lane) { return ((lane & 3) << 3) | (((lane >> 2) & 3) << 6) | (((lane >> 4) & 1) << 5) | (((lane >> 5) & 1) << 8); }
constexpr int v_rd_off(int d0, int ks, int half) { return d0 * 512 + ks * 4096 + half * 2048; }
template <int OFF> __device__ __forceinline__ s16x4 tr_read(int vb) {
  s16x4 r; asm volatile("ds_read_b64_tr_b16 %0, %1 offset:%2" : "=&v"(r) : "v"(vb), "i"(OFF) : "memory"); return r;
}
template <int D0> __device__ __forceinline__ void pv_one(f32x16& od, int vb, bf16x8 pa0, bf16x8 pa1, bf16x8 pa2, bf16x8 pa3) {
  const s16x4 l0 = tr_read<v_rd_off(D0, 0, 0)>(vb), h0 = tr_read<v_rd_off(D0, 0, 1)>(vb), l1 = tr_read<v_rd_off(D0, 1, 0)>(vb), h1 = tr_read<v_rd_off(D0, 1, 1)>(vb);
  const s16x4 l2 = tr_read<v_rd_off(D0, 2, 0)>(vb), h2 = tr_read<v_rd_off(D0, 2, 1)>(vb), l3 = tr_read<v_rd_off(D0, 3, 0)>(vb), h3 = tr_read<v_rd_off(D0, 3, 1)>(vb);
  asm volatile("s_waitcnt lgkmcnt(0)" ::: "memory"); AT_SBAR();
#define AT_PK(L_, H_) (bf16x8){L_[0], L_[1], L_[2], L_[3], H_[0], H_[1], H_[2], H_[3]}
  od = __builtin_amdgcn_mfma_f32_32x32x16_bf16(pa0, AT_PK(l0, h0), od, 0, 0, 0);
  od = __builtin_amdgcn_mfma_f32_32x32x16_bf16(pa1, AT_PK(l1, h1), od, 0, 0, 0);
  od = __builtin_amdgcn_mfma_f32_32x32x16_bf16(pa2, AT_PK(l2, h2), od, 0, 0, 0);
  od = __builtin_amdgcn_mfma_f32_32x32x16_bf16(pa3, AT_PK(l3, h3), od, 0, 0, 0);
#undef AT_PK
}
__device__ __forceinline__ void pv_d0(f32x16* o, int vb, bf16x8 pa0, bf16x8 pa1, bf16x8 pa2, bf16x8 pa3) {
  pv_one<0>(o[0], vb, pa0, pa1, pa2, pa3); pv_one<1>(o[1], vb, pa0, pa1, pa2, pa3); pv_one<2>(o[2], vb, pa0, pa1, pa2, pa3); pv_one<3>(o[3], vb, pa0, pa1, pa2, pa3);
}

__device__ __forceinline__ void attn_masked_body(const bf16_t* __restrict__ Qb, const bf16_t* __restrict__ Kh, const bf16_t* __restrict__ Vh, const unsigned long long* __restrict__ Mq,
                                                 bf16_t* __restrict__ Ob, int seq, LAS char* lds, int tid) {
  const int wid = tid >> 6, lane = tid & 63, r32 = lane & 31, hi = lane >> 5;
  LAS char* V_lds = lds; LAS char* K_lds = lds + 2 * SHM_V;
  LAS float* wsf = (LAS float*)(lds + 2 * SHM_V + 2 * SHM_K) + wid * 64; LAS float* li_l = wsf; LAS float* al_l = wsf + 32;
  float m_reg = -1e30f, l_reg = 0; f32x16 o[4] = {}; bf16x8 qr[8];
  const bf16_t* Qw = Qb + (long)(wid * QBLK + r32) * LDQ + hi * 8;
#pragma unroll
  for (int d0 = 0; d0 < 8; ++d0) qr[d0] = *reinterpret_cast<const bf16x8*>(Qw + d0 * 16);
  const unsigned long long* mrow = Mq + (size_t)(wid * QBLK + r32) * 64;
  const int sr = tid >> 4, sc = (tid & 15) * 8, vst0 = v_st(sr, sc), vst1 = v_st(32 + sr, sc);
  const int vb0 = (int)(uintptr_t)V_lds + v_rd_base(lane);
  struct { bf16x8 vs0, vs1, ks0, ks1; } sr_[2];
#define AT_SLOAD(i, k0) do { sr_[i].vs0 = *reinterpret_cast<const bf16x8*>(&Vh[(long)((k0) + sr) * LDK + sc]); sr_[i].vs1 = *reinterpret_cast<const bf16x8*>(&Vh[(long)((k0) + 32 + sr) * LDK + sc]); \
    sr_[i].ks0 = *reinterpret_cast<const bf16x8*>(&Kh[(long)((k0) + sr) * LDK + sc]); sr_[i].ks1 = *reinterpret_cast<const bf16x8*>(&Kh[(long)((k0) + 32 + sr) * LDK + sc]); } while (0)
#define AT_SWRITE(b, i) do { *(LAS bf16x8*)(V_lds + (b) * SHM_V + vst0) = sr_[i].vs0;          \
    *(LAS bf16x8*)(V_lds + (b) * SHM_V + vst1) = sr_[i].vs1; int kc = sc * 2;               \
    *(LAS bf16x8*)(K_lds + (b) * SHM_K + AT_KSWZ(sr, kc)) = sr_[i].ks0;                       \
    *(LAS bf16x8*)(K_lds + (b) * SHM_K + AT_KSWZ(32 + sr, kc)) = sr_[i].ks1; } while (0)
#define AT_SWAIT() asm volatile("s_waitcnt vmcnt(4)" ::: "memory")
#define AT_RESC(a) do { if (__any((a) < 1.f)) { if (hi == 0) al_l[r32] = (a); asm volatile("s_waitcnt lgkmcnt(0)" ::: "memory"); \
    _Pragma("unroll") for (int d = 0; d < 4; ++d) _Pragma("unroll") for (int r = 0; r < 16; ++r) o[d][r] *= al_l[crow(r, hi)]; } } while (0)
#define AT_MLOAD(mw, j) do { const unsigned long long _w = mrow[(j)]; (mw##lo) = (int)((unsigned)_w >> (4 * hi)); (mw##hi) = (int)((unsigned)(_w >> 32) >> (4 * hi)); } while (0)
  f32x16 pA0, pA1, pB0, pB1; float mnA, mnB, alA, alB; bf16x8 pa0, pa1, pa2, pa3; const int NT = seq / KVBLK;
  int mAlo, mAhi, mBlo, mBhi;
  constexpr int SE = 0, SO = 1;
  AT_SLOAD(SE, 0); AT_MLOAD(mA, 0); asm volatile("s_waitcnt vmcnt(0)" ::: "memory"); AT_SWRITE(0, SE); __syncthreads();
  qkt(pA0, pA1, K_lds, qr, r32, hi); partialSM(pA0, pA1, m_reg, mnA, alA);
  AT_SLOAD(SO, KVBLK); if (2 < NT) AT_SLOAD(SE, 2 * KVBLK);
  AT_SWAIT(); AT_SWRITE(1, SO); __syncthreads();
  for (int j = 1; j + 1 < NT; j += 2) {
    AT_SBAR(); AT_MLOAD(mB, j); qkt(pB0, pB1, K_lds + SHM_K, qr, r32, hi);
    finishSM(pA0, pA1, alA, l_reg, mAlo, mAhi, pa0, pa1, pa2, pa3); AT_SBAR();
    AT_SLOAD(SO, (j + 2) * KVBLK); AT_SBAR();
    pv_d0(o, vb0, pa0, pa1, pa2, pa3); partialSM(pB0, pB1, m_reg, mnB, alB);
    __syncthreads(); AT_SWAIT(); AT_SWRITE(0, SE);
    AT_RESC(alB); __syncthreads();
    AT_SBAR(); AT_MLOAD(mA, j + 1); qkt(pA0, pA1, K_lds, qr, r32, hi);
    finishSM(pB0, pB1, alB, l_reg, mBlo, mBhi, pa0, pa1, pa2, pa3); AT_SBAR();
    if (j + 3 < NT) AT_SLOAD(SE, (j + 3) * KVBLK); AT_SBAR();
    pv_d0(o, vb0 + (int)SHM_V, pa0, pa1, pa2, pa3); partialSM(pA0, pA1, m_reg, mnA, alA);
    __syncthreads(); AT_SWAIT(); AT_SWRITE(1, SO);
    AT_RESC(alA); __syncthreads();
  }
  AT_SBAR(); AT_MLOAD(mB, NT - 1); qkt(pB0, pB1, K_lds + SHM_K, qr, r32, hi);
  finishSM(pA0, pA1, alA, l_reg, mAlo, mAhi, pa0, pa1, pa2, pa3); AT_SBAR();
  pv_d0(o, vb0, pa0, pa1, pa2, pa3); partialSM(pB0, pB1, m_reg, mnB, alB);
  __syncthreads(); AT_RESC(alB);
  finishSM(pB0, pB1, alB, l_reg, mBlo, mBhi, pa0, pa1, pa2, pa3); AT_SBAR();
  pv_d0(o, vb0 + (int)SHM_V, pa0, pa1, pa2, pa3);
  if (hi == 0) li_l[r32] = l_reg; asm volatile("s_waitcnt lgkmcnt(0)" ::: "memory");
  float rli[16];
#pragma unroll
  for (int r = 0; r < 16; ++r) rli[r] = __builtin_amdgcn_rcpf(li_l[crow(r, hi)]);
  bf16_t* Ow = Ob + (long)(wid * QBLK) * LDQ;
#pragma unroll
  for (int r = 0; r < 16; ++r) { const int orow = crow(r, hi);
#pragma unroll
    for (int d0 = 0; d0 < 4; ++d0) Ow[(long)orow * LDQ + d0 * 32 + r32] = f2bf(o[d0][r] * rli[r]); }
#undef AT_SLOAD
#undef AT_SWRITE
#undef AT_SWAIT
#undef AT_RESC
#undef AT_MLOAD
}
}

__device__ __forceinline__ void phase_attn(KP P, LAS unsigned char* lds) {
    unsigned char* ws = as_global(P->ws);
    const bf16_t* QB = (const bf16_t*)(ws + WS_QB); const bf16_t* KB = (const bf16_t*)(ws + WS_KB); const bf16_t* VB = (const bf16_t*)(ws + WS_VB);
    const unsigned long long* MASK = (const unsigned long long*)(ws + WS_MASK); bf16_t* YB = (bf16_t*)(ws + WS_YB);
    const int G = nblk_();
    for (int p = bid_(); p < 256; p += G) {
        const int bh = p >> 3, b = bh >> 3, h = bh & 7, x = p & 7;
#pragma unroll 1
        for (int half = 0; half < 2; ++half) { const int qb = half ? 15 - x : x; const size_t row0 = (size_t)b * SEQ + (size_t)qb * 256;
            at::attn_masked_body(QB + row0 * 1024 + h * 128, KB + (size_t)b * SEQ * 1024 + h * 128, VB + (size_t)b * SEQ * 1024 + h * 128, MASK + row0 * 64,
                                 YB + row0 * 1024 + h * 128, 256 * (qb + 1), (LAS char*)lds, tid_());
            __syncthreads(); }
    }
}
__device__ __forceinline__ void idx_unit(const bf16_t* QI, const bf16_t* KI, const float* WI, float* Sc, int b, int c, int half, int tid) {
    const int lane = tid & 63, wave = tid >> 6, r = lane & 31, hh = lane >> 5, nk = 64 * (c + 1);
    const int s0 = c * 64 + half * 32 + wave * 4;
    const int aq = (r >> 2) & 1, ahead = (r & 3) + 4 * (r >> 3);
    bf16x8_t A[2][4]; float wv[2][16];
#pragma unroll
    for (int rt = 0; rt < 2; ++rt) { const size_t qrow = (size_t)b * SEQ + s0 + 2 * rt + aq;
#pragma unroll
        for (int ks = 0; ks < 4; ++ks) A[rt][ks] = *(const bf16x8_t*)(QI + qrow * 1024 + ahead * 64 + 16 * ks + 8 * hh);
        const float* wp = WI + ((size_t)b * SEQ + s0 + 2 * rt + hh) * 16;
#pragma unroll
        for (int i4 = 0; i4 < 4; ++i4) { const pg8::f32x4 w4 = *(const pg8::f32x4*)(wp + 4 * i4); wv[rt][4 * i4] = w4[0]; wv[rt][4 * i4 + 1] = w4[1]; wv[rt][4 * i4 + 2] = w4[2]; wv[rt][4 * i4 + 3] = w4[3]; } }
    float* srow[2];
#pragma unroll
    for (int rt = 0; rt < 2; ++rt) srow[rt] = Sc + (size_t)b * SCORE_B + (size_t)2048 * c * (c + 1) + (size_t)((s0 + 2 * rt + hh) & 63) * nk + r;
    const bf16_t* kp = KI + ((size_t)b * SEQ + r) * 64 + 8 * hh;
    bf16x8_t Bn[4];
#pragma unroll
    for (int ks = 0; ks < 4; ++ks) Bn[ks] = *(const bf16x8_t*)(kp + 16 * ks);
    const int ntile = nk / 32;
    for (int kt = 0; kt < ntile; ++kt) {
        bf16x8_t Bc[4];
#pragma unroll
        for (int ks = 0; ks < 4; ++ks) Bc[ks] = Bn[ks];
        if (kt + 1 < ntile) {
#pragma unroll
            for (int ks = 0; ks < 4; ++ks) Bn[ks] = *(const bf16x8_t*)(kp + (size_t)(kt + 1) * 32 * 64 + 16 * ks); }
#pragma unroll
        for (int rt = 0; rt < 2; ++rt) { f32x16_t acc;
#pragma unroll
            for (int i = 0; i < 16; ++i) acc[i] = 0.f;
#pragma unroll
            for (int ks = 0; ks < 4; ++ks) acc = __builtin_amdgcn_mfma_f32_32x32x16_bf16(A[rt][ks], Bc[ks], acc, 0, 0, 0);
            float sc = 0.f;
#pragma unroll
            for (int i = 0; i < 16; ++i) sc = fmaf(wv[rt][i], fmaxf(acc[i], 0.f), sc);
            srow[rt][kt * 32] = sc; }
    }
}
__device__ __forceinline__ void phase_idx(KP P) {
    unsigned char* ws = as_global(P->ws);
    const bf16_t* QI = (const bf16_t*)(ws + WS_QI); const bf16_t* KI = (const bf16_t*)(ws + WS_KI); const float* WI = (const float*)(ws + WS_WI); float* Sc = (float*)(ws + WS_XPRE);
    const int G = nblk_();
    for (int item = bid_(); item < 240; item += G) {
        const int pi = item % 30, combo = item / 30, b = combo >> 1, half = combo & 1;
        idx_unit(QI, KI, WI, Sc, b, 4 + pi, half, tid_());
        idx_unit(QI, KI, WI, Sc, b, 63 - pi, half, tid_());
    }
}
__device__ __forceinline__ void phase_select(KP P, LAS unsigned char* lds) {
    unsigned char* ws = as_global(P->ws); const float* S = (const float*)(ws + WS_XPRE); unsigned long long* MASK = (unsigned long long*)(ws + WS_MASK);
    const int tid = tid_(), wave = tid >> 6, lane = tid & 63, nb8 = nblk_() * 8;
    for (int q = bid_() * 8 + wave; q < TOK; q += nb8) {
        const int b = q >> 12, s = q & 4095, c = s >> 6, nw = c + 1;
        unsigned long long myword = 0ull;
        if (nw <= TOPK / 64) { myword = (lane < nw) ? ~0ull : 0ull; }
        else {
            const float* row = S + (size_t)b * SCORE_B + (size_t)2048 * c * (c + 1) + (size_t)(s & 63) * (nw * 64);
            unsigned u[64];
#pragma unroll
            for (int j = 0; j < 64; ++j) { unsigned v = 0u; if (j < nw) { const unsigned bits = __float_as_uint(row[j * 64 + lane]); v = (bits & 0x80000000u) ? ~bits : (bits | 0x80000000u); } u[j] = v; }
            unsigned prefix = 0u;
            for (int bit = 31; bit >= 0; --bit) { const unsigned cand = prefix | (1u << bit); int cnt = 0;
#pragma unroll
                for (int j8 = 0; j8 < 8; ++j8) if (j8 * 8 < nw) {
#pragma unroll
                    for (int jj = 0; jj < 8; ++jj) cnt += __popcll(__ballot(u[j8 * 8 + jj] >= cand)); }
                if (cnt >= TOPK) prefix = cand; }
            LAS unsigned long long* sm = (LAS unsigned long long*)lds + wave * 64;
#pragma unroll
            for (int j = 0; j < 64; ++j) { const unsigned long long w = __ballot(u[j] >= prefix); if (lane == 0) sm[j] = w; }
            myword = sm[lane];
        }
        MASK[(size_t)q * 64 + lane] = myword;
    }
}

__device__ __forceinline__ void phase_hgrn_naive(KP P, int layer, LAS unsigned char* lds) {
    unsigned char* ws = as_global(P->ws);
    const bf16_t* QA = (const bf16_t*)(ws + WS_QA); const bf16_t* KA = (const bf16_t*)(ws + WS_KA); const bf16_t* VA = (const bf16_t*)(ws + WS_VA); const bf16_t* GA = (const bf16_t*)(ws + WS_GA);
    const float* LF = (const float*)(ws + WS_LF); bf16_t* YA = (bf16_t*)(ws + WS_YA);
    const int tid = tid_(), bh = bid_(), b = bh >> 3, h = bh & 7, v = tid & 127; const bool act = (bh < 32) && (tid < 128);
    if (bh >= 32) return;
    LAS float* sf = (LAS float*)lds; LAS float* sk = sf + 16 * 128; LAS float* sq = sk + 16 * 128; LAS float* red = sq + 16 * 128;
    float S[128];
#pragma unroll
    for (int k = 0; k < 128; ++k) S[k] = 0.f;
    const float ng = as_global(P->hnorm_g)[layer * 128 + v];
    for (int t0 = 0; t0 < SEQ; t0 += 16) {
        if (act) for (int i = 0; i < 16; ++i) { const size_t idx = ((size_t)(b * SEQ + t0 + i)) * 1024 + h * 128 + v; sf[i * 128 + v] = expf(LF[idx]); sk[i * 128 + v] = bf2f(KA[idx]); sq[i * 128 + v] = bf2f(QA[idx]); }
        __syncthreads();
        for (int i = 0; i < 16; ++i) { const size_t idx = ((size_t)(b * SEQ + t0 + i)) * 1024 + h * 128 + v; float o = 0.f;
            if (act) { const float vt = bf2f(VA[idx]);
#pragma unroll
                for (int k = 0; k < 128; ++k) { S[k] = sf[i * 128 + k] * S[k] + sk[i * 128 + k] * vt; o += S[k] * sq[i * 128 + k]; } }
            float ss = o * o;
#pragma unroll
            for (int m = 32; m >= 1; m >>= 1) ss += __shfl_xor(ss, m);
            if (act && (v & 63) == 0) red[v >> 6] = ss;
            __syncthreads();
            if (act) { const float tot = red[0] + red[1]; YA[idx] = f2bf(o * (1.0f / sqrtf(tot * (1.0f / 128.0f) + RMS_EPS)) * ng * bf2f(GA[idx])); }
            __syncthreads(); }
    }
}
__device__ __forceinline__ void phase_idx_naive(KP P, LAS unsigned char* lds) {
    unsigned char* ws = as_global(P->ws);
    const bf16_t* QI = (const bf16_t*)(ws + WS_QI); const bf16_t* KI = (const bf16_t*)(ws + WS_KI); const float* WI = (const float*)(ws + WS_WI); float* Sc = (float*)(ws + WS_XPRE);
    const int tid = tid_(), G = nblk_();
    LAS float* qs = (LAS float*)lds; LAS float* wsh = qs + 1024;
    for (int q = bid_(); q < TOK; q += G) {
        const int b = q >> 12, s = q & 4095, c = s >> 6, nw = c + 1, nk = nw * 64;
        if (nw <= TOPK / 64) continue;
        __syncthreads();
        for (int i = tid; i < 1024; i += 512) qs[i] = bf2f(QI[(size_t)q * 1024 + i]);
        if (tid < 16) wsh[tid] = WI[(size_t)q * 16 + tid];
        __syncthreads();
        float* row = Sc + (size_t)b * SCORE_B + (size_t)2048 * c * (c + 1) + (size_t)(s & 63) * nk;
        for (int key = tid; key < nk; key += 512) {
            float kf[64]; const pg8::u32x4* kp = (const pg8::u32x4*)(KI + ((size_t)b * SEQ + key) * 64);
#pragma unroll
            for (int d8 = 0; d8 < 8; ++d8) { const pg8::u32x4 w = kp[d8]; pg8::f32x4 a, bb; pg8::unpack8(w, a, bb);
#pragma unroll
                for (int j = 0; j < 4; ++j) { kf[d8 * 8 + j] = a[j]; kf[d8 * 8 + 4 + j] = bb[j]; } }
            float sc = 0.f;
            for (int h = 0; h < 16; ++h) { float dot = 0.f;
#pragma unroll
                for (int d = 0; d < 64; ++d) dot += qs[h * 64 + d] * kf[d];
                sc += wsh[h] * fmaxf(dot, 0.f); }
            row[key] = sc;
        }
    }
}
__device__ __forceinline__ void phase_attn_naive(KP P, LAS unsigned char* lds) {
    unsigned char* ws = as_global(P->ws);
    const bf16_t* QB = (const bf16_t*)(ws + WS_QB); const bf16_t* KB = (const bf16_t*)(ws + WS_KB); const bf16_t* VB = (const bf16_t*)(ws + WS_VB);
    const unsigned long long* MASK = (const unsigned long long*)(ws + WS_MASK); bf16_t* YB = (bf16_t*)(ws + WS_YB);
    const int tid = tid_(), h = tid >> 6, lane = tid & 63, G = nblk_();
    LAS float* qs = (LAS float*)lds + h * 128; LAS int* keys = (LAS int*)((LAS float*)lds + 1024) + h * 320; LAS float* lg = (LAS float*)lds + 1024 + 8 * 320 + h * 320;
    for (int q = bid_(); q < TOK; q += G) {
        const int b = q >> 12, s = q & 4095, nw = (s >> 6) + 1;
        qs[lane] = bf2f(QB[(size_t)q * 1024 + h * 128 + lane]); qs[lane + 64] = bf2f(QB[(size_t)q * 1024 + h * 128 + 64 + lane]);
        int cnt = 0;
        for (int j = 0; j < nw; ++j) { const unsigned long long w = MASK[(size_t)q * 64 + j]; const bool on = (w >> lane) & 1ull; const int key = j * 64 + lane;
            if (on) { const pg8::u32x4* kp = (const pg8::u32x4*)(KB + ((size_t)b * SEQ + key) * 1024 + h * 128); float dot = 0.f;
                for (int d8 = 0; d8 < 16; ++d8) { pg8::f32x4 a, bb; pg8::unpack8(kp[d8], a, bb);
#pragma unroll
                    for (int j2 = 0; j2 < 4; ++j2) dot += qs[d8 * 8 + j2] * a[j2] + qs[d8 * 8 + 4 + j2] * bb[j2]; }
                const int pos = cnt + __popcll(w & ((1ull << lane) - 1ull));
                if (pos < 320) { keys[pos] = key; lg[pos] = dot * ATTN_SCALE; } }
            cnt += __popcll(w); }
        if (cnt > 320) cnt = 320;
        float mx = -1e30f; for (int e = lane; e < cnt; e += 64) mx = fmaxf(mx, lg[e]);
#pragma unroll
        for (int m = 32; m >= 1; m >>= 1) mx = fmaxf(mx, __shfl_xor(mx, m));
        float sum = 0.f; for (int e = lane; e < cnt; e += 64) { const float pe = expf(lg[e] - mx); lg[e] = pe; sum += pe; }
#pragma unroll
        for (int m = 32; m >= 1; m >>= 1) sum += __shfl_xor(sum, m);
        float a0 = 0.f, a1 = 0.f;
        for (int e = 0; e < cnt; ++e) { const float pe = lg[e]; const bf16_t* vp = VB + ((size_t)b * SEQ + keys[e]) * 1024 + h * 128 + 2 * lane; a0 += pe * bf2f(vp[0]); a1 += pe * bf2f(vp[1]); }
        const float inv = 1.0f / sum;
        *(unsigned*)(YB + (size_t)q * 1024 + h * 128 + 2 * lane) = pg8::cvt_pk_bf16(a0 * inv, a1 * inv);
    }
}

__global__ __launch_bounds__(128) void k_hgrn_naive(const bf16_t* QA, const bf16_t* KA, const bf16_t* VA, const bf16_t* GA, const float* LF, const float* norm_g, bf16_t* YA) {
    const int bh = blockIdx.x, b = bh >> 3, h = bh & 7, v = threadIdx.x;
    __shared__ float sf[16][128], sk[16][128], sq[16][128]; __shared__ float red[2];
    float S[128];
#pragma unroll
    for (int k = 0; k < 128; ++k) S[k] = 0.f;
    const float ng = norm_g[v];
    for (int t0 = 0; t0 < SEQ; t0 += 16) {
        for (int i = 0; i < 16; ++i) { const size_t idx = ((size_t)(b * SEQ + t0 + i)) * 1024 + h * 128 + v; sf[i][v] = expf(LF[idx]); sk[i][v] = bf2f(KA[idx]); sq[i][v] = bf2f(QA[idx]); }
        __syncthreads();
        for (int i = 0; i < 16; ++i) { const size_t idx = ((size_t)(b * SEQ + t0 + i)) * 1024 + h * 128 + v; const float vt = bf2f(VA[idx]); float o = 0.f;
#pragma unroll
            for (int k = 0; k < 128; ++k) { S[k] = sf[i][k] * S[k] + sk[i][k] * vt; o += S[k] * sq[i][k]; }
            float ss = o * o;
#pragma unroll
            for (int m = 32; m >= 1; m >>= 1) ss += __shfl_xor(ss, m);
            if ((v & 63) == 0) red[v >> 6] = ss;
            __syncthreads();
            const float tot = red[0] + red[1];
            const float y = o * (1.0f / sqrtf(tot * (1.0f / 128.0f) + RMS_EPS)) * ng * bf2f(GA[idx]);
            YA[idx] = f2bf(y);
            __syncthreads(); }
    }
}
__global__ __launch_bounds__(256) void k_idx_naive(const bf16_t* QI, const bf16_t* KI, const float* WI, float* S) {
    const int q = blockIdx.x, b = q >> 12, s = q & 4095, c = s >> 6, nw = c + 1, nk = nw * 64;
    if (nw <= TOPK / 64) return;
    __shared__ float qs[1024]; __shared__ float wsh[16];
    for (int i = threadIdx.x; i < 1024; i += 256) qs[i] = bf2f(QI[(size_t)q * 1024 + i]);
    if (threadIdx.x < 16) wsh[threadIdx.x] = WI[(size_t)q * 16 + threadIdx.x];
    __syncthreads();
    float* row = S + (size_t)b * SCORE_B + (size_t)2048 * c * (c + 1) + (size_t)(s & 63) * nk;
    for (int key = threadIdx.x; key < nk; key += 256) {
        float kf[64]; const bf16_t* kp = KI + ((size_t)b * SEQ + key) * 64;
#pragma unroll
        for (int d = 0; d < 64; ++d) kf[d] = bf2f(kp[d]);
        float sc = 0.f;
        for (int h = 0; h < 16; ++h) { float dot = 0.f;
#pragma unroll
            for (int d = 0; d < 64; ++d) dot += qs[h * 64 + d] * kf[d];
            sc += wsh[h] * fmaxf(dot, 0.f); }
        row[key] = sc;
    }
}
__global__ __launch_bounds__(512) void k_attn_naive(const bf16_t* QB, const bf16_t* KB, const bf16_t* VB, const unsigned long long* MASK, bf16_t* YB) {
    const int q = blockIdx.x, b = q >> 12, s = q & 4095, nw = (s >> 6) + 1, h = threadIdx.x >> 6, lane = threadIdx.x & 63;
    __shared__ float qs[8][128]; __shared__ int keys[8][320]; __shared__ float lg[8][320];
    qs[h][lane] = bf2f(QB[(size_t)q * 1024 + h * 128 + lane]); qs[h][lane + 64] = bf2f(QB[(size_t)q * 1024 + h * 128 + 64 + lane]);
    __syncthreads();
    int cnt = 0;
    for (int j = 0; j < nw; ++j) { const unsigned long long w = MASK[(size_t)q * 64 + j]; const bool on = (w >> lane) & 1ull; const int key = j * 64 + lane;
        if (on) { const bf16_t* kp = KB + ((size_t)b * SEQ + key) * 1024 + h * 128; float dot = 0.f;
            for (int d = 0; d < 128; ++d) dot += qs[h][d] * bf2f(kp[d]);
            const int pos = cnt + __popcll(w & ((1ull << lane) - 1ull));
            if (pos < 320) { keys[h][pos] = key; lg[h][pos] = dot * ATTN_SCALE; } }
        cnt += __popcll(w); }
    if (cnt > 320) cnt = 320;
    __syncthreads();
    float mx = -1e30f; for (int e = lane; e < cnt; e += 64) mx = fmaxf(mx, lg[h][e]);
#pragma unroll
    for (int m = 32; m >= 1; m >>= 1) mx = fmaxf(mx, __shfl_xor(mx, m));
    float sum = 0.f; for (int e = lane; e < cnt; e += 64) { const float pe = expf(lg[h][e] - mx); lg[h][e] = pe; sum += pe; }
#pragma unroll
    for (int m = 32; m >= 1; m >>= 1) sum += __shfl_xor(sum, m);
    __syncthreads();
    float a0 = 0.f, a1 = 0.f;
    for (int e = 0; e < cnt; ++e) { const float pe = lg[h][e]; const bf16_t* vp = VB + ((size_t)b * SEQ + keys[h][e]) * 1024 + h * 128 + 2 * lane; a0 += pe * bf2f(vp[0]); a1 += pe * bf2f(vp[1]); }
    const float inv = 1.0f / sum;
    YB[(size_t)q * 1024 + h * 128 + 2 * lane] = f2bf(a0 * inv); YB[(size_t)q * 1024 + h * 128 + 2 * lane + 1] = f2bf(a1 * inv);
}

__global__ __launch_bounds__(256) void k_dump(const unsigned char* ws, int which, float* out) {
    for (size_t i = (size_t)blockIdx.x * 256 + threadIdx.x; i < (size_t)TOK * DM; i += (size_t)gridDim.x * 256) {
        const size_t t = i / DM, c = i % DM; float v = 0.f;
        if (which == 0) { v = bf2f(((const bf16_t*)(ws + WS_MG))[i]) + ((const float*)(ws + WS_PP))[i]; }
        else if (which == 1) { const size_t j = t * 1024 + (c & 1023);
            v = bf2f(((const bf16_t*)(ws + WS_QA))[j]) + bf2f(((const bf16_t*)(ws + WS_KA))[j]) + bf2f(((const bf16_t*)(ws + WS_VA))[j]) + bf2f(((const bf16_t*)(ws + WS_GA))[j])
              + bf2f(((const bf16_t*)(ws + WS_QB))[j]) + bf2f(((const bf16_t*)(ws + WS_KB))[j]) + bf2f(((const bf16_t*)(ws + WS_VB))[j]) + bf2f(((const bf16_t*)(ws + WS_QI))[j])
              + ((const float*)(ws + WS_LF))[j] + bf2f(((const bf16_t*)(ws + WS_SGA))[i]) + bf2f(((const bf16_t*)(ws + WS_SGB))[i]) + ((const float*)(ws + WS_IKW))[t * 128 + (c & 127)]; }
        else if (which == 2) { const size_t j = t * 1024 + (c & 1023); v = (c < 1024) ? bf2f(((const bf16_t*)(ws + WS_YA))[j]) : bf2f(((const bf16_t*)(ws + WS_YB))[j]); }
        else if (which == 3) { v = ((const float*)(ws + WS_XPRE))[i]; }
        else if (which == 4) { v = ((const float*)(ws + WS_X32))[i]; }
        else if (which == 5) { v = bf2f(((const bf16_t*)(ws + WS_H))[t * DFF + c]) + bf2f(((const bf16_t*)(ws + WS_H))[t * DFF + 2048 + c]) + bf2f(((const bf16_t*)(ws + WS_H))[t * DFF + 3584 + c]); }
        else if (which == 6) { const unsigned long long m = ((const unsigned long long*)(ws + WS_MASK))[t * 64 + (c & 63)]; v = (float)__popcll(m) + (float)(unsigned)(m % 1000003ull) * 1e-3f; }
        else if (which == 7) { v = bf2f(((const bf16_t*)(ws + WS_WIN))[i % ((size_t)INP * DM)]) + bf2f(((const bf16_t*)(ws + WS_WGU))[(i * 7) % ((size_t)2 * DFF * DM)]) + bf2f(((const bf16_t*)(ws + WS_WDN))[(i * 3) % ((size_t)DFF * DM)]); }
        else if (which == 8) { v = bf2f(((const bf16_t*)(ws + WS_XB))[i]) + ((const float*)(ws + WS_COSH))[i % ((size_t)TOK * 64)] + ((const float*)(ws + WS_SINI))[i % ((size_t)TOK * 32)] + ((const float*)(ws + WS_LB))[i % 4096]; }
        else if (which == 9) { v = bf2f(((const bf16_t*)(ws + WS_H))[t * 6272 + c]) + bf2f(((const bf16_t*)(ws + WS_H))[t * 6272 + 2048 + c]) + bf2f(((const bf16_t*)(ws + WS_H))[t * 6272 + 4096 + c]) + bf2f(((const bf16_t*)(ws + WS_H))[t * 6272 + 4224 + c]); }
        else if (which == 10) { const size_t j = t * 1024 + (c & 1023); v = bf2f(((const bf16_t*)(ws + WS_QA))[j]) + bf2f(((const bf16_t*)(ws + WS_VA))[j]) + bf2f(((const bf16_t*)(ws + WS_GA))[j]) + bf2f(((const bf16_t*)(ws + WS_VB))[j]) + bf2f(((const bf16_t*)(ws + WS_SGA))[i]) + bf2f(((const bf16_t*)(ws + WS_SGB))[i]); }
        else if (which == 11) { const size_t j = t * 1024 + (c & 1023); v = bf2f(((const bf16_t*)(ws + WS_QB))[j]) + bf2f(((const bf16_t*)(ws + WS_KB))[j]) + bf2f(((const bf16_t*)(ws + WS_QI))[j]); }
        else if (which == 12) { const size_t j = t * 1024 + (c & 1023); v = ((const float*)(ws + WS_LF))[j] + bf2f(((const bf16_t*)(ws + WS_KA))[j]); }
        else if (which == 14) { v = ((const float*)(ws + WS_IKW))[t * 128 + (c & 127)]; }
        else if (which == 15) { const size_t j = t * 1024 + (c & 1023); v = bf2f(((const bf16_t*)(ws + WS_QA))[j]) + bf2f(((const bf16_t*)(ws + WS_GA))[j]); }
        else if (which == 16) { v = bf2f(((const bf16_t*)(ws + WS_SGA))[i]) + bf2f(((const bf16_t*)(ws + WS_SGB))[i]); }
        else if (which == 17) { const size_t j = t * 1024 + (c & 1023); v = bf2f(((const bf16_t*)(ws + WS_VA))[j]) + bf2f(((const bf16_t*)(ws + WS_VB))[j]); }
        out[i] = v;
    }
}
#ifndef OPT_HGRN
#define OPT_HGRN 1
#endif
#ifndef OPT_IDX
#define OPT_IDX 1
#endif
#ifndef OPT_ATT
#define OPT_ATT 1
#endif
#ifndef PHM
#define PHM 0x3fff
#endif
#ifndef ONE_LAUNCH
#define ONE_LAUNCH 1
#endif

__global__ void __launch_bounds__(512, 2) mega(Params P_unused) {
    extern __shared__ __attribute__((aligned(16))) unsigned char lds[];
    LAS unsigned char* L = (LAS unsigned char*)lds;
    volatile LAS unsigned* misc = (volatile LAS unsigned*)(L + MISC_OFF);
    if (threadIdx.x < 4) misc[threadIdx.x] = 0u;
    __syncthreads();
    int lo, hi; unsigned char* ws0; { KP P0 = kparams(); lo = P0->ph_lo; hi = P0->ph_hi; ws0 = as_global(P0->ws); }
    XcdBarrier bar; bar.bar = (unsigned*)(ws0 + WS_CTL); bar.x = 0; bar.st = misc;
    if (hi - lo > 1) bar = xcd_barrier_post((unsigned*)(ws0 + WS_CTL), misc);
#define WSP(T_, off) ((T_*)(ws + (off)))
#define WSL KP P = kparams(); unsigned char* ws = as_global(P->ws); const int G = nblk_(), bid = bid_(); (void)G; (void)bid

    for (int layer = 0; layer < DEPTH; ++layer) {
        const int base = layer * NPH_LAYER;
#define IN(k) (((PHM >> (k)) & 1) && lo <= base + (k) && base + (k) < hi)
#define SEAM(k) do { if (base + (k) + 1 < hi) xcd_barrier(bar); } while (0)
        if (IN(0)) { WSL; if (layer == 0) phase_prologue(P); phase_wconv(P, layer, (LAS float*)L); SEAM(0); }
        if (IN(1)) { WSL;
            pg8::Gemm g{WSP(const bf16_t, WS_XB), WSP(const bf16_t, WS_WIN), TOK, INP, DM}; pg8::StaticOrder S; S.init(TOK, INP, G, bid);
#ifdef RAWTEST
            pg8::EpiRawTest E{ws};
            pg8::gemm_phase<pg8::EpiRawTest, pg8::StaticOrder, true, true>(L, g, S, E); SEAM(1);
#else
            pg8::EpiIn E{ws, layer};
            pg8::gemm_phase<pg8::EpiIn, pg8::StaticOrder, true, true>(L, g, S, E); SEAM(1);
#endif
        }
        if (IN(2)) { WSL; phase_ikprep(P, layer);
#if OPT_HGRN
            phase_hgrn_h1(P, L);
#endif
            SEAM(2); }
        if (IN(3)) { WSL;
#if !OPT_HGRN
            phase_hgrn_naive(P, layer, L); __syncthreads();
#else
            phase_hgrn_h2(P);
#endif
#if !OPT_IDX
            phase_idx_naive(P, L);
#else
            phase_idx(P);
#endif
            SEAM(3); }
        if (IN(4)) { WSL; phase_select(P, L);
#if OPT_HGRN
            __syncthreads(); phase_hgrn_h3(P, layer, L);
#endif
            SEAM(4); }
        if (IN(5)) { WSL;
#if !OPT_ATT
            phase_attn_naive(P, L);
#else
            phase_attn(P, L);
#endif
            SEAM(5); }
        if (IN(6)) { WSL;
            { pg8::Gemm g{WSP(const bf16_t, WS_YA), WSP(const bf16_t, WS_WA), TOK, DM, AW}; pg8::StaticOrder S; S.init(TOK, DM, G, bid);
              pg8::EpiGateA E{ws}; pg8::gemm_phase<pg8::EpiGateA, pg8::StaticOrder, true, true>(L, g, S, E); }
            { pg8::Gemm g{WSP(const bf16_t, WS_YB), WSP(const bf16_t, WS_WB), TOK, DM, BW}; pg8::StaticOrder S; S.init(TOK, DM, G, bid);
              pg8::EpiGateB E{ws}; pg8::gemm_phase<pg8::EpiGateB, pg8::StaticOrder, true, true>(L, g, S, E); }
            { pg8::Gemm g{WSP(const bf16_t, WS_PB), WSP(const bf16_t, WS_WPP), TOK, DM, PLE}; pg8::StaticOrder S; S.init(TOK, DM, G, bid);
              pg8::EpiF32P E{ws}; pg8::gemm_phase<pg8::EpiF32P, pg8::StaticOrder, true, true>(L, g, S, E); }
            SEAM(6);
        }
        if (IN(7)) { WSL;
            pg8::Gemm g{WSP(const bf16_t, WS_MG), WSP(const bf16_t, WS_WO), TOK, DM, DM}; pg8::StaticOrder S; S.init(TOK, DM, G, bid);
            pg8::EpiRes E{layer == 0 ? as_global(P->x) : WSP(const float, WS_X32), ws}; pg8::gemm_phase<pg8::EpiRes, pg8::StaticOrder, true, true>(L, g, S, E); SEAM(7);
        }
        if (IN(8)) { WSL; phase_ln(WSP(const float, WS_XPRE), WSP(float, WS_X32), WSP(bf16_t, WS_XB), as_global(P->lnm_g) + layer * DM, as_global(P->lnm_b) + layer * DM); SEAM(8); }
        if (IN(9)) { WSL;
            pg8::Gemm g{WSP(const bf16_t, WS_XB), WSP(const bf16_t, WS_WGU), TOK, 2 * DFF, DM}; pg8::StaticOrder S; S.init(TOK, 2 * DFF, G, bid);
            pg8::EpiSwiGLU E{ws}; pg8::gemm_phase<pg8::EpiSwiGLU, pg8::StaticOrder, true, true>(L, g, S, E); SEAM(9);
        }
        if (IN(10)) { WSL;
            pg8::Gemm g{WSP(const bf16_t, WS_H), WSP(const bf16_t, WS_WDN), TOK, DM, DFF}; pg8::StaticOrder S; S.init(TOK, DM, G, bid);
            pg8::EpiRes E{WSP(const float, WS_X32), ws}; pg8::gemm_phase<pg8::EpiRes, pg8::StaticOrder, true, true>(L, g, S, E); SEAM(10);
        }
        if (IN(11)) { WSL; phase_ln(WSP(const float, WS_XPRE), WSP(float, WS_X32), WSP(bf16_t, WS_XB), as_global(P->lnf_g) + layer * DM, as_global(P->lnf_b) + layer * DM); SEAM(11); }
        if (IN(12)) { WSL;
            pg8::Gemm g{WSP(const bf16_t, WS_XB), WSP(const bf16_t, WS_WPG), TOK, DM, DM}; pg8::StaticOrder S; S.init(TOK, DM, G, bid);
            pg8::EpiPle E{ws}; pg8::gemm_phase<pg8::EpiPle, pg8::StaticOrder, true, true>(L, g, S, E); SEAM(12);
        }
        if (IN(13)) { WSL; phase_ln(WSP(const float, WS_XPRE), layer == DEPTH - 1 ? as_global(P->out) : WSP(float, WS_X32), WSP(bf16_t, WS_XB), as_global(P->lnp_g) + layer * DM, as_global(P->lnp_b) + layer * DM); SEAM(13); }
#undef IN
#undef SEAM
    }
}

extern "C" void kernel_launch(void* const* d_in, const int* in_sizes, int n_in, void* d_out, int out_size, void* d_ws, size_t ws_size, hipStream_t stream) {
    static int grid = 0;
    if (grid == 0) {
        if (n_in != 22 || out_size != TOK * DM || ws_size < WS_END) { fprintf(stderr, "kernel_launch: unexpected shapes: n_in %d out %d ws %zu (need %zu)\n", n_in, out_size, ws_size, (size_t)WS_END); grid = -1; return; }
        int dev = 0, cus = 0, per_cu = 0;
        if (hipGetDevice(&dev) != hipSuccess || hipDeviceGetAttribute(&cus, hipDeviceAttributeMultiprocessorCount, dev) != hipSuccess) { grid = -1; return; }
        if (hipFuncSetAttribute((const void*)mega, hipFuncAttributeMaxDynamicSharedMemorySize, LDS_BYTES) != hipSuccess) { fprintf(stderr, "kernel_launch: hipFuncSetAttribute failed\n"); grid = -1; return; }
        if (hipOccupancyMaxActiveBlocksPerMultiprocessor(&per_cu, (const void*)mega, 512, LDS_BYTES) != hipSuccess || per_cu < 1) { fprintf(stderr, "kernel_launch: occupancy query says %d\n", per_cu); (void)hipGetLastError(); }
        grid = cus;
    }
    if (grid < 0) return;
    (void)hipMemsetAsync((char*)d_ws + WS_CTL, 0, 65536, stream);
    Params P{};
    P.x = (const float*)d_in[0]; P.p = (const float*)d_in[1]; P.pos = (const int*)d_in[2];
    P.w_in = (const float*)d_in[3]; P.w_a = (const float*)d_in[4]; P.w_b = (const float*)d_in[5]; P.w_out = (const float*)d_in[6];
    P.lbraw = (const float*)d_in[7]; P.hnorm_g = (const float*)d_in[8]; P.ikn_g = (const float*)d_in[9]; P.ikn_b = (const float*)d_in[10];
    P.lnm_g = (const float*)d_in[11]; P.lnm_b = (const float*)d_in[12]; P.w_fg = (const float*)d_in[13]; P.w_fu = (const float*)d_in[14]; P.w_fd = (const float*)d_in[15];
    P.lnf_g = (const float*)d_in[16]; P.lnf_b = (const float*)d_in[17]; P.w_pg = (const float*)d_in[18]; P.w_pp = (const float*)d_in[19];
    P.lnp_g = (const float*)d_in[20]; P.lnp_b = (const float*)d_in[21];
    P.out = (float*)d_out; P.ws = (unsigned char*)d_ws;
    for (int j = 0; j < 64; ++j) P.invf_h[j] = pow(10000.0, -(double)j / 64.0) / 6.283185307179586476925286766559;
    for (int j = 0; j < 32; ++j) P.invf_i[j] = pow(10000.0, -(double)j / 32.0) / 6.283185307179586476925286766559;
#if ONE_LAUNCH
    P.ph_lo = 0; P.ph_hi = NPH;
    hipLaunchKernelGGL(mega, dim3(grid), dim3(512), LDS_BYTES, stream, P);
#elif defined(SEQ_TEST)
    { const int seq[] = SEQ_TEST; for (int i = 0; i < (int)(sizeof(seq) / sizeof(int)); ++i) { P.ph_lo = seq[i]; P.ph_hi = seq[i] + 1; hipLaunchKernelGGL(mega, dim3(grid), dim3(512), LDS_BYTES, stream, P); }
      hipLaunchKernelGGL(k_dump, dim3(4096), dim3(256), 0, stream, (const unsigned char*)d_ws, DUMP_WHICH, (float*)d_out); }
#else
    unsigned char* ws = (unsigned char*)d_ws;
    for (int layer = 0; layer < DEPTH; ++layer)
        for (int k = 0; k < NPH_LAYER; ++k) {
            P.ph_lo = layer * NPH_LAYER + k; P.ph_hi = P.ph_lo + 1;
            bool run_mega = true;
#if !OPT_HGRN
            if (k == 3) hipLaunchKernelGGL(k_hgrn_naive, dim3(32), dim3(128), 0, stream, (const bf16_t*)(ws + WS_QA), (const bf16_t*)(ws + WS_KA), (const bf16_t*)(ws + WS_VA), (const bf16_t*)(ws + WS_GA),
                                           (const float*)(ws + WS_LF), P.hnorm_g + layer * 128, (bf16_t*)(ws + WS_YA));
#endif
#if !OPT_IDX
            if (k == 3) hipLaunchKernelGGL(k_idx_naive, dim3(TOK), dim3(256), 0, stream, (const bf16_t*)(ws + WS_QI), (const bf16_t*)(ws + WS_KI), (const float*)(ws + WS_WI), (float*)(ws + WS_XPRE));
#endif
#if !OPT_ATT
            if (k == 5) hipLaunchKernelGGL(k_attn_naive, dim3(TOK), dim3(512), 0, stream, (const bf16_t*)(ws + WS_QB), (const bf16_t*)(ws + WS_KB), (const bf16_t*)(ws + WS_VB),
                                           (const unsigned long long*)(ws + WS_MASK), (bf16_t*)(ws + WS_YB));
#endif
#if !OPT_HGRN && !OPT_IDX
            if (k == 3) run_mega = false;
#endif
#if !OPT_ATT
            if (k == 5) run_mega = false;
#endif
            if (run_mega) hipLaunchKernelGGL(mega, dim3(grid), dim3(512), LDS_BYTES, stream, P);
#ifdef DUMP_AT
            if (layer * NPH_LAYER + k == DUMP_AT) { hipLaunchKernelGGL(k_dump, dim3(4096), dim3(256), 0, stream, (const unsigned char*)ws, DUMP_WHICH, (float*)d_out); return; }
#endif
        }
#endif
    const hipError_t le = hipPeekAtLastError();
    if (le != hipSuccess) fprintf(stderr, "kernel_launch: launch failed: %s\n", hipGetErrorName(le));
}
```

```cpp
#include <hip/hip_runtime.h>
#include <cstdio>
#include <cstdint>

constexpr int DM = 2048, NBATCH = 4, SEQ = 4096, TOK = NBATCH * SEQ, DEPTH = 4, CHUNK = 64, PLE = 256;
constexpr int AH = 8, AD = 128, AW = 1024, BH = 8, BD = 128, BW = 1024, IH = 16, IDIM = 64, TOPK = 256;
constexpr int DFF = 5632, INW = 12368, INP = 12544;
constexpr float ALPHA = 1.6817928305074290861f;
constexpr float LN_EPS = 1e-5f, RMS_EPS = 1e-6f;
constexpr float ATTN_SCALE = 0.088388347648318440f;
constexpr float IDX_SCALE = 0.03125f;

typedef unsigned short bf16_t;
__device__ __forceinline__ float bf2f(bf16_t b) { return __uint_as_float(((unsigned)b) << 16); }
__device__ __forceinline__ bf16_t f2bf(float f) { unsigned u = __float_as_uint(f); u += 0x7FFFu + ((u >> 16) & 1u); return (bf16_t)(u >> 16); }
__device__ __forceinline__ float sigmoid_f(float x) { return __builtin_amdgcn_rcpf(1.0f + __expf(-x)); }
__device__ __forceinline__ float silu_f(float x) { return x * sigmoid_f(x); }

__device__ __forceinline__ int tid_() { int t = (int)threadIdx.x; asm volatile("" : "+v"(t)); return t; }
__device__ __forceinline__ int bid_() { int b = (int)blockIdx.x; asm volatile("" : "+s"(b)); return b; }
__device__ __forceinline__ int nblk_() { int g = (int)gridDim.x; asm volatile("" : "+s"(g)); return g; }

template <class T> __device__ __forceinline__ T* as_global(T* p) { return (T*)(__attribute__((address_space(1))) T*)p; }

constexpr size_t MiB = 1048576;
constexpr size_t WS_CTL  = 0;
constexpr size_t WS_LB   = WS_CTL + 65536;
constexpr size_t WS_COSH = 1 * MiB;
constexpr size_t WS_SINH = WS_COSH + 4 * MiB;
constexpr size_t WS_COSI = WS_SINH + 4 * MiB;
constexpr size_t WS_SINI = WS_COSI + 2 * MiB;
constexpr size_t WS_WIN  = WS_SINI + 2 * MiB;
constexpr size_t WS_WA   = WS_WIN + 49 * MiB;
constexpr size_t WS_WB   = WS_WA + 4 * MiB;
constexpr size_t WS_WO   = WS_WB + 4 * MiB;
constexpr size_t WS_WGU  = WS_WO + 8 * MiB;
constexpr size_t WS_WDN  = WS_WGU + 44 * MiB;
constexpr size_t WS_WPG  = WS_WDN + 22 * MiB;
constexpr size_t WS_WPP  = WS_WPG + 8 * MiB;
constexpr size_t WS_X32  = WS_WPP + 1 * MiB;
constexpr size_t WS_XB   = WS_X32 + 128 * MiB;
constexpr size_t WS_XPRE = WS_XB + 64 * MiB;
constexpr size_t WS_R1   = WS_XPRE + 130 * MiB;
constexpr size_t WS_QA   = WS_R1;
constexpr size_t WS_LF   = WS_QA + 32 * MiB;
constexpr size_t WS_KA   = WS_LF + 64 * MiB;
constexpr size_t WS_VA   = WS_KA + 32 * MiB;
constexpr size_t WS_GA   = WS_VA + 32 * MiB;
constexpr size_t WS_QB   = WS_GA + 32 * MiB;
constexpr size_t WS_KB   = WS_QB + 32 * MiB;
constexpr size_t WS_VB   = WS_KB + 32 * MiB;
constexpr size_t WS_QI   = WS_VB + 32 * MiB;
constexpr size_t WS_SGA  = WS_QI + 32 * MiB;
constexpr size_t WS_SGB  = WS_SGA + 64 * MiB;
constexpr size_t WS_IKW  = WS_SGB + 64 * MiB;
constexpr size_t WS_H    = WS_R1;
constexpr size_t WS_PP   = WS_R1 + 176 * MiB;
constexpr size_t WS_R2   = WS_IKW + 8 * MiB;
constexpr size_t WS_LT   = WS_R2;
constexpr size_t WS_MG   = WS_R2;
constexpr size_t WS_PT   = WS_LT + 128 * MiB;
constexpr size_t WS_DEC  = WS_PT + 64 * MiB;
constexpr size_t WS_MASK = WS_DEC + 1 * MiB;
constexpr size_t WS_YA   = WS_MASK + 8 * MiB;
constexpr size_t WS_YB   = WS_YA + 32 * MiB;
constexpr size_t WS_KI   = WS_YB + 32 * MiB;
constexpr size_t WS_WI   = WS_KI + 2 * MiB;
constexpr size_t WS_PB   = WS_WI + 1 * MiB;
constexpr size_t WS_END  = WS_PB + 8 * MiB;
static_assert(WS_END < 1360000000ull, "workspace budget");
constexpr size_t SCORE_B = (size_t)4096 * 2080;

namespace pg8 {
#define PG8_LAS __attribute__((address_space(3)))
typedef unsigned short bf16_t;
typedef short bf16x8 __attribute__((ext_vector_type(8)));
typedef float f32x4 __attribute__((ext_vector_type(4)));
typedef unsigned u32x4 __attribute__((ext_vector_type(4)));
constexpr int BM = 256, BK = 64, HALF = 128, HTB = HALF * BK * 2  , STAGE_BYTES = 8 * HTB, NXCD = 8, WGM = 8;

__host__ __device__ __forceinline__ int lds_byte(int r, int c) { const int st = (r >> 4) * 2 + (c >> 5), rr = r & 15, cc = c & 31, ob = rr * 64 + cc * 2; return st * 1024 + (ob ^ (((ob >> 9) & 1) << 5)); }
__host__ __device__ __forceinline__ void stage_rc(int b, int& R, int& C) { const int st = b / 1024, sb = b % 1024, swz = sb ^ (((sb >> 9) & 1) << 5); R = (st >> 1) * 16 + swz / 64; C = (st & 1) * 32 + (swz % 64) / 2; }
__host__ __device__ __forceinline__ int perm32(int rho) { const int n = rho >> 4, i = rho & 15; return 8 * (i >> 2) + 4 * n + (i & 3); }

struct Unit { int pm, pn; };
struct Gemm { const bf16_t* A; const bf16_t* Bt; int M, N, K; };

struct StaticOrder {
    int nM, nN, nwg, G, c;
    __host__ __device__ void init(int M, int N, int G_, int c_) { nM = M / BM; nN = N / BM; nwg = nM * nN; G = G_; c = c_; }
    __host__ __device__ bool next(int i, Unit& u) const {
        const long L = (long)i * G + c; if (L >= nwg) return false;
        int wgid = (int)L; { const int q = nwg / NXCD, r = nwg % NXCD, xcd = wgid % NXCD, off = wgid / NXCD; wgid = (xcd < r ? xcd * (q + 1) : r * (q + 1) + (xcd - r) * q) + off; }
        const int nig = WGM * nN, gid = wgid / nig, fm = gid * WGM, gsz = (nM - fm) < WGM ? (nM - fm) : WGM;
        u.pm = fm + ((wgid % nig) % gsz); u.pn = (wgid % nig) / gsz; return true;
    }
    __device__ __forceinline__ void a_ready(const Unit&) const {}
    __device__ __forceinline__ void done(const Unit&) const {}
};

typedef float pk_f32x2 __attribute__((ext_vector_type(2)));
typedef __bf16 pk_bf16x2 __attribute__((ext_vector_type(2)));
__device__ __forceinline__ unsigned cvt_pk_bf16(float lo, float hi) { const pk_f32x2 v = {lo, hi}; const pk_bf16x2 b = __builtin_convertvector(v, pk_bf16x2); return __builtin_bit_cast(unsigned, b); }
typedef unsigned u32x2 __attribute__((ext_vector_type(2)));
__device__ __forceinline__ u32x4 pack8(const f32x4 a, const f32x4 b) { u32x4 w; w.x = cvt_pk_bf16(a[0], a[1]); w.y = cvt_pk_bf16(a[2], a[3]); w.z = cvt_pk_bf16(b[0], b[1]); w.w = cvt_pk_bf16(b[2], b[3]); return w; }
__device__ __forceinline__ void unpack8(const u32x4 w, f32x4& a, f32x4& b) {
    a[0] = __uint_as_float(w.x << 16); a[1] = __uint_as_float(w.x & 0xffff0000u); a[2] = __uint_as_float(w.y << 16); a[3] = __uint_as_float(w.y & 0xffff0000u);
    b[0] = __uint_as_float(w.z << 16); b[1] = __uint_as_float(w.z & 0xffff0000u); b[2] = __uint_as_float(w.w << 16); b[3] = __uint_as_float(w.w & 0xffff0000u); }
__device__ __forceinline__ float sigm(float x) { return __builtin_amdgcn_rcpf(1.0f + __expf(-x)); }
__device__ __forceinline__ f32x4 sigm4(const f32x4 x) { f32x4 r; r[0] = sigm(x[0]); r[1] = sigm(x[1]); r[2] = sigm(x[2]); r[3] = sigm(x[3]); return r; }
__device__ __forceinline__ f32x4 silu4(const f32x4 x) { return x * sigm4(x); }

#define PG8_GAS __attribute__((address_space(1)))
struct EpiIn {
    static constexpr bool PERM = true, AFTER_DRAIN = false;
    unsigned char* ws0; int layer;
    __device__ __forceinline__ void operator()(const f32x4 (&acc)[2][2][4][2], const Unit& u, int wr, int wc, int fr, int fq) const {
        unsigned char* wsq = ws0; asm volatile("" : "+s"(wsq)); PG8_GAS unsigned char* const ws = (PG8_GAS unsigned char*)wsq;
        const int pn = u.pn, row0 = u.pm * BM + wr * 64 + fr, cw = wc * 32 + 8 * fq;
        PG8_GAS bf16_t* const QA = (PG8_GAS bf16_t*)(ws + WS_QA); PG8_GAS bf16_t* const KA = (PG8_GAS bf16_t*)(ws + WS_KA); PG8_GAS bf16_t* const VA = (PG8_GAS bf16_t*)(ws + WS_VA); PG8_GAS bf16_t* const GA = (PG8_GAS bf16_t*)(ws + WS_GA);
        PG8_GAS bf16_t* const QB = (PG8_GAS bf16_t*)(ws + WS_QB); PG8_GAS bf16_t* const KB = (PG8_GAS bf16_t*)(ws + WS_KB); PG8_GAS bf16_t* const VB = (PG8_GAS bf16_t*)(ws + WS_VB); PG8_GAS bf16_t* const QI = (PG8_GAS bf16_t*)(ws + WS_QI);
        PG8_GAS bf16_t* const SGA = (PG8_GAS bf16_t*)(ws + WS_SGA); PG8_GAS bf16_t* const SGB = (PG8_GAS bf16_t*)(ws + WS_SGB); PG8_GAS float* const LF = (PG8_GAS float*)(ws + WS_LF); PG8_GAS float* const IKW = (PG8_GAS float*)(ws + WS_IKW);
        const PG8_GAS float* const lb = (const PG8_GAS float*)(ws + WS_LB) + layer * 1024; const PG8_GAS float* const cosh = (const PG8_GAS float*)(ws + WS_COSH); const PG8_GAS float* const sinh = (const PG8_GAS float*)(ws + WS_SINH);
        const PG8_GAS float* const cosi = (const PG8_GAS float*)(ws + WS_COSI); const PG8_GAS float* const sini = (const PG8_GAS float*)(ws + WS_SINI);
        if (pn < 32) {
            const int seg = pn >> 2, cb = (pn & 3) * 256;
            if (seg == 4 || seg == 5) {
                PG8_GAS bf16_t* O = (seg == 4) ? QB : KB; const int head = (pn & 3) * 2 + (wc >> 1), i0 = (wc & 1) * 32 + 8 * fq;
#pragma unroll
                for (int ai = 0; ai < 2; ++ai)
#pragma unroll
                    for (int m = 0; m < 4; ++m) { const int row = row0 + ai * HALF + m * 16;
                        const PG8_GAS float* cp = cosh + (size_t)row * 64 + i0; const PG8_GAS float* sp = sinh + (size_t)row * 64 + i0;
                        const f32x4 c0 = *(const PG8_GAS f32x4*)cp, c1 = *(const PG8_GAS f32x4*)(cp + 4), s0 = *(const PG8_GAS f32x4*)sp, s1 = *(const PG8_GAS f32x4*)(sp + 4);
                        const f32x4 xa = acc[ai][0][m][0], xb = acc[ai][0][m][1], ya = acc[ai][1][m][0], yb = acc[ai][1][m][1];
                        PG8_GAS bf16_t* rp = O + (size_t)row * 1024 + head * 128 + i0;
                        *(PG8_GAS u32x4*)rp = pack8(xa * c0 - ya * s0, xb * c1 - yb * s1);
                        *(PG8_GAS u32x4*)(rp + 64) = pack8(xa * s0 + ya * c0, xb * s1 + yb * c1); asm volatile("" ::: "memory"); }
            } else if (seg == 7) {
                const int head = (pn & 3) * 4 + wc, i0 = 8 * fq;
#pragma unroll
                for (int ai = 0; ai < 2; ++ai)
#pragma unroll
                    for (int m = 0; m < 4; ++m) { const int row = row0 + ai * HALF + m * 16;
                        const PG8_GAS float* cp = cosi + (size_t)row * 32 + i0; const PG8_GAS float* sp = sini + (size_t)row * 32 + i0;
                        const f32x4 c0 = *(const PG8_GAS f32x4*)cp, c1 = *(const PG8_GAS f32x4*)(cp + 4), s0 = *(const PG8_GAS f32x4*)sp, s1 = *(const PG8_GAS f32x4*)(sp + 4);
                        const f32x4 xa = acc[ai][0][m][0], xb = acc[ai][0][m][1], ya = acc[ai][1][m][0], yb = acc[ai][1][m][1];
                        PG8_GAS bf16_t* rp = QI + (size_t)row * 1024 + head * 64 + i0;
                        *(PG8_GAS u32x4*)rp = pack8(xa * c0 - ya * s0, xb * c1 - yb * s1);
                        *(PG8_GAS u32x4*)(rp + 32) = pack8(xa * s0 + ya * c0, xb * s1 + yb * c1); asm volatile("" ::: "memory"); }
            } else if (seg == 1) {
#pragma unroll
                for (int bj = 0; bj < 2; ++bj) { const int col = cb + bj * HALF + cw;
                    const f32x4 l0 = *(const PG8_GAS f32x4*)(lb + col), l1 = *(const PG8_GAS f32x4*)(lb + col + 4);
#pragma unroll
                    for (int ai = 0; ai < 2; ++ai)
#pragma unroll
                        for (int m = 0; m < 4; ++m) { const int row = row0 + ai * HALF + m * 16; f32x4 lf[2], kk[2];
#pragma unroll
                            for (int n = 0; n < 2; ++n) { const f32x4 x = acc[ai][bj][m][n]; const f32x4 lv = n ? l1 : l0;
#pragma unroll
                                for (int j = 0; j < 4; ++j) { const float xe = fminf(fmaxf(x[j], -80.f), 80.f), e = __expf(-xe), r = __builtin_amdgcn_rcpf(1.0f + e);
                                    const float om = 1.0f - lv[j]; lf[n][j] = logf(lv[j] + om * r); kk[n][j] = om * (e * r); } }
                            PG8_GAS float* lp = LF + (size_t)row * 1024 + col; *(PG8_GAS f32x4*)lp = lf[0]; *(PG8_GAS f32x4*)(lp + 4) = lf[1];
                            *(PG8_GAS u32x4*)(KA + (size_t)row * 1024 + col) = pack8(kk[0], kk[1]); asm volatile("" ::: "memory"); } }
            } else {
                PG8_GAS bf16_t* O = (seg == 0) ? QA : (seg == 2) ? VA : (seg == 3) ? GA : VB; const bool act = (seg == 0 || seg == 3);
#pragma unroll
                for (int ai = 0; ai < 2; ++ai)
#pragma unroll
                    for (int m = 0; m < 4; ++m) { const int row = row0 + ai * HALF + m * 16;
#pragma unroll
                        for (int bj = 0; bj < 2; ++bj) { f32x4 v0 = acc[ai][bj][m][0], v1 = acc[ai][bj][m][1];
                            if (act) { v0 = silu4(v0); v1 = silu4(v1); }
                            *(PG8_GAS u32x4*)(O + (size_t)row * 1024 + cb + bj * HALF + cw) = pack8(v0, v1); } }
            }
        } else if (pn < 48) {
            PG8_GAS bf16_t* O = (pn < 40) ? SGA : SGB; const int cb = ((pn - 32) & 7) * 256;
#pragma unroll
            for (int ai = 0; ai < 2; ++ai)
#pragma unroll
                for (int m = 0; m < 4; ++m) { const int row = row0 + ai * HALF + m * 16;
#pragma unroll
                    for (int bj = 0; bj < 2; ++bj)
                        *(PG8_GAS u32x4*)(O + (size_t)row * DM + cb + bj * HALF + cw) = pack8(sigm4(acc[ai][bj][m][0]), sigm4(acc[ai][bj][m][1])); }
        } else {
#pragma unroll
            for (int ai = 0; ai < 2; ++ai)
#pragma unroll
                for (int m = 0; m < 4; ++m) { PG8_GAS float* p = IKW + (size_t)(row0 + ai * HALF + m * 16) * 128 + cw; *(PG8_GAS f32x4*)p = acc[ai][0][m][0]; *(PG8_GAS f32x4*)(p + 4) = acc[ai][0][m][1]; }
        }
    }
};
struct EpiGateA {
    static constexpr bool PERM = true, AFTER_DRAIN = false;
    unsigned char* ws;
    __device__ __forceinline__ void operator()(const f32x4 (&acc)[2][2][4][2], const Unit& u, int wr, int wc, int fr, int fq) const {
        unsigned char* const wg = as_global(ws); const bf16_t* const SG = (const bf16_t*)(wg + WS_SGA); float* const AF = (float*)(wg + WS_XPRE);
        const int row0 = u.pm * BM + wr * 64 + fr, col0 = u.pn * BM + wc * 32 + 8 * fq;
#pragma unroll
        for (int ai = 0; ai < 2; ++ai)
#pragma unroll
            for (int m = 0; m < 4; ++m) { const size_t off = (size_t)(row0 + ai * HALF + m * 16) * DM + col0;
#pragma unroll
                for (int bj = 0; bj < 2; ++bj) { f32x4 g0, g1; unpack8(*(const u32x4*)(SG + off + bj * HALF), g0, g1);
                    float* p = AF + off + bj * HALF; *(f32x4*)p = g0 * acc[ai][bj][m][0]; *(f32x4*)(p + 4) = g1 * acc[ai][bj][m][1]; } asm volatile("" ::: "memory"); }
    }
};
struct EpiGateB {
    static constexpr bool PERM = true, AFTER_DRAIN = false;
    unsigned char* ws;
    __device__ __forceinline__ void operator()(const f32x4 (&acc)[2][2][4][2], const Unit& u, int wr, int wc, int fr, int fq) const {
        unsigned char* const wg = as_global(ws); const bf16_t* const SG = (const bf16_t*)(wg + WS_SGB); const float* const AF = (const float*)(wg + WS_XPRE); bf16_t* const MG = (bf16_t*)(wg + WS_MG);
        const int row0 = u.pm * BM + wr * 64 + fr, col0 = u.pn * BM + wc * 32 + 8 * fq;
#pragma unroll
        for (int ai = 0; ai < 2; ++ai)
#pragma unroll
            for (int m = 0; m < 4; ++m) { const size_t off = (size_t)(row0 + ai * HALF + m * 16) * DM + col0;
#pragma unroll
                for (int bj = 0; bj < 2; ++bj) { f32x4 g0, g1; unpack8(*(const u32x4*)(SG + off + bj * HALF), g0, g1);
                    const float* p = AF + off + bj * HALF; const f32x4 a0 = *(const f32x4*)p, a1 = *(const f32x4*)(p + 4);
                    *(u32x4*)(MG + off + bj * HALF) = pack8(a0 + g0 * acc[ai][bj][m][0], a1 + g1 * acc[ai][bj][m][1]); } asm volatile("" ::: "memory"); }
    }
};
struct EpiRes {
    static constexpr bool PERM = true, AFTER_DRAIN = false;
    const float* X; unsigned char* ws;
    __device__ __forceinline__ void operator()(const f32x4 (&acc)[2][2][4][2], const Unit& u, int wr, int wc, int fr, int fq) const {
        float* const XP = (float*)(as_global(ws) + WS_XPRE); const float* const Xg = as_global(X);
        const int row0 = u.pm * BM + wr * 64 + fr, col0 = u.pn * BM + wc * 32 + 8 * fq;
#pragma unroll
        for (int ai = 0; ai < 2; ++ai)
#pragma unroll
            for (int m = 0; m < 4; ++m) { const size_t off = (size_t)(row0 + ai * HALF + m * 16) * DM + col0;
#pragma unroll
                for (int bj = 0; bj < 2; ++bj) { const float* xp = Xg + off + bj * HALF; const f32x4 x0 = *(const f32x4*)xp, x1 = *(const f32x4*)(xp + 4);
                    float* p = XP + off + bj * HALF; *(f32x4*)p = x0 * ALPHA + acc[ai][bj][m][0]; *(f32x4*)(p + 4) = x1 * ALPHA + acc[ai][bj][m][1]; } asm volatile("" ::: "memory"); }
    }
};
struct EpiSwiGLU {
    static constexpr bool PERM = true, AFTER_DRAIN = false;
    unsigned char* ws;
    __device__ __forceinline__ void operator()(const f32x4 (&acc)[2][2][4][2], const Unit& u, int wr, int wc, int fr, int fq) const {
        bf16_t* const H = (bf16_t*)(as_global(ws) + WS_H);
        const int row0 = u.pm * BM + wr * 64 + fr, col0 = u.pn * HALF + wc * 32 + 8 * fq;
#pragma unroll
        for (int ai = 0; ai < 2; ++ai)
#pragma unroll
            for (int m = 0; m < 4; ++m)
                *(u32x4*)(H + (size_t)(row0 + ai * HALF + m * 16) * DFF + col0) = pack8(silu4(acc[ai][0][m][0]) * acc[ai][1][m][0], silu4(acc[ai][0][m][1]) * acc[ai][1][m][1]);
    }
};
struct EpiF32P {
    static constexpr bool PERM = true, AFTER_DRAIN = false;
    unsigned char* ws;
    __device__ __forceinline__ void operator()(const f32x4 (&acc)[2][2][4][2], const Unit& u, int wr, int wc, int fr, int fq) const {
        float* const C = (float*)(as_global(ws) + WS_PP);
        const int row0 = u.pm * BM + wr * 64 + fr, col0 = u.pn * BM + wc * 32 + 8 * fq;
#pragma unroll
        for (int ai = 0; ai < 2; ++ai)
#pragma unroll
            for (int m = 0; m < 4; ++m) { const size_t off = (size_t)(row0 + ai * HALF + m * 16) * DM + col0;
#pragma unroll
                for (int bj = 0; bj < 2; ++bj) { float* p = C + off + bj * HALF; *(f32x4*)p = acc[ai][bj][m][0]; *(f32x4*)(p + 4) = acc[ai][bj][m][1]; } }
    }
};
struct EpiPle {
    static constexpr bool PERM = true, AFTER_DRAIN = false;
    unsigned char* ws;
    __device__ __forceinline__ void operator()(const f32x4 (&acc)[2][2][4][2], const Unit& u, int wr, int wc, int fr, int fq) const {
        const float* const X = (const float*)(ws + WS_X32); const float* const PP = (const float*)(ws + WS_PP); float* const XP = (float*)(as_global(ws) + WS_XPRE); const float* const Xg = as_global(X);
        const int row0 = u.pm * BM + wr * 64 + fr, col0 = u.pn * BM + wc * 32 + 8 * fq;
#pragma unroll
        for (int ai = 0; ai < 2; ++ai)
#pragma unroll
            for (int m = 0; m < 4; ++m) { const size_t off = (size_t)(row0 + ai * HALF + m * 16) * DM + col0;
#pragma unroll
                for (int bj = 0; bj < 2; ++bj) { const float* xp = Xg + off + bj * HALF; const f32x4 x0 = *(const f32x4*)xp, x1 = *(const f32x4*)(xp + 4);
                    const float* pp = PP + off + bj * HALF; const f32x4 p0 = *(const f32x4*)pp, p1 = *(const f32x4*)(pp + 4);
                    float* p = XP + off + bj * HALF; *(f32x4*)p = x0 * ALPHA + sigm4(acc[ai][bj][m][0]) * p0; *(f32x4*)(p + 4) = x1 * ALPHA + sigm4(acc[ai][bj][m][1]) * p1; } asm volatile("" ::: "memory"); }
    }
};

struct EpiRawTest {
    static constexpr bool PERM = true, AFTER_DRAIN = false;
    unsigned char* ws;
    __device__ __forceinline__ void operator()(const f32x4 (&acc)[2][2][4][2], const Unit& u, int wr, int wc, int fr, int fq) const {
        bf16_t* const H = (bf16_t*)(as_global(ws) + WS_H);
        const int row0 = u.pm * BM + wr * 64 + fr, col0 = u.pn * HALF + wc * 32 + 8 * fq;
#pragma unroll
        for (int ai = 0; ai < 2; ++ai)
#pragma unroll
            for (int m = 0; m < 4; ++m)
                *(u32x4*)(H + (size_t)(row0 + ai * HALF + m * 16) * 6272 + col0) = pack8(acc[ai][0][m][0] + acc[ai][1][m][0], acc[ai][0][m][1] + acc[ai][1][m][1]);
    }
};
template <class Epi, class Sched, bool ALIGN_EPI = false, bool SP2 = false>
__device__ __forceinline__ void gemm_phase(PG8_LAS unsigned char* lds, const Gemm g, const Sched& S, const Epi& E) {
    const int tid = tid_(), wid = __builtin_amdgcn_readfirstlane(tid >> 6), lane = tid & 63, wr = wid >> 2, wc = wid & 3, fr = lane & 15, fq = lane >> 4;
    int Kq = g.K; asm volatile("" : "+s"(Kq)); const int K = Kq, nt = K / BK;
    unsigned voffA[2], voffB[2];
#pragma unroll
    for (int i = 0; i < 2; ++i) { int R, C; stage_rc(tid * 16 + i * 8192, R, C); const int Rb = Epi::PERM ? ((R & ~31) + perm32(R & 31)) : R;
        voffA[i] = (unsigned)(R * K + C) * 2u; voffB[i] = (unsigned)(Rb * K + C) * 2u; }
    const size_t kstep = (size_t)(BK * 2);
    const size_t hstep = (size_t)HALF * K * 2;
    const size_t tstep = 2 * hstep;
    const unsigned ldsw = (unsigned)wid * 1024u;
    const int aoff = lds_byte(wr * 64 + fr, fq * 8), boff = lds_byte(wc * 32 + fr, fq * 8);
#define PG8_SA(b, h) (((b) * 2 + (h)) * HTB)
#define PG8_SB(b, h) ((4 + (b) * 2 + (h)) * HTB)
#define PG8_STAGE(bufoff, gbase, voff) do { _Pragma("unroll") for (int _i = 0; _i < 2; ++_i) \
        __builtin_amdgcn_global_load_lds((const unsigned*)((const char*)(gbase) + (voff)[_i]), (PG8_LAS unsigned*)(lds + (bufoff) + ldsw + _i * 8192), 16, 0, 0); } while (0)
#define PG8_LDA(dst, b, h) do { _Pragma("unroll") for (int m = 0; m < 4; ++m) _Pragma("unroll") for (int k = 0; k < 2; ++k) dst[m][k] = *(const PG8_LAS bf16x8*)(lds + PG8_SA(b, h) + aoff + m * 2048 + k * 1024); } while (0)
#define PG8_LDB(dst, b, h) do { _Pragma("unroll") for (int n = 0; n < 2; ++n) _Pragma("unroll") for (int k = 0; k < 2; ++k) dst[n][k] = *(const PG8_LAS bf16x8*)(lds + PG8_SB(b, h) + boff + n * 2048 + k * 1024); } while (0)
#define PG8_MMA(ai, bj, At, Bt) do { __builtin_amdgcn_s_setprio(1); _Pragma("unroll") for (int m = 0; m < 4; ++m) _Pragma("unroll") for (int n = 0; n < 2; ++n) _Pragma("unroll") for (int k = 0; k < 2; ++k) \
        acc[ai][bj][m][n] = __builtin_amdgcn_mfma_f32_16x16x32_bf16(Bt[n][k], At[m][k], acc[ai][bj][m][n], 0, 0, 0); __builtin_amdgcn_s_setprio(0); } while (0)
#define PG8_WAIT_V(n) asm volatile("s_waitcnt vmcnt(" #n ")" ::: "memory")
#define PG8_WAIT_L(n) asm volatile("s_waitcnt lgkmcnt(" #n ")" ::: "memory")
#define PG8_BAR __builtin_amdgcn_s_barrier()
#define PG8_SCHED __builtin_amdgcn_sched_barrier(0)
    Unit cur, nxt; int ui = 0;
    if (!S.next(0, cur)) return;
    f32x4 acc[2][2][4][2];
#pragma unroll
    for (int a = 0; a < 2; ++a)
#pragma unroll
        for (int b = 0; b < 2; ++b)
#pragma unroll
            for (int m = 0; m < 4; ++m)
#pragma unroll
                for (int n = 0; n < 2; ++n) acc[a][b][m][n] = (f32x4){0.f, 0.f, 0.f, 0.f};
    bf16x8 At[4][2], B0[2][2], B1[2][2];
    const char* cA = (const char*)g.A + (size_t)cur.pm * tstep; const char* cB = (const char*)g.Bt + (size_t)cur.pn * tstep;
    S.a_ready(cur);
    if constexpr (SP2) {
        PG8_STAGE(PG8_SB(0, 0), cB, voffB); PG8_STAGE(PG8_SB(0, 1), cB + hstep, voffB); PG8_STAGE(PG8_SA(0, 0), cA, voffA); PG8_STAGE(PG8_SA(0, 1), cA + hstep, voffA);
        if (wr == 1) PG8_BAR;
        PG8_WAIT_V(2); PG8_BAR;
        PG8_STAGE(PG8_SB(1, 0), cB + kstep, voffB); PG8_STAGE(PG8_SA(1, 0), cA + kstep, voffA); PG8_STAGE(PG8_SB(1, 1), cB + hstep + kstep, voffB);
        PG8_WAIT_V(6); PG8_BAR;
    } else {
        PG8_STAGE(PG8_SB(0, 0), cB, voffB); PG8_STAGE(PG8_SA(0, 0), cA, voffA); PG8_STAGE(PG8_SB(0, 1), cB + hstep, voffB); PG8_STAGE(PG8_SA(0, 1), cA + hstep, voffA);
        if (wr == 1) PG8_BAR;
        PG8_WAIT_V(4); PG8_BAR;
        PG8_STAGE(PG8_SB(1, 0), cB + kstep, voffB); PG8_STAGE(PG8_SA(1, 0), cA + kstep, voffA); PG8_STAGE(PG8_SB(1, 1), cB + hstep + kstep, voffB);
        PG8_WAIT_V(6); PG8_BAR;
    }
    for (;;) {
        const bool has_next = S.next(ui + 1, nxt);
        const char* nA = has_next ? (const char*)g.A + (size_t)nxt.pm * tstep : cA; const char* nB = has_next ? (const char*)g.Bt + (size_t)nxt.pn * tstep : cB;
        for (int t = 0; t < nt; t += 2) {
            const bool last = (t == nt - 2);
            const char* a1 = cA + (size_t)(t + 1) * kstep;
            const char* a2 = last ? nA : cA + (size_t)(t + 2) * kstep; const char* b2 = last ? nB : cB + (size_t)(t + 2) * kstep;
            const char* a3 = a2 + kstep; const char* b3 = b2 + kstep;
            if (last && has_next) S.a_ready(nxt);
            if constexpr (SP2) {
            PG8_LDB(B0, 0, 0); PG8_LDB(B1, 0, 1); PG8_SCHED; PG8_LDA(At, 0, 0); PG8_STAGE(PG8_SA(1, 1), a1 + hstep, voffA);
            PG8_WAIT_V(8); PG8_WAIT_L(0); PG8_BAR; PG8_MMA(0, 0, At, B0); PG8_MMA(0, 1, At, B1); PG8_BAR; PG8_SCHED;
            PG8_LDA(At, 0, 1); PG8_STAGE(PG8_SB(0, 0), b2, voffB); PG8_STAGE(PG8_SB(0, 1), b2 + hstep, voffB); PG8_STAGE(PG8_SA(0, 0), a2, voffA);
            PG8_WAIT_V(8); PG8_WAIT_L(0); PG8_BAR; PG8_MMA(1, 0, At, B0); PG8_MMA(1, 1, At, B1); PG8_BAR; PG8_SCHED;
            PG8_LDB(B0, 1, 0); PG8_LDB(B1, 1, 1); PG8_SCHED; PG8_LDA(At, 1, 0); PG8_STAGE(PG8_SA(0, 1), a2 + hstep, voffA);
            PG8_WAIT_V(8); PG8_WAIT_L(0); PG8_BAR; PG8_MMA(0, 0, At, B0); PG8_MMA(0, 1, At, B1); PG8_BAR; PG8_SCHED;
            PG8_LDA(At, 1, 1); PG8_STAGE(PG8_SB(1, 0), b3, voffB); PG8_STAGE(PG8_SB(1, 1), b3 + hstep, voffB); PG8_STAGE(PG8_SA(1, 0), a3, voffA);
            PG8_WAIT_V(8); PG8_WAIT_L(0); PG8_BAR; PG8_MMA(1, 0, At, B0); PG8_MMA(1, 1, At, B1); PG8_BAR; PG8_SCHED;
            } else {
            PG8_LDB(B0, 0, 0); PG8_SCHED; PG8_LDA(At, 0, 0); PG8_STAGE(PG8_SA(1, 1), a1 + hstep, voffA);
            PG8_WAIT_L(8); PG8_BAR; PG8_WAIT_L(0); PG8_MMA(0, 0, At, B0); PG8_BAR; PG8_SCHED;
            PG8_LDB(B1, 0, 1); PG8_STAGE(PG8_SB(0, 0), b2, voffB);
            PG8_BAR; PG8_WAIT_L(0); PG8_MMA(0, 1, At, B1); PG8_BAR;
            PG8_LDA(At, 0, 1); PG8_STAGE(PG8_SA(0, 0), a2, voffA);
            PG8_BAR; PG8_WAIT_L(0); PG8_MMA(1, 0, At, B0); PG8_BAR; PG8_SCHED;
            PG8_STAGE(PG8_SB(0, 1), b2 + hstep, voffB);
            PG8_WAIT_V(6); PG8_BAR; PG8_MMA(1, 1, At, B1); PG8_BAR;
            PG8_LDB(B0, 1, 0); PG8_SCHED; PG8_LDA(At, 1, 0); PG8_STAGE(PG8_SA(0, 1), a2 + hstep, voffA);
            PG8_WAIT_L(8); PG8_BAR; PG8_WAIT_L(0); PG8_MMA(0, 0, At, B0); PG8_BAR; PG8_SCHED;
            PG8_LDB(B1, 1, 1); PG8_STAGE(PG8_SB(1, 0), b3, voffB);
            PG8_BAR; PG8_WAIT_L(0); PG8_MMA(0, 1, At, B1); PG8_BAR;
            PG8_LDA(At, 1, 1); PG8_STAGE(PG8_SA(1, 0), a3, voffA);
            PG8_BAR; PG8_WAIT_L(0); PG8_MMA(1, 0, At, B0); PG8_BAR; PG8_SCHED;
            PG8_STAGE(PG8_SB(1, 1), b3 + hstep, voffB);
            PG8_WAIT_V(6); PG8_BAR; PG8_MMA(1, 1, At, B1); PG8_BAR;
            }
        }
        if constexpr (ALIGN_EPI) { if (wr == 0) PG8_BAR; }
        if constexpr (!Epi::AFTER_DRAIN) { E(acc, cur, wr, wc, fr, fq); S.done(cur); }
        if (!has_next) break;
#pragma unroll
        for (int a = 0; a < 2; ++a)
#pragma unroll
            for (int b = 0; b < 2; ++b)
#pragma unroll
                for (int m = 0; m < 4; ++m)
#pragma unroll
                    for (int n = 0; n < 2; ++n) acc[a][b][m][n] = (f32x4){0.f, 0.f, 0.f, 0.f};
        cur = nxt; cA = nA; cB = nB; ++ui;
        if constexpr (ALIGN_EPI) { if (wr == 1) PG8_BAR; }
    }
    PG8_WAIT_V(0);
    if constexpr (!ALIGN_EPI) { if (wr == 0) PG8_BAR; }
    PG8_BAR;
    if constexpr (Epi::AFTER_DRAIN) { E.fused(acc, cur, wr, wc, fr, fq, lds, wid, lane); S.done(cur); }
#undef PG8_SA
#undef PG8_SB
#undef PG8_STAGE
#undef PG8_LDA
#undef PG8_LDB
#undef PG8_MMA
#undef PG8_WAIT_V
#undef PG8_WAIT_L
#undef PG8_BAR
#undef PG8_SCHED
}
}
#define XB_TMO      128
#define XB_XCNT(j)  (256  + 64 * (j))
#define XB_XSUB(j)  (1280 + 64 * (j))
#define XB_XGEN(j)  (2304 + 64 * (j))
#define XB_TOP      3328
#define XB_TOPGEN   3392
#define XCD_BAR_WORDS 3456
#define XB_SPIN_CAP (1u << 18)
#define LAS __attribute__((address_space(3)))

__device__ __forceinline__ unsigned xb_ld(unsigned* p)              { return __hip_atomic_load(p, __ATOMIC_RELAXED, __HIP_MEMORY_SCOPE_AGENT); }
__device__ __forceinline__ unsigned xb_add(unsigned* p, unsigned v) { return __hip_atomic_fetch_add(p, v, __ATOMIC_RELAXED, __HIP_MEMORY_SCOPE_AGENT); }
__device__ __forceinline__ unsigned xb_xcc_id() { return (unsigned)__builtin_amdgcn_s_getreg((3 << 11) | 20) & 0xFu; }
#define XB_SPIN(cond, bar) do { unsigned _sp = 0; while (cond) { __builtin_amdgcn_s_sleep(1); \
    if ((++_sp & 255u) == 0u) { if (xb_ld(&(bar)[XB_TMO])) break; if (_sp > XB_SPIN_CAP) { atomicAdd(&(bar)[XB_TMO], 1u); break; } } } } while (0)

struct XcdBarrier {
    unsigned* bar; unsigned x;
    volatile LAS unsigned* st;
};

__device__ __forceinline__ XcdBarrier xcd_barrier_post(unsigned* bar, volatile LAS unsigned* st) {
    XcdBarrier b; b.bar = bar; b.x = xb_xcc_id(); b.st = st;
    if (threadIdx.x == 0) (void)xb_add(&bar[XB_XCNT(b.x)], 1u);
    return b;
}
__device__ __forceinline__ void xcd_barrier_complete(unsigned* bar, unsigned x, unsigned& nloc, unsigned& nx) {
    const unsigned G = gridDim.x * gridDim.y * gridDim.z;
    unsigned sum, cnt, mine, sp = 0u;
    for (;;) {
        sum = 0u; cnt = 0u; mine = 0u;
#pragma unroll
        for (unsigned j = 0; j < 16; ++j) { const unsigned c = xb_ld(&bar[XB_XCNT(j)]); sum += c; cnt += (c > 0u) ? 1u : 0u; mine = (j == x) ? c : mine; }
        if (sum == G) break;
        __builtin_amdgcn_s_sleep(1);
        if ((++sp & 255u) == 0u) { if (xb_ld(&bar[XB_TMO])) break; if (sp > XB_SPIN_CAP) { atomicAdd(&bar[XB_TMO], 1u); break; } }
    }
    nloc = mine > 0u ? mine : 1u; nx = cnt > 0u ? cnt : 1u;
}

__device__ __forceinline__ void xcd_barrier(const XcdBarrier& b) {
    asm volatile("s_waitcnt vmcnt(0)" ::: "memory");
    __syncthreads();
    if (threadIdx.x == 0) {
        unsigned* bar = b.bar;
        __builtin_amdgcn_s_waitcnt(0);
        const unsigned bx = xb_xcc_id();
        unsigned nloc = b.st[0], nx = b.st[1];
        if (nloc == 0u) { xcd_barrier_complete(bar, bx, nloc, nx); b.st[0] = nloc; b.st[1] = nx; }
        const unsigned old = xb_add(&bar[XB_XSUB(bx)], 1u);
        const unsigned gen = old / nloc;
        if (old + 1u == (gen + 1u) * nloc) {
            __builtin_amdgcn_fence(__ATOMIC_RELEASE, "agent");
            asm volatile("s_waitcnt vmcnt(0)" ::: "memory");
            const unsigned og = xb_add(&bar[XB_TOP], 1u);
            const unsigned tg = og / nx;
            if (og + 1u == (tg + 1u) * nx) xb_add(&bar[XB_TOPGEN], 1u);
            else XB_SPIN(xb_ld(&bar[XB_TOPGEN]) == tg, bar);
            __builtin_amdgcn_fence(__ATOMIC_ACQUIRE, "agent");
            xb_add(&bar[XB_XGEN(bx)], 1u);
            asm volatile("s_waitcnt vmcnt(0)" ::: "memory");
        } else {
            XB_SPIN(xb_ld(&bar[XB_XGEN(bx)]) == gen, bar);
            __builtin_amdgcn_fence(__ATOMIC_ACQUIRE, "agent");
            asm volatile("s_waitcnt vmcnt(0)" ::: "memory");
        }
    }
    __syncthreads();
}

struct Params {
    const float* x; const float* p; const int* pos;
    const float *w_in, *w_a, *w_b, *w_out, *lbraw, *hnorm_g, *ikn_g, *ikn_b, *lnm_g, *lnm_b, *w_fg, *w_fu, *w_fd, *lnf_g, *lnf_b, *w_pg, *w_pp, *lnp_g, *lnp_b;
    float* out; unsigned char* ws;
    double invf_h[64]; double invf_i[32];
    int ph_lo, ph_hi;
};
typedef const __attribute__((address_space(4))) Params* KP;
__device__ __forceinline__ KP kparams() { KP p = (KP)__builtin_amdgcn_kernarg_segment_ptr(); asm volatile("" : "+s"(p)); return p; }
constexpr int NPH_LAYER = 14, NPH = DEPTH * NPH_LAYER;
constexpr int LDS_BYTES = 131072 + 1024;
constexpr int MISC_OFF = 131072;

__device__ __forceinline__ int wsrc_col_in(int n) {
    const int tile = n >> 8, t = n & 255;
    if (tile < 16) return n;
    if (tile < 24) { const int bj = t >> 7, u = t & 127, head = u >> 6, i = u & 63; return tile * 256 + 128 * head + 64 * bj + i; }
    if (tile < 28) return n;
    if (tile < 32) { const int bj = t >> 7, u = t & 127, head = u >> 5, i = u & 31; return tile * 256 + 64 * head + 32 * bj + i; }
    if (tile < 40) return 8272 + (n - 32 * 256);
    if (tile < 48) return 10320 + (n - 40 * 256);
    return t < 80 ? 8192 + t : -1;
}
template <int KIND>
__device__ __forceinline__ void wconv_wave_tile(const float* src, const float* src2, int nsrc, int K, bf16_t* dst, int n0, int k0, int lane) {
    const int n = n0 + lane; int c; const float* s = src;
    if (KIND == 0) c = n;
    else if (KIND == 1) c = wsrc_col_in(n);
    else { const int tl = n >> 8, t = n & 255; c = tl * 128 + (t & 127); if (t >= 128) s = src2; }
    float f[64];
    const float* sp = s + (size_t)k0 * nsrc + (c >= 0 ? c : 0);
#pragma unroll
    for (int kk = 0; kk < 64; ++kk) f[kk] = sp[(size_t)kk * nsrc];
    bf16_t* d = dst + (size_t)n * K + k0;
#pragma unroll
    for (int i = 0; i < 8; ++i) { pg8::u32x4 w;
        w.x = pg8::cvt_pk_bf16(f[8 * i], f[8 * i + 1]); w.y = pg8::cvt_pk_bf16(f[8 * i + 2], f[8 * i + 3]); w.z = pg8::cvt_pk_bf16(f[8 * i + 4], f[8 * i + 5]); w.w = pg8::cvt_pk_bf16(f[8 * i + 6], f[8 * i + 7]);
        if (c < 0) w = (pg8::u32x4){0u, 0u, 0u, 0u};
        *(pg8::u32x4*)(d + 8 * i) = w; }
}
template <int KIND>
__device__ __forceinline__ void wconv_job(const float* src, const float* src2, int nsrc, int K, bf16_t* dst, int ndst, int W, int NWV, int lane, int& tcount) {
    const int kt = K / 64, ntiles = (ndst / 64) * kt;
    const int nb = ndst / 64; int first = (W - tcount % NWV + NWV) % NWV;
    for (int t = first; t < ntiles; t += NWV) wconv_wave_tile<KIND>(src, src2, nsrc, K, dst, (t % nb) * 64, (t / nb) * 64, lane);
    tcount += ntiles;
}
__device__ __forceinline__ void phase_wconv(KP P, int layer) {
    unsigned char* ws = as_global(P->ws); int tc = 0;
    const int tid0 = tid_(), lane = tid0 & 63, W = bid_() * 8 + __builtin_amdgcn_readfirstlane(tid0 >> 6), NWV = nblk_() * 8;
    wconv_job<1>(as_global(P->w_in) + (size_t)layer * DM * INW, nullptr, INW, DM, (bf16_t*)(ws + WS_WIN), INP, W, NWV, lane, tc);
    wconv_job<0>(as_global(P->w_a) + (size_t)layer * AW * DM, nullptr, DM, AW, (bf16_t*)(ws + WS_WA), DM, W, NWV, lane, tc);
    wconv_job<0>(as_global(P->w_b) + (size_t)layer * BW * DM, nullptr, DM, BW, (bf16_t*)(ws + WS_WB), DM, W, NWV, lane, tc);
    wconv_job<0>(as_global(P->w_out) + (size_t)layer * DM * DM, nullptr, DM, DM, (bf16_t*)(ws + WS_WO), DM, W, NWV, lane, tc);
    wconv_job<2>(as_global(P->w_fg) + (size_t)layer * DM * DFF, as_global(P->w_fu) + (size_t)layer * DM * DFF, DFF, DM, (bf16_t*)(ws + WS_WGU), 2 * DFF, W, NWV, lane, tc);
    wconv_job<0>(as_global(P->w_fd) + (size_t)layer * DFF * DM, nullptr, DM, DFF, (bf16_t*)(ws + WS_WDN), DM, W, NWV, lane, tc);
    wconv_job<0>(as_global(P->w_pg) + (size_t)layer * DM * DM, nullptr, DM, DM, (bf16_t*)(ws + WS_WPG), DM, W, NWV, lane, tc);
    wconv_job<0>(as_global(P->w_pp) + (size_t)layer * PLE * DM, nullptr, DM, PLE, (bf16_t*)(ws + WS_WPP), DM, W, NWV, lane, tc);
    const float* ps = as_global(P->p) + (size_t)layer * TOK * PLE; bf16_t* pb = (bf16_t*)(ws + WS_PB);
    for (size_t i = ((size_t)bid_() * 512 + tid_()) * 8; i < (size_t)TOK * PLE; i += (size_t)nblk_() * 512 * 8)
        *(pg8::u32x4*)(pb + i) = pg8::pack8(*(const pg8::f32x4*)(ps + i), *(const pg8::f32x4*)(ps + i + 4));
}
__device__ __forceinline__ void phase_prologue(KP P) {
    unsigned char* ws = as_global(P->ws); const size_t gtid = (size_t)bid_() * 512 + tid_(), gsz = (size_t)nblk_() * 512;
    bf16_t* xb = (bf16_t*)(ws + WS_XB); const float* xin = as_global(P->x); const int* posg = as_global(P->pos); const float* lbr = as_global(P->lbraw);
    for (size_t i = gtid * 8; i < (size_t)TOK * DM; i += gsz * 8) *(pg8::u32x4*)(xb + i) = pg8::pack8(*(const pg8::f32x4*)(xin + i), *(const pg8::f32x4*)(xin + i + 4));
    float* ch = (float*)(ws + WS_COSH); float* sh = (float*)(ws + WS_SINH); float* ci = (float*)(ws + WS_COSI); float* si = (float*)(ws + WS_SINI);
    for (size_t i = gtid; i < (size_t)TOK * 64; i += gsz) { const int t = (int)(i >> 6), j = (int)(i & 63); const double rev = (double)posg[t] * P->invf_h[j]; const float fr = (float)(rev - rint(rev));
        ch[i] = __builtin_amdgcn_cosf(fr); sh[i] = __builtin_amdgcn_sinf(fr); }
    for (size_t i = gtid; i < (size_t)TOK * 32; i += gsz) { const int t = (int)(i >> 5), j = (int)(i & 31); const double rev = (double)posg[t] * P->invf_i[j]; const float fr = (float)(rev - rint(rev));
        ci[i] = __builtin_amdgcn_cosf(fr); si[i] = __builtin_amdgcn_sinf(fr); }
    float* lb = (float*)(ws + WS_LB);
    for (size_t c = gtid; c < 1024; c += gsz) { float v[4], mx = -1e30f; for (int l = 0; l < 4; ++l) { v[l] = lbr[l * 1024 + c]; mx = fmaxf(mx, v[l]); }
        float s = 0.f; for (int l = 0; l < 4; ++l) { v[l] = expf(v[l] - mx); s += v[l]; }
        float cum = 0.f; const float inv = 1.0f / s; for (int l = 0; l < 4; ++l) { cum += v[l] * inv; lb[l * 1024 + c] = cum - v[0] * inv; } }
}
__device__ __forceinline__ void phase_ln(const float* XP, float* X32, bf16_t* XB, const float* g, const float* b) {
    const int tid = tid_(), wave = __builtin_amdgcn_readfirstlane(tid >> 6), lane = tid & 63, nb8 = nblk_() * 8;
    for (int row = bid_() * 8 + wave; row < TOK; row += nb8) {
        const float* xp = XP + (size_t)row * DM; pg8::f32x4 v[8]; float s = 0.f;
#pragma unroll
        for (int c = 0; c < 8; ++c) { v[c] = *(const pg8::f32x4*)(xp + c * 256 + lane * 4); s += (v[c][0] + v[c][1]) + (v[c][2] + v[c][3]); }
#pragma unroll
        for (int o = 32; o >= 1; o >>= 1) s += __shfl_xor(s, o);
        const float mean = s * (1.0f / DM); float q = 0.f;
#pragma unroll
        for (int c = 0; c < 8; ++c) { v[c] = v[c] - mean; q += (v[c][0] * v[c][0] + v[c][1] * v[c][1]) + (v[c][2] * v[c][2] + v[c][3] * v[c][3]); }
#pragma unroll
        for (int o = 32; o >= 1; o >>= 1) q += __shfl_xor(q, o);
        const float rstd = 1.0f / sqrtf(q * (1.0f / DM) + LN_EPS);
#pragma unroll
        for (int c = 0; c < 8; ++c) { const int col = c * 256 + lane * 4; const pg8::f32x4 gg = *(const pg8::f32x4*)(g + col), bb = *(const pg8::f32x4*)(b + col);
            const pg8::f32x4 y = v[c] * rstd * gg + bb; *(pg8::f32x4*)(X32 + (size_t)row * DM + col) = y;
            pg8::u32x2 w; w.x = pg8::cvt_pk_bf16(y[0], y[1]); w.y = pg8::cvt_pk_bf16(y[2], y[3]); *(pg8::u32x2*)(XB + (size_t)row * DM + col) = w; }
    }
}
__device__ __forceinline__ void phase_ikprep(KP P, int layer) {
    unsigned char* ws = as_global(P->ws); const float* ikw = (const float*)(ws + WS_IKW); bf16_t* ki = (bf16_t*)(ws + WS_KI); float* wi = (float*)(ws + WS_WI);
    const float* ci = (const float*)(ws + WS_COSI); const float* si = (const float*)(ws + WS_SINI);
    const int tid = tid_(), wave = __builtin_amdgcn_readfirstlane(tid >> 6), lane = tid & 63, nb8 = nblk_() * 8;
    const float g = as_global(P->ikn_g)[layer * 64 + lane], b = as_global(P->ikn_b)[layer * 64 + lane];
    for (int t = bid_() * 8 + wave; t < TOK; t += nb8) {
        const float x = ikw[(size_t)t * 128 + lane]; float s = x;
#pragma unroll
        for (int o = 32; o >= 1; o >>= 1) s += __shfl_xor(s, o);
        const float mean = s * (1.0f / 64.0f), xc = x - mean; float q = xc * xc;
#pragma unroll
        for (int o = 32; o >= 1; o >>= 1) q += __shfl_xor(q, o);
        const float y = xc * (1.0f / sqrtf(q * (1.0f / 64.0f) + LN_EPS)) * g + b;
        const float other = __shfl_xor(y, 32); const int j = lane & 31; const float c = ci[(size_t)t * 32 + j], sn = si[(size_t)t * 32 + j];
        const float r = (lane < 32) ? (y * c - other * sn) : (other * sn + y * c);
        ki[(size_t)t * 64 + lane] = f2bf(r);
        if (lane < 16) wi[(size_t)t * 16 + lane] = ikw[(size_t)t * 128 + 64 + lane] * IDX_SCALE;
    }
}
typedef short bf16x8_t __attribute__((ext_vector_type(8)));
typedef short bf16x4_t __attribute__((ext_vector_type(4)));
typedef float f32x16_t __attribute__((ext_vector_type(16)));
constexpr int CUM_LD = 132;
constexpr int OPK_LD = 136;
constexpr int OPS_LD = 72;

__device__ __forceinline__ void hgrn_scan_cum(const float* LF, int tok0, int h, LAS float* cum, LAS float* tot, int tid) {
    const int k = tid & 127, qd = tid >> 7; float v[16];
#pragma unroll
    for (int i = 0; i < 16; ++i) v[i] = LF[(size_t)(tok0 + qd * 16 + i) * 1024 + h * 128 + k];
    float run = 0.f;
#pragma unroll
    for (int i = 0; i < 16; ++i) { run += v[i]; v[i] = run; }
    tot[qd * 128 + k] = run;
    __syncthreads();
    float off = 0.f;
#pragma unroll
    for (int q = 0; q < 3; ++q) off += (q < qd) ? tot[q * 128 + k] : 0.f;
#pragma unroll
    for (int i = 0; i < 16; ++i) cum[(qd * 16 + i) * CUM_LD + k] = v[i] + off;
    __syncthreads();
}

__device__ __forceinline__ void phase_hgrn_h1(KP P, LAS unsigned char* lds) {
    unsigned char* ws = as_global(P->ws);
    const bf16_t* KA = (const bf16_t*)(ws + WS_KA); const bf16_t* VA = (const bf16_t*)(ws + WS_VA); const float* LF = (const float*)(ws + WS_LF);
    float* LT = (float*)(ws + WS_LT); float* DEC = (float*)(ws + WS_DEC);
    const int tid = tid_(), lane = tid & 63, wave = __builtin_amdgcn_readfirstlane(tid >> 6), r = lane & 31, hh = lane >> 5, G = nblk_();
    LAS float* cum = (LAS float*)lds; LAS float* tot = cum + 64 * CUM_LD;
    LAS bf16_t* kdT = (LAS bf16_t*)(tot + 512); LAS bf16_t* vT = kdT + 128 * OPS_LD;
    for (int unit = bid_(); unit < NBATCH * AH * 64; unit += G) {
        const int c = unit & 63, h = (unit >> 6) & 7, b = unit >> 9, tok0 = b * SEQ + c * 64;
        hgrn_scan_cum(LF, tok0, h, cum, tot, tid);
#pragma unroll
        for (int it = 0; it < 8; ++it) { const int idx = tid + 512 * it, k = idx & 127, sp = idx >> 7, s = 2 * sp;
            const float last = cum[63 * CUM_LD + k];
            const size_t g0 = (size_t)(tok0 + s) * 1024 + h * 128 + k;
            const float k0 = bf2f(KA[g0]) * __expf(last - cum[s * CUM_LD + k]), k1 = bf2f(KA[g0 + 1024]) * __expf(last - cum[(s + 1) * CUM_LD + k]);
            *(LAS unsigned*)(kdT + k * OPS_LD + s) = pg8::cvt_pk_bf16(k0, k1);
            *(LAS unsigned*)(vT + k * OPS_LD + s) = (unsigned)VA[g0] | ((unsigned)VA[g0 + 1024] << 16); }
        if (tid < 128) DEC[(size_t)unit * 128 + tid] = __expf(cum[63 * CUM_LD + tid]);
        __syncthreads();
        const int mb = wave >> 1, nb0 = (wave & 1) * 2;
        f32x16_t acc[2];
#pragma unroll
        for (int n = 0; n < 2; ++n)
#pragma unroll
            for (int i = 0; i < 16; ++i) acc[n][i] = 0.f;
#pragma unroll
        for (int ks = 0; ks < 4; ++ks) { const bf16x8_t a = *(const LAS bf16x8_t*)(kdT + (32 * mb + r) * OPS_LD + 16 * ks + 8 * hh);
#pragma unroll
            for (int n = 0; n < 2; ++n) { const bf16x8_t bb = *(const LAS bf16x8_t*)(vT + (32 * (nb0 + n) + r) * OPS_LD + 16 * ks + 8 * hh);
                acc[n] = __builtin_amdgcn_mfma_f32_32x32x16_bf16(a, bb, acc[n], 0, 0, 0); } }
#pragma unroll
        for (int n = 0; n < 2; ++n) { float* dst = LT + (size_t)unit * 16384 + (size_t)(32 * (nb0 + n) + r) * 128 + 32 * mb + 4 * hh;
#pragma unroll
            for (int g = 0; g < 4; ++g) { pg8::f32x4 o; o[0] = acc[n][4 * g]; o[1] = acc[n][4 * g + 1]; o[2] = acc[n][4 * g + 2]; o[3] = acc[n][4 * g + 3]; *(pg8::f32x4*)(dst + 8 * g) = o; } }
        __syncthreads();
    }
}

__device__ __forceinline__ void phase_hgrn_h2(KP P) {
    unsigned char* ws = as_global(P->ws);
    const float* LT = (const float*)(ws + WS_LT); const float* DEC = (const float*)(ws + WS_DEC); bf16_t* PT = (bf16_t*)(ws + WS_PT);
    const int tid = tid_(), G = nblk_();
    for (int quad = bid_() * 512 + tid; quad < NBATCH * AH * 4096; quad += G * 512) {
        const int bh = quad >> 12, rem = quad & 4095, v = rem >> 5, k0 = (rem & 31) * 4;
        const size_t e0 = (size_t)bh * 64 * 16384 + (size_t)v * 128 + k0; const size_t d0 = (size_t)bh * 64 * 128 + k0;
        pg8::f32x4 S = {0.f, 0.f, 0.f, 0.f};
        for (int c0 = 0; c0 < 64; c0 += 8) { pg8::f32x4 Lc[8], Dc[8];
#pragma unroll
            for (int j = 0; j < 8; ++j) { Lc[j] = *(const pg8::f32x4*)(LT + e0 + (size_t)(c0 + j) * 16384); Dc[j] = *(const pg8::f32x4*)(DEC + d0 + (size_t)(c0 + j) * 128); }
#pragma unroll
            for (int j = 0; j < 8; ++j) { pg8::u32x2 w; w.x = pg8::cvt_pk_bf16(S[0], S[1]); w.y = pg8::cvt_pk_bf16(S[2], S[3]);
                *(pg8::u32x2*)(PT + e0 + (size_t)(c0 + j) * 16384) = w; S = Dc[j] * S + Lc[j]; } }
    }
}

__device__ __forceinline__ void phase_hgrn_h3(KP P, int layer, LAS unsigned char* lds) {
    unsigned char* ws = as_global(P->ws);
    const bf16_t* QA = (const bf16_t*)(ws + WS_QA); const bf16_t* KA = (const bf16_t*)(ws + WS_KA); const bf16_t* VA = (const bf16_t*)(ws + WS_VA); const bf16_t* GA = (const bf16_t*)(ws + WS_GA);
    const float* LF = (const float*)(ws + WS_LF); const bf16_t* PT = (const bf16_t*)(ws + WS_PT); bf16_t* YA = (bf16_t*)(ws + WS_YA);
    const float* ng = as_global(P->hnorm_g) + layer * 128;
    const int tid = tid_(), lane = tid & 63, wave = __builtin_amdgcn_readfirstlane(tid >> 6), r = lane & 31, hh = lane >> 5, G = nblk_();
    LAS float* cum = (LAS float*)lds; LAS float* tot = cum + 64 * CUM_LD; LAS float* ssq = tot + 512;
    LAS bf16_t* qd = (LAS bf16_t*)(ssq + 256); LAS bf16_t* qs = qd + 64 * OPK_LD; LAS bf16_t* ks = qs + 64 * OPK_LD; LAS bf16_t* vT = ks + 64 * OPK_LD;
    for (int unit = bid_(); unit < NBATCH * AH * 64; unit += G) {
        const int c = unit & 63, h = (unit >> 6) & 7, b = unit >> 9, tok0 = b * SEQ + c * 64;
        hgrn_scan_cum(LF, tok0, h, cum, tot, tid);
#pragma unroll
        for (int it = 0; it < 8; ++it) { const int idx = tid + 512 * it, kp = (idx & 63) * 2, t = idx >> 6;
            const size_t g0 = (size_t)(tok0 + t) * 1024 + h * 128 + kp;
            const unsigned qw = *(const unsigned*)(QA + g0), kw = *(const unsigned*)(KA + g0);
            const float c0 = cum[t * CUM_LD + kp], c1 = cum[t * CUM_LD + kp + 1], r0 = cum[31 * CUM_LD + kp], r1 = cum[31 * CUM_LD + kp + 1];
            const float q0 = __uint_as_float(qw << 16), q1 = __uint_as_float(qw & 0xffff0000u), k0 = __uint_as_float(kw << 16), k1 = __uint_as_float(kw & 0xffff0000u);
            *(LAS unsigned*)(qd + t * OPK_LD + kp) = pg8::cvt_pk_bf16(q0 * __expf(c0), q1 * __expf(c1));
            *(LAS unsigned*)(qs + t * OPK_LD + kp) = pg8::cvt_pk_bf16(q0 * __expf(c0 - r0), q1 * __expf(c1 - r1));
            *(LAS unsigned*)(ks + t * OPK_LD + kp) = pg8::cvt_pk_bf16(k0 * __expf(r0 - c0), k1 * __expf(r1 - c1)); }
#pragma unroll
        for (int it = 0; it < 8; ++it) { const int idx = tid + 512 * it, v = idx & 127, sp = idx >> 7, s = 2 * sp;
            const size_t g0 = (size_t)(tok0 + s) * 1024 + h * 128 + v;
            *(LAS unsigned*)(vT + v * OPS_LD + s) = (unsigned)VA[g0] | ((unsigned)VA[g0 + 1024] << 16); }
        __syncthreads();
        const int mb = wave >> 1, tb = wave & 1;
        f32x16_t acc;
#pragma unroll
        for (int i = 0; i < 16; ++i) acc[i] = 0.f;
        { const bf16_t* prow = PT + (size_t)unit * 16384 + (size_t)(32 * mb + r) * 128 + 8 * hh;
#pragma unroll
          for (int k8 = 0; k8 < 8; ++k8) { const bf16x8_t a = *(const bf16x8_t*)(prow + 16 * k8); const bf16x8_t bq = *(const LAS bf16x8_t*)(qd + (32 * tb + r) * OPK_LD + 16 * k8 + 8 * hh);
              acc = __builtin_amdgcn_mfma_f32_32x32x16_bf16(a, bq, acc, 0, 0, 0); } }
#pragma unroll
        for (int sb = 0; sb < 2; ++sb) if (sb <= tb) {
            f32x16_t sc;
#pragma unroll
            for (int i = 0; i < 16; ++i) sc[i] = 0.f;
#pragma unroll
            for (int k8 = 0; k8 < 8; ++k8) { const bf16x8_t a = *(const LAS bf16x8_t*)(ks + (32 * sb + r) * OPK_LD + 16 * k8 + 8 * hh); const bf16x8_t bq = *(const LAS bf16x8_t*)(qs + (32 * tb + r) * OPK_LD + 16 * k8 + 8 * hh);
                sc = __builtin_amdgcn_mfma_f32_32x32x16_bf16(a, bq, sc, 0, 0, 0); }
            if (sb == tb) {
#pragma unroll
                for (int i = 0; i < 16; ++i) { const int sl = 8 * (i >> 2) + 4 * hh + (i & 3); sc[i] = (sl <= r) ? sc[i] : 0.f; } }
#pragma unroll
            for (int u = 0; u < 2; ++u) {
                pg8::u32x4 pw; pw.x = pg8::cvt_pk_bf16(sc[8 * u], sc[8 * u + 1]); pw.y = pg8::cvt_pk_bf16(sc[8 * u + 2], sc[8 * u + 3]); pw.z = pg8::cvt_pk_bf16(sc[8 * u + 4], sc[8 * u + 5]); pw.w = pg8::cvt_pk_bf16(sc[8 * u + 6], sc[8 * u + 7]);
                const bf16x8_t pb = __builtin_bit_cast(bf16x8_t, pw);
                const LAS bf16_t* vrow = vT + (32 * mb + r) * OPS_LD + 32 * sb + 16 * u + 4 * hh;
                const bf16x4_t lo = *(const LAS bf16x4_t*)vrow, hi4 = *(const LAS bf16x4_t*)(vrow + 8);
                const bf16x8_t va = {lo[0], lo[1], lo[2], lo[3], hi4[0], hi4[1], hi4[2], hi4[3]};
                acc = __builtin_amdgcn_mfma_f32_32x32x16_bf16(va, pb, acc, 0, 0, 0); }
        }
        float ss = 0.f;
#pragma unroll
        for (int i = 0; i < 16; ++i) ss += acc[i] * acc[i];
        ss += __shfl_xor(ss, 32);
        if (hh == 0) ssq[mb * 64 + 32 * tb + r] = ss;
        __syncthreads();
        const int t = 32 * tb + r;
        const float tot2 = (ssq[t] + ssq[64 + t]) + (ssq[128 + t] + ssq[192 + t]);
        const float rs = 1.0f / sqrtf(tot2 * (1.0f / 128.0f) + RMS_EPS);
        const size_t orow = (size_t)(tok0 + t) * 1024 + h * 128;
#pragma unroll
        for (int g = 0; g < 4; ++g) { const int v0 = 32 * mb + 8 * g + 4 * hh;
            const pg8::u32x2 gw = *(const pg8::u32x2*)(GA + orow + v0); const pg8::f32x4 nv = *(const pg8::f32x4*)(ng + v0);
            const float y0 = acc[4 * g] * rs * nv[0] * __uint_as_float(gw.x << 16), y1 = acc[4 * g + 1] * rs * nv[1] * __uint_as_float(gw.x & 0xffff0000u);
            const float y2 = acc[4 * g + 2] * rs * nv[2] * __uint_as_float(gw.y << 16), y3 = acc[4 * g + 3] * rs * nv[3] * __uint_as_float(gw.y & 0xffff0000u);
            pg8::u32x2 w; w.x = pg8::cvt_pk_bf16(y0, y1); w.y = pg8::cvt_pk_bf16(y2, y3); *(pg8::u32x2*)(YA + orow + v0) = w; }
        __syncthreads();
    }
}
namespace at {
constexpr int D = 128, NW = 8, QBLK = 32, KVBLK = 64, LDQ = 1024, LDK = 1024;
constexpr float SCALE = ATTN_SCALE, THR = 8.f;
constexpr size_t SHM_V = KVBLK * D * 2, SHM_K = KVBLK * D * 2, SHM_ATTN = 2 * SHM_V + 2 * SHM_K + NW * 64 * 4;
using bf16x8 = __attribute__((ext_vector_type(8))) short;
using s16x4  = __attribute__((ext_vector_type(4))) short;
using f32x16 = __attribute__((ext_vector_type(16))) float;
using u32x4  = __attribute__((ext_vector_type(4))) unsigned;
#define AT_KSWZ(row, colB) ((row) * 256 + ((colB) ^ (((row) & 7) << 4)))
#define AT_SBAR() __builtin_amdgcn_sched_barrier(0)
__device__ __forceinline__ int crow(int r, int hi) { return (r & 3) + 8 * (r >> 2) + 4 * hi; }
__device__ __forceinline__ unsigned cvtpk(float lo, float hi) { return pg8::cvt_pk_bf16(lo, hi); }

__device__ __forceinline__ void partialSM(f32x16& p0, f32x16& p1, float& m_reg, float& mn, float& alpha) {
  constexpr float C = SCALE * 1.4426950408889634f;
  float pmax = p0[0];
#pragma unroll
  for (int r = 1; r < 16; ++r) pmax = fmaxf(pmax, p0[r]);
#pragma unroll
  for (int r = 0; r < 16; ++r) pmax = fmaxf(pmax, p1[r]);
  { auto rr = __builtin_amdgcn_permlane32_swap(__float_as_uint(pmax), __float_as_uint(pmax), false, false);
    pmax = fmaxf(__uint_as_float(rr[0]), __uint_as_float(rr[1])); }
  if (__builtin_expect(__all(pmax - m_reg <= THR / SCALE), 1)) { mn = m_reg; alpha = 1.f; }
  else { mn = fmaxf(m_reg, pmax); alpha = __builtin_amdgcn_exp2f((m_reg - mn) * C); m_reg = mn; }
  float mnC = -mn * C;
#pragma unroll
  for (int r = 0; r < 16; ++r) p0[r] = fmaf(p0[r], C, mnC);
#pragma unroll
  for (int r = 0; r < 16; ++r) p1[r] = fmaf(p1[r], C, mnC);
#pragma unroll
  for (int r = 0; r < 16; ++r) p0[r] = __builtin_amdgcn_exp2f(p0[r]);
}
__device__ __forceinline__ void finishSM(f32x16& p0, f32x16& p1, float alpha, float& l_reg, int mlo, int mhi, bf16x8& pa0, bf16x8& pa1, bf16x8& pa2, bf16x8& pa3) {
#pragma unroll
  for (int r = 0; r < 16; ++r) p1[r] = __builtin_amdgcn_exp2f(p1[r]);
#pragma unroll
  for (int r = 0; r < 16; ++r) { const int bit = (r & 3) + 8 * (r >> 2);
    p0[r] = __uint_as_float(__float_as_uint(p0[r]) & (unsigned)__builtin_amdgcn_sbfe(mlo, bit, 1));
    p1[r] = __uint_as_float(__float_as_uint(p1[r]) & (unsigned)__builtin_amdgcn_sbfe(mhi, bit, 1)); }
  float ps = 0;
#pragma unroll
  for (int r = 0; r < 16; ++r) ps += p0[r];
#pragma unroll
  for (int r = 0; r < 16; ++r) ps += p1[r];
  { auto rr = __builtin_amdgcn_permlane32_swap(__float_as_uint(ps), __float_as_uint(ps), false, false);
    ps = __uint_as_float(rr[0]) + __uint_as_float(rr[1]); }
  l_reg = l_reg * alpha + ps;
#define AT_PK4(P, BASE, OUT) do { unsigned a0 = cvtpk(P[BASE + 0], P[BASE + 1]), a1 = cvtpk(P[BASE + 2], P[BASE + 3]);   \
    unsigned b0 = cvtpk(P[BASE + 4], P[BASE + 5]), b1 = cvtpk(P[BASE + 6], P[BASE + 7]);                              \
    auto r0 = __builtin_amdgcn_permlane32_swap(a0, b0, false, false); auto r1 = __builtin_amdgcn_permlane32_swap(a1, b1, false, false); \
    u32x4 w = {r0[0], r1[0], r0[1], r1[1]}; OUT = *reinterpret_cast<bf16x8*>(&w); } while (0)
  AT_PK4(p0, 0, pa0); AT_PK4(p0, 8, pa1); AT_PK4(p1, 0, pa2); AT_PK4(p1, 8, pa3);
#undef AT_PK4
}
__device__ __forceinline__ void qkt(f32x16& p0, f32x16& p1, const LAS char* Ks, const bf16x8* qr, int r32, int hi) {
  p0 = f32x16{}; p1 = f32x16{};
#pragma unroll
  for (int d0 = 0; d0 < 8; ++d0) { int cb = (d0 * 16 + hi * 8) * 2;
    bf16x8 b0 = *reinterpret_cast<const LAS bf16x8*>(Ks + AT_KSWZ(r32, cb));
    bf16x8 b1 = *reinterpret_cast<const LAS bf16x8*>(Ks + AT_KSWZ(32 + r32, cb));
    p0 = __builtin_amdgcn_mfma_f32_32x32x16_bf16(b0, qr[d0], p0, 0, 0, 0);
    p1 = __builtin_amdgcn_mfma_f32_32x32x16_bf16(b1, qr[d0], p1, 0, 0, 0); }
}
__device__ __forceinline__ int v_st(int k, int c) { const int kk = (k & ~0xC) | ((k & 4) << 1) | ((k & 8) >> 1); return ((kk >> 3) * 4 + (c >> 5)) * 512 + ((kk & 7) * 32 + (c & 31)) * 2; }
__device__ __forceinline__ int v_rd_base(int lane) { return ((lane & 3) << 3) | (((lane >> 2) & 3) << 6) | (((lane >> 4) & 1) << 5) | (((lane >> 5) & 1) << 8); }
constexpr int v_rd_off(int d0, int ks, int half) { return d0 * 512 + ks * 4096 + half * 2048; }
template <int OFF> __device__ __forceinline__ s16x4 tr_read(int vb) {
  s16x4 r; asm volatile("ds_read_b64_tr_b16 %0, %1 offset:%2" : "=&v"(r) : "v"(vb), "i"(OFF) : "memory"); return r;
}
template <int D0> __device__ __forceinline__ void pv_one(f32x16& od, int vb, bf16x8 pa0, bf16x8 pa1, bf16x8 pa2, bf16x8 pa3) {
  const s16x4 l0 = tr_read<v_rd_off(D0, 0, 0)>(vb), h0 = tr_read<v_rd_off(D0, 0, 1)>(vb), l1 = tr_read<v_rd_off(D0, 1, 0)>(vb), h1 = tr_read<v_rd_off(D0, 1, 1)>(vb);
  const s16x4 l2 = tr_read<v_rd_off(D0, 2, 0)>(vb), h2 = tr_read<v_rd_off(D0, 2, 1)>(vb), l3 = tr_read<v_rd_off(D0, 3, 0)>(vb), h3 = tr_read<v_rd_off(D0, 3, 1)>(vb);
  asm volatile("s_waitcnt lgkmcnt(0)" ::: "memory"); AT_SBAR();
#define AT_PK(L_, H_) (bf16x8){L_[0], L_[1], L_[2], L_[3], H_[0], H_[1], H_[2], H_[3]}
  od = __builtin_amdgcn_mfma_f32_32x32x16_bf16(pa0, AT_PK(l0, h0), od, 0, 0, 0);
  od = __builtin_amdgcn_mfma_f32_32x32x16_bf16(pa1, AT_PK(l1, h1), od, 0, 0, 0);
  od = __builtin_amdgcn_mfma_f32_32x32x16_bf16(pa2, AT_PK(l2, h2), od, 0, 0, 0);
  od = __builtin_amdgcn_mfma_f32_32x32x16_bf16(pa3, AT_PK(l3, h3), od, 0, 0, 0);
#undef AT_PK
}
__device__ __forceinline__ void pv_d0(f32x16* o, int vb, bf16x8 pa0, bf16x8 pa1, bf16x8 pa2, bf16x8 pa3) {
  pv_one<0>(o[0], vb, pa0, pa1, pa2, pa3); pv_one<1>(o[1], vb, pa0, pa1, pa2, pa3); pv_one<2>(o[2], vb, pa0, pa1, pa2, pa3); pv_one<3>(o[3], vb, pa0, pa1, pa2, pa3);
}

__device__ __forceinline__ void attn_masked_body(const bf16_t* __restrict__ Qb, const bf16_t* __restrict__ Kh, const bf16_t* __restrict__ Vh, const unsigned long long* __restrict__ Mq,
                                                 bf16_t* __restrict__ Ob, int seq, LAS char* lds, int tid) {
  const int wid = __builtin_amdgcn_readfirstlane(tid >> 6), lane = tid & 63, r32 = lane & 31, hi = lane >> 5;
  LAS char* V_lds = lds; LAS char* K_lds = lds + 2 * SHM_V;
  LAS float* wsf = (LAS float*)(lds + 2 * SHM_V + 2 * SHM_K) + wid * 64; LAS float* li_l = wsf; LAS float* al_l = wsf + 32;
  float m_reg = -1e30f, l_reg = 0; f32x16 o[4] = {}; bf16x8 qr[8];
  const bf16_t* Qw = Qb + (long)(wid * QBLK + r32) * LDQ + hi * 8;
#pragma unroll
  for (int d0 = 0; d0 < 8; ++d0) qr[d0] = *reinterpret_cast<const bf16x8*>(Qw + d0 * 16);
  const unsigned long long* mrow = Mq + (size_t)(wid * QBLK + r32) * 64;
  const int sr = tid >> 4, sc = (tid & 15) * 8, vst0 = v_st(sr, sc), vst1 = v_st(32 + sr, sc);
  const int vb0 = (int)(uintptr_t)V_lds + v_rd_base(lane);
  struct { bf16x8 vs0, vs1, ks0, ks1; } sr_[2];
#define AT_SLOAD(i, k0) do { sr_[i].vs0 = *reinterpret_cast<const bf16x8*>(&Vh[(long)((k0) + sr) * LDK + sc]); sr_[i].vs1 = *reinterpret_cast<const bf16x8*>(&Vh[(long)((k0) + 32 + sr) * LDK + sc]); \
    sr_[i].ks0 = *reinterpret_cast<const bf16x8*>(&Kh[(long)((k0) + sr) * LDK + sc]); sr_[i].ks1 = *reinterpret_cast<const bf16x8*>(&Kh[(long)((k0) + 32 + sr) * LDK + sc]); } while (0)
#define AT_SWRITE(b, i) do { *(LAS bf16x8*)(V_lds + (b) * SHM_V + vst0) = sr_[i].vs0;          \
    *(LAS bf16x8*)(V_lds + (b) * SHM_V + vst1) = sr_[i].vs1; int kc = sc * 2;               \
    *(LAS bf16x8*)(K_lds + (b) * SHM_K + AT_KSWZ(sr, kc)) = sr_[i].ks0;                       \
    *(LAS bf16x8*)(K_lds + (b) * SHM_K + AT_KSWZ(32 + sr, kc)) = sr_[i].ks1; } while (0)
#define AT_SWAIT() asm volatile("s_waitcnt vmcnt(4)" ::: "memory")
#define AT_RESC(a) do { if (__any((a) < 1.f)) { if (hi == 0) al_l[r32] = (a); asm volatile("s_waitcnt lgkmcnt(0)" ::: "memory"); \
    _Pragma("unroll") for (int d = 0; d < 4; ++d) _Pragma("unroll") for (int r = 0; r < 16; ++r) o[d][r] *= al_l[crow(r, hi)]; } } while (0)
#define AT_MLOAD(mw, j) do { const unsigned long long _w = mrow[(j)]; (mw##lo) = (int)((unsigned)_w >> (4 * hi)); (mw##hi) = (int)((unsigned)(_w >> 32) >> (4 * hi)); } while (0)
  f32x16 pA0, pA1, pB0, pB1; float mnA, mnB, alA, alB; bf16x8 pa0, pa1, pa2, pa3; const int NT = seq / KVBLK;
  int mAlo, mAhi, mBlo, mBhi;
  constexpr int SE = 0, SO = 1;
  AT_SLOAD(SE, 0); AT_MLOAD(mA, 0); asm volatile("s_waitcnt vmcnt(0)" ::: "memory"); AT_SWRITE(0, SE); __syncthreads();
  qkt(pA0, pA1, K_lds, qr, r32, hi); partialSM(pA0, pA1, m_reg, mnA, alA);
  AT_SLOAD(SO, KVBLK); if (2 < NT) AT_SLOAD(SE, 2 * KVBLK);
  AT_SWAIT(); AT_SWRITE(1, SO); __syncthreads();
  for (int j = 1; j + 1 < NT; j += 2) {
    AT_SBAR(); AT_MLOAD(mB, j); qkt(pB0, pB1, K_lds + SHM_K, qr, r32, hi);
    finishSM(pA0, pA1, alA, l_reg, mAlo, mAhi, pa0, pa1, pa2, pa3); AT_SBAR();
    AT_SLOAD(SO, (j + 2) * KVBLK); AT_SBAR();
    pv_d0(o, vb0, pa0, pa1, pa2, pa3); partialSM(pB0, pB1, m_reg, mnB, alB);
    __syncthreads(); AT_SWAIT(); AT_SWRITE(0, SE);
    AT_RESC(alB); __syncthreads();
    AT_SBAR(); AT_MLOAD(mA, j + 1); qkt(pA0, pA1, K_lds, qr, r32, hi);
    finishSM(pB0, pB1, alB, l_reg, mBlo, mBhi, pa0, pa1, pa2, pa3); AT_SBAR();
    if (j + 3 < NT) AT_SLOAD(SE, (j + 3) * KVBLK); AT_SBAR();
    pv_d0(o, vb0 + (int)SHM_V, pa0, pa1, pa2, pa3); partialSM(pA0, pA1, m_reg, mnA, alA);
    __syncthreads(); AT_SWAIT(); AT_SWRITE(1, SO);
    AT_RESC(alA); __syncthreads();
  }
  AT_SBAR(); AT_MLOAD(mB, NT - 1); qkt(pB0, pB1, K_lds + SHM_K, qr, r32, hi);
  finishSM(pA0, pA1, alA, l_reg, mAlo, mAhi, pa0, pa1, pa2, pa3); AT_SBAR();
  pv_d0(o, vb0, pa0, pa1, pa2, pa3); partialSM(pB0, pB1, m_reg, mnB, alB);
  __syncthreads(); AT_RESC(alB);
  finishSM(pB0, pB1, alB, l_reg, mBlo, mBhi, pa0, pa1, pa2, pa3); AT_SBAR();
  pv_d0(o, vb0 + (int)SHM_V, pa0, pa1, pa2, pa3);
  if (hi == 0) li_l[r32] = l_reg; asm volatile("s_waitcnt lgkmcnt(0)" ::: "memory");
  float rli[16];
#pragma unroll
  for (int r = 0; r < 16; ++r) rli[r] = __builtin_amdgcn_rcpf(li_l[crow(r, hi)]);
  bf16_t* Ow = Ob + (long)(wid * QBLK) * LDQ;
#pragma unroll
  for (int r = 0; r < 16; ++r) { const int orow = crow(r, hi);
#pragma unroll
    for (int d0 = 0; d0 < 4; ++d0) Ow[(long)orow * LDQ + d0 * 32 + r32] = f2bf(o[d0][r] * rli[r]); }
#undef AT_SLOAD
#undef AT_SWRITE
#undef AT_SWAIT
#undef AT_RESC
#undef AT_MLOAD
}
}

__device__ __forceinline__ void phase_attn(KP P, LAS unsigned char* lds) {
    unsigned char* ws = as_global(P->ws);
    const bf16_t* QB = (const bf16_t*)(ws + WS_QB); const bf16_t* KB = (const bf16_t*)(ws + WS_KB); const bf16_t* VB = (const bf16_t*)(ws + WS_VB);
    const unsigned long long* MASK = (const unsigned long long*)(ws + WS_MASK); bf16_t* YB = (bf16_t*)(ws + WS_YB);
    const int G = nblk_();
    for (int p = bid_(); p < 256; p += G) {
        const int bh = p >> 3, b = bh >> 3, h = bh & 7, x = p & 7;
#pragma unroll 1
        for (int half = 0; half < 2; ++half) { const int qb = half ? 15 - x : x; const size_t row0 = (size_t)b * SEQ + (size_t)qb * 256;
            at::attn_masked_body(QB + row0 * 1024 + h * 128, KB + (size_t)b * SEQ * 1024 + h * 128, VB + (size_t)b * SEQ * 1024 + h * 128, MASK + row0 * 64,
                                 YB + row0 * 1024 + h * 128, 256 * (qb + 1), (LAS char*)lds, tid_());
            __syncthreads(); }
    }
}
__device__ __forceinline__ void idx_unit(const bf16_t* QI, const bf16_t* KI, const float* WI, float* Sc, int b, int c, int half, int tid) {
    const int lane = tid & 63, wave = __builtin_amdgcn_readfirstlane(tid >> 6), r = lane & 31, hh = lane >> 5, nk = 64 * (c + 1);
    const int s0 = c * 64 + half * 32 + wave * 4;
    const int aq = (r >> 2) & 1, ahead = (r & 3) + 4 * (r >> 3);
    bf16x8_t A[2][4]; float wv[2][16];
#pragma unroll
    for (int rt = 0; rt < 2; ++rt) { const size_t qrow = (size_t)b * SEQ + s0 + 2 * rt + aq;
#pragma unroll
        for (int ks = 0; ks < 4; ++ks) A[rt][ks] = *(const bf16x8_t*)(QI + qrow * 1024 + ahead * 64 + 16 * ks + 8 * hh);
        const float* wp = WI + ((size_t)b * SEQ + s0 + 2 * rt + hh) * 16;
#pragma unroll
        for (int i4 = 0; i4 < 4; ++i4) { const pg8::f32x4 w4 = *(const pg8::f32x4*)(wp + 4 * i4); wv[rt][4 * i4] = w4[0]; wv[rt][4 * i4 + 1] = w4[1]; wv[rt][4 * i4 + 2] = w4[2]; wv[rt][4 * i4 + 3] = w4[3]; } }
    float* srow[2];
#pragma unroll
    for (int rt = 0; rt < 2; ++rt) srow[rt] = Sc + (size_t)b * SCORE_B + (size_t)2048 * c * (c + 1) + (size_t)((s0 + 2 * rt + hh) & 63) * nk + r;
    const bf16_t* kp = KI + ((size_t)b * SEQ + r) * 64 + 8 * hh;
    bf16x8_t Bn[4];
#pragma unroll
    for (int ks = 0; ks < 4; ++ks) Bn[ks] = *(const bf16x8_t*)(kp + 16 * ks);
    const int ntile = nk / 32;
    for (int kt = 0; kt < ntile; ++kt) {
        bf16x8_t Bc[4];
#pragma unroll
        for (int ks = 0; ks < 4; ++ks) Bc[ks] = Bn[ks];
        if (kt + 1 < ntile) {
#pragma unroll
            for (int ks = 0; ks < 4; ++ks) Bn[ks] = *(const bf16x8_t*)(kp + (size_t)(kt + 1) * 32 * 64 + 16 * ks); }
#pragma unroll
        for (int rt = 0; rt < 2; ++rt) { f32x16_t acc;
#pragma unroll
            for (int i = 0; i < 16; ++i) acc[i] = 0.f;
#pragma unroll
            for (int ks = 0; ks < 4; ++ks) acc = __builtin_amdgcn_mfma_f32_32x32x16_bf16(A[rt][ks], Bc[ks], acc, 0, 0, 0);
            float sc = 0.f;
#pragma unroll
            for (int i = 0; i < 16; ++i) sc = fmaf(wv[rt][i], fmaxf(acc[i], 0.f), sc);
            srow[rt][kt * 32] = sc; }
    }
}
__device__ __forceinline__ void phase_idx(KP P) {
    unsigned char* ws = as_global(P->ws);
    const bf16_t* QI = (const bf16_t*)(ws + WS_QI); const bf16_t* KI = (const bf16_t*)(ws + WS_KI); const float* WI = (const float*)(ws + WS_WI); float* Sc = (float*)(ws + WS_XPRE);
    const int G = nblk_();
    for (int item = bid_(); item < 240; item += G) {
        const int pi = item % 30, combo = item / 30, b = combo >> 1, half = combo & 1;
        idx_unit(QI, KI, WI, Sc, b, 4 + pi, half, tid_());
        idx_unit(QI, KI, WI, Sc, b, 63 - pi, half, tid_());
    }
}
__device__ __forceinline__ const float* sel_row(const float* S, int q, int& nw) {
    const int b = q >> 12, s = q & 4095, c = s >> 6; nw = c + 1;
    return S + (size_t)b * SCORE_B + (size_t)2048 * c * (c + 1) + (size_t)(s & 63) * (nw * 64);
}
__device__ __forceinline__ void sel_load(const float* row, int nw, int lane, float (&f)[64]) {
    if (nw > 32) {
#pragma unroll
        for (int j = 0; j < 64; ++j) { const int jc = j < nw ? j : nw - 1; f[j] = row[jc * 64 + lane]; }
    } else {
#pragma unroll
        for (int j = 0; j < 32; ++j) { const int jc = j < nw ? j : nw - 1; f[j] = row[jc * 64 + lane]; }
#pragma unroll
        for (int j = 32; j < 64; ++j) f[j] = 0.f;
    }
}
__device__ __forceinline__ void phase_select(KP P, LAS unsigned char* lds) {
    unsigned char* ws = as_global(P->ws); const float* S = (const float*)(ws + WS_XPRE); unsigned long long* MASK = (unsigned long long*)(ws + WS_MASK);
    const int tid = tid_(), wave = __builtin_amdgcn_readfirstlane(tid >> 6), lane = tid & 63, nb8 = nblk_() * 8;
    LAS unsigned long long* sm = (LAS unsigned long long*)lds + wave * 64;
    float f[64]; int it = (bid_() * 8 + wave) * 8, nw = 0; const float* row = nullptr;
    const int itstep = nb8 * 8 - 7;
#define SEL_Q(it_) ((((it_) >> 3) & 3) * 4096 + ((it_) >> 5) + 512 * ((it_) & 7))
    int q = it < TOK ? SEL_Q(it) : TOK;
    if (q < TOK) { row = sel_row(S, q, nw); if (nw > TOPK / 64) sel_load(row, nw, lane, f); }
    while (q < TOK) {
        unsigned long long myword = 0ull;
        const int itn = ((it & 7) == 7) ? it + itstep : it + 1; const int qn = itn < TOK ? SEL_Q(itn) : TOK; int nwn = 0; const float* rown = nullptr;
        if (nw <= TOPK / 64) {
            myword = (lane < nw) ? ~0ull : 0ull;
            if (qn < TOK) { rown = sel_row(S, qn, nwn); if (nwn > TOPK / 64) sel_load(rown, nwn, lane, f); }
        } else {
            unsigned u[64];
#pragma unroll
            for (int j = 0; j < 64; ++j) { const unsigned bits = __float_as_uint(f[j]); const unsigned v = (bits & 0x80000000u) ? ~bits : (bits | 0x80000000u); u[j] = (j < nw) ? v : 0u; }
            if (qn < TOK) { rown = sel_row(S, qn, nwn); if (nwn > TOPK / 64) sel_load(rown, nwn, lane, f); }
            unsigned prefix = 0u;
            for (int bit = 31; bit >= 0; --bit) { const unsigned cand = prefix | (1u << bit); int cnt = 0;
#pragma unroll
                for (int j8 = 0; j8 < 8; ++j8) if (j8 * 8 < nw) { unsigned long long bl[8];
#pragma unroll
                    for (int jj = 0; jj < 8; ++jj) bl[jj] = __ballot(u[j8 * 8 + jj] >= cand);
                    asm volatile("" : "+s"(bl[0]), "+s"(bl[1]), "+s"(bl[2]), "+s"(bl[3]), "+s"(bl[4]), "+s"(bl[5]), "+s"(bl[6]), "+s"(bl[7]));
#pragma unroll
                    for (int jj = 0; jj < 8; ++jj) cnt += __popcll(bl[jj]); }
                if (cnt >= TOPK) prefix = cand; }
#pragma unroll
            for (int j = 0; j < 64; ++j) { const unsigned long long w = __ballot(u[j] >= prefix); if (lane == 0) sm[j] = w; }
            myword = sm[lane];
        }
        MASK[(size_t)q * 64 + lane] = myword;
        q = qn; it = itn; nw = nwn; row = rown;
    }
#undef SEL_Q
}

__device__ __forceinline__ void phase_hgrn_naive(KP P, int layer, LAS unsigned char* lds) {
    unsigned char* ws = as_global(P->ws);
    const bf16_t* QA = (const bf16_t*)(ws + WS_QA); const bf16_t* KA = (const bf16_t*)(ws + WS_KA); const bf16_t* VA = (const bf16_t*)(ws + WS_VA); const bf16_t* GA = (const bf16_t*)(ws + WS_GA);
    const float* LF = (const float*)(ws + WS_LF); bf16_t* YA = (bf16_t*)(ws + WS_YA);
    const int tid = tid_(), bh = bid_(), b = bh >> 3, h = bh & 7, v = tid & 127; const bool act = (bh < 32) && (tid < 128);
    if (bh >= 32) return;
    LAS float* sf = (LAS float*)lds; LAS float* sk = sf + 16 * 128; LAS float* sq = sk + 16 * 128; LAS float* red = sq + 16 * 128;
    float S[128];
#pragma unroll
    for (int k = 0; k < 128; ++k) S[k] = 0.f;
    const float ng = as_global(P->hnorm_g)[layer * 128 + v];
    for (int t0 = 0; t0 < SEQ; t0 += 16) {
        if (act) for (int i = 0; i < 16; ++i) { const size_t idx = ((size_t)(b * SEQ + t0 + i)) * 1024 + h * 128 + v; sf[i * 128 + v] = expf(LF[idx]); sk[i * 128 + v] = bf2f(KA[idx]); sq[i * 128 + v] = bf2f(QA[idx]); }
        __syncthreads();
        for (int i = 0; i < 16; ++i) { const size_t idx = ((size_t)(b * SEQ + t0 + i)) * 1024 + h * 128 + v; float o = 0.f;
            if (act) { const float vt = bf2f(VA[idx]);
#pragma unroll
                for (int k = 0; k < 128; ++k) { S[k] = sf[i * 128 + k] * S[k] + sk[i * 128 + k] * vt; o += S[k] * sq[i * 128 + k]; } }
            float ss = o * o;
#pragma unroll
            for (int m = 32; m >= 1; m >>= 1) ss += __shfl_xor(ss, m);
            if (act && (v & 63) == 0) red[v >> 6] = ss;
            __syncthreads();
            if (act) { const float tot = red[0] + red[1]; YA[idx] = f2bf(o * (1.0f / sqrtf(tot * (1.0f / 128.0f) + RMS_EPS)) * ng * bf2f(GA[idx])); }
            __syncthreads(); }
    }
}
__device__ __forceinline__ void phase_idx_naive(KP P, LAS unsigned char* lds) {
    unsigned char* ws = as_global(P->ws);
    const bf16_t* QI = (const bf16_t*)(ws + WS_QI); const bf16_t* KI = (const bf16_t*)(ws + WS_KI); const float* WI = (const float*)(ws + WS_WI); float* Sc = (float*)(ws + WS_XPRE);
    const int tid = tid_(), G = nblk_();
    LAS float* qs = (LAS float*)lds; LAS float* wsh = qs + 1024;
    for (int q = bid_(); q < TOK; q += G) {
        const int b = q >> 12, s = q & 4095, c = s >> 6, nw = c + 1, nk = nw * 64;
        if (nw <= TOPK / 64) continue;
        __syncthreads();
        for (int i = tid; i < 1024; i += 512) qs[i] = bf2f(QI[(size_t)q * 1024 + i]);
        if (tid < 16) wsh[tid] = WI[(size_t)q * 16 + tid];
        __syncthreads();
        float* row = Sc + (size_t)b * SCORE_B + (size_t)2048 * c * (c + 1) + (size_t)(s & 63) * nk;
        for (int key = tid; key < nk; key += 512) {
            float kf[64]; const pg8::u32x4* kp = (const pg8::u32x4*)(KI + ((size_t)b * SEQ + key) * 64);
#pragma unroll
            for (int d8 = 0; d8 < 8; ++d8) { const pg8::u32x4 w = kp[d8]; pg8::f32x4 a, bb; pg8::unpack8(w, a, bb);
#pragma unroll
                for (int j = 0; j < 4; ++j) { kf[d8 * 8 + j] = a[j]; kf[d8 * 8 + 4 + j] = bb[j]; } }
            float sc = 0.f;
            for (int h = 0; h < 16; ++h) { float dot = 0.f;
#pragma unroll
                for (int d = 0; d < 64; ++d) dot += qs[h * 64 + d] * kf[d];
                sc += wsh[h] * fmaxf(dot, 0.f); }
            row[key] = sc;
        }
    }
}
__device__ __forceinline__ void phase_attn_naive(KP P, LAS unsigned char* lds) {
    unsigned char* ws = as_global(P->ws);
    const bf16_t* QB = (const bf16_t*)(ws + WS_QB); const bf16_t* KB = (const bf16_t*)(ws + WS_KB); const bf16_t* VB = (const bf16_t*)(ws + WS_VB);
    const unsigned long long* MASK = (const unsigned long long*)(ws + WS_MASK); bf16_t* YB = (bf16_t*)(ws + WS_YB);
    const int tid = tid_(), h = tid >> 6, lane = tid & 63, G = nblk_();
    LAS float* qs = (LAS float*)lds + h * 128; LAS int* keys = (LAS int*)((LAS float*)lds + 1024) + h * 320; LAS float* lg = (LAS float*)lds + 1024 + 8 * 320 + h * 320;
    for (int q = bid_(); q < TOK; q += G) {
        const int b = q >> 12, s = q & 4095, nw = (s >> 6) + 1;
        qs[lane] = bf2f(QB[(size_t)q * 1024 + h * 128 + lane]); qs[lane + 64] = bf2f(QB[(size_t)q * 1024 + h * 128 + 64 + lane]);
        int cnt = 0;
        for (int j = 0; j < nw; ++j) { const unsigned long long w = MASK[(size_t)q * 64 + j]; const bool on = (w >> lane) & 1ull; const int key = j * 64 + lane;
            if (on) { const pg8::u32x4* kp = (const pg8::u32x4*)(KB + ((size_t)b * SEQ + key) * 1024 + h * 128); float dot = 0.f;
                for (int d8 = 0; d8 < 16; ++d8) { pg8::f32x4 a, bb; pg8::unpack8(kp[d8], a, bb);
#pragma unroll
                    for (int j2 = 0; j2 < 4; ++j2) dot += qs[d8 * 8 + j2] * a[j2] + qs[d8 * 8 + 4 + j2] * bb[j2]; }
                const int pos = cnt + __popcll(w & ((1ull << lane) - 1ull));
                if (pos < 320) { keys[pos] = key; lg[pos] = dot * ATTN_SCALE; } }
            cnt += __popcll(w); }
        if (cnt > 320) cnt = 320;
        float mx = -1e30f; for (int e = lane; e < cnt; e += 64) mx = fmaxf(mx, lg[e]);
#pragma unroll
        for (int m = 32; m >= 1; m >>= 1) mx = fmaxf(mx, __shfl_xor(mx, m));
        float sum = 0.f; for (int e = lane; e < cnt; e += 64) { const float pe = expf(lg[e] - mx); lg[e] = pe; sum += pe; }
#pragma unroll
        for (int m = 32; m >= 1; m >>= 1) sum += __shfl_xor(sum, m);
        float a0 = 0.f, a1 = 0.f;
        for (int e = 0; e < cnt; ++e) { const float pe = lg[e]; const bf16_t* vp = VB + ((size_t)b * SEQ + keys[e]) * 1024 + h * 128 + 2 * lane; a0 += pe * bf2f(vp[0]); a1 += pe * bf2f(vp[1]); }
        const float inv = 1.0f / sum;
        *(unsigned*)(YB + (size_t)q * 1024 + h * 128 + 2 * lane) = pg8::cvt_pk_bf16(a0 * inv, a1 * inv);
    }
}

__global__ __launch_bounds__(128) void k_hgrn_naive(const bf16_t* QA, const bf16_t* KA, const bf16_t* VA, const bf16_t* GA, const float* LF, const float* norm_g, bf16_t* YA) {
    const int bh = blockIdx.x, b = bh >> 3, h = bh & 7, v = threadIdx.x;
    __shared__ float sf[16][128], sk[16][128], sq[16][128]; __shared__ float red[2];
    float S[128];
#pragma unroll
    for (int k = 0; k < 128; ++k) S[k] = 0.f;
    const float ng = norm_g[v];
    for (int t0 = 0; t0 < SEQ; t0 += 16) {
        for (int i = 0; i < 16; ++i) { const size_t idx = ((size_t)(b * SEQ + t0 + i)) * 1024 + h * 128 + v; sf[i][v] = expf(LF[idx]); sk[i][v] = bf2f(KA[idx]); sq[i][v] = bf2f(QA[idx]); }
        __syncthreads();
        for (int i = 0; i < 16; ++i) { const size_t idx = ((size_t)(b * SEQ + t0 + i)) * 1024 + h * 128 + v; const float vt = bf2f(VA[idx]); float o = 0.f;
#pragma unroll
            for (int k = 0; k < 128; ++k) { S[k] = sf[i][k] * S[k] + sk[i][k] * vt; o += S[k] * sq[i][k]; }
            float ss = o * o;
#pragma unroll
            for (int m = 32; m >= 1; m >>= 1) ss += __shfl_xor(ss, m);
            if ((v & 63) == 0) red[v >> 6] = ss;
            __syncthreads();
            const float tot = red[0] + red[1];
            const float y = o * (1.0f / sqrtf(tot * (1.0f / 128.0f) + RMS_EPS)) * ng * bf2f(GA[idx]);
            YA[idx] = f2bf(y);
            __syncthreads(); }
    }
}
__global__ __launch_bounds__(256) void k_idx_naive(const bf16_t* QI, const bf16_t* KI, const float* WI, float* S) {
    const int q = blockIdx.x, b = q >> 12, s = q & 4095, c = s >> 6, nw = c + 1, nk = nw * 64;
    if (nw <= TOPK / 64) return;
    __shared__ float qs[1024]; __shared__ float wsh[16];
    for (int i = threadIdx.x; i < 1024; i += 256) qs[i] = bf2f(QI[(size_t)q * 1024 + i]);
    if (threadIdx.x < 16) wsh[threadIdx.x] = WI[(size_t)q * 16 + threadIdx.x];
    __syncthreads();
    float* row = S + (size_t)b * SCORE_B + (size_t)2048 * c * (c + 1) + (size_t)(s & 63) * nk;
    for (int key = threadIdx.x; key < nk; key += 256) {
        float kf[64]; const bf16_t* kp = KI + ((size_t)b * SEQ + key) * 64;
#pragma unroll
        for (int d = 0; d < 64; ++d) kf[d] = bf2f(kp[d]);
        float sc = 0.f;
        for (int h = 0; h < 16; ++h) { float dot = 0.f;
#pragma unroll
            for (int d = 0; d < 64; ++d) dot += qs[h * 64 + d] * kf[d];
            sc += wsh[h] * fmaxf(dot, 0.f); }
        row[key] = sc;
    }
}
__global__ __launch_bounds__(512) void k_attn_naive(const bf16_t* QB, const bf16_t* KB, const bf16_t* VB, const unsigned long long* MASK, bf16_t* YB) {
    const int q = blockIdx.x, b = q >> 12, s = q & 4095, nw = (s >> 6) + 1, h = threadIdx.x >> 6, lane = threadIdx.x & 63;
    __shared__ float qs[8][128]; __shared__ int keys[8][320]; __shared__ float lg[8][320];
    qs[h][lane] = bf2f(QB[(size_t)q * 1024 + h * 128 + lane]); qs[h][lane + 64] = bf2f(QB[(size_t)q * 1024 + h * 128 + 64 + lane]);
    __syncthreads();
    int cnt = 0;
    for (int j = 0; j < nw; ++j) { const unsigned long long w = MASK[(size_t)q * 64 + j]; const bool on = (w >> lane) & 1ull; const int key = j * 64 + lane;
        if (on) { const bf16_t* kp = KB + ((size_t)b * SEQ + key) * 1024 + h * 128; float dot = 0.f;
            for (int d = 0; d < 128; ++d) dot += qs[h][d] * bf2f(kp[d]);
            const int pos = cnt + __popcll(w & ((1ull << lane) - 1ull));
            if (pos < 320) { keys[h][pos] = key; lg[h][pos] = dot * ATTN_SCALE; } }
        cnt += __popcll(w); }
    if (cnt > 320) cnt = 320;
    __syncthreads();
    float mx = -1e30f; for (int e = lane; e < cnt; e += 64) mx = fmaxf(mx, lg[h][e]);
#pragma unroll
    for (int m = 32; m >= 1; m >>= 1) mx = fmaxf(mx, __shfl_xor(mx, m));
    float sum = 0.f; for (int e = lane; e < cnt; e += 64) { const float pe = expf(lg[h][e] - mx); lg[h][e] = pe; sum += pe; }
#pragma unroll
    for (int m = 32; m >= 1; m >>= 1) sum += __shfl_xor(sum, m);
    __syncthreads();
    float a0 = 0.f, a1 = 0.f;
    for (int e = 0; e < cnt; ++e) { const float pe = lg[h][e]; const bf16_t* vp = VB + ((size_t)b * SEQ + keys[h][e]) * 1024 + h * 128 + 2 * lane; a0 += pe * bf2f(vp[0]); a1 += pe * bf2f(vp[1]); }
    const float inv = 1.0f / sum;
    YB[(size_t)q * 1024 + h * 128 + 2 * lane] = f2bf(a0 * inv); YB[(size_t)q * 1024 + h * 128 + 2 * lane + 1] = f2bf(a1 * inv);
}

__global__ __launch_bounds__(256) void k_dump(const unsigned char* ws, int which, float* out) {
    for (size_t i = (size_t)blockIdx.x * 256 + threadIdx.x; i < (size_t)TOK * DM; i += (size_t)gridDim.x * 256) {
        const size_t t = i / DM, c = i % DM; float v = 0.f;
        if (which == 0) { v = bf2f(((const bf16_t*)(ws + WS_MG))[i]) + ((const float*)(ws + WS_PP))[i]; }
        else if (which == 1) { const size_t j = t * 1024 + (c & 1023);
            v = bf2f(((const bf16_t*)(ws + WS_QA))[j]) + bf2f(((const bf16_t*)(ws + WS_KA))[j]) + bf2f(((const bf16_t*)(ws + WS_VA))[j]) + bf2f(((const bf16_t*)(ws + WS_GA))[j])
              + bf2f(((const bf16_t*)(ws + WS_QB))[j]) + bf2f(((const bf16_t*)(ws + WS_KB))[j]) + bf2f(((const bf16_t*)(ws + WS_VB))[j]) + bf2f(((const bf16_t*)(ws + WS_QI))[j])
              + ((const float*)(ws + WS_LF))[j] + bf2f(((const bf16_t*)(ws + WS_SGA))[i]) + bf2f(((const bf16_t*)(ws + WS_SGB))[i]) + ((const float*)(ws + WS_IKW))[t * 128 + (c & 127)]; }
        else if (which == 2) { const size_t j = t * 1024 + (c & 1023); v = (c < 1024) ? bf2f(((const bf16_t*)(ws + WS_YA))[j]) : bf2f(((const bf16_t*)(ws + WS_YB))[j]); }
        else if (which == 3) { v = ((const float*)(ws + WS_XPRE))[i]; }
        else if (which == 4) { v = ((const float*)(ws + WS_X32))[i]; }
        else if (which == 5) { v = bf2f(((const bf16_t*)(ws + WS_H))[t * DFF + c]) + bf2f(((const bf16_t*)(ws + WS_H))[t * DFF + 2048 + c]) + bf2f(((const bf16_t*)(ws + WS_H))[t * DFF + 3584 + c]); }
        else if (which == 6) { const unsigned long long m = ((const unsigned long long*)(ws + WS_MASK))[t * 64 + (c & 63)]; v = (float)__popcll(m) + (float)(unsigned)(m % 1000003ull) * 1e-3f; }
        else if (which == 7) { v = bf2f(((const bf16_t*)(ws + WS_WIN))[i % ((size_t)INP * DM)]) + bf2f(((const bf16_t*)(ws + WS_WGU))[(i * 7) % ((size_t)2 * DFF * DM)]) + bf2f(((const bf16_t*)(ws + WS_WDN))[(i * 3) % ((size_t)DFF * DM)]); }
        else if (which == 8) { v = bf2f(((const bf16_t*)(ws + WS_XB))[i]) + ((const float*)(ws + WS_COSH))[i % ((size_t)TOK * 64)] + ((const float*)(ws + WS_SINI))[i % ((size_t)TOK * 32)] + ((const float*)(ws + WS_LB))[i % 4096]; }
        else if (which == 9) { v = bf2f(((const bf16_t*)(ws + WS_H))[t * 6272 + c]) + bf2f(((const bf16_t*)(ws + WS_H))[t * 6272 + 2048 + c]) + bf2f(((const bf16_t*)(ws + WS_H))[t * 6272 + 4096 + c]) + bf2f(((const bf16_t*)(ws + WS_H))[t * 6272 + 4224 + c]); }
        else if (which == 10) { const size_t j = t * 1024 + (c & 1023); v = bf2f(((const bf16_t*)(ws + WS_QA))[j]) + bf2f(((const bf16_t*)(ws + WS_VA))[j]) + bf2f(((const bf16_t*)(ws + WS_GA))[j]) + bf2f(((const bf16_t*)(ws + WS_VB))[j]) + bf2f(((const bf16_t*)(ws + WS_SGA))[i]) + bf2f(((const bf16_t*)(ws + WS_SGB))[i]); }
        else if (which == 11) { const size_t j = t * 1024 + (c & 1023); v = bf2f(((const bf16_t*)(ws + WS_QB))[j]) + bf2f(((const bf16_t*)(ws + WS_KB))[j]) + bf2f(((const bf16_t*)(ws + WS_QI))[j]); }
        else if (which == 12) { const size_t j = t * 1024 + (c & 1023); v = ((const float*)(ws + WS_LF))[j] + bf2f(((const bf16_t*)(ws + WS_KA))[j]); }
        else if (which == 14) { v = ((const float*)(ws + WS_IKW))[t * 128 + (c & 127)]; }
        else if (which == 15) { const size_t j = t * 1024 + (c & 1023); v = bf2f(((const bf16_t*)(ws + WS_QA))[j]) + bf2f(((const bf16_t*)(ws + WS_GA))[j]); }
        else if (which == 16) { v = bf2f(((const bf16_t*)(ws + WS_SGA))[i]) + bf2f(((const bf16_t*)(ws + WS_SGB))[i]); }
        else if (which == 17) { const size_t j = t * 1024 + (c & 1023); v = bf2f(((const bf16_t*)(ws + WS_VA))[j]) + bf2f(((const bf16_t*)(ws + WS_VB))[j]); }
        out[i] = v;
    }
}
#ifndef OPT_HGRN
#define OPT_HGRN 1
#endif
#ifndef OPT_IDX
#define OPT_IDX 1
#endif
#ifndef OPT_ATT
#define OPT_ATT 1
#endif
#ifndef PHM
#define PHM 0x3fff
#endif
#ifndef DUP_MASK
#define DUP_MASK 0
#endif
#ifndef ONE_LAUNCH
#define ONE_LAUNCH 1
#endif

__global__ void __launch_bounds__(512, 2) mega(Params P_unused) {
    extern __shared__ __attribute__((aligned(16))) unsigned char lds[];
    LAS unsigned char* L = (LAS unsigned char*)lds;
    volatile LAS unsigned* misc = (volatile LAS unsigned*)(L + MISC_OFF);
    if (threadIdx.x < 4) misc[threadIdx.x] = 0u;
    __syncthreads();
    int lo, hi; unsigned char* ws0; { KP P0 = kparams(); lo = P0->ph_lo; hi = P0->ph_hi; ws0 = as_global(P0->ws); }
    XcdBarrier bar; bar.bar = (unsigned*)(ws0 + WS_CTL); bar.x = 0; bar.st = misc;
    if (hi - lo > 1) bar = xcd_barrier_post((unsigned*)(ws0 + WS_CTL), misc);
#define WSP(T_, off) ((T_*)(ws + (off)))
#define WSL KP P = kparams(); unsigned char* ws = as_global(P->ws); const int G = nblk_(), bid = bid_(); (void)G; (void)bid

    for (int layer = 0; layer < DEPTH; ++layer) {
        const int base = layer * NPH_LAYER;
#define IN(k) (((PHM >> (k)) & 1) && lo <= base + (k) && base + (k) < hi)
#define SEAM(k) do { if (rep + 1 == ((((DUP_MASK >> (k)) & 1) ? 2 : 1)) && base + (k) + 1 < hi) xcd_barrier(bar); } while (0)
        if (IN(0)) for (int rep = 0; rep < (((DUP_MASK >> 0) & 1) ? 2 : 1); ++rep) { WSL; if (layer == 0) phase_prologue(P); phase_wconv(P, layer); SEAM(0); }
        if (IN(1)) for (int rep = 0; rep < (((DUP_MASK >> 1) & 1) ? 2 : 1); ++rep) { WSL;
            pg8::Gemm g{WSP(const bf16_t, WS_XB), WSP(const bf16_t, WS_WIN), TOK, INP, DM}; pg8::StaticOrder S; S.init(TOK, INP, G, bid);
#ifdef RAWTEST
            pg8::EpiRawTest E{ws};
            pg8::gemm_phase<pg8::EpiRawTest, pg8::StaticOrder, true, true>(L, g, S, E); SEAM(1);
#else
            pg8::EpiIn E{ws, layer};
            pg8::gemm_phase<pg8::EpiIn, pg8::StaticOrder, true, true>(L, g, S, E); SEAM(1);
#endif
        }
        if (IN(2)) for (int rep = 0; rep < (((DUP_MASK >> 2) & 1) ? 2 : 1); ++rep) { WSL; phase_ikprep(P, layer);
#if OPT_HGRN
            phase_hgrn_h1(P, L);
#endif
            SEAM(2); }
        if (IN(3)) for (int rep = 0; rep < (((DUP_MASK >> 3) & 1) ? 2 : 1); ++rep) { WSL;
#if !OPT_HGRN
            phase_hgrn_naive(P, layer, L); __syncthreads();
#else
            phase_hgrn_h2(P);
#endif
#if !OPT_IDX
            phase_idx_naive(P, L);
#else
            phase_idx(P);
#endif
            SEAM(3); }
        if (IN(4)) for (int rep = 0; rep < (((DUP_MASK >> 4) & 1) ? 2 : 1); ++rep) { WSL;
#ifdef DUP_SEL
            phase_select(P, L); __syncthreads();
#endif
            phase_select(P, L);
#if OPT_HGRN
            __syncthreads(); phase_hgrn_h3(P, layer, L);
#ifdef DUP_H3
            __syncthreads(); phase_hgrn_h3(P, layer, L);
#endif
#endif
            SEAM(4); }
        if (IN(5)) for (int rep = 0; rep < (((DUP_MASK >> 5) & 1) ? 2 : 1); ++rep) { WSL;
#if !OPT_ATT
            phase_attn_naive(P, L);
#else
            phase_attn(P, L);
#endif
            SEAM(5); }
        if (IN(6)) for (int rep = 0; rep < (((DUP_MASK >> 6) & 1) ? 2 : 1); ++rep) { WSL;
            { pg8::Gemm g{WSP(const bf16_t, WS_YA), WSP(const bf16_t, WS_WA), TOK, DM, AW}; pg8::StaticOrder S; S.init(TOK, DM, G, bid);
              pg8::EpiGateA E{ws}; pg8::gemm_phase<pg8::EpiGateA, pg8::StaticOrder, true, true>(L, g, S, E); }
            { pg8::Gemm g{WSP(const bf16_t, WS_YB), WSP(const bf16_t, WS_WB), TOK, DM, BW}; pg8::StaticOrder S; S.init(TOK, DM, G, bid);
              pg8::EpiGateB E{ws}; pg8::gemm_phase<pg8::EpiGateB, pg8::StaticOrder, true, true>(L, g, S, E); }
            { pg8::Gemm g{WSP(const bf16_t, WS_PB), WSP(const bf16_t, WS_WPP), TOK, DM, PLE}; pg8::StaticOrder S; S.init(TOK, DM, G, bid);
              pg8::EpiF32P E{ws}; pg8::gemm_phase<pg8::EpiF32P, pg8::StaticOrder, true, true>(L, g, S, E); }
            SEAM(6);
        }
        if (IN(7)) for (int rep = 0; rep < (((DUP_MASK >> 7) & 1) ? 2 : 1); ++rep) { WSL;
            pg8::Gemm g{WSP(const bf16_t, WS_MG), WSP(const bf16_t, WS_WO), TOK, DM, DM}; pg8::StaticOrder S; S.init(TOK, DM, G, bid);
            pg8::EpiRes E{layer == 0 ? as_global(P->x) : WSP(const float, WS_X32), ws}; pg8::gemm_phase<pg8::EpiRes, pg8::StaticOrder, true, true>(L, g, S, E); SEAM(7);
        }
        if (IN(8)) for (int rep = 0; rep < (((DUP_MASK >> 8) & 1) ? 2 : 1); ++rep) { WSL; phase_ln(WSP(const float, WS_XPRE), WSP(float, WS_X32), WSP(bf16_t, WS_XB), as_global(P->lnm_g) + layer * DM, as_global(P->lnm_b) + layer * DM); SEAM(8); }
        if (IN(9)) for (int rep = 0; rep < (((DUP_MASK >> 9) & 1) ? 2 : 1); ++rep) { WSL;
            pg8::Gemm g{WSP(const bf16_t, WS_XB), WSP(const bf16_t, WS_WGU), TOK, 2 * DFF, DM}; pg8::StaticOrder S; S.init(TOK, 2 * DFF, G, bid);
            pg8::EpiSwiGLU E{ws}; pg8::gemm_phase<pg8::EpiSwiGLU, pg8::StaticOrder, true, true>(L, g, S, E); SEAM(9);
        }
        if (IN(10)) for (int rep = 0; rep < (((DUP_MASK >> 10) & 1) ? 2 : 1); ++rep) { WSL;
            pg8::Gemm g{WSP(const bf16_t, WS_H), WSP(const bf16_t, WS_WDN), TOK, DM, DFF}; pg8::StaticOrder S; S.init(TOK, DM, G, bid);
            pg8::EpiRes E{WSP(const float, WS_X32), ws}; pg8::gemm_phase<pg8::EpiRes, pg8::StaticOrder, true, true>(L, g, S, E); SEAM(10);
        }
        if (IN(11)) for (int rep = 0; rep < (((DUP_MASK >> 11) & 1) ? 2 : 1); ++rep) { WSL; phase_ln(WSP(const float, WS_XPRE), WSP(float, WS_X32), WSP(bf16_t, WS_XB), as_global(P->lnf_g) + layer * DM, as_global(P->lnf_b) + layer * DM); SEAM(11); }
        if (IN(12)) for (int rep = 0; rep < (((DUP_MASK >> 12) & 1) ? 2 : 1); ++rep) { WSL;
            pg8::Gemm g{WSP(const bf16_t, WS_XB), WSP(const bf16_t, WS_WPG), TOK, DM, DM}; pg8::StaticOrder S; S.init(TOK, DM, G, bid);
            pg8::EpiPle E{ws}; pg8::gemm_phase<pg8::EpiPle, pg8::StaticOrder, true, true>(L, g, S, E); SEAM(12);
        }
        if (IN(13)) for (int rep = 0; rep < (((DUP_MASK >> 13) & 1) ? 2 : 1); ++rep) { WSL; phase_ln(WSP(const float, WS_XPRE), layer == DEPTH - 1 ? as_global(P->out) : WSP(float, WS_X32), WSP(bf16_t, WS_XB), as_global(P->lnp_g) + layer * DM, as_global(P->lnp_b) + layer * DM); SEAM(13); }
#undef IN
#undef SEAM
    }
}

extern "C" void kernel_launch(void* const* d_in, const int* in_sizes, int n_in, void* d_out, int out_size, void* d_ws, size_t ws_size, hipStream_t stream) {
    static int grid = 0;
    if (grid == 0) {
        if (n_in != 22 || out_size != TOK * DM || ws_size < WS_END) { fprintf(stderr, "kernel_launch: unexpected shapes: n_in %d out %d ws %zu (need %zu)\n", n_in, out_size, ws_size, (size_t)WS_END); grid = -1; return; }
        int dev = 0, cus = 0, per_cu = 0;
        if (hipGetDevice(&dev) != hipSuccess || hipDeviceGetAttribute(&cus, hipDeviceAttributeMultiprocessorCount, dev) != hipSuccess) { grid = -1; return; }
        if (hipFuncSetAttribute((const void*)mega, hipFuncAttributeMaxDynamicSharedMemorySize, LDS_BYTES) != hipSuccess) { fprintf(stderr, "kernel_launch: hipFuncSetAttribute failed\n"); grid = -1; return; }
        if (hipOccupancyMaxActiveBlocksPerMultiprocessor(&per_cu, (const void*)mega, 512, LDS_BYTES) != hipSuccess || per_cu < 1) { fprintf(stderr, "kernel_launch: occupancy query says %d\n", per_cu); (void)hipGetLastError(); }
        grid = cus;
    }
    if (grid < 0) return;
    (void)hipMemsetAsync((char*)d_ws + WS_CTL, 0, 65536, stream);
    Params P{};
    P.x = (const float*)d_in[0]; P.p = (const float*)d_in[1]; P.pos = (const int*)d_in[2];
    P.w_in = (const float*)d_in[3]; P.w_a = (const float*)d_in[4]; P.w_b = (const float*)d_in[5]; P.w_out = (const float*)d_in[6];
    P.lbraw = (const float*)d_in[7]; P.hnorm_g = (const float*)d_in[8]; P.ikn_g = (const float*)d_in[9]; P.ikn_b = (const float*)d_in[10];
    P.lnm_g = (const float*)d_in[11]; P.lnm_b = (const float*)d_in[12]; P.w_fg = (const float*)d_in[13]; P.w_fu = (const float*)d_in[14]; P.w_fd = (const float*)d_in[15];
    P.lnf_g = (const float*)d_in[16]; P.lnf_b = (const float*)d_in[17]; P.w_pg = (const float*)d_in[18]; P.w_pp = (const float*)d_in[19];
    P.lnp_g = (const float*)d_in[20]; P.lnp_b = (const float*)d_in[21];
    P.out = (float*)d_out; P.ws = (unsigned char*)d_ws;
    for (int j = 0; j < 64; ++j) P.invf_h[j] = pow(10000.0, -(double)j / 64.0) / 6.283185307179586476925286766559;
    for (int j = 0; j < 32; ++j) P.invf_i[j] = pow(10000.0, -(double)j / 32.0) / 6.283185307179586476925286766559;
#if ONE_LAUNCH
    P.ph_lo = 0; P.ph_hi = NPH;
    hipLaunchKernelGGL(mega, dim3(grid), dim3(512), LDS_BYTES, stream, P);
#elif defined(SEQ_TEST)
    { const int seq[] = SEQ_TEST; for (int i = 0; i < (int)(sizeof(seq) / sizeof(int)); ++i) { P.ph_lo = seq[i]; P.ph_hi = seq[i] + 1; hipLaunchKernelGGL(mega, dim3(grid), dim3(512), LDS_BYTES, stream, P); }
      hipLaunchKernelGGL(k_dump, dim3(4096), dim3(256), 0, stream, (const unsigned char*)d_ws, DUMP_WHICH, (float*)d_out); }
#else
    unsigned char* ws = (unsigned char*)d_ws;
    for (int layer = 0; layer < DEPTH; ++layer)
        for (int k = 0; k < NPH_LAYER; ++k) {
            P.ph_lo = layer * NPH_LAYER + k; P.ph_hi = P.ph_lo + 1;
            bool run_mega = true;
#if !OPT_HGRN
            if (k == 3) hipLaunchKernelGGL(k_hgrn_naive, dim3(32), dim3(128), 0, stream, (const bf16_t*)(ws + WS_QA), (const bf16_t*)(ws + WS_KA), (const bf16_t*)(ws + WS_VA), (const bf16_t*)(ws + WS_GA),
                                           (const float*)(ws + WS_LF), P.hnorm_g + layer * 128, (bf16_t*)(ws + WS_YA));
#endif
#if !OPT_IDX
            if (k == 3) hipLaunchKernelGGL(k_idx_naive, dim3(TOK), dim3(256), 0, stream, (const bf16_t*)(ws + WS_QI), (const bf16_t*)(ws + WS_KI), (const float*)(ws + WS_WI), (float*)(ws + WS_XPRE));
#endif
#if !OPT_ATT
            if (k == 5) hipLaunchKernelGGL(k_attn_naive, dim3(TOK), dim3(512), 0, stream, (const bf16_t*)(ws + WS_QB), (const bf16_t*)(ws + WS_KB), (const bf16_t*)(ws + WS_VB),
                                           (const unsigned long long*)(ws + WS_MASK), (bf16_t*)(ws + WS_YB));
#endif
#if !OPT_HGRN && !OPT_IDX
            if (k == 3) run_mega = false;
#endif
#if !OPT_ATT
            if (k == 5) run_mega = false;
#endif
            if (run_mega) hipLaunchKernelGGL(mega, dim3(grid), dim3(512), LDS_BYTES, stream, P);
#ifdef DUMP_AT
            if (layer * NPH_LAYER + k == DUMP_AT) { hipLaunchKernelGGL(k_dump, dim3(4096), dim3(256), 0, stream, (const unsigned char*)ws, DUMP_WHICH, (float*)d_out); return; }
#endif
        }
#endif
    const hipError_t le = hipPeekAtLastError();
    if (le != hipSuccess) fprintf(stderr, "kernel_launch: launch failed: %s\n", hipGetErrorName(le));
}
```

```cpp
#include <hip/hip_runtime.h>
#include <cstdio>
#include <cstdint>

constexpr int DM = 2048, NBATCH = 4, SEQ = 4096, TOK = NBATCH * SEQ, DEPTH = 4, CHUNK = 64, PLE = 256;
constexpr int AH = 8, AD = 128, AW = 1024, BH = 8, BD = 128, BW = 1024, IH = 16, IDIM = 64, TOPK = 256;
constexpr int DFF = 5632, INW = 12368, INP = 12544;
constexpr float ALPHA = 1.6817928305074290861f;
constexpr float LN_EPS = 1e-5f, RMS_EPS = 1e-6f;
constexpr float ATTN_SCALE = 0.088388347648318440f;
constexpr float IDX_SCALE = 0.03125f;

typedef unsigned short bf16_t;
__device__ __forceinline__ float bf2f(bf16_t b) { return __uint_as_float(((unsigned)b) << 16); }
__device__ __forceinline__ bf16_t f2bf(float f) { unsigned u = __float_as_uint(f); u += 0x7FFFu + ((u >> 16) & 1u); return (bf16_t)(u >> 16); }
__device__ __forceinline__ float sigmoid_f(float x) { return __builtin_amdgcn_rcpf(1.0f + __expf(-x)); }
__device__ __forceinline__ float silu_f(float x) { return x * sigmoid_f(x); }

__device__ __forceinline__ int tid_() { int t = (int)threadIdx.x; asm volatile("" : "+v"(t)); return t; }
__device__ __forceinline__ int bid_() { int b = (int)blockIdx.x; asm volatile("" : "+s"(b)); return b; }
__device__ __forceinline__ int nblk_() { int g = (int)gridDim.x; asm volatile("" : "+s"(g)); return g; }

template <class T> __device__ __forceinline__ T* as_global(T* p) { return (T*)(__attribute__((address_space(1))) T*)p; }

constexpr size_t MiB = 1048576;
constexpr size_t WS_CTL  = 0;
constexpr size_t WS_LB   = WS_CTL + 65536;
constexpr size_t WS_STATS = WS_CTL + 131072;
constexpr size_t WS_COSH = 1 * MiB;
constexpr size_t WS_SINH = WS_COSH + 4 * MiB;
constexpr size_t WS_COSI = WS_SINH + 4 * MiB;
constexpr size_t WS_SINI = WS_COSI + 2 * MiB;
constexpr size_t WS_WIN  = WS_SINI + 2 * MiB;
constexpr size_t WS_WA   = WS_WIN + 49 * MiB;
constexpr size_t WS_WB   = WS_WA + 4 * MiB;
constexpr size_t WS_WO   = WS_WB + 4 * MiB;
constexpr size_t WS_WGU  = WS_WO + 8 * MiB;
constexpr size_t WS_WDN  = WS_WGU + 44 * MiB;
constexpr size_t WS_WPG  = WS_WDN + 22 * MiB;
constexpr size_t WS_WPP  = WS_WPG + 8 * MiB;
constexpr size_t WS_S    = WS_WPP + 1 * MiB;
constexpr size_t WS_XB   = WS_S + 130 * MiB;
constexpr size_t WS_XPRE = WS_XB + 64 * MiB;
constexpr size_t WS_R1   = WS_XPRE + 130 * MiB;
constexpr size_t WS_QA   = WS_R1;
constexpr size_t WS_LF   = WS_QA + 32 * MiB;
constexpr size_t WS_KA   = WS_LF + 64 * MiB;
constexpr size_t WS_VA   = WS_KA + 32 * MiB;
constexpr size_t WS_GA   = WS_VA + 32 * MiB;
constexpr size_t WS_QB   = WS_GA + 32 * MiB;
constexpr size_t WS_KB   = WS_QB + 32 * MiB;
constexpr size_t WS_VB   = WS_KB + 32 * MiB;
constexpr size_t WS_QI   = WS_VB + 32 * MiB;
constexpr size_t WS_SGA  = WS_QI + 32 * MiB;
constexpr size_t WS_SGB  = WS_SGA + 64 * MiB;
constexpr size_t WS_IKW  = WS_SGB + 64 * MiB;
constexpr size_t WS_H    = WS_R1;
constexpr size_t WS_PP   = WS_R1 + 176 * MiB;
constexpr size_t WS_R2   = WS_IKW + 8 * MiB;
constexpr size_t WS_LT   = WS_R2;
constexpr size_t WS_MG   = WS_R2;
constexpr size_t WS_AF   = WS_R2 + 64 * MiB;
constexpr size_t WS_PT   = WS_LT + 128 * MiB;
constexpr size_t WS_DEC  = WS_PT + 64 * MiB;
constexpr size_t WS_MASK = WS_DEC + 1 * MiB;
constexpr size_t WS_YA   = WS_MASK + 8 * MiB;
constexpr size_t WS_YB   = WS_YA + 32 * MiB;
constexpr size_t WS_KI   = WS_YB + 32 * MiB;
constexpr size_t WS_WI   = WS_KI + 2 * MiB;
constexpr size_t WS_PB   = WS_WI + 1 * MiB;
constexpr size_t WS_END  = WS_PB + 8 * MiB;
static_assert(WS_END < 1360000000ull, "workspace budget");
constexpr size_t SCORE_B = (size_t)4096 * 2080;

namespace pg8 {
#define PG8_LAS __attribute__((address_space(3)))
typedef unsigned short bf16_t;
typedef short bf16x8 __attribute__((ext_vector_type(8)));
typedef float f32x4 __attribute__((ext_vector_type(4)));
typedef unsigned u32x4 __attribute__((ext_vector_type(4)));
constexpr int BM = 256, BK = 64, HALF = 128, HTB = HALF * BK * 2  , STAGE_BYTES = 8 * HTB, NXCD = 8, WGM = 8;

__host__ __device__ __forceinline__ int lds_byte(int r, int c) { const int st = (r >> 4) * 2 + (c >> 5), rr = r & 15, cc = c & 31, ob = rr * 64 + cc * 2; return st * 1024 + (ob ^ (((ob >> 9) & 1) << 5)); }
__host__ __device__ __forceinline__ void stage_rc(int b, int& R, int& C) { const int st = b / 1024, sb = b % 1024, swz = sb ^ (((sb >> 9) & 1) << 5); R = (st >> 1) * 16 + swz / 64; C = (st & 1) * 32 + (swz % 64) / 2; }
__host__ __device__ __forceinline__ int perm32(int rho) { const int n = rho >> 4, i = rho & 15; return 8 * (i >> 2) + 4 * n + (i & 3); }

struct Unit { int pm, pn; };
struct Gemm { const bf16_t* A; const bf16_t* Bt; int M, N, K; };

struct StaticOrder {
    int nM, nN, nwg, G, c;
    __host__ __device__ void init(int M, int N, int G_, int c_) { nM = M / BM; nN = N / BM; nwg = nM * nN; G = G_; c = c_; }
    __host__ __device__ bool next(int i, Unit& u) const {
        const long L = (long)i * G + c; if (L >= nwg) return false;
        int wgid = (int)L; { const int q = nwg / NXCD, r = nwg % NXCD, xcd = wgid % NXCD, off = wgid / NXCD; wgid = (xcd < r ? xcd * (q + 1) : r * (q + 1) + (xcd - r) * q) + off; }
        const int nig = WGM * nN, gid = wgid / nig, fm = gid * WGM, gsz = (nM - fm) < WGM ? (nM - fm) : WGM;
        u.pm = fm + ((wgid % nig) % gsz); u.pn = (wgid % nig) / gsz; return true;
    }
    __device__ __forceinline__ void a_ready(const Unit&) const {}
    __device__ __forceinline__ void done(const Unit&) const {}
};

typedef float pk_f32x2 __attribute__((ext_vector_type(2)));
typedef __bf16 pk_bf16x2 __attribute__((ext_vector_type(2)));
__device__ __forceinline__ unsigned cvt_pk_bf16(float lo, float hi) { const pk_f32x2 v = {lo, hi}; const pk_bf16x2 b = __builtin_convertvector(v, pk_bf16x2); return __builtin_bit_cast(unsigned, b); }
typedef unsigned u32x2 __attribute__((ext_vector_type(2)));
typedef float f32x2 __attribute__((ext_vector_type(2)));
__device__ __forceinline__ u32x4 pack8(const f32x4 a, const f32x4 b) { u32x4 w; w.x = cvt_pk_bf16(a[0], a[1]); w.y = cvt_pk_bf16(a[2], a[3]); w.z = cvt_pk_bf16(b[0], b[1]); w.w = cvt_pk_bf16(b[2], b[3]); return w; }
__device__ __forceinline__ void unpack8(const u32x4 w, f32x4& a, f32x4& b) {
    a[0] = __uint_as_float(w.x << 16); a[1] = __uint_as_float(w.x & 0xffff0000u); a[2] = __uint_as_float(w.y << 16); a[3] = __uint_as_float(w.y & 0xffff0000u);
    b[0] = __uint_as_float(w.z << 16); b[1] = __uint_as_float(w.z & 0xffff0000u); b[2] = __uint_as_float(w.w << 16); b[3] = __uint_as_float(w.w & 0xffff0000u); }
__device__ __forceinline__ float sigm(float x) { return __builtin_amdgcn_rcpf(1.0f + __expf(-x)); }
__device__ __forceinline__ f32x4 sigm4(const f32x4 x) { f32x4 r; r[0] = sigm(x[0]); r[1] = sigm(x[1]); r[2] = sigm(x[2]); r[3] = sigm(x[3]); return r; }
__device__ __forceinline__ f32x4 silu4(const f32x4 x) { return x * sigm4(x); }

#define PG8_GAS __attribute__((address_space(1)))
struct EpiIn {
    static constexpr bool PERM = true, AFTER_DRAIN = false;
    unsigned char* ws0; int layer;
    __device__ __forceinline__ void operator()(const f32x4 (&acc)[2][2][4][2], const Unit& u, int wr, int wc, int fr, int fq) const {
        unsigned char* wsq = ws0; asm volatile("" : "+s"(wsq)); PG8_GAS unsigned char* const ws = (PG8_GAS unsigned char*)wsq;
        const int pn = u.pn, row0 = u.pm * BM + wr * 64 + fr, cw = wc * 32 + 8 * fq;
        PG8_GAS bf16_t* const QA = (PG8_GAS bf16_t*)(ws + WS_QA); PG8_GAS bf16_t* const KA = (PG8_GAS bf16_t*)(ws + WS_KA); PG8_GAS bf16_t* const VA = (PG8_GAS bf16_t*)(ws + WS_VA); PG8_GAS bf16_t* const GA = (PG8_GAS bf16_t*)(ws + WS_GA);
        PG8_GAS bf16_t* const QB = (PG8_GAS bf16_t*)(ws + WS_QB); PG8_GAS bf16_t* const KB = (PG8_GAS bf16_t*)(ws + WS_KB); PG8_GAS bf16_t* const VB = (PG8_GAS bf16_t*)(ws + WS_VB); PG8_GAS bf16_t* const QI = (PG8_GAS bf16_t*)(ws + WS_QI);
        PG8_GAS bf16_t* const SGA = (PG8_GAS bf16_t*)(ws + WS_SGA); PG8_GAS bf16_t* const SGB = (PG8_GAS bf16_t*)(ws + WS_SGB); PG8_GAS float* const LF = (PG8_GAS float*)(ws + WS_LF); PG8_GAS float* const IKW = (PG8_GAS float*)(ws + WS_IKW);
        const PG8_GAS float* const lb = (const PG8_GAS float*)(ws + WS_LB) + layer * 1024; const PG8_GAS float* const cosh = (const PG8_GAS float*)(ws + WS_COSH); const PG8_GAS float* const sinh = (const PG8_GAS float*)(ws + WS_SINH);
        const PG8_GAS float* const cosi = (const PG8_GAS float*)(ws + WS_COSI); const PG8_GAS float* const sini = (const PG8_GAS float*)(ws + WS_SINI);
        if (pn < 32) {
            const int seg = pn >> 2, cb = (pn & 3) * 256;
            if (seg == 4 || seg == 5) {
                PG8_GAS bf16_t* O = (seg == 4) ? QB : KB; const int head = (pn & 3) * 2 + (wc >> 1), i0 = (wc & 1) * 32 + 8 * fq;
#pragma unroll
                for (int ai = 0; ai < 2; ++ai)
#pragma unroll
                    for (int m = 0; m < 4; ++m) { const int row = row0 + ai * HALF + m * 16;
                        const PG8_GAS float* cp = cosh + (size_t)row * 64 + i0; const PG8_GAS float* sp = sinh + (size_t)row * 64 + i0;
                        const f32x4 c0 = *(const PG8_GAS f32x4*)cp, c1 = *(const PG8_GAS f32x4*)(cp + 4), s0 = *(const PG8_GAS f32x4*)sp, s1 = *(const PG8_GAS f32x4*)(sp + 4);
                        const f32x4 xa = acc[ai][0][m][0], xb = acc[ai][0][m][1], ya = acc[ai][1][m][0], yb = acc[ai][1][m][1];
                        PG8_GAS bf16_t* rp = O + (size_t)row * 1024 + head * 128 + i0;
                        *(PG8_GAS u32x4*)rp = pack8(xa * c0 - ya * s0, xb * c1 - yb * s1);
                        *(PG8_GAS u32x4*)(rp + 64) = pack8(xa * s0 + ya * c0, xb * s1 + yb * c1); asm volatile("" ::: "memory"); }
            } else if (seg == 7) {
                const int head = (pn & 3) * 4 + wc, i0 = 8 * fq;
#pragma unroll
                for (int ai = 0; ai < 2; ++ai)
#pragma unroll
                    for (int m = 0; m < 4; ++m) { const int row = row0 + ai * HALF + m * 16;
                        const PG8_GAS float* cp = cosi + (size_t)row * 32 + i0; const PG8_GAS float* sp = sini + (size_t)row * 32 + i0;
                        const f32x4 c0 = *(const PG8_GAS f32x4*)cp, c1 = *(const PG8_GAS f32x4*)(cp + 4), s0 = *(const PG8_GAS f32x4*)sp, s1 = *(const PG8_GAS f32x4*)(sp + 4);
                        const f32x4 xa = acc[ai][0][m][0], xb = acc[ai][0][m][1], ya = acc[ai][1][m][0], yb = acc[ai][1][m][1];
                        PG8_GAS bf16_t* rp = QI + (size_t)row * 1024 + head * 64 + i0;
                        *(PG8_GAS u32x4*)rp = pack8(xa * c0 - ya * s0, xb * c1 - yb * s1);
                        *(PG8_GAS u32x4*)(rp + 32) = pack8(xa * s0 + ya * c0, xb * s1 + yb * c1); asm volatile("" ::: "memory"); }
            } else if (seg == 1) {
#pragma unroll
                for (int bj = 0; bj < 2; ++bj) { const int col = cb + bj * HALF + cw;
                    const f32x4 l0 = *(const PG8_GAS f32x4*)(lb + col), l1 = *(const PG8_GAS f32x4*)(lb + col + 4);
#pragma unroll
                    for (int ai = 0; ai < 2; ++ai)
#pragma unroll
                        for (int m = 0; m < 4; ++m) { const int row = row0 + ai * HALF + m * 16; f32x4 lf[2], kk[2];
#pragma unroll
                            for (int n = 0; n < 2; ++n) { const f32x4 x = acc[ai][bj][m][n]; const f32x4 lv = n ? l1 : l0;
#pragma unroll
                                for (int j = 0; j < 4; ++j) { const float xe = fminf(fmaxf(x[j], -80.f), 80.f), e = __expf(-xe), r = __builtin_amdgcn_rcpf(1.0f + e);
                                    const float om = 1.0f - lv[j]; lf[n][j] = logf(lv[j] + om * r); kk[n][j] = om * (e * r); } }
                            PG8_GAS float* lp = LF + (size_t)row * 1024 + col; *(PG8_GAS f32x4*)lp = lf[0]; *(PG8_GAS f32x4*)(lp + 4) = lf[1];
                            *(PG8_GAS u32x4*)(KA + (size_t)row * 1024 + col) = pack8(kk[0], kk[1]); asm volatile("" ::: "memory"); } }
            } else {
                PG8_GAS bf16_t* O = (seg == 0) ? QA : (seg == 2) ? VA : (seg == 3) ? GA : VB; const bool act = (seg == 0 || seg == 3);
#pragma unroll
                for (int ai = 0; ai < 2; ++ai)
#pragma unroll
                    for (int m = 0; m < 4; ++m) { const int row = row0 + ai * HALF + m * 16;
#pragma unroll
                        for (int bj = 0; bj < 2; ++bj) { f32x4 v0 = acc[ai][bj][m][0], v1 = acc[ai][bj][m][1];
                            if (act) { v0 = silu4(v0); v1 = silu4(v1); }
                            *(PG8_GAS u32x4*)(O + (size_t)row * 1024 + cb + bj * HALF + cw) = pack8(v0, v1); } }
            }
        } else if (pn < 48) {
            PG8_GAS bf16_t* O = (pn < 40) ? SGA : SGB; const int cb = ((pn - 32) & 7) * 256;
#pragma unroll
            for (int ai = 0; ai < 2; ++ai)
#pragma unroll
                for (int m = 0; m < 4; ++m) { const int row = row0 + ai * HALF + m * 16;
#pragma unroll
                    for (int bj = 0; bj < 2; ++bj)
                        *(PG8_GAS u32x4*)(O + (size_t)row * DM + cb + bj * HALF + cw) = pack8(sigm4(acc[ai][bj][m][0]), sigm4(acc[ai][bj][m][1])); }
        } else {
#pragma unroll
            for (int ai = 0; ai < 2; ++ai)
#pragma unroll
                for (int m = 0; m < 4; ++m) { PG8_GAS float* p = IKW + (size_t)(row0 + ai * HALF + m * 16) * 128 + cw; *(PG8_GAS f32x4*)p = acc[ai][0][m][0]; *(PG8_GAS f32x4*)(p + 4) = acc[ai][0][m][1]; }
        }
    }
};
struct EpiGateA {
    static constexpr bool PERM = true, AFTER_DRAIN = false;
    unsigned char* ws;
    __device__ __forceinline__ void operator()(const f32x4 (&acc)[2][2][4][2], const Unit& u, int wr, int wc, int fr, int fq) const {
        unsigned char* const wg = as_global(ws); const bf16_t* const SG = (const bf16_t*)(wg + WS_SGA); bf16_t* const AF = (bf16_t*)(wg + WS_AF);
        const int row0 = u.pm * BM + wr * 64 + fr, col0 = u.pn * BM + wc * 32 + 8 * fq;
#pragma unroll
        for (int ai = 0; ai < 2; ++ai)
#pragma unroll
            for (int m = 0; m < 4; ++m) { const size_t off = (size_t)(row0 + ai * HALF + m * 16) * DM + col0;
#pragma unroll
                for (int bj = 0; bj < 2; ++bj) { f32x4 g0, g1; unpack8(*(const u32x4*)(SG + off + bj * HALF), g0, g1);
                    *(u32x4*)(AF + off + bj * HALF) = pack8(g0 * acc[ai][bj][m][0], g1 * acc[ai][bj][m][1]); } asm volatile("" ::: "memory"); }
    }
};
struct EpiGateB {
    static constexpr bool PERM = true, AFTER_DRAIN = false;
    unsigned char* ws;
    __device__ __forceinline__ void operator()(const f32x4 (&acc)[2][2][4][2], const Unit& u, int wr, int wc, int fr, int fq) const {
        unsigned char* const wg = as_global(ws); const bf16_t* const SG = (const bf16_t*)(wg + WS_SGB); const bf16_t* const AF = (const bf16_t*)(wg + WS_AF); bf16_t* const MG = (bf16_t*)(wg + WS_MG);
        const int row0 = u.pm * BM + wr * 64 + fr, col0 = u.pn * BM + wc * 32 + 8 * fq;
#pragma unroll
        for (int ai = 0; ai < 2; ++ai)
#pragma unroll
            for (int m = 0; m < 4; ++m) { const size_t off = (size_t)(row0 + ai * HALF + m * 16) * DM + col0;
#pragma unroll
                for (int bj = 0; bj < 2; ++bj) { f32x4 g0, g1; unpack8(*(const u32x4*)(SG + off + bj * HALF), g0, g1);
                    f32x4 a0, a1; unpack8(*(const u32x4*)(AF + off + bj * HALF), a0, a1);
                    *(u32x4*)(MG + off + bj * HALF) = pack8(a0 + g0 * acc[ai][bj][m][0], a1 + g1 * acc[ai][bj][m][1]); } asm volatile("" ::: "memory"); }
    }
};
template <bool PLAIN> struct EpiRes {
    static constexpr bool PERM = true, AFTER_DRAIN = false;
    const float* X; const float* g; const float* b; unsigned char* ws;
    __device__ __forceinline__ void operator()(const f32x4 (&acc)[2][2][4][2], const Unit& u, int wr, int wc, int fr, int fq) const {
        unsigned char* const wg = as_global(ws); float* const XP = (float*)(wg + WS_XPRE); const float* const ST = (const float*)(wg + WS_STATS); const float* const Xg = as_global(X);
        const int row0 = u.pm * BM + wr * 64 + fr, col0 = u.pn * BM + wc * 32 + 8 * fq;
        f32x4 gv[2][2], bv[2][2];
        if (!PLAIN) { const float* gg = as_global(g); const float* bb = as_global(b);
#pragma unroll
            for (int bj = 0; bj < 2; ++bj)
#pragma unroll
                for (int n = 0; n < 2; ++n) { gv[bj][n] = *(const f32x4*)(gg + col0 + bj * HALF + 4 * n); bv[bj][n] = *(const f32x4*)(bb + col0 + bj * HALF + 4 * n); } }
#pragma unroll
        for (int ai = 0; ai < 2; ++ai)
#pragma unroll
            for (int m = 0; m < 4; ++m) { const int row = row0 + ai * HALF + m * 16; const size_t off = (size_t)row * DM + col0;
                float mean = 0.f, rstd = 1.f; if (!PLAIN) { const f32x2 s2 = *(const f32x2*)(ST + 2 * (size_t)row); mean = s2[0]; rstd = s2[1]; }
#pragma unroll
                for (int bj = 0; bj < 2; ++bj) { float* p = XP + off + bj * HALF; f32x4 x0, x1;
                    if (PLAIN) { const float* xp = Xg + off + bj * HALF; x0 = *(const f32x4*)xp; x1 = *(const f32x4*)(xp + 4); }
                    else { x0 = (*(const f32x4*)p - mean) * rstd * gv[bj][0] + bv[bj][0]; x1 = (*(const f32x4*)(p + 4) - mean) * rstd * gv[bj][1] + bv[bj][1]; }
                    *(f32x4*)p = x0 * ALPHA + acc[ai][bj][m][0]; *(f32x4*)(p + 4) = x1 * ALPHA + acc[ai][bj][m][1]; } asm volatile("" ::: "memory"); }
    }
};
struct EpiSwiGLU {
    static constexpr bool PERM = true, AFTER_DRAIN = false;
    unsigned char* ws;
    __device__ __forceinline__ void operator()(const f32x4 (&acc)[2][2][4][2], const Unit& u, int wr, int wc, int fr, int fq) const {
        bf16_t* const H = (bf16_t*)(as_global(ws) + WS_H);
        const int row0 = u.pm * BM + wr * 64 + fr, col0 = u.pn * HALF + wc * 32 + 8 * fq;
#pragma unroll
        for (int ai = 0; ai < 2; ++ai)
#pragma unroll
            for (int m = 0; m < 4; ++m)
                *(u32x4*)(H + (size_t)(row0 + ai * HALF + m * 16) * DFF + col0) = pack8(silu4(acc[ai][0][m][0]) * acc[ai][1][m][0], silu4(acc[ai][0][m][1]) * acc[ai][1][m][1]);
    }
};
struct EpiF32P {
    static constexpr bool PERM = true, AFTER_DRAIN = false;
    unsigned char* ws;
    __device__ __forceinline__ void operator()(const f32x4 (&acc)[2][2][4][2], const Unit& u, int wr, int wc, int fr, int fq) const {
        bf16_t* const C = (bf16_t*)(as_global(ws) + WS_PP);
        const int row0 = u.pm * BM + wr * 64 + fr, col0 = u.pn * BM + wc * 32 + 8 * fq;
#pragma unroll
        for (int ai = 0; ai < 2; ++ai)
#pragma unroll
            for (int m = 0; m < 4; ++m) { const size_t off = (size_t)(row0 + ai * HALF + m * 16) * DM + col0;
#pragma unroll
                for (int bj = 0; bj < 2; ++bj) *(u32x4*)(C + off + bj * HALF) = pack8(acc[ai][bj][m][0], acc[ai][bj][m][1]); }
    }
};
struct EpiPle {
    static constexpr bool PERM = true, AFTER_DRAIN = false;
    const float* g; const float* b; unsigned char* ws;
    __device__ __forceinline__ void operator()(const f32x4 (&acc)[2][2][4][2], const Unit& u, int wr, int wc, int fr, int fq) const {
        unsigned char* const wg = as_global(ws); const bf16_t* const PP = (const bf16_t*)(wg + WS_PP); float* const XP = (float*)(wg + WS_XPRE); const float* const ST = (const float*)(wg + WS_STATS);
        const int row0 = u.pm * BM + wr * 64 + fr, col0 = u.pn * BM + wc * 32 + 8 * fq;
        f32x4 gv[2][2], bv[2][2]; { const float* gg = as_global(g); const float* bb = as_global(b);
#pragma unroll
            for (int bj = 0; bj < 2; ++bj)
#pragma unroll
                for (int n = 0; n < 2; ++n) { gv[bj][n] = *(const f32x4*)(gg + col0 + bj * HALF + 4 * n); bv[bj][n] = *(const f32x4*)(bb + col0 + bj * HALF + 4 * n); } }
#pragma unroll
        for (int ai = 0; ai < 2; ++ai)
#pragma unroll
            for (int m = 0; m < 4; ++m) { const int row = row0 + ai * HALF + m * 16; const size_t off = (size_t)row * DM + col0;
                const f32x2 s2 = *(const f32x2*)(ST + 2 * (size_t)row); const float mean = s2[0], rstd = s2[1];
#pragma unroll
                for (int bj = 0; bj < 2; ++bj) { float* p = XP + off + bj * HALF; f32x4 p0, p1; unpack8(*(const u32x4*)(PP + off + bj * HALF), p0, p1);
                    const f32x4 x0 = (*(const f32x4*)p - mean) * rstd * gv[bj][0] + bv[bj][0], x1 = (*(const f32x4*)(p + 4) - mean) * rstd * gv[bj][1] + bv[bj][1];
                    *(f32x4*)p = x0 * ALPHA + sigm4(acc[ai][bj][m][0]) * p0; *(f32x4*)(p + 4) = x1 * ALPHA + sigm4(acc[ai][bj][m][1]) * p1; } asm volatile("" ::: "memory"); }
    }
};

struct EpiRawTest {
    static constexpr bool PERM = true, AFTER_DRAIN = false;
    unsigned char* ws;
    __device__ __forceinline__ void operator()(const f32x4 (&acc)[2][2][4][2], const Unit& u, int wr, int wc, int fr, int fq) const {
        bf16_t* const H = (bf16_t*)(as_global(ws) + WS_H);
        const int row0 = u.pm * BM + wr * 64 + fr, col0 = u.pn * HALF + wc * 32 + 8 * fq;
#pragma unroll
        for (int ai = 0; ai < 2; ++ai)
#pragma unroll
            for (int m = 0; m < 4; ++m)
                *(u32x4*)(H + (size_t)(row0 + ai * HALF + m * 16) * 6272 + col0) = pack8(acc[ai][0][m][0] + acc[ai][1][m][0], acc[ai][0][m][1] + acc[ai][1][m][1]);
    }
};
template <class Epi, class Sched, bool ALIGN_EPI = false, bool SP2 = false>
__device__ __forceinline__ void gemm_phase(PG8_LAS unsigned char* lds, const Gemm g, const Sched& S, const Epi& E) {
    const int tid = tid_(), wid = __builtin_amdgcn_readfirstlane(tid >> 6), lane = tid & 63, wr = wid >> 2, wc = wid & 3, fr = lane & 15, fq = lane >> 4;
    int Kq = g.K; asm volatile("" : "+s"(Kq)); const int K = Kq, nt = K / BK;
    unsigned voffA[2], voffB[2];
#pragma unroll
    for (int i = 0; i < 2; ++i) { int R, C; stage_rc(tid * 16 + i * 8192, R, C); const int Rb = Epi::PERM ? ((R & ~31) + perm32(R & 31)) : R;
        voffA[i] = (unsigned)(R * K + C) * 2u; voffB[i] = (unsigned)(Rb * K + C) * 2u; }
    const size_t kstep = (size_t)(BK * 2);
    const size_t hstep = (size_t)HALF * K * 2;
    const size_t tstep = 2 * hstep;
    const unsigned ldsw = (unsigned)wid * 1024u;
    const int aoff = lds_byte(wr * 64 + fr, fq * 8), boff = lds_byte(wc * 32 + fr, fq * 8);
#define PG8_SA(b, h) (((b) * 2 + (h)) * HTB)
#define PG8_SB(b, h) ((4 + (b) * 2 + (h)) * HTB)
#define PG8_STAGE(bufoff, gbase, voff) do { _Pragma("unroll") for (int _i = 0; _i < 2; ++_i) \
        __builtin_amdgcn_global_load_lds((const unsigned*)((const char*)(gbase) + (voff)[_i]), (PG8_LAS unsigned*)(lds + (bufoff) + ldsw + _i * 8192), 16, 0, 0); } while (0)
#define PG8_LDA(dst, b, h) do { _Pragma("unroll") for (int m = 0; m < 4; ++m) _Pragma("unroll") for (int k = 0; k < 2; ++k) dst[m][k] = *(const PG8_LAS bf16x8*)(lds + PG8_SA(b, h) + aoff + m * 2048 + k * 1024); } while (0)
#define PG8_LDB(dst, b, h) do { _Pragma("unroll") for (int n = 0; n < 2; ++n) _Pragma("unroll") for (int k = 0; k < 2; ++k) dst[n][k] = *(const PG8_LAS bf16x8*)(lds + PG8_SB(b, h) + boff + n * 2048 + k * 1024); } while (0)
#define PG8_MMA(ai, bj, At, Bt) do { __builtin_amdgcn_s_setprio(1); _Pragma("unroll") for (int m = 0; m < 4; ++m) _Pragma("unroll") for (int n = 0; n < 2; ++n) _Pragma("unroll") for (int k = 0; k < 2; ++k) \
        acc[ai][bj][m][n] = __builtin_amdgcn_mfma_f32_16x16x32_bf16(Bt[n][k], At[m][k], acc[ai][bj][m][n], 0, 0, 0); __builtin_amdgcn_s_setprio(0); } while (0)
#define PG8_WAIT_V(n) asm volatile("s_waitcnt vmcnt(" #n ")" ::: "memory")
#define PG8_WAIT_L(n) asm volatile("s_waitcnt lgkmcnt(" #n ")" ::: "memory")
#define PG8_BAR __builtin_amdgcn_s_barrier()
#define PG8_SCHED __builtin_amdgcn_sched_barrier(0)
    Unit cur, nxt; int ui = 0;
    if (!S.next(0, cur)) return;
    f32x4 acc[2][2][4][2];
#pragma unroll
    for (int a = 0; a < 2; ++a)
#pragma unroll
        for (int b = 0; b < 2; ++b)
#pragma unroll
            for (int m = 0; m < 4; ++m)
#pragma unroll
                for (int n = 0; n < 2; ++n) acc[a][b][m][n] = (f32x4){0.f, 0.f, 0.f, 0.f};
    bf16x8 At[4][2], B0[2][2], B1[2][2];
    const char* cA = (const char*)g.A + (size_t)cur.pm * tstep; const char* cB = (const char*)g.Bt + (size_t)cur.pn * tstep;
    S.a_ready(cur);
    if constexpr (SP2) {
        PG8_STAGE(PG8_SB(0, 0), cB, voffB); PG8_STAGE(PG8_SB(0, 1), cB + hstep, voffB); PG8_STAGE(PG8_SA(0, 0), cA, voffA); PG8_STAGE(PG8_SA(0, 1), cA + hstep, voffA);
        if (wr == 1) PG8_BAR;
        PG8_WAIT_V(2); PG8_BAR;
        PG8_STAGE(PG8_SB(1, 0), cB + kstep, voffB); PG8_STAGE(PG8_SA(1, 0), cA + kstep, voffA); PG8_STAGE(PG8_SB(1, 1), cB + hstep + kstep, voffB);
        PG8_WAIT_V(6); PG8_BAR;
    } else {
        PG8_STAGE(PG8_SB(0, 0), cB, voffB); PG8_STAGE(PG8_SA(0, 0), cA, voffA); PG8_STAGE(PG8_SB(0, 1), cB + hstep, voffB); PG8_STAGE(PG8_SA(0, 1), cA + hstep, voffA);
        if (wr == 1) PG8_BAR;
        PG8_WAIT_V(4); PG8_BAR;
        PG8_STAGE(PG8_SB(1, 0), cB + kstep, voffB); PG8_STAGE(PG8_SA(1, 0), cA + kstep, voffA); PG8_STAGE(PG8_SB(1, 1), cB + hstep + kstep, voffB);
        PG8_WAIT_V(6); PG8_BAR;
    }
    for (;;) {
        const bool has_next = S.next(ui + 1, nxt);
        const char* nA = has_next ? (const char*)g.A + (size_t)nxt.pm * tstep : cA; const char* nB = has_next ? (const char*)g.Bt + (size_t)nxt.pn * tstep : cB;
        for (int t = 0; t < nt; t += 2) {
            const bool last = (t == nt - 2);
            const char* a1 = cA + (size_t)(t + 1) * kstep;
            const char* a2 = last ? nA : cA + (size_t)(t + 2) * kstep; const char* b2 = last ? nB : cB + (size_t)(t + 2) * kstep;
            const char* a3 = a2 + kstep; const char* b3 = b2 + kstep;
            if (last && has_next) S.a_ready(nxt);
            if constexpr (SP2) {
            PG8_LDB(B0, 0, 0); PG8_LDB(B1, 0, 1); PG8_SCHED; PG8_LDA(At, 0, 0); PG8_STAGE(PG8_SA(1, 1), a1 + hstep, voffA);
            PG8_WAIT_V(8); PG8_WAIT_L(0); PG8_BAR; PG8_MMA(0, 0, At, B0); PG8_MMA(0, 1, At, B1); PG8_BAR; PG8_SCHED;
            PG8_LDA(At, 0, 1); PG8_STAGE(PG8_SB(0, 0), b2, voffB); PG8_STAGE(PG8_SB(0, 1), b2 + hstep, voffB); PG8_STAGE(PG8_SA(0, 0), a2, voffA);
            PG8_WAIT_V(8); PG8_WAIT_L(0); PG8_BAR; PG8_MMA(1, 0, At, B0); PG8_MMA(1, 1, At, B1); PG8_BAR; PG8_SCHED;
            PG8_LDB(B0, 1, 0); PG8_LDB(B1, 1, 1); PG8_SCHED; PG8_LDA(At, 1, 0); PG8_STAGE(PG8_SA(0, 1), a2 + hstep, voffA);
            PG8_WAIT_V(8); PG8_WAIT_L(0); PG8_BAR; PG8_MMA(0, 0, At, B0); PG8_MMA(0, 1, At, B1); PG8_BAR; PG8_SCHED;
            PG8_LDA(At, 1, 1); PG8_STAGE(PG8_SB(1, 0), b3, voffB); PG8_STAGE(PG8_SB(1, 1), b3 + hstep, voffB); PG8_STAGE(PG8_SA(1, 0), a3, voffA);
            PG8_WAIT_V(8); PG8_WAIT_L(0); PG8_BAR; PG8_MMA(1, 0, At, B0); PG8_MMA(1, 1, At, B1); PG8_BAR; PG8_SCHED;
            } else {
            PG8_LDB(B0, 0, 0); PG8_SCHED; PG8_LDA(At, 0, 0); PG8_STAGE(PG8_SA(1, 1), a1 + hstep, voffA);
            PG8_WAIT_L(8); PG8_BAR; PG8_WAIT_L(0); PG8_MMA(0, 0, At, B0); PG8_BAR; PG8_SCHED;
            PG8_LDB(B1, 0, 1); PG8_STAGE(PG8_SB(0, 0), b2, voffB);
            PG8_BAR; PG8_WAIT_L(0); PG8_MMA(0, 1, At, B1); PG8_BAR;
            PG8_LDA(At, 0, 1); PG8_STAGE(PG8_SA(0, 0), a2, voffA);
            PG8_BAR; PG8_WAIT_L(0); PG8_MMA(1, 0, At, B0); PG8_BAR; PG8_SCHED;
            PG8_STAGE(PG8_SB(0, 1), b2 + hstep, voffB);
            PG8_WAIT_V(6); PG8_BAR; PG8_MMA(1, 1, At, B1); PG8_BAR;
            PG8_LDB(B0, 1, 0); PG8_SCHED; PG8_LDA(At, 1, 0); PG8_STAGE(PG8_SA(0, 1), a2 + hstep, voffA);
            PG8_WAIT_L(8); PG8_BAR; PG8_WAIT_L(0); PG8_MMA(0, 0, At, B0); PG8_BAR; PG8_SCHED;
            PG8_LDB(B1, 1, 1); PG8_STAGE(PG8_SB(1, 0), b3, voffB);
            PG8_BAR; PG8_WAIT_L(0); PG8_MMA(0, 1, At, B1); PG8_BAR;
            PG8_LDA(At, 1, 1); PG8_STAGE(PG8_SA(1, 0), a3, voffA);
            PG8_BAR; PG8_WAIT_L(0); PG8_MMA(1, 0, At, B0); PG8_BAR; PG8_SCHED;
            PG8_STAGE(PG8_SB(1, 1), b3 + hstep, voffB);
            PG8_WAIT_V(6); PG8_BAR; PG8_MMA(1, 1, At, B1); PG8_BAR;
            }
        }
        if constexpr (ALIGN_EPI) { if (wr == 0) PG8_BAR; }
        if constexpr (!Epi::AFTER_DRAIN) { E(acc, cur, wr, wc, fr, fq); S.done(cur); }
        if (!has_next) break;
#pragma unroll
        for (int a = 0; a < 2; ++a)
#pragma unroll
            for (int b = 0; b < 2; ++b)
#pragma unroll
                for (int m = 0; m < 4; ++m)
#pragma unroll
                    for (int n = 0; n < 2; ++n) acc[a][b][m][n] = (f32x4){0.f, 0.f, 0.f, 0.f};
        cur = nxt; cA = nA; cB = nB; ++ui;
        if constexpr (ALIGN_EPI) { if (wr == 1) PG8_BAR; }
    }
    PG8_WAIT_V(0);
    if constexpr (!ALIGN_EPI) { if (wr == 0) PG8_BAR; }
    PG8_BAR;
    if constexpr (Epi::AFTER_DRAIN) { E.fused(acc, cur, wr, wc, fr, fq, lds, wid, lane); S.done(cur); }
#undef PG8_SA
#undef PG8_SB
#undef PG8_STAGE
#undef PG8_LDA
#undef PG8_LDB
#undef PG8_MMA
#undef PG8_WAIT_V
#undef PG8_WAIT_L
#undef PG8_BAR
#undef PG8_SCHED
}
}
#define XB_TMO      128
#define XB_XCNT(j)  (256  + 64 * (j))
#define XB_XSUB(j)  (1280 + 64 * (j))
#define XB_XGEN(j)  (2304 + 64 * (j))
#define XB_TOP      3328
#define XB_TOPGEN   3392
#define XCD_BAR_WORDS 3456
#define XB_SPIN_CAP (1u << 18)
#define LAS __attribute__((address_space(3)))

__device__ __forceinline__ unsigned xb_ld(unsigned* p)              { return __hip_atomic_load(p, __ATOMIC_RELAXED, __HIP_MEMORY_SCOPE_AGENT); }
__device__ __forceinline__ unsigned xb_add(unsigned* p, unsigned v) { return __hip_atomic_fetch_add(p, v, __ATOMIC_RELAXED, __HIP_MEMORY_SCOPE_AGENT); }
__device__ __forceinline__ unsigned xb_xcc_id() { return (unsigned)__builtin_amdgcn_s_getreg((3 << 11) | 20) & 0xFu; }
#define XB_SPIN(cond, bar) do { unsigned _sp = 0; while (cond) { __builtin_amdgcn_s_sleep(1); \
    if ((++_sp & 255u) == 0u) { if (xb_ld(&(bar)[XB_TMO])) break; if (_sp > XB_SPIN_CAP) { atomicAdd(&(bar)[XB_TMO], 1u); break; } } } } while (0)

struct XcdBarrier {
    unsigned* bar; unsigned x;
    volatile LAS unsigned* st;
};

__device__ __forceinline__ XcdBarrier xcd_barrier_post(unsigned* bar, volatile LAS unsigned* st) {
    XcdBarrier b; b.bar = bar; b.x = xb_xcc_id(); b.st = st;
    if (threadIdx.x == 0) (void)xb_add(&bar[XB_XCNT(b.x)], 1u);
    return b;
}
__device__ __forceinline__ void xcd_barrier_complete(unsigned* bar, unsigned x, unsigned& nloc, unsigned& nx) {
    const unsigned G = gridDim.x * gridDim.y * gridDim.z;
    unsigned sum, cnt, mine, sp = 0u;
    for (;;) {
        sum = 0u; cnt = 0u; mine = 0u;
#pragma unroll
        for (unsigned j = 0; j < 16; ++j) { const unsigned c = xb_ld(&bar[XB_XCNT(j)]); sum += c; cnt += (c > 0u) ? 1u : 0u; mine = (j == x) ? c : mine; }
        if (sum == G) break;
        __builtin_amdgcn_s_sleep(1);
        if ((++sp & 255u) == 0u) { if (xb_ld(&bar[XB_TMO])) break; if (sp > XB_SPIN_CAP) { atomicAdd(&bar[XB_TMO], 1u); break; } }
    }
    nloc = mine > 0u ? mine : 1u; nx = cnt > 0u ? cnt : 1u;
}

__device__ __forceinline__ void xcd_barrier(const XcdBarrier& b) {
    asm volatile("s_waitcnt vmcnt(0)" ::: "memory");
    __syncthreads();
    if (threadIdx.x == 0) {
        unsigned* bar = b.bar;
        __builtin_amdgcn_s_waitcnt(0);
        const unsigned bx = xb_xcc_id();
        unsigned nloc = b.st[0], nx = b.st[1];
        if (nloc == 0u) { xcd_barrier_complete(bar, bx, nloc, nx); b.st[0] = nloc; b.st[1] = nx; }
        const unsigned old = xb_add(&bar[XB_XSUB(bx)], 1u);
        const unsigned gen = old / nloc;
        if (old + 1u == (gen + 1u) * nloc) {
            __builtin_amdgcn_fence(__ATOMIC_RELEASE, "agent");
            asm volatile("s_waitcnt vmcnt(0)" ::: "memory");
            const unsigned og = xb_add(&bar[XB_TOP], 1u);
            const unsigned tg = og / nx;
            if (og + 1u == (tg + 1u) * nx) xb_add(&bar[XB_TOPGEN], 1u);
            else XB_SPIN(xb_ld(&bar[XB_TOPGEN]) == tg, bar);
            __builtin_amdgcn_fence(__ATOMIC_ACQUIRE, "agent");
            xb_add(&bar[XB_XGEN(bx)], 1u);
            asm volatile("s_waitcnt vmcnt(0)" ::: "memory");
        } else {
            XB_SPIN(xb_ld(&bar[XB_XGEN(bx)]) == gen, bar);
            __builtin_amdgcn_fence(__ATOMIC_ACQUIRE, "agent");
            asm volatile("s_waitcnt vmcnt(0)" ::: "memory");
        }
    }
    __syncthreads();
}

struct Params {
    const float* x; const float* p; const int* pos;
    const float *w_in, *w_a, *w_b, *w_out, *lbraw, *hnorm_g, *ikn_g, *ikn_b, *lnm_g, *lnm_b, *w_fg, *w_fu, *w_fd, *lnf_g, *lnf_b, *w_pg, *w_pp, *lnp_g, *lnp_b;
    float* out; unsigned char* ws;
    double invf_h[64]; double invf_i[32];
    int ph_lo, ph_hi;
};
typedef const __attribute__((address_space(4))) Params* KP;
__device__ __forceinline__ KP kparams() { KP p = (KP)__builtin_amdgcn_kernarg_segment_ptr(); asm volatile("" : "+s"(p)); return p; }
constexpr int NPH_LAYER = 14, NPH = DEPTH * NPH_LAYER;
constexpr int LDS_BYTES = 131072 + 1024;
constexpr int MISC_OFF = 131072;

__device__ __forceinline__ int wsrc_col_in(int n) {
    const int tile = n >> 8, t = n & 255;
    if (tile < 16) return n;
    if (tile < 24) { const int bj = t >> 7, u = t & 127, head = u >> 6, i = u & 63; return tile * 256 + 128 * head + 64 * bj + i; }
    if (tile < 28) return n;
    if (tile < 32) { const int bj = t >> 7, u = t & 127, head = u >> 5, i = u & 31; return tile * 256 + 64 * head + 32 * bj + i; }
    if (tile < 40) return 8272 + (n - 32 * 256);
    if (tile < 48) return 10320 + (n - 40 * 256);
    return t < 80 ? 8192 + t : -1;
}
template <int KIND>
__device__ __forceinline__ void wconv_wave_tile(const float* src, const float* src2, int nsrc, int K, bf16_t* dst, int n0, int k0, int lane) {
    const int n = n0 + lane; int c; const float* s = src;
    if (KIND == 0) c = n;
    else if (KIND == 1) c = wsrc_col_in(n);
    else { const int tl = n >> 8, t = n & 255; c = tl * 128 + (t & 127); if (t >= 128) s = src2; }
    float f[64];
    const float* sp = s + (size_t)k0 * nsrc + (c >= 0 ? c : 0);
#pragma unroll
    for (int kk = 0; kk < 64; ++kk) f[kk] = sp[(size_t)kk * nsrc];
    bf16_t* d = dst + (size_t)n * K + k0;
#pragma unroll
    for (int i = 0; i < 8; ++i) { pg8::u32x4 w;
        w.x = pg8::cvt_pk_bf16(f[8 * i], f[8 * i + 1]); w.y = pg8::cvt_pk_bf16(f[8 * i + 2], f[8 * i + 3]); w.z = pg8::cvt_pk_bf16(f[8 * i + 4], f[8 * i + 5]); w.w = pg8::cvt_pk_bf16(f[8 * i + 6], f[8 * i + 7]);
        if (c < 0) w = (pg8::u32x4){0u, 0u, 0u, 0u};
        *(pg8::u32x4*)(d + 8 * i) = w; }
}
template <int KIND>
__device__ __forceinline__ void wconv_job(const float* src, const float* src2, int nsrc, int K, bf16_t* dst, int ndst, int W, int NWV, int lane, int& tcount) {
    const int kt = K / 64, ntiles = (ndst / 64) * kt;
    const int nb = ndst / 64; int first = (W - tcount % NWV + NWV) % NWV;
    for (int t = first; t < ntiles; t += NWV) wconv_wave_tile<KIND>(src, src2, nsrc, K, dst, (t % nb) * 64, (t / nb) * 64, lane);
    tcount += ntiles;
}
__device__ __forceinline__ void phase_wconv(KP P, int layer) {
    unsigned char* ws = as_global(P->ws); int tc = 0;
    const int tid0 = tid_(), lane = tid0 & 63, W = bid_() * 8 + __builtin_amdgcn_readfirstlane(tid0 >> 6), NWV = nblk_() * 8;
    wconv_job<1>(as_global(P->w_in) + (size_t)layer * DM * INW, nullptr, INW, DM, (bf16_t*)(ws + WS_WIN), INP, W, NWV, lane, tc);
    wconv_job<0>(as_global(P->w_a) + (size_t)layer * AW * DM, nullptr, DM, AW, (bf16_t*)(ws + WS_WA), DM, W, NWV, lane, tc);
    wconv_job<0>(as_global(P->w_b) + (size_t)layer * BW * DM, nullptr, DM, BW, (bf16_t*)(ws + WS_WB), DM, W, NWV, lane, tc);
    wconv_job<0>(as_global(P->w_out) + (size_t)layer * DM * DM, nullptr, DM, DM, (bf16_t*)(ws + WS_WO), DM, W, NWV, lane, tc);
    wconv_job<2>(as_global(P->w_fg) + (size_t)layer * DM * DFF, as_global(P->w_fu) + (size_t)layer * DM * DFF, DFF, DM, (bf16_t*)(ws + WS_WGU), 2 * DFF, W, NWV, lane, tc);
    wconv_job<0>(as_global(P->w_fd) + (size_t)layer * DFF * DM, nullptr, DM, DFF, (bf16_t*)(ws + WS_WDN), DM, W, NWV, lane, tc);
    wconv_job<0>(as_global(P->w_pg) + (size_t)layer * DM * DM, nullptr, DM, DM, (bf16_t*)(ws + WS_WPG), DM, W, NWV, lane, tc);
    wconv_job<0>(as_global(P->w_pp) + (size_t)layer * PLE * DM, nullptr, DM, PLE, (bf16_t*)(ws + WS_WPP), DM, W, NWV, lane, tc);
    const float* ps = as_global(P->p) + (size_t)layer * TOK * PLE; bf16_t* pb = (bf16_t*)(ws + WS_PB);
    for (size_t i = ((size_t)bid_() * 512 + tid_()) * 8; i < (size_t)TOK * PLE; i += (size_t)nblk_() * 512 * 8)
        *(pg8::u32x4*)(pb + i) = pg8::pack8(*(const pg8::f32x4*)(ps + i), *(const pg8::f32x4*)(ps + i + 4));
}
__device__ __forceinline__ void phase_prologue(KP P) {
    unsigned char* ws = as_global(P->ws); const size_t gtid = (size_t)bid_() * 512 + tid_(), gsz = (size_t)nblk_() * 512;
    bf16_t* xb = (bf16_t*)(ws + WS_XB); const float* xin = as_global(P->x); const int* posg = as_global(P->pos); const float* lbr = as_global(P->lbraw);
    for (size_t i = gtid * 8; i < (size_t)TOK * DM; i += gsz * 8) *(pg8::u32x4*)(xb + i) = pg8::pack8(*(const pg8::f32x4*)(xin + i), *(const pg8::f32x4*)(xin + i + 4));
    float* ch = (float*)(ws + WS_COSH); float* sh = (float*)(ws + WS_SINH); float* ci = (float*)(ws + WS_COSI); float* si = (float*)(ws + WS_SINI);
    for (size_t i = gtid; i < (size_t)TOK * 64; i += gsz) { const int t = (int)(i >> 6), j = (int)(i & 63); const double rev = (double)posg[t] * P->invf_h[j]; const float fr = (float)(rev - rint(rev));
        ch[i] = __builtin_amdgcn_cosf(fr); sh[i] = __builtin_amdgcn_sinf(fr); }
    for (size_t i = gtid; i < (size_t)TOK * 32; i += gsz) { const int t = (int)(i >> 5), j = (int)(i & 31); const double rev = (double)posg[t] * P->invf_i[j]; const float fr = (float)(rev - rint(rev));
        ci[i] = __builtin_amdgcn_cosf(fr); si[i] = __builtin_amdgcn_sinf(fr); }
    float* lb = (float*)(ws + WS_LB);
    for (size_t c = gtid; c < 1024; c += gsz) { float v[4], mx = -1e30f; for (int l = 0; l < 4; ++l) { v[l] = lbr[l * 1024 + c]; mx = fmaxf(mx, v[l]); }
        float s = 0.f; for (int l = 0; l < 4; ++l) { v[l] = expf(v[l] - mx); s += v[l]; }
        float cum = 0.f; const float inv = 1.0f / s; for (int l = 0; l < 4; ++l) { cum += v[l] * inv; lb[l * 1024 + c] = cum - v[0] * inv; } }
}
__device__ __forceinline__ void phase_ln(const float* XP, float* OUT, bf16_t* XB, float* ST, const float* g, const float* b) {
    const int tid = tid_(), wave = __builtin_amdgcn_readfirstlane(tid >> 6), lane = tid & 63, nb8 = nblk_() * 8;
    for (int row = bid_() * 8 + wave; row < TOK; row += nb8) {
        const float* xp = XP + (size_t)row * DM; pg8::f32x4 v[8]; float s = 0.f;
#pragma unroll
        for (int c = 0; c < 8; ++c) { v[c] = *(const pg8::f32x4*)(xp + c * 256 + lane * 4); s += (v[c][0] + v[c][1]) + (v[c][2] + v[c][3]); }
#pragma unroll
        for (int o = 32; o >= 1; o >>= 1) s += __shfl_xor(s, o);
        const float mean = s * (1.0f / DM); float q = 0.f;
#pragma unroll
        for (int c = 0; c < 8; ++c) { v[c] = v[c] - mean; q += (v[c][0] * v[c][0] + v[c][1] * v[c][1]) + (v[c][2] * v[c][2] + v[c][3] * v[c][3]); }
#pragma unroll
        for (int o = 32; o >= 1; o >>= 1) q += __shfl_xor(q, o);
        const float rstd = 1.0f / sqrtf(q * (1.0f / DM) + LN_EPS);
        if (lane == 0) { pg8::f32x2 s2; s2[0] = mean; s2[1] = rstd; *(pg8::f32x2*)(ST + 2 * (size_t)row) = s2; }
#pragma unroll
        for (int c = 0; c < 8; ++c) { const int col = c * 256 + lane * 4; const pg8::f32x4 gg = *(const pg8::f32x4*)(g + col), bb = *(const pg8::f32x4*)(b + col);
            const pg8::f32x4 y = v[c] * rstd * gg + bb; if (OUT) *(pg8::f32x4*)(OUT + (size_t)row * DM + col) = y;
            pg8::u32x2 w; w.x = pg8::cvt_pk_bf16(y[0], y[1]); w.y = pg8::cvt_pk_bf16(y[2], y[3]); *(pg8::u32x2*)(XB + (size_t)row * DM + col) = w; }
    }
}
__device__ __forceinline__ void phase_ikprep(KP P, int layer) {
    unsigned char* ws = as_global(P->ws); const float* ikw = (const float*)(ws + WS_IKW); bf16_t* ki = (bf16_t*)(ws + WS_KI); float* wi = (float*)(ws + WS_WI);
    const float* ci = (const float*)(ws + WS_COSI); const float* si = (const float*)(ws + WS_SINI);
    const int tid = tid_(), wave = __builtin_amdgcn_readfirstlane(tid >> 6), lane = tid & 63, nb8 = nblk_() * 8;
    const float g = as_global(P->ikn_g)[layer * 64 + lane], b = as_global(P->ikn_b)[layer * 64 + lane];
    for (int t = bid_() * 8 + wave; t < TOK; t += nb8) {
        const float x = ikw[(size_t)t * 128 + lane]; float s = x;
#pragma unroll
        for (int o = 32; o >= 1; o >>= 1) s += __shfl_xor(s, o);
        const float mean = s * (1.0f / 64.0f), xc = x - mean; float q = xc * xc;
#pragma unroll
        for (int o = 32; o >= 1; o >>= 1) q += __shfl_xor(q, o);
        const float y = xc * (1.0f / sqrtf(q * (1.0f / 64.0f) + LN_EPS)) * g + b;
        const float other = __shfl_xor(y, 32); const int j = lane & 31; const float c = ci[(size_t)t * 32 + j], sn = si[(size_t)t * 32 + j];
        const float r = (lane < 32) ? (y * c - other * sn) : (other * sn + y * c);
        ki[(size_t)t * 64 + lane] = f2bf(r);
        if (lane < 16) wi[(size_t)t * 16 + lane] = ikw[(size_t)t * 128 + 64 + lane] * IDX_SCALE;
    }
}
typedef short bf16x8_t __attribute__((ext_vector_type(8)));
typedef short bf16x4_t __attribute__((ext_vector_type(4)));
typedef float f32x16_t __attribute__((ext_vector_type(16)));
constexpr int CUM_LD = 132;
constexpr int OPK_LD = 136;
constexpr int OPS_LD = 72;

__device__ __forceinline__ void hgrn_scan_cum(const float* LF, int tok0, int h, LAS float* cum, LAS float* tot, int tid) {
    const int k = tid & 127, qd = tid >> 7; float v[16];
#pragma unroll
    for (int i = 0; i < 16; ++i) v[i] = LF[(size_t)(tok0 + qd * 16 + i) * 1024 + h * 128 + k];
    float run = 0.f;
#pragma unroll
    for (int i = 0; i < 16; ++i) { run += v[i]; v[i] = run; }
    tot[qd * 128 + k] = run;
    __syncthreads();
    float off = 0.f;
#pragma unroll
    for (int q = 0; q < 3; ++q) off += (q < qd) ? tot[q * 128 + k] : 0.f;
#pragma unroll
    for (int i = 0; i < 16; ++i) cum[(qd * 16 + i) * CUM_LD + k] = v[i] + off;
    __syncthreads();
}

__device__ __forceinline__ void phase_hgrn_h1(KP P, LAS unsigned char* lds) {
    unsigned char* ws = as_global(P->ws);
    const bf16_t* KA = (const bf16_t*)(ws + WS_KA); const bf16_t* VA = (const bf16_t*)(ws + WS_VA); const float* LF = (const float*)(ws + WS_LF);
    float* LT = (float*)(ws + WS_LT); float* DEC = (float*)(ws + WS_DEC);
    const int tid = tid_(), lane = tid & 63, wave = __builtin_amdgcn_readfirstlane(tid >> 6), r = lane & 31, hh = lane >> 5, G = nblk_();
    LAS float* cum = (LAS float*)lds; LAS float* tot = cum + 64 * CUM_LD;
    LAS bf16_t* kdT = (LAS bf16_t*)(tot + 512); LAS bf16_t* vT = kdT + 128 * OPS_LD;
    for (int unit = bid_(); unit < NBATCH * AH * 64; unit += G) {
        const int c = unit & 63, h = (unit >> 6) & 7, b = unit >> 9, tok0 = b * SEQ + c * 64;
        hgrn_scan_cum(LF, tok0, h, cum, tot, tid);
#pragma unroll
        for (int it = 0; it < 8; ++it) { const int idx = tid + 512 * it, k = idx & 127, sp = idx >> 7, s = 2 * sp;
            const float last = cum[63 * CUM_LD + k];
            const size_t g0 = (size_t)(tok0 + s) * 1024 + h * 128 + k;
            const float k0 = bf2f(KA[g0]) * __expf(last - cum[s * CUM_LD + k]), k1 = bf2f(KA[g0 + 1024]) * __expf(last - cum[(s + 1) * CUM_LD + k]);
            *(LAS unsigned*)(kdT + k * OPS_LD + s) = pg8::cvt_pk_bf16(k0, k1);
            *(LAS unsigned*)(vT + k * OPS_LD + s) = (unsigned)VA[g0] | ((unsigned)VA[g0 + 1024] << 16); }
        if (tid < 128) DEC[(size_t)unit * 128 + tid] = __expf(cum[63 * CUM_LD + tid]);
        __syncthreads();
        const int mb = wave >> 1, nb0 = (wave & 1) * 2;
        f32x16_t acc[2];
#pragma unroll
        for (int n = 0; n < 2; ++n)
#pragma unroll
            for (int i = 0; i < 16; ++i) acc[n][i] = 0.f;
#pragma unroll
        for (int ks = 0; ks < 4; ++ks) { const bf16x8_t a = *(const LAS bf16x8_t*)(kdT + (32 * mb + r) * OPS_LD + 16 * ks + 8 * hh);
#pragma unroll
            for (int n = 0; n < 2; ++n) { const bf16x8_t bb = *(const LAS bf16x8_t*)(vT + (32 * (nb0 + n) + r) * OPS_LD + 16 * ks + 8 * hh);
                acc[n] = __builtin_amdgcn_mfma_f32_32x32x16_bf16(a, bb, acc[n], 0, 0, 0); } }
#pragma unroll
        for (int n = 0; n < 2; ++n) { float* dst = LT + (size_t)unit * 16384 + (size_t)(32 * (nb0 + n) + r) * 128 + 32 * mb + 4 * hh;
#pragma unroll
            for (int g = 0; g < 4; ++g) { pg8::f32x4 o; o[0] = acc[n][4 * g]; o[1] = acc[n][4 * g + 1]; o[2] = acc[n][4 * g + 2]; o[3] = acc[n][4 * g + 3]; *(pg8::f32x4*)(dst + 8 * g) = o; } }
        __syncthreads();
    }
}

__device__ __forceinline__ void phase_hgrn_h2(KP P) {
    unsigned char* ws = as_global(P->ws);
    const float* LT = (const float*)(ws + WS_LT); const float* DEC = (const float*)(ws + WS_DEC); bf16_t* PT = (bf16_t*)(ws + WS_PT);
    const int tid = tid_(), G = nblk_();
    for (int quad = bid_() * 512 + tid; quad < NBATCH * AH * 4096; quad += G * 512) {
        const int bh = quad >> 12, rem = quad & 4095, v = rem >> 5, k0 = (rem & 31) * 4;
        const size_t e0 = (size_t)bh * 64 * 16384 + (size_t)v * 128 + k0; const size_t d0 = (size_t)bh * 64 * 128 + k0;
        pg8::f32x4 S = {0.f, 0.f, 0.f, 0.f};
        for (int c0 = 0; c0 < 64; c0 += 8) { pg8::f32x4 Lc[8], Dc[8];
#pragma unroll
            for (int j = 0; j < 8; ++j) { Lc[j] = *(const pg8::f32x4*)(LT + e0 + (size_t)(c0 + j) * 16384); Dc[j] = *(const pg8::f32x4*)(DEC + d0 + (size_t)(c0 + j) * 128); }
#pragma unroll
            for (int j = 0; j < 8; ++j) { pg8::u32x2 w; w.x = pg8::cvt_pk_bf16(S[0], S[1]); w.y = pg8::cvt_pk_bf16(S[2], S[3]);
                *(pg8::u32x2*)(PT + e0 + (size_t)(c0 + j) * 16384) = w; S = Dc[j] * S + Lc[j]; } }
    }
}

__device__ __forceinline__ void phase_hgrn_h3(KP P, int layer, LAS unsigned char* lds) {
    unsigned char* ws = as_global(P->ws);
    const bf16_t* QA = (const bf16_t*)(ws + WS_QA); const bf16_t* KA = (const bf16_t*)(ws + WS_KA); const bf16_t* VA = (const bf16_t*)(ws + WS_VA); const bf16_t* GA = (const bf16_t*)(ws + WS_GA);
    const float* LF = (const float*)(ws + WS_LF); const bf16_t* PT = (const bf16_t*)(ws + WS_PT); bf16_t* YA = (bf16_t*)(ws + WS_YA);
    const float* ng = as_global(P->hnorm_g) + layer * 128;
    const int tid = tid_(), lane = tid & 63, wave = __builtin_amdgcn_readfirstlane(tid >> 6), r = lane & 31, hh = lane >> 5, G = nblk_();
    LAS float* cum = (LAS float*)lds; LAS float* tot = cum + 64 * CUM_LD; LAS float* ssq = tot + 512;
    LAS bf16_t* qd = (LAS bf16_t*)(ssq + 256); LAS bf16_t* qs = qd + 64 * OPK_LD; LAS bf16_t* ks = qs + 64 * OPK_LD; LAS bf16_t* vT = ks + 64 * OPK_LD;
    for (int unit = bid_(); unit < NBATCH * AH * 64; unit += G) {
        const int c = unit & 63, h = (unit >> 6) & 7, b = unit >> 9, tok0 = b * SEQ + c * 64;
        hgrn_scan_cum(LF, tok0, h, cum, tot, tid);
#pragma unroll
        for (int it = 0; it < 8; ++it) { const int idx = tid + 512 * it, kp = (idx & 63) * 2, t = idx >> 6;
            const size_t g0 = (size_t)(tok0 + t) * 1024 + h * 128 + kp;
            const unsigned qw = *(const unsigned*)(QA + g0), kw = *(const unsigned*)(KA + g0);
            const float c0 = cum[t * CUM_LD + kp], c1 = cum[t * CUM_LD + kp + 1], r0 = cum[31 * CUM_LD + kp], r1 = cum[31 * CUM_LD + kp + 1];
            const float q0 = __uint_as_float(qw << 16), q1 = __uint_as_float(qw & 0xffff0000u), k0 = __uint_as_float(kw << 16), k1 = __uint_as_float(kw & 0xffff0000u);
            *(LAS unsigned*)(qd + t * OPK_LD + kp) = pg8::cvt_pk_bf16(q0 * __expf(c0), q1 * __expf(c1));
            *(LAS unsigned*)(qs + t * OPK_LD + kp) = pg8::cvt_pk_bf16(q0 * __expf(c0 - r0), q1 * __expf(c1 - r1));
            *(LAS unsigned*)(ks + t * OPK_LD + kp) = pg8::cvt_pk_bf16(k0 * __expf(r0 - c0), k1 * __expf(r1 - c1)); }
#pragma unroll
        for (int it = 0; it < 8; ++it) { const int idx = tid + 512 * it, v = idx & 127, sp = idx >> 7, s = 2 * sp;
            const size_t g0 = (size_t)(tok0 + s) * 1024 + h * 128 + v;
            *(LAS unsigned*)(vT + v * OPS_LD + s) = (unsigned)VA[g0] | ((unsigned)VA[g0 + 1024] << 16); }
        __syncthreads();
        const int mb = wave >> 1, tb = wave & 1;
        f32x16_t acc;
#pragma unroll
        for (int i = 0; i < 16; ++i) acc[i] = 0.f;
        { const bf16_t* prow = PT + (size_t)unit * 16384 + (size_t)(32 * mb + r) * 128 + 8 * hh;
#pragma unroll
          for (int k8 = 0; k8 < 8; ++k8) { const bf16x8_t a = *(const bf16x8_t*)(prow + 16 * k8); const bf16x8_t bq = *(const LAS bf16x8_t*)(qd + (32 * tb + r) * OPK_LD + 16 * k8 + 8 * hh);
              acc = __builtin_amdgcn_mfma_f32_32x32x16_bf16(a, bq, acc, 0, 0, 0); } }
#pragma unroll
        for (int sb = 0; sb < 2; ++sb) if (sb <= tb) {
            f32x16_t sc;
#pragma unroll
            for (int i = 0; i < 16; ++i) sc[i] = 0.f;
#pragma unroll
            for (int k8 = 0; k8 < 8; ++k8) { const bf16x8_t a = *(const LAS bf16x8_t*)(ks + (32 * sb + r) * OPK_LD + 16 * k8 + 8 * hh); const bf16x8_t bq = *(const LAS bf16x8_t*)(qs + (32 * tb + r) * OPK_LD + 16 * k8 + 8 * hh);
                sc = __builtin_amdgcn_mfma_f32_32x32x16_bf16(a, bq, sc, 0, 0, 0); }
            if (sb == tb) {
#pragma unroll
                for (int i = 0; i < 16; ++i) { const int sl = 8 * (i >> 2) + 4 * hh + (i & 3); sc[i] = (sl <= r) ? sc[i] : 0.f; } }
#pragma unroll
            for (int u = 0; u < 2; ++u) {
                pg8::u32x4 pw; pw.x = pg8::cvt_pk_bf16(sc[8 * u], sc[8 * u + 1]); pw.y = pg8::cvt_pk_bf16(sc[8 * u + 2], sc[8 * u + 3]); pw.z = pg8::cvt_pk_bf16(sc[8 * u + 4], sc[8 * u + 5]); pw.w = pg8::cvt_pk_bf16(sc[8 * u + 6], sc[8 * u + 7]);
                const bf16x8_t pb = __builtin_bit_cast(bf16x8_t, pw);
                const LAS bf16_t* vrow = vT + (32 * mb + r) * OPS_LD + 32 * sb + 16 * u + 4 * hh;
                const bf16x4_t lo = *(const LAS bf16x4_t*)vrow, hi4 = *(const LAS bf16x4_t*)(vrow + 8);
                const bf16x8_t va = {lo[0], lo[1], lo[2], lo[3], hi4[0], hi4[1], hi4[2], hi4[3]};
                acc = __builtin_amdgcn_mfma_f32_32x32x16_bf16(va, pb, acc, 0, 0, 0); }
        }
        float ss = 0.f;
#pragma unroll
        for (int i = 0; i < 16; ++i) ss += acc[i] * acc[i];
        ss += __shfl_xor(ss, 32);
        if (hh == 0) ssq[mb * 64 + 32 * tb + r] = ss;
        __syncthreads();
        const int t = 32 * tb + r;
        const float tot2 = (ssq[t] + ssq[64 + t]) + (ssq[128 + t] + ssq[192 + t]);
        const float rs = 1.0f / sqrtf(tot2 * (1.0f / 128.0f) + RMS_EPS);
        const size_t orow = (size_t)(tok0 + t) * 1024 + h * 128;
#pragma unroll
        for (int g = 0; g < 4; ++g) { const int v0 = 32 * mb + 8 * g + 4 * hh;
            const pg8::u32x2 gw = *(const pg8::u32x2*)(GA + orow + v0); const pg8::f32x4 nv = *(const pg8::f32x4*)(ng + v0);
            const float y0 = acc[4 * g] * rs * nv[0] * __uint_as_float(gw.x << 16), y1 = acc[4 * g + 1] * rs * nv[1] * __uint_as_float(gw.x & 0xffff0000u);
            const float y2 = acc[4 * g + 2] * rs * nv[2] * __uint_as_float(gw.y << 16), y3 = acc[4 * g + 3] * rs * nv[3] * __uint_as_float(gw.y & 0xffff0000u);
            pg8::u32x2 w; w.x = pg8::cvt_pk_bf16(y0, y1); w.y = pg8::cvt_pk_bf16(y2, y3); *(pg8::u32x2*)(YA + orow + v0) = w; }
        __syncthreads();
    }
}
namespace at {
constexpr int D = 128, NW = 8, QBLK = 32, KVBLK = 64, LDQ = 1024, LDK = 1024;
constexpr float SCALE = ATTN_SCALE, THR = 8.f;
constexpr size_t SHM_V = KVBLK * D * 2, SHM_K = KVBLK * D * 2, SHM_ATTN = 2 * SHM_V + 2 * SHM_K + NW * 64 * 4;
using bf16x8 = __attribute__((ext_vector_type(8))) short;
using s16x4  = __attribute__((ext_vector_type(4))) short;
using f32x16 = __attribute__((ext_vector_type(16))) float;
using u32x4  = __attribute__((ext_vector_type(4))) unsigned;
#define AT_KSWZ(row, colB) ((row) * 256 + ((colB) ^ (((row) & 7) << 4)))
#define AT_SBAR() __builtin_amdgcn_sched_barrier(0)
__device__ __forceinline__ int crow(int r, int hi) { return (r & 3) + 8 * (r >> 2) + 4 * hi; }
__device__ __forceinline__ unsigned cvtpk(float lo, float hi) { return pg8::cvt_pk_bf16(lo, hi); }

__device__ __forceinline__ void partialSM(f32x16& p0, f32x16& p1, float& m_reg, float& mn, float& alpha) {
  constexpr float C = SCALE * 1.4426950408889634f;
  float pmax = p0[0];
#pragma unroll
  for (int r = 1; r < 16; ++r) pmax = fmaxf(pmax, p0[r]);
#pragma unroll
  for (int r = 0; r < 16; ++r) pmax = fmaxf(pmax, p1[r]);
  { auto rr = __builtin_amdgcn_permlane32_swap(__float_as_uint(pmax), __float_as_uint(pmax), false, false);
    pmax = fmaxf(__uint_as_float(rr[0]), __uint_as_float(rr[1])); }
  if (__builtin_expect(__all(pmax - m_reg <= THR / SCALE), 1)) { mn = m_reg; alpha = 1.f; }
  else { mn = fmaxf(m_reg, pmax); alpha = __builtin_amdgcn_exp2f((m_reg - mn) * C); m_reg = mn; }
  float mnC = -mn * C;
#pragma unroll
  for (int r = 0; r < 16; ++r) p0[r] = fmaf(p0[r], C, mnC);
#pragma unroll
  for (int r = 0; r < 16; ++r) p1[r] = fmaf(p1[r], C, mnC);
#pragma unroll
  for (int r = 0; r < 16; ++r) p0[r] = __builtin_amdgcn_exp2f(p0[r]);
}
__device__ __forceinline__ void finishSM(f32x16& p0, f32x16& p1, float alpha, float& l_reg, int mlo, int mhi, bf16x8& pa0, bf16x8& pa1, bf16x8& pa2, bf16x8& pa3) {
#pragma unroll
  for (int r = 0; r < 16; ++r) p1[r] = __builtin_amdgcn_exp2f(p1[r]);
#pragma unroll
  for (int r = 0; r < 16; ++r) { const int bit = (r & 3) + 8 * (r >> 2);
    p0[r] = __uint_as_float(__float_as_uint(p0[r]) & (unsigned)__builtin_amdgcn_sbfe(mlo, bit, 1));
    p1[r] = __uint_as_float(__float_as_uint(p1[r]) & (unsigned)__builtin_amdgcn_sbfe(mhi, bit, 1)); }
  float ps = 0;
#pragma unroll
  for (int r = 0; r < 16; ++r) ps += p0[r];
#pragma unroll
  for (int r = 0; r < 16; ++r) ps += p1[r];
  { auto rr = __builtin_amdgcn_permlane32_swap(__float_as_uint(ps), __float_as_uint(ps), false, false);
    ps = __uint_as_float(rr[0]) + __uint_as_float(rr[1]); }
  l_reg = l_reg * alpha + ps;
#define AT_PK4(P, BASE, OUT) do { unsigned a0 = cvtpk(P[BASE + 0], P[BASE + 1]), a1 = cvtpk(P[BASE + 2], P[BASE + 3]);   \
    unsigned b0 = cvtpk(P[BASE + 4], P[BASE + 5]), b1 = cvtpk(P[BASE + 6], P[BASE + 7]);                              \
    auto r0 = __builtin_amdgcn_permlane32_swap(a0, b0, false, false); auto r1 = __builtin_amdgcn_permlane32_swap(a1, b1, false, false); \
    u32x4 w = {r0[0], r1[0], r0[1], r1[1]}; OUT = *reinterpret_cast<bf16x8*>(&w); } while (0)
  AT_PK4(p0, 0, pa0); AT_PK4(p0, 8, pa1); AT_PK4(p1, 0, pa2); AT_PK4(p1, 8, pa3);
#undef AT_PK4
}
__device__ __forceinline__ void qkt(f32x16& p0, f32x16& p1, const LAS char* Ks, const bf16x8* qr, int r32, int hi) {
  p0 = f32x16{}; p1 = f32x16{};
#pragma unroll
  for (int d0 = 0; d0 < 8; ++d0) { int cb = (d0 * 16 + hi * 8) * 2;
    bf16x8 b0 = *reinterpret_cast<const LAS bf16x8*>(Ks + AT_KSWZ(r32, cb));
    bf16x8 b1 = *reinterpret_cast<const LAS bf16x8*>(Ks + AT_KSWZ(32 + r32, cb));
    p0 = __builtin_amdgcn_mfma_f32_32x32x16_bf16(b0, qr[d0], p0, 0, 0, 0);
    p1 = __builtin_amdgcn_mfma_f32_32x32x16_bf16(b1, qr[d0], p1, 0, 0, 0); }
}
__device__ __forceinline__ int v_st(int k, int c) { const int kk = (k & ~0xC) | ((k & 4) << 1) | ((k & 8) >> 1); return ((kk >> 3) * 4 + (c >> 5)) * 512 + ((kk & 7) * 32 + (c & 31)) * 2; }
__device__ __forceinline__ int v_rd_base(int lane) { return ((lane & 3) << 3) | (((lane >> 2) & 3) << 6) | (((lane >> 4) & 1) << 5) | (((lane >> 5) & 1) << 8); }
constexpr int v_rd_off(int d0, int ks, int half) { return d0 * 512 + ks * 4096 + half * 2048; }
template <int OFF> __device__ __forceinline__ s16x4 tr_read(int vb) {
  s16x4 r; asm volatile("ds_read_b64_tr_b16 %0, %1 offset:%2" : "=&v"(r) : "v"(vb), "i"(OFF) : "memory"); return r;
}
template <int D0> __device__ __forceinline__ void pv_one(f32x16& od, int vb, bf16x8 pa0, bf16x8 pa1, bf16x8 pa2, bf16x8 pa3) {
  const s16x4 l0 = tr_read<v_rd_off(D0, 0, 0)>(vb), h0 = tr_read<v_rd_off(D0, 0, 1)>(vb), l1 = tr_read<v_rd_off(D0, 1, 0)>(vb), h1 = tr_read<v_rd_off(D0, 1, 1)>(vb);
  const s16x4 l2 = tr_read<v_rd_off(D0, 2, 0)>(vb), h2 = tr_read<v_rd_off(D0, 2, 1)>(vb), l3 = tr_read<v_rd_off(D0, 3, 0)>(vb), h3 = tr_read<v_rd_off(D0, 3, 1)>(vb);
  asm volatile("s_waitcnt lgkmcnt(0)" ::: "memory"); AT_SBAR();
#define AT_PK(L_, H_) (bf16x8){L_[0], L_[1], L_[2], L_[3], H_[0], H_[1], H_[2], H_[3]}
  od = __builtin_amdgcn_mfma_f32_32x32x16_bf16(pa0, AT_PK(l0, h0), od, 0, 0, 0);
  od = __builtin_amdgcn_mfma_f32_32x32x16_bf16(pa1, AT_PK(l1, h1), od, 0, 0, 0);
  od = __builtin_amdgcn_mfma_f32_32x32x16_bf16(pa2, AT_PK(l2, h2), od, 0, 0, 0);
  od = __builtin_amdgcn_mfma_f32_32x32x16_bf16(pa3, AT_PK(l3, h3), od, 0, 0, 0);
#undef AT_PK
}
__device__ __forceinline__ void pv_d0(f32x16* o, int vb, bf16x8 pa0, bf16x8 pa1, bf16x8 pa2, bf16x8 pa3) {
  pv_one<0>(o[0], vb, pa0, pa1, pa2, pa3); pv_one<1>(o[1], vb, pa0, pa1, pa2, pa3); pv_one<2>(o[2], vb, pa0, pa1, pa2, pa3); pv_one<3>(o[3], vb, pa0, pa1, pa2, pa3);
}

__device__ __forceinline__ void attn_masked_body(const bf16_t* __restrict__ Qb, const bf16_t* __restrict__ Kh, const bf16_t* __restrict__ Vh, const unsigned long long* __restrict__ Mq,
                                                 bf16_t* __restrict__ Ob, int seq, LAS char* lds, int tid) {
  const int wid = __builtin_amdgcn_readfirstlane(tid >> 6), lane = tid & 63, r32 = lane & 31, hi = lane >> 5;
  LAS char* V_lds = lds; LAS char* K_lds = lds + 2 * SHM_V;
  LAS float* wsf = (LAS float*)(lds + 2 * SHM_V + 2 * SHM_K) + wid * 64; LAS float* li_l = wsf; LAS float* al_l = wsf + 32;
  float m_reg = -1e30f, l_reg = 0; f32x16 o[4] = {}; bf16x8 qr[8];
  const bf16_t* Qw = Qb + (long)(wid * QBLK + r32) * LDQ + hi * 8;
#pragma unroll
  for (int d0 = 0; d0 < 8; ++d0) qr[d0] = *reinterpret_cast<const bf16x8*>(Qw + d0 * 16);
  const unsigned long long* mrow = Mq + (size_t)(wid * QBLK + r32) * 64;
  const int sr = tid >> 4, sc = (tid & 15) * 8, vst0 = v_st(sr, sc), vst1 = v_st(32 + sr, sc);
  const int vb0 = (int)(uintptr_t)V_lds + v_rd_base(lane);
  struct { bf16x8 vs0, vs1, ks0, ks1; } sr_[2];
#define AT_SLOAD(i, k0) do { sr_[i].vs0 = *reinterpret_cast<const bf16x8*>(&Vh[(long)((k0) + sr) * LDK + sc]); sr_[i].vs1 = *reinterpret_cast<const bf16x8*>(&Vh[(long)((k0) + 32 + sr) * LDK + sc]); \
    sr_[i].ks0 = *reinterpret_cast<const bf16x8*>(&Kh[(long)((k0) + sr) * LDK + sc]); sr_[i].ks1 = *reinterpret_cast<const bf16x8*>(&Kh[(long)((k0) + 32 + sr) * LDK + sc]); } while (0)
#define AT_SWRITE(b, i) do { *(LAS bf16x8*)(V_lds + (b) * SHM_V + vst0) = sr_[i].vs0;          \
    *(LAS bf16x8*)(V_lds + (b) * SHM_V + vst1) = sr_[i].vs1; int kc = sc * 2;               \
    *(LAS bf16x8*)(K_lds + (b) * SHM_K + AT_KSWZ(sr, kc)) = sr_[i].ks0;                       \
    *(LAS bf16x8*)(K_lds + (b) * SHM_K + AT_KSWZ(32 + sr, kc)) = sr_[i].ks1; } while (0)
#define AT_SWAIT() asm volatile("s_waitcnt vmcnt(4)" ::: "memory")
#define AT_RESC(a) do { if (__any((a) < 1.f)) { if (hi == 0) al_l[r32] = (a); asm volatile("s_waitcnt lgkmcnt(0)" ::: "memory"); \
    _Pragma("unroll") for (int d = 0; d < 4; ++d) _Pragma("unroll") for (int r = 0; r < 16; ++r) o[d][r] *= al_l[crow(r, hi)]; } } while (0)
#define AT_MLOAD(mw, j) do { const unsigned long long _w = mrow[(j)]; (mw##lo) = (int)((unsigned)_w >> (4 * hi)); (mw##hi) = (int)((unsigned)(_w >> 32) >> (4 * hi)); } while (0)
  f32x16 pA0, pA1, pB0, pB1; float mnA, mnB, alA, alB; bf16x8 pa0, pa1, pa2, pa3; const int NT = seq / KVBLK;
  int mAlo, mAhi, mBlo, mBhi;
  constexpr int SE = 0, SO = 1;
  AT_SLOAD(SE, 0); AT_MLOAD(mA, 0); asm volatile("s_waitcnt vmcnt(0)" ::: "memory"); AT_SWRITE(0, SE); __syncthreads();
  qkt(pA0, pA1, K_lds, qr, r32, hi); partialSM(pA0, pA1, m_reg, mnA, alA);
  AT_SLOAD(SO, KVBLK); if (2 < NT) AT_SLOAD(SE, 2 * KVBLK);
  AT_SWAIT(); AT_SWRITE(1, SO); __syncthreads();
  for (int j = 1; j + 1 < NT; j += 2) {
    AT_SBAR(); AT_MLOAD(mB, j); qkt(pB0, pB1, K_lds + SHM_K, qr, r32, hi);
    finishSM(pA0, pA1, alA, l_reg, mAlo, mAhi, pa0, pa1, pa2, pa3); AT_SBAR();
    AT_SLOAD(SO, (j + 2) * KVBLK); AT_SBAR();
    pv_d0(o, vb0, pa0, pa1, pa2, pa3); partialSM(pB0, pB1, m_reg, mnB, alB);
    __syncthreads(); AT_SWAIT(); AT_SWRITE(0, SE);
    AT_RESC(alB); __syncthreads();
    AT_SBAR(); AT_MLOAD(mA, j + 1); qkt(pA0, pA1, K_lds, qr, r32, hi);
    finishSM(pB0, pB1, alB, l_reg, mBlo, mBhi, pa0, pa1, pa2, pa3); AT_SBAR();
    if (j + 3 < NT) AT_SLOAD(SE, (j + 3) * KVBLK); AT_SBAR();
    pv_d0(o, vb0 + (int)SHM_V, pa0, pa1, pa2, pa3); partialSM(pA0, pA1, m_reg, mnA, alA);
    __syncthreads(); AT_SWAIT(); AT_SWRITE(1, SO);
    AT_RESC(alA); __syncthreads();
  }
  AT_SBAR(); AT_MLOAD(mB, NT - 1); qkt(pB0, pB1, K_lds + SHM_K, qr, r32, hi);
  finishSM(pA0, pA1, alA, l_reg, mAlo, mAhi, pa0, pa1, pa2, pa3); AT_SBAR();
  pv_d0(o, vb0, pa0, pa1, pa2, pa3); partialSM(pB0, pB1, m_reg, mnB, alB);
  __syncthreads(); AT_RESC(alB);
  finishSM(pB0, pB1, alB, l_reg, mBlo, mBhi, pa0, pa1, pa2, pa3); AT_SBAR();
  pv_d0(o, vb0 + (int)SHM_V, pa0, pa1, pa2, pa3);
  if (hi == 0) li_l[r32] = l_reg; asm volatile("s_waitcnt lgkmcnt(0)" ::: "memory");
  float rli[16];
#pragma unroll
  for (int r = 0; r < 16; ++r) rli[r] = __builtin_amdgcn_rcpf(li_l[crow(r, hi)]);
  bf16_t* Ow = Ob + (long)(wid * QBLK) * LDQ;
#pragma unroll
  for (int r = 0; r < 16; ++r) { const int orow = crow(r, hi);
#pragma unroll
    for (int d0 = 0; d0 < 4; ++d0) Ow[(long)orow * LDQ + d0 * 32 + r32] = f2bf(o[d0][r] * rli[r]); }
#undef AT_SLOAD
#undef AT_SWRITE
#undef AT_SWAIT
#undef AT_RESC
#undef AT_MLOAD
}
}

__device__ __forceinline__ void phase_attn(KP P, LAS unsigned char* lds) {
    unsigned char* ws = as_global(P->ws);
    const bf16_t* QB = (const bf16_t*)(ws + WS_QB); const bf16_t* KB = (const bf16_t*)(ws + WS_KB); const bf16_t* VB = (const bf16_t*)(ws + WS_VB);
    const unsigned long long* MASK = (const unsigned long long*)(ws + WS_MASK); bf16_t* YB = (bf16_t*)(ws + WS_YB);
    const int G = nblk_();
    for (int p = bid_(); p < 256; p += G) {
        const int bh = p >> 3, b = bh >> 3, h = bh & 7, x = p & 7;
#pragma unroll 1
        for (int half = 0; half < 2; ++half) { const int qb = half ? 15 - x : x; const size_t row0 = (size_t)b * SEQ + (size_t)qb * 256;
            at::attn_masked_body(QB + row0 * 1024 + h * 128, KB + (size_t)b * SEQ * 1024 + h * 128, VB + (size_t)b * SEQ * 1024 + h * 128, MASK + row0 * 64,
                                 YB + row0 * 1024 + h * 128, 256 * (qb + 1), (LAS char*)lds, tid_());
            __syncthreads(); }
    }
}
__device__ __forceinline__ void idx_unit(const bf16_t* QI, const bf16_t* KI, const float* WI, float* Sc, int b, int c, int half, int tid) {
    const int lane = tid & 63, wave = __builtin_amdgcn_readfirstlane(tid >> 6), r = lane & 31, hh = lane >> 5, nk = 64 * (c + 1);
    const int s0 = c * 64 + half * 32 + wave * 4;
    const int aq = (r >> 2) & 1, ahead = (r & 3) + 4 * (r >> 3);
    bf16x8_t A[2][4]; float wv[2][16];
#pragma unroll
    for (int rt = 0; rt < 2; ++rt) { const size_t qrow = (size_t)b * SEQ + s0 + 2 * rt + aq;
#pragma unroll
        for (int ks = 0; ks < 4; ++ks) A[rt][ks] = *(const bf16x8_t*)(QI + qrow * 1024 + ahead * 64 + 16 * ks + 8 * hh);
        const float* wp = WI + ((size_t)b * SEQ + s0 + 2 * rt + hh) * 16;
#pragma unroll
        for (int i4 = 0; i4 < 4; ++i4) { const pg8::f32x4 w4 = *(const pg8::f32x4*)(wp + 4 * i4); wv[rt][4 * i4] = w4[0]; wv[rt][4 * i4 + 1] = w4[1]; wv[rt][4 * i4 + 2] = w4[2]; wv[rt][4 * i4 + 3] = w4[3]; } }
    float* srow[2];
#pragma unroll
    for (int rt = 0; rt < 2; ++rt) srow[rt] = Sc + (size_t)b * SCORE_B + (size_t)2048 * c * (c + 1) + (size_t)((s0 + 2 * rt + hh) & 63) * nk + r;
    const bf16_t* kp = KI + ((size_t)b * SEQ + r) * 64 + 8 * hh;
    bf16x8_t Bn[4];
#pragma unroll
    for (int ks = 0; ks < 4; ++ks) Bn[ks] = *(const bf16x8_t*)(kp + 16 * ks);
    const int ntile = nk / 32;
    for (int kt = 0; kt < ntile; ++kt) {
        bf16x8_t Bc[4];
#pragma unroll
        for (int ks = 0; ks < 4; ++ks) Bc[ks] = Bn[ks];
        if (kt + 1 < ntile) {
#pragma unroll
            for (int ks = 0; ks < 4; ++ks) Bn[ks] = *(const bf16x8_t*)(kp + (size_t)(kt + 1) * 32 * 64 + 16 * ks); }
#pragma unroll
        for (int rt = 0; rt < 2; ++rt) { f32x16_t acc;
#pragma unroll
            for (int i = 0; i < 16; ++i) acc[i] = 0.f;
#pragma unroll
            for (int ks = 0; ks < 4; ++ks) acc = __builtin_amdgcn_mfma_f32_32x32x16_bf16(A[rt][ks], Bc[ks], acc, 0, 0, 0);
            float sc = 0.f;
#pragma unroll
            for (int i = 0; i < 16; ++i) sc = fmaf(wv[rt][i], fmaxf(acc[i], 0.f), sc);
            srow[rt][kt * 32] = sc; }
    }
}
__device__ __forceinline__ void phase_idx(KP P) {
    unsigned char* ws = as_global(P->ws);
    const bf16_t* QI = (const bf16_t*)(ws + WS_QI); const bf16_t* KI = (const bf16_t*)(ws + WS_KI); const float* WI = (const float*)(ws + WS_WI); float* Sc = (float*)(ws + WS_S);
    const int G = nblk_();
    for (int item = bid_(); item < 240; item += G) {
        const int pi = item % 30, combo = item / 30, b = combo >> 1, half = combo & 1;
        idx_unit(QI, KI, WI, Sc, b, 4 + pi, half, tid_());
        idx_unit(QI, KI, WI, Sc, b, 63 - pi, half, tid_());
    }
}
__device__ __forceinline__ const float* sel_row(const float* S, int q, int& nw) {
    const int b = q >> 12, s = q & 4095, c = s >> 6; nw = c + 1;
    return S + (size_t)b * SCORE_B + (size_t)2048 * c * (c + 1) + (size_t)(s & 63) * (nw * 64);
}
__device__ __forceinline__ void sel_load(const float* row, int nw, int lane, float (&f)[64]) {
    if (nw > 32) {
#pragma unroll
        for (int j = 0; j < 64; ++j) { const int jc = j < nw ? j : nw - 1; f[j] = row[jc * 64 + lane]; }
    } else {
#pragma unroll
        for (int j = 0; j < 32; ++j) { const int jc = j < nw ? j : nw - 1; f[j] = row[jc * 64 + lane]; }
#pragma unroll
        for (int j = 32; j < 64; ++j) f[j] = 0.f;
    }
}
__device__ __forceinline__ void phase_select(KP P, LAS unsigned char* lds) {
    unsigned char* ws = as_global(P->ws); const float* S = (const float*)(ws + WS_S); unsigned long long* MASK = (unsigned long long*)(ws + WS_MASK);
    const int tid = tid_(), wave = __builtin_amdgcn_readfirstlane(tid >> 6), lane = tid & 63, nb8 = nblk_() * 8;
    LAS unsigned long long* sm = (LAS unsigned long long*)lds + wave * 64;
    float f[64]; int it = (bid_() * 8 + wave) * 8, nw = 0; const float* row = nullptr;
    const int itstep = nb8 * 8 - 7;
#define SEL_Q(it_) ((((it_) >> 3) & 3) * 4096 + ((it_) >> 5) + 512 * ((it_) & 7))
    int q = it < TOK ? SEL_Q(it) : TOK;
    if (q < TOK) { row = sel_row(S, q, nw); if (nw > TOPK / 64) sel_load(row, nw, lane, f); }
    while (q < TOK) {
        unsigned long long myword = 0ull;
        const int itn = ((it & 7) == 7) ? it + itstep : it + 1; const int qn = itn < TOK ? SEL_Q(itn) : TOK; int nwn = 0; const float* rown = nullptr;
        if (nw <= TOPK / 64) {
            myword = (lane < nw) ? ~0ull : 0ull;
            if (qn < TOK) { rown = sel_row(S, qn, nwn); if (nwn > TOPK / 64) sel_load(rown, nwn, lane, f); }
        } else {
            unsigned u[64];
#pragma unroll
            for (int j = 0; j < 64; ++j) { const unsigned bits = __float_as_uint(f[j]); const unsigned v = (bits & 0x80000000u) ? ~bits : (bits | 0x80000000u); u[j] = (j < nw) ? v : 0u; }
            if (qn < TOK) { rown = sel_row(S, qn, nwn); if (nwn > TOPK / 64) sel_load(rown, nwn, lane, f); }
            unsigned prefix = 0u;
            for (int bit = 31; bit >= 0; --bit) { const unsigned cand = prefix | (1u << bit); int cnt = 0;
#pragma unroll
                for (int j8 = 0; j8 < 8; ++j8) if (j8 * 8 < nw) { unsigned long long bl[8];
#pragma unroll
                    for (int jj = 0; jj < 8; ++jj) bl[jj] = __ballot(u[j8 * 8 + jj] >= cand);
                    asm volatile("" : "+s"(bl[0]), "+s"(bl[1]), "+s"(bl[2]), "+s"(bl[3]), "+s"(bl[4]), "+s"(bl[5]), "+s"(bl[6]), "+s"(bl[7]));
#pragma unroll
                    for (int jj = 0; jj < 8; ++jj) cnt += __popcll(bl[jj]); }
                if (cnt >= TOPK) prefix = cand; }
#pragma unroll
            for (int j = 0; j < 64; ++j) { const unsigned long long w = __ballot(u[j] >= prefix); if (lane == 0) sm[j] = w; }
            myword = sm[lane];
        }
        MASK[(size_t)q * 64 + lane] = myword;
        q = qn; it = itn; nw = nwn; row = rown;
    }
#undef SEL_Q
}

__device__ __forceinline__ void phase_hgrn_naive(KP P, int layer, LAS unsigned char* lds) {
    unsigned char* ws = as_global(P->ws);
    const bf16_t* QA = (const bf16_t*)(ws + WS_QA); const bf16_t* KA = (const bf16_t*)(ws + WS_KA); const bf16_t* VA = (const bf16_t*)(ws + WS_VA); const bf16_t* GA = (const bf16_t*)(ws + WS_GA);
    const float* LF = (const float*)(ws + WS_LF); bf16_t* YA = (bf16_t*)(ws + WS_YA);
    const int tid = tid_(), bh = bid_(), b = bh >> 3, h = bh & 7, v = tid & 127; const bool act = (bh < 32) && (tid < 128);
    if (bh >= 32) return;
    LAS float* sf = (LAS float*)lds; LAS float* sk = sf + 16 * 128; LAS float* sq = sk + 16 * 128; LAS float* red = sq + 16 * 128;
    float S[128];
#pragma unroll
    for (int k = 0; k < 128; ++k) S[k] = 0.f;
    const float ng = as_global(P->hnorm_g)[layer * 128 + v];
    for (int t0 = 0; t0 < SEQ; t0 += 16) {
        if (act) for (int i = 0; i < 16; ++i) { const size_t idx = ((size_t)(b * SEQ + t0 + i)) * 1024 + h * 128 + v; sf[i * 128 + v] = expf(LF[idx]); sk[i * 128 + v] = bf2f(KA[idx]); sq[i * 128 + v] = bf2f(QA[idx]); }
        __syncthreads();
        for (int i = 0; i < 16; ++i) { const size_t idx = ((size_t)(b * SEQ + t0 + i)) * 1024 + h * 128 + v; float o = 0.f;
            if (act) { const float vt = bf2f(VA[idx]);
#pragma unroll
                for (int k = 0; k < 128; ++k) { S[k] = sf[i * 128 + k] * S[k] + sk[i * 128 + k] * vt; o += S[k] * sq[i * 128 + k]; } }
            float ss = o * o;
#pragma unroll
            for (int m = 32; m >= 1; m >>= 1) ss += __shfl_xor(ss, m);
            if (act && (v & 63) == 0) red[v >> 6] = ss;
            __syncthreads();
            if (act) { const float tot = red[0] + red[1]; YA[idx] = f2bf(o * (1.0f / sqrtf(tot * (1.0f / 128.0f) + RMS_EPS)) * ng * bf2f(GA[idx])); }
            __syncthreads(); }
    }
}
__device__ __forceinline__ void phase_idx_naive(KP P, LAS unsigned char* lds) {
    unsigned char* ws = as_global(P->ws);
    const bf16_t* QI = (const bf16_t*)(ws + WS_QI); const bf16_t* KI = (const bf16_t*)(ws + WS_KI); const float* WI = (const float*)(ws + WS_WI); float* Sc = (float*)(ws + WS_S);
    const int tid = tid_(), G = nblk_();
    LAS float* qs = (LAS float*)lds; LAS float* wsh = qs + 1024;
    for (int q = bid_(); q < TOK; q += G) {
        const int b = q >> 12, s = q & 4095, c = s >> 6, nw = c + 1, nk = nw * 64;
        if (nw <= TOPK / 64) continue;
        __syncthreads();
        for (int i = tid; i < 1024; i += 512) qs[i] = bf2f(QI[(size_t)q * 1024 + i]);
        if (tid < 16) wsh[tid] = WI[(size_t)q * 16 + tid];
        __syncthreads();
        float* row = Sc + (size_t)b * SCORE_B + (size_t)2048 * c * (c + 1) + (size_t)(s & 63) * nk;
        for (int key = tid; key < nk; key += 512) {
            float kf[64]; const pg8::u32x4* kp = (const pg8::u32x4*)(KI + ((size_t)b * SEQ + key) * 64);
#pragma unroll
            for (int d8 = 0; d8 < 8; ++d8) { const pg8::u32x4 w = kp[d8]; pg8::f32x4 a, bb; pg8::unpack8(w, a, bb);
#pragma unroll
                for (int j = 0; j < 4; ++j) { kf[d8 * 8 + j] = a[j]; kf[d8 * 8 + 4 + j] = bb[j]; } }
            float sc = 0.f;
            for (int h = 0; h < 16; ++h) { float dot = 0.f;
#pragma unroll
                for (int d = 0; d < 64; ++d) dot += qs[h * 64 + d] * kf[d];
                sc += wsh[h] * fmaxf(dot, 0.f); }
            row[key] = sc;
        }
    }
}
__device__ __forceinline__ void phase_attn_naive(KP P, LAS unsigned char* lds) {
    unsigned char* ws = as_global(P->ws);
    const bf16_t* QB = (const bf16_t*)(ws + WS_QB); const bf16_t* KB = (const bf16_t*)(ws + WS_KB); const bf16_t* VB = (const bf16_t*)(ws + WS_VB);
    const unsigned long long* MASK = (const unsigned long long*)(ws + WS_MASK); bf16_t* YB = (bf16_t*)(ws + WS_YB);
    const int tid = tid_(), h = tid >> 6, lane = tid & 63, G = nblk_();
    LAS float* qs = (LAS float*)lds + h * 128; LAS int* keys = (LAS int*)((LAS float*)lds + 1024) + h * 320; LAS float* lg = (LAS float*)lds + 1024 + 8 * 320 + h * 320;
    for (int q = bid_(); q < TOK; q += G) {
        const int b = q >> 12, s = q & 4095, nw = (s >> 6) + 1;
        qs[lane] = bf2f(QB[(size_t)q * 1024 + h * 128 + lane]); qs[lane + 64] = bf2f(QB[(size_t)q * 1024 + h * 128 + 64 + lane]);
        int cnt = 0;
        for (int j = 0; j < nw; ++j) { const unsigned long long w = MASK[(size_t)q * 64 + j]; const bool on = (w >> lane) & 1ull; const int key = j * 64 + lane;
            if (on) { const pg8::u32x4* kp = (const pg8::u32x4*)(KB + ((size_t)b * SEQ + key) * 1024 + h * 128); float dot = 0.f;
                for (int d8 = 0; d8 < 16; ++d8) { pg8::f32x4 a, bb; pg8::unpack8(kp[d8], a, bb);
#pragma unroll
                    for (int j2 = 0; j2 < 4; ++j2) dot += qs[d8 * 8 + j2] * a[j2] + qs[d8 * 8 + 4 + j2] * bb[j2]; }
                const int pos = cnt + __popcll(w & ((1ull << lane) - 1ull));
                if (pos < 320) { keys[pos] = key; lg[pos] = dot * ATTN_SCALE; } }
            cnt += __popcll(w); }
        if (cnt > 320) cnt = 320;
        float mx = -1e30f; for (int e = lane; e < cnt; e += 64) mx = fmaxf(mx, lg[e]);
#pragma unroll
        for (int m = 32; m >= 1; m >>= 1) mx = fmaxf(mx, __shfl_xor(mx, m));
        float sum = 0.f; for (int e = lane; e < cnt; e += 64) { const float pe = expf(lg[e] - mx); lg[e] = pe; sum += pe; }
#pragma unroll
        for (int m = 32; m >= 1; m >>= 1) sum += __shfl_xor(sum, m);
        float a0 = 0.f, a1 = 0.f;
        for (int e = 0; e < cnt; ++e) { const float pe = lg[e]; const bf16_t* vp = VB + ((size_t)b * SEQ + keys[e]) * 1024 + h * 128 + 2 * lane; a0 += pe * bf2f(vp[0]); a1 += pe * bf2f(vp[1]); }
        const float inv = 1.0f / sum;
        *(unsigned*)(YB + (size_t)q * 1024 + h * 128 + 2 * lane) = pg8::cvt_pk_bf16(a0 * inv, a1 * inv);
    }
}

__global__ __launch_bounds__(128) void k_hgrn_naive(const bf16_t* QA, const bf16_t* KA, const bf16_t* VA, const bf16_t* GA, const float* LF, const float* norm_g, bf16_t* YA) {
    const int bh = blockIdx.x, b = bh >> 3, h = bh & 7, v = threadIdx.x;
    __shared__ float sf[16][128], sk[16][128], sq[16][128]; __shared__ float red[2];
    float S[128];
#pragma unroll
    for (int k = 0; k < 128; ++k) S[k] = 0.f;
    const float ng = norm_g[v];
    for (int t0 = 0; t0 < SEQ; t0 += 16) {
        for (int i = 0; i < 16; ++i) { const size_t idx = ((size_t)(b * SEQ + t0 + i)) * 1024 + h * 128 + v; sf[i][v] = expf(LF[idx]); sk[i][v] = bf2f(KA[idx]); sq[i][v] = bf2f(QA[idx]); }
        __syncthreads();
        for (int i = 0; i < 16; ++i) { const size_t idx = ((size_t)(b * SEQ + t0 + i)) * 1024 + h * 128 + v; const float vt = bf2f(VA[idx]); float o = 0.f;
#pragma unroll
            for (int k = 0; k < 128; ++k) { S[k] = sf[i][k] * S[k] + sk[i][k] * vt; o += S[k] * sq[i][k]; }
            float ss = o * o;
#pragma unroll
            for (int m = 32; m >= 1; m >>= 1) ss += __shfl_xor(ss, m);
            if ((v & 63) == 0) red[v >> 6] = ss;
            __syncthreads();
            const float tot = red[0] + red[1];
            const float y = o * (1.0f / sqrtf(tot * (1.0f / 128.0f) + RMS_EPS)) * ng * bf2f(GA[idx]);
            YA[idx] = f2bf(y);
            __syncthreads(); }
    }
}
__global__ __launch_bounds__(256) void k_idx_naive(const bf16_t* QI, const bf16_t* KI, const float* WI, float* S) {
    const int q = blockIdx.x, b = q >> 12, s = q & 4095, c = s >> 6, nw = c + 1, nk = nw * 64;
    if (nw <= TOPK / 64) return;
    __shared__ float qs[1024]; __shared__ float wsh[16];
    for (int i = threadIdx.x; i < 1024; i += 256) qs[i] = bf2f(QI[(size_t)q * 1024 + i]);
    if (threadIdx.x < 16) wsh[threadIdx.x] = WI[(size_t)q * 16 + threadIdx.x];
    __syncthreads();
    float* row = S + (size_t)b * SCORE_B + (size_t)2048 * c * (c + 1) + (size_t)(s & 63) * nk;
    for (int key = threadIdx.x; key < nk; key += 256) {
        float kf[64]; const bf16_t* kp = KI + ((size_t)b * SEQ + key) * 64;
#pragma unroll
        for (int d = 0; d < 64; ++d) kf[d] = bf2f(kp[d]);
        float sc = 0.f;
        for (int h = 0; h < 16; ++h) { float dot = 0.f;
#pragma unroll
            for (int d = 0; d < 64; ++d) dot += qs[h * 64 + d] * kf[d];
            sc += wsh[h] * fmaxf(dot, 0.f); }
        row[key] = sc;
    }
}
__global__ __launch_bounds__(512) void k_attn_naive(const bf16_t* QB, const bf16_t* KB, const bf16_t* VB, const unsigned long long* MASK, bf16_t* YB) {
    const int q = blockIdx.x, b = q >> 12, s = q & 4095, nw = (s >> 6) + 1, h = threadIdx.x >> 6, lane = threadIdx.x & 63;
    __shared__ float qs[8][128]; __shared__ int keys[8][320]; __shared__ float lg[8][320];
    qs[h][lane] = bf2f(QB[(size_t)q * 1024 + h * 128 + lane]); qs[h][lane + 64] = bf2f(QB[(size_t)q * 1024 + h * 128 + 64 + lane]);
    __syncthreads();
    int cnt = 0;
    for (int j = 0; j < nw; ++j) { const unsigned long long w = MASK[(size_t)q * 64 + j]; const bool on = (w >> lane) & 1ull; const int key = j * 64 + lane;
        if (on) { const bf16_t* kp = KB + ((size_t)b * SEQ + key) * 1024 + h * 128; float dot = 0.f;
            for (int d = 0; d < 128; ++d) dot += qs[h][d] * bf2f(kp[d]);
            const int pos = cnt + __popcll(w & ((1ull << lane) - 1ull));
            if (pos < 320) { keys[h][pos] = key; lg[h][pos] = dot * ATTN_SCALE; } }
        cnt += __popcll(w); }
    if (cnt > 320) cnt = 320;
    __syncthreads();
    float mx = -1e30f; for (int e = lane; e < cnt; e += 64) mx = fmaxf(mx, lg[h][e]);
#pragma unroll
    for (int m = 32; m >= 1; m >>= 1) mx = fmaxf(mx, __shfl_xor(mx, m));
    float sum = 0.f; for (int e = lane; e < cnt; e += 64) { const float pe = expf(lg[h][e] - mx); lg[h][e] = pe; sum += pe; }
#pragma unroll
    for (int m = 32; m >= 1; m >>= 1) sum += __shfl_xor(sum, m);
    __syncthreads();
    float a0 = 0.f, a1 = 0.f;
    for (int e = 0; e < cnt; ++e) { const float pe = lg[h][e]; const bf16_t* vp = VB + ((size_t)b * SEQ + keys[h][e]) * 1024 + h * 128 + 2 * lane; a0 += pe * bf2f(vp[0]); a1 += pe * bf2f(vp[1]); }
    const float inv = 1.0f / sum;
    YB[(size_t)q * 1024 + h * 128 + 2 * lane] = f2bf(a0 * inv); YB[(size_t)q * 1024 + h * 128 + 2 * lane + 1] = f2bf(a1 * inv);
}

__global__ __launch_bounds__(256) void k_dump(const unsigned char* ws, int which, float* out) {
    for (size_t i = (size_t)blockIdx.x * 256 + threadIdx.x; i < (size_t)TOK * DM; i += (size_t)gridDim.x * 256) {
        const size_t t = i / DM, c = i % DM; float v = 0.f;
        if (which == 0) { v = bf2f(((const bf16_t*)(ws + WS_MG))[i]) + ((const float*)(ws + WS_PP))[i]; }
        else if (which == 1) { const size_t j = t * 1024 + (c & 1023);
            v = bf2f(((const bf16_t*)(ws + WS_QA))[j]) + bf2f(((const bf16_t*)(ws + WS_KA))[j]) + bf2f(((const bf16_t*)(ws + WS_VA))[j]) + bf2f(((const bf16_t*)(ws + WS_GA))[j])
              + bf2f(((const bf16_t*)(ws + WS_QB))[j]) + bf2f(((const bf16_t*)(ws + WS_KB))[j]) + bf2f(((const bf16_t*)(ws + WS_VB))[j]) + bf2f(((const bf16_t*)(ws + WS_QI))[j])
              + ((const float*)(ws + WS_LF))[j] + bf2f(((const bf16_t*)(ws + WS_SGA))[i]) + bf2f(((const bf16_t*)(ws + WS_SGB))[i]) + ((const float*)(ws + WS_IKW))[t * 128 + (c & 127)]; }
        else if (which == 2) { const size_t j = t * 1024 + (c & 1023); v = (c < 1024) ? bf2f(((const bf16_t*)(ws + WS_YA))[j]) : bf2f(((const bf16_t*)(ws + WS_YB))[j]); }
        else if (which == 3) { v = ((const float*)(ws + WS_XPRE))[i]; }
        else if (which == 4) { v = ((const float*)(ws + WS_XPRE))[i]; }
        else if (which == 5) { v = bf2f(((const bf16_t*)(ws + WS_H))[t * DFF + c]) + bf2f(((const bf16_t*)(ws + WS_H))[t * DFF + 2048 + c]) + bf2f(((const bf16_t*)(ws + WS_H))[t * DFF + 3584 + c]); }
        else if (which == 6) { const unsigned long long m = ((const unsigned long long*)(ws + WS_MASK))[t * 64 + (c & 63)]; v = (float)__popcll(m) + (float)(unsigned)(m % 1000003ull) * 1e-3f; }
        else if (which == 7) { v = bf2f(((const bf16_t*)(ws + WS_WIN))[i % ((size_t)INP * DM)]) + bf2f(((const bf16_t*)(ws + WS_WGU))[(i * 7) % ((size_t)2 * DFF * DM)]) + bf2f(((const bf16_t*)(ws + WS_WDN))[(i * 3) % ((size_t)DFF * DM)]); }
        else if (which == 8) { v = bf2f(((const bf16_t*)(ws + WS_XB))[i]) + ((const float*)(ws + WS_COSH))[i % ((size_t)TOK * 64)] + ((const float*)(ws + WS_SINI))[i % ((size_t)TOK * 32)] + ((const float*)(ws + WS_LB))[i % 4096]; }
        else if (which == 9) { v = bf2f(((const bf16_t*)(ws + WS_H))[t * 6272 + c]) + bf2f(((const bf16_t*)(ws + WS_H))[t * 6272 + 2048 + c]) + bf2f(((const bf16_t*)(ws + WS_H))[t * 6272 + 4096 + c]) + bf2f(((const bf16_t*)(ws + WS_H))[t * 6272 + 4224 + c]); }
        else if (which == 10) { const size_t j = t * 1024 + (c & 1023); v = bf2f(((const bf16_t*)(ws + WS_QA))[j]) + bf2f(((const bf16_t*)(ws + WS_VA))[j]) + bf2f(((const bf16_t*)(ws + WS_GA))[j]) + bf2f(((const bf16_t*)(ws + WS_VB))[j]) + bf2f(((const bf16_t*)(ws + WS_SGA))[i]) + bf2f(((const bf16_t*)(ws + WS_SGB))[i]); }
        else if (which == 11) { const size_t j = t * 1024 + (c & 1023); v = bf2f(((const bf16_t*)(ws + WS_QB))[j]) + bf2f(((const bf16_t*)(ws + WS_KB))[j]) + bf2f(((const bf16_t*)(ws + WS_QI))[j]); }
        else if (which == 12) { const size_t j = t * 1024 + (c & 1023); v = ((const float*)(ws + WS_LF))[j] + bf2f(((const bf16_t*)(ws + WS_KA))[j]); }
        else if (which == 14) { v = ((const float*)(ws + WS_IKW))[t * 128 + (c & 127)]; }
        else if (which == 15) { const size_t j = t * 1024 + (c & 1023); v = bf2f(((const bf16_t*)(ws + WS_QA))[j]) + bf2f(((const bf16_t*)(ws + WS_GA))[j]); }
        else if (which == 16) { v = bf2f(((const bf16_t*)(ws + WS_SGA))[i]) + bf2f(((const bf16_t*)(ws + WS_SGB))[i]); }
        else if (which == 17) { const size_t j = t * 1024 + (c & 1023); v = bf2f(((const bf16_t*)(ws + WS_VA))[j]) + bf2f(((const bf16_t*)(ws + WS_VB))[j]); }
        out[i] = v;
    }
}
#ifndef OPT_HGRN
#define OPT_HGRN 1
#endif
#ifndef OPT_IDX
#define OPT_IDX 1
#endif
#ifndef OPT_ATT
#define OPT_ATT 1
#endif
#ifndef PHM
#define PHM 0x3fff
#endif
#ifndef DUP_MASK
#define DUP_MASK 0
#endif
#ifndef ONE_LAUNCH
#define ONE_LAUNCH 1
#endif

__global__ void __launch_bounds__(512, 2) mega(Params P_unused) {
    extern __shared__ __attribute__((aligned(16))) unsigned char lds[];
    LAS unsigned char* L = (LAS unsigned char*)lds;
    volatile LAS unsigned* misc = (volatile LAS unsigned*)(L + MISC_OFF);
    if (threadIdx.x < 4) misc[threadIdx.x] = 0u;
    __syncthreads();
    int lo, hi; unsigned char* ws0; { KP P0 = kparams(); lo = P0->ph_lo; hi = P0->ph_hi; ws0 = as_global(P0->ws); }
    XcdBarrier bar; bar.bar = (unsigned*)(ws0 + WS_CTL); bar.x = 0; bar.st = misc;
    if (hi - lo > 1) bar = xcd_barrier_post((unsigned*)(ws0 + WS_CTL), misc);
#define WSP(T_, off) ((T_*)(ws + (off)))
#define WSL KP P = kparams(); unsigned char* ws = as_global(P->ws); const int G = nblk_(), bid = bid_(); (void)G; (void)bid

    for (int layer = 0; layer < DEPTH; ++layer) {
        const int base = layer * NPH_LAYER;
#define IN(k) (((PHM >> (k)) & 1) && lo <= base + (k) && base + (k) < hi)
#define SEAM(k) do { if (rep + 1 == ((((DUP_MASK >> (k)) & 1) ? 2 : 1)) && base + (k) + 1 < hi) xcd_barrier(bar); } while (0)
        if (IN(0)) for (int rep = 0; rep < (((DUP_MASK >> 0) & 1) ? 2 : 1); ++rep) { WSL; if (layer == 0) phase_prologue(P); phase_wconv(P, layer); SEAM(0); }
        if (IN(1)) for (int rep = 0; rep < (((DUP_MASK >> 1) & 1) ? 2 : 1); ++rep) { WSL;
            pg8::Gemm g{WSP(const bf16_t, WS_XB), WSP(const bf16_t, WS_WIN), TOK, INP, DM}; pg8::StaticOrder S; S.init(TOK, INP, G, bid);
#ifdef RAWTEST
            pg8::EpiRawTest E{ws};
            pg8::gemm_phase<pg8::EpiRawTest, pg8::StaticOrder, true, true>(L, g, S, E); SEAM(1);
#else
            pg8::EpiIn E{ws, layer};
            pg8::gemm_phase<pg8::EpiIn, pg8::StaticOrder, true, true>(L, g, S, E); SEAM(1);
#endif
        }
        if (IN(2)) for (int rep = 0; rep < (((DUP_MASK >> 2) & 1) ? 2 : 1); ++rep) { WSL; phase_ikprep(P, layer);
#if OPT_HGRN
            phase_hgrn_h1(P, L);
#endif
            SEAM(2); }
        if (IN(3)) for (int rep = 0; rep < (((DUP_MASK >> 3) & 1) ? 2 : 1); ++rep) { WSL;
#if !OPT_HGRN
            phase_hgrn_naive(P, layer, L); __syncthreads();
#else
            phase_hgrn_h2(P);
#endif
#if !OPT_IDX
            phase_idx_naive(P, L);
#else
            phase_idx(P);
#endif
            SEAM(3); }
        if (IN(4)) for (int rep = 0; rep < (((DUP_MASK >> 4) & 1) ? 2 : 1); ++rep) { WSL;
#ifdef DUP_SEL
            phase_select(P, L); __syncthreads();
#endif
            phase_select(P, L);
#if OPT_HGRN
            __syncthreads(); phase_hgrn_h3(P, layer, L);
#ifdef DUP_H3
            __syncthreads(); phase_hgrn_h3(P, layer, L);
#endif
#endif
            SEAM(4); }
        if (IN(5)) for (int rep = 0; rep < (((DUP_MASK >> 5) & 1) ? 2 : 1); ++rep) { WSL;
#if !OPT_ATT
            phase_attn_naive(P, L);
#else
            phase_attn(P, L);
#endif
            SEAM(5); }
        if (IN(6)) for (int rep = 0; rep < (((DUP_MASK >> 6) & 1) ? 2 : 1); ++rep) { WSL;
            { pg8::Gemm g{WSP(const bf16_t, WS_YA), WSP(const bf16_t, WS_WA), TOK, DM, AW}; pg8::StaticOrder S; S.init(TOK, DM, G, bid);
              pg8::EpiGateA E{ws}; pg8::gemm_phase<pg8::EpiGateA, pg8::StaticOrder, true, true>(L, g, S, E); }
            { pg8::Gemm g{WSP(const bf16_t, WS_YB), WSP(const bf16_t, WS_WB), TOK, DM, BW}; pg8::StaticOrder S; S.init(TOK, DM, G, bid);
              pg8::EpiGateB E{ws}; pg8::gemm_phase<pg8::EpiGateB, pg8::StaticOrder, true, true>(L, g, S, E); }
            { pg8::Gemm g{WSP(const bf16_t, WS_PB), WSP(const bf16_t, WS_WPP), TOK, DM, PLE}; pg8::StaticOrder S; S.init(TOK, DM, G, bid);
              pg8::EpiF32P E{ws}; pg8::gemm_phase<pg8::EpiF32P, pg8::StaticOrder, true, true>(L, g, S, E); }
            SEAM(6);
        }
        if (IN(7)) for (int rep = 0; rep < (((DUP_MASK >> 7) & 1) ? 2 : 1); ++rep) { WSL;
            pg8::Gemm g{WSP(const bf16_t, WS_MG), WSP(const bf16_t, WS_WO), TOK, DM, DM}; pg8::StaticOrder S; S.init(TOK, DM, G, bid);
            if (layer == 0) { pg8::EpiRes<true> E{as_global(P->x), nullptr, nullptr, ws}; pg8::gemm_phase<pg8::EpiRes<true>, pg8::StaticOrder, true, true>(L, g, S, E); }
            else { pg8::EpiRes<false> E{nullptr, P->lnp_g + (layer - 1) * DM, P->lnp_b + (layer - 1) * DM, ws}; pg8::gemm_phase<pg8::EpiRes<false>, pg8::StaticOrder, true, true>(L, g, S, E); }
            SEAM(7);
        }
        if (IN(8)) for (int rep = 0; rep < (((DUP_MASK >> 8) & 1) ? 2 : 1); ++rep) { WSL; phase_ln(WSP(const float, WS_XPRE), nullptr, WSP(bf16_t, WS_XB), WSP(float, WS_STATS), as_global(P->lnm_g) + layer * DM, as_global(P->lnm_b) + layer * DM); SEAM(8); }
        if (IN(9)) for (int rep = 0; rep < (((DUP_MASK >> 9) & 1) ? 2 : 1); ++rep) { WSL;
            pg8::Gemm g{WSP(const bf16_t, WS_XB), WSP(const bf16_t, WS_WGU), TOK, 2 * DFF, DM}; pg8::StaticOrder S; S.init(TOK, 2 * DFF, G, bid);
            pg8::EpiSwiGLU E{ws}; pg8::gemm_phase<pg8::EpiSwiGLU, pg8::StaticOrder, true, true>(L, g, S, E); SEAM(9);
        }
        if (IN(10)) for (int rep = 0; rep < (((DUP_MASK >> 10) & 1) ? 2 : 1); ++rep) { WSL;
            pg8::Gemm g{WSP(const bf16_t, WS_H), WSP(const bf16_t, WS_WDN), TOK, DM, DFF}; pg8::StaticOrder S; S.init(TOK, DM, G, bid);
            pg8::EpiRes<false> E{nullptr, P->lnm_g + layer * DM, P->lnm_b + layer * DM, ws}; pg8::gemm_phase<pg8::EpiRes<false>, pg8::StaticOrder, true, true>(L, g, S, E); SEAM(10);
        }
        if (IN(11)) for (int rep = 0; rep < (((DUP_MASK >> 11) & 1) ? 2 : 1); ++rep) { WSL; phase_ln(WSP(const float, WS_XPRE), nullptr, WSP(bf16_t, WS_XB), WSP(float, WS_STATS), as_global(P->lnf_g) + layer * DM, as_global(P->lnf_b) + layer * DM); SEAM(11); }
        if (IN(12)) for (int rep = 0; rep < (((DUP_MASK >> 12) & 1) ? 2 : 1); ++rep) { WSL;
            pg8::Gemm g{WSP(const bf16_t, WS_XB), WSP(const bf16_t, WS_WPG), TOK, DM, DM}; pg8::StaticOrder S; S.init(TOK, DM, G, bid);
            pg8::EpiPle E{P->lnf_g + layer * DM, P->lnf_b + layer * DM, ws}; pg8::gemm_phase<pg8::EpiPle, pg8::StaticOrder, true, true>(L, g, S, E); SEAM(12);
        }
        if (IN(13)) for (int rep = 0; rep < (((DUP_MASK >> 13) & 1) ? 2 : 1); ++rep) { WSL; phase_ln(WSP(const float, WS_XPRE), layer == DEPTH - 1 ? as_global(P->out) : nullptr, WSP(bf16_t, WS_XB), WSP(float, WS_STATS), as_global(P->lnp_g) + layer * DM, as_global(P->lnp_b) + layer * DM); SEAM(13); }
#undef IN
#undef SEAM
    }
}

extern "C" void kernel_launch(void* const* d_in, const int* in_sizes, int n_in, void* d_out, int out_size, void* d_ws, size_t ws_size, hipStream_t stream) {
    static int grid = 0;
    if (grid == 0) {
        if (n_in != 22 || out_size != TOK * DM || ws_size < WS_END) { fprintf(stderr, "kernel_launch: unexpected shapes: n_in %d out %d ws %zu (need %zu)\n", n_in, out_size, ws_size, (size_t)WS_END); grid = -1; return; }
        int dev = 0, cus = 0, per_cu = 0;
        if (hipGetDevice(&dev) != hipSuccess || hipDeviceGetAttribute(&cus, hipDeviceAttributeMultiprocessorCount, dev) != hipSuccess) { grid = -1; return; }
        if (hipFuncSetAttribute((const void*)mega, hipFuncAttributeMaxDynamicSharedMemorySize, LDS_BYTES) != hipSuccess) { fprintf(stderr, "kernel_launch: hipFuncSetAttribute failed\n"); grid = -1; return; }
        if (hipOccupancyMaxActiveBlocksPerMultiprocessor(&per_cu, (const void*)mega, 512, LDS_BYTES) != hipSuccess || per_cu < 1) { fprintf(stderr, "kernel_launch: occupancy query says %d\n", per_cu); (void)hipGetLastError(); }
        grid = cus;
    }
    if (grid < 0) return;
    (void)hipMemsetAsync((char*)d_ws + WS_CTL, 0, 65536, stream);
    Params P{};
    P.x = (const float*)d_in[0]; P.p = (const float*)d_in[1]; P.pos = (const int*)d_in[2];
    P.w_in = (const float*)d_in[3]; P.w_a = (const float*)d_in[4]; P.w_b = (const float*)d_in[5]; P.w_out = (const float*)d_in[6];
    P.lbraw = (const float*)d_in[7]; P.hnorm_g = (const float*)d_in[8]; P.ikn_g = (const float*)d_in[9]; P.ikn_b = (const float*)d_in[10];
    P.lnm_g = (const float*)d_in[11]; P.lnm_b = (const float*)d_in[12]; P.w_fg = (const float*)d_in[13]; P.w_fu = (const float*)d_in[14]; P.w_fd = (const float*)d_in[15];
    P.lnf_g = (const float*)d_in[16]; P.lnf_b = (const float*)d_in[17]; P.w_pg = (const float*)d_in[18]; P.w_pp = (const float*)d_in[19];
    P.lnp_g = (const float*)d_in[20]; P.lnp_b = (const float*)d_in[21];
    P.out = (float*)d_out; P.ws = (unsigned char*)d_ws;
    for (int j = 0; j < 64; ++j) P.invf_h[j] = pow(10000.0, -(double)j / 64.0) / 6.283185307179586476925286766559;
    for (int j = 0; j < 32; ++j) P.invf_i[j] = pow(10000.0, -(double)j / 32.0) / 6.283185307179586476925286766559;
#if ONE_LAUNCH
    P.ph_lo = 0; P.ph_hi = NPH;
    hipLaunchKernelGGL(mega, dim3(grid), dim3(512), LDS_BYTES, stream, P);
#elif defined(SEQ_TEST)
    { const int seq[] = SEQ_TEST; for (int i = 0; i < (int)(sizeof(seq) / sizeof(int)); ++i) { P.ph_lo = seq[i]; P.ph_hi = seq[i] + 1; hipLaunchKernelGGL(mega, dim3(grid), dim3(512), LDS_BYTES, stream, P); }
      hipLaunchKernelGGL(k_dump, dim3(4096), dim3(256), 0, stream, (const unsigned char*)d_ws, DUMP_WHICH, (float*)d_out); }
#else
    unsigned char* ws = (unsigned char*)d_ws;
    for (int layer = 0; layer < DEPTH; ++layer)
        for (int k = 0; k < NPH_LAYER; ++k) {
            P.ph_lo = layer * NPH_LAYER + k; P.ph_hi = P.ph_lo + 1;
            bool run_mega = true;
#if !OPT_HGRN
            if (k == 3) hipLaunchKernelGGL(k_hgrn_naive, dim3(32), dim3(128), 0, stream, (const bf16_t*)(ws + WS_QA), (const bf16_t*)(ws + WS_KA), (const bf16_t*)(ws + WS_VA), (const bf16_t*)(ws + WS_GA),
                                           (const float*)(ws + WS_LF), P.hnorm_g + layer * 128, (bf16_t*)(ws + WS_YA));
#endif
#if !OPT_IDX
            if (k == 3) hipLaunchKernelGGL(k_idx_naive, dim3(TOK), dim3(256), 0, stream, (const bf16_t*)(ws + WS_QI), (const bf16_t*)(ws + WS_KI), (const float*)(ws + WS_WI), (float*)(ws + WS_S));
#endif
#if !OPT_ATT
            if (k == 5) hipLaunchKernelGGL(k_attn_naive, dim3(TOK), dim3(512), 0, stream, (const bf16_t*)(ws + WS_QB), (const bf16_t*)(ws + WS_KB), (const bf16_t*)(ws + WS_VB),
                                           (const unsigned long long*)(ws + WS_MASK), (bf16_t*)(ws + WS_YB));
#endif
#if !OPT_HGRN && !OPT_IDX
            if (k == 3) run_mega = false;
#endif
#if !OPT_ATT
            if (k == 5) run_mega = false;
#endif
            if (run_mega) hipLaunchKernelGGL(mega, dim3(grid), dim3(512), LDS_BYTES, stream, P);
#ifdef DUMP_AT
            if (layer * NPH_LAYER + k == DUMP_AT) { hipLaunchKernelGGL(k_dump, dim3(4096), dim3(256), 0, stream, (const unsigned char*)ws, DUMP_WHICH, (float*)d_out); return; }
#endif
        }
#endif
    const hipError_t le = hipPeekAtLastError();
    if (le != hipSuccess) fprintf(stderr, "kernel_launch: launch failed: %s\n", hipGetErrorName(le));
}
```

```cpp
#include <hip/hip_runtime.h>
#include <cstdio>
#include <cstdint>

constexpr int DM = 2048, NBATCH = 4, SEQ = 4096, TOK = NBATCH * SEQ, DEPTH = 4, CHUNK = 64, PLE = 256;
constexpr int AH = 8, AD = 128, AW = 1024, BH = 8, BD = 128, BW = 1024, IH = 16, IDIM = 64, TOPK = 256;
constexpr int DFF = 5632, INW = 12368, INP = 12544;
constexpr float ALPHA = 1.6817928305074290861f;
constexpr float LN_EPS = 1e-5f, RMS_EPS = 1e-6f;
constexpr float ATTN_SCALE = 0.088388347648318440f;
constexpr float IDX_SCALE = 0.03125f;

typedef unsigned short bf16_t;
__device__ __forceinline__ float bf2f(bf16_t b) { return __uint_as_float(((unsigned)b) << 16); }
__device__ __forceinline__ bf16_t f2bf(float f) { unsigned u = __float_as_uint(f); u += 0x7FFFu + ((u >> 16) & 1u); return (bf16_t)(u >> 16); }
__device__ __forceinline__ float sigmoid_f(float x) { return __builtin_amdgcn_rcpf(1.0f + __expf(-x)); }
__device__ __forceinline__ float silu_f(float x) { return x * sigmoid_f(x); }

__device__ __forceinline__ int tid_() { int t = (int)threadIdx.x; asm volatile("" : "+v"(t)); return t; }
__device__ __forceinline__ int bid_() { int b = (int)blockIdx.x; asm volatile("" : "+s"(b)); return b; }
__device__ __forceinline__ int nblk_() { int g = (int)gridDim.x; asm volatile("" : "+s"(g)); return g; }

template <class T> __device__ __forceinline__ T* as_global(T* p) { return (T*)(__attribute__((address_space(1))) T*)p; }

constexpr size_t MiB = 1048576;
constexpr size_t WS_CTL  = 0;
constexpr size_t WS_LB   = WS_CTL + 65536;
constexpr size_t WS_STATS = WS_CTL + 131072;
constexpr size_t WS_COSH = 1 * MiB;
constexpr size_t WS_SINH = WS_COSH + 4 * MiB;
constexpr size_t WS_COSI = WS_SINH + 4 * MiB;
constexpr size_t WS_SINI = WS_COSI + 2 * MiB;
constexpr size_t WS_WIN  = WS_SINI + 2 * MiB;
constexpr size_t WS_WA   = WS_WIN + 49 * MiB;
constexpr size_t WS_WB   = WS_WA + 4 * MiB;
constexpr size_t WS_WO   = WS_WB + 4 * MiB;
constexpr size_t WS_WGU  = WS_WO + 8 * MiB;
constexpr size_t WS_WDN  = WS_WGU + 44 * MiB;
constexpr size_t WS_WPG  = WS_WDN + 22 * MiB;
constexpr size_t WS_WPP  = WS_WPG + 8 * MiB;
constexpr size_t WS_S    = WS_WPP + 1 * MiB;
constexpr size_t WS_XB   = WS_S + 130 * MiB;
constexpr size_t WS_XPRE = WS_XB + 64 * MiB;
constexpr size_t WS_R1   = WS_XPRE + 130 * MiB;
constexpr size_t WS_QA   = WS_R1;
constexpr size_t WS_LF   = WS_QA + 32 * MiB;
constexpr size_t WS_KA   = WS_LF + 64 * MiB;
constexpr size_t WS_VA   = WS_KA + 32 * MiB;
constexpr size_t WS_GA   = WS_VA + 32 * MiB;
constexpr size_t WS_QB   = WS_GA + 32 * MiB;
constexpr size_t WS_KB   = WS_QB + 32 * MiB;
constexpr size_t WS_VB   = WS_KB + 32 * MiB;
constexpr size_t WS_QI   = WS_VB + 32 * MiB;
constexpr size_t WS_SGA  = WS_QI + 32 * MiB;
constexpr size_t WS_SGB  = WS_SGA + 64 * MiB;
constexpr size_t WS_IKW  = WS_SGB + 64 * MiB;
constexpr size_t WS_H    = WS_R1;
constexpr size_t WS_PP   = WS_R1 + 176 * MiB;
constexpr size_t WS_R2   = WS_IKW + 8 * MiB;
constexpr size_t WS_LT   = WS_R2;
constexpr size_t WS_MG   = WS_R2;
constexpr size_t WS_AF   = WS_R2 + 64 * MiB;
constexpr size_t WS_PT   = WS_LT + 128 * MiB;
constexpr size_t WS_DEC  = WS_PT + 64 * MiB;
constexpr size_t WS_MASK = WS_DEC + 1 * MiB;
constexpr size_t WS_YA   = WS_MASK + 8 * MiB;
constexpr size_t WS_YB   = WS_YA + 32 * MiB;
constexpr size_t WS_KI   = WS_YB + 32 * MiB;
constexpr size_t WS_WI   = WS_KI + 2 * MiB;
constexpr size_t WS_PB   = WS_WI + 1 * MiB;
constexpr size_t WS_END  = WS_PB + 8 * MiB;
static_assert(WS_END < 1360000000ull, "workspace budget");
constexpr size_t SCORE_B = (size_t)4096 * 2080;

namespace pg8 {
#define PG8_LAS __attribute__((address_space(3)))
typedef unsigned short bf16_t;
typedef short bf16x8 __attribute__((ext_vector_type(8)));
typedef float f32x4 __attribute__((ext_vector_type(4)));
typedef unsigned u32x4 __attribute__((ext_vector_type(4)));
constexpr int BM = 256, BK = 64, HALF = 128, HTB = HALF * BK * 2  , STAGE_BYTES = 8 * HTB, NXCD = 8, WGM = 8;

__host__ __device__ __forceinline__ int lds_byte(int r, int c) { const int st = (r >> 4) * 2 + (c >> 5), rr = r & 15, cc = c & 31, ob = rr * 64 + cc * 2; return st * 1024 + (ob ^ (((ob >> 9) & 1) << 5)); }
__host__ __device__ __forceinline__ void stage_rc(int b, int& R, int& C) { const int st = b / 1024, sb = b % 1024, swz = sb ^ (((sb >> 9) & 1) << 5); R = (st >> 1) * 16 + swz / 64; C = (st & 1) * 32 + (swz % 64) / 2; }
__host__ __device__ __forceinline__ int perm32(int rho) { const int n = rho >> 4, i = rho & 15; return 8 * (i >> 2) + 4 * n + (i & 3); }

struct Unit { int pm, pn; };
struct Gemm { const bf16_t* A; const bf16_t* Bt; int M, N, K; };

struct StaticOrder {
    int nM, nN, nwg, G, c;
    __host__ __device__ void init(int M, int N, int G_, int c_) { nM = M / BM; nN = N / BM; nwg = nM * nN; G = G_; c = c_; }
    __host__ __device__ bool next(int i, Unit& u) const {
        const long L = (long)i * G + c; if (L >= nwg) return false;
        int wgid = (int)L; { const int q = nwg / NXCD, r = nwg % NXCD, xcd = wgid % NXCD, off = wgid / NXCD; wgid = (xcd < r ? xcd * (q + 1) : r * (q + 1) + (xcd - r) * q) + off; }
        const int nig = WGM * nN, gid = wgid / nig, fm = gid * WGM, gsz = (nM - fm) < WGM ? (nM - fm) : WGM;
        u.pm = fm + ((wgid % nig) % gsz); u.pn = (wgid % nig) / gsz; return true;
    }
    __device__ __forceinline__ void a_ready(const Unit&) const {}
    __device__ __forceinline__ void done(const Unit&) const {}
};

typedef float pk_f32x2 __attribute__((ext_vector_type(2)));
typedef __bf16 pk_bf16x2 __attribute__((ext_vector_type(2)));
__device__ __forceinline__ unsigned cvt_pk_bf16(float lo, float hi) { const pk_f32x2 v = {lo, hi}; const pk_bf16x2 b = __builtin_convertvector(v, pk_bf16x2); return __builtin_bit_cast(unsigned, b); }
typedef unsigned u32x2 __attribute__((ext_vector_type(2)));
typedef float f32x2 __attribute__((ext_vector_type(2)));
__device__ __forceinline__ u32x4 pack8(const f32x4 a, const f32x4 b) { u32x4 w; w.x = cvt_pk_bf16(a[0], a[1]); w.y = cvt_pk_bf16(a[2], a[3]); w.z = cvt_pk_bf16(b[0], b[1]); w.w = cvt_pk_bf16(b[2], b[3]); return w; }
__device__ __forceinline__ void unpack8(const u32x4 w, f32x4& a, f32x4& b) {
    a[0] = __uint_as_float(w.x << 16); a[1] = __uint_as_float(w.x & 0xffff0000u); a[2] = __uint_as_float(w.y << 16); a[3] = __uint_as_float(w.y & 0xffff0000u);
    b[0] = __uint_as_float(w.z << 16); b[1] = __uint_as_float(w.z & 0xffff0000u); b[2] = __uint_as_float(w.w << 16); b[3] = __uint_as_float(w.w & 0xffff0000u); }
__device__ __forceinline__ float sigm(float x) { return __builtin_amdgcn_rcpf(1.0f + __expf(-x)); }
__device__ __forceinline__ f32x4 sigm4(const f32x4 x) { f32x4 r; r[0] = sigm(x[0]); r[1] = sigm(x[1]); r[2] = sigm(x[2]); r[3] = sigm(x[3]); return r; }
__device__ __forceinline__ f32x4 silu4(const f32x4 x) { return x * sigm4(x); }

#define PG8_GAS __attribute__((address_space(1)))
struct EpiIn {
    static constexpr bool PERM = true, AFTER_DRAIN = false;
    unsigned char* ws0; int layer;
    __device__ __forceinline__ void operator()(const f32x4 (&acc)[2][2][4][2], const Unit& u, int wr, int wc, int fr, int fq) const {
        unsigned char* wsq = ws0; asm volatile("" : "+s"(wsq)); PG8_GAS unsigned char* const ws = (PG8_GAS unsigned char*)wsq;
        const int pn = u.pn, row0 = u.pm * BM + wr * 64 + fr, cw = wc * 32 + 8 * fq;
        PG8_GAS bf16_t* const QA = (PG8_GAS bf16_t*)(ws + WS_QA); PG8_GAS bf16_t* const KA = (PG8_GAS bf16_t*)(ws + WS_KA); PG8_GAS bf16_t* const VA = (PG8_GAS bf16_t*)(ws + WS_VA); PG8_GAS bf16_t* const GA = (PG8_GAS bf16_t*)(ws + WS_GA);
        PG8_GAS bf16_t* const QB = (PG8_GAS bf16_t*)(ws + WS_QB); PG8_GAS bf16_t* const KB = (PG8_GAS bf16_t*)(ws + WS_KB); PG8_GAS bf16_t* const VB = (PG8_GAS bf16_t*)(ws + WS_VB); PG8_GAS bf16_t* const QI = (PG8_GAS bf16_t*)(ws + WS_QI);
        PG8_GAS bf16_t* const SGA = (PG8_GAS bf16_t*)(ws + WS_SGA); PG8_GAS bf16_t* const SGB = (PG8_GAS bf16_t*)(ws + WS_SGB); PG8_GAS float* const LF = (PG8_GAS float*)(ws + WS_LF); PG8_GAS float* const IKW = (PG8_GAS float*)(ws + WS_IKW);
        const PG8_GAS float* const lb = (const PG8_GAS float*)(ws + WS_LB) + layer * 1024; const PG8_GAS float* const cosh = (const PG8_GAS float*)(ws + WS_COSH); const PG8_GAS float* const sinh = (const PG8_GAS float*)(ws + WS_SINH);
        const PG8_GAS float* const cosi = (const PG8_GAS float*)(ws + WS_COSI); const PG8_GAS float* const sini = (const PG8_GAS float*)(ws + WS_SINI);
        if (pn < 32) {
            const int seg = pn >> 2, cb = (pn & 3) * 256;
            if (seg == 4 || seg == 5) {
                PG8_GAS bf16_t* O = (seg == 4) ? QB : KB; const int head = (pn & 3) * 2 + (wc >> 1), i0 = (wc & 1) * 32 + 8 * fq;
#pragma unroll
                for (int ai = 0; ai < 2; ++ai)
#pragma unroll
                    for (int m = 0; m < 4; ++m) { const int row = row0 + ai * HALF + m * 16;
                        const PG8_GAS float* cp = cosh + (size_t)row * 64 + i0; const PG8_GAS float* sp = sinh + (size_t)row * 64 + i0;
                        const f32x4 c0 = *(const PG8_GAS f32x4*)cp, c1 = *(const PG8_GAS f32x4*)(cp + 4), s0 = *(const PG8_GAS f32x4*)sp, s1 = *(const PG8_GAS f32x4*)(sp + 4);
                        const f32x4 xa = acc[ai][0][m][0], xb = acc[ai][0][m][1], ya = acc[ai][1][m][0], yb = acc[ai][1][m][1];
                        PG8_GAS bf16_t* rp = O + (size_t)row * 1024 + head * 128 + i0;
                        *(PG8_GAS u32x4*)rp = pack8(xa * c0 - ya * s0, xb * c1 - yb * s1);
                        *(PG8_GAS u32x4*)(rp + 64) = pack8(xa * s0 + ya * c0, xb * s1 + yb * c1); asm volatile("" ::: "memory"); }
            } else if (seg == 7) {
                const int head = (pn & 3) * 4 + wc, i0 = 8 * fq;
#pragma unroll
                for (int ai = 0; ai < 2; ++ai)
#pragma unroll
                    for (int m = 0; m < 4; ++m) { const int row = row0 + ai * HALF + m * 16;
                        const PG8_GAS float* cp = cosi + (size_t)row * 32 + i0; const PG8_GAS float* sp = sini + (size_t)row * 32 + i0;
                        const f32x4 c0 = *(const PG8_GAS f32x4*)cp, c1 = *(const PG8_GAS f32x4*)(cp + 4), s0 = *(const PG8_GAS f32x4*)sp, s1 = *(const PG8_GAS f32x4*)(sp + 4);
                        const f32x4 xa = acc[ai][0][m][0], xb = acc[ai][0][m][1], ya = acc[ai][1][m][0], yb = acc[ai][1][m][1];
                        PG8_GAS bf16_t* rp = QI + (size_t)row * 1024 + head * 64 + i0;
                        *(PG8_GAS u32x4*)rp = pack8(xa * c0 - ya * s0, xb * c1 - yb * s1);
                        *(PG8_GAS u32x4*)(rp + 32) = pack8(xa * s0 + ya * c0, xb * s1 + yb * c1); asm volatile("" ::: "memory"); }
            } else if (seg == 1) {
#pragma unroll
                for (int bj = 0; bj < 2; ++bj) { const int col = cb + bj * HALF + cw;
                    const f32x4 l0 = *(const PG8_GAS f32x4*)(lb + col), l1 = *(const PG8_GAS f32x4*)(lb + col + 4);
#pragma unroll
                    for (int ai = 0; ai < 2; ++ai)
#pragma unroll
                        for (int m = 0; m < 4; ++m) { const int row = row0 + ai * HALF + m * 16; f32x4 lf[2], kk[2];
#pragma unroll
                            for (int n = 0; n < 2; ++n) { const f32x4 x = acc[ai][bj][m][n]; const f32x4 lv = n ? l1 : l0;
#pragma unroll
                                for (int j = 0; j < 4; ++j) { const float xe = fminf(fmaxf(x[j], -80.f), 80.f), e = __expf(-xe), r = __builtin_amdgcn_rcpf(1.0f + e);
                                    const float om = 1.0f - lv[j]; lf[n][j] = logf(lv[j] + om * r); kk[n][j] = om * (e * r); } }
                            PG8_GAS float* lp = LF + (size_t)row * 1024 + col; *(PG8_GAS f32x4*)lp = lf[0]; *(PG8_GAS f32x4*)(lp + 4) = lf[1];
                            *(PG8_GAS u32x4*)(KA + (size_t)row * 1024 + col) = pack8(kk[0], kk[1]); asm volatile("" ::: "memory"); } }
            } else {
                PG8_GAS bf16_t* O = (seg == 0) ? QA : (seg == 2) ? VA : (seg == 3) ? GA : VB; const bool act = (seg == 0 || seg == 3);
#pragma unroll
                for (int ai = 0; ai < 2; ++ai)
#pragma unroll
                    for (int m = 0; m < 4; ++m) { const int row = row0 + ai * HALF + m * 16;
#pragma unroll
                        for (int bj = 0; bj < 2; ++bj) { f32x4 v0 = acc[ai][bj][m][0], v1 = acc[ai][bj][m][1];
                            if (act) { v0 = silu4(v0); v1 = silu4(v1); }
                            *(PG8_GAS u32x4*)(O + (size_t)row * 1024 + cb + bj * HALF + cw) = pack8(v0, v1); } }
            }
        } else if (pn < 48) {
            PG8_GAS bf16_t* O = (pn < 40) ? SGA : SGB; const int cb = ((pn - 32) & 7) * 256;
#pragma unroll
            for (int ai = 0; ai < 2; ++ai)
#pragma unroll
                for (int m = 0; m < 4; ++m) { const int row = row0 + ai * HALF + m * 16;
#pragma unroll
                    for (int bj = 0; bj < 2; ++bj)
                        *(PG8_GAS u32x4*)(O + (size_t)row * DM + cb + bj * HALF + cw) = pack8(sigm4(acc[ai][bj][m][0]), sigm4(acc[ai][bj][m][1])); }
        } else {
#pragma unroll
            for (int ai = 0; ai < 2; ++ai)
#pragma unroll
                for (int m = 0; m < 4; ++m) { PG8_GAS float* p = IKW + (size_t)(row0 + ai * HALF + m * 16) * 128 + cw; *(PG8_GAS f32x4*)p = acc[ai][0][m][0]; *(PG8_GAS f32x4*)(p + 4) = acc[ai][0][m][1]; }
        }
    }
};
struct EpiGateA {
    static constexpr bool PERM = true, AFTER_DRAIN = false;
    unsigned char* ws;
    __device__ __forceinline__ void operator()(const f32x4 (&acc)[2][2][4][2], const Unit& u, int wr, int wc, int fr, int fq) const {
        unsigned char* const wg = as_global(ws); const bf16_t* const SG = (const bf16_t*)(wg + WS_SGA); bf16_t* const AF = (bf16_t*)(wg + WS_AF);
        const int row0 = u.pm * BM + wr * 64 + fr, col0 = u.pn * BM + wc * 32 + 8 * fq;
#pragma unroll
        for (int ai = 0; ai < 2; ++ai)
#pragma unroll
            for (int m = 0; m < 4; ++m) { const size_t off = (size_t)(row0 + ai * HALF + m * 16) * DM + col0;
#pragma unroll
                for (int bj = 0; bj < 2; ++bj) { f32x4 g0, g1; unpack8(*(const u32x4*)(SG + off + bj * HALF), g0, g1);
                    *(u32x4*)(AF + off + bj * HALF) = pack8(g0 * acc[ai][bj][m][0], g1 * acc[ai][bj][m][1]); } asm volatile("" ::: "memory"); }
    }
};
struct EpiGateB {
    static constexpr bool PERM = true, AFTER_DRAIN = false;
    unsigned char* ws;
    __device__ __forceinline__ void operator()(const f32x4 (&acc)[2][2][4][2], const Unit& u, int wr, int wc, int fr, int fq) const {
        unsigned char* const wg = as_global(ws); const bf16_t* const SG = (const bf16_t*)(wg + WS_SGB); const bf16_t* const AF = (const bf16_t*)(wg + WS_AF); bf16_t* const MG = (bf16_t*)(wg + WS_MG);
        const int row0 = u.pm * BM + wr * 64 + fr, col0 = u.pn * BM + wc * 32 + 8 * fq;
#pragma unroll
        for (int ai = 0; ai < 2; ++ai)
#pragma unroll
            for (int m = 0; m < 4; ++m) { const size_t off = (size_t)(row0 + ai * HALF + m * 16) * DM + col0;
#pragma unroll
                for (int bj = 0; bj < 2; ++bj) { f32x4 g0, g1; unpack8(*(const u32x4*)(SG + off + bj * HALF), g0, g1);
                    f32x4 a0, a1; unpack8(*(const u32x4*)(AF + off + bj * HALF), a0, a1);
                    *(u32x4*)(MG + off + bj * HALF) = pack8(a0 + g0 * acc[ai][bj][m][0], a1 + g1 * acc[ai][bj][m][1]); } asm volatile("" ::: "memory"); }
    }
};
template <bool PLAIN> struct EpiRes {
    static constexpr bool PERM = true, AFTER_DRAIN = false;
    const float* X; const float* g; const float* b; unsigned char* ws;
    __device__ __forceinline__ void operator()(const f32x4 (&acc)[2][2][4][2], const Unit& u, int wr, int wc, int fr, int fq) const {
        unsigned char* const wg = as_global(ws); float* const XP = (float*)(wg + WS_XPRE); const float* const ST = (const float*)(wg + WS_STATS); const float* const Xg = as_global(X);
        const int row0 = u.pm * BM + wr * 64 + fr, col0 = u.pn * BM + wc * 32 + 8 * fq;
        f32x4 gv[2][2], bv[2][2];
        if (!PLAIN) { const float* gg = as_global(g); const float* bb = as_global(b);
#pragma unroll
            for (int bj = 0; bj < 2; ++bj)
#pragma unroll
                for (int n = 0; n < 2; ++n) { gv[bj][n] = *(const f32x4*)(gg + col0 + bj * HALF + 4 * n); bv[bj][n] = *(const f32x4*)(bb + col0 + bj * HALF + 4 * n); } }
#pragma unroll
        for (int ai = 0; ai < 2; ++ai)
#pragma unroll
            for (int m = 0; m < 4; ++m) { const int row = row0 + ai * HALF + m * 16; const size_t off = (size_t)row * DM + col0;
                float mean = 0.f, rstd = 1.f; if (!PLAIN) { const f32x2 s2 = *(const f32x2*)(ST + 2 * (size_t)row); mean = s2[0]; rstd = s2[1]; }
#pragma unroll
                for (int bj = 0; bj < 2; ++bj) { float* p = XP + off + bj * HALF; f32x4 x0, x1;
                    if (PLAIN) { const float* xp = Xg + off + bj * HALF; x0 = *(const f32x4*)xp; x1 = *(const f32x4*)(xp + 4); }
                    else { x0 = (*(const f32x4*)p - mean) * rstd * gv[bj][0] + bv[bj][0]; x1 = (*(const f32x4*)(p + 4) - mean) * rstd * gv[bj][1] + bv[bj][1]; }
                    *(f32x4*)p = x0 * ALPHA + acc[ai][bj][m][0]; *(f32x4*)(p + 4) = x1 * ALPHA + acc[ai][bj][m][1]; } asm volatile("" ::: "memory"); }
    }
};
struct EpiSwiGLU {
    static constexpr bool PERM = true, AFTER_DRAIN = false;
    unsigned char* ws;
    __device__ __forceinline__ void operator()(const f32x4 (&acc)[2][2][4][2], const Unit& u, int wr, int wc, int fr, int fq) const {
        bf16_t* const H = (bf16_t*)(as_global(ws) + WS_H);
        const int row0 = u.pm * BM + wr * 64 + fr, col0 = u.pn * HALF + wc * 32 + 8 * fq;
#pragma unroll
        for (int ai = 0; ai < 2; ++ai)
#pragma unroll
            for (int m = 0; m < 4; ++m)
                *(u32x4*)(H + (size_t)(row0 + ai * HALF + m * 16) * DFF + col0) = pack8(silu4(acc[ai][0][m][0]) * acc[ai][1][m][0], silu4(acc[ai][0][m][1]) * acc[ai][1][m][1]);
    }
};
struct EpiF32P {
    static constexpr bool PERM = true, AFTER_DRAIN = false;
    unsigned char* ws;
    __device__ __forceinline__ void operator()(const f32x4 (&acc)[2][2][4][2], const Unit& u, int wr, int wc, int fr, int fq) const {
        bf16_t* const C = (bf16_t*)(as_global(ws) + WS_PP);
        const int row0 = u.pm * BM + wr * 64 + fr, col0 = u.pn * BM + wc * 32 + 8 * fq;
#pragma unroll
        for (int ai = 0; ai < 2; ++ai)
#pragma unroll
            for (int m = 0; m < 4; ++m) { const size_t off = (size_t)(row0 + ai * HALF + m * 16) * DM + col0;
#pragma unroll
                for (int bj = 0; bj < 2; ++bj) *(u32x4*)(C + off + bj * HALF) = pack8(acc[ai][bj][m][0], acc[ai][bj][m][1]); }
    }
};
struct EpiPle {
    static constexpr bool PERM = true, AFTER_DRAIN = false;
    const float* g; const float* b; unsigned char* ws;
    __device__ __forceinline__ void operator()(const f32x4 (&acc)[2][2][4][2], const Unit& u, int wr, int wc, int fr, int fq) const {
        unsigned char* const wg = as_global(ws); const bf16_t* const PP = (const bf16_t*)(wg + WS_PP); float* const XP = (float*)(wg + WS_XPRE); const float* const ST = (const float*)(wg + WS_STATS);
        const int row0 = u.pm * BM + wr * 64 + fr, col0 = u.pn * BM + wc * 32 + 8 * fq;
        f32x4 gv[2][2], bv[2][2]; { const float* gg = as_global(g); const float* bb = as_global(b);
#pragma unroll
            for (int bj = 0; bj < 2; ++bj)
#pragma unroll
                for (int n = 0; n < 2; ++n) { gv[bj][n] = *(const f32x4*)(gg + col0 + bj * HALF + 4 * n); bv[bj][n] = *(const f32x4*)(bb + col0 + bj * HALF + 4 * n); } }
#pragma unroll
        for (int ai = 0; ai < 2; ++ai)
#pragma unroll
            for (int m = 0; m < 4; ++m) { const int row = row0 + ai * HALF + m * 16; const size_t off = (size_t)row * DM + col0;
                const f32x2 s2 = *(const f32x2*)(ST + 2 * (size_t)row); const float mean = s2[0], rstd = s2[1];
#pragma unroll
                for (int bj = 0; bj < 2; ++bj) { float* p = XP + off + bj * HALF; f32x4 p0, p1; unpack8(*(const u32x4*)(PP + off + bj * HALF), p0, p1);
                    const f32x4 x0 = (*(const f32x4*)p - mean) * rstd * gv[bj][0] + bv[bj][0], x1 = (*(const f32x4*)(p + 4) - mean) * rstd * gv[bj][1] + bv[bj][1];
                    *(f32x4*)p = x0 * ALPHA + sigm4(acc[ai][bj][m][0]) * p0; *(f32x4*)(p + 4) = x1 * ALPHA + sigm4(acc[ai][bj][m][1]) * p1; } asm volatile("" ::: "memory"); }
    }
};

struct EpiRawTest {
    static constexpr bool PERM = true, AFTER_DRAIN = false;
    unsigned char* ws;
    __device__ __forceinline__ void operator()(const f32x4 (&acc)[2][2][4][2], const Unit& u, int wr, int wc, int fr, int fq) const {
        bf16_t* const H = (bf16_t*)(as_global(ws) + WS_H);
        const int row0 = u.pm * BM + wr * 64 + fr, col0 = u.pn * HALF + wc * 32 + 8 * fq;
#pragma unroll
        for (int ai = 0; ai < 2; ++ai)
#pragma unroll
            for (int m = 0; m < 4; ++m)
                *(u32x4*)(H + (size_t)(row0 + ai * HALF + m * 16) * 6272 + col0) = pack8(acc[ai][0][m][0] + acc[ai][1][m][0], acc[ai][0][m][1] + acc[ai][1][m][1]);
    }
};
template <class Epi, class Sched, bool ALIGN_EPI = false, bool SP2 = false>
__device__ __forceinline__ void gemm_phase(PG8_LAS unsigned char* lds, const Gemm g, const Sched& S, const Epi& E) {
    const int tid = tid_(), wid = __builtin_amdgcn_readfirstlane(tid >> 6), lane = tid & 63, wr = wid >> 2, wc = wid & 3, fr = lane & 15, fq = lane >> 4;
    int Kq = g.K; asm volatile("" : "+s"(Kq)); const int K = Kq, nt = K / BK;
    unsigned voffA[2], voffB[2];
#pragma unroll
    for (int i = 0; i < 2; ++i) { int R, C; stage_rc(tid * 16 + i * 8192, R, C); const int Rb = Epi::PERM ? ((R & ~31) + perm32(R & 31)) : R;
        voffA[i] = (unsigned)(R * K + C) * 2u; voffB[i] = (unsigned)(Rb * K + C) * 2u; }
    const size_t kstep = (size_t)(BK * 2);
    const size_t hstep = (size_t)HALF * K * 2;
    const size_t tstep = 2 * hstep;
    const unsigned ldsw = (unsigned)wid * 1024u;
    const int aoff = lds_byte(wr * 64 + fr, fq * 8), boff = lds_byte(wc * 32 + fr, fq * 8);
#define PG8_SA(b, h) (((b) * 2 + (h)) * HTB)
#define PG8_SB(b, h) ((4 + (b) * 2 + (h)) * HTB)
#define PG8_STAGE(bufoff, gbase, voff) do { _Pragma("unroll") for (int _i = 0; _i < 2; ++_i) \
        __builtin_amdgcn_global_load_lds((const unsigned*)((const char*)(gbase) + (voff)[_i]), (PG8_LAS unsigned*)(lds + (bufoff) + ldsw + _i * 8192), 16, 0, 0); } while (0)
#define PG8_LDA(dst, b, h) do { _Pragma("unroll") for (int m = 0; m < 4; ++m) _Pragma("unroll") for (int k = 0; k < 2; ++k) dst[m][k] = *(const PG8_LAS bf16x8*)(lds + PG8_SA(b, h) + aoff + m * 2048 + k * 1024); } while (0)
#define PG8_LDB(dst, b, h) do { _Pragma("unroll") for (int n = 0; n < 2; ++n) _Pragma("unroll") for (int k = 0; k < 2; ++k) dst[n][k] = *(const PG8_LAS bf16x8*)(lds + PG8_SB(b, h) + boff + n * 2048 + k * 1024); } while (0)
#define PG8_MMA(ai, bj, At, Bt) do { __builtin_amdgcn_s_setprio(1); _Pragma("unroll") for (int m = 0; m < 4; ++m) _Pragma("unroll") for (int n = 0; n < 2; ++n) _Pragma("unroll") for (int k = 0; k < 2; ++k) \
        acc[ai][bj][m][n] = __builtin_amdgcn_mfma_f32_16x16x32_bf16(Bt[n][k], At[m][k], acc[ai][bj][m][n], 0, 0, 0); __builtin_amdgcn_s_setprio(0); } while (0)
#define PG8_WAIT_V(n) asm volatile("s_waitcnt vmcnt(" #n ")" ::: "memory")
#define PG8_WAIT_L(n) asm volatile("s_waitcnt lgkmcnt(" #n ")" ::: "memory")
#define PG8_BAR __builtin_amdgcn_s_barrier()
#define PG8_SCHED __builtin_amdgcn_sched_barrier(0)
    Unit cur, nxt; int ui = 0;
    if (!S.next(0, cur)) return;
    f32x4 acc[2][2][4][2];
#pragma unroll
    for (int a = 0; a < 2; ++a)
#pragma unroll
        for (int b = 0; b < 2; ++b)
#pragma unroll
            for (int m = 0; m < 4; ++m)
#pragma unroll
                for (int n = 0; n < 2; ++n) acc[a][b][m][n] = (f32x4){0.f, 0.f, 0.f, 0.f};
    bf16x8 At[4][2], B0[2][2], B1[2][2];
    const char* cA = (const char*)g.A + (size_t)cur.pm * tstep; const char* cB = (const char*)g.Bt + (size_t)cur.pn * tstep;
    S.a_ready(cur);
    if constexpr (SP2) {
        PG8_STAGE(PG8_SB(0, 0), cB, voffB); PG8_STAGE(PG8_SB(0, 1), cB + hstep, voffB); PG8_STAGE(PG8_SA(0, 0), cA, voffA); PG8_STAGE(PG8_SA(0, 1), cA + hstep, voffA);
        if (wr == 1) PG8_BAR;
        PG8_WAIT_V(2); PG8_BAR;
        PG8_STAGE(PG8_SB(1, 0), cB + kstep, voffB); PG8_STAGE(PG8_SA(1, 0), cA + kstep, voffA); PG8_STAGE(PG8_SB(1, 1), cB + hstep + kstep, voffB);
        PG8_WAIT_V(6); PG8_BAR;
    } else {
        PG8_STAGE(PG8_SB(0, 0), cB, voffB); PG8_STAGE(PG8_SA(0, 0), cA, voffA); PG8_STAGE(PG8_SB(0, 1), cB + hstep, voffB); PG8_STAGE(PG8_SA(0, 1), cA + hstep, voffA);
        if (wr == 1) PG8_BAR;
        PG8_WAIT_V(4); PG8_BAR;
        PG8_STAGE(PG8_SB(1, 0), cB + kstep, voffB); PG8_STAGE(PG8_SA(1, 0), cA + kstep, voffA); PG8_STAGE(PG8_SB(1, 1), cB + hstep + kstep, voffB);
        PG8_WAIT_V(6); PG8_BAR;
    }
    for (;;) {
        const bool has_next = S.next(ui + 1, nxt);
        const char* nA = has_next ? (const char*)g.A + (size_t)nxt.pm * tstep : cA; const char* nB = has_next ? (const char*)g.Bt + (size_t)nxt.pn * tstep : cB;
        for (int t = 0; t < nt; t += 2) {
            const bool last = (t == nt - 2);
            const char* a1 = cA + (size_t)(t + 1) * kstep;
            const char* a2 = last ? nA : cA + (size_t)(t + 2) * kstep; const char* b2 = last ? nB : cB + (size_t)(t + 2) * kstep;
            const char* a3 = a2 + kstep; const char* b3 = b2 + kstep;
            if (last && has_next) S.a_ready(nxt);
            if constexpr (SP2) {
            PG8_LDB(B0, 0, 0); PG8_LDB(B1, 0, 1); PG8_SCHED; PG8_LDA(At, 0, 0); PG8_STAGE(PG8_SA(1, 1), a1 + hstep, voffA);
            PG8_WAIT_V(8); PG8_WAIT_L(0); PG8_BAR; PG8_MMA(0, 0, At, B0); PG8_MMA(0, 1, At, B1); PG8_BAR; PG8_SCHED;
            PG8_LDA(At, 0, 1); PG8_STAGE(PG8_SB(0, 0), b2, voffB); PG8_STAGE(PG8_SB(0, 1), b2 + hstep, voffB); PG8_STAGE(PG8_SA(0, 0), a2, voffA);
            PG8_WAIT_V(8); PG8_WAIT_L(0); PG8_BAR; PG8_MMA(1, 0, At, B0); PG8_MMA(1, 1, At, B1); PG8_BAR; PG8_SCHED;
            PG8_LDB(B0, 1, 0); PG8_LDB(B1, 1, 1); PG8_SCHED; PG8_LDA(At, 1, 0); PG8_STAGE(PG8_SA(0, 1), a2 + hstep, voffA);
            PG8_WAIT_V(8); PG8_WAIT_L(0); PG8_BAR; PG8_MMA(0, 0, At, B0); PG8_MMA(0, 1, At, B1); PG8_BAR; PG8_SCHED;
            PG8_LDA(At, 1, 1); PG8_STAGE(PG8_SB(1, 0), b3, voffB); PG8_STAGE(PG8_SB(1, 1), b3 + hstep, voffB); PG8_STAGE(PG8_SA(1, 0), a3, voffA);
            PG8_WAIT_V(8); PG8_WAIT_L(0); PG8_BAR; PG8_MMA(1, 0, At, B0); PG8_MMA(1, 1, At, B1); PG8_BAR; PG8_SCHED;
            } else {
            PG8_LDB(B0, 0, 0); PG8_SCHED; PG8_LDA(At, 0, 0); PG8_STAGE(PG8_SA(1, 1), a1 + hstep, voffA);
            PG8_WAIT_L(8); PG8_BAR; PG8_WAIT_L(0); PG8_MMA(0, 0, At, B0); PG8_BAR; PG8_SCHED;
            PG8_LDB(B1, 0, 1); PG8_STAGE(PG8_SB(0, 0), b2, voffB);
            PG8_BAR; PG8_WAIT_L(0); PG8_MMA(0, 1, At, B1); PG8_BAR;
            PG8_LDA(At, 0, 1); PG8_STAGE(PG8_SA(0, 0), a2, voffA);
            PG8_BAR; PG8_WAIT_L(0); PG8_MMA(1, 0, At, B0); PG8_BAR; PG8_SCHED;
            PG8_STAGE(PG8_SB(0, 1), b2 + hstep, voffB);
            PG8_WAIT_V(6); PG8_BAR; PG8_MMA(1, 1, At, B1); PG8_BAR;
            PG8_LDB(B0, 1, 0); PG8_SCHED; PG8_LDA(At, 1, 0); PG8_STAGE(PG8_SA(0, 1), a2 + hstep, voffA);
            PG8_WAIT_L(8); PG8_BAR; PG8_WAIT_L(0); PG8_MMA(0, 0, At, B0); PG8_BAR; PG8_SCHED;
            PG8_LDB(B1, 1, 1); PG8_STAGE(PG8_SB(1, 0), b3, voffB);
            PG8_BAR; PG8_WAIT_L(0); PG8_MMA(0, 1, At, B1); PG8_BAR;
            PG8_LDA(At, 1, 1); PG8_STAGE(PG8_SA(1, 0), a3, voffA);
            PG8_BAR; PG8_WAIT_L(0); PG8_MMA(1, 0, At, B0); PG8_BAR; PG8_SCHED;
            PG8_STAGE(PG8_SB(1, 1), b3 + hstep, voffB);
            PG8_WAIT_V(6); PG8_BAR; PG8_MMA(1, 1, At, B1); PG8_BAR;
            }
        }
        if constexpr (ALIGN_EPI) { if (wr == 0) PG8_BAR; }
        if constexpr (!Epi::AFTER_DRAIN) { E(acc, cur, wr, wc, fr, fq); S.done(cur); }
        if (!has_next) break;
#pragma unroll
        for (int a = 0; a < 2; ++a)
#pragma unroll
            for (int b = 0; b < 2; ++b)
#pragma unroll
                for (int m = 0; m < 4; ++m)
#pragma unroll
                    for (int n = 0; n < 2; ++n) acc[a][b][m][n] = (f32x4){0.f, 0.f, 0.f, 0.f};
        cur = nxt; cA = nA; cB = nB; ++ui;
        if constexpr (ALIGN_EPI) { if (wr == 1) PG8_BAR; }
    }
    PG8_WAIT_V(0);
    if constexpr (!ALIGN_EPI) { if (wr == 0) PG8_BAR; }
    PG8_BAR;
    if constexpr (Epi::AFTER_DRAIN) { E.fused(acc, cur, wr, wc, fr, fq, lds, wid, lane); S.done(cur); }
#undef PG8_SA
#undef PG8_SB
#undef PG8_STAGE
#undef PG8_LDA
#undef PG8_LDB
#undef PG8_MMA
#undef PG8_WAIT_V
#undef PG8_WAIT_L
#undef PG8_BAR
#undef PG8_SCHED
}
}
#define XB_TMO      128
#define XB_XCNT(j)  (256  + 64 * (j))
#define XB_XSUB(j)  (1280 + 64 * (j))
#define XB_XGEN(j)  (2304 + 64 * (j))
#define XB_TOP      3328
#define XB_TOPGEN   3392
#define XCD_BAR_WORDS 3456
#define XB_SPIN_CAP (1u << 18)
#define LAS __attribute__((address_space(3)))

__device__ __forceinline__ unsigned xb_ld(unsigned* p)              { return __hip_atomic_load(p, __ATOMIC_RELAXED, __HIP_MEMORY_SCOPE_AGENT); }
__device__ __forceinline__ unsigned xb_add(unsigned* p, unsigned v) { return __hip_atomic_fetch_add(p, v, __ATOMIC_RELAXED, __HIP_MEMORY_SCOPE_AGENT); }
__device__ __forceinline__ unsigned xb_xcc_id() { return (unsigned)__builtin_amdgcn_s_getreg((3 << 11) | 20) & 0xFu; }
#define XB_SPIN(cond, bar) do { unsigned _sp = 0; while (cond) { __builtin_amdgcn_s_sleep(1); \
    if ((++_sp & 255u) == 0u) { if (xb_ld(&(bar)[XB_TMO])) break; if (_sp > XB_SPIN_CAP) { atomicAdd(&(bar)[XB_TMO], 1u); break; } } } } while (0)

struct XcdBarrier {
    unsigned* bar; unsigned x;
    volatile LAS unsigned* st;
};

__device__ __forceinline__ XcdBarrier xcd_barrier_post(unsigned* bar, volatile LAS unsigned* st) {
    XcdBarrier b; b.bar = bar; b.x = xb_xcc_id(); b.st = st;
    if (threadIdx.x == 0) (void)xb_add(&bar[XB_XCNT(b.x)], 1u);
    return b;
}
__device__ __forceinline__ void xcd_barrier_complete(unsigned* bar, unsigned x, unsigned& nloc, unsigned& nx) {
    const unsigned G = gridDim.x * gridDim.y * gridDim.z;
    unsigned sum, cnt, mine, sp = 0u;
    for (;;) {
        sum = 0u; cnt = 0u; mine = 0u;
#pragma unroll
        for (unsigned j = 0; j < 16; ++j) { const unsigned c = xb_ld(&bar[XB_XCNT(j)]); sum += c; cnt += (c > 0u) ? 1u : 0u; mine = (j == x) ? c : mine; }
        if (sum == G) break;
        __builtin_amdgcn_s_sleep(1);
        if ((++sp & 255u) == 0u) { if (xb_ld(&bar[XB_TMO])) break; if (sp > XB_SPIN_CAP) { atomicAdd(&bar[XB_TMO], 1u); break; } }
    }
    nloc = mine > 0u ? mine : 1u; nx = cnt > 0u ? cnt : 1u;
}

__device__ __forceinline__ void xcd_barrier(const XcdBarrier& b) {
    asm volatile("s_waitcnt vmcnt(0)" ::: "memory");
    __syncthreads();
    if (threadIdx.x == 0) {
        unsigned* bar = b.bar;
        __builtin_amdgcn_s_waitcnt(0);
        const unsigned bx = xb_xcc_id();
        unsigned nloc = b.st[0], nx = b.st[1];
        if (nloc == 0u) { xcd_barrier_complete(bar, bx, nloc, nx); b.st[0] = nloc; b.st[1] = nx; }
        const unsigned old = xb_add(&bar[XB_XSUB(bx)], 1u);
        const unsigned gen = old / nloc;
        if (old + 1u == (gen + 1u) * nloc) {
            __builtin_amdgcn_fence(__ATOMIC_RELEASE, "agent");
            asm volatile("s_waitcnt vmcnt(0)" ::: "memory");
            const unsigned og = xb_add(&bar[XB_TOP], 1u);
            const unsigned tg = og / nx;
            if (og + 1u == (tg + 1u) * nx) xb_add(&bar[XB_TOPGEN], 1u);
            else XB_SPIN(xb_ld(&bar[XB_TOPGEN]) == tg, bar);
            __builtin_amdgcn_fence(__ATOMIC_ACQUIRE, "agent");
            xb_add(&bar[XB_XGEN(bx)], 1u);
            asm volatile("s_waitcnt vmcnt(0)" ::: "memory");
        } else {
            XB_SPIN(xb_ld(&bar[XB_XGEN(bx)]) == gen, bar);
            __builtin_amdgcn_fence(__ATOMIC_ACQUIRE, "agent");
            asm volatile("s_waitcnt vmcnt(0)" ::: "memory");
        }
    }
    __syncthreads();
}

struct Params {
    const float* x; const float* p; const int* pos;
    const float *w_in, *w_a, *w_b, *w_out, *lbraw, *hnorm_g, *ikn_g, *ikn_b, *lnm_g, *lnm_b, *w_fg, *w_fu, *w_fd, *lnf_g, *lnf_b, *w_pg, *w_pp, *lnp_g, *lnp_b;
    float* out; unsigned char* ws;
    double invf_h[64]; double invf_i[32];
    int ph_lo, ph_hi;
};
typedef const __attribute__((address_space(4))) Params* KP;
__device__ __forceinline__ KP kparams() { KP p = (KP)__builtin_amdgcn_kernarg_segment_ptr(); asm volatile("" : "+s"(p)); return p; }
constexpr int NPH_LAYER = 14, NPH = DEPTH * NPH_LAYER;
constexpr int LDS_BYTES = 131072 + 1024;
constexpr int MISC_OFF = 131072;

__device__ __forceinline__ int wsrc_col_in(int n) {
    const int tile = n >> 8, t = n & 255;
    if (tile < 16) return n;
    if (tile < 24) { const int bj = t >> 7, u = t & 127, head = u >> 6, i = u & 63; return tile * 256 + 128 * head + 64 * bj + i; }
    if (tile < 28) return n;
    if (tile < 32) { const int bj = t >> 7, u = t & 127, head = u >> 5, i = u & 31; return tile * 256 + 64 * head + 32 * bj + i; }
    if (tile < 40) return 8272 + (n - 32 * 256);
    if (tile < 48) return 10320 + (n - 40 * 256);
    return t < 80 ? 8192 + t : -1;
}
template <int KIND>
__device__ __forceinline__ void wconv_wave_tile(const float* src, const float* src2, int nsrc, int K, bf16_t* dst, int n0, int k0, int lane) {
    const int n = n0 + lane; int c; const float* s = src;
    if (KIND == 0) c = n;
    else if (KIND == 1) c = wsrc_col_in(n);
    else { const int tl = n >> 8, t = n & 255; c = tl * 128 + (t & 127); if (t >= 128) s = src2; }
    float f[64];
    const float* sp = s + (size_t)k0 * nsrc + (c >= 0 ? c : 0);
#pragma unroll
    for (int kk = 0; kk < 64; ++kk) f[kk] = sp[(size_t)kk * nsrc];
    bf16_t* d = dst + (size_t)n * K + k0;
#pragma unroll
    for (int i = 0; i < 8; ++i) { pg8::u32x4 w;
        w.x = pg8::cvt_pk_bf16(f[8 * i], f[8 * i + 1]); w.y = pg8::cvt_pk_bf16(f[8 * i + 2], f[8 * i + 3]); w.z = pg8::cvt_pk_bf16(f[8 * i + 4], f[8 * i + 5]); w.w = pg8::cvt_pk_bf16(f[8 * i + 6], f[8 * i + 7]);
        if (c < 0) w = (pg8::u32x4){0u, 0u, 0u, 0u};
        *(pg8::u32x4*)(d + 8 * i) = w; }
}
template <int KIND>
__device__ __forceinline__ void wconv_wave_tile2(const float* src, const float* src2, int nsrc, int K, bf16_t* dst, int n0a, int k0a, int n0b, int k0b, int lane) {
    int ca, cb; const float* sa = src; const float* sb = src; const int na = n0a + lane, nb = n0b + lane;
    if (KIND == 0) { ca = na; cb = nb; }
    else if (KIND == 1) { ca = wsrc_col_in(na); cb = wsrc_col_in(nb); }
    else { { const int tl = na >> 8, t = na & 255; ca = tl * 128 + (t & 127); if (t >= 128) sa = src2; } { const int tl = nb >> 8, t = nb & 255; cb = tl * 128 + (t & 127); if (t >= 128) sb = src2; } }
    float fa[64], fb[64];
    const float* spa = sa + (size_t)k0a * nsrc + (ca >= 0 ? ca : 0); const float* spb = sb + (size_t)k0b * nsrc + (cb >= 0 ? cb : 0);
#pragma unroll
    for (int kk = 0; kk < 64; ++kk) fa[kk] = spa[(size_t)kk * nsrc];
#pragma unroll
    for (int kk = 0; kk < 64; ++kk) fb[kk] = spb[(size_t)kk * nsrc];
    bf16_t* da = dst + (size_t)na * K + k0a; bf16_t* db = dst + (size_t)nb * K + k0b;
#pragma unroll
    for (int i = 0; i < 8; ++i) { pg8::u32x4 w;
        w.x = pg8::cvt_pk_bf16(fa[8 * i], fa[8 * i + 1]); w.y = pg8::cvt_pk_bf16(fa[8 * i + 2], fa[8 * i + 3]); w.z = pg8::cvt_pk_bf16(fa[8 * i + 4], fa[8 * i + 5]); w.w = pg8::cvt_pk_bf16(fa[8 * i + 6], fa[8 * i + 7]);
        if (ca < 0) w = (pg8::u32x4){0u, 0u, 0u, 0u};
        *(pg8::u32x4*)(da + 8 * i) = w; }
#pragma unroll
    for (int i = 0; i < 8; ++i) { pg8::u32x4 w;
        w.x = pg8::cvt_pk_bf16(fb[8 * i], fb[8 * i + 1]); w.y = pg8::cvt_pk_bf16(fb[8 * i + 2], fb[8 * i + 3]); w.z = pg8::cvt_pk_bf16(fb[8 * i + 4], fb[8 * i + 5]); w.w = pg8::cvt_pk_bf16(fb[8 * i + 6], fb[8 * i + 7]);
        if (cb < 0) w = (pg8::u32x4){0u, 0u, 0u, 0u};
        *(pg8::u32x4*)(db + 8 * i) = w; }
}
template <int KIND>
__device__ __forceinline__ void wconv_job(const float* src, const float* src2, int nsrc, int K, bf16_t* dst, int ndst, int W, int NWV, int lane, int& tcount) {
    const int kt = K / 64, ntiles = (ndst / 64) * kt;
    const int nb = ndst / 64; int first = (W - tcount % NWV + NWV) % NWV;
    int t = first;
    for (; t + NWV < ntiles; t += 2 * NWV) wconv_wave_tile2<KIND>(src, src2, nsrc, K, dst, (t % nb) * 64, (t / nb) * 64, ((t + NWV) % nb) * 64, ((t + NWV) / nb) * 64, lane);
    if (t < ntiles) wconv_wave_tile<KIND>(src, src2, nsrc, K, dst, (t % nb) * 64, (t / nb) * 64, lane);
    tcount += ntiles;
}
__device__ __forceinline__ void phase_wconv(KP P, int layer) {
    unsigned char* ws = as_global(P->ws); int tc = 0;
    const int tid0 = tid_(), lane = tid0 & 63, W = bid_() * 8 + __builtin_amdgcn_readfirstlane(tid0 >> 6), NWV = nblk_() * 8;
    wconv_job<1>(as_global(P->w_in) + (size_t)layer * DM * INW, nullptr, INW, DM, (bf16_t*)(ws + WS_WIN), INP, W, NWV, lane, tc);
    wconv_job<0>(as_global(P->w_a) + (size_t)layer * AW * DM, nullptr, DM, AW, (bf16_t*)(ws + WS_WA), DM, W, NWV, lane, tc);
    wconv_job<0>(as_global(P->w_b) + (size_t)layer * BW * DM, nullptr, DM, BW, (bf16_t*)(ws + WS_WB), DM, W, NWV, lane, tc);
    wconv_job<0>(as_global(P->w_out) + (size_t)layer * DM * DM, nullptr, DM, DM, (bf16_t*)(ws + WS_WO), DM, W, NWV, lane, tc);
    wconv_job<2>(as_global(P->w_fg) + (size_t)layer * DM * DFF, as_global(P->w_fu) + (size_t)layer * DM * DFF, DFF, DM, (bf16_t*)(ws + WS_WGU), 2 * DFF, W, NWV, lane, tc);
    wconv_job<0>(as_global(P->w_fd) + (size_t)layer * DFF * DM, nullptr, DM, DFF, (bf16_t*)(ws + WS_WDN), DM, W, NWV, lane, tc);
    wconv_job<0>(as_global(P->w_pg) + (size_t)layer * DM * DM, nullptr, DM, DM, (bf16_t*)(ws + WS_WPG), DM, W, NWV, lane, tc);
    wconv_job<0>(as_global(P->w_pp) + (size_t)layer * PLE * DM, nullptr, DM, PLE, (bf16_t*)(ws + WS_WPP), DM, W, NWV, lane, tc);
    const float* ps = as_global(P->p) + (size_t)layer * TOK * PLE; bf16_t* pb = (bf16_t*)(ws + WS_PB);
    for (size_t i = ((size_t)bid_() * 512 + tid_()) * 8; i < (size_t)TOK * PLE; i += (size_t)nblk_() * 512 * 8)
        *(pg8::u32x4*)(pb + i) = pg8::pack8(*(const pg8::f32x4*)(ps + i), *(const pg8::f32x4*)(ps + i + 4));
}
__device__ __forceinline__ void phase_prologue(KP P) {
    unsigned char* ws = as_global(P->ws); const size_t gtid = (size_t)bid_() * 512 + tid_(), gsz = (size_t)nblk_() * 512;
    bf16_t* xb = (bf16_t*)(ws + WS_XB); const float* xin = as_global(P->x); const int* posg = as_global(P->pos); const float* lbr = as_global(P->lbraw);
    for (size_t i = gtid * 8; i < (size_t)TOK * DM; i += gsz * 8) *(pg8::u32x4*)(xb + i) = pg8::pack8(*(const pg8::f32x4*)(xin + i), *(const pg8::f32x4*)(xin + i + 4));
    float* ch = (float*)(ws + WS_COSH); float* sh = (float*)(ws + WS_SINH); float* ci = (float*)(ws + WS_COSI); float* si = (float*)(ws + WS_SINI);
    for (size_t i = gtid; i < (size_t)TOK * 64; i += gsz) { const int t = (int)(i >> 6), j = (int)(i & 63); const double rev = (double)posg[t] * P->invf_h[j]; const float fr = (float)(rev - rint(rev));
        ch[i] = __builtin_amdgcn_cosf(fr); sh[i] = __builtin_amdgcn_sinf(fr); }
    for (size_t i = gtid; i < (size_t)TOK * 32; i += gsz) { const int t = (int)(i >> 5), j = (int)(i & 31); const double rev = (double)posg[t] * P->invf_i[j]; const float fr = (float)(rev - rint(rev));
        ci[i] = __builtin_amdgcn_cosf(fr); si[i] = __builtin_amdgcn_sinf(fr); }
    float* lb = (float*)(ws + WS_LB);
    for (size_t c = gtid; c < 1024; c += gsz) { float v[4], mx = -1e30f; for (int l = 0; l < 4; ++l) { v[l] = lbr[l * 1024 + c]; mx = fmaxf(mx, v[l]); }
        float s = 0.f; for (int l = 0; l < 4; ++l) { v[l] = expf(v[l] - mx); s += v[l]; }
        float cum = 0.f; const float inv = 1.0f / s; for (int l = 0; l < 4; ++l) { cum += v[l] * inv; lb[l * 1024 + c] = cum - v[0] * inv; } }
}
__device__ __forceinline__ void phase_ln(const float* XP, float* OUT, bf16_t* XB, float* ST, const float* g, const float* b) {
    const int tid = tid_(), wave = __builtin_amdgcn_readfirstlane(tid >> 6), lane = tid & 63, nb8 = nblk_() * 8;
    for (int row = bid_() * 8 + wave; row < TOK; row += nb8) {
        const float* xp = XP + (size_t)row * DM; pg8::f32x4 v[8]; float s = 0.f;
#pragma unroll
        for (int c = 0; c < 8; ++c) { v[c] = *(const pg8::f32x4*)(xp + c * 256 + lane * 4); s += (v[c][0] + v[c][1]) + (v[c][2] + v[c][3]); }
#pragma unroll
        for (int o = 32; o >= 1; o >>= 1) s += __shfl_xor(s, o);
        const float mean = s * (1.0f / DM); float q = 0.f;
#pragma unroll
        for (int c = 0; c < 8; ++c) { v[c] = v[c] - mean; q += (v[c][0] * v[c][0] + v[c][1] * v[c][1]) + (v[c][2] * v[c][2] + v[c][3] * v[c][3]); }
#pragma unroll
        for (int o = 32; o >= 1; o >>= 1) q += __shfl_xor(q, o);
        const float rstd = 1.0f / sqrtf(q * (1.0f / DM) + LN_EPS);
        if (lane == 0) { pg8::f32x2 s2; s2[0] = mean; s2[1] = rstd; *(pg8::f32x2*)(ST + 2 * (size_t)row) = s2; }
#pragma unroll
        for (int c = 0; c < 8; ++c) { const int col = c * 256 + lane * 4; const pg8::f32x4 gg = *(const pg8::f32x4*)(g + col), bb = *(const pg8::f32x4*)(b + col);
            const pg8::f32x4 y = v[c] * rstd * gg + bb; if (OUT) *(pg8::f32x4*)(OUT + (size_t)row * DM + col) = y;
            pg8::u32x2 w; w.x = pg8::cvt_pk_bf16(y[0], y[1]); w.y = pg8::cvt_pk_bf16(y[2], y[3]); *(pg8::u32x2*)(XB + (size_t)row * DM + col) = w; }
    }
}
__device__ __forceinline__ void phase_ikprep(KP P, int layer) {
    unsigned char* ws = as_global(P->ws); const float* ikw = (const float*)(ws + WS_IKW); bf16_t* ki = (bf16_t*)(ws + WS_KI); float* wi = (float*)(ws + WS_WI);
    const float* ci = (const float*)(ws + WS_COSI); const float* si = (const float*)(ws + WS_SINI);
    const int tid = tid_(), wave = __builtin_amdgcn_readfirstlane(tid >> 6), lane = tid & 63, nb8 = nblk_() * 8;
    const float g = as_global(P->ikn_g)[layer * 64 + lane], b = as_global(P->ikn_b)[layer * 64 + lane];
    for (int t = bid_() * 8 + wave; t < TOK; t += nb8) {
        const float x = ikw[(size_t)t * 128 + lane]; float s = x;
#pragma unroll
        for (int o = 32; o >= 1; o >>= 1) s += __shfl_xor(s, o);
        const float mean = s * (1.0f / 64.0f), xc = x - mean; float q = xc * xc;
#pragma unroll
        for (int o = 32; o >= 1; o >>= 1) q += __shfl_xor(q, o);
        const float y = xc * (1.0f / sqrtf(q * (1.0f / 64.0f) + LN_EPS)) * g + b;
        const float other = __shfl_xor(y, 32); const int j = lane & 31; const float c = ci[(size_t)t * 32 + j], sn = si[(size_t)t * 32 + j];
        const float r = (lane < 32) ? (y * c - other * sn) : (other * sn + y * c);
        ki[(size_t)t * 64 + lane] = f2bf(r);
        if (lane < 16) wi[(size_t)t * 16 + lane] = ikw[(size_t)t * 128 + 64 + lane] * IDX_SCALE;
    }
}
typedef short bf16x8_t __attribute__((ext_vector_type(8)));
typedef short bf16x4_t __attribute__((ext_vector_type(4)));
typedef float f32x16_t __attribute__((ext_vector_type(16)));
constexpr int CUM_LD = 132;
constexpr int OPK_LD = 136;
constexpr int OPS_LD = 72;

__device__ __forceinline__ void hgrn_scan_load(const float* LF, int tok0, int h, int tid, float (&v)[16]) {
    const int k = tid & 127, qd = tid >> 7;
#pragma unroll
    for (int i = 0; i < 16; ++i) v[i] = LF[(size_t)(tok0 + qd * 16 + i) * 1024 + h * 128 + k];
}
__device__ __forceinline__ void hgrn_scan_cum(float (&v)[16], LAS float* cum, LAS float* tot, int tid) {
    const int k = tid & 127, qd = tid >> 7;
    float run = 0.f;
#pragma unroll
    for (int i = 0; i < 16; ++i) { run += v[i]; v[i] = run; }
    tot[qd * 128 + k] = run;
    __syncthreads();
    float off = 0.f;
#pragma unroll
    for (int q = 0; q < 3; ++q) off += (q < qd) ? tot[q * 128 + k] : 0.f;
#pragma unroll
    for (int i = 0; i < 16; ++i) cum[(qd * 16 + i) * CUM_LD + k] = v[i] + off;
    __syncthreads();
}

struct H1Pre { float lf[16]; unsigned ka[8], va[8]; };
__device__ __forceinline__ void h1_load(const bf16_t* KA, const bf16_t* VA, const float* LF, int unit, int tid, H1Pre& p) {
    const int c = unit & 63, h = (unit >> 6) & 7, b = unit >> 9, tok0 = b * SEQ + c * 64;
    hgrn_scan_load(LF, tok0, h, tid, p.lf);
#pragma unroll
    for (int it = 0; it < 8; ++it) { const int idx = tid + 512 * it, k = idx & 127, s = 2 * (idx >> 7); const size_t g0 = (size_t)(tok0 + s) * 1024 + h * 128 + k;
        p.ka[it] = (unsigned)KA[g0] | ((unsigned)KA[g0 + 1024] << 16); p.va[it] = (unsigned)VA[g0] | ((unsigned)VA[g0 + 1024] << 16); }
}
__device__ __forceinline__ void phase_hgrn_h1(KP P, LAS unsigned char* lds) {
    unsigned char* ws = as_global(P->ws);
    const bf16_t* KA = (const bf16_t*)(ws + WS_KA); const bf16_t* VA = (const bf16_t*)(ws + WS_VA); const float* LF = (const float*)(ws + WS_LF);
    bf16_t* LT = (bf16_t*)(ws + WS_LT); float* DEC = (float*)(ws + WS_DEC);
    const int tid = tid_(), lane = tid & 63, wave = __builtin_amdgcn_readfirstlane(tid >> 6), r = lane & 31, hh = lane >> 5, G = nblk_();
    LAS float* cum = (LAS float*)lds; LAS float* tot = cum + 64 * CUM_LD;
    LAS bf16_t* kdT = (LAS bf16_t*)(tot + 512); LAS bf16_t* vT = kdT + 128 * OPS_LD;
    constexpr int NU = NBATCH * AH * 64;
    H1Pre pre; int unit = bid_();
    if (unit < NU) h1_load(KA, VA, LF, unit, tid, pre);
    for (; unit < NU; unit += G) {
        hgrn_scan_cum(pre.lf, cum, tot, tid);
#pragma unroll
        for (int it = 0; it < 8; ++it) { const int idx = tid + 512 * it, k = idx & 127, sp = idx >> 7, s = 2 * sp;
            const float last = cum[63 * CUM_LD + k];
            const float k0 = __uint_as_float(pre.ka[it] << 16) * __expf(last - cum[s * CUM_LD + k]), k1 = __uint_as_float(pre.ka[it] & 0xffff0000u) * __expf(last - cum[(s + 1) * CUM_LD + k]);
            *(LAS unsigned*)(kdT + k * OPS_LD + s) = pg8::cvt_pk_bf16(k0, k1);
            *(LAS unsigned*)(vT + k * OPS_LD + s) = pre.va[it]; }
        if (tid < 128) DEC[(size_t)unit * 128 + tid] = __expf(cum[63 * CUM_LD + tid]);
        if (unit + G < NU) h1_load(KA, VA, LF, unit + G, tid, pre);
        __syncthreads();
        const int mb = wave >> 1, nb0 = (wave & 1) * 2;
        f32x16_t acc[2];
#pragma unroll
        for (int n = 0; n < 2; ++n)
#pragma unroll
            for (int i = 0; i < 16; ++i) acc[n][i] = 0.f;
#pragma unroll
        for (int ks = 0; ks < 4; ++ks) { const bf16x8_t a = *(const LAS bf16x8_t*)(kdT + (32 * mb + r) * OPS_LD + 16 * ks + 8 * hh);
#pragma unroll
            for (int n = 0; n < 2; ++n) { const bf16x8_t bb = *(const LAS bf16x8_t*)(vT + (32 * (nb0 + n) + r) * OPS_LD + 16 * ks + 8 * hh);
                acc[n] = __builtin_amdgcn_mfma_f32_32x32x16_bf16(a, bb, acc[n], 0, 0, 0); } }
#pragma unroll
        for (int n = 0; n < 2; ++n) { bf16_t* dst = LT + (size_t)unit * 16384 + (size_t)(32 * (nb0 + n) + r) * 128 + 32 * mb + 4 * hh;
#pragma unroll
            for (int g = 0; g < 4; ++g) { pg8::u32x2 o; o.x = pg8::cvt_pk_bf16(acc[n][4 * g], acc[n][4 * g + 1]); o.y = pg8::cvt_pk_bf16(acc[n][4 * g + 2], acc[n][4 * g + 3]); *(pg8::u32x2*)(dst + 8 * g) = o; } }
        __syncthreads();
    }
}

__device__ __forceinline__ void phase_hgrn_h2(KP P) {
    unsigned char* ws = as_global(P->ws);
    const bf16_t* LT = (const bf16_t*)(ws + WS_LT); const float* DEC = (const float*)(ws + WS_DEC); bf16_t* PT = (bf16_t*)(ws + WS_PT);
    const int tid = tid_(), G = nblk_();
    for (int oct = bid_() * 512 + tid; oct < NBATCH * AH * 2048; oct += G * 512) {
        const int bh = oct >> 11, rem = oct & 2047, v = rem >> 4, k0 = (rem & 15) * 8;
        const size_t e0 = (size_t)bh * 64 * 16384 + (size_t)v * 128 + k0; const size_t d0 = (size_t)bh * 64 * 128 + k0;
        pg8::f32x4 S0 = {0.f, 0.f, 0.f, 0.f}, S1 = {0.f, 0.f, 0.f, 0.f};
        for (int c0 = 0; c0 < 64; c0 += 4) { pg8::u32x4 Lc[4]; pg8::f32x4 Da[4], Db[4];
#pragma unroll
            for (int j = 0; j < 4; ++j) { Lc[j] = *(const pg8::u32x4*)(LT + e0 + (size_t)(c0 + j) * 16384); Da[j] = *(const pg8::f32x4*)(DEC + d0 + (size_t)(c0 + j) * 128); Db[j] = *(const pg8::f32x4*)(DEC + d0 + (size_t)(c0 + j) * 128 + 4); }
#pragma unroll
            for (int j = 0; j < 4; ++j) { *(pg8::u32x4*)(PT + e0 + (size_t)(c0 + j) * 16384) = pg8::pack8(S0, S1);
                pg8::f32x4 l0, l1; pg8::unpack8(Lc[j], l0, l1); S0 = Da[j] * S0 + l0; S1 = Db[j] * S1 + l1; } }
    }
}

struct H3Pre { float lf[16]; unsigned qw[8], kw[8], vv[8]; bf16x8_t pt[8]; pg8::u32x2 ga[4]; };
__device__ __forceinline__ void h3_load(const bf16_t* QA, const bf16_t* KA, const bf16_t* VA, const bf16_t* GA, const float* LF, const bf16_t* PT, int unit, int tid, H3Pre& p) {
    const int c = unit & 63, h = (unit >> 6) & 7, b = unit >> 9, tok0 = b * SEQ + c * 64;
    const int lane = tid & 63, wave = __builtin_amdgcn_readfirstlane(tid >> 6), r = lane & 31, hh = lane >> 5, mb = wave >> 1, tb = wave & 1;
    hgrn_scan_load(LF, tok0, h, tid, p.lf);
#pragma unroll
    for (int it = 0; it < 8; ++it) { const int idx = tid + 512 * it, kp = (idx & 63) * 2, t = idx >> 6; const size_t g0 = (size_t)(tok0 + t) * 1024 + h * 128 + kp;
        p.qw[it] = *(const unsigned*)(QA + g0); p.kw[it] = *(const unsigned*)(KA + g0); }
#pragma unroll
    for (int it = 0; it < 8; ++it) { const int idx = tid + 512 * it, v = idx & 127, s = 2 * (idx >> 7); const size_t g0 = (size_t)(tok0 + s) * 1024 + h * 128 + v;
        p.vv[it] = (unsigned)VA[g0] | ((unsigned)VA[g0 + 1024] << 16); }
    const bf16_t* prow = PT + (size_t)unit * 16384 + (size_t)(32 * mb + r) * 128 + 8 * hh;
#pragma unroll
    for (int k8 = 0; k8 < 8; ++k8) p.pt[k8] = *(const bf16x8_t*)(prow + 16 * k8);
    const size_t orow = (size_t)(tok0 + 32 * tb + r) * 1024 + h * 128;
#pragma unroll
    for (int g = 0; g < 4; ++g) p.ga[g] = *(const pg8::u32x2*)(GA + orow + 32 * mb + 8 * g + 4 * hh);
}
__device__ __forceinline__ void phase_hgrn_h3(KP P, int layer, LAS unsigned char* lds) {
    unsigned char* ws = as_global(P->ws);
    const bf16_t* QA = (const bf16_t*)(ws + WS_QA); const bf16_t* KA = (const bf16_t*)(ws + WS_KA); const bf16_t* VA = (const bf16_t*)(ws + WS_VA); const bf16_t* GA = (const bf16_t*)(ws + WS_GA);
    const float* LF = (const float*)(ws + WS_LF); const bf16_t* PT = (const bf16_t*)(ws + WS_PT); bf16_t* YA = (bf16_t*)(ws + WS_YA);
    const float* ng = as_global(P->hnorm_g) + layer * 128;
    const int tid = tid_(), lane = tid & 63, wave = __builtin_amdgcn_readfirstlane(tid >> 6), r = lane & 31, hh = lane >> 5, G = nblk_();
    LAS float* cum = (LAS float*)lds; LAS float* tot = cum + 64 * CUM_LD; LAS float* ssq = tot + 512;
    LAS bf16_t* qd = (LAS bf16_t*)(ssq + 256); LAS bf16_t* qs = qd + 64 * OPK_LD; LAS bf16_t* ks = qs + 64 * OPK_LD; LAS bf16_t* vT = ks + 64 * OPK_LD;
    constexpr int NU = NBATCH * AH * 64;
    const int mb = wave >> 1, tb = wave & 1;
    H3Pre pre; int unit = bid_();
    if (unit < NU) h3_load(QA, KA, VA, GA, LF, PT, unit, tid, pre);
    for (; unit < NU; unit += G) {
        const int c = unit & 63, h = (unit >> 6) & 7, b = unit >> 9, tok0 = b * SEQ + c * 64;
#ifdef H3_DUP_SCAN
        { float tmp[16];
#pragma unroll
          for (int i = 0; i < 16; ++i) tmp[i] = pre.lf[i];
          hgrn_scan_cum(tmp, cum, tot, tid); }
#endif
        hgrn_scan_cum(pre.lf, cum, tot, tid);
#ifdef H3_DUP_BUILD
        for (int rep_b = 0; rep_b < 2; ++rep_b) {
#else
        {
#endif
#pragma unroll
        for (int it = 0; it < 8; ++it) { const int idx = tid + 512 * it, kp = (idx & 63) * 2, t = idx >> 6;
            const unsigned qw = pre.qw[it], kw = pre.kw[it];
            const float c0 = cum[t * CUM_LD + kp], c1 = cum[t * CUM_LD + kp + 1], r0 = cum[31 * CUM_LD + kp], r1 = cum[31 * CUM_LD + kp + 1];
            const float q0 = __uint_as_float(qw << 16), q1 = __uint_as_float(qw & 0xffff0000u), k0 = __uint_as_float(kw << 16), k1 = __uint_as_float(kw & 0xffff0000u);
            *(LAS unsigned*)(qd + t * OPK_LD + kp) = pg8::cvt_pk_bf16(q0 * __expf(c0), q1 * __expf(c1));
            *(LAS unsigned*)(qs + t * OPK_LD + kp) = pg8::cvt_pk_bf16(q0 * __expf(c0 - r0), q1 * __expf(c1 - r1));
            *(LAS unsigned*)(ks + t * OPK_LD + kp) = pg8::cvt_pk_bf16(k0 * __expf(r0 - c0), k1 * __expf(r1 - c1)); }
#pragma unroll
        for (int it = 0; it < 8; ++it) { const int idx = tid + 512 * it, v = idx & 127, s = 2 * (idx >> 7); *(LAS unsigned*)(vT + v * OPS_LD + s) = pre.vv[it]; }
        }
        bf16x8_t ptc[8]; pg8::u32x2 gac[4];
#pragma unroll
        for (int k8 = 0; k8 < 8; ++k8) ptc[k8] = pre.pt[k8];
#pragma unroll
        for (int g = 0; g < 4; ++g) gac[g] = pre.ga[g];
        if (unit + G < NU) h3_load(QA, KA, VA, GA, LF, PT, unit + G, tid, pre);
        __syncthreads();
        f32x16_t acc;
#ifdef H3_DUP_MMA
        for (int rep_m = 0; rep_m < 2; ++rep_m) {
#else
        {
#endif
#pragma unroll
        for (int i = 0; i < 16; ++i) acc[i] = 0.f;
#pragma unroll
        for (int k8 = 0; k8 < 8; ++k8) { const bf16x8_t bq = *(const LAS bf16x8_t*)(qd + (32 * tb + r) * OPK_LD + 16 * k8 + 8 * hh);
            acc = __builtin_amdgcn_mfma_f32_32x32x16_bf16(ptc[k8], bq, acc, 0, 0, 0); }
#pragma unroll
        for (int sb = 0; sb < 2; ++sb) if (sb <= tb) {
            f32x16_t sc;
#pragma unroll
            for (int i = 0; i < 16; ++i) sc[i] = 0.f;
#pragma unroll
            for (int k8 = 0; k8 < 8; ++k8) { const bf16x8_t a = *(const LAS bf16x8_t*)(ks + (32 * sb + r) * OPK_LD + 16 * k8 + 8 * hh); const bf16x8_t bq = *(const LAS bf16x8_t*)(qs + (32 * tb + r) * OPK_LD + 16 * k8 + 8 * hh);
                sc = __builtin_amdgcn_mfma_f32_32x32x16_bf16(a, bq, sc, 0, 0, 0); }
            if (sb == tb) {
#pragma unroll
                for (int i = 0; i < 16; ++i) { const int sl = 8 * (i >> 2) + 4 * hh + (i & 3); sc[i] = (sl <= r) ? sc[i] : 0.f; } }
#pragma unroll
            for (int u = 0; u < 2; ++u) {
                pg8::u32x4 pw; pw.x = pg8::cvt_pk_bf16(sc[8 * u], sc[8 * u + 1]); pw.y = pg8::cvt_pk_bf16(sc[8 * u + 2], sc[8 * u + 3]); pw.z = pg8::cvt_pk_bf16(sc[8 * u + 4], sc[8 * u + 5]); pw.w = pg8::cvt_pk_bf16(sc[8 * u + 6], sc[8 * u + 7]);
                const bf16x8_t pb = __builtin_bit_cast(bf16x8_t, pw);
                const LAS bf16_t* vrow = vT + (32 * mb + r) * OPS_LD + 32 * sb + 16 * u + 4 * hh;
                const bf16x4_t lo = *(const LAS bf16x4_t*)vrow, hi4 = *(const LAS bf16x4_t*)(vrow + 8);
                const bf16x8_t va = {lo[0], lo[1], lo[2], lo[3], hi4[0], hi4[1], hi4[2], hi4[3]};
                acc = __builtin_amdgcn_mfma_f32_32x32x16_bf16(va, pb, acc, 0, 0, 0); }
        }
        }
        float ss = 0.f;
#pragma unroll
        for (int i = 0; i < 16; ++i) ss += acc[i] * acc[i];
        ss += __shfl_xor(ss, 32);
        if (hh == 0) ssq[mb * 64 + 32 * tb + r] = ss;
        __syncthreads();
        const int t = 32 * tb + r;
        const float tot2 = (ssq[t] + ssq[64 + t]) + (ssq[128 + t] + ssq[192 + t]);
        const float rs = 1.0f / sqrtf(tot2 * (1.0f / 128.0f) + RMS_EPS);
        const size_t orow = (size_t)(tok0 + t) * 1024 + h * 128;
#pragma unroll
        for (int g = 0; g < 4; ++g) { const int v0 = 32 * mb + 8 * g + 4 * hh;
            const pg8::u32x2 gw = gac[g]; const pg8::f32x4 nv = *(const pg8::f32x4*)(ng + v0);
            const float y0 = acc[4 * g] * rs * nv[0] * __uint_as_float(gw.x << 16), y1 = acc[4 * g + 1] * rs * nv[1] * __uint_as_float(gw.x & 0xffff0000u);
            const float y2 = acc[4 * g + 2] * rs * nv[2] * __uint_as_float(gw.y << 16), y3 = acc[4 * g + 3] * rs * nv[3] * __uint_as_float(gw.y & 0xffff0000u);
            pg8::u32x2 w; w.x = pg8::cvt_pk_bf16(y0, y1); w.y = pg8::cvt_pk_bf16(y2, y3); *(pg8::u32x2*)(YA + orow + v0) = w; }
        __syncthreads();
    }
}
namespace at {
constexpr int D = 128, NW = 8, QBLK = 32, KVBLK = 64, LDQ = 1024, LDK = 1024;
constexpr float SCALE = ATTN_SCALE, THR = 8.f;
constexpr size_t SHM_V = KVBLK * D * 2, SHM_K = KVBLK * D * 2, SHM_ATTN = 2 * SHM_V + 2 * SHM_K + NW * 64 * 4;
using bf16x8 = __attribute__((ext_vector_type(8))) short;
using s16x4  = __attribute__((ext_vector_type(4))) short;
using f32x16 = __attribute__((ext_vector_type(16))) float;
using u32x4  = __attribute__((ext_vector_type(4))) unsigned;
#define AT_KSWZ(row, colB) ((row) * 256 + ((colB) ^ (((row) & 7) << 4)))
#define AT_SBAR() __builtin_amdgcn_sched_barrier(0)
__device__ __forceinline__ int crow(int r, int hi) { return (r & 3) + 8 * (r >> 2) + 4 * hi; }
__device__ __forceinline__ unsigned cvtpk(float lo, float hi) { return pg8::cvt_pk_bf16(lo, hi); }

__device__ __forceinline__ void partialSM(f32x16& p0, f32x16& p1, float& m_reg, float& mn, float& alpha) {
  constexpr float C = SCALE * 1.4426950408889634f;
  float pmax = p0[0];
#pragma unroll
  for (int r = 1; r < 16; ++r) pmax = fmaxf(pmax, p0[r]);
#pragma unroll
  for (int r = 0; r < 16; ++r) pmax = fmaxf(pmax, p1[r]);
  { auto rr = __builtin_amdgcn_permlane32_swap(__float_as_uint(pmax), __float_as_uint(pmax), false, false);
    pmax = fmaxf(__uint_as_float(rr[0]), __uint_as_float(rr[1])); }
  if (__builtin_expect(__all(pmax - m_reg <= THR / SCALE), 1)) { mn = m_reg; alpha = 1.f; }
  else { mn = fmaxf(m_reg, pmax); alpha = __builtin_amdgcn_exp2f((m_reg - mn) * C); m_reg = mn; }
  float mnC = -mn * C;
#pragma unroll
  for (int r = 0; r < 16; ++r) p0[r] = fmaf(p0[r], C, mnC);
#pragma unroll
  for (int r = 0; r < 16; ++r) p1[r] = fmaf(p1[r], C, mnC);
#pragma unroll
  for (int r = 0; r < 16; ++r) p0[r] = __builtin_amdgcn_exp2f(p0[r]);
}
__device__ __forceinline__ void finishSM(f32x16& p0, f32x16& p1, float alpha, float& l_reg, int mlo, int mhi, bf16x8& pa0, bf16x8& pa1, bf16x8& pa2, bf16x8& pa3) {
#pragma unroll
  for (int r = 0; r < 16; ++r) p1[r] = __builtin_amdgcn_exp2f(p1[r]);
#pragma unroll
  for (int r = 0; r < 16; ++r) { const int bit = (r & 3) + 8 * (r >> 2);
    p0[r] = __uint_as_float(__float_as_uint(p0[r]) & (unsigned)__builtin_amdgcn_sbfe(mlo, bit, 1));
    p1[r] = __uint_as_float(__float_as_uint(p1[r]) & (unsigned)__builtin_amdgcn_sbfe(mhi, bit, 1)); }
  float ps = 0;
#pragma unroll
  for (int r = 0; r < 16; ++r) ps += p0[r];
#pragma unroll
  for (int r = 0; r < 16; ++r) ps += p1[r];
  { auto rr = __builtin_amdgcn_permlane32_swap(__float_as_uint(ps), __float_as_uint(ps), false, false);
    ps = __uint_as_float(rr[0]) + __uint_as_float(rr[1]); }
  l_reg = l_reg * alpha + ps;
#define AT_PK4(P, BASE, OUT) do { unsigned a0 = cvtpk(P[BASE + 0], P[BASE + 1]), a1 = cvtpk(P[BASE + 2], P[BASE + 3]);   \
    unsigned b0 = cvtpk(P[BASE + 4], P[BASE + 5]), b1 = cvtpk(P[BASE + 6], P[BASE + 7]);                              \
    auto r0 = __builtin_amdgcn_permlane32_swap(a0, b0, false, false); auto r1 = __builtin_amdgcn_permlane32_swap(a1, b1, false, false); \
    u32x4 w = {r0[0], r1[0], r0[1], r1[1]}; OUT = *reinterpret_cast<bf16x8*>(&w); } while (0)
  AT_PK4(p0, 0, pa0); AT_PK4(p0, 8, pa1); AT_PK4(p1, 0, pa2); AT_PK4(p1, 8, pa3);
#undef AT_PK4
}
__device__ __forceinline__ void qkt(f32x16& p0, f32x16& p1, const LAS char* Ks, const bf16x8* qr, int r32, int hi) {
  p0 = f32x16{}; p1 = f32x16{};
#pragma unroll
  for (int d0 = 0; d0 < 8; ++d0) { int cb = (d0 * 16 + hi * 8) * 2;
    bf16x8 b0 = *reinterpret_cast<const LAS bf16x8*>(Ks + AT_KSWZ(r32, cb));
    bf16x8 b1 = *reinterpret_cast<const LAS bf16x8*>(Ks + AT_KSWZ(32 + r32, cb));
    p0 = __builtin_amdgcn_mfma_f32_32x32x16_bf16(b0, qr[d0], p0, 0, 0, 0);
    p1 = __builtin_amdgcn_mfma_f32_32x32x16_bf16(b1, qr[d0], p1, 0, 0, 0); }
}
__device__ __forceinline__ int v_st(int k, int c) { const int kk = (k & ~0xC) | ((k & 4) << 1) | ((k & 8) >> 1); return ((kk >> 3) * 4 + (c >> 5)) * 512 + ((kk & 7) * 32 + (c & 31)) * 2; }
__device__ __forceinline__ int v_rd_base(int lane) { return ((lane & 3) << 3) | (((lane >> 2) & 3) << 6) | (((lane >> 4) & 1) << 5) | (((lane >> 5) & 1) << 8); }
constexpr int v_rd_off(int d0, int ks, int half) { return d0 * 512 + ks * 4096 + half * 2048; }
template <int OFF> __device__ __forceinline__ s16x4 tr_read(int vb) {
  s16x4 r; asm volatile("ds_read_b64_tr_b16 %0, %1 offset:%2" : "=&v"(r) : "v"(vb), "i"(OFF) : "memory"); return r;
}
template <int D0> __device__ __forceinline__ void pv_one(f32x16& od, int vb, bf16x8 pa0, bf16x8 pa1, bf16x8 pa2, bf16x8 pa3) {
  const s16x4 l0 = tr_read<v_rd_off(D0, 0, 0)>(vb), h0 = tr_read<v_rd_off(D0, 0, 1)>(vb), l1 = tr_read<v_rd_off(D0, 1, 0)>(vb), h1 = tr_read<v_rd_off(D0, 1, 1)>(vb);
  const s16x4 l2 = tr_read<v_rd_off(D0, 2, 0)>(vb), h2 = tr_read<v_rd_off(D0, 2, 1)>(vb), l3 = tr_read<v_rd_off(D0, 3, 0)>(vb), h3 = tr_read<v_rd_off(D0, 3, 1)>(vb);
  asm volatile("s_waitcnt lgkmcnt(0)" ::: "memory"); AT_SBAR();
#define AT_PK(L_, H_) (bf16x8){L_[0], L_[1], L_[2], L_[3], H_[0], H_[1], H_[2], H_[3]}
  od = __builtin_amdgcn_mfma_f32_32x32x16_bf16(pa0, AT_PK(l0, h0), od, 0, 0, 0);
  od = __builtin_amdgcn_mfma_f32_32x32x16_bf16(pa1, AT_PK(l1, h1), od, 0, 0, 0);
  od = __builtin_amdgcn_mfma_f32_32x32x16_bf16(pa2, AT_PK(l2, h2), od, 0, 0, 0);
  od = __builtin_amdgcn_mfma_f32_32x32x16_bf16(pa3, AT_PK(l3, h3), od, 0, 0, 0);
#undef AT_PK
}
__device__ __forceinline__ void pv_d0(f32x16* o, int vb, bf16x8 pa0, bf16x8 pa1, bf16x8 pa2, bf16x8 pa3) {
  pv_one<0>(o[0], vb, pa0, pa1, pa2, pa3); pv_one<1>(o[1], vb, pa0, pa1, pa2, pa3); pv_one<2>(o[2], vb, pa0, pa1, pa2, pa3); pv_one<3>(o[3], vb, pa0, pa1, pa2, pa3);
}

__device__ __forceinline__ void attn_masked_body(const bf16_t* __restrict__ Qb, const bf16_t* __restrict__ Kh, const bf16_t* __restrict__ Vh, const unsigned long long* __restrict__ Mq,
                                                 bf16_t* __restrict__ Ob, int seq, LAS char* lds, int tid) {
  const int wid = __builtin_amdgcn_readfirstlane(tid >> 6), lane = tid & 63, r32 = lane & 31, hi = lane >> 5;
  LAS char* V_lds = lds; LAS char* K_lds = lds + 2 * SHM_V;
  LAS float* wsf = (LAS float*)(lds + 2 * SHM_V + 2 * SHM_K) + wid * 64; LAS float* li_l = wsf; LAS float* al_l = wsf + 32;
  float m_reg = -1e30f, l_reg = 0; f32x16 o[4] = {}; bf16x8 qr[8];
  const bf16_t* Qw = Qb + (long)(wid * QBLK + r32) * LDQ + hi * 8;
#pragma unroll
  for (int d0 = 0; d0 < 8; ++d0) qr[d0] = *reinterpret_cast<const bf16x8*>(Qw + d0 * 16);
  const unsigned long long* mrow = Mq + (size_t)(wid * QBLK + r32) * 64;
  const int sr = tid >> 4, sc = (tid & 15) * 8, vst0 = v_st(sr, sc), vst1 = v_st(32 + sr, sc);
  const int vb0 = (int)(uintptr_t)V_lds + v_rd_base(lane);
  struct { bf16x8 vs0, vs1, ks0, ks1; } sr_[2];
#define AT_SLOAD(i, k0) do { sr_[i].vs0 = *reinterpret_cast<const bf16x8*>(&Vh[(long)((k0) + sr) * LDK + sc]); sr_[i].vs1 = *reinterpret_cast<const bf16x8*>(&Vh[(long)((k0) + 32 + sr) * LDK + sc]); \
    sr_[i].ks0 = *reinterpret_cast<const bf16x8*>(&Kh[(long)((k0) + sr) * LDK + sc]); sr_[i].ks1 = *reinterpret_cast<const bf16x8*>(&Kh[(long)((k0) + 32 + sr) * LDK + sc]); } while (0)
#define AT_SWRITE(b, i) do { *(LAS bf16x8*)(V_lds + (b) * SHM_V + vst0) = sr_[i].vs0;          \
    *(LAS bf16x8*)(V_lds + (b) * SHM_V + vst1) = sr_[i].vs1; int kc = sc * 2;               \
    *(LAS bf16x8*)(K_lds + (b) * SHM_K + AT_KSWZ(sr, kc)) = sr_[i].ks0;                       \
    *(LAS bf16x8*)(K_lds + (b) * SHM_K + AT_KSWZ(32 + sr, kc)) = sr_[i].ks1; } while (0)
#define AT_SWAIT() asm volatile("s_waitcnt vmcnt(4)" ::: "memory")
#define AT_RESC(a) do { if (__any((a) < 1.f)) { if (hi == 0) al_l[r32] = (a); asm volatile("s_waitcnt lgkmcnt(0)" ::: "memory"); \
    _Pragma("unroll") for (int d = 0; d < 4; ++d) _Pragma("unroll") for (int r = 0; r < 16; ++r) o[d][r] *= al_l[crow(r, hi)]; } } while (0)
#define AT_MLOAD(mw, j) do { const unsigned long long _w = mrow[(j)]; (mw##lo) = (int)((unsigned)_w >> (4 * hi)); (mw##hi) = (int)((unsigned)(_w >> 32) >> (4 * hi)); } while (0)
  f32x16 pA0, pA1, pB0, pB1; float mnA, mnB, alA, alB; bf16x8 pa0, pa1, pa2, pa3; const int NT = seq / KVBLK;
  int mAlo, mAhi, mBlo, mBhi;
  constexpr int SE = 0, SO = 1;
  AT_SLOAD(SE, 0); AT_MLOAD(mA, 0); asm volatile("s_waitcnt vmcnt(0)" ::: "memory"); AT_SWRITE(0, SE); __syncthreads();
  qkt(pA0, pA1, K_lds, qr, r32, hi); partialSM(pA0, pA1, m_reg, mnA, alA);
  AT_SLOAD(SO, KVBLK); if (2 < NT) AT_SLOAD(SE, 2 * KVBLK);
  AT_SWAIT(); AT_SWRITE(1, SO); __syncthreads();
  for (int j = 1; j + 1 < NT; j += 2) {
    AT_SBAR(); AT_MLOAD(mB, j); qkt(pB0, pB1, K_lds + SHM_K, qr, r32, hi);
    finishSM(pA0, pA1, alA, l_reg, mAlo, mAhi, pa0, pa1, pa2, pa3); AT_SBAR();
    AT_SLOAD(SO, (j + 2) * KVBLK); AT_SBAR();
    pv_d0(o, vb0, pa0, pa1, pa2, pa3); partialSM(pB0, pB1, m_reg, mnB, alB);
    __syncthreads(); AT_SWAIT(); AT_SWRITE(0, SE);
    AT_RESC(alB); __syncthreads();
    AT_SBAR(); AT_MLOAD(mA, j + 1); qkt(pA0, pA1, K_lds, qr, r32, hi);
    finishSM(pB0, pB1, alB, l_reg, mBlo, mBhi, pa0, pa1, pa2, pa3); AT_SBAR();
    if (j + 3 < NT) AT_SLOAD(SE, (j + 3) * KVBLK); AT_SBAR();
    pv_d0(o, vb0 + (int)SHM_V, pa0, pa1, pa2, pa3); partialSM(pA0, pA1, m_reg, mnA, alA);
    __syncthreads(); AT_SWAIT(); AT_SWRITE(1, SO);
    AT_RESC(alA); __syncthreads();
  }
  AT_SBAR(); AT_MLOAD(mB, NT - 1); qkt(pB0, pB1, K_lds + SHM_K, qr, r32, hi);
  finishSM(pA0, pA1, alA, l_reg, mAlo, mAhi, pa0, pa1, pa2, pa3); AT_SBAR();
  pv_d0(o, vb0, pa0, pa1, pa2, pa3); partialSM(pB0, pB1, m_reg, mnB, alB);
  __syncthreads(); AT_RESC(alB);
  finishSM(pB0, pB1, alB, l_reg, mBlo, mBhi, pa0, pa1, pa2, pa3); AT_SBAR();
  pv_d0(o, vb0 + (int)SHM_V, pa0, pa1, pa2, pa3);
  if (hi == 0) li_l[r32] = l_reg; asm volatile("s_waitcnt lgkmcnt(0)" ::: "memory");
  float rli[16];
#pragma unroll
  for (int r = 0; r < 16; ++r) rli[r] = __builtin_amdgcn_rcpf(li_l[crow(r, hi)]);
  bf16_t* Ow = Ob + (long)(wid * QBLK) * LDQ;
#pragma unroll
  for (int r = 0; r < 16; ++r) { const int orow = crow(r, hi);
#pragma unroll
    for (int d0 = 0; d0 < 4; ++d0) Ow[(long)orow * LDQ + d0 * 32 + r32] = f2bf(o[d0][r] * rli[r]); }
#undef AT_SLOAD
#undef AT_SWRITE
#undef AT_SWAIT
#undef AT_RESC
#undef AT_MLOAD
}
}

__device__ __forceinline__ void phase_attn(KP P, LAS unsigned char* lds) {
    unsigned char* ws = as_global(P->ws);
    const bf16_t* QB = (const bf16_t*)(ws + WS_QB); const bf16_t* KB = (const bf16_t*)(ws + WS_KB); const bf16_t* VB = (const bf16_t*)(ws + WS_VB);
    const unsigned long long* MASK = (const unsigned long long*)(ws + WS_MASK); bf16_t* YB = (bf16_t*)(ws + WS_YB);
    const int G = nblk_();
    for (int p = bid_(); p < 256; p += G) {
        const int bh = p >> 3, b = bh >> 3, h = bh & 7, x = p & 7;
#pragma unroll 1
        for (int half = 0; half < 2; ++half) { const int qb = half ? 15 - x : x; const size_t row0 = (size_t)b * SEQ + (size_t)qb * 256;
            at::attn_masked_body(QB + row0 * 1024 + h * 128, KB + (size_t)b * SEQ * 1024 + h * 128, VB + (size_t)b * SEQ * 1024 + h * 128, MASK + row0 * 64,
                                 YB + row0 * 1024 + h * 128, 256 * (qb + 1), (LAS char*)lds, tid_());
            __syncthreads(); }
    }
}
constexpr int IXK = 512, IX_LD = 144;
__device__ __forceinline__ void idx_unit(const bf16_t* QI, const bf16_t* KI, const float* WI, float* Sc, int b, int c, int half, int tid, LAS unsigned char* lds) {
    const int lane = tid & 63, wave = __builtin_amdgcn_readfirstlane(tid >> 6), r = lane & 31, hh = lane >> 5, nk = 64 * (c + 1);
    const int s0 = c * 64 + half * 32 + wave * 4;
    const int aq = (r >> 2) & 1, ahead = (r & 3) + 4 * (r >> 3);
    bf16x8_t A[2][4]; float wv[2][16];
#pragma unroll
    for (int rt = 0; rt < 2; ++rt) { const size_t qrow = (size_t)b * SEQ + s0 + 2 * rt + aq;
#pragma unroll
        for (int ks = 0; ks < 4; ++ks) A[rt][ks] = *(const bf16x8_t*)(QI + qrow * 1024 + ahead * 64 + 16 * ks + 8 * hh);
        const float* wp = WI + ((size_t)b * SEQ + s0 + 2 * rt + hh) * 16;
#pragma unroll
        for (int i4 = 0; i4 < 4; ++i4) { const pg8::f32x4 w4 = *(const pg8::f32x4*)(wp + 4 * i4); wv[rt][4 * i4] = w4[0]; wv[rt][4 * i4 + 1] = w4[1]; wv[rt][4 * i4 + 2] = w4[2]; wv[rt][4 * i4 + 3] = w4[3]; } }
    float* srow[2];
#pragma unroll
    for (int rt = 0; rt < 2; ++rt) srow[rt] = Sc + (size_t)b * SCORE_B + (size_t)2048 * c * (c + 1) + (size_t)((s0 + 2 * rt + hh) & 63) * nk + r;
    const bf16_t* kbase = KI + (size_t)b * SEQ * 64;
    const int nblk = (nk + IXK - 1) / IXK;
    pg8::u32x4 stg[8];
#define IX_LOAD(kb) do { _Pragma("unroll") for (int i = 0; i < 8; ++i) { const int p = tid + 512 * i; int key = (kb) * IXK + (p >> 3); key = key < nk ? key : nk - 1; \
        stg[i] = *(const pg8::u32x4*)(kbase + (size_t)key * 64 + (p & 7) * 8); } } while (0)
#define IX_STORE() do { _Pragma("unroll") for (int i = 0; i < 8; ++i) { const int p = tid + 512 * i; *(LAS pg8::u32x4*)(lds + (p >> 3) * IX_LD + (p & 7) * 16) = stg[i]; } } while (0)
    IX_LOAD(0);
    for (int kb = 0; kb < nblk; ++kb) {
        __syncthreads();
        IX_STORE();
        __syncthreads();
        if (kb + 1 < nblk) IX_LOAD(kb + 1);
        const int ntile = (nk - kb * IXK < IXK ? nk - kb * IXK : IXK) / 32;
        for (int t = 0; t < ntile; ++t) { bf16x8_t Bc[4];
#pragma unroll
            for (int ks = 0; ks < 4; ++ks) Bc[ks] = *(const LAS bf16x8_t*)(lds + (32 * t + r) * IX_LD + (16 * ks + 8 * hh) * 2);
#pragma unroll
            for (int rt = 0; rt < 2; ++rt) { f32x16_t acc;
#pragma unroll
                for (int i = 0; i < 16; ++i) acc[i] = 0.f;
#pragma unroll
                for (int ks = 0; ks < 4; ++ks) acc = __builtin_amdgcn_mfma_f32_32x32x16_bf16(A[rt][ks], Bc[ks], acc, 0, 0, 0);
                float sc = 0.f;
#pragma unroll
                for (int i = 0; i < 16; ++i) sc = fmaf(wv[rt][i], fmaxf(acc[i], 0.f), sc);
                srow[rt][kb * IXK + t * 32] = sc; } }
    }
#undef IX_LOAD
#undef IX_STORE
}
__device__ __forceinline__ void phase_idx(KP P, LAS unsigned char* lds) {
    unsigned char* ws = as_global(P->ws);
    const bf16_t* QI = (const bf16_t*)(ws + WS_QI); const bf16_t* KI = (const bf16_t*)(ws + WS_KI); const float* WI = (const float*)(ws + WS_WI); float* Sc = (float*)(ws + WS_S);
    const int G = nblk_();
    for (int item = bid_(); item < 240; item += G) {
        const int pi = item % 30, combo = item / 30, b = combo >> 1, half = combo & 1;
        idx_unit(QI, KI, WI, Sc, b, 4 + pi, half, tid_(), lds); __syncthreads();
        idx_unit(QI, KI, WI, Sc, b, 63 - pi, half, tid_(), lds); __syncthreads();
    }
}
__device__ __forceinline__ const float* sel_row(const float* S, int q, int& nw) {
    const int b = q >> 12, s = q & 4095, c = s >> 6; nw = c + 1;
    return S + (size_t)b * SCORE_B + (size_t)2048 * c * (c + 1) + (size_t)(s & 63) * (nw * 64);
}
__device__ __forceinline__ void sel_load(const float* row, int nw, int lane, float (&f)[64]) {
    if (nw > 32) {
#pragma unroll
        for (int j = 0; j < 64; ++j) { const int jc = j < nw ? j : nw - 1; f[j] = row[jc * 64 + lane]; }
    } else {
#pragma unroll
        for (int j = 0; j < 32; ++j) { const int jc = j < nw ? j : nw - 1; f[j] = row[jc * 64 + lane]; }
#pragma unroll
        for (int j = 32; j < 64; ++j) f[j] = 0.f;
    }
}
__device__ __forceinline__ void phase_select(KP P, LAS unsigned char* lds) {
    unsigned char* ws = as_global(P->ws); const float* S = (const float*)(ws + WS_S); unsigned long long* MASK = (unsigned long long*)(ws + WS_MASK);
    const int tid = tid_(), wave = __builtin_amdgcn_readfirstlane(tid >> 6), lane = tid & 63, nb8 = nblk_() * 8;
    LAS unsigned long long* sm = (LAS unsigned long long*)lds + wave * 64;
    float f[64]; int it = (bid_() * 8 + wave) * 8, nw = 0; const float* row = nullptr;
    const int itstep = nb8 * 8 - 7;
#define SEL_Q(it_) ((((it_) >> 3) & 3) * 4096 + ((it_) >> 5) + 512 * ((it_) & 7))
    int q = it < TOK ? SEL_Q(it) : TOK;
    if (q < TOK) { row = sel_row(S, q, nw); if (nw > TOPK / 64) sel_load(row, nw, lane, f); }
    while (q < TOK) {
        unsigned long long myword = 0ull;
        const int itn = ((it & 7) == 7) ? it + itstep : it + 1; const int qn = itn < TOK ? SEL_Q(itn) : TOK; int nwn = 0; const float* rown = nullptr;
        if (nw <= TOPK / 64) {
            myword = (lane < nw) ? ~0ull : 0ull;
            if (qn < TOK) { rown = sel_row(S, qn, nwn); if (nwn > TOPK / 64) sel_load(rown, nwn, lane, f); }
        } else {
            unsigned u[64];
#pragma unroll
            for (int j = 0; j < 64; ++j) { const unsigned bits = __float_as_uint(f[j]); const unsigned v = (bits & 0x80000000u) ? ~bits : (bits | 0x80000000u); u[j] = (j < nw) ? v : 0u; }
            if (qn < TOK) { rown = sel_row(S, qn, nwn); if (nwn > TOPK / 64) sel_load(rown, nwn, lane, f); }
            unsigned prefix = 0u;
            for (int bit = 31; bit >= 0; --bit) { const unsigned cand = prefix | (1u << bit); int cnt = 0;
#pragma unroll
                for (int j8 = 0; j8 < 8; ++j8) if (j8 * 8 < nw) { unsigned long long bl[8];
#pragma unroll
                    for (int jj = 0; jj < 8; ++jj) bl[jj] = __ballot(u[j8 * 8 + jj] >= cand);
                    asm volatile("" : "+s"(bl[0]), "+s"(bl[1]), "+s"(bl[2]), "+s"(bl[3]), "+s"(bl[4]), "+s"(bl[5]), "+s"(bl[6]), "+s"(bl[7]));
#pragma unroll
                    for (int jj = 0; jj < 8; ++jj) cnt += __popcll(bl[jj]); }
                if (cnt >= TOPK) prefix = cand; }
#pragma unroll
            for (int j = 0; j < 64; ++j) { const unsigned long long w = __ballot(u[j] >= prefix); if (lane == 0) sm[j] = w; }
            myword = sm[lane];
        }
        MASK[(size_t)q * 64 + lane] = myword;
        q = qn; it = itn; nw = nwn; row = rown;
    }
#undef SEL_Q
}

__device__ __forceinline__ void phase_hgrn_naive(KP P, int layer, LAS unsigned char* lds) {
    unsigned char* ws = as_global(P->ws);
    const bf16_t* QA = (const bf16_t*)(ws + WS_QA); const bf16_t* KA = (const bf16_t*)(ws + WS_KA); const bf16_t* VA = (const bf16_t*)(ws + WS_VA); const bf16_t* GA = (const bf16_t*)(ws + WS_GA);
    const float* LF = (const float*)(ws + WS_LF); bf16_t* YA = (bf16_t*)(ws + WS_YA);
    const int tid = tid_(), bh = bid_(), b = bh >> 3, h = bh & 7, v = tid & 127; const bool act = (bh < 32) && (tid < 128);
    if (bh >= 32) return;
    LAS float* sf = (LAS float*)lds; LAS float* sk = sf + 16 * 128; LAS float* sq = sk + 16 * 128; LAS float* red = sq + 16 * 128;
    float S[128];
#pragma unroll
    for (int k = 0; k < 128; ++k) S[k] = 0.f;
    const float ng = as_global(P->hnorm_g)[layer * 128 + v];
    for (int t0 = 0; t0 < SEQ; t0 += 16) {
        if (act) for (int i = 0; i < 16; ++i) { const size_t idx = ((size_t)(b * SEQ + t0 + i)) * 1024 + h * 128 + v; sf[i * 128 + v] = expf(LF[idx]); sk[i * 128 + v] = bf2f(KA[idx]); sq[i * 128 + v] = bf2f(QA[idx]); }
        __syncthreads();
        for (int i = 0; i < 16; ++i) { const size_t idx = ((size_t)(b * SEQ + t0 + i)) * 1024 + h * 128 + v; float o = 0.f;
            if (act) { const float vt = bf2f(VA[idx]);
#pragma unroll
                for (int k = 0; k < 128; ++k) { S[k] = sf[i * 128 + k] * S[k] + sk[i * 128 + k] * vt; o += S[k] * sq[i * 128 + k]; } }
            float ss = o * o;
#pragma unroll
            for (int m = 32; m >= 1; m >>= 1) ss += __shfl_xor(ss, m);
            if (act && (v & 63) == 0) red[v >> 6] = ss;
            __syncthreads();
            if (act) { const float tot = red[0] + red[1]; YA[idx] = f2bf(o * (1.0f / sqrtf(tot * (1.0f / 128.0f) + RMS_EPS)) * ng * bf2f(GA[idx])); }
            __syncthreads(); }
    }
}
__device__ __forceinline__ void phase_idx_naive(KP P, LAS unsigned char* lds) {
    unsigned char* ws = as_global(P->ws);
    const bf16_t* QI = (const bf16_t*)(ws + WS_QI); const bf16_t* KI = (const bf16_t*)(ws + WS_KI); const float* WI = (const float*)(ws + WS_WI); float* Sc = (float*)(ws + WS_S);
    const int tid = tid_(), G = nblk_();
    LAS float* qs = (LAS float*)lds; LAS float* wsh = qs + 1024;
    for (int q = bid_(); q < TOK; q += G) {
        const int b = q >> 12, s = q & 4095, c = s >> 6, nw = c + 1, nk = nw * 64;
        if (nw <= TOPK / 64) continue;
        __syncthreads();
        for (int i = tid; i < 1024; i += 512) qs[i] = bf2f(QI[(size_t)q * 1024 + i]);
        if (tid < 16) wsh[tid] = WI[(size_t)q * 16 + tid];
        __syncthreads();
        float* row = Sc + (size_t)b * SCORE_B + (size_t)2048 * c * (c + 1) + (size_t)(s & 63) * nk;
        for (int key = tid; key < nk; key += 512) {
            float kf[64]; const pg8::u32x4* kp = (const pg8::u32x4*)(KI + ((size_t)b * SEQ + key) * 64);
#pragma unroll
            for (int d8 = 0; d8 < 8; ++d8) { const pg8::u32x4 w = kp[d8]; pg8::f32x4 a, bb; pg8::unpack8(w, a, bb);
#pragma unroll
                for (int j = 0; j < 4; ++j) { kf[d8 * 8 + j] = a[j]; kf[d8 * 8 + 4 + j] = bb[j]; } }
            float sc = 0.f;
            for (int h = 0; h < 16; ++h) { float dot = 0.f;
#pragma unroll
                for (int d = 0; d < 64; ++d) dot += qs[h * 64 + d] * kf[d];
                sc += wsh[h] * fmaxf(dot, 0.f); }
            row[key] = sc;
        }
    }
}
__device__ __forceinline__ void phase_attn_naive(KP P, LAS unsigned char* lds) {
    unsigned char* ws = as_global(P->ws);
    const bf16_t* QB = (const bf16_t*)(ws + WS_QB); const bf16_t* KB = (const bf16_t*)(ws + WS_KB); const bf16_t* VB = (const bf16_t*)(ws + WS_VB);
    const unsigned long long* MASK = (const unsigned long long*)(ws + WS_MASK); bf16_t* YB = (bf16_t*)(ws + WS_YB);
    const int tid = tid_(), h = tid >> 6, lane = tid & 63, G = nblk_();
    LAS float* qs = (LAS float*)lds + h * 128; LAS int* keys = (LAS int*)((LAS float*)lds + 1024) + h * 320; LAS float* lg = (LAS float*)lds + 1024 + 8 * 320 + h * 320;
    for (int q = bid_(); q < TOK; q += G) {
        const int b = q >> 12, s = q & 4095, nw = (s >> 6) + 1;
        qs[lane] = bf2f(QB[(size_t)q * 1024 + h * 128 + lane]); qs[lane + 64] = bf2f(QB[(size_t)q * 1024 + h * 128 + 64 + lane]);
        int cnt = 0;
        for (int j = 0; j < nw; ++j) { const unsigned long long w = MASK[(size_t)q * 64 + j]; const bool on = (w >> lane) & 1ull; const int key = j * 64 + lane;
            if (on) { const pg8::u32x4* kp = (const pg8::u32x4*)(KB + ((size_t)b * SEQ + key) * 1024 + h * 128); float dot = 0.f;
                for (int d8 = 0; d8 < 16; ++d8) { pg8::f32x4 a, bb; pg8::unpack8(kp[d8], a, bb);
#pragma unroll
                    for (int j2 = 0; j2 < 4; ++j2) dot += qs[d8 * 8 + j2] * a[j2] + qs[d8 * 8 + 4 + j2] * bb[j2]; }
                const int pos = cnt + __popcll(w & ((1ull << lane) - 1ull));
                if (pos < 320) { keys[pos] = key; lg[pos] = dot * ATTN_SCALE; } }
            cnt += __popcll(w); }
        if (cnt > 320) cnt = 320;
        float mx = -1e30f; for (int e = lane; e < cnt; e += 64) mx = fmaxf(mx, lg[e]);
#pragma unroll
        for (int m = 32; m >= 1; m >>= 1) mx = fmaxf(mx, __shfl_xor(mx, m));
        float sum = 0.f; for (int e = lane; e < cnt; e += 64) { const float pe = expf(lg[e] - mx); lg[e] = pe; sum += pe; }
#pragma unroll
        for (int m = 32; m >= 1; m >>= 1) sum += __shfl_xor(sum, m);
        float a0 = 0.f, a1 = 0.f;
        for (int e = 0; e < cnt; ++e) { const float pe = lg[e]; const bf16_t* vp = VB + ((size_t)b * SEQ + keys[e]) * 1024 + h * 128 + 2 * lane; a0 += pe * bf2f(vp[0]); a1 += pe * bf2f(vp[1]); }
        const float inv = 1.0f / sum;
        *(unsigned*)(YB + (size_t)q * 1024 + h * 128 + 2 * lane) = pg8::cvt_pk_bf16(a0 * inv, a1 * inv);
    }
}

__global__ __launch_bounds__(128) void k_hgrn_naive(const bf16_t* QA, const bf16_t* KA, const bf16_t* VA, const bf16_t* GA, const float* LF, const float* norm_g, bf16_t* YA) {
    const int bh = blockIdx.x, b = bh >> 3, h = bh & 7, v = threadIdx.x;
    __shared__ float sf[16][128], sk[16][128], sq[16][128]; __shared__ float red[2];
    float S[128];
#pragma unroll
    for (int k = 0; k < 128; ++k) S[k] = 0.f;
    const float ng = norm_g[v];
    for (int t0 = 0; t0 < SEQ; t0 += 16) {
        for (int i = 0; i < 16; ++i) { const size_t idx = ((size_t)(b * SEQ + t0 + i)) * 1024 + h * 128 + v; sf[i][v] = expf(LF[idx]); sk[i][v] = bf2f(KA[idx]); sq[i][v] = bf2f(QA[idx]); }
        __syncthreads();
        for (int i = 0; i < 16; ++i) { const size_t idx = ((size_t)(b * SEQ + t0 + i)) * 1024 + h * 128 + v; const float vt = bf2f(VA[idx]); float o = 0.f;
#pragma unroll
            for (int k = 0; k < 128; ++k) { S[k] = sf[i][k] * S[k] + sk[i][k] * vt; o += S[k] * sq[i][k]; }
            float ss = o * o;
#pragma unroll
            for (int m = 32; m >= 1; m >>= 1) ss += __shfl_xor(ss, m);
            if ((v & 63) == 0) red[v >> 6] = ss;
            __syncthreads();
            const float tot = red[0] + red[1];
            const float y = o * (1.0f / sqrtf(tot * (1.0f / 128.0f) + RMS_EPS)) * ng * bf2f(GA[idx]);
            YA[idx] = f2bf(y);
            __syncthreads(); }
    }
}
__global__ __launch_bounds__(256) void k_idx_naive(const bf16_t* QI, const bf16_t* KI, const float* WI, float* S) {
    const int q = blockIdx.x, b = q >> 12, s = q & 4095, c = s >> 6, nw = c + 1, nk = nw * 64;
    if (nw <= TOPK / 64) return;
    __shared__ float qs[1024]; __shared__ float wsh[16];
    for (int i = threadIdx.x; i < 1024; i += 256) qs[i] = bf2f(QI[(size_t)q * 1024 + i]);
    if (threadIdx.x < 16) wsh[threadIdx.x] = WI[(size_t)q * 16 + threadIdx.x];
    __syncthreads();
    float* row = S + (size_t)b * SCORE_B + (size_t)2048 * c * (c + 1) + (size_t)(s & 63) * nk;
    for (int key = threadIdx.x; key < nk; key += 256) {
        float kf[64]; const bf16_t* kp = KI + ((size_t)b * SEQ + key) * 64;
#pragma unroll
        for (int d = 0; d < 64; ++d) kf[d] = bf2f(kp[d]);
        float sc = 0.f;
        for (int h = 0; h < 16; ++h) { float dot = 0.f;
#pragma unroll
            for (int d = 0; d < 64; ++d) dot += qs[h * 64 + d] * kf[d];
            sc += wsh[h] * fmaxf(dot, 0.f); }
        row[key] = sc;
    }
}
__global__ __launch_bounds__(512) void k_attn_naive(const bf16_t* QB, const bf16_t* KB, const bf16_t* VB, const unsigned long long* MASK, bf16_t* YB) {
    const int q = blockIdx.x, b = q >> 12, s = q & 4095, nw = (s >> 6) + 1, h = threadIdx.x >> 6, lane = threadIdx.x & 63;
    __shared__ float qs[8][128]; __shared__ int keys[8][320]; __shared__ float lg[8][320];
    qs[h][lane] = bf2f(QB[(size_t)q * 1024 + h * 128 + lane]); qs[h][lane + 64] = bf2f(QB[(size_t)q * 1024 + h * 128 + 64 + lane]);
    __syncthreads();
    int cnt = 0;
    for (int j = 0; j < nw; ++j) { const unsigned long long w = MASK[(size_t)q * 64 + j]; const bool on = (w >> lane) & 1ull; const int key = j * 64 + lane;
        if (on) { const bf16_t* kp = KB + ((size_t)b * SEQ + key) * 1024 + h * 128; float dot = 0.f;
            for (int d = 0; d < 128; ++d) dot += qs[h][d] * bf2f(kp[d]);
            const int pos = cnt + __popcll(w & ((1ull << lane) - 1ull));
            if (pos < 320) { keys[h][pos] = key; lg[h][pos] = dot * ATTN_SCALE; } }
        cnt += __popcll(w); }
    if (cnt > 320) cnt = 320;
    __syncthreads();
    float mx = -1e30f; for (int e = lane; e < cnt; e += 64) mx = fmaxf(mx, lg[h][e]);
#pragma unroll
    for (int m = 32; m >= 1; m >>= 1) mx = fmaxf(mx, __shfl_xor(mx, m));
    float sum = 0.f; for (int e = lane; e < cnt; e += 64) { const float pe = expf(lg[h][e] - mx); lg[h][e] = pe; sum += pe; }
#pragma unroll
    for (int m = 32; m >= 1; m >>= 1) sum += __shfl_xor(sum, m);
    __syncthreads();
    float a0 = 0.f, a1 = 0.f;
    for (int e = 0; e < cnt; ++e) { const float pe = lg[h][e]; const bf16_t* vp = VB + ((size_t)b * SEQ + keys[h][e]) * 1024 + h * 128 + 2 * lane; a0 += pe * bf2f(vp[0]); a1 += pe * bf2f(vp[1]); }
    const float inv = 1.0f / sum;
    YB[(size_t)q * 1024 + h * 128 + 2 * lane] = f2bf(a0 * inv); YB[(size_t)q * 1024 + h * 128 + 2 * lane + 1] = f2bf(a1 * inv);
}

__global__ __launch_bounds__(256) void k_dump(const unsigned char* ws, int which, float* out) {
    for (size_t i = (size_t)blockIdx.x * 256 + threadIdx.x; i < (size_t)TOK * DM; i += (size_t)gridDim.x * 256) {
        const size_t t = i / DM, c = i % DM; float v = 0.f;
        if (which == 0) { v = bf2f(((const bf16_t*)(ws + WS_MG))[i]) + ((const float*)(ws + WS_PP))[i]; }
        else if (which == 1) { const size_t j = t * 1024 + (c & 1023);
            v = bf2f(((const bf16_t*)(ws + WS_QA))[j]) + bf2f(((const bf16_t*)(ws + WS_KA))[j]) + bf2f(((const bf16_t*)(ws + WS_VA))[j]) + bf2f(((const bf16_t*)(ws + WS_GA))[j])
              + bf2f(((const bf16_t*)(ws + WS_QB))[j]) + bf2f(((const bf16_t*)(ws + WS_KB))[j]) + bf2f(((const bf16_t*)(ws + WS_VB))[j]) + bf2f(((const bf16_t*)(ws + WS_QI))[j])
              + ((const float*)(ws + WS_LF))[j] + bf2f(((const bf16_t*)(ws + WS_SGA))[i]) + bf2f(((const bf16_t*)(ws + WS_SGB))[i]) + ((const float*)(ws + WS_IKW))[t * 128 + (c & 127)]; }
        else if (which == 2) { const size_t j = t * 1024 + (c & 1023); v = (c < 1024) ? bf2f(((const bf16_t*)(ws + WS_YA))[j]) : bf2f(((const bf16_t*)(ws + WS_YB))[j]); }
        else if (which == 3) { v = ((const float*)(ws + WS_XPRE))[i]; }
        else if (which == 4) { v = ((const float*)(ws + WS_XPRE))[i]; }
        else if (which == 5) { v = bf2f(((const bf16_t*)(ws + WS_H))[t * DFF + c]) + bf2f(((const bf16_t*)(ws + WS_H))[t * DFF + 2048 + c]) + bf2f(((const bf16_t*)(ws + WS_H))[t * DFF + 3584 + c]); }
        else if (which == 6) { const unsigned long long m = ((const unsigned long long*)(ws + WS_MASK))[t * 64 + (c & 63)]; v = (float)__popcll(m) + (float)(unsigned)(m % 1000003ull) * 1e-3f; }
        else if (which == 7) { v = bf2f(((const bf16_t*)(ws + WS_WIN))[i % ((size_t)INP * DM)]) + bf2f(((const bf16_t*)(ws + WS_WGU))[(i * 7) % ((size_t)2 * DFF * DM)]) + bf2f(((const bf16_t*)(ws + WS_WDN))[(i * 3) % ((size_t)DFF * DM)]); }
        else if (which == 8) { v = bf2f(((const bf16_t*)(ws + WS_XB))[i]) + ((const float*)(ws + WS_COSH))[i % ((size_t)TOK * 64)] + ((const float*)(ws + WS_SINI))[i % ((size_t)TOK * 32)] + ((const float*)(ws + WS_LB))[i % 4096]; }
        else if (which == 9) { v = bf2f(((const bf16_t*)(ws + WS_H))[t * 6272 + c]) + bf2f(((const bf16_t*)(ws + WS_H))[t * 6272 + 2048 + c]) + bf2f(((const bf16_t*)(ws + WS_H))[t * 6272 + 4096 + c]) + bf2f(((const bf16_t*)(ws + WS_H))[t * 6272 + 4224 + c]); }
        else if (which == 10) { const size_t j = t * 1024 + (c & 1023); v = bf2f(((const bf16_t*)(ws + WS_QA))[j]) + bf2f(((const bf16_t*)(ws + WS_VA))[j]) + bf2f(((const bf16_t*)(ws + WS_GA))[j]) + bf2f(((const bf16_t*)(ws + WS_VB))[j]) + bf2f(((const bf16_t*)(ws + WS_SGA))[i]) + bf2f(((const bf16_t*)(ws + WS_SGB))[i]); }
        else if (which == 11) { const size_t j = t * 1024 + (c & 1023); v = bf2f(((const bf16_t*)(ws + WS_QB))[j]) + bf2f(((const bf16_t*)(ws + WS_KB))[j]) + bf2f(((const bf16_t*)(ws + WS_QI))[j]); }
        else if (which == 12) { const size_t j = t * 1024 + (c & 1023); v = ((const float*)(ws + WS_LF))[j] + bf2f(((const bf16_t*)(ws + WS_KA))[j]); }
        else if (which == 14) { v = ((const float*)(ws + WS_IKW))[t * 128 + (c & 127)]; }
        else if (which == 15) { const size_t j = t * 1024 + (c & 1023); v = bf2f(((const bf16_t*)(ws + WS_QA))[j]) + bf2f(((const bf16_t*)(ws + WS_GA))[j]); }
        else if (which == 16) { v = bf2f(((const bf16_t*)(ws + WS_SGA))[i]) + bf2f(((const bf16_t*)(ws + WS_SGB))[i]); }
        else if (which == 17) { const size_t j = t * 1024 + (c & 1023); v = bf2f(((const bf16_t*)(ws + WS_VA))[j]) + bf2f(((const bf16_t*)(ws + WS_VB))[j]); }
        out[i] = v;
    }
}
#ifndef OPT_HGRN
#define OPT_HGRN 1
#endif
#ifndef OPT_IDX
#define OPT_IDX 1
#endif
#ifndef OPT_ATT
#define OPT_ATT 1
#endif
#ifndef PHM
#define PHM 0x3fff
#endif
#ifndef DUP_MASK
#define DUP_MASK 0
#endif
#ifndef ONE_LAUNCH
#define ONE_LAUNCH 1
#endif

__global__ void __launch_bounds__(512, 2) mega(Params P_unused) {
    extern __shared__ __attribute__((aligned(16))) unsigned char lds[];
    LAS unsigned char* L = (LAS unsigned char*)lds;
    volatile LAS unsigned* misc = (volatile LAS unsigned*)(L + MISC_OFF);
    if (threadIdx.x < 4) misc[threadIdx.x] = 0u;
    __syncthreads();
    int lo, hi; unsigned char* ws0; { KP P0 = kparams(); lo = P0->ph_lo; hi = P0->ph_hi; ws0 = as_global(P0->ws); }
    XcdBarrier bar; bar.bar = (unsigned*)(ws0 + WS_CTL); bar.x = 0; bar.st = misc;
    if (hi - lo > 1) bar = xcd_barrier_post((unsigned*)(ws0 + WS_CTL), misc);
#define WSP(T_, off) ((T_*)(ws + (off)))
#define WSL KP P = kparams(); unsigned char* ws = as_global(P->ws); const int G = nblk_(), bid = bid_(); (void)G; (void)bid

    for (int layer = 0; layer < DEPTH; ++layer) {
        const int base = layer * NPH_LAYER;
#define IN(k) (((PHM >> (k)) & 1) && lo <= base + (k) && base + (k) < hi)
#define SEAM(k) do { if (rep + 1 == ((((DUP_MASK >> (k)) & 1) ? 2 : 1)) && base + (k) + 1 < hi) xcd_barrier(bar); } while (0)
        if (IN(0)) for (int rep = 0; rep < (((DUP_MASK >> 0) & 1) ? 2 : 1); ++rep) { WSL; if (layer == 0) phase_prologue(P); phase_wconv(P, layer); SEAM(0); }
        if (IN(1)) for (int rep = 0; rep < (((DUP_MASK >> 1) & 1) ? 2 : 1); ++rep) { WSL;
            pg8::Gemm g{WSP(const bf16_t, WS_XB), WSP(const bf16_t, WS_WIN), TOK, INP, DM}; pg8::StaticOrder S; S.init(TOK, INP, G, bid);
#ifdef RAWTEST
            pg8::EpiRawTest E{ws};
            pg8::gemm_phase<pg8::EpiRawTest, pg8::StaticOrder, true, true>(L, g, S, E); SEAM(1);
#else
            pg8::EpiIn E{ws, layer};
            pg8::gemm_phase<pg8::EpiIn, pg8::StaticOrder, true, true>(L, g, S, E); SEAM(1);
#endif
        }
        if (IN(2)) for (int rep = 0; rep < (((DUP_MASK >> 2) & 1) ? 2 : 1); ++rep) { WSL; phase_ikprep(P, layer);
#if OPT_HGRN
            phase_hgrn_h1(P, L);
#ifdef DUP_H1
            phase_hgrn_h1(P, L);
#endif
#endif
            SEAM(2); }
        if (IN(3)) for (int rep = 0; rep < (((DUP_MASK >> 3) & 1) ? 2 : 1); ++rep) { WSL;
#if !OPT_HGRN
            phase_hgrn_naive(P, layer, L); __syncthreads();
#else
            phase_hgrn_h2(P);
#ifdef DUP_H2
            phase_hgrn_h2(P);
#endif
#endif
#if !OPT_IDX
            phase_idx_naive(P, L);
#else
            __syncthreads(); phase_idx(P, L);
#ifdef DUP_IDX
            __syncthreads(); phase_idx(P, L);
#endif
#endif
            SEAM(3); }
        if (IN(4)) for (int rep = 0; rep < (((DUP_MASK >> 4) & 1) ? 2 : 1); ++rep) { WSL;
#ifdef DUP_SEL
            phase_select(P, L); __syncthreads();
#endif
            phase_select(P, L);
#if OPT_HGRN
            __syncthreads(); phase_hgrn_h3(P, layer, L);
#ifdef DUP_H3
            __syncthreads(); phase_hgrn_h3(P, layer, L);
#endif
#endif
            SEAM(4); }
        if (IN(5)) for (int rep = 0; rep < (((DUP_MASK >> 5) & 1) ? 2 : 1); ++rep) { WSL;
#if !OPT_ATT
            phase_attn_naive(P, L);
#else
            phase_attn(P, L);
#endif
            SEAM(5); }
        if (IN(6)) for (int rep = 0; rep < (((DUP_MASK >> 6) & 1) ? 2 : 1); ++rep) { WSL;
            { pg8::Gemm g{WSP(const bf16_t, WS_YA), WSP(const bf16_t, WS_WA), TOK, DM, AW}; pg8::StaticOrder S; S.init(TOK, DM, G, bid);
              pg8::EpiGateA E{ws}; pg8::gemm_phase<pg8::EpiGateA, pg8::StaticOrder, true, true>(L, g, S, E); }
            { pg8::Gemm g{WSP(const bf16_t, WS_YB), WSP(const bf16_t, WS_WB), TOK, DM, BW}; pg8::StaticOrder S; S.init(TOK, DM, G, bid);
              pg8::EpiGateB E{ws}; pg8::gemm_phase<pg8::EpiGateB, pg8::StaticOrder, true, true>(L, g, S, E); }
            { pg8::Gemm g{WSP(const bf16_t, WS_PB), WSP(const bf16_t, WS_WPP), TOK, DM, PLE}; pg8::StaticOrder S; S.init(TOK, DM, G, bid);
              pg8::EpiF32P E{ws}; pg8::gemm_phase<pg8::EpiF32P, pg8::StaticOrder, true, true>(L, g, S, E); }
            SEAM(6);
        }
        if (IN(7)) for (int rep = 0; rep < (((DUP_MASK >> 7) & 1) ? 2 : 1); ++rep) { WSL;
            pg8::Gemm g{WSP(const bf16_t, WS_MG), WSP(const bf16_t, WS_WO), TOK, DM, DM}; pg8::StaticOrder S; S.init(TOK, DM, G, bid);
            if (layer == 0) { pg8::EpiRes<true> E{as_global(P->x), nullptr, nullptr, ws}; pg8::gemm_phase<pg8::EpiRes<true>, pg8::StaticOrder, true, true>(L, g, S, E); }
            else { pg8::EpiRes<false> E{nullptr, P->lnp_g + (layer - 1) * DM, P->lnp_b + (layer - 1) * DM, ws}; pg8::gemm_phase<pg8::EpiRes<false>, pg8::StaticOrder, true, true>(L, g, S, E); }
            SEAM(7);
        }
        if (IN(8)) for (int rep = 0; rep < (((DUP_MASK >> 8) & 1) ? 2 : 1); ++rep) { WSL; phase_ln(WSP(const float, WS_XPRE), nullptr, WSP(bf16_t, WS_XB), WSP(float, WS_STATS), as_global(P->lnm_g) + layer * DM, as_global(P->lnm_b) + layer * DM); SEAM(8); }
        if (IN(9)) for (int rep = 0; rep < (((DUP_MASK >> 9) & 1) ? 2 : 1); ++rep) { WSL;
            pg8::Gemm g{WSP(const bf16_t, WS_XB), WSP(const bf16_t, WS_WGU), TOK, 2 * DFF, DM}; pg8::StaticOrder S; S.init(TOK, 2 * DFF, G, bid);
            pg8::EpiSwiGLU E{ws}; pg8::gemm_phase<pg8::EpiSwiGLU, pg8::StaticOrder, true, true>(L, g, S, E); SEAM(9);
        }
        if (IN(10)) for (int rep = 0; rep < (((DUP_MASK >> 10) & 1) ? 2 : 1); ++rep) { WSL;
            pg8::Gemm g{WSP(const bf16_t, WS_H), WSP(const bf16_t, WS_WDN), TOK, DM, DFF}; pg8::StaticOrder S; S.init(TOK, DM, G, bid);
            pg8::EpiRes<false> E{nullptr, P->lnm_g + layer * DM, P->lnm_b + layer * DM, ws}; pg8::gemm_phase<pg8::EpiRes<false>, pg8::StaticOrder, true, true>(L, g, S, E); SEAM(10);
        }
        if (IN(11)) for (int rep = 0; rep < (((DUP_MASK >> 11) & 1) ? 2 : 1); ++rep) { WSL; phase_ln(WSP(const float, WS_XPRE), nullptr, WSP(bf16_t, WS_XB), WSP(float, WS_STATS), as_global(P->lnf_g) + layer * DM, as_global(P->lnf_b) + layer * DM); SEAM(11); }
        if (IN(12)) for (int rep = 0; rep < (((DUP_MASK >> 12) & 1) ? 2 : 1); ++rep) { WSL;
            pg8::Gemm g{WSP(const bf16_t, WS_XB), WSP(const bf16_t, WS_WPG), TOK, DM, DM}; pg8::StaticOrder S; S.init(TOK, DM, G, bid);
            pg8::EpiPle E{P->lnf_g + layer * DM, P->lnf_b + layer * DM, ws}; pg8::gemm_phase<pg8::EpiPle, pg8::StaticOrder, true, true>(L, g, S, E); SEAM(12);
        }
        if (IN(13)) for (int rep = 0; rep < (((DUP_MASK >> 13) & 1) ? 2 : 1); ++rep) { WSL; phase_ln(WSP(const float, WS_XPRE), layer == DEPTH - 1 ? as_global(P->out) : nullptr, WSP(bf16_t, WS_XB), WSP(float, WS_STATS), as_global(P->lnp_g) + layer * DM, as_global(P->lnp_b) + layer * DM); SEAM(13); }
#undef IN
#undef SEAM
    }
}

extern "C" void kernel_launch(void* const* d_in, const int* in_sizes, int n_in, void* d_out, int out_size, void* d_ws, size_t ws_size, hipStream_t stream) {
    static int grid = 0;
    if (grid == 0) {
        if (n_in != 22 || out_size != TOK * DM || ws_size < WS_END) { fprintf(stderr, "kernel_launch: unexpected shapes: n_in %d out %d ws %zu (need %zu)\n", n_in, out_size, ws_size, (size_t)WS_END); grid = -1; return; }
        int dev = 0, cus = 0, per_cu = 0;
        if (hipGetDevice(&dev) != hipSuccess || hipDeviceGetAttribute(&cus, hipDeviceAttributeMultiprocessorCount, dev) != hipSuccess) { grid = -1; return; }
        if (hipFuncSetAttribute((const void*)mega, hipFuncAttributeMaxDynamicSharedMemorySize, LDS_BYTES) != hipSuccess) { fprintf(stderr, "kernel_launch: hipFuncSetAttribute failed\n"); grid = -1; return; }
        if (hipOccupancyMaxActiveBlocksPerMultiprocessor(&per_cu, (const void*)mega, 512, LDS_BYTES) != hipSuccess || per_cu < 1) { fprintf(stderr, "kernel_launch: occupancy query says %d\n", per_cu); (void)hipGetLastError(); }
        grid = cus;
    }
    if (grid < 0) return;
    (void)hipMemsetAsync((char*)d_ws + WS_CTL, 0, 65536, stream);
    Params P{};
    P.x = (const float*)d_in[0]; P.p = (const float*)d_in[1]; P.pos = (const int*)d_in[2];
    P.w_in = (const float*)d_in[3]; P.w_a = (const float*)d_in[4]; P.w_b = (const float*)d_in[5]; P.w_out = (const float*)d_in[6];
    P.lbraw = (const float*)d_in[7]; P.hnorm_g = (const float*)d_in[8]; P.ikn_g = (const float*)d_in[9]; P.ikn_b = (const float*)d_in[10];
    P.lnm_g = (const float*)d_in[11]; P.lnm_b = (const float*)d_in[12]; P.w_fg = (const float*)d_in[13]; P.w_fu = (const float*)d_in[14]; P.w_fd = (const float*)d_in[15];
    P.lnf_g = (const float*)d_in[16]; P.lnf_b = (const float*)d_in[17]; P.w_pg = (const float*)d_in[18]; P.w_pp = (const float*)d_in[19];
    P.lnp_g = (const float*)d_in[20]; P.lnp_b = (const float*)d_in[21];
    P.out = (float*)d_out; P.ws = (unsigned char*)d_ws;
    for (int j = 0; j < 64; ++j) P.invf_h[j] = pow(10000.0, -(double)j / 64.0) / 6.283185307179586476925286766559;
    for (int j = 0; j < 32; ++j) P.invf_i[j] = pow(10000.0, -(double)j / 32.0) / 6.283185307179586476925286766559;
#if ONE_LAUNCH
    P.ph_lo = 0; P.ph_hi = NPH;
    hipLaunchKernelGGL(mega, dim3(grid), dim3(512), LDS_BYTES, stream, P);
#elif defined(SEQ_TEST)
    { const int seq[] = SEQ_TEST; for (int i = 0; i < (int)(sizeof(seq) / sizeof(int)); ++i) { P.ph_lo = seq[i]; P.ph_hi = seq[i] + 1; hipLaunchKernelGGL(mega, dim3(grid), dim3(512), LDS_BYTES, stream, P); }
      hipLaunchKernelGGL(k_dump, dim3(4096), dim3(256), 0, stream, (const unsigned char*)d_ws, DUMP_WHICH, (float*)d_out); }
#else
    unsigned char* ws = (unsigned char*)d_ws;
    for (int layer = 0; layer < DEPTH; ++layer)
        for (int k = 0; k < NPH_LAYER; ++k) {
            P.ph_lo = layer * NPH_LAYER + k; P.ph_hi = P.ph_lo + 1;
            bool run_mega = true;
#if !OPT_HGRN
            if (k == 3) hipLaunchKernelGGL(k_hgrn_naive, dim3(32), dim3(128), 0, stream, (const bf16_t*)(ws + WS_QA), (const bf16_t*)(ws + WS_KA), (const bf16_t*)(ws + WS_VA), (const bf16_t*)(ws + WS_GA),
                                           (const float*)(ws + WS_LF), P.hnorm_g + layer * 128, (bf16_t*)(ws + WS_YA));
#endif
#if !OPT_IDX
            if (k == 3) hipLaunchKernelGGL(k_idx_naive, dim3(TOK), dim3(256), 0, stream, (const bf16_t*)(ws + WS_QI), (const bf16_t*)(ws + WS_KI), (const float*)(ws + WS_WI), (float*)(ws + WS_S));
#endif
#if !OPT_ATT
            if (k == 5) hipLaunchKernelGGL(k_attn_naive, dim3(TOK), dim3(512), 0, stream, (const bf16_t*)(ws + WS_QB), (const bf16_t*)(ws + WS_KB), (const bf16_t*)(ws + WS_VB),
                                           (const unsigned long long*)(ws + WS_MASK), (bf16_t*)(ws + WS_YB));
#endif
#if !OPT_HGRN && !OPT_IDX
            if (k == 3) run_mega = false;
#endif
#if !OPT_ATT
            if (k == 5) run_mega = false;
#endif
            if (run_mega) hipLaunchKernelGGL(mega, dim3(grid), dim3(512), LDS_BYTES, stream, P);
#ifdef DUMP_AT
            if (layer * NPH_LAYER + k == DUMP_AT) { hipLaunchKernelGGL(k_dump, dim3(4096), dim3(256), 0, stream, (const unsigned char*)ws, DUMP_WHICH, (float*)d_out); return; }
#endif
        }
#endif
    const hipError_t le = hipPeekAtLastError();
    if (le != hipSuccess) fprintf(stderr, "kernel_launch: launch failed: %s\n", hipGetErrorName(le));
}
```

```cpp
#include <hip/hip_runtime.h>
#include <cstdio>
#include <cstdint>

constexpr int DM = 2048, NBATCH = 4, SEQ = 4096, TOK = NBATCH * SEQ, DEPTH = 4, CHUNK = 64, PLE = 256;
constexpr int AH = 8, AD = 128, AW = 1024, BH = 8, BD = 128, BW = 1024, IH = 16, IDIM = 64, TOPK = 256;
constexpr int DFF = 5632, INW = 12368, INP = 12544;
constexpr float ALPHA = 1.6817928305074290861f;
constexpr float LN_EPS = 1e-5f, RMS_EPS = 1e-6f;
constexpr float ATTN_SCALE = 0.088388347648318440f;
constexpr float IDX_SCALE = 0.03125f;

typedef unsigned short bf16_t;
__device__ __forceinline__ float bf2f(bf16_t b) { return __uint_as_float(((unsigned)b) << 16); }
__device__ __forceinline__ bf16_t f2bf(float f) { unsigned u = __float_as_uint(f); u += 0x7FFFu + ((u >> 16) & 1u); return (bf16_t)(u >> 16); }
__device__ __forceinline__ float sigmoid_f(float x) { return __builtin_amdgcn_rcpf(1.0f + __expf(-x)); }
__device__ __forceinline__ float silu_f(float x) { return x * sigmoid_f(x); }

__device__ __forceinline__ int tid_() { int t = (int)threadIdx.x; asm volatile("" : "+v"(t)); return t; }
__device__ __forceinline__ int bid_() { int b = (int)blockIdx.x; asm volatile("" : "+s"(b)); return b; }
__device__ __forceinline__ int nblk_() { int g = (int)gridDim.x; asm volatile("" : "+s"(g)); return g; }

template <class T> __device__ __forceinline__ T* as_global(T* p) { return (T*)(__attribute__((address_space(1))) T*)p; }

constexpr size_t MiB = 1048576;
constexpr size_t WS_CTL  = 0;
constexpr size_t WS_LB   = WS_CTL + 65536;
constexpr size_t WS_STATS = WS_CTL + 131072;
constexpr size_t WS_COSH = 1 * MiB;
constexpr size_t WS_SINH = WS_COSH + 4 * MiB;
constexpr size_t WS_COSI = WS_SINH + 4 * MiB;
constexpr size_t WS_SINI = WS_COSI + 2 * MiB;
constexpr size_t WS_WIN  = WS_SINI + 2 * MiB;
constexpr size_t WS_WA   = WS_WIN + 49 * MiB;
constexpr size_t WS_WB   = WS_WA + 4 * MiB;
constexpr size_t WS_WO   = WS_WB + 4 * MiB;
constexpr size_t WS_WGU  = WS_WO + 8 * MiB;
constexpr size_t WS_WDN  = WS_WGU + 44 * MiB;
constexpr size_t WS_WPG  = WS_WDN + 22 * MiB;
constexpr size_t WS_WPP  = WS_WPG + 8 * MiB;
constexpr size_t WS_S    = WS_WPP + 1 * MiB;
constexpr size_t WS_XB   = WS_S + 130 * MiB;
constexpr size_t WS_XPRE = WS_XB + 64 * MiB;
constexpr size_t WS_R1   = WS_XPRE + 130 * MiB;
constexpr size_t WS_QA   = WS_R1;
constexpr size_t WS_LF   = WS_QA + 32 * MiB;
constexpr size_t WS_KA   = WS_LF + 64 * MiB;
constexpr size_t WS_VA   = WS_KA + 32 * MiB;
constexpr size_t WS_GA   = WS_VA + 32 * MiB;
constexpr size_t WS_QB   = WS_GA + 32 * MiB;
constexpr size_t WS_KB   = WS_QB + 32 * MiB;
constexpr size_t WS_VB   = WS_KB + 32 * MiB;
constexpr size_t WS_QI   = WS_VB + 32 * MiB;
constexpr size_t WS_SGA  = WS_QI + 32 * MiB;
constexpr size_t WS_SGB  = WS_SGA + 64 * MiB;
constexpr size_t WS_IKW  = WS_SGB + 64 * MiB;
constexpr size_t WS_H    = WS_R1;
constexpr size_t WS_PP   = WS_R1 + 176 * MiB;
constexpr size_t WS_R2   = WS_IKW + 8 * MiB;
constexpr size_t WS_LT   = WS_R2;
constexpr size_t WS_MG   = WS_R2;
constexpr size_t WS_AF   = WS_R2 + 64 * MiB;
constexpr size_t WS_PT   = WS_LT + 128 * MiB;
constexpr size_t WS_DEC  = WS_PT + 64 * MiB;
constexpr size_t WS_MASK = WS_DEC + 1 * MiB;
constexpr size_t WS_YA   = WS_MASK + 8 * MiB;
constexpr size_t WS_YB   = WS_YA + 32 * MiB;
constexpr size_t WS_KI   = WS_YB + 32 * MiB;
constexpr size_t WS_WI   = WS_KI + 2 * MiB;
constexpr size_t WS_PB   = WS_WI + 1 * MiB;
constexpr size_t WS_END  = WS_PB + 8 * MiB;
static_assert(WS_END < 1360000000ull, "workspace budget");
constexpr size_t SCORE_B = (size_t)4096 * 2080;

namespace pg8 {
#define PG8_LAS __attribute__((address_space(3)))
typedef unsigned short bf16_t;
typedef short bf16x8 __attribute__((ext_vector_type(8)));
typedef float f32x4 __attribute__((ext_vector_type(4)));
typedef unsigned u32x4 __attribute__((ext_vector_type(4)));
constexpr int BM = 256, BK = 64, HALF = 128, HTB = HALF * BK * 2  , STAGE_BYTES = 8 * HTB, NXCD = 8, WGM = 8;

__host__ __device__ __forceinline__ int lds_byte(int r, int c) { const int st = (r >> 4) * 2 + (c >> 5), rr = r & 15, cc = c & 31, ob = rr * 64 + cc * 2; return st * 1024 + (ob ^ (((ob >> 9) & 1) << 5)); }
__host__ __device__ __forceinline__ void stage_rc(int b, int& R, int& C) { const int st = b / 1024, sb = b % 1024, swz = sb ^ (((sb >> 9) & 1) << 5); R = (st >> 1) * 16 + swz / 64; C = (st & 1) * 32 + (swz % 64) / 2; }
__host__ __device__ __forceinline__ int perm32(int rho) { const int n = rho >> 4, i = rho & 15; return 8 * (i >> 2) + 4 * n + (i & 3); }

struct Unit { int pm, pn; };
struct Gemm { const bf16_t* A; const bf16_t* Bt; int M, N, K; };

struct StaticOrder {
    int nM, nN, nwg, G, c;
    __host__ __device__ void init(int M, int N, int G_, int c_) { nM = M / BM; nN = N / BM; nwg = nM * nN; G = G_; c = c_; }
    __host__ __device__ bool next(int i, Unit& u) const {
        const long L = (long)i * G + c; if (L >= nwg) return false;
        int wgid = (int)L; { const int q = nwg / NXCD, r = nwg % NXCD, xcd = wgid % NXCD, off = wgid / NXCD; wgid = (xcd < r ? xcd * (q + 1) : r * (q + 1) + (xcd - r) * q) + off; }
        const int nig = WGM * nN, gid = wgid / nig, fm = gid * WGM, gsz = (nM - fm) < WGM ? (nM - fm) : WGM;
        u.pm = fm + ((wgid % nig) % gsz); u.pn = (wgid % nig) / gsz; return true;
    }
    __device__ __forceinline__ void a_ready(const Unit&) const {}
    __device__ __forceinline__ void done(const Unit&) const {}
};

typedef float pk_f32x2 __attribute__((ext_vector_type(2)));
typedef __bf16 pk_bf16x2 __attribute__((ext_vector_type(2)));
__device__ __forceinline__ unsigned cvt_pk_bf16(float lo, float hi) { const pk_f32x2 v = {lo, hi}; const pk_bf16x2 b = __builtin_convertvector(v, pk_bf16x2); return __builtin_bit_cast(unsigned, b); }
typedef unsigned u32x2 __attribute__((ext_vector_type(2)));
typedef float f32x2 __attribute__((ext_vector_type(2)));
__device__ __forceinline__ u32x4 pack8(const f32x4 a, const f32x4 b) { u32x4 w; w.x = cvt_pk_bf16(a[0], a[1]); w.y = cvt_pk_bf16(a[2], a[3]); w.z = cvt_pk_bf16(b[0], b[1]); w.w = cvt_pk_bf16(b[2], b[3]); return w; }
__device__ __forceinline__ void unpack8(const u32x4 w, f32x4& a, f32x4& b) {
    a[0] = __uint_as_float(w.x << 16); a[1] = __uint_as_float(w.x & 0xffff0000u); a[2] = __uint_as_float(w.y << 16); a[3] = __uint_as_float(w.y & 0xffff0000u);
    b[0] = __uint_as_float(w.z << 16); b[1] = __uint_as_float(w.z & 0xffff0000u); b[2] = __uint_as_float(w.w << 16); b[3] = __uint_as_float(w.w & 0xffff0000u); }
__device__ __forceinline__ float sigm(float x) { return __builtin_amdgcn_rcpf(1.0f + __expf(-x)); }
__device__ __forceinline__ f32x4 sigm4(const f32x4 x) { f32x4 r; r[0] = sigm(x[0]); r[1] = sigm(x[1]); r[2] = sigm(x[2]); r[3] = sigm(x[3]); return r; }
__device__ __forceinline__ f32x4 silu4(const f32x4 x) { return x * sigm4(x); }

#define PG8_GAS __attribute__((address_space(1)))
struct EpiIn {
    static constexpr bool PERM = true, AFTER_DRAIN = false;
    unsigned char* ws0; int layer;
    __device__ __forceinline__ void operator()(const f32x4 (&acc)[2][2][4][2], const Unit& u, int wr, int wc, int fr, int fq) const {
        unsigned char* wsq = ws0; asm volatile("" : "+s"(wsq)); PG8_GAS unsigned char* const ws = (PG8_GAS unsigned char*)wsq;
        const int pn = u.pn, row0 = u.pm * BM + wr * 64 + fr, cw = wc * 32 + 8 * fq;
        PG8_GAS bf16_t* const QA = (PG8_GAS bf16_t*)(ws + WS_QA); PG8_GAS bf16_t* const KA = (PG8_GAS bf16_t*)(ws + WS_KA); PG8_GAS bf16_t* const VA = (PG8_GAS bf16_t*)(ws + WS_VA); PG8_GAS bf16_t* const GA = (PG8_GAS bf16_t*)(ws + WS_GA);
        PG8_GAS bf16_t* const QB = (PG8_GAS bf16_t*)(ws + WS_QB); PG8_GAS bf16_t* const KB = (PG8_GAS bf16_t*)(ws + WS_KB); PG8_GAS bf16_t* const VB = (PG8_GAS bf16_t*)(ws + WS_VB); PG8_GAS bf16_t* const QI = (PG8_GAS bf16_t*)(ws + WS_QI);
        PG8_GAS bf16_t* const SGA = (PG8_GAS bf16_t*)(ws + WS_SGA); PG8_GAS bf16_t* const SGB = (PG8_GAS bf16_t*)(ws + WS_SGB); PG8_GAS float* const LF = (PG8_GAS float*)(ws + WS_LF); PG8_GAS float* const IKW = (PG8_GAS float*)(ws + WS_IKW);
        const PG8_GAS float* const lb = (const PG8_GAS float*)(ws + WS_LB) + layer * 1024; const PG8_GAS float* const cosh = (const PG8_GAS float*)(ws + WS_COSH); const PG8_GAS float* const sinh = (const PG8_GAS float*)(ws + WS_SINH);
        const PG8_GAS float* const cosi = (const PG8_GAS float*)(ws + WS_COSI); const PG8_GAS float* const sini = (const PG8_GAS float*)(ws + WS_SINI);
        if (pn < 32) {
            const int seg = pn >> 2, cb = (pn & 3) * 256;
            if (seg == 4 || seg == 5) {
                PG8_GAS bf16_t* O = (seg == 4) ? QB : KB; const int head = (pn & 3) * 2 + (wc >> 1), i0 = (wc & 1) * 32 + 8 * fq;
#pragma unroll
                for (int ai = 0; ai < 2; ++ai)
#pragma unroll
                    for (int m = 0; m < 4; ++m) { const int row = row0 + ai * HALF + m * 16;
                        const PG8_GAS float* cp = cosh + (size_t)row * 64 + i0; const PG8_GAS float* sp = sinh + (size_t)row * 64 + i0;
                        const f32x4 c0 = *(const PG8_GAS f32x4*)cp, c1 = *(const PG8_GAS f32x4*)(cp + 4), s0 = *(const PG8_GAS f32x4*)sp, s1 = *(const PG8_GAS f32x4*)(sp + 4);
                        const f32x4 xa = acc[ai][0][m][0], xb = acc[ai][0][m][1], ya = acc[ai][1][m][0], yb = acc[ai][1][m][1];
                        PG8_GAS bf16_t* rp = O + (size_t)row * 1024 + head * 128 + i0;
                        *(PG8_GAS u32x4*)rp = pack8(xa * c0 - ya * s0, xb * c1 - yb * s1);
                        *(PG8_GAS u32x4*)(rp + 64) = pack8(xa * s0 + ya * c0, xb * s1 + yb * c1); asm volatile("" ::: "memory"); }
            } else if (seg == 7) {
                const int head = (pn & 3) * 4 + wc, i0 = 8 * fq;
#pragma unroll
                for (int ai = 0; ai < 2; ++ai)
#pragma unroll
                    for (int m = 0; m < 4; ++m) { const int row = row0 + ai * HALF + m * 16;
                        const PG8_GAS float* cp = cosi + (size_t)row * 32 + i0; const PG8_GAS float* sp = sini + (size_t)row * 32 + i0;
                        const f32x4 c0 = *(const PG8_GAS f32x4*)cp, c1 = *(const PG8_GAS f32x4*)(cp + 4), s0 = *(const PG8_GAS f32x4*)sp, s1 = *(const PG8_GAS f32x4*)(sp + 4);
                        const f32x4 xa = acc[ai][0][m][0], xb = acc[ai][0][m][1], ya = acc[ai][1][m][0], yb = acc[ai][1][m][1];
                        PG8_GAS bf16_t* rp = QI + (size_t)row * 1024 + head * 64 + i0;
                        *(PG8_GAS u32x4*)rp = pack8(xa * c0 - ya * s0, xb * c1 - yb * s1);
                        *(PG8_GAS u32x4*)(rp + 32) = pack8(xa * s0 + ya * c0, xb * s1 + yb * c1); asm volatile("" ::: "memory"); }
            } else if (seg == 1) {
#pragma unroll
                for (int bj = 0; bj < 2; ++bj) { const int col = cb + bj * HALF + cw;
                    const f32x4 l0 = *(const PG8_GAS f32x4*)(lb + col), l1 = *(const PG8_GAS f32x4*)(lb + col + 4);
#pragma unroll
                    for (int ai = 0; ai < 2; ++ai)
#pragma unroll
                        for (int m = 0; m < 4; ++m) { const int row = row0 + ai * HALF + m * 16; f32x4 lf[2], kk[2];
#pragma unroll
                            for (int n = 0; n < 2; ++n) { const f32x4 x = acc[ai][bj][m][n]; const f32x4 lv = n ? l1 : l0;
#pragma unroll
                                for (int j = 0; j < 4; ++j) { const float xe = fminf(fmaxf(x[j], -80.f), 80.f), e = __expf(-xe), r = __builtin_amdgcn_rcpf(1.0f + e);
                                    const float om = 1.0f - lv[j]; lf[n][j] = logf(lv[j] + om * r); kk[n][j] = om * (e * r); } }
                            PG8_GAS float* lp = LF + (size_t)row * 1024 + col; *(PG8_GAS f32x4*)lp = lf[0]; *(PG8_GAS f32x4*)(lp + 4) = lf[1];
                            *(PG8_GAS u32x4*)(KA + (size_t)row * 1024 + col) = pack8(kk[0], kk[1]); asm volatile("" ::: "memory"); } }
            } else {
                PG8_GAS bf16_t* O = (seg == 0) ? QA : (seg == 2) ? VA : (seg == 3) ? GA : VB; const bool act = (seg == 0 || seg == 3);
#pragma unroll
                for (int ai = 0; ai < 2; ++ai)
#pragma unroll
                    for (int m = 0; m < 4; ++m) { const int row = row0 + ai * HALF + m * 16;
#pragma unroll
                        for (int bj = 0; bj < 2; ++bj) { f32x4 v0 = acc[ai][bj][m][0], v1 = acc[ai][bj][m][1];
                            if (act) { v0 = silu4(v0); v1 = silu4(v1); }
                            *(PG8_GAS u32x4*)(O + (size_t)row * 1024 + cb + bj * HALF + cw) = pack8(v0, v1); } }
            }
        } else if (pn < 48) {
            PG8_GAS bf16_t* O = (pn < 40) ? SGA : SGB; const int cb = ((pn - 32) & 7) * 256;
#pragma unroll
            for (int ai = 0; ai < 2; ++ai)
#pragma unroll
                for (int m = 0; m < 4; ++m) { const int row = row0 + ai * HALF + m * 16;
#pragma unroll
                    for (int bj = 0; bj < 2; ++bj)
                        *(PG8_GAS u32x4*)(O + (size_t)row * DM + cb + bj * HALF + cw) = pack8(sigm4(acc[ai][bj][m][0]), sigm4(acc[ai][bj][m][1])); }
        } else {
#pragma unroll
            for (int ai = 0; ai < 2; ++ai)
#pragma unroll
                for (int m = 0; m < 4; ++m) { PG8_GAS float* p = IKW + (size_t)(row0 + ai * HALF + m * 16) * 128 + cw; *(PG8_GAS f32x4*)p = acc[ai][0][m][0]; *(PG8_GAS f32x4*)(p + 4) = acc[ai][0][m][1]; }
        }
    }
};
struct EpiGateA {
    static constexpr bool PERM = true, AFTER_DRAIN = false;
    unsigned char* ws;
    __device__ __forceinline__ void operator()(const f32x4 (&acc)[2][2][4][2], const Unit& u, int wr, int wc, int fr, int fq) const {
        unsigned char* const wg = as_global(ws); const bf16_t* const SG = (const bf16_t*)(wg + WS_SGA); bf16_t* const AF = (bf16_t*)(wg + WS_AF);
        const int row0 = u.pm * BM + wr * 64 + fr, col0 = u.pn * BM + wc * 32 + 8 * fq;
#pragma unroll
        for (int ai = 0; ai < 2; ++ai)
#pragma unroll
            for (int m = 0; m < 4; ++m) { const size_t off = (size_t)(row0 + ai * HALF + m * 16) * DM + col0;
#pragma unroll
                for (int bj = 0; bj < 2; ++bj) { f32x4 g0, g1; unpack8(*(const u32x4*)(SG + off + bj * HALF), g0, g1);
                    *(u32x4*)(AF + off + bj * HALF) = pack8(g0 * acc[ai][bj][m][0], g1 * acc[ai][bj][m][1]); } asm volatile("" ::: "memory"); }
    }
};
struct EpiGateB {
    static constexpr bool PERM = true, AFTER_DRAIN = false;
    unsigned char* ws;
    __device__ __forceinline__ void operator()(const f32x4 (&acc)[2][2][4][2], const Unit& u, int wr, int wc, int fr, int fq) const {
        unsigned char* const wg = as_global(ws); const bf16_t* const SG = (const bf16_t*)(wg + WS_SGB); const bf16_t* const AF = (const bf16_t*)(wg + WS_AF); bf16_t* const MG = (bf16_t*)(wg + WS_MG);
        const int row0 = u.pm * BM + wr * 64 + fr, col0 = u.pn * BM + wc * 32 + 8 * fq;
#pragma unroll
        for (int ai = 0; ai < 2; ++ai)
#pragma unroll
            for (int m = 0; m < 4; ++m) { const size_t off = (size_t)(row0 + ai * HALF + m * 16) * DM + col0;
#pragma unroll
                for (int bj = 0; bj < 2; ++bj) { f32x4 g0, g1; unpack8(*(const u32x4*)(SG + off + bj * HALF), g0, g1);
                    f32x4 a0, a1; unpack8(*(const u32x4*)(AF + off + bj * HALF), a0, a1);
                    *(u32x4*)(MG + off + bj * HALF) = pack8(a0 + g0 * acc[ai][bj][m][0], a1 + g1 * acc[ai][bj][m][1]); } asm volatile("" ::: "memory"); }
    }
};
template <bool PLAIN> struct EpiRes {
    static constexpr bool PERM = true, AFTER_DRAIN = false;
    const float* X; const float* g; const float* b; unsigned char* ws;
    __device__ __forceinline__ void operator()(const f32x4 (&acc)[2][2][4][2], const Unit& u, int wr, int wc, int fr, int fq) const {
        unsigned char* const wg = as_global(ws); float* const XP = (float*)(wg + WS_XPRE); const float* const ST = (const float*)(wg + WS_STATS); const float* const Xg = as_global(X);
        const int row0 = u.pm * BM + wr * 64 + fr, col0 = u.pn * BM + wc * 32 + 8 * fq;
        f32x4 gv[2][2], bv[2][2];
        if (!PLAIN) { const float* gg = as_global(g); const float* bb = as_global(b);
#pragma unroll
            for (int bj = 0; bj < 2; ++bj)
#pragma unroll
                for (int n = 0; n < 2; ++n) { gv[bj][n] = *(const f32x4*)(gg + col0 + bj * HALF + 4 * n); bv[bj][n] = *(const f32x4*)(bb + col0 + bj * HALF + 4 * n); } }
#pragma unroll
        for (int ai = 0; ai < 2; ++ai)
#pragma unroll
            for (int m = 0; m < 4; ++m) { const int row = row0 + ai * HALF + m * 16; const size_t off = (size_t)row * DM + col0;
                float mean = 0.f, rstd = 1.f; if (!PLAIN) { const f32x2 s2 = *(const f32x2*)(ST + 2 * (size_t)row); mean = s2[0]; rstd = s2[1]; }
#pragma unroll
                for (int bj = 0; bj < 2; ++bj) { float* p = XP + off + bj * HALF; f32x4 x0, x1;
                    if (PLAIN) { const float* xp = Xg + off + bj * HALF; x0 = *(const f32x4*)xp; x1 = *(const f32x4*)(xp + 4); }
                    else { x0 = (*(const f32x4*)p - mean) * rstd * gv[bj][0] + bv[bj][0]; x1 = (*(const f32x4*)(p + 4) - mean) * rstd * gv[bj][1] + bv[bj][1]; }
                    *(f32x4*)p = x0 * ALPHA + acc[ai][bj][m][0]; *(f32x4*)(p + 4) = x1 * ALPHA + acc[ai][bj][m][1]; } asm volatile("" ::: "memory"); }
    }
};
struct EpiSwiGLU {
    static constexpr bool PERM = true, AFTER_DRAIN = false;
    unsigned char* ws;
    __device__ __forceinline__ void operator()(const f32x4 (&acc)[2][2][4][2], const Unit& u, int wr, int wc, int fr, int fq) const {
        bf16_t* const H = (bf16_t*)(as_global(ws) + WS_H);
        const int row0 = u.pm * BM + wr * 64 + fr, col0 = u.pn * HALF + wc * 32 + 8 * fq;
#pragma unroll
        for (int ai = 0; ai < 2; ++ai)
#pragma unroll
            for (int m = 0; m < 4; ++m)
                *(u32x4*)(H + (size_t)(row0 + ai * HALF + m * 16) * DFF + col0) = pack8(silu4(acc[ai][0][m][0]) * acc[ai][1][m][0], silu4(acc[ai][0][m][1]) * acc[ai][1][m][1]);
    }
};
struct EpiF32P {
    static constexpr bool PERM = true, AFTER_DRAIN = false;
    unsigned char* ws;
    __device__ __forceinline__ void operator()(const f32x4 (&acc)[2][2][4][2], const Unit& u, int wr, int wc, int fr, int fq) const {
        bf16_t* const C = (bf16_t*)(as_global(ws) + WS_PP);
        const int row0 = u.pm * BM + wr * 64 + fr, col0 = u.pn * BM + wc * 32 + 8 * fq;
#pragma unroll
        for (int ai = 0; ai < 2; ++ai)
#pragma unroll
            for (int m = 0; m < 4; ++m) { const size_t off = (size_t)(row0 + ai * HALF + m * 16) * DM + col0;
#pragma unroll
                for (int bj = 0; bj < 2; ++bj) *(u32x4*)(C + off + bj * HALF) = pack8(acc[ai][bj][m][0], acc[ai][bj][m][1]); }
    }
};
struct EpiPle {
    static constexpr bool PERM = true, AFTER_DRAIN = false;
    const float* g; const float* b; unsigned char* ws;
    __device__ __forceinline__ void operator()(const f32x4 (&acc)[2][2][4][2], const Unit& u, int wr, int wc, int fr, int fq) const {
        unsigned char* const wg = as_global(ws); const bf16_t* const PP = (const bf16_t*)(wg + WS_PP); float* const XP = (float*)(wg + WS_XPRE); const float* const ST = (const float*)(wg + WS_STATS);
        const int row0 = u.pm * BM + wr * 64 + fr, col0 = u.pn * BM + wc * 32 + 8 * fq;
        f32x4 gv[2][2], bv[2][2]; { const float* gg = as_global(g); const float* bb = as_global(b);
#pragma unroll
            for (int bj = 0; bj < 2; ++bj)
#pragma unroll
                for (int n = 0; n < 2; ++n) { gv[bj][n] = *(const f32x4*)(gg + col0 + bj * HALF + 4 * n); bv[bj][n] = *(const f32x4*)(bb + col0 + bj * HALF + 4 * n); } }
#pragma unroll
        for (int ai = 0; ai < 2; ++ai)
#pragma unroll
            for (int m = 0; m < 4; ++m) { const int row = row0 + ai * HALF + m * 16; const size_t off = (size_t)row * DM + col0;
                const f32x2 s2 = *(const f32x2*)(ST + 2 * (size_t)row); const float mean = s2[0], rstd = s2[1];
#pragma unroll
                for (int bj = 0; bj < 2; ++bj) { float* p = XP + off + bj * HALF; f32x4 p0, p1; unpack8(*(const u32x4*)(PP + off + bj * HALF), p0, p1);
                    const f32x4 x0 = (*(const f32x4*)p - mean) * rstd * gv[bj][0] + bv[bj][0], x1 = (*(const f32x4*)(p + 4) - mean) * rstd * gv[bj][1] + bv[bj][1];
                    *(f32x4*)p = x0 * ALPHA + sigm4(acc[ai][bj][m][0]) * p0; *(f32x4*)(p + 4) = x1 * ALPHA + sigm4(acc[ai][bj][m][1]) * p1; } asm volatile("" ::: "memory"); }
    }
};

struct EpiRawTest {
    static constexpr bool PERM = true, AFTER_DRAIN = false;
    unsigned char* ws;
    __device__ __forceinline__ void operator()(const f32x4 (&acc)[2][2][4][2], const Unit& u, int wr, int wc, int fr, int fq) const {
        bf16_t* const H = (bf16_t*)(as_global(ws) + WS_H);
        const int row0 = u.pm * BM + wr * 64 + fr, col0 = u.pn * HALF + wc * 32 + 8 * fq;
#pragma unroll
        for (int ai = 0; ai < 2; ++ai)
#pragma unroll
            for (int m = 0; m < 4; ++m)
                *(u32x4*)(H + (size_t)(row0 + ai * HALF + m * 16) * 6272 + col0) = pack8(acc[ai][0][m][0] + acc[ai][1][m][0], acc[ai][0][m][1] + acc[ai][1][m][1]);
    }
};
template <class Epi, class Sched, bool ALIGN_EPI = false, bool SP2 = false>
__device__ __forceinline__ void gemm_phase(PG8_LAS unsigned char* lds, const Gemm g, const Sched& S, const Epi& E) {
    const int tid = tid_(), wid = __builtin_amdgcn_readfirstlane(tid >> 6), lane = tid & 63, wr = wid >> 2, wc = wid & 3, fr = lane & 15, fq = lane >> 4;
    int Kq = g.K; asm volatile("" : "+s"(Kq)); const int K = Kq, nt = K / BK;
    unsigned voffA[2], voffB[2];
#pragma unroll
    for (int i = 0; i < 2; ++i) { int R, C; stage_rc(tid * 16 + i * 8192, R, C); const int Rb = Epi::PERM ? ((R & ~31) + perm32(R & 31)) : R;
        voffA[i] = (unsigned)(R * K + C) * 2u; voffB[i] = (unsigned)(Rb * K + C) * 2u; }
    const size_t kstep = (size_t)(BK * 2);
    const size_t hstep = (size_t)HALF * K * 2;
    const size_t tstep = 2 * hstep;
    const unsigned ldsw = (unsigned)wid * 1024u;
    const int aoff = lds_byte(wr * 64 + fr, fq * 8), boff = lds_byte(wc * 32 + fr, fq * 8);
#define PG8_SA(b, h) (((b) * 2 + (h)) * HTB)
#define PG8_SB(b, h) ((4 + (b) * 2 + (h)) * HTB)
#define PG8_STAGE(bufoff, gbase, voff) do { _Pragma("unroll") for (int _i = 0; _i < 2; ++_i) \
        __builtin_amdgcn_global_load_lds((const unsigned*)((const char*)(gbase) + (voff)[_i]), (PG8_LAS unsigned*)(lds + (bufoff) + ldsw + _i * 8192), 16, 0, 0); } while (0)
#define PG8_LDA(dst, b, h) do { _Pragma("unroll") for (int m = 0; m < 4; ++m) _Pragma("unroll") for (int k = 0; k < 2; ++k) dst[m][k] = *(const PG8_LAS bf16x8*)(lds + PG8_SA(b, h) + aoff + m * 2048 + k * 1024); } while (0)
#define PG8_LDB(dst, b, h) do { _Pragma("unroll") for (int n = 0; n < 2; ++n) _Pragma("unroll") for (int k = 0; k < 2; ++k) dst[n][k] = *(const PG8_LAS bf16x8*)(lds + PG8_SB(b, h) + boff + n * 2048 + k * 1024); } while (0)
#define PG8_MMA(ai, bj, At, Bt) do { __builtin_amdgcn_s_setprio(1); _Pragma("unroll") for (int m = 0; m < 4; ++m) _Pragma("unroll") for (int n = 0; n < 2; ++n) _Pragma("unroll") for (int k = 0; k < 2; ++k) \
        acc[ai][bj][m][n] = __builtin_amdgcn_mfma_f32_16x16x32_bf16(Bt[n][k], At[m][k], acc[ai][bj][m][n], 0, 0, 0); __builtin_amdgcn_s_setprio(0); } while (0)
#define PG8_WAIT_V(n) asm volatile("s_waitcnt vmcnt(" #n ")" ::: "memory")
#define PG8_WAIT_L(n) asm volatile("s_waitcnt lgkmcnt(" #n ")" ::: "memory")
#define PG8_BAR __builtin_amdgcn_s_barrier()
#define PG8_SCHED __builtin_amdgcn_sched_barrier(0)
    Unit cur, nxt; int ui = 0;
    if (!S.next(0, cur)) return;
    f32x4 acc[2][2][4][2];
#pragma unroll
    for (int a = 0; a < 2; ++a)
#pragma unroll
        for (int b = 0; b < 2; ++b)
#pragma unroll
            for (int m = 0; m < 4; ++m)
#pragma unroll
                for (int n = 0; n < 2; ++n) acc[a][b][m][n] = (f32x4){0.f, 0.f, 0.f, 0.f};
    bf16x8 At[4][2], B0[2][2], B1[2][2];
    const char* cA = (const char*)g.A + (size_t)cur.pm * tstep; const char* cB = (const char*)g.Bt + (size_t)cur.pn * tstep;
    S.a_ready(cur);
    if constexpr (SP2) {
        PG8_STAGE(PG8_SB(0, 0), cB, voffB); PG8_STAGE(PG8_SB(0, 1), cB + hstep, voffB); PG8_STAGE(PG8_SA(0, 0), cA, voffA); PG8_STAGE(PG8_SA(0, 1), cA + hstep, voffA);
        if (wr == 1) PG8_BAR;
        PG8_WAIT_V(2); PG8_BAR;
        PG8_STAGE(PG8_SB(1, 0), cB + kstep, voffB); PG8_STAGE(PG8_SA(1, 0), cA + kstep, voffA); PG8_STAGE(PG8_SB(1, 1), cB + hstep + kstep, voffB);
        PG8_WAIT_V(6); PG8_BAR;
    } else {
        PG8_STAGE(PG8_SB(0, 0), cB, voffB); PG8_STAGE(PG8_SA(0, 0), cA, voffA); PG8_STAGE(PG8_SB(0, 1), cB + hstep, voffB); PG8_STAGE(PG8_SA(0, 1), cA + hstep, voffA);
        if (wr == 1) PG8_BAR;
        PG8_WAIT_V(4); PG8_BAR;
        PG8_STAGE(PG8_SB(1, 0), cB + kstep, voffB); PG8_STAGE(PG8_SA(1, 0), cA + kstep, voffA); PG8_STAGE(PG8_SB(1, 1), cB + hstep + kstep, voffB);
        PG8_WAIT_V(6); PG8_BAR;
    }
    for (;;) {
        const bool has_next = S.next(ui + 1, nxt);
        const char* nA = has_next ? (const char*)g.A + (size_t)nxt.pm * tstep : cA; const char* nB = has_next ? (const char*)g.Bt + (size_t)nxt.pn * tstep : cB;
        for (int t = 0; t < nt; t += 2) {
            const bool last = (t == nt - 2);
            const char* a1 = cA + (size_t)(t + 1) * kstep;
            const char* a2 = last ? nA : cA + (size_t)(t + 2) * kstep; const char* b2 = last ? nB : cB + (size_t)(t + 2) * kstep;
            const char* a3 = a2 + kstep; const char* b3 = b2 + kstep;
            if (last && has_next) S.a_ready(nxt);
            if constexpr (SP2) {
            PG8_LDB(B0, 0, 0); PG8_LDB(B1, 0, 1); PG8_SCHED; PG8_LDA(At, 0, 0); PG8_STAGE(PG8_SA(1, 1), a1 + hstep, voffA);
            PG8_WAIT_V(8); PG8_WAIT_L(0); PG8_BAR; PG8_MMA(0, 0, At, B0); PG8_MMA(0, 1, At, B1); PG8_BAR; PG8_SCHED;
            PG8_LDA(At, 0, 1); PG8_STAGE(PG8_SB(0, 0), b2, voffB); PG8_STAGE(PG8_SB(0, 1), b2 + hstep, voffB); PG8_STAGE(PG8_SA(0, 0), a2, voffA);
            PG8_WAIT_V(8); PG8_WAIT_L(0); PG8_BAR; PG8_MMA(1, 0, At, B0); PG8_MMA(1, 1, At, B1); PG8_BAR; PG8_SCHED;
            PG8_LDB(B0, 1, 0); PG8_LDB(B1, 1, 1); PG8_SCHED; PG8_LDA(At, 1, 0); PG8_STAGE(PG8_SA(0, 1), a2 + hstep, voffA);
            PG8_WAIT_V(8); PG8_WAIT_L(0); PG8_BAR; PG8_MMA(0, 0, At, B0); PG8_MMA(0, 1, At, B1); PG8_BAR; PG8_SCHED;
            PG8_LDA(At, 1, 1); PG8_STAGE(PG8_SB(1, 0), b3, voffB); PG8_STAGE(PG8_SB(1, 1), b3 + hstep, voffB); PG8_STAGE(PG8_SA(1, 0), a3, voffA);
            PG8_WAIT_V(8); PG8_WAIT_L(0); PG8_BAR; PG8_MMA(1, 0, At, B0); PG8_MMA(1, 1, At, B1); PG8_BAR; PG8_SCHED;
            } else {
            PG8_LDB(B0, 0, 0); PG8_SCHED; PG8_LDA(At, 0, 0); PG8_STAGE(PG8_SA(1, 1), a1 + hstep, voffA);
            PG8_WAIT_L(8); PG8_BAR; PG8_WAIT_L(0); PG8_MMA(0, 0, At, B0); PG8_BAR; PG8_SCHED;
            PG8_LDB(B1, 0, 1); PG8_STAGE(PG8_SB(0, 0), b2, voffB);
            PG8_BAR; PG8_WAIT_L(0); PG8_MMA(0, 1, At, B1); PG8_BAR;
            PG8_LDA(At, 0, 1); PG8_STAGE(PG8_SA(0, 0), a2, voffA);
            PG8_BAR; PG8_WAIT_L(0); PG8_MMA(1, 0, At, B0); PG8_BAR; PG8_SCHED;
            PG8_STAGE(PG8_SB(0, 1), b2 + hstep, voffB);
            PG8_WAIT_V(6); PG8_BAR; PG8_MMA(1, 1, At, B1); PG8_BAR;
            PG8_LDB(B0, 1, 0); PG8_SCHED; PG8_LDA(At, 1, 0); PG8_STAGE(PG8_SA(0, 1), a2 + hstep, voffA);
            PG8_WAIT_L(8); PG8_BAR; PG8_WAIT_L(0); PG8_MMA(0, 0, At, B0); PG8_BAR; PG8_SCHED;
            PG8_LDB(B1, 1, 1); PG8_STAGE(PG8_SB(1, 0), b3, voffB);
            PG8_BAR; PG8_WAIT_L(0); PG8_MMA(0, 1, At, B1); PG8_BAR;
            PG8_LDA(At, 1, 1); PG8_STAGE(PG8_SA(1, 0), a3, voffA);
            PG8_BAR; PG8_WAIT_L(0); PG8_MMA(1, 0, At, B0); PG8_BAR; PG8_SCHED;
            PG8_STAGE(PG8_SB(1, 1), b3 + hstep, voffB);
            PG8_WAIT_V(6); PG8_BAR; PG8_MMA(1, 1, At, B1); PG8_BAR;
            }
        }
        if constexpr (ALIGN_EPI) { if (wr == 0) PG8_BAR; }
        if constexpr (!Epi::AFTER_DRAIN) { E(acc, cur, wr, wc, fr, fq); S.done(cur); }
        if (!has_next) break;
#pragma unroll
        for (int a = 0; a < 2; ++a)
#pragma unroll
            for (int b = 0; b < 2; ++b)
#pragma unroll
                for (int m = 0; m < 4; ++m)
#pragma unroll
                    for (int n = 0; n < 2; ++n) acc[a][b][m][n] = (f32x4){0.f, 0.f, 0.f, 0.f};
        cur = nxt; cA = nA; cB = nB; ++ui;
        if constexpr (ALIGN_EPI) { if (wr == 1) PG8_BAR; }
    }
    PG8_WAIT_V(0);
    if constexpr (!ALIGN_EPI) { if (wr == 0) PG8_BAR; }
    PG8_BAR;
    if constexpr (Epi::AFTER_DRAIN) { E.fused(acc, cur, wr, wc, fr, fq, lds, wid, lane); S.done(cur); }
#undef PG8_SA
#undef PG8_SB
#undef PG8_STAGE
#undef PG8_LDA
#undef PG8_LDB
#undef PG8_MMA
#undef PG8_WAIT_V
#undef PG8_WAIT_L
#undef PG8_BAR
#undef PG8_SCHED
}
}
#define XB_TMO      128
#define XB_XCNT(j)  (256  + 64 * (j))
#define XB_XSUB(j)  (1280 + 64 * (j))
#define XB_XGEN(j)  (2304 + 64 * (j))
#define XB_TOP      3328
#define XB_TOPGEN   3392
#define XCD_BAR_WORDS 3456
#define XB_SPIN_CAP (1u << 18)
#define LAS __attribute__((address_space(3)))

__device__ __forceinline__ unsigned xb_ld(unsigned* p)              { return __hip_atomic_load(p, __ATOMIC_RELAXED, __HIP_MEMORY_SCOPE_AGENT); }
__device__ __forceinline__ unsigned xb_add(unsigned* p, unsigned v) { return __hip_atomic_fetch_add(p, v, __ATOMIC_RELAXED, __HIP_MEMORY_SCOPE_AGENT); }
__device__ __forceinline__ unsigned xb_xcc_id() { return (unsigned)__builtin_amdgcn_s_getreg((3 << 11) | 20) & 0xFu; }
#define XB_SPIN(cond, bar) do { unsigned _sp = 0; while (cond) { __builtin_amdgcn_s_sleep(1); \
    if ((++_sp & 255u) == 0u) { if (xb_ld(&(bar)[XB_TMO])) break; if (_sp > XB_SPIN_CAP) { atomicAdd(&(bar)[XB_TMO], 1u); break; } } } } while (0)

struct XcdBarrier {
    unsigned* bar; unsigned x;
    volatile LAS unsigned* st;
};

__device__ __forceinline__ XcdBarrier xcd_barrier_post(unsigned* bar, volatile LAS unsigned* st) {
    XcdBarrier b; b.bar = bar; b.x = xb_xcc_id(); b.st = st;
    if (threadIdx.x == 0) (void)xb_add(&bar[XB_XCNT(b.x)], 1u);
    return b;
}
__device__ __forceinline__ void xcd_barrier_complete(unsigned* bar, unsigned x, unsigned& nloc, unsigned& nx) {
    const unsigned G = gridDim.x * gridDim.y * gridDim.z;
    unsigned sum, cnt, mine, sp = 0u;
    for (;;) {
        sum = 0u; cnt = 0u; mine = 0u;
#pragma unroll
        for (unsigned j = 0; j < 16; ++j) { const unsigned c = xb_ld(&bar[XB_XCNT(j)]); sum += c; cnt += (c > 0u) ? 1u : 0u; mine = (j == x) ? c : mine; }
        if (sum == G) break;
        __builtin_amdgcn_s_sleep(1);
        if ((++sp & 255u) == 0u) { if (xb_ld(&bar[XB_TMO])) break; if (sp > XB_SPIN_CAP) { atomicAdd(&bar[XB_TMO], 1u); break; } }
    }
    nloc = mine > 0u ? mine : 1u; nx = cnt > 0u ? cnt : 1u;
}

__device__ __forceinline__ void xcd_barrier(const XcdBarrier& b) {
    asm volatile("s_waitcnt vmcnt(0)" ::: "memory");
    __syncthreads();
    if (threadIdx.x == 0) {
        unsigned* bar = b.bar;
        __builtin_amdgcn_s_waitcnt(0);
        const unsigned bx = xb_xcc_id();
        unsigned nloc = b.st[0], nx = b.st[1];
        if (nloc == 0u) { xcd_barrier_complete(bar, bx, nloc, nx); b.st[0] = nloc; b.st[1] = nx; }
        const unsigned old = xb_add(&bar[XB_XSUB(bx)], 1u);
        const unsigned gen = old / nloc;
        if (old + 1u == (gen + 1u) * nloc) {
            __builtin_amdgcn_fence(__ATOMIC_RELEASE, "agent");
            asm volatile("s_waitcnt vmcnt(0)" ::: "memory");
            const unsigned og = xb_add(&bar[XB_TOP], 1u);
            const unsigned tg = og / nx;
            if (og + 1u == (tg + 1u) * nx) xb_add(&bar[XB_TOPGEN], 1u);
            else XB_SPIN(xb_ld(&bar[XB_TOPGEN]) == tg, bar);
            __builtin_amdgcn_fence(__ATOMIC_ACQUIRE, "agent");
            xb_add(&bar[XB_XGEN(bx)], 1u);
            asm volatile("s_waitcnt vmcnt(0)" ::: "memory");
        } else {
            XB_SPIN(xb_ld(&bar[XB_XGEN(bx)]) == gen, bar);
            __builtin_amdgcn_fence(__ATOMIC_ACQUIRE, "agent");
            asm volatile("s_waitcnt vmcnt(0)" ::: "memory");
        }
    }
    __syncthreads();
}

struct Params {
    const float* x; const float* p; const int* pos;
    const float *w_in, *w_a, *w_b, *w_out, *lbraw, *hnorm_g, *ikn_g, *ikn_b, *lnm_g, *lnm_b, *w_fg, *w_fu, *w_fd, *lnf_g, *lnf_b, *w_pg, *w_pp, *lnp_g, *lnp_b;
    float* out; unsigned char* ws;
    double invf_h[64]; double invf_i[32];
    int ph_lo, ph_hi;
};
typedef const __attribute__((address_space(4))) Params* KP;
__device__ __forceinline__ KP kparams() { KP p = (KP)__builtin_amdgcn_kernarg_segment_ptr(); asm volatile("" : "+s"(p)); return p; }
constexpr int NPH_LAYER = 14, NPH = DEPTH * NPH_LAYER;
constexpr int LDS_BYTES = 131072 + 1024;
constexpr int MISC_OFF = 131072;

__device__ __forceinline__ int wsrc_col_in(int n) {
    const int tile = n >> 8, t = n & 255;
    if (tile < 16) return n;
    if (tile < 24) { const int bj = t >> 7, u = t & 127, head = u >> 6, i = u & 63; return tile * 256 + 128 * head + 64 * bj + i; }
    if (tile < 28) return n;
    if (tile < 32) { const int bj = t >> 7, u = t & 127, head = u >> 5, i = u & 31; return tile * 256 + 64 * head + 32 * bj + i; }
    if (tile < 40) return 8272 + (n - 32 * 256);
    if (tile < 48) return 10320 + (n - 40 * 256);
    return t < 80 ? 8192 + t : -1;
}
constexpr int WC_LD = 144;
template <int KIND>
__device__ __forceinline__ void wconv_wave_tile(const float* src, const float* src2, int nsrc, int K, bf16_t* dst, int n0, int k0, int lane, LAS unsigned char* img) {
    const int n = n0 + lane; int c; const float* s = src;
    if (KIND == 0) c = n;
    else if (KIND == 1) c = wsrc_col_in(n);
    else { const int tl = n >> 8, t = n & 255; c = tl * 128 + (t & 127); if (t >= 128) s = src2; }
    float f[64];
    const float* sp = s + (size_t)k0 * nsrc + (c >= 0 ? c : 0);
#pragma unroll
    for (int kk = 0; kk < 64; ++kk) f[kk] = sp[(size_t)kk * nsrc];
#pragma unroll
    for (int i = 0; i < 8; ++i) { pg8::u32x4 w;
        w.x = pg8::cvt_pk_bf16(f[8 * i], f[8 * i + 1]); w.y = pg8::cvt_pk_bf16(f[8 * i + 2], f[8 * i + 3]); w.z = pg8::cvt_pk_bf16(f[8 * i + 4], f[8 * i + 5]); w.w = pg8::cvt_pk_bf16(f[8 * i + 6], f[8 * i + 7]);
        if (c < 0) w = (pg8::u32x4){0u, 0u, 0u, 0u};
        *(LAS pg8::u32x4*)(img + lane * WC_LD + 16 * i) = w; }
#pragma unroll
    for (int i = 0; i < 8; ++i) { const int p = lane + 64 * i, row = p >> 3, seg = p & 7;
        const pg8::u32x4 w = *(const LAS pg8::u32x4*)(img + row * WC_LD + 16 * seg);
        *(pg8::u32x4*)(dst + (size_t)(n0 + row) * K + k0 + 8 * seg) = w; }
}
template <int KIND>
__device__ __forceinline__ void wconv_job(const float* src, const float* src2, int nsrc, int K, bf16_t* dst, int ndst, int W, int NWV, int lane, LAS unsigned char* img, int& tcount) {
    const int kt = K / 64, ntiles = (ndst / 64) * kt;
    const int nb = ndst / 64; int first = (W - tcount % NWV + NWV) % NWV;
    for (int t = first; t < ntiles; t += NWV) wconv_wave_tile<KIND>(src, src2, nsrc, K, dst, (t % nb) * 64, (t / nb) * 64, lane, img);
    tcount += ntiles;
}
__device__ __forceinline__ void phase_wconv(KP P, int layer, LAS unsigned char* lds) {
    unsigned char* ws = as_global(P->ws); int tc = 0;
    const int tid0 = tid_(), lane = tid0 & 63, wv0 = __builtin_amdgcn_readfirstlane(tid0 >> 6), W = bid_() * 8 + wv0, NWV = nblk_() * 8;
    LAS unsigned char* img = lds + wv0 * (64 * WC_LD);
    wconv_job<1>(as_global(P->w_in) + (size_t)layer * DM * INW, nullptr, INW, DM, (bf16_t*)(ws + WS_WIN), INP, W, NWV, lane, img, tc);
    wconv_job<0>(as_global(P->w_a) + (size_t)layer * AW * DM, nullptr, DM, AW, (bf16_t*)(ws + WS_WA), DM, W, NWV, lane, img, tc);
    wconv_job<0>(as_global(P->w_b) + (size_t)layer * BW * DM, nullptr, DM, BW, (bf16_t*)(ws + WS_WB), DM, W, NWV, lane, img, tc);
    wconv_job<0>(as_global(P->w_out) + (size_t)layer * DM * DM, nullptr, DM, DM, (bf16_t*)(ws + WS_WO), DM, W, NWV, lane, img, tc);
    wconv_job<2>(as_global(P->w_fg) + (size_t)layer * DM * DFF, as_global(P->w_fu) + (size_t)layer * DM * DFF, DFF, DM, (bf16_t*)(ws + WS_WGU), 2 * DFF, W, NWV, lane, img, tc);
    wconv_job<0>(as_global(P->w_fd) + (size_t)layer * DFF * DM, nullptr, DM, DFF, (bf16_t*)(ws + WS_WDN), DM, W, NWV, lane, img, tc);
    wconv_job<0>(as_global(P->w_pg) + (size_t)layer * DM * DM, nullptr, DM, DM, (bf16_t*)(ws + WS_WPG), DM, W, NWV, lane, img, tc);
    wconv_job<0>(as_global(P->w_pp) + (size_t)layer * PLE * DM, nullptr, DM, PLE, (bf16_t*)(ws + WS_WPP), DM, W, NWV, lane, img, tc);
    const float* ps = as_global(P->p) + (size_t)layer * TOK * PLE; bf16_t* pb = (bf16_t*)(ws + WS_PB);
    for (size_t i = ((size_t)bid_() * 512 + tid_()) * 8; i < (size_t)TOK * PLE; i += (size_t)nblk_() * 512 * 8)
        *(pg8::u32x4*)(pb + i) = pg8::pack8(*(const pg8::f32x4*)(ps + i), *(const pg8::f32x4*)(ps + i + 4));
}
__device__ __forceinline__ void phase_prologue(KP P) {
    unsigned char* ws = as_global(P->ws); const size_t gtid = (size_t)bid_() * 512 + tid_(), gsz = (size_t)nblk_() * 512;
    bf16_t* xb = (bf16_t*)(ws + WS_XB); const float* xin = as_global(P->x); const int* posg = as_global(P->pos); const float* lbr = as_global(P->lbraw);
    for (size_t i = gtid * 8; i < (size_t)TOK * DM; i += gsz * 8) *(pg8::u32x4*)(xb + i) = pg8::pack8(*(const pg8::f32x4*)(xin + i), *(const pg8::f32x4*)(xin + i + 4));
    float* ch = (float*)(ws + WS_COSH); float* sh = (float*)(ws + WS_SINH); float* ci = (float*)(ws + WS_COSI); float* si = (float*)(ws + WS_SINI);
    for (size_t i = gtid; i < (size_t)TOK * 64; i += gsz) { const int t = (int)(i >> 6), j = (int)(i & 63); const double rev = (double)posg[t] * P->invf_h[j]; const float fr = (float)(rev - rint(rev));
        ch[i] = __builtin_amdgcn_cosf(fr); sh[i] = __builtin_amdgcn_sinf(fr); }
    for (size_t i = gtid; i < (size_t)TOK * 32; i += gsz) { const int t = (int)(i >> 5), j = (int)(i & 31); const double rev = (double)posg[t] * P->invf_i[j]; const float fr = (float)(rev - rint(rev));
        ci[i] = __builtin_amdgcn_cosf(fr); si[i] = __builtin_amdgcn_sinf(fr); }
    float* lb = (float*)(ws + WS_LB);
    for (size_t c = gtid; c < 1024; c += gsz) { float v[4], mx = -1e30f; for (int l = 0; l < 4; ++l) { v[l] = lbr[l * 1024 + c]; mx = fmaxf(mx, v[l]); }
        float s = 0.f; for (int l = 0; l < 4; ++l) { v[l] = expf(v[l] - mx); s += v[l]; }
        float cum = 0.f; const float inv = 1.0f / s; for (int l = 0; l < 4; ++l) { cum += v[l] * inv; lb[l * 1024 + c] = cum - v[0] * inv; } }
}
__device__ __forceinline__ void phase_ln(const float* XP, float* OUT, bf16_t* XB, float* ST, const float* g, const float* b) {
    const int tid = tid_(), wave = __builtin_amdgcn_readfirstlane(tid >> 6), lane = tid & 63, nb8 = nblk_() * 8;
    for (int row = bid_() * 8 + wave; row < TOK; row += nb8) {
        const float* xp = XP + (size_t)row * DM; pg8::f32x4 v[8]; float s = 0.f;
#pragma unroll
        for (int c = 0; c < 8; ++c) { v[c] = *(const pg8::f32x4*)(xp + c * 256 + lane * 4); s += (v[c][0] + v[c][1]) + (v[c][2] + v[c][3]); }
#pragma unroll
        for (int o = 32; o >= 1; o >>= 1) s += __shfl_xor(s, o);
        const float mean = s * (1.0f / DM); float q = 0.f;
#pragma unroll
        for (int c = 0; c < 8; ++c) { v[c] = v[c] - mean; q += (v[c][0] * v[c][0] + v[c][1] * v[c][1]) + (v[c][2] * v[c][2] + v[c][3] * v[c][3]); }
#pragma unroll
        for (int o = 32; o >= 1; o >>= 1) q += __shfl_xor(q, o);
        const float rstd = 1.0f / sqrtf(q * (1.0f / DM) + LN_EPS);
        if (lane == 0) { pg8::f32x2 s2; s2[0] = mean; s2[1] = rstd; *(pg8::f32x2*)(ST + 2 * (size_t)row) = s2; }
#pragma unroll
        for (int c = 0; c < 8; ++c) { const int col = c * 256 + lane * 4; const pg8::f32x4 gg = *(const pg8::f32x4*)(g + col), bb = *(const pg8::f32x4*)(b + col);
            const pg8::f32x4 y = v[c] * rstd * gg + bb; if (OUT) *(pg8::f32x4*)(OUT + (size_t)row * DM + col) = y;
            pg8::u32x2 w; w.x = pg8::cvt_pk_bf16(y[0], y[1]); w.y = pg8::cvt_pk_bf16(y[2], y[3]); *(pg8::u32x2*)(XB + (size_t)row * DM + col) = w; }
    }
}
__device__ __forceinline__ void phase_ikprep(KP P, int layer) {
    unsigned char* ws = as_global(P->ws); const float* ikw = (const float*)(ws + WS_IKW); bf16_t* ki = (bf16_t*)(ws + WS_KI); float* wi = (float*)(ws + WS_WI);
    const float* ci = (const float*)(ws + WS_COSI); const float* si = (const float*)(ws + WS_SINI);
    const int tid = tid_(), wave = __builtin_amdgcn_readfirstlane(tid >> 6), lane = tid & 63, nb8 = nblk_() * 8;
    const float g = as_global(P->ikn_g)[layer * 64 + lane], b = as_global(P->ikn_b)[layer * 64 + lane];
    for (int t = bid_() * 8 + wave; t < TOK; t += nb8) {
        const float x = ikw[(size_t)t * 128 + lane]; float s = x;
#pragma unroll
        for (int o = 32; o >= 1; o >>= 1) s += __shfl_xor(s, o);
        const float mean = s * (1.0f / 64.0f), xc = x - mean; float q = xc * xc;
#pragma unroll
        for (int o = 32; o >= 1; o >>= 1) q += __shfl_xor(q, o);
        const float y = xc * (1.0f / sqrtf(q * (1.0f / 64.0f) + LN_EPS)) * g + b;
        const float other = __shfl_xor(y, 32); const int j = lane & 31; const float c = ci[(size_t)t * 32 + j], sn = si[(size_t)t * 32 + j];
        const float r = (lane < 32) ? (y * c - other * sn) : (other * sn + y * c);
        ki[(size_t)t * 64 + lane] = f2bf(r);
        if (lane < 16) wi[(size_t)t * 16 + lane] = ikw[(size_t)t * 128 + 64 + lane] * IDX_SCALE;
    }
}
typedef short bf16x8_t __attribute__((ext_vector_type(8)));
typedef short bf16x4_t __attribute__((ext_vector_type(4)));
typedef float f32x16_t __attribute__((ext_vector_type(16)));
constexpr int CUM_LD = 132;
constexpr int OPK_LD = 136;
constexpr int OPS_LD = 72;

__device__ __forceinline__ void hgrn_scan_load(const float* LF, int tok0, int h, int tid, float (&v)[16]) {
    const int k = tid & 127, qd = tid >> 7;
#pragma unroll
    for (int i = 0; i < 16; ++i) v[i] = LF[(size_t)(tok0 + qd * 16 + i) * 1024 + h * 128 + k];
}
__device__ __forceinline__ void hgrn_scan_cum(float (&v)[16], LAS float* cum, LAS float* tot, int tid) {
    const int k = tid & 127, qd = tid >> 7;
    float run = 0.f;
#pragma unroll
    for (int i = 0; i < 16; ++i) { run += v[i]; v[i] = run; }
    tot[qd * 128 + k] = run;
    __syncthreads();
    float off = 0.f;
#pragma unroll
    for (int q = 0; q < 3; ++q) off += (q < qd) ? tot[q * 128 + k] : 0.f;
#pragma unroll
    for (int i = 0; i < 16; ++i) cum[(qd * 16 + i) * CUM_LD + k] = v[i] + off;
    __syncthreads();
}

struct H1Pre { float lf[16]; unsigned ka[8], va[8]; };
__device__ __forceinline__ void h1_load(const bf16_t* KA, const bf16_t* VA, const float* LF, int unit, int tid, H1Pre& p) {
    const int c = unit & 63, h = (unit >> 6) & 7, b = unit >> 9, tok0 = b * SEQ + c * 64;
    hgrn_scan_load(LF, tok0, h, tid, p.lf);
#pragma unroll
    for (int it = 0; it < 8; ++it) { const int idx = tid + 512 * it, k = idx & 127, s = 2 * (idx >> 7); const size_t g0 = (size_t)(tok0 + s) * 1024 + h * 128 + k;
        p.ka[it] = (unsigned)KA[g0] | ((unsigned)KA[g0 + 1024] << 16); p.va[it] = (unsigned)VA[g0] | ((unsigned)VA[g0 + 1024] << 16); }
}
__device__ __forceinline__ void phase_hgrn_h1(KP P, LAS unsigned char* lds) {
    unsigned char* ws = as_global(P->ws);
    const bf16_t* KA = (const bf16_t*)(ws + WS_KA); const bf16_t* VA = (const bf16_t*)(ws + WS_VA); const float* LF = (const float*)(ws + WS_LF);
    bf16_t* LT = (bf16_t*)(ws + WS_LT); float* DEC = (float*)(ws + WS_DEC);
    const int tid = tid_(), lane = tid & 63, wave = __builtin_amdgcn_readfirstlane(tid >> 6), r = lane & 31, hh = lane >> 5, G = nblk_();
    LAS float* cum = (LAS float*)lds; LAS float* tot = cum + 64 * CUM_LD;
    LAS bf16_t* kdT = (LAS bf16_t*)(tot + 512); LAS bf16_t* vT = kdT + 128 * OPS_LD;
    constexpr int NU = NBATCH * AH * 64;
    H1Pre pre; int unit = bid_();
    if (unit < NU) h1_load(KA, VA, LF, unit, tid, pre);
    for (; unit < NU; unit += G) {
        hgrn_scan_cum(pre.lf, cum, tot, tid);
#pragma unroll
        for (int it = 0; it < 8; ++it) { const int idx = tid + 512 * it, k = idx & 127, sp = idx >> 7, s = 2 * sp;
            const float last = cum[63 * CUM_LD + k];
            const float k0 = __uint_as_float(pre.ka[it] << 16) * __expf(last - cum[s * CUM_LD + k]), k1 = __uint_as_float(pre.ka[it] & 0xffff0000u) * __expf(last - cum[(s + 1) * CUM_LD + k]);
            *(LAS unsigned*)(kdT + k * OPS_LD + s) = pg8::cvt_pk_bf16(k0, k1);
            *(LAS unsigned*)(vT + k * OPS_LD + s) = pre.va[it]; }
        if (tid < 128) DEC[(size_t)unit * 128 + tid] = __expf(cum[63 * CUM_LD + tid]);
        if (unit + G < NU) h1_load(KA, VA, LF, unit + G, tid, pre);
        __syncthreads();
        const int mb = wave >> 1, nb0 = (wave & 1) * 2;
        f32x16_t acc[2];
#pragma unroll
        for (int n = 0; n < 2; ++n)
#pragma unroll
            for (int i = 0; i < 16; ++i) acc[n][i] = 0.f;
#pragma unroll
        for (int ks = 0; ks < 4; ++ks) { const bf16x8_t a = *(const LAS bf16x8_t*)(kdT + (32 * mb + r) * OPS_LD + 16 * ks + 8 * hh);
#pragma unroll
            for (int n = 0; n < 2; ++n) { const bf16x8_t bb = *(const LAS bf16x8_t*)(vT + (32 * (nb0 + n) + r) * OPS_LD + 16 * ks + 8 * hh);
                acc[n] = __builtin_amdgcn_mfma_f32_32x32x16_bf16(a, bb, acc[n], 0, 0, 0); } }
#pragma unroll
        for (int n = 0; n < 2; ++n) { bf16_t* dst = LT + (size_t)unit * 16384 + (size_t)(32 * (nb0 + n) + r) * 128 + 32 * mb + 4 * hh;
#pragma unroll
            for (int g = 0; g < 4; ++g) { pg8::u32x2 o; o.x = pg8::cvt_pk_bf16(acc[n][4 * g], acc[n][4 * g + 1]); o.y = pg8::cvt_pk_bf16(acc[n][4 * g + 2], acc[n][4 * g + 3]); *(pg8::u32x2*)(dst + 8 * g) = o; } }
        __syncthreads();
    }
}

__device__ __forceinline__ void phase_hgrn_h2(KP P) {
    unsigned char* ws = as_global(P->ws);
    const bf16_t* LT = (const bf16_t*)(ws + WS_LT); const float* DEC = (const float*)(ws + WS_DEC); bf16_t* PT = (bf16_t*)(ws + WS_PT);
    const int tid = tid_(), G = nblk_();
    for (int oct = bid_() * 512 + tid; oct < NBATCH * AH * 2048; oct += G * 512) {
        const int bh = oct >> 11, rem = oct & 2047, v = rem >> 4, k0 = (rem & 15) * 8;
        const size_t e0 = (size_t)bh * 64 * 16384 + (size_t)v * 128 + k0; const size_t d0 = (size_t)bh * 64 * 128 + k0;
        pg8::f32x4 S0 = {0.f, 0.f, 0.f, 0.f}, S1 = {0.f, 0.f, 0.f, 0.f};
        for (int c0 = 0; c0 < 64; c0 += 4) { pg8::u32x4 Lc[4]; pg8::f32x4 Da[4], Db[4];
#pragma unroll
            for (int j = 0; j < 4; ++j) { Lc[j] = *(const pg8::u32x4*)(LT + e0 + (size_t)(c0 + j) * 16384); Da[j] = *(const pg8::f32x4*)(DEC + d0 + (size_t)(c0 + j) * 128); Db[j] = *(const pg8::f32x4*)(DEC + d0 + (size_t)(c0 + j) * 128 + 4); }
#pragma unroll
            for (int j = 0; j < 4; ++j) { *(pg8::u32x4*)(PT + e0 + (size_t)(c0 + j) * 16384) = pg8::pack8(S0, S1);
                pg8::f32x4 l0, l1; pg8::unpack8(Lc[j], l0, l1); S0 = Da[j] * S0 + l0; S1 = Db[j] * S1 + l1; } }
    }
}

struct H3Pre { float lf[16]; unsigned qw[8], kw[8], vv[8]; bf16x8_t pt[8]; pg8::u32x2 ga[4]; };
__device__ __forceinline__ void h3_load(const bf16_t* QA, const bf16_t* KA, const bf16_t* VA, const bf16_t* GA, const float* LF, const bf16_t* PT, int unit, int tid, H3Pre& p) {
    const int c = unit & 63, h = (unit >> 6) & 7, b = unit >> 9, tok0 = b * SEQ + c * 64;
    const int lane = tid & 63, wave = __builtin_amdgcn_readfirstlane(tid >> 6), r = lane & 31, hh = lane >> 5, mb = wave >> 1, tb = wave & 1;
    hgrn_scan_load(LF, tok0, h, tid, p.lf);
#pragma unroll
    for (int it = 0; it < 8; ++it) { const int idx = tid + 512 * it, kp = (idx & 63) * 2, t = idx >> 6; const size_t g0 = (size_t)(tok0 + t) * 1024 + h * 128 + kp;
        p.qw[it] = *(const unsigned*)(QA + g0); p.kw[it] = *(const unsigned*)(KA + g0); }
#pragma unroll
    for (int it = 0; it < 8; ++it) { const int idx = tid + 512 * it, v = idx & 127, s = 2 * (idx >> 7); const size_t g0 = (size_t)(tok0 + s) * 1024 + h * 128 + v;
        p.vv[it] = (unsigned)VA[g0] | ((unsigned)VA[g0 + 1024] << 16); }
    const bf16_t* prow = PT + (size_t)unit * 16384 + (size_t)(32 * mb + r) * 128 + 8 * hh;
#pragma unroll
    for (int k8 = 0; k8 < 8; ++k8) p.pt[k8] = *(const bf16x8_t*)(prow + 16 * k8);
    const size_t orow = (size_t)(tok0 + 32 * tb + r) * 1024 + h * 128;
#pragma unroll
    for (int g = 0; g < 4; ++g) p.ga[g] = *(const pg8::u32x2*)(GA + orow + 32 * mb + 8 * g + 4 * hh);
}
__device__ __forceinline__ void phase_hgrn_h3(KP P, int layer, LAS unsigned char* lds) {
    unsigned char* ws = as_global(P->ws);
    const bf16_t* QA = (const bf16_t*)(ws + WS_QA); const bf16_t* KA = (const bf16_t*)(ws + WS_KA); const bf16_t* VA = (const bf16_t*)(ws + WS_VA); const bf16_t* GA = (const bf16_t*)(ws + WS_GA);
    const float* LF = (const float*)(ws + WS_LF); const bf16_t* PT = (const bf16_t*)(ws + WS_PT); bf16_t* YA = (bf16_t*)(ws + WS_YA);
    const float* ng = as_global(P->hnorm_g) + layer * 128;
    const int tid = tid_(), lane = tid & 63, wave = __builtin_amdgcn_readfirstlane(tid >> 6), r = lane & 31, hh = lane >> 5, G = nblk_();
    LAS float* cum = (LAS float*)lds; LAS float* tot = cum + 64 * CUM_LD; LAS float* ssq = tot + 512;
    LAS bf16_t* qd = (LAS bf16_t*)(ssq + 256); LAS bf16_t* qs = qd + 64 * OPK_LD; LAS bf16_t* ks = qs + 64 * OPK_LD; LAS bf16_t* vT = ks + 64 * OPK_LD;
    constexpr int NU = NBATCH * AH * 64;
    const int mb = wave >> 1, tb = wave & 1;
    H3Pre pre; int unit = bid_();
    if (unit < NU) h3_load(QA, KA, VA, GA, LF, PT, unit, tid, pre);
    for (; unit < NU; unit += G) {
        const int c = unit & 63, h = (unit >> 6) & 7, b = unit >> 9, tok0 = b * SEQ + c * 64;
#ifdef H3_DUP_SCAN
        { float tmp[16];
#pragma unroll
          for (int i = 0; i < 16; ++i) tmp[i] = pre.lf[i];
          hgrn_scan_cum(tmp, cum, tot, tid); }
#endif
        hgrn_scan_cum(pre.lf, cum, tot, tid);
#ifdef H3_DUP_BUILD
        for (int rep_b = 0; rep_b < 2; ++rep_b) {
#else
        {
#endif
#pragma unroll
        for (int it = 0; it < 8; ++it) { const int idx = tid + 512 * it, kp = (idx & 63) * 2, t = idx >> 6;
            const unsigned qw = pre.qw[it], kw = pre.kw[it];
            const float c0 = cum[t * CUM_LD + kp], c1 = cum[t * CUM_LD + kp + 1], r0 = cum[31 * CUM_LD + kp], r1 = cum[31 * CUM_LD + kp + 1];
            const float q0 = __uint_as_float(qw << 16), q1 = __uint_as_float(qw & 0xffff0000u), k0 = __uint_as_float(kw << 16), k1 = __uint_as_float(kw & 0xffff0000u);
            *(LAS unsigned*)(qd + t * OPK_LD + kp) = pg8::cvt_pk_bf16(q0 * __expf(c0), q1 * __expf(c1));
            *(LAS unsigned*)(qs + t * OPK_LD + kp) = pg8::cvt_pk_bf16(q0 * __expf(c0 - r0), q1 * __expf(c1 - r1));
            *(LAS unsigned*)(ks + t * OPK_LD + kp) = pg8::cvt_pk_bf16(k0 * __expf(r0 - c0), k1 * __expf(r1 - c1)); }
#pragma unroll
        for (int it = 0; it < 8; ++it) { const int idx = tid + 512 * it, v = idx & 127, s = 2 * (idx >> 7); *(LAS unsigned*)(vT + v * OPS_LD + s) = pre.vv[it]; }
        }
        bf16x8_t ptc[8]; pg8::u32x2 gac[4];
#pragma unroll
        for (int k8 = 0; k8 < 8; ++k8) ptc[k8] = pre.pt[k8];
#pragma unroll
        for (int g = 0; g < 4; ++g) gac[g] = pre.ga[g];
        if (unit + G < NU) h3_load(QA, KA, VA, GA, LF, PT, unit + G, tid, pre);
        __syncthreads();
        f32x16_t acc;
#ifdef H3_DUP_MMA
        for (int rep_m = 0; rep_m < 2; ++rep_m) {
#else
        {
#endif
#pragma unroll
        for (int i = 0; i < 16; ++i) acc[i] = 0.f;
#pragma unroll
        for (int k8 = 0; k8 < 8; ++k8) { const bf16x8_t bq = *(const LAS bf16x8_t*)(qd + (32 * tb + r) * OPK_LD + 16 * k8 + 8 * hh);
            acc = __builtin_amdgcn_mfma_f32_32x32x16_bf16(ptc[k8], bq, acc, 0, 0, 0); }
#pragma unroll
        for (int sb = 0; sb < 2; ++sb) if (sb <= tb) {
            f32x16_t sc;
#pragma unroll
            for (int i = 0; i < 16; ++i) sc[i] = 0.f;
#pragma unroll
            for (int k8 = 0; k8 < 8; ++k8) { const bf16x8_t a = *(const LAS bf16x8_t*)(ks + (32 * sb + r) * OPK_LD + 16 * k8 + 8 * hh); const bf16x8_t bq = *(const LAS bf16x8_t*)(qs + (32 * tb + r) * OPK_LD + 16 * k8 + 8 * hh);
                sc = __builtin_amdgcn_mfma_f32_32x32x16_bf16(a, bq, sc, 0, 0, 0); }
            if (sb == tb) {
#pragma unroll
                for (int i = 0; i < 16; ++i) { const int sl = 8 * (i >> 2) + 4 * hh + (i & 3); sc[i] = (sl <= r) ? sc[i] : 0.f; } }
#pragma unroll
            for (int u = 0; u < 2; ++u) {
                pg8::u32x4 pw; pw.x = pg8::cvt_pk_bf16(sc[8 * u], sc[8 * u + 1]); pw.y = pg8::cvt_pk_bf16(sc[8 * u + 2], sc[8 * u + 3]); pw.z = pg8::cvt_pk_bf16(sc[8 * u + 4], sc[8 * u + 5]); pw.w = pg8::cvt_pk_bf16(sc[8 * u + 6], sc[8 * u + 7]);
                const bf16x8_t pb = __builtin_bit_cast(bf16x8_t, pw);
                const LAS bf16_t* vrow = vT + (32 * mb + r) * OPS_LD + 32 * sb + 16 * u + 4 * hh;
                const bf16x4_t lo = *(const LAS bf16x4_t*)vrow, hi4 = *(const LAS bf16x4_t*)(vrow + 8);
                const bf16x8_t va = {lo[0], lo[1], lo[2], lo[3], hi4[0], hi4[1], hi4[2], hi4[3]};
                acc = __builtin_amdgcn_mfma_f32_32x32x16_bf16(va, pb, acc, 0, 0, 0); }
        }
        }
        float ss = 0.f;
#pragma unroll
        for (int i = 0; i < 16; ++i) ss += acc[i] * acc[i];
        ss += __shfl_xor(ss, 32);
        if (hh == 0) ssq[mb * 64 + 32 * tb + r] = ss;
        __syncthreads();
        const int t = 32 * tb + r;
        const float tot2 = (ssq[t] + ssq[64 + t]) + (ssq[128 + t] + ssq[192 + t]);
        const float rs = 1.0f / sqrtf(tot2 * (1.0f / 128.0f) + RMS_EPS);
        const size_t orow = (size_t)(tok0 + t) * 1024 + h * 128;
#pragma unroll
        for (int g = 0; g < 4; ++g) { const int v0 = 32 * mb + 8 * g + 4 * hh;
            const pg8::u32x2 gw = gac[g]; const pg8::f32x4 nv = *(const pg8::f32x4*)(ng + v0);
            const float y0 = acc[4 * g] * rs * nv[0] * __uint_as_float(gw.x << 16), y1 = acc[4 * g + 1] * rs * nv[1] * __uint_as_float(gw.x & 0xffff0000u);
            const float y2 = acc[4 * g + 2] * rs * nv[2] * __uint_as_float(gw.y << 16), y3 = acc[4 * g + 3] * rs * nv[3] * __uint_as_float(gw.y & 0xffff0000u);
            pg8::u32x2 w; w.x = pg8::cvt_pk_bf16(y0, y1); w.y = pg8::cvt_pk_bf16(y2, y3); *(pg8::u32x2*)(YA + orow + v0) = w; }
        __syncthreads();
    }
}
namespace at {
constexpr int D = 128, NW = 8, QBLK = 32, KVBLK = 64, LDQ = 1024, LDK = 1024;
constexpr float SCALE = ATTN_SCALE, THR = 8.f;
constexpr size_t SHM_V = KVBLK * D * 2, SHM_K = KVBLK * D * 2, SHM_ATTN = 2 * SHM_V + 2 * SHM_K + NW * 64 * 4;
using bf16x8 = __attribute__((ext_vector_type(8))) short;
using s16x4  = __attribute__((ext_vector_type(4))) short;
using f32x16 = __attribute__((ext_vector_type(16))) float;
using u32x4  = __attribute__((ext_vector_type(4))) unsigned;
#define AT_KSWZ(row, colB) ((row) * 256 + ((colB) ^ (((row) & 7) << 4)))
#define AT_SBAR() __builtin_amdgcn_sched_barrier(0)
__device__ __forceinline__ int crow(int r, int hi) { return (r & 3) + 8 * (r >> 2) + 4 * hi; }
__device__ __forceinline__ unsigned cvtpk(float lo, float hi) { return pg8::cvt_pk_bf16(lo, hi); }

__device__ __forceinline__ void partialSM(f32x16& p0, f32x16& p1, float& m_reg, float& mn, float& alpha) {
  constexpr float C = SCALE * 1.4426950408889634f;
  float pmax = p0[0];
#pragma unroll
  for (int r = 1; r < 16; ++r) pmax = fmaxf(pmax, p0[r]);
#pragma unroll
  for (int r = 0; r < 16; ++r) pmax = fmaxf(pmax, p1[r]);
  { auto rr = __builtin_amdgcn_permlane32_swap(__float_as_uint(pmax), __float_as_uint(pmax), false, false);
    pmax = fmaxf(__uint_as_float(rr[0]), __uint_as_float(rr[1])); }
  if (__builtin_expect(__all(pmax - m_reg <= THR / SCALE), 1)) { mn = m_reg; alpha = 1.f; }
  else { mn = fmaxf(m_reg, pmax); alpha = __builtin_amdgcn_exp2f((m_reg - mn) * C); m_reg = mn; }
  float mnC = -mn * C;
#pragma unroll
  for (int r = 0; r < 16; ++r) p0[r] = fmaf(p0[r], C, mnC);
#pragma unroll
  for (int r = 0; r < 16; ++r) p1[r] = fmaf(p1[r], C, mnC);
#pragma unroll
  for (int r = 0; r < 16; ++r) p0[r] = __builtin_amdgcn_exp2f(p0[r]);
}
__device__ __forceinline__ void finishSM(f32x16& p0, f32x16& p1, float alpha, float& l_reg, int mlo, int mhi, bf16x8& pa0, bf16x8& pa1, bf16x8& pa2, bf16x8& pa3) {
#pragma unroll
  for (int r = 0; r < 16; ++r) p1[r] = __builtin_amdgcn_exp2f(p1[r]);
#pragma unroll
  for (int r = 0; r < 16; ++r) { const int bit = (r & 3) + 8 * (r >> 2);
    p0[r] = __uint_as_float(__float_as_uint(p0[r]) & (unsigned)__builtin_amdgcn_sbfe(mlo, bit, 1));
    p1[r] = __uint_as_float(__float_as_uint(p1[r]) & (unsigned)__builtin_amdgcn_sbfe(mhi, bit, 1)); }
  float ps = 0;
#pragma unroll
  for (int r = 0; r < 16; ++r) ps += p0[r];
#pragma unroll
  for (int r = 0; r < 16; ++r) ps += p1[r];
  { auto rr = __builtin_amdgcn_permlane32_swap(__float_as_uint(ps), __float_as_uint(ps), false, false);
    ps = __uint_as_float(rr[0]) + __uint_as_float(rr[1]); }
  l_reg = l_reg * alpha + ps;
#define AT_PK4(P, BASE, OUT) do { unsigned a0 = cvtpk(P[BASE + 0], P[BASE + 1]), a1 = cvtpk(P[BASE + 2], P[BASE + 3]);   \
    unsigned b0 = cvtpk(P[BASE + 4], P[BASE + 5]), b1 = cvtpk(P[BASE + 6], P[BASE + 7]);                              \
    auto r0 = __builtin_amdgcn_permlane32_swap(a0, b0, false, false); auto r1 = __builtin_amdgcn_permlane32_swap(a1, b1, false, false); \
    u32x4 w = {r0[0], r1[0], r0[1], r1[1]}; OUT = *reinterpret_cast<bf16x8*>(&w); } while (0)
  AT_PK4(p0, 0, pa0); AT_PK4(p0, 8, pa1); AT_PK4(p1, 0, pa2); AT_PK4(p1, 8, pa3);
#undef AT_PK4
}
__device__ __forceinline__ void qkt(f32x16& p0, f32x16& p1, const LAS char* Ks, const bf16x8* qr, int r32, int hi) {
  p0 = f32x16{}; p1 = f32x16{};
#pragma unroll
  for (int d0 = 0; d0 < 8; ++d0) { int cb = (d0 * 16 + hi * 8) * 2;
    bf16x8 b0 = *reinterpret_cast<const LAS bf16x8*>(Ks + AT_KSWZ(r32, cb));
    bf16x8 b1 = *reinterpret_cast<const LAS bf16x8*>(Ks + AT_KSWZ(32 + r32, cb));
    p0 = __builtin_amdgcn_mfma_f32_32x32x16_bf16(b0, qr[d0], p0, 0, 0, 0);
    p1 = __builtin_amdgcn_mfma_f32_32x32x16_bf16(b1, qr[d0], p1, 0, 0, 0); }
}
__device__ __forceinline__ int v_st(int k, int c) { const int kk = (k & ~0xC) | ((k & 4) << 1) | ((k & 8) >> 1); return ((kk >> 3) * 4 + (c >> 5)) * 512 + ((kk & 7) * 32 + (c & 31)) * 2; }
__device__ __forceinline__ int v_rd_base(int lane) { return ((lane & 3) << 3) | (((lane >> 2) & 3) << 6) | (((lane >> 4) & 1) << 5) | (((lane >> 5) & 1) << 8); }
constexpr int v_rd_off(int d0, int ks, int half) { return d0 * 512 + ks * 4096 + half * 2048; }
template <int OFF> __device__ __forceinline__ s16x4 tr_read(int vb) {
  s16x4 r; asm volatile("ds_read_b64_tr_b16 %0, %1 offset:%2" : "=&v"(r) : "v"(vb), "i"(OFF) : "memory"); return r;
}
template <int D0> __device__ __forceinline__ void pv_one(f32x16& od, int vb, bf16x8 pa0, bf16x8 pa1, bf16x8 pa2, bf16x8 pa3) {
  const s16x4 l0 = tr_read<v_rd_off(D0, 0, 0)>(vb), h0 = tr_read<v_rd_off(D0, 0, 1)>(vb), l1 = tr_read<v_rd_off(D0, 1, 0)>(vb), h1 = tr_read<v_rd_off(D0, 1, 1)>(vb);
  const s16x4 l2 = tr_read<v_rd_off(D0, 2, 0)>(vb), h2 = tr_read<v_rd_off(D0, 2, 1)>(vb), l3 = tr_read<v_rd_off(D0, 3, 0)>(vb), h3 = tr_read<v_rd_off(D0, 3, 1)>(vb);
  asm volatile("s_waitcnt lgkmcnt(0)" ::: "memory"); AT_SBAR();
#define AT_PK(L_, H_) (bf16x8){L_[0], L_[1], L_[2], L_[3], H_[0], H_[1], H_[2], H_[3]}
  od = __builtin_amdgcn_mfma_f32_32x32x16_bf16(pa0, AT_PK(l0, h0), od, 0, 0, 0);
  od = __builtin_amdgcn_mfma_f32_32x32x16_bf16(pa1, AT_PK(l1, h1), od, 0, 0, 0);
  od = __builtin_amdgcn_mfma_f32_32x32x16_bf16(pa2, AT_PK(l2, h2), od, 0, 0, 0);
  od = __builtin_amdgcn_mfma_f32_32x32x16_bf16(pa3, AT_PK(l3, h3), od, 0, 0, 0);
#undef AT_PK
}
__device__ __forceinline__ void pv_d0(f32x16* o, int vb, bf16x8 pa0, bf16x8 pa1, bf16x8 pa2, bf16x8 pa3) {
  pv_one<0>(o[0], vb, pa0, pa1, pa2, pa3); pv_one<1>(o[1], vb, pa0, pa1, pa2, pa3); pv_one<2>(o[2], vb, pa0, pa1, pa2, pa3); pv_one<3>(o[3], vb, pa0, pa1, pa2, pa3);
}

__device__ __forceinline__ void attn_masked_body(const bf16_t* __restrict__ Qb, const bf16_t* __restrict__ Kh, const bf16_t* __restrict__ Vh, const unsigned long long* __restrict__ Mq,
                                                 bf16_t* __restrict__ Ob, int seq, LAS char* lds, int tid) {
  const int wid = __builtin_amdgcn_readfirstlane(tid >> 6), lane = tid & 63, r32 = lane & 31, hi = lane >> 5;
  LAS char* V_lds = lds; LAS char* K_lds = lds + 2 * SHM_V;
  LAS float* wsf = (LAS float*)(lds + 2 * SHM_V + 2 * SHM_K) + wid * 64; LAS float* li_l = wsf; LAS float* al_l = wsf + 32;
  float m_reg = -1e30f, l_reg = 0; f32x16 o[4] = {}; bf16x8 qr[8];
  const bf16_t* Qw = Qb + (long)(wid * QBLK + r32) * LDQ + hi * 8;
#pragma unroll
  for (int d0 = 0; d0 < 8; ++d0) qr[d0] = *reinterpret_cast<const bf16x8*>(Qw + d0 * 16);
  const unsigned long long* mrow = Mq + (size_t)(wid * QBLK + r32) * 64;
  const int sr = tid >> 4, sc = (tid & 15) * 8, vst0 = v_st(sr, sc), vst1 = v_st(32 + sr, sc);
  const int vb0 = (int)(uintptr_t)V_lds + v_rd_base(lane);
  struct { bf16x8 vs0, vs1, ks0, ks1; } sr_[2];
#define AT_SLOAD(i, k0) do { sr_[i].vs0 = *reinterpret_cast<const bf16x8*>(&Vh[(long)((k0) + sr) * LDK + sc]); sr_[i].vs1 = *reinterpret_cast<const bf16x8*>(&Vh[(long)((k0) + 32 + sr) * LDK + sc]); \
    sr_[i].ks0 = *reinterpret_cast<const bf16x8*>(&Kh[(long)((k0) + sr) * LDK + sc]); sr_[i].ks1 = *reinterpret_cast<const bf16x8*>(&Kh[(long)((k0) + 32 + sr) * LDK + sc]); } while (0)
#define AT_SWRITE(b, i) do { *(LAS bf16x8*)(V_lds + (b) * SHM_V + vst0) = sr_[i].vs0;          \
    *(LAS bf16x8*)(V_lds + (b) * SHM_V + vst1) = sr_[i].vs1; int kc = sc * 2;               \
    *(LAS bf16x8*)(K_lds + (b) * SHM_K + AT_KSWZ(sr, kc)) = sr_[i].ks0;                       \
    *(LAS bf16x8*)(K_lds + (b) * SHM_K + AT_KSWZ(32 + sr, kc)) = sr_[i].ks1; } while (0)
#define AT_SWAIT() asm volatile("s_waitcnt vmcnt(4)" ::: "memory")
#define AT_RESC(a) do { if (__any((a) < 1.f)) { if (hi == 0) al_l[r32] = (a); asm volatile("s_waitcnt lgkmcnt(0)" ::: "memory"); \
    _Pragma("unroll") for (int d = 0; d < 4; ++d) _Pragma("unroll") for (int r = 0; r < 16; ++r) o[d][r] *= al_l[crow(r, hi)]; } } while (0)
#define AT_MLOAD(mw, j) do { const unsigned long long _w = mrow[(j)]; (mw##lo) = (int)((unsigned)_w >> (4 * hi)); (mw##hi) = (int)((unsigned)(_w >> 32) >> (4 * hi)); } while (0)
  f32x16 pA0, pA1, pB0, pB1; float mnA, mnB, alA, alB; bf16x8 pa0, pa1, pa2, pa3; const int NT = seq / KVBLK;
  int mAlo, mAhi, mBlo, mBhi;
  constexpr int SE = 0, SO = 1;
  AT_SLOAD(SE, 0); AT_MLOAD(mA, 0); asm volatile("s_waitcnt vmcnt(0)" ::: "memory"); AT_SWRITE(0, SE); __syncthreads();
  qkt(pA0, pA1, K_lds, qr, r32, hi); partialSM(pA0, pA1, m_reg, mnA, alA);
  AT_SLOAD(SO, KVBLK); if (2 < NT) AT_SLOAD(SE, 2 * KVBLK);
  AT_SWAIT(); AT_SWRITE(1, SO); __syncthreads();
  for (int j = 1; j + 1 < NT; j += 2) {
    AT_SBAR(); AT_MLOAD(mB, j); qkt(pB0, pB1, K_lds + SHM_K, qr, r32, hi);
    finishSM(pA0, pA1, alA, l_reg, mAlo, mAhi, pa0, pa1, pa2, pa3); AT_SBAR();
    AT_SLOAD(SO, (j + 2) * KVBLK); AT_SBAR();
    pv_d0(o, vb0, pa0, pa1, pa2, pa3); partialSM(pB0, pB1, m_reg, mnB, alB);
    __syncthreads(); AT_SWAIT(); AT_SWRITE(0, SE);
    AT_RESC(alB); __syncthreads();
    AT_SBAR(); AT_MLOAD(mA, j + 1); qkt(pA0, pA1, K_lds, qr, r32, hi);
    finishSM(pB0, pB1, alB, l_reg, mBlo, mBhi, pa0, pa1, pa2, pa3); AT_SBAR();
    if (j + 3 < NT) AT_SLOAD(SE, (j + 3) * KVBLK); AT_SBAR();
    pv_d0(o, vb0 + (int)SHM_V, pa0, pa1, pa2, pa3); partialSM(pA0, pA1, m_reg, mnA, alA);
    __syncthreads(); AT_SWAIT(); AT_SWRITE(1, SO);
    AT_RESC(alA); __syncthreads();
  }
  AT_SBAR(); AT_MLOAD(mB, NT - 1); qkt(pB0, pB1, K_lds + SHM_K, qr, r32, hi);
  finishSM(pA0, pA1, alA, l_reg, mAlo, mAhi, pa0, pa1, pa2, pa3); AT_SBAR();
  pv_d0(o, vb0, pa0, pa1, pa2, pa3); partialSM(pB0, pB1, m_reg, mnB, alB);
  __syncthreads(); AT_RESC(alB);
  finishSM(pB0, pB1, alB, l_reg, mBlo, mBhi, pa0, pa1, pa2, pa3); AT_SBAR();
  pv_d0(o, vb0 + (int)SHM_V, pa0, pa1, pa2, pa3);
  if (hi == 0) li_l[r32] = l_reg; asm volatile("s_waitcnt lgkmcnt(0)" ::: "memory");
  float rli[16];
#pragma unroll
  for (int r = 0; r < 16; ++r) rli[r] = __builtin_amdgcn_rcpf(li_l[crow(r, hi)]);
  bf16_t* Ow = Ob + (long)(wid * QBLK) * LDQ;
#pragma unroll
  for (int r = 0; r < 16; ++r) { const int orow = crow(r, hi);
#pragma unroll
    for (int d0 = 0; d0 < 4; ++d0) Ow[(long)orow * LDQ + d0 * 32 + r32] = f2bf(o[d0][r] * rli[r]); }
#undef AT_SLOAD
#undef AT_SWRITE
#undef AT_SWAIT
#undef AT_RESC
#undef AT_MLOAD
}
}

__device__ __forceinline__ void phase_attn(KP P, LAS unsigned char* lds) {
    unsigned char* ws = as_global(P->ws);
    const bf16_t* QB = (const bf16_t*)(ws + WS_QB); const bf16_t* KB = (const bf16_t*)(ws + WS_KB); const bf16_t* VB = (const bf16_t*)(ws + WS_VB);
    const unsigned long long* MASK = (const unsigned long long*)(ws + WS_MASK); bf16_t* YB = (bf16_t*)(ws + WS_YB);
    const int G = nblk_();
    for (int p = bid_(); p < 256; p += G) {
        const int bh = p >> 3, b = bh >> 3, h = bh & 7, x = p & 7;
#pragma unroll 1
        for (int half = 0; half < 2; ++half) { const int qb = half ? 15 - x : x; const size_t row0 = (size_t)b * SEQ + (size_t)qb * 256;
            at::attn_masked_body(QB + row0 * 1024 + h * 128, KB + (size_t)b * SEQ * 1024 + h * 128, VB + (size_t)b * SEQ * 1024 + h * 128, MASK + row0 * 64,
                                 YB + row0 * 1024 + h * 128, 256 * (qb + 1), (LAS char*)lds, tid_());
            __syncthreads(); }
    }
}
constexpr int IXK = 512, IX_LD = 144;
__device__ __forceinline__ void idx_unit(const bf16_t* QI, const bf16_t* KI, const float* WI, float* Sc, int b, int c, int half, int tid, LAS unsigned char* lds) {
    const int lane = tid & 63, wave = __builtin_amdgcn_readfirstlane(tid >> 6), r = lane & 31, hh = lane >> 5, nk = 64 * (c + 1);
    const int s0 = c * 64 + half * 32 + wave * 4;
    const int aq = (r >> 2) & 1, ahead = (r & 3) + 4 * (r >> 3);
    bf16x8_t A[2][4]; float wv[2][16];
#pragma unroll
    for (int rt = 0; rt < 2; ++rt) { const size_t qrow = (size_t)b * SEQ + s0 + 2 * rt + aq;
#pragma unroll
        for (int ks = 0; ks < 4; ++ks) A[rt][ks] = *(const bf16x8_t*)(QI + qrow * 1024 + ahead * 64 + 16 * ks + 8 * hh);
        const float* wp = WI + ((size_t)b * SEQ + s0 + 2 * rt + hh) * 16;
#pragma unroll
        for (int i4 = 0; i4 < 4; ++i4) { const pg8::f32x4 w4 = *(const pg8::f32x4*)(wp + 4 * i4); wv[rt][4 * i4] = w4[0]; wv[rt][4 * i4 + 1] = w4[1]; wv[rt][4 * i4 + 2] = w4[2]; wv[rt][4 * i4 + 3] = w4[3]; } }
    float* srow[2];
#pragma unroll
    for (int rt = 0; rt < 2; ++rt) srow[rt] = Sc + (size_t)b * SCORE_B + (size_t)2048 * c * (c + 1) + (size_t)((s0 + 2 * rt + hh) & 63) * nk + r;
    const bf16_t* kbase = KI + (size_t)b * SEQ * 64;
    const int nblk = (nk + IXK - 1) / IXK;
    pg8::u32x4 stg[8];
#define IX_LOAD(kb) do { _Pragma("unroll") for (int i = 0; i < 8; ++i) { const int p = tid + 512 * i; int key = (kb) * IXK + (p >> 3); key = key < nk ? key : nk - 1; \
        stg[i] = *(const pg8::u32x4*)(kbase + (size_t)key * 64 + (p & 7) * 8); } } while (0)
#define IX_STORE() do { _Pragma("unroll") for (int i = 0; i < 8; ++i) { const int p = tid + 512 * i; *(LAS pg8::u32x4*)(lds + (p >> 3) * IX_LD + (p & 7) * 16) = stg[i]; } } while (0)
    IX_LOAD(0);
    for (int kb = 0; kb < nblk; ++kb) {
        __syncthreads();
        IX_STORE();
        __syncthreads();
        if (kb + 1 < nblk) IX_LOAD(kb + 1);
        const int ntile = (nk - kb * IXK < IXK ? nk - kb * IXK : IXK) / 32;
        for (int t = 0; t < ntile; ++t) { bf16x8_t Bc[4];
#pragma unroll
            for (int ks = 0; ks < 4; ++ks) Bc[ks] = *(const LAS bf16x8_t*)(lds + (32 * t + r) * IX_LD + (16 * ks + 8 * hh) * 2);
#pragma unroll
            for (int rt = 0; rt < 2; ++rt) { f32x16_t acc;
#pragma unroll
                for (int i = 0; i < 16; ++i) acc[i] = 0.f;
#pragma unroll
                for (int ks = 0; ks < 4; ++ks) acc = __builtin_amdgcn_mfma_f32_32x32x16_bf16(A[rt][ks], Bc[ks], acc, 0, 0, 0);
                float sc = 0.f;
#pragma unroll
                for (int i = 0; i < 16; ++i) sc = fmaf(wv[rt][i], fmaxf(acc[i], 0.f), sc);
                srow[rt][kb * IXK + t * 32] = sc; } }
    }
#undef IX_LOAD
#undef IX_STORE
}
__device__ __forceinline__ void phase_idx(KP P, LAS unsigned char* lds) {
    unsigned char* ws = as_global(P->ws);
    const bf16_t* QI = (const bf16_t*)(ws + WS_QI); const bf16_t* KI = (const bf16_t*)(ws + WS_KI); const float* WI = (const float*)(ws + WS_WI); float* Sc = (float*)(ws + WS_S);
    const int G = nblk_();
    for (int item = bid_(); item < 240; item += G) {
        const int pi = item % 30, combo = item / 30, b = combo >> 1, half = combo & 1;
        idx_unit(QI, KI, WI, Sc, b, 4 + pi, half, tid_(), lds); __syncthreads();
        idx_unit(QI, KI, WI, Sc, b, 63 - pi, half, tid_(), lds); __syncthreads();
    }
}
__device__ __forceinline__ void ixs_unit(const bf16_t* QI, const bf16_t* KI, const float* WI, unsigned long long* MASK, int b, int u8, int tid, LAS unsigned char* lds) {
    const int lane = tid & 63, wave = __builtin_amdgcn_readfirstlane(tid >> 6), r = lane & 31, hh = lane >> 5;
    const int s0 = 8 * u8, c = s0 >> 6, nw = c + 1, nk = 64 * nw;
    LAS float* SC = (LAS float*)lds;
    unsigned long long myword;
    if (nw > TOPK / 64) {
        { const int aq = (r >> 2) & 1, ahead = (r & 3) + 4 * (r >> 3);
          bf16x8_t A[4][4]; float wv[4][16];
#pragma unroll
          for (int rt = 0; rt < 4; ++rt) { const size_t qrow = (size_t)b * SEQ + s0 + 2 * rt + aq;
#pragma unroll
              for (int ks = 0; ks < 4; ++ks) A[rt][ks] = *(const bf16x8_t*)(QI + qrow * 1024 + ahead * 64 + 16 * ks + 8 * hh);
              const float* wp = WI + ((size_t)b * SEQ + s0 + 2 * rt + hh) * 16;
#pragma unroll
              for (int i4 = 0; i4 < 4; ++i4) { const pg8::f32x4 w4 = *(const pg8::f32x4*)(wp + 4 * i4); wv[rt][4 * i4] = w4[0]; wv[rt][4 * i4 + 1] = w4[1]; wv[rt][4 * i4 + 2] = w4[2]; wv[rt][4 * i4 + 3] = w4[3]; } }
          const bf16_t* kp = KI + ((size_t)b * SEQ + r) * 64 + 8 * hh;
          const int ntile = nk / 32;
          bf16x8_t Ca[4], Cb[4];
#define IXS_LOAD(t0_) do { const int ta = (t0_) < ntile ? (t0_) : ntile - 1, tb_ = (t0_) + 8 < ntile ? (t0_) + 8 : ntile - 1; \
              _Pragma("unroll") for (int ks = 0; ks < 4; ++ks) { Ca[ks] = *(const bf16x8_t*)(kp + (size_t)ta * 2048 + 16 * ks); Cb[ks] = *(const bf16x8_t*)(kp + (size_t)tb_ * 2048 + 16 * ks); } } while (0)
#define IXS_TILE(BUF, tt) do { _Pragma("unroll") for (int rt = 0; rt < 4; ++rt) { f32x16_t acc; _Pragma("unroll") for (int i = 0; i < 16; ++i) acc[i] = 0.f; \
              _Pragma("unroll") for (int ks = 0; ks < 4; ++ks) acc = __builtin_amdgcn_mfma_f32_32x32x16_bf16(A[rt][ks], BUF[ks], acc, 0, 0, 0); \
              pg8::f32x2 sc2 = {0.f, 0.f}; _Pragma("unroll") for (int i = 0; i < 16; i += 2) { pg8::f32x2 rl, wq; \
                  rl[0] = __int_as_float(max(__float_as_int(acc[i]), 0)); rl[1] = __int_as_float(max(__float_as_int(acc[i + 1]), 0)); wq[0] = wv[rt][i]; wq[1] = wv[rt][i + 1]; \
                  sc2 = __builtin_elementwise_fma(wq, rl, sc2); } const float sc = sc2[0] + sc2[1];     \
              SC[(2 * rt + hh) * 4096 + 32 * (tt) + r] = sc; } } while (0)
          IXS_LOAD(wave);
          for (int t = wave; t < ntile; t += 16) {
              bf16x8_t Ba[4], Bb[4];
#pragma unroll
              for (int ks = 0; ks < 4; ++ks) { Ba[ks] = Ca[ks]; Bb[ks] = Cb[ks]; }
              IXS_LOAD(t + 16);
              IXS_TILE(Ba, t);
              if (t + 8 < ntile) IXS_TILE(Bb, t + 8);
          }
#undef IXS_LOAD
#undef IXS_TILE
        }
        __syncthreads();
        unsigned u[64];
        { const LAS float* row = SC + wave * 4096 + lane;
#pragma unroll
          for (int j = 0; j < 64; ++j) { const int jc = j < nw ? j : nw - 1; const unsigned bits = __float_as_uint(row[jc * 64]); const unsigned v = (bits & 0x80000000u) ? ~bits : (bits | 0x80000000u); u[j] = (j < nw) ? v : 0u; } }
        unsigned prefix = 0u;
#ifdef IXS_DUP_SEARCH
        for (int rep_s = 0; rep_s < 2; ++rep_s) { prefix = 0u;
#else
        {
#endif
        for (int bit = 31; bit >= 0; --bit) { const unsigned cand = prefix | (1u << bit); int cnt = 0;
            unsigned cl = 0u;
#pragma unroll
            for (int j8 = 0; j8 < 8; ++j8) if (j8 * 8 < nw) {
#pragma unroll
                for (int jj = 0; jj < 8; ++jj) cl += (u[j8 * 8 + jj] >= cand) ? 1u : 0u; }
#pragma unroll
            for (int bb = 0; bb < 7; ++bb) cnt += __popcll(__ballot((cl >> bb) & 1u)) << bb;
            if (cnt >= TOPK) prefix = cand; }
        }
        LAS unsigned long long* sm = (LAS unsigned long long*)(SC + wave * 4096);
#pragma unroll
        for (int j = 0; j < 64; ++j) { const unsigned long long w = __ballot(u[j] >= prefix); if (lane == 0) sm[j] = w; }
        myword = sm[lane];
    } else {
        myword = (lane < nw) ? ~0ull : 0ull;
    }
    MASK[((size_t)b * SEQ + s0 + wave) * 64 + lane] = myword;
    __syncthreads();
}
__device__ __forceinline__ void phase_ixs(KP P, LAS unsigned char* lds) {
    unsigned char* ws = as_global(P->ws);
    const bf16_t* QI = (const bf16_t*)(ws + WS_QI); const bf16_t* KI = (const bf16_t*)(ws + WS_KI); const float* WI = (const float*)(ws + WS_WI); unsigned long long* MASK = (unsigned long long*)(ws + WS_MASK);
    const int G = nblk_();
    for (int W = bid_(); W < 256; W += G)
        for (int kk = 0; kk < 8; ++kk) ixs_unit(QI, KI, WI, MASK, W & 3, (W >> 2) + 64 * kk, tid_(), lds);
}
__device__ __forceinline__ const float* sel_row(const float* S, int q, int& nw) {
    const int b = q >> 12, s = q & 4095, c = s >> 6; nw = c + 1;
    return S + (size_t)b * SCORE_B + (size_t)2048 * c * (c + 1) + (size_t)(s & 63) * (nw * 64);
}
__device__ __forceinline__ void sel_load(const float* row, int nw, int lane, float (&f)[64]) {
    if (nw > 32) {
#pragma unroll
        for (int j = 0; j < 64; ++j) { const int jc = j < nw ? j : nw - 1; f[j] = row[jc * 64 + lane]; }
    } else {
#pragma unroll
        for (int j = 0; j < 32; ++j) { const int jc = j < nw ? j : nw - 1; f[j] = row[jc * 64 + lane]; }
#pragma unroll
        for (int j = 32; j < 64; ++j) f[j] = 0.f;
    }
}
__device__ __forceinline__ void phase_select(KP P, LAS unsigned char* lds) {
    unsigned char* ws = as_global(P->ws); const float* S = (const float*)(ws + WS_S); unsigned long long* MASK = (unsigned long long*)(ws + WS_MASK);
    const int tid = tid_(), wave = __builtin_amdgcn_readfirstlane(tid >> 6), lane = tid & 63, nb8 = nblk_() * 8;
    LAS unsigned long long* sm = (LAS unsigned long long*)lds + wave * 64;
    float f[64]; int it = (bid_() * 8 + wave) * 8, nw = 0; const float* row = nullptr;
    const int itstep = nb8 * 8 - 7;
#define SEL_Q(it_) ((((it_) >> 3) & 3) * 4096 + ((it_) >> 5) + 512 * ((it_) & 7))
    int q = it < TOK ? SEL_Q(it) : TOK;
    if (q < TOK) { row = sel_row(S, q, nw); if (nw > TOPK / 64) sel_load(row, nw, lane, f); }
    while (q < TOK) {
        unsigned long long myword = 0ull;
        const int itn = ((it & 7) == 7) ? it + itstep : it + 1; const int qn = itn < TOK ? SEL_Q(itn) : TOK; int nwn = 0; const float* rown = nullptr;
        if (nw <= TOPK / 64) {
            myword = (lane < nw) ? ~0ull : 0ull;
            if (qn < TOK) { rown = sel_row(S, qn, nwn); if (nwn > TOPK / 64) sel_load(rown, nwn, lane, f); }
        } else {
            unsigned u[64];
#pragma unroll
            for (int j = 0; j < 64; ++j) { const unsigned bits = __float_as_uint(f[j]); const unsigned v = (bits & 0x80000000u) ? ~bits : (bits | 0x80000000u); u[j] = (j < nw) ? v : 0u; }
            if (qn < TOK) { rown = sel_row(S, qn, nwn); if (nwn > TOPK / 64) sel_load(rown, nwn, lane, f); }
            unsigned prefix = 0u;
            for (int bit = 31; bit >= 0; --bit) { const unsigned cand = prefix | (1u << bit); int cnt = 0;
#pragma unroll
                for (int j8 = 0; j8 < 8; ++j8) if (j8 * 8 < nw) { unsigned long long bl[8];
#pragma unroll
                    for (int jj = 0; jj < 8; ++jj) bl[jj] = __ballot(u[j8 * 8 + jj] >= cand);
                    asm volatile("" : "+s"(bl[0]), "+s"(bl[1]), "+s"(bl[2]), "+s"(bl[3]), "+s"(bl[4]), "+s"(bl[5]), "+s"(bl[6]), "+s"(bl[7]));
#pragma unroll
                    for (int jj = 0; jj < 8; ++jj) cnt += __popcll(bl[jj]); }
                if (cnt >= TOPK) prefix = cand; }
#pragma unroll
            for (int j = 0; j < 64; ++j) { const unsigned long long w = __ballot(u[j] >= prefix); if (lane == 0) sm[j] = w; }
            myword = sm[lane];
        }
        MASK[(size_t)q * 64 + lane] = myword;
        q = qn; it = itn; nw = nwn; row = rown;
    }
#undef SEL_Q
}

__device__ __forceinline__ void phase_hgrn_naive(KP P, int layer, LAS unsigned char* lds) {
    unsigned char* ws = as_global(P->ws);
    const bf16_t* QA = (const bf16_t*)(ws + WS_QA); const bf16_t* KA = (const bf16_t*)(ws + WS_KA); const bf16_t* VA = (const bf16_t*)(ws + WS_VA); const bf16_t* GA = (const bf16_t*)(ws + WS_GA);
    const float* LF = (const float*)(ws + WS_LF); bf16_t* YA = (bf16_t*)(ws + WS_YA);
    const int tid = tid_(), bh = bid_(), b = bh >> 3, h = bh & 7, v = tid & 127; const bool act = (bh < 32) && (tid < 128);
    if (bh >= 32) return;
    LAS float* sf = (LAS float*)lds; LAS float* sk = sf + 16 * 128; LAS float* sq = sk + 16 * 128; LAS float* red = sq + 16 * 128;
    float S[128];
#pragma unroll
    for (int k = 0; k < 128; ++k) S[k] = 0.f;
    const float ng = as_global(P->hnorm_g)[layer * 128 + v];
    for (int t0 = 0; t0 < SEQ; t0 += 16) {
        if (act) for (int i = 0; i < 16; ++i) { const size_t idx = ((size_t)(b * SEQ + t0 + i)) * 1024 + h * 128 + v; sf[i * 128 + v] = expf(LF[idx]); sk[i * 128 + v] = bf2f(KA[idx]); sq[i * 128 + v] = bf2f(QA[idx]); }
        __syncthreads();
        for (int i = 0; i < 16; ++i) { const size_t idx = ((size_t)(b * SEQ + t0 + i)) * 1024 + h * 128 + v; float o = 0.f;
            if (act) { const float vt = bf2f(VA[idx]);
#pragma unroll
                for (int k = 0; k < 128; ++k) { S[k] = sf[i * 128 + k] * S[k] + sk[i * 128 + k] * vt; o += S[k] * sq[i * 128 + k]; } }
            float ss = o * o;
#pragma unroll
            for (int m = 32; m >= 1; m >>= 1) ss += __shfl_xor(ss, m);
            if (act && (v & 63) == 0) red[v >> 6] = ss;
            __syncthreads();
            if (act) { const float tot = red[0] + red[1]; YA[idx] = f2bf(o * (1.0f / sqrtf(tot * (1.0f / 128.0f) + RMS_EPS)) * ng * bf2f(GA[idx])); }
            __syncthreads(); }
    }
}
__device__ __forceinline__ void phase_idx_naive(KP P, LAS unsigned char* lds) {
    unsigned char* ws = as_global(P->ws);
    const bf16_t* QI = (const bf16_t*)(ws + WS_QI); const bf16_t* KI = (const bf16_t*)(ws + WS_KI); const float* WI = (const float*)(ws + WS_WI); float* Sc = (float*)(ws + WS_S);
    const int tid = tid_(), G = nblk_();
    LAS float* qs = (LAS float*)lds; LAS float* wsh = qs + 1024;
    for (int q = bid_(); q < TOK; q += G) {
        const int b = q >> 12, s = q & 4095, c = s >> 6, nw = c + 1, nk = nw * 64;
        if (nw <= TOPK / 64) continue;
        __syncthreads();
        for (int i = tid; i < 1024; i += 512) qs[i] = bf2f(QI[(size_t)q * 1024 + i]);
        if (tid < 16) wsh[tid] = WI[(size_t)q * 16 + tid];
        __syncthreads();
        float* row = Sc + (size_t)b * SCORE_B + (size_t)2048 * c * (c + 1) + (size_t)(s & 63) * nk;
        for (int key = tid; key < nk; key += 512) {
            float kf[64]; const pg8::u32x4* kp = (const pg8::u32x4*)(KI + ((size_t)b * SEQ + key) * 64);
#pragma unroll
            for (int d8 = 0; d8 < 8; ++d8) { const pg8::u32x4 w = kp[d8]; pg8::f32x4 a, bb; pg8::unpack8(w, a, bb);
#pragma unroll
                for (int j = 0; j < 4; ++j) { kf[d8 * 8 + j] = a[j]; kf[d8 * 8 + 4 + j] = bb[j]; } }
            float sc = 0.f;
            for (int h = 0; h < 16; ++h) { float dot = 0.f;
#pragma unroll
                for (int d = 0; d < 64; ++d) dot += qs[h * 64 + d] * kf[d];
                sc += wsh[h] * fmaxf(dot, 0.f); }
            row[key] = sc;
        }
    }
}
__device__ __forceinline__ void phase_attn_naive(KP P, LAS unsigned char* lds) {
    unsigned char* ws = as_global(P->ws);
    const bf16_t* QB = (const bf16_t*)(ws + WS_QB); const bf16_t* KB = (const bf16_t*)(ws + WS_KB); const bf16_t* VB = (const bf16_t*)(ws + WS_VB);
    const unsigned long long* MASK = (const unsigned long long*)(ws + WS_MASK); bf16_t* YB = (bf16_t*)(ws + WS_YB);
    const int tid = tid_(), h = tid >> 6, lane = tid & 63, G = nblk_();
    LAS float* qs = (LAS float*)lds + h * 128; LAS int* keys = (LAS int*)((LAS float*)lds + 1024) + h * 320; LAS float* lg = (LAS float*)lds + 1024 + 8 * 320 + h * 320;
    for (int q = bid_(); q < TOK; q += G) {
        const int b = q >> 12, s = q & 4095, nw = (s >> 6) + 1;
        qs[lane] = bf2f(QB[(size_t)q * 1024 + h * 128 + lane]); qs[lane + 64] = bf2f(QB[(size_t)q * 1024 + h * 128 + 64 + lane]);
        int cnt = 0;
        for (int j = 0; j < nw; ++j) { const unsigned long long w = MASK[(size_t)q * 64 + j]; const bool on = (w >> lane) & 1ull; const int key = j * 64 + lane;
            if (on) { const pg8::u32x4* kp = (const pg8::u32x4*)(KB + ((size_t)b * SEQ + key) * 1024 + h * 128); float dot = 0.f;
                for (int d8 = 0; d8 < 16; ++d8) { pg8::f32x4 a, bb; pg8::unpack8(kp[d8], a, bb);
#pragma unroll
                    for (int j2 = 0; j2 < 4; ++j2) dot += qs[d8 * 8 + j2] * a[j2] + qs[d8 * 8 + 4 + j2] * bb[j2]; }
                const int pos = cnt + __popcll(w & ((1ull << lane) - 1ull));
                if (pos < 320) { keys[pos] = key; lg[pos] = dot * ATTN_SCALE; } }
            cnt += __popcll(w); }
        if (cnt > 320) cnt = 320;
        float mx = -1e30f; for (int e = lane; e < cnt; e += 64) mx = fmaxf(mx, lg[e]);
#pragma unroll
        for (int m = 32; m >= 1; m >>= 1) mx = fmaxf(mx, __shfl_xor(mx, m));
        float sum = 0.f; for (int e = lane; e < cnt; e += 64) { const float pe = expf(lg[e] - mx); lg[e] = pe; sum += pe; }
#pragma unroll
        for (int m = 32; m >= 1; m >>= 1) sum += __shfl_xor(sum, m);
        float a0 = 0.f, a1 = 0.f;
        for (int e = 0; e < cnt; ++e) { const float pe = lg[e]; const bf16_t* vp = VB + ((size_t)b * SEQ + keys[e]) * 1024 + h * 128 + 2 * lane; a0 += pe * bf2f(vp[0]); a1 += pe * bf2f(vp[1]); }
        const float inv = 1.0f / sum;
        *(unsigned*)(YB + (size_t)q * 1024 + h * 128 + 2 * lane) = pg8::cvt_pk_bf16(a0 * inv, a1 * inv);
    }
}

__global__ __launch_bounds__(128) void k_hgrn_naive(const bf16_t* QA, const bf16_t* KA, const bf16_t* VA, const bf16_t* GA, const float* LF, const float* norm_g, bf16_t* YA) {
    const int bh = blockIdx.x, b = bh >> 3, h = bh & 7, v = threadIdx.x;
    __shared__ float sf[16][128], sk[16][128], sq[16][128]; __shared__ float red[2];
    float S[128];
#pragma unroll
    for (int k = 0; k < 128; ++k) S[k] = 0.f;
    const float ng = norm_g[v];
    for (int t0 = 0; t0 < SEQ; t0 += 16) {
        for (int i = 0; i < 16; ++i) { const size_t idx = ((size_t)(b * SEQ + t0 + i)) * 1024 + h * 128 + v; sf[i][v] = expf(LF[idx]); sk[i][v] = bf2f(KA[idx]); sq[i][v] = bf2f(QA[idx]); }
        __syncthreads();
        for (int i = 0; i < 16; ++i) { const size_t idx = ((size_t)(b * SEQ + t0 + i)) * 1024 + h * 128 + v; const float vt = bf2f(VA[idx]); float o = 0.f;
#pragma unroll
            for (int k = 0; k < 128; ++k) { S[k] = sf[i][k] * S[k] + sk[i][k] * vt; o += S[k] * sq[i][k]; }
            float ss = o * o;
#pragma unroll
            for (int m = 32; m >= 1; m >>= 1) ss += __shfl_xor(ss, m);
            if ((v & 63) == 0) red[v >> 6] = ss;
            __syncthreads();
            const float tot = red[0] + red[1];
            const float y = o * (1.0f / sqrtf(tot * (1.0f / 128.0f) + RMS_EPS)) * ng * bf2f(GA[idx]);
            YA[idx] = f2bf(y);
            __syncthreads(); }
    }
}
__global__ __launch_bounds__(256) void k_idx_naive(const bf16_t* QI, const bf16_t* KI, const float* WI, float* S) {
    const int q = blockIdx.x, b = q >> 12, s = q & 4095, c = s >> 6, nw = c + 1, nk = nw * 64;
    if (nw <= TOPK / 64) return;
    __shared__ float qs[1024]; __shared__ float wsh[16];
    for (int i = threadIdx.x; i < 1024; i += 256) qs[i] = bf2f(QI[(size_t)q * 1024 + i]);
    if (threadIdx.x < 16) wsh[threadIdx.x] = WI[(size_t)q * 16 + threadIdx.x];
    __syncthreads();
    float* row = S + (size_t)b * SCORE_B + (size_t)2048 * c * (c + 1) + (size_t)(s & 63) * nk;
    for (int key = threadIdx.x; key < nk; key += 256) {
        float kf[64]; const bf16_t* kp = KI + ((size_t)b * SEQ + key) * 64;
#pragma unroll
        for (int d = 0; d < 64; ++d) kf[d] = bf2f(kp[d]);
        float sc = 0.f;
        for (int h = 0; h < 16; ++h) { float dot = 0.f;
#pragma unroll
            for (int d = 0; d < 64; ++d) dot += qs[h * 64 + d] * kf[d];
            sc += wsh[h] * fmaxf(dot, 0.f); }
        row[key] = sc;
    }
}
__global__ __launch_bounds__(512) void k_attn_naive(const bf16_t* QB, const bf16_t* KB, const bf16_t* VB, const unsigned long long* MASK, bf16_t* YB) {
    const int q = blockIdx.x, b = q >> 12, s = q & 4095, nw = (s >> 6) + 1, h = threadIdx.x >> 6, lane = threadIdx.x & 63;
    __shared__ float qs[8][128]; __shared__ int keys[8][320]; __shared__ float lg[8][320];
    qs[h][lane] = bf2f(QB[(size_t)q * 1024 + h * 128 + lane]); qs[h][lane + 64] = bf2f(QB[(size_t)q * 1024 + h * 128 + 64 + lane]);
    __syncthreads();
    int cnt = 0;
    for (int j = 0; j < nw; ++j) { const unsigned long long w = MASK[(size_t)q * 64 + j]; const bool on = (w >> lane) & 1ull; const int key = j * 64 + lane;
        if (on) { const bf16_t* kp = KB + ((size_t)b * SEQ + key) * 1024 + h * 128; float dot = 0.f;
            for (int d = 0; d < 128; ++d) dot += qs[h][d] * bf2f(kp[d]);
            const int pos = cnt + __popcll(w & ((1ull << lane) - 1ull));
            if (pos < 320) { keys[h][pos] = key; lg[h][pos] = dot * ATTN_SCALE; } }
        cnt += __popcll(w); }
    if (cnt > 320) cnt = 320;
    __syncthreads();
    float mx = -1e30f; for (int e = lane; e < cnt; e += 64) mx = fmaxf(mx, lg[h][e]);
#pragma unroll
    for (int m = 32; m >= 1; m >>= 1) mx = fmaxf(mx, __shfl_xor(mx, m));
    float sum = 0.f; for (int e = lane; e < cnt; e += 64) { const float pe = expf(lg[h][e] - mx); lg[h][e] = pe; sum += pe; }
#pragma unroll
    for (int m = 32; m >= 1; m >>= 1) sum += __shfl_xor(sum, m);
    __syncthreads();
    float a0 = 0.f, a1 = 0.f;
    for (int e = 0; e < cnt; ++e) { const float pe = lg[h][e]; const bf16_t* vp = VB + ((size_t)b * SEQ + keys[h][e]) * 1024 + h * 128 + 2 * lane; a0 += pe * bf2f(vp[0]); a1 += pe * bf2f(vp[1]); }
    const float inv = 1.0f / sum;
    YB[(size_t)q * 1024 + h * 128 + 2 * lane] = f2bf(a0 * inv); YB[(size_t)q * 1024 + h * 128 + 2 * lane + 1] = f2bf(a1 * inv);
}

__global__ __launch_bounds__(256) void k_dump(const unsigned char* ws, int which, float* out) {
    for (size_t i = (size_t)blockIdx.x * 256 + threadIdx.x; i < (size_t)TOK * DM; i += (size_t)gridDim.x * 256) {
        const size_t t = i / DM, c = i % DM; float v = 0.f;
        if (which == 0) { v = bf2f(((const bf16_t*)(ws + WS_MG))[i]) + ((const float*)(ws + WS_PP))[i]; }
        else if (which == 1) { const size_t j = t * 1024 + (c & 1023);
            v = bf2f(((const bf16_t*)(ws + WS_QA))[j]) + bf2f(((const bf16_t*)(ws + WS_KA))[j]) + bf2f(((const bf16_t*)(ws + WS_VA))[j]) + bf2f(((const bf16_t*)(ws + WS_GA))[j])
              + bf2f(((const bf16_t*)(ws + WS_QB))[j]) + bf2f(((const bf16_t*)(ws + WS_KB))[j]) + bf2f(((const bf16_t*)(ws + WS_VB))[j]) + bf2f(((const bf16_t*)(ws + WS_QI))[j])
              + ((const float*)(ws + WS_LF))[j] + bf2f(((const bf16_t*)(ws + WS_SGA))[i]) + bf2f(((const bf16_t*)(ws + WS_SGB))[i]) + ((const float*)(ws + WS_IKW))[t * 128 + (c & 127)]; }
        else if (which == 2) { const size_t j = t * 1024 + (c & 1023); v = (c < 1024) ? bf2f(((const bf16_t*)(ws + WS_YA))[j]) : bf2f(((const bf16_t*)(ws + WS_YB))[j]); }
        else if (which == 3) { v = ((const float*)(ws + WS_XPRE))[i]; }
        else if (which == 4) { v = ((const float*)(ws + WS_XPRE))[i]; }
        else if (which == 5) { v = bf2f(((const bf16_t*)(ws + WS_H))[t * DFF + c]) + bf2f(((const bf16_t*)(ws + WS_H))[t * DFF + 2048 + c]) + bf2f(((const bf16_t*)(ws + WS_H))[t * DFF + 3584 + c]); }
        else if (which == 6) { const unsigned long long m = ((const unsigned long long*)(ws + WS_MASK))[t * 64 + (c & 63)]; v = (float)__popcll(m) + (float)(unsigned)(m % 1000003ull) * 1e-3f; }
        else if (which == 7) { v = bf2f(((const bf16_t*)(ws + WS_WIN))[i % ((size_t)INP * DM)]) + bf2f(((const bf16_t*)(ws + WS_WGU))[(i * 7) % ((size_t)2 * DFF * DM)]) + bf2f(((const bf16_t*)(ws + WS_WDN))[(i * 3) % ((size_t)DFF * DM)]); }
        else if (which == 8) { v = bf2f(((const bf16_t*)(ws + WS_XB))[i]) + ((const float*)(ws + WS_COSH))[i % ((size_t)TOK * 64)] + ((const float*)(ws + WS_SINI))[i % ((size_t)TOK * 32)] + ((const float*)(ws + WS_LB))[i % 4096]; }
        else if (which == 9) { v = bf2f(((const bf16_t*)(ws + WS_H))[t * 6272 + c]) + bf2f(((const bf16_t*)(ws + WS_H))[t * 6272 + 2048 + c]) + bf2f(((const bf16_t*)(ws + WS_H))[t * 6272 + 4096 + c]) + bf2f(((const bf16_t*)(ws + WS_H))[t * 6272 + 4224 + c]); }
        else if (which == 10) { const size_t j = t * 1024 + (c & 1023); v = bf2f(((const bf16_t*)(ws + WS_QA))[j]) + bf2f(((const bf16_t*)(ws + WS_VA))[j]) + bf2f(((const bf16_t*)(ws + WS_GA))[j]) + bf2f(((const bf16_t*)(ws + WS_VB))[j]) + bf2f(((const bf16_t*)(ws + WS_SGA))[i]) + bf2f(((const bf16_t*)(ws + WS_SGB))[i]); }
        else if (which == 11) { const size_t j = t * 1024 + (c & 1023); v = bf2f(((const bf16_t*)(ws + WS_QB))[j]) + bf2f(((const bf16_t*)(ws + WS_KB))[j]) + bf2f(((const bf16_t*)(ws + WS_QI))[j]); }
        else if (which == 12) { const size_t j = t * 1024 + (c & 1023); v = ((const float*)(ws + WS_LF))[j] + bf2f(((const bf16_t*)(ws + WS_KA))[j]); }
        else if (which == 14) { v = ((const float*)(ws + WS_IKW))[t * 128 + (c & 127)]; }
        else if (which == 15) { const size_t j = t * 1024 + (c & 1023); v = bf2f(((const bf16_t*)(ws + WS_QA))[j]) + bf2f(((const bf16_t*)(ws + WS_GA))[j]); }
        else if (which == 16) { v = bf2f(((const bf16_t*)(ws + WS_SGA))[i]) + bf2f(((const bf16_t*)(ws + WS_SGB))[i]); }
        else if (which == 17) { const size_t j = t * 1024 + (c & 1023); v = bf2f(((const bf16_t*)(ws + WS_VA))[j]) + bf2f(((const bf16_t*)(ws + WS_VB))[j]); }
        out[i] = v;
    }
}
#ifndef OPT_HGRN
#define OPT_HGRN 1
#endif
#ifndef OPT_IDX
#define OPT_IDX 1
#endif
#ifndef OPT_ATT
#define OPT_ATT 1
#endif
#ifndef OPT_IXS
#define OPT_IXS 0
#endif
#ifndef PHM
#define PHM 0x3fff
#endif
#ifndef DUP_MASK
#define DUP_MASK 0
#endif
#ifndef ONE_LAUNCH
#define ONE_LAUNCH 1
#endif

__global__ void __launch_bounds__(512, 2) mega(Params P_unused) {
    extern __shared__ __attribute__((aligned(16))) unsigned char lds[];
    LAS unsigned char* L = (LAS unsigned char*)lds;
    volatile LAS unsigned* misc = (volatile LAS unsigned*)(L + MISC_OFF);
    if (threadIdx.x < 4) misc[threadIdx.x] = 0u;
    __syncthreads();
    int lo, hi; unsigned char* ws0; { KP P0 = kparams(); lo = P0->ph_lo; hi = P0->ph_hi; ws0 = as_global(P0->ws); }
    XcdBarrier bar; bar.bar = (unsigned*)(ws0 + WS_CTL); bar.x = 0; bar.st = misc;
    if (hi - lo > 1) bar = xcd_barrier_post((unsigned*)(ws0 + WS_CTL), misc);
#define WSP(T_, off) ((T_*)(ws + (off)))
#define WSL KP P = kparams(); unsigned char* ws = as_global(P->ws); const int G = nblk_(), bid = bid_(); (void)G; (void)bid

    for (int layer = 0; layer < DEPTH; ++layer) {
        const int base = layer * NPH_LAYER;
#define IN(k) (((PHM >> (k)) & 1) && lo <= base + (k) && base + (k) < hi)
#define SEAM(k) do { if (rep + 1 == ((((DUP_MASK >> (k)) & 1) ? 2 : 1)) && base + (k) + 1 < hi) xcd_barrier(bar); } while (0)
        if (layer == 0 && IN(0)) for (int rep = 0; rep < (((DUP_MASK >> 0) & 1) ? 2 : 1); ++rep) { WSL; phase_prologue(P); phase_wconv(P, 0, L); SEAM(0); }
        if (IN(1)) for (int rep = 0; rep < (((DUP_MASK >> 1) & 1) ? 2 : 1); ++rep) { WSL;
            pg8::Gemm g{WSP(const bf16_t, WS_XB), WSP(const bf16_t, WS_WIN), TOK, INP, DM}; pg8::StaticOrder S; S.init(TOK, INP, G, bid);
#ifdef RAWTEST
            pg8::EpiRawTest E{ws};
            pg8::gemm_phase<pg8::EpiRawTest, pg8::StaticOrder, true, true>(L, g, S, E); SEAM(1);
#else
            pg8::EpiIn E{ws, layer};
            pg8::gemm_phase<pg8::EpiIn, pg8::StaticOrder, true, true>(L, g, S, E); SEAM(1);
#endif
        }
        if (IN(2)) for (int rep = 0; rep < (((DUP_MASK >> 2) & 1) ? 2 : 1); ++rep) { WSL; phase_ikprep(P, layer);
#if OPT_HGRN
            phase_hgrn_h1(P, L);
#ifdef DUP_H1
            phase_hgrn_h1(P, L);
#endif
#endif
            SEAM(2); }
        if (IN(3)) for (int rep = 0; rep < (((DUP_MASK >> 3) & 1) ? 2 : 1); ++rep) { WSL;
#if !OPT_HGRN
            phase_hgrn_naive(P, layer, L); __syncthreads();
#else
            phase_hgrn_h2(P);
#ifdef DUP_H2
            phase_hgrn_h2(P);
#endif
#endif
#if !OPT_IDX
            phase_idx_naive(P, L);
#else
#if OPT_IXS
            __syncthreads(); phase_ixs(P, L);
#ifdef DUP_IXS
            __syncthreads(); phase_ixs(P, L);
#endif
#else
            __syncthreads(); phase_idx(P, L);
#endif
#endif
            SEAM(3); }
        if (IN(4)) for (int rep = 0; rep < (((DUP_MASK >> 4) & 1) ? 2 : 1); ++rep) { WSL;
#if !OPT_IXS
            phase_select(P, L);
#endif
#if OPT_HGRN
            __syncthreads(); phase_hgrn_h3(P, layer, L);
#ifdef DUP_H3
            __syncthreads(); phase_hgrn_h3(P, layer, L);
#endif
#endif
            SEAM(4); }
        if (IN(5)) for (int rep = 0; rep < (((DUP_MASK >> 5) & 1) ? 2 : 1); ++rep) { WSL;
#if !OPT_ATT
            phase_attn_naive(P, L);
#else
            phase_attn(P, L);
#endif
            SEAM(5); }
        if (IN(6)) for (int rep = 0; rep < (((DUP_MASK >> 6) & 1) ? 2 : 1); ++rep) { WSL;
            { pg8::Gemm g{WSP(const bf16_t, WS_YA), WSP(const bf16_t, WS_WA), TOK, DM, AW}; pg8::StaticOrder S; S.init(TOK, DM, G, bid);
              pg8::EpiGateA E{ws}; pg8::gemm_phase<pg8::EpiGateA, pg8::StaticOrder, true, true>(L, g, S, E); }
            { pg8::Gemm g{WSP(const bf16_t, WS_YB), WSP(const bf16_t, WS_WB), TOK, DM, BW}; pg8::StaticOrder S; S.init(TOK, DM, G, bid);
              pg8::EpiGateB E{ws}; pg8::gemm_phase<pg8::EpiGateB, pg8::StaticOrder, true, true>(L, g, S, E); }
            { pg8::Gemm g{WSP(const bf16_t, WS_PB), WSP(const bf16_t, WS_WPP), TOK, DM, PLE}; pg8::StaticOrder S; S.init(TOK, DM, G, bid);
              pg8::EpiF32P E{ws}; pg8::gemm_phase<pg8::EpiF32P, pg8::StaticOrder, true, true>(L, g, S, E); }
            SEAM(6);
        }
        if (IN(7)) for (int rep = 0; rep < (((DUP_MASK >> 7) & 1) ? 2 : 1); ++rep) { WSL;
            pg8::Gemm g{WSP(const bf16_t, WS_MG), WSP(const bf16_t, WS_WO), TOK, DM, DM}; pg8::StaticOrder S; S.init(TOK, DM, G, bid);
            if (layer == 0) { pg8::EpiRes<true> E{as_global(P->x), nullptr, nullptr, ws}; pg8::gemm_phase<pg8::EpiRes<true>, pg8::StaticOrder, true, true>(L, g, S, E); }
            else { pg8::EpiRes<false> E{nullptr, P->lnp_g + (layer - 1) * DM, P->lnp_b + (layer - 1) * DM, ws}; pg8::gemm_phase<pg8::EpiRes<false>, pg8::StaticOrder, true, true>(L, g, S, E); }
            SEAM(7);
        }
        if (IN(8)) for (int rep = 0; rep < (((DUP_MASK >> 8) & 1) ? 2 : 1); ++rep) { WSL; phase_ln(WSP(const float, WS_XPRE), nullptr, WSP(bf16_t, WS_XB), WSP(float, WS_STATS), as_global(P->lnm_g) + layer * DM, as_global(P->lnm_b) + layer * DM); SEAM(8); }
        if (IN(9)) for (int rep = 0; rep < (((DUP_MASK >> 9) & 1) ? 2 : 1); ++rep) { WSL;
            pg8::Gemm g{WSP(const bf16_t, WS_XB), WSP(const bf16_t, WS_WGU), TOK, 2 * DFF, DM}; pg8::StaticOrder S; S.init(TOK, 2 * DFF, G, bid);
            pg8::EpiSwiGLU E{ws}; pg8::gemm_phase<pg8::EpiSwiGLU, pg8::StaticOrder, true, true>(L, g, S, E); SEAM(9);
        }
        if (IN(10)) for (int rep = 0; rep < (((DUP_MASK >> 10) & 1) ? 2 : 1); ++rep) { WSL;
            pg8::Gemm g{WSP(const bf16_t, WS_H), WSP(const bf16_t, WS_WDN), TOK, DM, DFF}; pg8::StaticOrder S; S.init(TOK, DM, G, bid);
            pg8::EpiRes<false> E{nullptr, P->lnm_g + layer * DM, P->lnm_b + layer * DM, ws}; pg8::gemm_phase<pg8::EpiRes<false>, pg8::StaticOrder, true, true>(L, g, S, E); SEAM(10);
        }
        if (IN(11)) for (int rep = 0; rep < (((DUP_MASK >> 11) & 1) ? 2 : 1); ++rep) { WSL; phase_ln(WSP(const float, WS_XPRE), nullptr, WSP(bf16_t, WS_XB), WSP(float, WS_STATS), as_global(P->lnf_g) + layer * DM, as_global(P->lnf_b) + layer * DM); SEAM(11); }
        if (IN(12)) for (int rep = 0; rep < (((DUP_MASK >> 12) & 1) ? 2 : 1); ++rep) { WSL;
            pg8::Gemm g{WSP(const bf16_t, WS_XB), WSP(const bf16_t, WS_WPG), TOK, DM, DM}; pg8::StaticOrder S; S.init(TOK, DM, G, bid);
            pg8::EpiPle E{P->lnf_g + layer * DM, P->lnf_b + layer * DM, ws}; pg8::gemm_phase<pg8::EpiPle, pg8::StaticOrder, true, true>(L, g, S, E); SEAM(12);
        }
        if (IN(13)) for (int rep = 0; rep < (((DUP_MASK >> 13) & 1) ? 2 : 1); ++rep) { WSL; phase_ln(WSP(const float, WS_XPRE), layer == DEPTH - 1 ? as_global(P->out) : nullptr, WSP(bf16_t, WS_XB), WSP(float, WS_STATS), as_global(P->lnp_g) + layer * DM, as_global(P->lnp_b) + layer * DM);
            if (layer + 1 < DEPTH) { __syncthreads(); phase_wconv(P, layer + 1, L); }
            SEAM(13); }
#undef IN
#undef SEAM
    }
}

extern "C" void kernel_launch(void* const* d_in, const int* in_sizes, int n_in, void* d_out, int out_size, void* d_ws, size_t ws_size, hipStream_t stream) {
    static int grid = 0;
    if (grid == 0) {
        if (n_in != 22 || out_size != TOK * DM || ws_size < WS_END) { fprintf(stderr, "kernel_launch: unexpected shapes: n_in %d out %d ws %zu (need %zu)\n", n_in, out_size, ws_size, (size_t)WS_END); grid = -1; return; }
        int dev = 0, cus = 0, per_cu = 0;
        if (hipGetDevice(&dev) != hipSuccess || hipDeviceGetAttribute(&cus, hipDeviceAttributeMultiprocessorCount, dev) != hipSuccess) { grid = -1; return; }
        if (hipFuncSetAttribute((const void*)mega, hipFuncAttributeMaxDynamicSharedMemorySize, LDS_BYTES) != hipSuccess) { fprintf(stderr, "kernel_launch: hipFuncSetAttribute failed\n"); grid = -1; return; }
        if (hipOccupancyMaxActiveBlocksPerMultiprocessor(&per_cu, (const void*)mega, 512, LDS_BYTES) != hipSuccess || per_cu < 1) { fprintf(stderr, "kernel_launch: occupancy query says %d\n", per_cu); (void)hipGetLastError(); }
        grid = cus;
    }
    if (grid < 0) return;
    (void)hipMemsetAsync((char*)d_ws + WS_CTL, 0, 65536, stream);
    Params P{};
    P.x = (const float*)d_in[0]; P.p = (const float*)d_in[1]; P.pos = (const int*)d_in[2];
    P.w_in = (const float*)d_in[3]; P.w_a = (const float*)d_in[4]; P.w_b = (const float*)d_in[5]; P.w_out = (const float*)d_in[6];
    P.lbraw = (const float*)d_in[7]; P.hnorm_g = (const float*)d_in[8]; P.ikn_g = (const float*)d_in[9]; P.ikn_b = (const float*)d_in[10];
    P.lnm_g = (const float*)d_in[11]; P.lnm_b = (const float*)d_in[12]; P.w_fg = (const float*)d_in[13]; P.w_fu = (const float*)d_in[14]; P.w_fd = (const float*)d_in[15];
    P.lnf_g = (const float*)d_in[16]; P.lnf_b = (const float*)d_in[17]; P.w_pg = (const float*)d_in[18]; P.w_pp = (const float*)d_in[19];
    P.lnp_g = (const float*)d_in[20]; P.lnp_b = (const float*)d_in[21];
    P.out = (float*)d_out; P.ws = (unsigned char*)d_ws;
    for (int j = 0; j < 64; ++j) P.invf_h[j] = pow(10000.0, -(double)j / 64.0) / 6.283185307179586476925286766559;
    for (int j = 0; j < 32; ++j) P.invf_i[j] = pow(10000.0, -(double)j / 32.0) / 6.283185307179586476925286766559;
#if ONE_LAUNCH
    P.ph_lo = 0; P.ph_hi = NPH;
    hipLaunchKernelGGL(mega, dim3(grid), dim3(512), LDS_BYTES, stream, P);
#elif defined(SEQ_TEST)
    { const int seq[] = SEQ_TEST; for (int i = 0; i < (int)(sizeof(seq) / sizeof(int)); ++i) { P.ph_lo = seq[i]; P.ph_hi = seq[i] + 1; hipLaunchKernelGGL(mega, dim3(grid), dim3(512), LDS_BYTES, stream, P); }
      hipLaunchKernelGGL(k_dump, dim3(4096), dim3(256), 0, stream, (const unsigned char*)d_ws, DUMP_WHICH, (float*)d_out); }
#else
    unsigned char* ws = (unsigned char*)d_ws;
    for (int layer = 0; layer < DEPTH; ++layer)
        for (int k = 0; k < NPH_LAYER; ++k) {
            P.ph_lo = layer * NPH_LAYER + k; P.ph_hi = P.ph_lo + 1;
            bool run_mega = true;
#if !OPT_HGRN
            if (k == 3) hipLaunchKernelGGL(k_hgrn_naive, dim3(32), dim3(128), 0, stream, (const bf16_t*)(ws + WS_QA), (const bf16_t*)(ws + WS_KA), (const bf16_t*)(ws + WS_VA), (const bf16_t*)(ws + WS_GA),
                                           (const float*)(ws + WS_LF), P.hnorm_g + layer * 128, (bf16_t*)(ws + WS_YA));
#endif
#if !OPT_IDX
            if (k == 3) hipLaunchKernelGGL(k_idx_naive, dim3(TOK), dim3(256), 0, stream, (const bf16_t*)(ws + WS_QI), (const bf16_t*)(ws + WS_KI), (const float*)(ws + WS_WI), (float*)(ws + WS_S));
#endif
#if !OPT_ATT
            if (k == 5) hipLaunchKernelGGL(k_attn_naive, dim3(TOK), dim3(512), 0, stream, (const bf16_t*)(ws + WS_QB), (const bf16_t*)(ws + WS_KB), (const bf16_t*)(ws + WS_VB),
                                           (const unsigned long long*)(ws + WS_MASK), (bf16_t*)(ws + WS_YB));
#endif
#if !OPT_HGRN && !OPT_IDX
            if (k == 3) run_mega = false;
#endif
#if !OPT_ATT
            if (k == 5) run_mega = false;
#endif
            if (run_mega) hipLaunchKernelGGL(mega, dim3(grid), dim3(512), LDS_BYTES, stream, P);
#ifdef DUMP_AT
            if (layer * NPH_LAYER + k == DUMP_AT) { hipLaunchKernelGGL(k_dump, dim3(4096), dim3(256), 0, stream, (const unsigned char*)ws, DUMP_WHICH, (float*)d_out); return; }
#endif
        }
#endif
    const hipError_t le = hipPeekAtLastError();
    if (le != hipSuccess) fprintf(stderr, "kernel_launch: launch failed: %s\n", hipGetErrorName(le));
}
```

```cpp
#include <hip/hip_runtime.h>
#include <cstdio>
#include <cstdint>

constexpr int DM = 2048, NBATCH = 4, SEQ = 4096, TOK = NBATCH * SEQ, DEPTH = 4, CHUNK = 64, PLE = 256;
constexpr int AH = 8, AD = 128, AW = 1024, BH = 8, BD = 128, BW = 1024, IH = 16, IDIM = 64, TOPK = 256;
constexpr int DFF = 5632, INW = 12368, INP = 12544;
constexpr float ALPHA = 1.6817928305074290861f;
constexpr float LN_EPS = 1e-5f, RMS_EPS = 1e-6f;
constexpr float ATTN_SCALE = 0.088388347648318440f;
constexpr float IDX_SCALE = 0.03125f;

typedef unsigned short bf16_t;
__device__ __forceinline__ float bf2f(bf16_t b) { return __uint_as_float(((unsigned)b) << 16); }
__device__ __forceinline__ bf16_t f2bf(float f) { unsigned u = __float_as_uint(f); u += 0x7FFFu + ((u >> 16) & 1u); return (bf16_t)(u >> 16); }
__device__ __forceinline__ float sigmoid_f(float x) { return __builtin_amdgcn_rcpf(1.0f + __expf(-x)); }
__device__ __forceinline__ float silu_f(float x) { return x * sigmoid_f(x); }

__device__ __forceinline__ int tid_() { int t = (int)threadIdx.x; asm volatile("" : "+v"(t)); return t; }
__device__ __forceinline__ int bid_() { int b = (int)blockIdx.x; asm volatile("" : "+s"(b)); return b; }
__device__ __forceinline__ int nblk_() { int g = (int)gridDim.x; asm volatile("" : "+s"(g)); return g; }

template <class T> __device__ __forceinline__ T* as_global(T* p) { return (T*)(__attribute__((address_space(1))) T*)p; }

constexpr size_t MiB = 1048576;
constexpr size_t WS_CTL  = 0;
constexpr size_t WS_LB   = WS_CTL + 65536;
constexpr size_t WS_STATS = WS_CTL + 131072;
constexpr size_t WS_COSH = 1 * MiB;
constexpr size_t WS_SINH = WS_COSH + 4 * MiB;
constexpr size_t WS_COSI = WS_SINH + 4 * MiB;
constexpr size_t WS_SINI = WS_COSI + 2 * MiB;
constexpr size_t WS_WIN  = WS_SINI + 2 * MiB;
constexpr size_t WS_WA   = WS_WIN + 49 * MiB;
constexpr size_t WS_WB   = WS_WA + 4 * MiB;
constexpr size_t WS_WO   = WS_WB + 4 * MiB;
constexpr size_t WS_WGU  = WS_WO + 8 * MiB;
constexpr size_t WS_WDN  = WS_WGU + 44 * MiB;
constexpr size_t WS_WPG  = WS_WDN + 22 * MiB;
constexpr size_t WS_WPP  = WS_WPG + 8 * MiB;
constexpr size_t WS_S    = WS_WPP + 1 * MiB;
constexpr size_t WS_XB   = WS_S + 130 * MiB;
constexpr size_t WS_XPRE = WS_XB + 64 * MiB;
constexpr size_t WS_R1   = WS_XPRE + 130 * MiB;
constexpr size_t WS_QA   = WS_R1;
constexpr size_t WS_LF   = WS_QA + 32 * MiB;
constexpr size_t WS_KA   = WS_LF + 64 * MiB;
constexpr size_t WS_VA   = WS_KA + 32 * MiB;
constexpr size_t WS_GA   = WS_VA + 32 * MiB;
constexpr size_t WS_QB   = WS_GA + 32 * MiB;
constexpr size_t WS_KB   = WS_QB + 32 * MiB;
constexpr size_t WS_VB   = WS_KB + 32 * MiB;
constexpr size_t WS_QI   = WS_VB + 32 * MiB;
constexpr size_t WS_SGA  = WS_QI + 32 * MiB;
constexpr size_t WS_SGB  = WS_SGA + 64 * MiB;
constexpr size_t WS_IKW  = WS_SGB + 64 * MiB;
constexpr size_t WS_H    = WS_R1;
constexpr size_t WS_PP   = WS_R1 + 176 * MiB;
constexpr size_t WS_R2   = WS_IKW + 8 * MiB;
constexpr size_t WS_LT   = WS_R2;
constexpr size_t WS_MG   = WS_R2;
constexpr size_t WS_AF   = WS_R2 + 64 * MiB;
constexpr size_t WS_PT   = WS_LT + 128 * MiB;
constexpr size_t WS_DEC  = WS_PT + 64 * MiB;
constexpr size_t WS_MASK = WS_DEC + 1 * MiB;
constexpr size_t WS_YA   = WS_MASK + 8 * MiB;
constexpr size_t WS_YB   = WS_YA + 32 * MiB;
constexpr size_t WS_KI   = WS_YB + 32 * MiB;
constexpr size_t WS_WI   = WS_KI + 2 * MiB;
constexpr size_t WS_PB   = WS_WI + 1 * MiB;
constexpr size_t WS_END  = WS_PB + 8 * MiB;
static_assert(WS_END < 1360000000ull, "workspace budget");
constexpr size_t SCORE_B = (size_t)4096 * 2080;

namespace pg8 {
#define PG8_LAS __attribute__((address_space(3)))
typedef unsigned short bf16_t;
typedef short bf16x8 __attribute__((ext_vector_type(8)));
typedef float f32x4 __attribute__((ext_vector_type(4)));
typedef unsigned u32x4 __attribute__((ext_vector_type(4)));
constexpr int BM = 256, BK = 64, HALF = 128, HTB = HALF * BK * 2  , STAGE_BYTES = 8 * HTB, NXCD = 8, WGM = 8;

__host__ __device__ __forceinline__ int lds_byte(int r, int c) { const int st = (r >> 4) * 2 + (c >> 5), rr = r & 15, cc = c & 31, ob = rr * 64 + cc * 2; return st * 1024 + (ob ^ (((ob >> 9) & 1) << 5)); }
__host__ __device__ __forceinline__ void stage_rc(int b, int& R, int& C) { const int st = b / 1024, sb = b % 1024, swz = sb ^ (((sb >> 9) & 1) << 5); R = (st >> 1) * 16 + swz / 64; C = (st & 1) * 32 + (swz % 64) / 2; }
__host__ __device__ __forceinline__ int perm32(int rho) { const int n = rho >> 4, i = rho & 15; return 8 * (i >> 2) + 4 * n + (i & 3); }

struct Unit { int pm, pn; };
struct Gemm { const bf16_t* A; const bf16_t* Bt; int M, N, K; };

struct StaticOrder {
    int nM, nN, nwg, G, c;
    __host__ __device__ void init(int M, int N, int G_, int c_) { nM = M / BM; nN = N / BM; nwg = nM * nN; G = G_; c = c_; }
    __host__ __device__ bool next(int i, Unit& u) const {
        const long L = (long)i * G + c; if (L >= nwg) return false;
        int wgid = (int)L; { const int q = nwg / NXCD, r = nwg % NXCD, xcd = wgid % NXCD, off = wgid / NXCD; wgid = (xcd < r ? xcd * (q + 1) : r * (q + 1) + (xcd - r) * q) + off; }
        const int nig = WGM * nN, gid = wgid / nig, fm = gid * WGM, gsz = (nM - fm) < WGM ? (nM - fm) : WGM;
        u.pm = fm + ((wgid % nig) % gsz); u.pn = (wgid % nig) / gsz; return true;
    }
    __device__ __forceinline__ void a_ready(const Unit&) const {}
    __device__ __forceinline__ void done(const Unit&) const {}
};

typedef float pk_f32x2 __attribute__((ext_vector_type(2)));
typedef __bf16 pk_bf16x2 __attribute__((ext_vector_type(2)));
__device__ __forceinline__ unsigned cvt_pk_bf16(float lo, float hi) { const pk_f32x2 v = {lo, hi}; const pk_bf16x2 b = __builtin_convertvector(v, pk_bf16x2); return __builtin_bit_cast(unsigned, b); }
typedef unsigned u32x2 __attribute__((ext_vector_type(2)));
typedef float f32x2 __attribute__((ext_vector_type(2)));
__device__ __forceinline__ u32x4 pack8(const f32x4 a, const f32x4 b) { u32x4 w; w.x = cvt_pk_bf16(a[0], a[1]); w.y = cvt_pk_bf16(a[2], a[3]); w.z = cvt_pk_bf16(b[0], b[1]); w.w = cvt_pk_bf16(b[2], b[3]); return w; }
__device__ __forceinline__ void unpack8(const u32x4 w, f32x4& a, f32x4& b) {
    a[0] = __uint_as_float(w.x << 16); a[1] = __uint_as_float(w.x & 0xffff0000u); a[2] = __uint_as_float(w.y << 16); a[3] = __uint_as_float(w.y & 0xffff0000u);
    b[0] = __uint_as_float(w.z << 16); b[1] = __uint_as_float(w.z & 0xffff0000u); b[2] = __uint_as_float(w.w << 16); b[3] = __uint_as_float(w.w & 0xffff0000u); }
__device__ __forceinline__ float sigm(float x) { return __builtin_amdgcn_rcpf(1.0f + __expf(-x)); }
__device__ __forceinline__ f32x4 sigm4(const f32x4 x) { f32x4 r; r[0] = sigm(x[0]); r[1] = sigm(x[1]); r[2] = sigm(x[2]); r[3] = sigm(x[3]); return r; }
__device__ __forceinline__ f32x4 silu4(const f32x4 x) { return x * sigm4(x); }

#define PG8_GAS __attribute__((address_space(1)))
struct EpiIn {
    static constexpr bool PERM = true, AFTER_DRAIN = false;
    unsigned char* ws0; int layer;
    __device__ __forceinline__ void operator()(const f32x4 (&acc)[2][2][4][2], const Unit& u, int wr, int wc, int fr, int fq) const {
        unsigned char* wsq = ws0; asm volatile("" : "+s"(wsq)); PG8_GAS unsigned char* const ws = (PG8_GAS unsigned char*)wsq;
        const int pn = u.pn, row0 = u.pm * BM + wr * 64 + fr, cw = wc * 32 + 8 * fq;
        PG8_GAS bf16_t* const QA = (PG8_GAS bf16_t*)(ws + WS_QA); PG8_GAS bf16_t* const KA = (PG8_GAS bf16_t*)(ws + WS_KA); PG8_GAS bf16_t* const VA = (PG8_GAS bf16_t*)(ws + WS_VA); PG8_GAS bf16_t* const GA = (PG8_GAS bf16_t*)(ws + WS_GA);
        PG8_GAS bf16_t* const QB = (PG8_GAS bf16_t*)(ws + WS_QB); PG8_GAS bf16_t* const KB = (PG8_GAS bf16_t*)(ws + WS_KB); PG8_GAS bf16_t* const VB = (PG8_GAS bf16_t*)(ws + WS_VB); PG8_GAS bf16_t* const QI = (PG8_GAS bf16_t*)(ws + WS_QI);
        PG8_GAS bf16_t* const SGA = (PG8_GAS bf16_t*)(ws + WS_SGA); PG8_GAS bf16_t* const SGB = (PG8_GAS bf16_t*)(ws + WS_SGB); PG8_GAS float* const LF = (PG8_GAS float*)(ws + WS_LF); PG8_GAS float* const IKW = (PG8_GAS float*)(ws + WS_IKW);
        const PG8_GAS float* const lb = (const PG8_GAS float*)(ws + WS_LB) + layer * 1024; const PG8_GAS float* const cosh = (const PG8_GAS float*)(ws + WS_COSH); const PG8_GAS float* const sinh = (const PG8_GAS float*)(ws + WS_SINH);
        const PG8_GAS float* const cosi = (const PG8_GAS float*)(ws + WS_COSI); const PG8_GAS float* const sini = (const PG8_GAS float*)(ws + WS_SINI);
        if (pn < 32) {
            const int seg = pn >> 2, cb = (pn & 3) * 256;
            if (seg == 4 || seg == 5) {
                PG8_GAS bf16_t* O = (seg == 4) ? QB : KB; const int head = (pn & 3) * 2 + (wc >> 1), i0 = (wc & 1) * 32 + 8 * fq;
#pragma unroll
                for (int ai = 0; ai < 2; ++ai)
#pragma unroll
                    for (int m = 0; m < 4; ++m) { const int row = row0 + ai * HALF + m * 16;
                        const PG8_GAS float* cp = cosh + (size_t)row * 64 + i0; const PG8_GAS float* sp = sinh + (size_t)row * 64 + i0;
                        const f32x4 c0 = *(const PG8_GAS f32x4*)cp, c1 = *(const PG8_GAS f32x4*)(cp + 4), s0 = *(const PG8_GAS f32x4*)sp, s1 = *(const PG8_GAS f32x4*)(sp + 4);
                        const f32x4 xa = acc[ai][0][m][0], xb = acc[ai][0][m][1], ya = acc[ai][1][m][0], yb = acc[ai][1][m][1];
                        PG8_GAS bf16_t* rp = O + (size_t)row * 1024 + head * 128 + i0;
                        *(PG8_GAS u32x4*)rp = pack8(xa * c0 - ya * s0, xb * c1 - yb * s1);
                        *(PG8_GAS u32x4*)(rp + 64) = pack8(xa * s0 + ya * c0, xb * s1 + yb * c1); asm volatile("" ::: "memory"); }
            } else if (seg == 7) {
                const int head = (pn & 3) * 4 + wc, i0 = 8 * fq;
#pragma unroll
                for (int ai = 0; ai < 2; ++ai)
#pragma unroll
                    for (int m = 0; m < 4; ++m) { const int row = row0 + ai * HALF + m * 16;
                        const PG8_GAS float* cp = cosi + (size_t)row * 32 + i0; const PG8_GAS float* sp = sini + (size_t)row * 32 + i0;
                        const f32x4 c0 = *(const PG8_GAS f32x4*)cp, c1 = *(const PG8_GAS f32x4*)(cp + 4), s0 = *(const PG8_GAS f32x4*)sp, s1 = *(const PG8_GAS f32x4*)(sp + 4);
                        const f32x4 xa = acc[ai][0][m][0], xb = acc[ai][0][m][1], ya = acc[ai][1][m][0], yb = acc[ai][1][m][1];
                        PG8_GAS bf16_t* rp = QI + (size_t)row * 1024 + head * 64 + i0;
                        *(PG8_GAS u32x4*)rp = pack8(xa * c0 - ya * s0, xb * c1 - yb * s1);
                        *(PG8_GAS u32x4*)(rp + 32) = pack8(xa * s0 + ya * c0, xb * s1 + yb * c1); asm volatile("" ::: "memory"); }
            } else if (seg == 1) {
#pragma unroll
                for (int bj = 0; bj < 2; ++bj) { const int col = cb + bj * HALF + cw;
                    const f32x4 l0 = *(const PG8_GAS f32x4*)(lb + col), l1 = *(const PG8_GAS f32x4*)(lb + col + 4);
#pragma unroll
                    for (int ai = 0; ai < 2; ++ai)
#pragma unroll
                        for (int m = 0; m < 4; ++m) { const int row = row0 + ai * HALF + m * 16; f32x4 lf[2], kk[2];
#pragma unroll
                            for (int n = 0; n < 2; ++n) { const f32x4 x = acc[ai][bj][m][n]; const f32x4 lv = n ? l1 : l0;
#pragma unroll
                                for (int j = 0; j < 4; ++j) { const float xe = fminf(fmaxf(x[j], -80.f), 80.f), e = __expf(-xe), r = __builtin_amdgcn_rcpf(1.0f + e);
                                    const float om = 1.0f - lv[j]; lf[n][j] = logf(lv[j] + om * r); kk[n][j] = om * (e * r); } }
                            PG8_GAS float* lp = LF + (size_t)row * 1024 + col; *(PG8_GAS f32x4*)lp = lf[0]; *(PG8_GAS f32x4*)(lp + 4) = lf[1];
                            *(PG8_GAS u32x4*)(KA + (size_t)row * 1024 + col) = pack8(kk[0], kk[1]); asm volatile("" ::: "memory"); } }
            } else {
                PG8_GAS bf16_t* O = (seg == 0) ? QA : (seg == 2) ? VA : (seg == 3) ? GA : VB; const bool act = (seg == 0 || seg == 3);
#pragma unroll
                for (int ai = 0; ai < 2; ++ai)
#pragma unroll
                    for (int m = 0; m < 4; ++m) { const int row = row0 + ai * HALF + m * 16;
#pragma unroll
                        for (int bj = 0; bj < 2; ++bj) { f32x4 v0 = acc[ai][bj][m][0], v1 = acc[ai][bj][m][1];
                            if (act) { v0 = silu4(v0); v1 = silu4(v1); }
                            *(PG8_GAS u32x4*)(O + (size_t)row * 1024 + cb + bj * HALF + cw) = pack8(v0, v1); } }
            }
        } else if (pn < 48) {
            PG8_GAS bf16_t* O = (pn < 40) ? SGA : SGB; const int cb = ((pn - 32) & 7) * 256;
#pragma unroll
            for (int ai = 0; ai < 2; ++ai)
#pragma unroll
                for (int m = 0; m < 4; ++m) { const int row = row0 + ai * HALF + m * 16;
#pragma unroll
                    for (int bj = 0; bj < 2; ++bj)
                        *(PG8_GAS u32x4*)(O + (size_t)row * DM + cb + bj * HALF + cw) = pack8(sigm4(acc[ai][bj][m][0]), sigm4(acc[ai][bj][m][1])); }
        } else {
#pragma unroll
            for (int ai = 0; ai < 2; ++ai)
#pragma unroll
                for (int m = 0; m < 4; ++m) { PG8_GAS float* p = IKW + (size_t)(row0 + ai * HALF + m * 16) * 128 + cw; *(PG8_GAS f32x4*)p = acc[ai][0][m][0]; *(PG8_GAS f32x4*)(p + 4) = acc[ai][0][m][1]; }
        }
    }
};
struct EpiGateA {
    static constexpr bool PERM = true, AFTER_DRAIN = false;
    unsigned char* ws;
    __device__ __forceinline__ void operator()(const f32x4 (&acc)[2][2][4][2], const Unit& u, int wr, int wc, int fr, int fq) const {
        unsigned char* const wg = as_global(ws); const bf16_t* const SG = (const bf16_t*)(wg + WS_SGA); bf16_t* const AF = (bf16_t*)(wg + WS_AF);
        const int row0 = u.pm * BM + wr * 64 + fr, col0 = u.pn * BM + wc * 32 + 8 * fq;
#pragma unroll
        for (int ai = 0; ai < 2; ++ai)
#pragma unroll
            for (int m = 0; m < 4; ++m) { const size_t off = (size_t)(row0 + ai * HALF + m * 16) * DM + col0;
#pragma unroll
                for (int bj = 0; bj < 2; ++bj) { f32x4 g0, g1; unpack8(*(const u32x4*)(SG + off + bj * HALF), g0, g1);
                    *(u32x4*)(AF + off + bj * HALF) = pack8(g0 * acc[ai][bj][m][0], g1 * acc[ai][bj][m][1]); } asm volatile("" ::: "memory"); }
    }
};
struct EpiGateB {
    static constexpr bool PERM = true, AFTER_DRAIN = false;
    unsigned char* ws;
    __device__ __forceinline__ void operator()(const f32x4 (&acc)[2][2][4][2], const Unit& u, int wr, int wc, int fr, int fq) const {
        unsigned char* const wg = as_global(ws); const bf16_t* const SG = (const bf16_t*)(wg + WS_SGB); const bf16_t* const AF = (const bf16_t*)(wg + WS_AF); bf16_t* const MG = (bf16_t*)(wg + WS_MG);
        const int row0 = u.pm * BM + wr * 64 + fr, col0 = u.pn * BM + wc * 32 + 8 * fq;
#pragma unroll
        for (int ai = 0; ai < 2; ++ai)
#pragma unroll
            for (int m = 0; m < 4; ++m) { const size_t off = (size_t)(row0 + ai * HALF + m * 16) * DM + col0;
#pragma unroll
                for (int bj = 0; bj < 2; ++bj) { f32x4 g0, g1; unpack8(*(const u32x4*)(SG + off + bj * HALF), g0, g1);
                    f32x4 a0, a1; unpack8(*(const u32x4*)(AF + off + bj * HALF), a0, a1);
                    *(u32x4*)(MG + off + bj * HALF) = pack8(a0 + g0 * acc[ai][bj][m][0], a1 + g1 * acc[ai][bj][m][1]); } asm volatile("" ::: "memory"); }
    }
};
template <bool PLAIN> struct EpiRes {
    static constexpr bool PERM = true, AFTER_DRAIN = false;
    const float* X; const float* g; const float* b; unsigned char* ws;
    __device__ __forceinline__ void operator()(const f32x4 (&acc)[2][2][4][2], const Unit& u, int wr, int wc, int fr, int fq) const {
        unsigned char* const wg = as_global(ws); float* const XP = (float*)(wg + WS_XPRE); const float* const ST = (const float*)(wg + WS_STATS); const float* const Xg = as_global(X);
        const int row0 = u.pm * BM + wr * 64 + fr, col0 = u.pn * BM + wc * 32 + 8 * fq;
        f32x4 gv[2][2], bv[2][2];
        if (!PLAIN) { const float* gg = as_global(g); const float* bb = as_global(b);
#pragma unroll
            for (int bj = 0; bj < 2; ++bj)
#pragma unroll
                for (int n = 0; n < 2; ++n) { gv[bj][n] = *(const f32x4*)(gg + col0 + bj * HALF + 4 * n); bv[bj][n] = *(const f32x4*)(bb + col0 + bj * HALF + 4 * n); } }
#pragma unroll
        for (int ai = 0; ai < 2; ++ai)
#pragma unroll
            for (int m = 0; m < 4; ++m) { const int row = row0 + ai * HALF + m * 16; const size_t off = (size_t)row * DM + col0;
                float mean = 0.f, rstd = 1.f; if (!PLAIN) { const f32x2 s2 = *(const f32x2*)(ST + 2 * (size_t)row); mean = s2[0]; rstd = s2[1]; }
#pragma unroll
                for (int bj = 0; bj < 2; ++bj) { float* p = XP + off + bj * HALF; f32x4 x0, x1;
                    if (PLAIN) { const float* xp = Xg + off + bj * HALF; x0 = *(const f32x4*)xp; x1 = *(const f32x4*)(xp + 4); }
                    else { x0 = (*(const f32x4*)p - mean) * rstd * gv[bj][0] + bv[bj][0]; x1 = (*(const f32x4*)(p + 4) - mean) * rstd * gv[bj][1] + bv[bj][1]; }
                    *(f32x4*)p = x0 * ALPHA + acc[ai][bj][m][0]; *(f32x4*)(p + 4) = x1 * ALPHA + acc[ai][bj][m][1]; } asm volatile("" ::: "memory"); }
    }
};
struct EpiSwiGLU {
    static constexpr bool PERM = true, AFTER_DRAIN = false;
    unsigned char* ws;
    __device__ __forceinline__ void operator()(const f32x4 (&acc)[2][2][4][2], const Unit& u, int wr, int wc, int fr, int fq) const {
        bf16_t* const H = (bf16_t*)(as_global(ws) + WS_H);
        const int row0 = u.pm * BM + wr * 64 + fr, col0 = u.pn * HALF + wc * 32 + 8 * fq;
#pragma unroll
        for (int ai = 0; ai < 2; ++ai)
#pragma unroll
            for (int m = 0; m < 4; ++m)
                *(u32x4*)(H + (size_t)(row0 + ai * HALF + m * 16) * DFF + col0) = pack8(silu4(acc[ai][0][m][0]) * acc[ai][1][m][0], silu4(acc[ai][0][m][1]) * acc[ai][1][m][1]);
    }
};
struct EpiF32P {
    static constexpr bool PERM = true, AFTER_DRAIN = false;
    unsigned char* ws;
    __device__ __forceinline__ void operator()(const f32x4 (&acc)[2][2][4][2], const Unit& u, int wr, int wc, int fr, int fq) const {
        bf16_t* const C = (bf16_t*)(as_global(ws) + WS_PP);
        const int row0 = u.pm * BM + wr * 64 + fr, col0 = u.pn * BM + wc * 32 + 8 * fq;
#pragma unroll
        for (int ai = 0; ai < 2; ++ai)
#pragma unroll
            for (int m = 0; m < 4; ++m) { const size_t off = (size_t)(row0 + ai * HALF + m * 16) * DM + col0;
#pragma unroll
                for (int bj = 0; bj < 2; ++bj) *(u32x4*)(C + off + bj * HALF) = pack8(acc[ai][bj][m][0], acc[ai][bj][m][1]); }
    }
};
struct EpiPle {
    static constexpr bool PERM = true, AFTER_DRAIN = false;
    const float* g; const float* b; unsigned char* ws;
    __device__ __forceinline__ void operator()(const f32x4 (&acc)[2][2][4][2], const Unit& u, int wr, int wc, int fr, int fq) const {
        unsigned char* const wg = as_global(ws); const bf16_t* const PP = (const bf16_t*)(wg + WS_PP); float* const XP = (float*)(wg + WS_XPRE); const float* const ST = (const float*)(wg + WS_STATS);
        const int row0 = u.pm * BM + wr * 64 + fr, col0 = u.pn * BM + wc * 32 + 8 * fq;
        f32x4 gv[2][2], bv[2][2]; { const float* gg = as_global(g); const float* bb = as_global(b);
#pragma unroll
            for (int bj = 0; bj < 2; ++bj)
#pragma unroll
                for (int n = 0; n < 2; ++n) { gv[bj][n] = *(const f32x4*)(gg + col0 + bj * HALF + 4 * n); bv[bj][n] = *(const f32x4*)(bb + col0 + bj * HALF + 4 * n); } }
#pragma unroll
        for (int ai = 0; ai < 2; ++ai)
#pragma unroll
            for (int m = 0; m < 4; ++m) { const int row = row0 + ai * HALF + m * 16; const size_t off = (size_t)row * DM + col0;
                const f32x2 s2 = *(const f32x2*)(ST + 2 * (size_t)row); const float mean = s2[0], rstd = s2[1];
#pragma unroll
                for (int bj = 0; bj < 2; ++bj) { float* p = XP + off + bj * HALF; f32x4 p0, p1; unpack8(*(const u32x4*)(PP + off + bj * HALF), p0, p1);
                    const f32x4 x0 = (*(const f32x4*)p - mean) * rstd * gv[bj][0] + bv[bj][0], x1 = (*(const f32x4*)(p + 4) - mean) * rstd * gv[bj][1] + bv[bj][1];
                    *(f32x4*)p = x0 * ALPHA + sigm4(acc[ai][bj][m][0]) * p0; *(f32x4*)(p + 4) = x1 * ALPHA + sigm4(acc[ai][bj][m][1]) * p1; } asm volatile("" ::: "memory"); }
    }
};

template <class Epi, class Sched, bool ALIGN_EPI = false, bool SP2 = false>
__device__ __forceinline__ void gemm_phase(PG8_LAS unsigned char* lds, const Gemm g, const Sched& S, const Epi& E) {
    const int tid = tid_(), wid = __builtin_amdgcn_readfirstlane(tid >> 6), lane = tid & 63, wr = wid >> 2, wc = wid & 3, fr = lane & 15, fq = lane >> 4;
    int Kq = g.K; asm volatile("" : "+s"(Kq)); const int K = Kq, nt = K / BK;
    unsigned voffA[2], voffB[2];
#pragma unroll
    for (int i = 0; i < 2; ++i) { int R, C; stage_rc(tid * 16 + i * 8192, R, C); const int Rb = Epi::PERM ? ((R & ~31) + perm32(R & 31)) : R;
        voffA[i] = (unsigned)(R * K + C) * 2u; voffB[i] = (unsigned)(Rb * K + C) * 2u; }
    const size_t kstep = (size_t)(BK * 2);
    const size_t hstep = (size_t)HALF * K * 2;
    const size_t tstep = 2 * hstep;
    const unsigned ldsw = (unsigned)wid * 1024u;
    const int aoff = lds_byte(wr * 64 + fr, fq * 8), boff = lds_byte(wc * 32 + fr, fq * 8);
#define PG8_SA(b, h) (((b) * 2 + (h)) * HTB)
#define PG8_SB(b, h) ((4 + (b) * 2 + (h)) * HTB)
#define PG8_STAGE(bufoff, gbase, voff) do { _Pragma("unroll") for (int _i = 0; _i < 2; ++_i) \
        __builtin_amdgcn_global_load_lds((const unsigned*)((const char*)(gbase) + (voff)[_i]), (PG8_LAS unsigned*)(lds + (bufoff) + ldsw + _i * 8192), 16, 0, 0); } while (0)
#define PG8_LDA(dst, b, h) do { _Pragma("unroll") for (int m = 0; m < 4; ++m) _Pragma("unroll") for (int k = 0; k < 2; ++k) dst[m][k] = *(const PG8_LAS bf16x8*)(lds + PG8_SA(b, h) + aoff + m * 2048 + k * 1024); } while (0)
#define PG8_LDB(dst, b, h) do { _Pragma("unroll") for (int n = 0; n < 2; ++n) _Pragma("unroll") for (int k = 0; k < 2; ++k) dst[n][k] = *(const PG8_LAS bf16x8*)(lds + PG8_SB(b, h) + boff + n * 2048 + k * 1024); } while (0)
#define PG8_MMA(ai, bj, At, Bt) do { __builtin_amdgcn_s_setprio(1); _Pragma("unroll") for (int m = 0; m < 4; ++m) _Pragma("unroll") for (int n = 0; n < 2; ++n) _Pragma("unroll") for (int k = 0; k < 2; ++k) \
        acc[ai][bj][m][n] = __builtin_amdgcn_mfma_f32_16x16x32_bf16(Bt[n][k], At[m][k], acc[ai][bj][m][n], 0, 0, 0); __builtin_amdgcn_s_setprio(0); } while (0)
#define PG8_WAIT_V(n) asm volatile("s_waitcnt vmcnt(" #n ")" ::: "memory")
#define PG8_WAIT_L(n) asm volatile("s_waitcnt lgkmcnt(" #n ")" ::: "memory")
#define PG8_BAR __builtin_amdgcn_s_barrier()
#define PG8_SCHED __builtin_amdgcn_sched_barrier(0)
    Unit cur, nxt; int ui = 0;
    if (!S.next(0, cur)) return;
    f32x4 acc[2][2][4][2];
#pragma unroll
    for (int a = 0; a < 2; ++a)
#pragma unroll
        for (int b = 0; b < 2; ++b)
#pragma unroll
            for (int m = 0; m < 4; ++m)
#pragma unroll
                for (int n = 0; n < 2; ++n) acc[a][b][m][n] = (f32x4){0.f, 0.f, 0.f, 0.f};
    bf16x8 At[4][2], B0[2][2], B1[2][2];
    const char* cA = (const char*)g.A + (size_t)cur.pm * tstep; const char* cB = (const char*)g.Bt + (size_t)cur.pn * tstep;
    S.a_ready(cur);
    if constexpr (SP2) {
        PG8_STAGE(PG8_SB(0, 0), cB, voffB); PG8_STAGE(PG8_SB(0, 1), cB + hstep, voffB); PG8_STAGE(PG8_SA(0, 0), cA, voffA); PG8_STAGE(PG8_SA(0, 1), cA + hstep, voffA);
        if (wr == 1) PG8_BAR;
        PG8_WAIT_V(2); PG8_BAR;
        PG8_STAGE(PG8_SB(1, 0), cB + kstep, voffB); PG8_STAGE(PG8_SA(1, 0), cA + kstep, voffA); PG8_STAGE(PG8_SB(1, 1), cB + hstep + kstep, voffB);
        PG8_WAIT_V(6); PG8_BAR;
    } else {
        PG8_STAGE(PG8_SB(0, 0), cB, voffB); PG8_STAGE(PG8_SA(0, 0), cA, voffA); PG8_STAGE(PG8_SB(0, 1), cB + hstep, voffB); PG8_STAGE(PG8_SA(0, 1), cA + hstep, voffA);
        if (wr == 1) PG8_BAR;
        PG8_WAIT_V(4); PG8_BAR;
        PG8_STAGE(PG8_SB(1, 0), cB + kstep, voffB); PG8_STAGE(PG8_SA(1, 0), cA + kstep, voffA); PG8_STAGE(PG8_SB(1, 1), cB + hstep + kstep, voffB);
        PG8_WAIT_V(6); PG8_BAR;
    }
    for (;;) {
        const bool has_next = S.next(ui + 1, nxt);
        const char* nA = has_next ? (const char*)g.A + (size_t)nxt.pm * tstep : cA; const char* nB = has_next ? (const char*)g.Bt + (size_t)nxt.pn * tstep : cB;
        for (int t = 0; t < nt; t += 2) {
            const bool last = (t == nt - 2);
            const char* a1 = cA + (size_t)(t + 1) * kstep;
            const char* a2 = last ? nA : cA + (size_t)(t + 2) * kstep; const char* b2 = last ? nB : cB + (size_t)(t + 2) * kstep;
            const char* a3 = a2 + kstep; const char* b3 = b2 + kstep;
            if (last && has_next) S.a_ready(nxt);
            if constexpr (SP2) {
            PG8_LDB(B0, 0, 0); PG8_LDB(B1, 0, 1); PG8_SCHED; PG8_LDA(At, 0, 0); PG8_STAGE(PG8_SA(1, 1), a1 + hstep, voffA);
            PG8_WAIT_V(8); PG8_WAIT_L(0); PG8_BAR; PG8_MMA(0, 0, At, B0); PG8_MMA(0, 1, At, B1); PG8_BAR; PG8_SCHED;
            PG8_LDA(At, 0, 1); PG8_STAGE(PG8_SB(0, 0), b2, voffB); PG8_STAGE(PG8_SB(0, 1), b2 + hstep, voffB); PG8_STAGE(PG8_SA(0, 0), a2, voffA);
            PG8_WAIT_V(8); PG8_WAIT_L(0); PG8_BAR; PG8_MMA(1, 0, At, B0); PG8_MMA(1, 1, At, B1); PG8_BAR; PG8_SCHED;
            PG8_LDB(B0, 1, 0); PG8_LDB(B1, 1, 1); PG8_SCHED; PG8_LDA(At, 1, 0); PG8_STAGE(PG8_SA(0, 1), a2 + hstep, voffA);
            PG8_WAIT_V(8); PG8_WAIT_L(0); PG8_BAR; PG8_MMA(0, 0, At, B0); PG8_MMA(0, 1, At, B1); PG8_BAR; PG8_SCHED;
            PG8_LDA(At, 1, 1); PG8_STAGE(PG8_SB(1, 0), b3, voffB); PG8_STAGE(PG8_SB(1, 1), b3 + hstep, voffB); PG8_STAGE(PG8_SA(1, 0), a3, voffA);
            PG8_WAIT_V(8); PG8_WAIT_L(0); PG8_BAR; PG8_MMA(1, 0, At, B0); PG8_MMA(1, 1, At, B1); PG8_BAR; PG8_SCHED;
            } else {
            PG8_LDB(B0, 0, 0); PG8_SCHED; PG8_LDA(At, 0, 0); PG8_STAGE(PG8_SA(1, 1), a1 + hstep, voffA);
            PG8_WAIT_L(8); PG8_BAR; PG8_WAIT_L(0); PG8_MMA(0, 0, At, B0); PG8_BAR; PG8_SCHED;
            PG8_LDB(B1, 0, 1); PG8_STAGE(PG8_SB(0, 0), b2, voffB);
            PG8_BAR; PG8_WAIT_L(0); PG8_MMA(0, 1, At, B1); PG8_BAR;
            PG8_LDA(At, 0, 1); PG8_STAGE(PG8_SA(0, 0), a2, voffA);
            PG8_BAR; PG8_WAIT_L(0); PG8_MMA(1, 0, At, B0); PG8_BAR; PG8_SCHED;
            PG8_STAGE(PG8_SB(0, 1), b2 + hstep, voffB);
            PG8_WAIT_V(6); PG8_BAR; PG8_MMA(1, 1, At, B1); PG8_BAR;
            PG8_LDB(B0, 1, 0); PG8_SCHED; PG8_LDA(At, 1, 0); PG8_STAGE(PG8_SA(0, 1), a2 + hstep, voffA);
            PG8_WAIT_L(8); PG8_BAR; PG8_WAIT_L(0); PG8_MMA(0, 0, At, B0); PG8_BAR; PG8_SCHED;
            PG8_LDB(B1, 1, 1); PG8_STAGE(PG8_SB(1, 0), b3, voffB);
            PG8_BAR; PG8_WAIT_L(0); PG8_MMA(0, 1, At, B1); PG8_BAR;
            PG8_LDA(At, 1, 1); PG8_STAGE(PG8_SA(1, 0), a3, voffA);
            PG8_BAR; PG8_WAIT_L(0); PG8_MMA(1, 0, At, B0); PG8_BAR; PG8_SCHED;
            PG8_STAGE(PG8_SB(1, 1), b3 + hstep, voffB);
            PG8_WAIT_V(6); PG8_BAR; PG8_MMA(1, 1, At, B1); PG8_BAR;
            }
        }
        if constexpr (ALIGN_EPI) { if (wr == 0) PG8_BAR; }
        if constexpr (!Epi::AFTER_DRAIN) { E(acc, cur, wr, wc, fr, fq); S.done(cur); }
        if (!has_next) break;
#pragma unroll
        for (int a = 0; a < 2; ++a)
#pragma unroll
            for (int b = 0; b < 2; ++b)
#pragma unroll
                for (int m = 0; m < 4; ++m)
#pragma unroll
                    for (int n = 0; n < 2; ++n) acc[a][b][m][n] = (f32x4){0.f, 0.f, 0.f, 0.f};
        cur = nxt; cA = nA; cB = nB; ++ui;
        if constexpr (ALIGN_EPI) { if (wr == 1) PG8_BAR; }
    }
    PG8_WAIT_V(0);
    if constexpr (!ALIGN_EPI) { if (wr == 0) PG8_BAR; }
    PG8_BAR;
    if constexpr (Epi::AFTER_DRAIN) { E.fused(acc, cur, wr, wc, fr, fq, lds, wid, lane); S.done(cur); }
#undef PG8_SA
#undef PG8_SB
#undef PG8_STAGE
#undef PG8_LDA
#undef PG8_LDB
#undef PG8_MMA
#undef PG8_WAIT_V
#undef PG8_WAIT_L
#undef PG8_BAR
#undef PG8_SCHED
}
}
#define XB_TMO      128
#define XB_XCNT(j)  (256  + 64 * (j))
#define XB_XSUB(j)  (1280 + 64 * (j))
#define XB_XGEN(j)  (2304 + 64 * (j))
#define XB_TOP      3328
#define XB_TOPGEN   3392
#define XCD_BAR_WORDS 3456
#define XB_SPIN_CAP (1u << 18)
#define LAS __attribute__((address_space(3)))

__device__ __forceinline__ unsigned xb_ld(unsigned* p)              { return __hip_atomic_load(p, __ATOMIC_RELAXED, __HIP_MEMORY_SCOPE_AGENT); }
__device__ __forceinline__ unsigned xb_add(unsigned* p, unsigned v) { return __hip_atomic_fetch_add(p, v, __ATOMIC_RELAXED, __HIP_MEMORY_SCOPE_AGENT); }
__device__ __forceinline__ unsigned xb_xcc_id() { return (unsigned)__builtin_amdgcn_s_getreg((3 << 11) | 20) & 0xFu; }
#define XB_SPIN(cond, bar) do { unsigned _sp = 0; while (cond) { __builtin_amdgcn_s_sleep(1); \
    if ((++_sp & 255u) == 0u) { if (xb_ld(&(bar)[XB_TMO])) break; if (_sp > XB_SPIN_CAP) { atomicAdd(&(bar)[XB_TMO], 1u); break; } } } } while (0)

struct XcdBarrier {
    unsigned* bar; unsigned x;
    volatile LAS unsigned* st;
};

__device__ __forceinline__ XcdBarrier xcd_barrier_post(unsigned* bar, volatile LAS unsigned* st) {
    XcdBarrier b; b.bar = bar; b.x = xb_xcc_id(); b.st = st;
    if (threadIdx.x == 0) (void)xb_add(&bar[XB_XCNT(b.x)], 1u);
    return b;
}
__device__ __forceinline__ void xcd_barrier_complete(unsigned* bar, unsigned x, unsigned& nloc, unsigned& nx) {
    const unsigned G = gridDim.x * gridDim.y * gridDim.z;
    unsigned sum, cnt, mine, sp = 0u;
    for (;;) {
        sum = 0u; cnt = 0u; mine = 0u;
#pragma unroll
        for (unsigned j = 0; j < 16; ++j) { const unsigned c = xb_ld(&bar[XB_XCNT(j)]); sum += c; cnt += (c > 0u) ? 1u : 0u; mine = (j == x) ? c : mine; }
        if (sum == G) break;
        __builtin_amdgcn_s_sleep(1);
        if ((++sp & 255u) == 0u) { if (xb_ld(&bar[XB_TMO])) break; if (sp > XB_SPIN_CAP) { atomicAdd(&bar[XB_TMO], 1u); break; } }
    }
    nloc = mine > 0u ? mine : 1u; nx = cnt > 0u ? cnt : 1u;
}

__device__ __forceinline__ void xcd_barrier(const XcdBarrier& b) {
    asm volatile("s_waitcnt vmcnt(0)" ::: "memory");
    __syncthreads();
    if (threadIdx.x == 0) {
        unsigned* bar = b.bar;
        __builtin_amdgcn_s_waitcnt(0);
        const unsigned bx = xb_xcc_id();
        unsigned nloc = b.st[0], nx = b.st[1];
        if (nloc == 0u) { xcd_barrier_complete(bar, bx, nloc, nx); b.st[0] = nloc; b.st[1] = nx; }
        const unsigned old = xb_add(&bar[XB_XSUB(bx)], 1u);
        const unsigned gen = old / nloc;
        if (old + 1u == (gen + 1u) * nloc) {
            __builtin_amdgcn_fence(__ATOMIC_RELEASE, "agent");
            asm volatile("s_waitcnt vmcnt(0)" ::: "memory");
            const unsigned og = xb_add(&bar[XB_TOP], 1u);
            const unsigned tg = og / nx;
            if (og + 1u == (tg + 1u) * nx) xb_add(&bar[XB_TOPGEN], 1u);
            else XB_SPIN(xb_ld(&bar[XB_TOPGEN]) == tg, bar);
            __builtin_amdgcn_fence(__ATOMIC_ACQUIRE, "agent");
            xb_add(&bar[XB_XGEN(bx)], 1u);
            asm volatile("s_waitcnt vmcnt(0)" ::: "memory");
        } else {
            XB_SPIN(xb_ld(&bar[XB_XGEN(bx)]) == gen, bar);
            __builtin_amdgcn_fence(__ATOMIC_ACQUIRE, "agent");
            asm volatile("s_waitcnt vmcnt(0)" ::: "memory");
        }
    }
    __syncthreads();
}

struct Params {
    const float* x; const float* p; const int* pos;
    const float *w_in, *w_a, *w_b, *w_out, *lbraw, *hnorm_g, *ikn_g, *ikn_b, *lnm_g, *lnm_b, *w_fg, *w_fu, *w_fd, *lnf_g, *lnf_b, *w_pg, *w_pp, *lnp_g, *lnp_b;
    float* out; unsigned char* ws;
    double invf_h[64]; double invf_i[32];
    int ph_lo, ph_hi;
};
typedef const __attribute__((address_space(4))) Params* KP;
__device__ __forceinline__ KP kparams() { KP p = (KP)__builtin_amdgcn_kernarg_segment_ptr(); asm volatile("" : "+s"(p)); return p; }
constexpr int NPH_LAYER = 14, NPH = DEPTH * NPH_LAYER;
constexpr int LDS_BYTES = 131072 + 1024;
constexpr int MISC_OFF = 131072;

__device__ __forceinline__ int wsrc_col_in(int n) {
    const int tile = n >> 8, t = n & 255;
    if (tile < 16) return n;
    if (tile < 24) { const int bj = t >> 7, u = t & 127, head = u >> 6, i = u & 63; return tile * 256 + 128 * head + 64 * bj + i; }
    if (tile < 28) return n;
    if (tile < 32) { const int bj = t >> 7, u = t & 127, head = u >> 5, i = u & 31; return tile * 256 + 64 * head + 32 * bj + i; }
    if (tile < 40) return 8272 + (n - 32 * 256);
    if (tile < 48) return 10320 + (n - 40 * 256);
    return t < 80 ? 8192 + t : -1;
}
constexpr int WC_LD = 144;
template <int KIND>
__device__ __forceinline__ void wconv_wave_tile(const float* src, const float* src2, int nsrc, int K, bf16_t* dst, int n0, int k0, int lane, LAS unsigned char* img) {
    const int n = n0 + lane; int c; const float* s = src;
    if (KIND == 0) c = n;
    else if (KIND == 1) c = wsrc_col_in(n);
    else { const int tl = n >> 8, t = n & 255; c = tl * 128 + (t & 127); if (t >= 128) s = src2; }
    float f[64];
    const float* sp = s + (size_t)k0 * nsrc + (c >= 0 ? c : 0);
#pragma unroll
    for (int kk = 0; kk < 64; ++kk) f[kk] = sp[(size_t)kk * nsrc];
#pragma unroll
    for (int i = 0; i < 8; ++i) { pg8::u32x4 w;
        w.x = pg8::cvt_pk_bf16(f[8 * i], f[8 * i + 1]); w.y = pg8::cvt_pk_bf16(f[8 * i + 2], f[8 * i + 3]); w.z = pg8::cvt_pk_bf16(f[8 * i + 4], f[8 * i + 5]); w.w = pg8::cvt_pk_bf16(f[8 * i + 6], f[8 * i + 7]);
        if (c < 0) w = (pg8::u32x4){0u, 0u, 0u, 0u};
        *(LAS pg8::u32x4*)(img + lane * WC_LD + 16 * i) = w; }
#pragma unroll
    for (int i = 0; i < 8; ++i) { const int p = lane + 64 * i, row = p >> 3, seg = p & 7;
        const pg8::u32x4 w = *(const LAS pg8::u32x4*)(img + row * WC_LD + 16 * seg);
        *(pg8::u32x4*)(dst + (size_t)(n0 + row) * K + k0 + 8 * seg) = w; }
}
template <int KIND>
__device__ __forceinline__ void wconv_job(const float* src, const float* src2, int nsrc, int K, bf16_t* dst, int ndst, int W, int NWV, int lane, LAS unsigned char* img, int& tcount) {
    const int kt = K / 64, ntiles = (ndst / 64) * kt;
    const int nb = ndst / 64; int first = (W - tcount % NWV + NWV) % NWV;
    for (int t = first; t < ntiles; t += NWV) wconv_wave_tile<KIND>(src, src2, nsrc, K, dst, (t % nb) * 64, (t / nb) * 64, lane, img);
    tcount += ntiles;
}
__device__ __forceinline__ void phase_wconv(KP P, int layer, LAS unsigned char* lds) {
    unsigned char* ws = as_global(P->ws); int tc = 0;
    const int tid0 = tid_(), lane = tid0 & 63, wv0 = __builtin_amdgcn_readfirstlane(tid0 >> 6), W = bid_() * 8 + wv0, NWV = nblk_() * 8;
    LAS unsigned char* img = lds + wv0 * (64 * WC_LD);
    wconv_job<1>(as_global(P->w_in) + (size_t)layer * DM * INW, nullptr, INW, DM, (bf16_t*)(ws + WS_WIN), INP, W, NWV, lane, img, tc);
    wconv_job<0>(as_global(P->w_a) + (size_t)layer * AW * DM, nullptr, DM, AW, (bf16_t*)(ws + WS_WA), DM, W, NWV, lane, img, tc);
    wconv_job<0>(as_global(P->w_b) + (size_t)layer * BW * DM, nullptr, DM, BW, (bf16_t*)(ws + WS_WB), DM, W, NWV, lane, img, tc);
    wconv_job<0>(as_global(P->w_out) + (size_t)layer * DM * DM, nullptr, DM, DM, (bf16_t*)(ws + WS_WO), DM, W, NWV, lane, img, tc);
    wconv_job<2>(as_global(P->w_fg) + (size_t)layer * DM * DFF, as_global(P->w_fu) + (size_t)layer * DM * DFF, DFF, DM, (bf16_t*)(ws + WS_WGU), 2 * DFF, W, NWV, lane, img, tc);
    wconv_job<0>(as_global(P->w_fd) + (size_t)layer * DFF * DM, nullptr, DM, DFF, (bf16_t*)(ws + WS_WDN), DM, W, NWV, lane, img, tc);
    wconv_job<0>(as_global(P->w_pg) + (size_t)layer * DM * DM, nullptr, DM, DM, (bf16_t*)(ws + WS_WPG), DM, W, NWV, lane, img, tc);
    wconv_job<0>(as_global(P->w_pp) + (size_t)layer * PLE * DM, nullptr, DM, PLE, (bf16_t*)(ws + WS_WPP), DM, W, NWV, lane, img, tc);
    const float* ps = as_global(P->p) + (size_t)layer * TOK * PLE; bf16_t* pb = (bf16_t*)(ws + WS_PB);
    for (size_t i = ((size_t)bid_() * 512 + tid_()) * 8; i < (size_t)TOK * PLE; i += (size_t)nblk_() * 512 * 8)
        *(pg8::u32x4*)(pb + i) = pg8::pack8(*(const pg8::f32x4*)(ps + i), *(const pg8::f32x4*)(ps + i + 4));
}
__device__ __forceinline__ void phase_prologue(KP P) {
    unsigned char* ws = as_global(P->ws); const size_t gtid = (size_t)bid_() * 512 + tid_(), gsz = (size_t)nblk_() * 512;
    bf16_t* xb = (bf16_t*)(ws + WS_XB); const float* xin = as_global(P->x); const int* posg = as_global(P->pos); const float* lbr = as_global(P->lbraw);
    for (size_t i = gtid * 8; i < (size_t)TOK * DM; i += gsz * 8) *(pg8::u32x4*)(xb + i) = pg8::pack8(*(const pg8::f32x4*)(xin + i), *(const pg8::f32x4*)(xin + i + 4));
    float* ch = (float*)(ws + WS_COSH); float* sh = (float*)(ws + WS_SINH); float* ci = (float*)(ws + WS_COSI); float* si = (float*)(ws + WS_SINI);
    for (size_t i = gtid; i < (size_t)TOK * 64; i += gsz) { const int t = (int)(i >> 6), j = (int)(i & 63); const double rev = (double)posg[t] * P->invf_h[j]; const float fr = (float)(rev - rint(rev));
        ch[i] = __builtin_amdgcn_cosf(fr); sh[i] = __builtin_amdgcn_sinf(fr); }
    for (size_t i = gtid; i < (size_t)TOK * 32; i += gsz) { const int t = (int)(i >> 5), j = (int)(i & 31); const double rev = (double)posg[t] * P->invf_i[j]; const float fr = (float)(rev - rint(rev));
        ci[i] = __builtin_amdgcn_cosf(fr); si[i] = __builtin_amdgcn_sinf(fr); }
    float* lb = (float*)(ws + WS_LB);
    for (size_t c = gtid; c < 1024; c += gsz) { float v[4], mx = -1e30f; for (int l = 0; l < 4; ++l) { v[l] = lbr[l * 1024 + c]; mx = fmaxf(mx, v[l]); }
        float s = 0.f; for (int l = 0; l < 4; ++l) { v[l] = expf(v[l] - mx); s += v[l]; }
        float cum = 0.f; const float inv = 1.0f / s; for (int l = 0; l < 4; ++l) { cum += v[l] * inv; lb[l * 1024 + c] = cum - v[0] * inv; } }
}
__device__ __forceinline__ void phase_ln(const float* XP, float* OUT, bf16_t* XB, float* ST, const float* g, const float* b) {
    const int tid = tid_(), wave = __builtin_amdgcn_readfirstlane(tid >> 6), lane = tid & 63, nb8 = nblk_() * 8;
    for (int row = bid_() * 8 + wave; row < TOK; row += nb8) {
        const float* xp = XP + (size_t)row * DM; pg8::f32x4 v[8]; float s = 0.f;
#pragma unroll
        for (int c = 0; c < 8; ++c) { v[c] = *(const pg8::f32x4*)(xp + c * 256 + lane * 4); s += (v[c][0] + v[c][1]) + (v[c][2] + v[c][3]); }
#pragma unroll
        for (int o = 32; o >= 1; o >>= 1) s += __shfl_xor(s, o);
        const float mean = s * (1.0f / DM); float q = 0.f;
#pragma unroll
        for (int c = 0; c < 8; ++c) { v[c] = v[c] - mean; q += (v[c][0] * v[c][0] + v[c][1] * v[c][1]) + (v[c][2] * v[c][2] + v[c][3] * v[c][3]); }
#pragma unroll
        for (int o = 32; o >= 1; o >>= 1) q += __shfl_xor(q, o);
        const float rstd = 1.0f / sqrtf(q * (1.0f / DM) + LN_EPS);
        if (lane == 0) { pg8::f32x2 s2; s2[0] = mean; s2[1] = rstd; *(pg8::f32x2*)(ST + 2 * (size_t)row) = s2; }
#pragma unroll
        for (int c = 0; c < 8; ++c) { const int col = c * 256 + lane * 4; const pg8::f32x4 gg = *(const pg8::f32x4*)(g + col), bb = *(const pg8::f32x4*)(b + col);
            const pg8::f32x4 y = v[c] * rstd * gg + bb; if (OUT) *(pg8::f32x4*)(OUT + (size_t)row * DM + col) = y;
            pg8::u32x2 w; w.x = pg8::cvt_pk_bf16(y[0], y[1]); w.y = pg8::cvt_pk_bf16(y[2], y[3]); *(pg8::u32x2*)(XB + (size_t)row * DM + col) = w; }
    }
}
__device__ __forceinline__ void phase_ikprep(KP P, int layer) {
    unsigned char* ws = as_global(P->ws); const float* ikw = (const float*)(ws + WS_IKW); bf16_t* ki = (bf16_t*)(ws + WS_KI); float* wi = (float*)(ws + WS_WI);
    const float* ci = (const float*)(ws + WS_COSI); const float* si = (const float*)(ws + WS_SINI);
    const int tid = tid_(), wave = __builtin_amdgcn_readfirstlane(tid >> 6), lane = tid & 63, nb8 = nblk_() * 8;
    const float g = as_global(P->ikn_g)[layer * 64 + lane], b = as_global(P->ikn_b)[layer * 64 + lane];
    for (int t = bid_() * 8 + wave; t < TOK; t += nb8) {
        const float x = ikw[(size_t)t * 128 + lane]; float s = x;
#pragma unroll
        for (int o = 32; o >= 1; o >>= 1) s += __shfl_xor(s, o);
        const float mean = s * (1.0f / 64.0f), xc = x - mean; float q = xc * xc;
#pragma unroll
        for (int o = 32; o >= 1; o >>= 1) q += __shfl_xor(q, o);
        const float y = xc * (1.0f / sqrtf(q * (1.0f / 64.0f) + LN_EPS)) * g + b;
        const float other = __shfl_xor(y, 32); const int j = lane & 31; const float c = ci[(size_t)t * 32 + j], sn = si[(size_t)t * 32 + j];
        const float r = (lane < 32) ? (y * c - other * sn) : (other * sn + y * c);
        ki[(size_t)t * 64 + lane] = f2bf(r);
        if (lane < 16) wi[(size_t)t * 16 + lane] = ikw[(size_t)t * 128 + 64 + lane] * IDX_SCALE;
    }
}
typedef short bf16x8_t __attribute__((ext_vector_type(8)));
typedef short bf16x4_t __attribute__((ext_vector_type(4)));
typedef float f32x16_t __attribute__((ext_vector_type(16)));
constexpr int CUM_LD = 132;
constexpr int OPK_LD = 136;
constexpr int OPS_LD = 72;

__device__ __forceinline__ void hgrn_scan_load(const float* LF, int tok0, int h, int tid, float (&v)[16]) {
    const int k = tid & 127, qd = tid >> 7;
#pragma unroll
    for (int i = 0; i < 16; ++i) v[i] = LF[(size_t)(tok0 + qd * 16 + i) * 1024 + h * 128 + k];
}
__device__ __forceinline__ void hgrn_scan_cum(float (&v)[16], LAS float* cum, LAS float* tot, int tid) {
    const int k = tid & 127, qd = tid >> 7;
    float run = 0.f;
#pragma unroll
    for (int i = 0; i < 16; ++i) { run += v[i]; v[i] = run; }
    tot[qd * 128 + k] = run;
    __syncthreads();
    float off = 0.f;
#pragma unroll
    for (int q = 0; q < 3; ++q) off += (q < qd) ? tot[q * 128 + k] : 0.f;
#pragma unroll
    for (int i = 0; i < 16; ++i) cum[(qd * 16 + i) * CUM_LD + k] = v[i] + off;
    __syncthreads();
}

struct H1Pre { float lf[16]; unsigned ka[8], va[8]; };
__device__ __forceinline__ void h1_load(const bf16_t* KA, const bf16_t* VA, const float* LF, int unit, int tid, H1Pre& p) {
    const int c = unit & 63, h = (unit >> 6) & 7, b = unit >> 9, tok0 = b * SEQ + c * 64;
    hgrn_scan_load(LF, tok0, h, tid, p.lf);
#pragma unroll
    for (int it = 0; it < 8; ++it) { const int idx = tid + 512 * it, k = idx & 127, s = 2 * (idx >> 7); const size_t g0 = (size_t)(tok0 + s) * 1024 + h * 128 + k;
        p.ka[it] = (unsigned)KA[g0] | ((unsigned)KA[g0 + 1024] << 16); p.va[it] = (unsigned)VA[g0] | ((unsigned)VA[g0 + 1024] << 16); }
}
__device__ __forceinline__ void phase_hgrn_h1(KP P, LAS unsigned char* lds) {
    unsigned char* ws = as_global(P->ws);
    const bf16_t* KA = (const bf16_t*)(ws + WS_KA); const bf16_t* VA = (const bf16_t*)(ws + WS_VA); const float* LF = (const float*)(ws + WS_LF);
    bf16_t* LT = (bf16_t*)(ws + WS_LT); float* DEC = (float*)(ws + WS_DEC);
    const int tid = tid_(), lane = tid & 63, wave = __builtin_amdgcn_readfirstlane(tid >> 6), r = lane & 31, hh = lane >> 5, G = nblk_();
    LAS float* cum = (LAS float*)lds; LAS float* tot = cum + 64 * CUM_LD;
    LAS bf16_t* kdT = (LAS bf16_t*)(tot + 512); LAS bf16_t* vT = kdT + 128 * OPS_LD;
    constexpr int NU = NBATCH * AH * 64;
    H1Pre pre; int unit = bid_();
    if (unit < NU) h1_load(KA, VA, LF, unit, tid, pre);
    for (; unit < NU; unit += G) {
        hgrn_scan_cum(pre.lf, cum, tot, tid);
#pragma unroll
        for (int it = 0; it < 8; ++it) { const int idx = tid + 512 * it, k = idx & 127, sp = idx >> 7, s = 2 * sp;
            const float last = cum[63 * CUM_LD + k];
            const float k0 = __uint_as_float(pre.ka[it] << 16) * __expf(last - cum[s * CUM_LD + k]), k1 = __uint_as_float(pre.ka[it] & 0xffff0000u) * __expf(last - cum[(s + 1) * CUM_LD + k]);
            *(LAS unsigned*)(kdT + k * OPS_LD + s) = pg8::cvt_pk_bf16(k0, k1);
            *(LAS unsigned*)(vT + k * OPS_LD + s) = pre.va[it]; }
        if (tid < 128) DEC[(size_t)unit * 128 + tid] = __expf(cum[63 * CUM_LD + tid]);
        if (unit + G < NU) h1_load(KA, VA, LF, unit + G, tid, pre);
        __syncthreads();
        const int mb = wave >> 1, nb0 = (wave & 1) * 2;
        f32x16_t acc[2];
#pragma unroll
        for (int n = 0; n < 2; ++n)
#pragma unroll
            for (int i = 0; i < 16; ++i) acc[n][i] = 0.f;
#pragma unroll
        for (int ks = 0; ks < 4; ++ks) { const bf16x8_t a = *(const LAS bf16x8_t*)(kdT + (32 * mb + r) * OPS_LD + 16 * ks + 8 * hh);
#pragma unroll
            for (int n = 0; n < 2; ++n) { const bf16x8_t bb = *(const LAS bf16x8_t*)(vT + (32 * (nb0 + n) + r) * OPS_LD + 16 * ks + 8 * hh);
                acc[n] = __builtin_amdgcn_mfma_f32_32x32x16_bf16(a, bb, acc[n], 0, 0, 0); } }
#pragma unroll
        for (int n = 0; n < 2; ++n) { bf16_t* dst = LT + (size_t)unit * 16384 + (size_t)(32 * (nb0 + n) + r) * 128 + 32 * mb + 4 * hh;
#pragma unroll
            for (int g = 0; g < 4; ++g) { pg8::u32x2 o; o.x = pg8::cvt_pk_bf16(acc[n][4 * g], acc[n][4 * g + 1]); o.y = pg8::cvt_pk_bf16(acc[n][4 * g + 2], acc[n][4 * g + 3]); *(pg8::u32x2*)(dst + 8 * g) = o; } }
        __syncthreads();
    }
}

__device__ __forceinline__ void phase_hgrn_h2(KP P) {
    unsigned char* ws = as_global(P->ws);
    const bf16_t* LT = (const bf16_t*)(ws + WS_LT); const float* DEC = (const float*)(ws + WS_DEC); bf16_t* PT = (bf16_t*)(ws + WS_PT);
    const int tid = tid_(), G = nblk_();
    for (int oct = bid_() * 512 + tid; oct < NBATCH * AH * 2048; oct += G * 512) {
        const int bh = oct >> 11, rem = oct & 2047, v = rem >> 4, k0 = (rem & 15) * 8;
        const size_t e0 = (size_t)bh * 64 * 16384 + (size_t)v * 128 + k0; const size_t d0 = (size_t)bh * 64 * 128 + k0;
        pg8::f32x4 S0 = {0.f, 0.f, 0.f, 0.f}, S1 = {0.f, 0.f, 0.f, 0.f};
        for (int c0 = 0; c0 < 64; c0 += 4) { pg8::u32x4 Lc[4]; pg8::f32x4 Da[4], Db[4];
#pragma unroll
            for (int j = 0; j < 4; ++j) { Lc[j] = *(const pg8::u32x4*)(LT + e0 + (size_t)(c0 + j) * 16384); Da[j] = *(const pg8::f32x4*)(DEC + d0 + (size_t)(c0 + j) * 128); Db[j] = *(const pg8::f32x4*)(DEC + d0 + (size_t)(c0 + j) * 128 + 4); }
#pragma unroll
            for (int j = 0; j < 4; ++j) { *(pg8::u32x4*)(PT + e0 + (size_t)(c0 + j) * 16384) = pg8::pack8(S0, S1);
                pg8::f32x4 l0, l1; pg8::unpack8(Lc[j], l0, l1); S0 = Da[j] * S0 + l0; S1 = Db[j] * S1 + l1; } }
    }
}

struct H3Pre { float lf[16]; unsigned qw[8], kw[8], vv[8]; bf16x8_t pt[8]; pg8::u32x2 ga[4]; };
__device__ __forceinline__ void h3_load(const bf16_t* QA, const bf16_t* KA, const bf16_t* VA, const bf16_t* GA, const float* LF, const bf16_t* PT, int unit, int tid, H3Pre& p) {
    const int c = unit & 63, h = (unit >> 6) & 7, b = unit >> 9, tok0 = b * SEQ + c * 64;
    const int lane = tid & 63, wave = __builtin_amdgcn_readfirstlane(tid >> 6), r = lane & 31, hh = lane >> 5, mb = wave >> 1, tb = wave & 1;
    hgrn_scan_load(LF, tok0, h, tid, p.lf);
#pragma unroll
    for (int it = 0; it < 8; ++it) { const int idx = tid + 512 * it, kp = (idx & 63) * 2, t = idx >> 6; const size_t g0 = (size_t)(tok0 + t) * 1024 + h * 128 + kp;
        p.qw[it] = *(const unsigned*)(QA + g0); p.kw[it] = *(const unsigned*)(KA + g0); }
#pragma unroll
    for (int it = 0; it < 8; ++it) { const int idx = tid + 512 * it, v = idx & 127, s = 2 * (idx >> 7); const size_t g0 = (size_t)(tok0 + s) * 1024 + h * 128 + v;
        p.vv[it] = (unsigned)VA[g0] | ((unsigned)VA[g0 + 1024] << 16); }
    const bf16_t* prow = PT + (size_t)unit * 16384 + (size_t)(32 * mb + r) * 128 + 8 * hh;
#pragma unroll
    for (int k8 = 0; k8 < 8; ++k8) p.pt[k8] = *(const bf16x8_t*)(prow + 16 * k8);
    const size_t orow = (size_t)(tok0 + 32 * tb + r) * 1024 + h * 128;
#pragma unroll
    for (int g = 0; g < 4; ++g) p.ga[g] = *(const pg8::u32x2*)(GA + orow + 32 * mb + 8 * g + 4 * hh);
}
__device__ __forceinline__ void phase_hgrn_h3(KP P, int layer, LAS unsigned char* lds) {
    unsigned char* ws = as_global(P->ws);
    const bf16_t* QA = (const bf16_t*)(ws + WS_QA); const bf16_t* KA = (const bf16_t*)(ws + WS_KA); const bf16_t* VA = (const bf16_t*)(ws + WS_VA); const bf16_t* GA = (const bf16_t*)(ws + WS_GA);
    const float* LF = (const float*)(ws + WS_LF); const bf16_t* PT = (const bf16_t*)(ws + WS_PT); bf16_t* YA = (bf16_t*)(ws + WS_YA);
    const float* ng = as_global(P->hnorm_g) + layer * 128;
    const int tid = tid_(), lane = tid & 63, wave = __builtin_amdgcn_readfirstlane(tid >> 6), r = lane & 31, hh = lane >> 5, G = nblk_();
    LAS float* cum = (LAS float*)lds; LAS float* tot = cum + 64 * CUM_LD; LAS float* ssq = tot + 512;
    LAS bf16_t* qd = (LAS bf16_t*)(ssq + 256); LAS bf16_t* qs = qd + 64 * OPK_LD; LAS bf16_t* ks = qs + 64 * OPK_LD; LAS bf16_t* vT = ks + 64 * OPK_LD;
    constexpr int NU = NBATCH * AH * 64;
    const int mb = wave >> 1, tb = wave & 1;
    H3Pre pre; int unit = bid_();
    if (unit < NU) h3_load(QA, KA, VA, GA, LF, PT, unit, tid, pre);
    for (; unit < NU; unit += G) {
        const int c = unit & 63, h = (unit >> 6) & 7, b = unit >> 9, tok0 = b * SEQ + c * 64;
#ifdef H3_DUP_SCAN
        { float tmp[16];
#pragma unroll
          for (int i = 0; i < 16; ++i) tmp[i] = pre.lf[i];
          hgrn_scan_cum(tmp, cum, tot, tid); }
#endif
        hgrn_scan_cum(pre.lf, cum, tot, tid);
#ifdef H3_DUP_BUILD
        for (int rep_b = 0; rep_b < 2; ++rep_b) {
#else
        {
#endif
#pragma unroll
        for (int it = 0; it < 8; ++it) { const int idx = tid + 512 * it, kp = (idx & 63) * 2, t = idx >> 6;
            const unsigned qw = pre.qw[it], kw = pre.kw[it];
            const float c0 = cum[t * CUM_LD + kp], c1 = cum[t * CUM_LD + kp + 1], r0 = cum[31 * CUM_LD + kp], r1 = cum[31 * CUM_LD + kp + 1];
            const float q0 = __uint_as_float(qw << 16), q1 = __uint_as_float(qw & 0xffff0000u), k0 = __uint_as_float(kw << 16), k1 = __uint_as_float(kw & 0xffff0000u);
            *(LAS unsigned*)(qd + t * OPK_LD + kp) = pg8::cvt_pk_bf16(q0 * __expf(c0), q1 * __expf(c1));
            *(LAS unsigned*)(qs + t * OPK_LD + kp) = pg8::cvt_pk_bf16(q0 * __expf(c0 - r0), q1 * __expf(c1 - r1));
            *(LAS unsigned*)(ks + t * OPK_LD + kp) = pg8::cvt_pk_bf16(k0 * __expf(r0 - c0), k1 * __expf(r1 - c1)); }
#pragma unroll
        for (int it = 0; it < 8; ++it) { const int idx = tid + 512 * it, v = idx & 127, s = 2 * (idx >> 7); *(LAS unsigned*)(vT + v * OPS_LD + s) = pre.vv[it]; }
        }
        bf16x8_t ptc[8]; pg8::u32x2 gac[4];
#pragma unroll
        for (int k8 = 0; k8 < 8; ++k8) ptc[k8] = pre.pt[k8];
#pragma unroll
        for (int g = 0; g < 4; ++g) gac[g] = pre.ga[g];
        if (unit + G < NU) h3_load(QA, KA, VA, GA, LF, PT, unit + G, tid, pre);
        __syncthreads();
        f32x16_t acc;
#ifdef H3_DUP_MMA
        for (int rep_m = 0; rep_m < 2; ++rep_m) {
#else
        {
#endif
#pragma unroll
        for (int i = 0; i < 16; ++i) acc[i] = 0.f;
#pragma unroll
        for (int k8 = 0; k8 < 8; ++k8) { const bf16x8_t bq = *(const LAS bf16x8_t*)(qd + (32 * tb + r) * OPK_LD + 16 * k8 + 8 * hh);
            acc = __builtin_amdgcn_mfma_f32_32x32x16_bf16(ptc[k8], bq, acc, 0, 0, 0); }
#pragma unroll
        for (int sb = 0; sb < 2; ++sb) if (sb <= tb) {
            f32x16_t sc;
#pragma unroll
            for (int i = 0; i < 16; ++i) sc[i] = 0.f;
#pragma unroll
            for (int k8 = 0; k8 < 8; ++k8) { const bf16x8_t a = *(const LAS bf16x8_t*)(ks + (32 * sb + r) * OPK_LD + 16 * k8 + 8 * hh); const bf16x8_t bq = *(const LAS bf16x8_t*)(qs + (32 * tb + r) * OPK_LD + 16 * k8 + 8 * hh);
                sc = __builtin_amdgcn_mfma_f32_32x32x16_bf16(a, bq, sc, 0, 0, 0); }
            if (sb == tb) {
#pragma unroll
                for (int i = 0; i < 16; ++i) { const int sl = 8 * (i >> 2) + 4 * hh + (i & 3); sc[i] = (sl <= r) ? sc[i] : 0.f; } }
#pragma unroll
            for (int u = 0; u < 2; ++u) {
                pg8::u32x4 pw; pw.x = pg8::cvt_pk_bf16(sc[8 * u], sc[8 * u + 1]); pw.y = pg8::cvt_pk_bf16(sc[8 * u + 2], sc[8 * u + 3]); pw.z = pg8::cvt_pk_bf16(sc[8 * u + 4], sc[8 * u + 5]); pw.w = pg8::cvt_pk_bf16(sc[8 * u + 6], sc[8 * u + 7]);
                const bf16x8_t pb = __builtin_bit_cast(bf16x8_t, pw);
                const LAS bf16_t* vrow = vT + (32 * mb + r) * OPS_LD + 32 * sb + 16 * u + 4 * hh;
                const bf16x4_t lo = *(const LAS bf16x4_t*)vrow, hi4 = *(const LAS bf16x4_t*)(vrow + 8);
                const bf16x8_t va = {lo[0], lo[1], lo[2], lo[3], hi4[0], hi4[1], hi4[2], hi4[3]};
                acc = __builtin_amdgcn_mfma_f32_32x32x16_bf16(va, pb, acc, 0, 0, 0); }
        }
        }
        float ss = 0.f;
#pragma unroll
        for (int i = 0; i < 16; ++i) ss += acc[i] * acc[i];
        ss += __shfl_xor(ss, 32);
        if (hh == 0) ssq[mb * 64 + 32 * tb + r] = ss;
        __syncthreads();
        const int t = 32 * tb + r;
        const float tot2 = (ssq[t] + ssq[64 + t]) + (ssq[128 + t] + ssq[192 + t]);
        const float rs = 1.0f / sqrtf(tot2 * (1.0f / 128.0f) + RMS_EPS);
        const size_t orow = (size_t)(tok0 + t) * 1024 + h * 128;
#pragma unroll
        for (int g = 0; g < 4; ++g) { const int v0 = 32 * mb + 8 * g + 4 * hh;
            const pg8::u32x2 gw = gac[g]; const pg8::f32x4 nv = *(const pg8::f32x4*)(ng + v0);
            const float y0 = acc[4 * g] * rs * nv[0] * __uint_as_float(gw.x << 16), y1 = acc[4 * g + 1] * rs * nv[1] * __uint_as_float(gw.x & 0xffff0000u);
            const float y2 = acc[4 * g + 2] * rs * nv[2] * __uint_as_float(gw.y << 16), y3 = acc[4 * g + 3] * rs * nv[3] * __uint_as_float(gw.y & 0xffff0000u);
            pg8::u32x2 w; w.x = pg8::cvt_pk_bf16(y0, y1); w.y = pg8::cvt_pk_bf16(y2, y3); *(pg8::u32x2*)(YA + orow + v0) = w; }
        __syncthreads();
    }
}
namespace at {
constexpr int D = 128, NW = 8, QBLK = 32, KVBLK = 64, LDQ = 1024, LDK = 1024;
constexpr float SCALE = ATTN_SCALE, THR = 8.f;
constexpr size_t SHM_V = KVBLK * D * 2, SHM_K = KVBLK * D * 2, SHM_ATTN = 2 * SHM_V + 2 * SHM_K + NW * 64 * 4;
using bf16x8 = __attribute__((ext_vector_type(8))) short;
using s16x4  = __attribute__((ext_vector_type(4))) short;
using f32x16 = __attribute__((ext_vector_type(16))) float;
using u32x4  = __attribute__((ext_vector_type(4))) unsigned;
#define AT_KSWZ(row, colB) ((row) * 256 + ((colB) ^ (((row) & 7) << 4)))
#define AT_SBAR() __builtin_amdgcn_sched_barrier(0)
__device__ __forceinline__ int crow(int r, int hi) { return (r & 3) + 8 * (r >> 2) + 4 * hi; }
__device__ __forceinline__ unsigned cvtpk(float lo, float hi) { return pg8::cvt_pk_bf16(lo, hi); }

__device__ __forceinline__ void partialSM(f32x16& p0, f32x16& p1, float& m_reg, float& mn, float& alpha) {
  constexpr float C = SCALE * 1.4426950408889634f;
  float pmax = p0[0];
#pragma unroll
  for (int r = 1; r < 16; ++r) pmax = fmaxf(pmax, p0[r]);
#pragma unroll
  for (int r = 0; r < 16; ++r) pmax = fmaxf(pmax, p1[r]);
  { auto rr = __builtin_amdgcn_permlane32_swap(__float_as_uint(pmax), __float_as_uint(pmax), false, false);
    pmax = fmaxf(__uint_as_float(rr[0]), __uint_as_float(rr[1])); }
  if (__builtin_expect(__all(pmax - m_reg <= THR / SCALE), 1)) { mn = m_reg; alpha = 1.f; }
  else { mn = fmaxf(m_reg, pmax); alpha = __builtin_amdgcn_exp2f((m_reg - mn) * C); m_reg = mn; }
  float mnC = -mn * C;
#pragma unroll
  for (int r = 0; r < 16; ++r) p0[r] = fmaf(p0[r], C, mnC);
#pragma unroll
  for (int r = 0; r < 16; ++r) p1[r] = fmaf(p1[r], C, mnC);
#pragma unroll
  for (int r = 0; r < 16; ++r) p0[r] = __builtin_amdgcn_exp2f(p0[r]);
}
__device__ __forceinline__ void finishSM(f32x16& p0, f32x16& p1, float alpha, float& l_reg, int mlo, int mhi, bf16x8& pa0, bf16x8& pa1, bf16x8& pa2, bf16x8& pa3) {
#pragma unroll
  for (int r = 0; r < 16; ++r) p1[r] = __builtin_amdgcn_exp2f(p1[r]);
#pragma unroll
  for (int r = 0; r < 16; ++r) { const int bit = (r & 3) + 8 * (r >> 2);
    p0[r] = __uint_as_float(__float_as_uint(p0[r]) & (unsigned)__builtin_amdgcn_sbfe(mlo, bit, 1));
    p1[r] = __uint_as_float(__float_as_uint(p1[r]) & (unsigned)__builtin_amdgcn_sbfe(mhi, bit, 1)); }
  float ps = 0;
#pragma unroll
  for (int r = 0; r < 16; ++r) ps += p0[r];
#pragma unroll
  for (int r = 0; r < 16; ++r) ps += p1[r];
  { auto rr = __builtin_amdgcn_permlane32_swap(__float_as_uint(ps), __float_as_uint(ps), false, false);
    ps = __uint_as_float(rr[0]) + __uint_as_float(rr[1]); }
  l_reg = l_reg * alpha + ps;
#define AT_PK4(P, BASE, OUT) do { unsigned a0 = cvtpk(P[BASE + 0], P[BASE + 1]), a1 = cvtpk(P[BASE + 2], P[BASE + 3]);   \
    unsigned b0 = cvtpk(P[BASE + 4], P[BASE + 5]), b1 = cvtpk(P[BASE + 6], P[BASE + 7]);                              \
    auto r0 = __builtin_amdgcn_permlane32_swap(a0, b0, false, false); auto r1 = __builtin_amdgcn_permlane32_swap(a1, b1, false, false); \
    u32x4 w = {r0[0], r1[0], r0[1], r1[1]}; OUT = *reinterpret_cast<bf16x8*>(&w); } while (0)
  AT_PK4(p0, 0, pa0); AT_PK4(p0, 8, pa1); AT_PK4(p1, 0, pa2); AT_PK4(p1, 8, pa3);
#undef AT_PK4
}
__device__ __forceinline__ void qkt(f32x16& p0, f32x16& p1, const LAS char* Ks, const bf16x8* qr, int r32, int hi) {
  p0 = f32x16{}; p1 = f32x16{};
#pragma unroll
  for (int d0 = 0; d0 < 8; ++d0) { int cb = (d0 * 16 + hi * 8) * 2;
    bf16x8 b0 = *reinterpret_cast<const LAS bf16x8*>(Ks + AT_KSWZ(r32, cb));
    bf16x8 b1 = *reinterpret_cast<const LAS bf16x8*>(Ks + AT_KSWZ(32 + r32, cb));
    p0 = __builtin_amdgcn_mfma_f32_32x32x16_bf16(b0, qr[d0], p0, 0, 0, 0);
    p1 = __builtin_amdgcn_mfma_f32_32x32x16_bf16(b1, qr[d0], p1, 0, 0, 0); }
}
__device__ __forceinline__ int v_st(int k, int c) { const int kk = (k & ~0xC) | ((k & 4) << 1) | ((k & 8) >> 1); return ((kk >> 3) * 4 + (c >> 5)) * 512 + ((kk & 7) * 32 + (c & 31)) * 2; }
__device__ __forceinline__ int v_rd_base(int lane) { return ((lane & 3) << 3) | (((lane >> 2) & 3) << 6) | (((lane >> 4) & 1) << 5) | (((lane >> 5) & 1) << 8); }
constexpr int v_rd_off(int d0, int ks, int half) { return d0 * 512 + ks * 4096 + half * 2048; }
template <int OFF> __device__ __forceinline__ s16x4 tr_read(int vb) {
  s16x4 r; asm volatile("ds_read_b64_tr_b16 %0, %1 offset:%2" : "=&v"(r) : "v"(vb), "i"(OFF) : "memory"); return r;
}
template <int D0> __device__ __forceinline__ void pv_one(f32x16& od, int vb, bf16x8 pa0, bf16x8 pa1, bf16x8 pa2, bf16x8 pa3) {
  const s16x4 l0 = tr_read<v_rd_off(D0, 0, 0)>(vb), h0 = tr_read<v_rd_off(D0, 0, 1)>(vb), l1 = tr_read<v_rd_off(D0, 1, 0)>(vb), h1 = tr_read<v_rd_off(D0, 1, 1)>(vb);
  const s16x4 l2 = tr_read<v_rd_off(D0, 2, 0)>(vb), h2 = tr_read<v_rd_off(D0, 2, 1)>(vb), l3 = tr_read<v_rd_off(D0, 3, 0)>(vb), h3 = tr_read<v_rd_off(D0, 3, 1)>(vb);
  asm volatile("s_waitcnt lgkmcnt(0)" ::: "memory"); AT_SBAR();
#define AT_PK(L_, H_) (bf16x8){L_[0], L_[1], L_[2], L_[3], H_[0], H_[1], H_[2], H_[3]}
  od = __builtin_amdgcn_mfma_f32_32x32x16_bf16(pa0, AT_PK(l0, h0), od, 0, 0, 0);
  od = __builtin_amdgcn_mfma_f32_32x32x16_bf16(pa1, AT_PK(l1, h1), od, 0, 0, 0);
  od = __builtin_amdgcn_mfma_f32_32x32x16_bf16(pa2, AT_PK(l2, h2), od, 0, 0, 0);
  od = __builtin_amdgcn_mfma_f32_32x32x16_bf16(pa3, AT_PK(l3, h3), od, 0, 0, 0);
#undef AT_PK
}
__device__ __forceinline__ void pv_d0(f32x16* o, int vb, bf16x8 pa0, bf16x8 pa1, bf16x8 pa2, bf16x8 pa3) {
  pv_one<0>(o[0], vb, pa0, pa1, pa2, pa3); pv_one<1>(o[1], vb, pa0, pa1, pa2, pa3); pv_one<2>(o[2], vb, pa0, pa1, pa2, pa3); pv_one<3>(o[3], vb, pa0, pa1, pa2, pa3);
}

__device__ __forceinline__ void attn_masked_body(const bf16_t* __restrict__ Qb, const bf16_t* __restrict__ Kh, const bf16_t* __restrict__ Vh, const unsigned long long* __restrict__ Mq,
                                                 bf16_t* __restrict__ Ob, int seq, LAS char* lds, int tid) {
  const int wid = __builtin_amdgcn_readfirstlane(tid >> 6), lane = tid & 63, r32 = lane & 31, hi = lane >> 5;
  LAS char* V_lds = lds; LAS char* K_lds = lds + 2 * SHM_V;
  LAS float* wsf = (LAS float*)(lds + 2 * SHM_V + 2 * SHM_K) + wid * 64; LAS float* li_l = wsf; LAS float* al_l = wsf + 32;
  float m_reg = -1e30f, l_reg = 0; f32x16 o[4] = {}; bf16x8 qr[8];
  const bf16_t* Qw = Qb + (long)(wid * QBLK + r32) * LDQ + hi * 8;
#pragma unroll
  for (int d0 = 0; d0 < 8; ++d0) qr[d0] = *reinterpret_cast<const bf16x8*>(Qw + d0 * 16);
  const unsigned long long* mrow = Mq + (size_t)(wid * QBLK + r32) * 64;
  const int sr = tid >> 4, sc = (tid & 15) * 8, vst0 = v_st(sr, sc), vst1 = v_st(32 + sr, sc);
  const int vb0 = (int)(uintptr_t)V_lds + v_rd_base(lane);
  struct { bf16x8 vs0, vs1, ks0, ks1; } sr_[2];
#define AT_SLOAD(i, k0) do { sr_[i].vs0 = *reinterpret_cast<const bf16x8*>(&Vh[(long)((k0) + sr) * LDK + sc]); sr_[i].vs1 = *reinterpret_cast<const bf16x8*>(&Vh[(long)((k0) + 32 + sr) * LDK + sc]); \
    sr_[i].ks0 = *reinterpret_cast<const bf16x8*>(&Kh[(long)((k0) + sr) * LDK + sc]); sr_[i].ks1 = *reinterpret_cast<const bf16x8*>(&Kh[(long)((k0) + 32 + sr) * LDK + sc]); } while (0)
#define AT_SWRITE(b, i) do { *(LAS bf16x8*)(V_lds + (b) * SHM_V + vst0) = sr_[i].vs0;          \
    *(LAS bf16x8*)(V_lds + (b) * SHM_V + vst1) = sr_[i].vs1; int kc = sc * 2;               \
    *(LAS bf16x8*)(K_lds + (b) * SHM_K + AT_KSWZ(sr, kc)) = sr_[i].ks0;                       \
    *(LAS bf16x8*)(K_lds + (b) * SHM_K + AT_KSWZ(32 + sr, kc)) = sr_[i].ks1; } while (0)
#define AT_SWAIT() asm volatile("s_waitcnt vmcnt(4)" ::: "memory")
#define AT_RESC(a) do { if (__any((a) < 1.f)) { if (hi == 0) al_l[r32] = (a); asm volatile("s_waitcnt lgkmcnt(0)" ::: "memory"); \
    _Pragma("unroll") for (int d = 0; d < 4; ++d) _Pragma("unroll") for (int r = 0; r < 16; ++r) o[d][r] *= al_l[crow(r, hi)]; } } while (0)
#define AT_MLOAD(mw, j) do { const unsigned long long _w = mrow[(j)]; (mw##lo) = (int)((unsigned)_w >> (4 * hi)); (mw##hi) = (int)((unsigned)(_w >> 32) >> (4 * hi)); } while (0)
  f32x16 pA0, pA1, pB0, pB1; float mnA, mnB, alA, alB; bf16x8 pa0, pa1, pa2, pa3; const int NT = seq / KVBLK;
  int mAlo, mAhi, mBlo, mBhi;
  constexpr int SE = 0, SO = 1;
  AT_SLOAD(SE, 0); AT_MLOAD(mA, 0); asm volatile("s_waitcnt vmcnt(0)" ::: "memory"); AT_SWRITE(0, SE); __syncthreads();
  qkt(pA0, pA1, K_lds, qr, r32, hi); partialSM(pA0, pA1, m_reg, mnA, alA);
  AT_SLOAD(SO, KVBLK); if (2 < NT) AT_SLOAD(SE, 2 * KVBLK);
  AT_SWAIT(); AT_SWRITE(1, SO); __syncthreads();
  for (int j = 1; j + 1 < NT; j += 2) {
    AT_SBAR(); AT_MLOAD(mB, j); qkt(pB0, pB1, K_lds + SHM_K, qr, r32, hi);
    finishSM(pA0, pA1, alA, l_reg, mAlo, mAhi, pa0, pa1, pa2, pa3); AT_SBAR();
    AT_SLOAD(SO, (j + 2) * KVBLK); AT_SBAR();
    pv_d0(o, vb0, pa0, pa1, pa2, pa3); partialSM(pB0, pB1, m_reg, mnB, alB);
    __syncthreads(); AT_SWAIT(); AT_SWRITE(0, SE);
    AT_RESC(alB); __syncthreads();
    AT_SBAR(); AT_MLOAD(mA, j + 1); qkt(pA0, pA1, K_lds, qr, r32, hi);
    finishSM(pB0, pB1, alB, l_reg, mBlo, mBhi, pa0, pa1, pa2, pa3); AT_SBAR();
    if (j + 3 < NT) AT_SLOAD(SE, (j + 3) * KVBLK); AT_SBAR();
    pv_d0(o, vb0 + (int)SHM_V, pa0, pa1, pa2, pa3); partialSM(pA0, pA1, m_reg, mnA, alA);
    __syncthreads(); AT_SWAIT(); AT_SWRITE(1, SO);
    AT_RESC(alA); __syncthreads();
  }
  AT_SBAR(); AT_MLOAD(mB, NT - 1); qkt(pB0, pB1, K_lds + SHM_K, qr, r32, hi);
  finishSM(pA0, pA1, alA, l_reg, mAlo, mAhi, pa0, pa1, pa2, pa3); AT_SBAR();
  pv_d0(o, vb0, pa0, pa1, pa2, pa3); partialSM(pB0, pB1, m_reg, mnB, alB);
  __syncthreads(); AT_RESC(alB);
  finishSM(pB0, pB1, alB, l_reg, mBlo, mBhi, pa0, pa1, pa2, pa3); AT_SBAR();
  pv_d0(o, vb0 + (int)SHM_V, pa0, pa1, pa2, pa3);
  if (hi == 0) li_l[r32] = l_reg; asm volatile("s_waitcnt lgkmcnt(0)" ::: "memory");
  float rli[16];
#pragma unroll
  for (int r = 0; r < 16; ++r) rli[r] = __builtin_amdgcn_rcpf(li_l[crow(r, hi)]);
  bf16_t* Ow = Ob + (long)(wid * QBLK) * LDQ;
#pragma unroll
  for (int r = 0; r < 16; ++r) { const int orow = crow(r, hi);
#pragma unroll
    for (int d0 = 0; d0 < 4; ++d0) Ow[(long)orow * LDQ + d0 * 32 + r32] = f2bf(o[d0][r] * rli[r]); }
#undef AT_SLOAD
#undef AT_SWRITE
#undef AT_SWAIT
#undef AT_RESC
#undef AT_MLOAD
}
}

__device__ __forceinline__ void phase_attn(KP P, LAS unsigned char* lds) {
    unsigned char* ws = as_global(P->ws);
    const bf16_t* QB = (const bf16_t*)(ws + WS_QB); const bf16_t* KB = (const bf16_t*)(ws + WS_KB); const bf16_t* VB = (const bf16_t*)(ws + WS_VB);
    const unsigned long long* MASK = (const unsigned long long*)(ws + WS_MASK); bf16_t* YB = (bf16_t*)(ws + WS_YB);
    const int G = nblk_();
    for (int p = bid_(); p < 256; p += G) {
        const int bh = p >> 3, b = bh >> 3, h = bh & 7, x = p & 7;
#pragma unroll 1
        for (int half = 0; half < 2; ++half) { const int qb = half ? 15 - x : x; const size_t row0 = (size_t)b * SEQ + (size_t)qb * 256;
            at::attn_masked_body(QB + row0 * 1024 + h * 128, KB + (size_t)b * SEQ * 1024 + h * 128, VB + (size_t)b * SEQ * 1024 + h * 128, MASK + row0 * 64,
                                 YB + row0 * 1024 + h * 128, 256 * (qb + 1), (LAS char*)lds, tid_());
            __syncthreads(); }
    }
}
__device__ __forceinline__ const float* sel_row(const float* S, int q, int& nw) {
    const int b = q >> 12, s = q & 4095, c = s >> 6; nw = c + 1;
    return S + (size_t)b * SCORE_B + (size_t)2048 * c * (c + 1) + (size_t)(s & 63) * (nw * 64);
}
__device__ __forceinline__ void sel_load(const float* row, int nw, int lane, float (&f)[64]) {
    if (nw > 32) {
#pragma unroll
        for (int j = 0; j < 64; ++j) { const int jc = j < nw ? j : nw - 1; f[j] = row[jc * 64 + lane]; }
    } else {
#pragma unroll
        for (int j = 0; j < 32; ++j) { const int jc = j < nw ? j : nw - 1; f[j] = row[jc * 64 + lane]; }
#pragma unroll
        for (int j = 32; j < 64; ++j) f[j] = 0.f;
    }
}
__device__ __forceinline__ void phase_select(KP P, LAS unsigned char* lds) {
    unsigned char* ws = as_global(P->ws); const float* S = (const float*)(ws + WS_S); unsigned long long* MASK = (unsigned long long*)(ws + WS_MASK);
    const int tid = tid_(), wave = __builtin_amdgcn_readfirstlane(tid >> 6), lane = tid & 63, nb8 = nblk_() * 8;
    LAS unsigned long long* sm = (LAS unsigned long long*)lds + wave * 64;
    float f[64]; int it = (bid_() * 8 + wave) * 8, nw = 0; const float* row = nullptr;
    const int itstep = nb8 * 8 - 7;
#define SEL_Q(it_) ((((it_) >> 3) & 3) * 4096 + ((it_) >> 5) + 512 * ((it_) & 7))
    int q = it < TOK ? SEL_Q(it) : TOK;
    if (q < TOK) { row = sel_row(S, q, nw); if (nw > TOPK / 64) sel_load(row, nw, lane, f); }
    while (q < TOK) {
        unsigned long long myword = 0ull;
        const int itn = ((it & 7) == 7) ? it + itstep : it + 1; const int qn = itn < TOK ? SEL_Q(itn) : TOK; int nwn = 0; const float* rown = nullptr;
        if (nw <= TOPK / 64) {
            myword = (lane < nw) ? ~0ull : 0ull;
            if (qn < TOK) { rown = sel_row(S, qn, nwn); if (nwn > TOPK / 64) sel_load(rown, nwn, lane, f); }
        } else {
            unsigned u[64];
#pragma unroll
            for (int j = 0; j < 64; ++j) { const unsigned bits = __float_as_uint(f[j]); const unsigned v = (bits & 0x80000000u) ? ~bits : (bits | 0x80000000u); u[j] = (j < nw) ? v : 0u; }
            if (qn < TOK) { rown = sel_row(S, qn, nwn); if (nwn > TOPK / 64) sel_load(rown, nwn, lane, f); }
            unsigned prefix = 0u;
            for (int bit = 31; bit >= 0; --bit) { const unsigned cand = prefix | (1u << bit); int cnt = 0;
#pragma unroll
                for (int j8 = 0; j8 < 8; ++j8) if (j8 * 8 < nw) { unsigned long long bl[8];
#pragma unroll
                    for (int jj = 0; jj < 8; ++jj) bl[jj] = __ballot(u[j8 * 8 + jj] >= cand);
                    asm volatile("" : "+s"(bl[0]), "+s"(bl[1]), "+s"(bl[2]), "+s"(bl[3]), "+s"(bl[4]), "+s"(bl[5]), "+s"(bl[6]), "+s"(bl[7]));
#pragma unroll
                    for (int jj = 0; jj < 8; ++jj) cnt += __popcll(bl[jj]); }
                if (cnt >= TOPK) prefix = cand; }
#pragma unroll
            for (int j = 0; j < 64; ++j) { const unsigned long long w = __ballot(u[j] >= prefix); if (lane == 0) sm[j] = w; }
            myword = sm[lane];
        }
        MASK[(size_t)q * 64 + lane] = myword;
        q = qn; it = itn; nw = nwn; row = rown;
    }
#undef SEL_Q
}

__device__ __forceinline__ void phase_hgrn_naive(KP P, int layer, LAS unsigned char* lds) {
    unsigned char* ws = as_global(P->ws);
    const bf16_t* QA = (const bf16_t*)(ws + WS_QA); const bf16_t* KA = (const bf16_t*)(ws + WS_KA); const bf16_t* VA = (const bf16_t*)(ws + WS_VA); const bf16_t* GA = (const bf16_t*)(ws + WS_GA);
    const float* LF = (const float*)(ws + WS_LF); bf16_t* YA = (bf16_t*)(ws + WS_YA);
    const int tid = tid_(), bh = bid_(), b = bh >> 3, h = bh & 7, v = tid & 127; const bool act = (bh < 32) && (tid < 128);
    if (bh >= 32) return;
    LAS float* sf = (LAS float*)lds; LAS float* sk = sf + 16 * 128; LAS float* sq = sk + 16 * 128; LAS float* red = sq + 16 * 128;
    float S[128];
#pragma unroll
    for (int k = 0; k < 128; ++k) S[k] = 0.f;
    const float ng = as_global(P->hnorm_g)[layer * 128 + v];
    for (int t0 = 0; t0 < SEQ; t0 += 16) {
        if (act) for (int i = 0; i < 16; ++i) { const size_t idx = ((size_t)(b * SEQ + t0 + i)) * 1024 + h * 128 + v; sf[i * 128 + v] = expf(LF[idx]); sk[i * 128 + v] = bf2f(KA[idx]); sq[i * 128 + v] = bf2f(QA[idx]); }
        __syncthreads();
        for (int i = 0; i < 16; ++i) { const size_t idx = ((size_t)(b * SEQ + t0 + i)) * 1024 + h * 128 + v; float o = 0.f;
            if (act) { const float vt = bf2f(VA[idx]);
#pragma unroll
                for (int k = 0; k < 128; ++k) { S[k] = sf[i * 128 + k] * S[k] + sk[i * 128 + k] * vt; o += S[k] * sq[i * 128 + k]; } }
            float ss = o * o;
#pragma unroll
            for (int m = 32; m >= 1; m >>= 1) ss += __shfl_xor(ss, m);
            if (act && (v & 63) == 0) red[v >> 6] = ss;
            __syncthreads();
            if (act) { const float tot = red[0] + red[1]; YA[idx] = f2bf(o * (1.0f / sqrtf(tot * (1.0f / 128.0f) + RMS_EPS)) * ng * bf2f(GA[idx])); }
            __syncthreads(); }
    }
}
__device__ __forceinline__ void phase_idx_naive(KP P, LAS unsigned char* lds) {
    unsigned char* ws = as_global(P->ws);
    const bf16_t* QI = (const bf16_t*)(ws + WS_QI); const bf16_t* KI = (const bf16_t*)(ws + WS_KI); const float* WI = (const float*)(ws + WS_WI); float* Sc = (float*)(ws + WS_S);
    const int tid = tid_(), G = nblk_();
    LAS float* qs = (LAS float*)lds; LAS float* wsh = qs + 1024;
    for (int q = bid_(); q < TOK; q += G) {
        const int b = q >> 12, s = q & 4095, c = s >> 6, nw = c + 1, nk = nw * 64;
        if (nw <= TOPK / 64) continue;
        __syncthreads();
        for (int i = tid; i < 1024; i += 512) qs[i] = bf2f(QI[(size_t)q * 1024 + i]);
        if (tid < 16) wsh[tid] = WI[(size_t)q * 16 + tid];
        __syncthreads();
        float* row = Sc + (size_t)b * SCORE_B + (size_t)2048 * c * (c + 1) + (size_t)(s & 63) * nk;
        for (int key = tid; key < nk; key += 512) {
            float kf[64]; const pg8::u32x4* kp = (const pg8::u32x4*)(KI + ((size_t)b * SEQ + key) * 64);
#pragma unroll
            for (int d8 = 0; d8 < 8; ++d8) { const pg8::u32x4 w = kp[d8]; pg8::f32x4 a, bb; pg8::unpack8(w, a, bb);
#pragma unroll
                for (int j = 0; j < 4; ++j) { kf[d8 * 8 + j] = a[j]; kf[d8 * 8 + 4 + j] = bb[j]; } }
            float sc = 0.f;
            for (int h = 0; h < 16; ++h) { float dot = 0.f;
#pragma unroll
                for (int d = 0; d < 64; ++d) dot += qs[h * 64 + d] * kf[d];
                sc += wsh[h] * fmaxf(dot, 0.f); }
            row[key] = sc;
        }
    }
}
__device__ __forceinline__ void phase_attn_naive(KP P, LAS unsigned char* lds) {
    unsigned char* ws = as_global(P->ws);
    const bf16_t* QB = (const bf16_t*)(ws + WS_QB); const bf16_t* KB = (const bf16_t*)(ws + WS_KB); const bf16_t* VB = (const bf16_t*)(ws + WS_VB);
    const unsigned long long* MASK = (const unsigned long long*)(ws + WS_MASK); bf16_t* YB = (bf16_t*)(ws + WS_YB);
    const int tid = tid_(), h = tid >> 6, lane = tid & 63, G = nblk_();
    LAS float* qs = (LAS float*)lds + h * 128; LAS int* keys = (LAS int*)((LAS float*)lds + 1024) + h * 320; LAS float* lg = (LAS float*)lds + 1024 + 8 * 320 + h * 320;
    for (int q = bid_(); q < TOK; q += G) {
        const int b = q >> 12, s = q & 4095, nw = (s >> 6) + 1;
        qs[lane] = bf2f(QB[(size_t)q * 1024 + h * 128 + lane]); qs[lane + 64] = bf2f(QB[(size_t)q * 1024 + h * 128 + 64 + lane]);
        int cnt = 0;
        for (int j = 0; j < nw; ++j) { const unsigned long long w = MASK[(size_t)q * 64 + j]; const bool on = (w >> lane) & 1ull; const int key = j * 64 + lane;
            if (on) { const pg8::u32x4* kp = (const pg8::u32x4*)(KB + ((size_t)b * SEQ + key) * 1024 + h * 128); float dot = 0.f;
                for (int d8 = 0; d8 < 16; ++d8) { pg8::f32x4 a, bb; pg8::unpack8(kp[d8], a, bb);
#pragma unroll
                    for (int j2 = 0; j2 < 4; ++j2) dot += qs[d8 * 8 + j2] * a[j2] + qs[d8 * 8 + 4 + j2] * bb[j2]; }
                const int pos = cnt + __popcll(w & ((1ull << lane) - 1ull));
                if (pos < 320) { keys[pos] = key; lg[pos] = dot * ATTN_SCALE; } }
            cnt += __popcll(w); }
        if (cnt > 320) cnt = 320;
        float mx = -1e30f; for (int e = lane; e < cnt; e += 64) mx = fmaxf(mx, lg[e]);
#pragma unroll
        for (int m = 32; m >= 1; m >>= 1) mx = fmaxf(mx, __shfl_xor(mx, m));
        float sum = 0.f; for (int e = lane; e < cnt; e += 64) { const float pe = expf(lg[e] - mx); lg[e] = pe; sum += pe; }
#pragma unroll
        for (int m = 32; m >= 1; m >>= 1) sum += __shfl_xor(sum, m);
        float a0 = 0.f, a1 = 0.f;
        for (int e = 0; e < cnt; ++e) { const float pe = lg[e]; const bf16_t* vp = VB + ((size_t)b * SEQ + keys[e]) * 1024 + h * 128 + 2 * lane; a0 += pe * bf2f(vp[0]); a1 += pe * bf2f(vp[1]); }
        const float inv = 1.0f / sum;
        *(unsigned*)(YB + (size_t)q * 1024 + h * 128 + 2 * lane) = pg8::cvt_pk_bf16(a0 * inv, a1 * inv);
    }
}

constexpr int IXK = 512, IX_LD = 144;
__device__ __forceinline__ void idx_unit(const bf16_t* QI, const bf16_t* KI, const float* WI, float* Sc, int b, int c, int half, int tid, LAS unsigned char* lds) {
    const int lane = tid & 63, wave = __builtin_amdgcn_readfirstlane(tid >> 6), r = lane & 31, hh = lane >> 5, nk = 64 * (c + 1);
    const int s0 = c * 64 + half * 32 + wave * 4;
    const int aq = (r >> 2) & 1, ahead = (r & 3) + 4 * (r >> 3);
    bf16x8_t A[2][4]; float wv[2][16];
#pragma unroll
    for (int rt = 0; rt < 2; ++rt) { const size_t qrow = (size_t)b * SEQ + s0 + 2 * rt + aq;
#pragma unroll
        for (int ks = 0; ks < 4; ++ks) A[rt][ks] = *(const bf16x8_t*)(QI + qrow * 1024 + ahead * 64 + 16 * ks + 8 * hh);
        const float* wp = WI + ((size_t)b * SEQ + s0 + 2 * rt + hh) * 16;
#pragma unroll
        for (int i4 = 0; i4 < 4; ++i4) { const pg8::f32x4 w4 = *(const pg8::f32x4*)(wp + 4 * i4); wv[rt][4 * i4] = w4[0]; wv[rt][4 * i4 + 1] = w4[1]; wv[rt][4 * i4 + 2] = w4[2]; wv[rt][4 * i4 + 3] = w4[3]; } }
    float* srow[2];
#pragma unroll
    for (int rt = 0; rt < 2; ++rt) srow[rt] = Sc + (size_t)b * SCORE_B + (size_t)2048 * c * (c + 1) + (size_t)((s0 + 2 * rt + hh) & 63) * nk + r;
    const bf16_t* kbase = KI + (size_t)b * SEQ * 64;
    const int nblk = (nk + IXK - 1) / IXK;
    pg8::u32x4 stg[8];
#define IX_LOAD(kb) do { _Pragma("unroll") for (int i = 0; i < 8; ++i) { const int p = tid + 512 * i; int key = (kb) * IXK + (p >> 3); key = key < nk ? key : nk - 1; \
        stg[i] = *(const pg8::u32x4*)(kbase + (size_t)key * 64 + (p & 7) * 8); } } while (0)
#define IX_STORE() do { _Pragma("unroll") for (int i = 0; i < 8; ++i) { const int p = tid + 512 * i; *(LAS pg8::u32x4*)(lds + (p >> 3) * IX_LD + (p & 7) * 16) = stg[i]; } } while (0)
    IX_LOAD(0);
    for (int kb = 0; kb < nblk; ++kb) {
        __syncthreads();
        IX_STORE();
        __syncthreads();
        if (kb + 1 < nblk) IX_LOAD(kb + 1);
        const int ntile = (nk - kb * IXK < IXK ? nk - kb * IXK : IXK) / 32;
        for (int t = 0; t < ntile; ++t) { bf16x8_t Bc[4];
#pragma unroll
            for (int ks = 0; ks < 4; ++ks) Bc[ks] = *(const LAS bf16x8_t*)(lds + (32 * t + r) * IX_LD + (16 * ks + 8 * hh) * 2);
#pragma unroll
            for (int rt = 0; rt < 2; ++rt) { f32x16_t acc;
#pragma unroll
                for (int i = 0; i < 16; ++i) acc[i] = 0.f;
#pragma unroll
                for (int ks = 0; ks < 4; ++ks) acc = __builtin_amdgcn_mfma_f32_32x32x16_bf16(A[rt][ks], Bc[ks], acc, 0, 0, 0);
                float sc = 0.f;
#pragma unroll
                for (int i = 0; i < 16; ++i) sc = fmaf(wv[rt][i], fmaxf(acc[i], 0.f), sc);
                srow[rt][kb * IXK + t * 32] = sc; } }
    }
#undef IX_LOAD
#undef IX_STORE
}
__device__ __forceinline__ void phase_idx(KP P, LAS unsigned char* lds) {
    unsigned char* ws = as_global(P->ws);
    const bf16_t* QI = (const bf16_t*)(ws + WS_QI); const bf16_t* KI = (const bf16_t*)(ws + WS_KI); const float* WI = (const float*)(ws + WS_WI); float* Sc = (float*)(ws + WS_S);
    const int G = nblk_();
    for (int item = bid_(); item < 240; item += G) {
        const int pi = item % 30, combo = item / 30, b = combo >> 1, half = combo & 1;
        idx_unit(QI, KI, WI, Sc, b, 4 + pi, half, tid_(), lds); __syncthreads();
        idx_unit(QI, KI, WI, Sc, b, 63 - pi, half, tid_(), lds); __syncthreads();
    }
}

__device__ __forceinline__ void sel_unit(const float* S, unsigned long long* MASK, int b, int c, int half, int tid, LAS unsigned char* lds) {
    const int lane = tid & 63, wave = __builtin_amdgcn_readfirstlane(tid >> 6), nw = c + 1;
    LAS unsigned long long* sm = (LAS unsigned long long*)lds + wave * 64;
    float f[64]; const int s0 = c * 64 + half * 32 + wave * 4;
    const float* rowbase = S + (size_t)b * SCORE_B + (size_t)2048 * c * (c + 1);
#pragma unroll 1
    for (int i = 0; i < 4; ++i) {
        unsigned u[64];
        sel_load(rowbase + (size_t)((s0 + i) & 63) * (nw * 64), nw, lane, f);
#pragma unroll
        for (int j = 0; j < 64; ++j) { const unsigned bits = __float_as_uint(f[j]); const unsigned v = (bits & 0x80000000u) ? ~bits : (bits | 0x80000000u); u[j] = (j < nw) ? v : 0u; }
        unsigned prefix = 0u;
        for (int bit = 31; bit >= 0; --bit) { const unsigned cand = prefix | (1u << bit); int cnt = 0;
#pragma unroll
            for (int j8 = 0; j8 < 8; ++j8) if (j8 * 8 < nw) { unsigned long long bl[8];
#pragma unroll
                for (int jj = 0; jj < 8; ++jj) bl[jj] = __ballot(u[j8 * 8 + jj] >= cand);
                asm volatile("" : "+s"(bl[0]), "+s"(bl[1]), "+s"(bl[2]), "+s"(bl[3]), "+s"(bl[4]), "+s"(bl[5]), "+s"(bl[6]), "+s"(bl[7]));
#pragma unroll
                for (int jj = 0; jj < 8; ++jj) cnt += __popcll(bl[jj]); }
            if (cnt >= TOPK) prefix = cand; }
#pragma unroll
        for (int j = 0; j < 64; ++j) { const unsigned long long w = __ballot(u[j] >= prefix); if (lane == 0) sm[j] = w; }
        MASK[((size_t)b * SEQ + s0 + i) * 64 + lane] = sm[lane];
    }
}
__device__ __forceinline__ void phase_idxsel(KP P, LAS unsigned char* lds) {
    unsigned char* ws = as_global(P->ws);
    const bf16_t* QI = (const bf16_t*)(ws + WS_QI); const bf16_t* KI = (const bf16_t*)(ws + WS_KI); const float* WI = (const float*)(ws + WS_WI); float* Sc = (float*)(ws + WS_S);
    unsigned long long* MASK = (unsigned long long*)(ws + WS_MASK);
    const int G = nblk_();
    { const int tid = tid_(), lane = tid & 63, gw = bid_() * 8 + __builtin_amdgcn_readfirstlane(tid >> 6);
      for (int qq = gw; qq < NBATCH * 256; qq += G * 8) { const int b = qq >> 8, s = qq & 255, nw = (s >> 6) + 1; MASK[((size_t)b * SEQ + s) * 64 + lane] = (lane < nw) ? ~0ull : 0ull; } }
    for (int item = bid_(); item < 240; item += G) {
        const int pi = item % 30, combo = item / 30, b = combo >> 1, half = combo & 1;
#pragma unroll 1
        for (int which = 0; which < 2; ++which) { const int c = which ? 63 - pi : 4 + pi;
            idx_unit(QI, KI, WI, Sc, b, c, half, tid_(), lds);
            asm volatile("s_waitcnt vmcnt(0)" ::: "memory"); __syncthreads();
            sel_unit(Sc, MASK, b, c, half, tid_(), lds);
            __syncthreads(); }
    }
}
__device__ __forceinline__ void ixs_unit(const bf16_t* QI, const bf16_t* KI, const float* WI, unsigned long long* MASK, int b, int u8, int tid, LAS unsigned char* lds) {
    const int lane = tid & 63, wave = __builtin_amdgcn_readfirstlane(tid >> 6), r = lane & 31, hh = lane >> 5;
    const int s0 = 8 * u8, c = s0 >> 6, nw = c + 1, nk = 64 * nw;
    LAS float* SC = (LAS float*)lds;
    unsigned long long myword;
    if (nw > TOPK / 64) {
        { const int aq = (r >> 2) & 1, ahead = (r & 3) + 4 * (r >> 3);
          bf16x8_t A[4][4]; float wv[4][16];
#pragma unroll
          for (int rt = 0; rt < 4; ++rt) { const size_t qrow = (size_t)b * SEQ + s0 + 2 * rt + aq;
#pragma unroll
              for (int ks = 0; ks < 4; ++ks) A[rt][ks] = *(const bf16x8_t*)(QI + qrow * 1024 + ahead * 64 + 16 * ks + 8 * hh);
              const float* wp = WI + ((size_t)b * SEQ + s0 + 2 * rt + hh) * 16;
#pragma unroll
              for (int i4 = 0; i4 < 4; ++i4) { const pg8::f32x4 w4 = *(const pg8::f32x4*)(wp + 4 * i4); wv[rt][4 * i4] = w4[0]; wv[rt][4 * i4 + 1] = w4[1]; wv[rt][4 * i4 + 2] = w4[2]; wv[rt][4 * i4 + 3] = w4[3]; } }
          const bf16_t* kp = KI + ((size_t)b * SEQ + r) * 64 + 8 * hh;
          const int ntile = nk / 32;
          bf16x8_t Ca[4], Cb[4];
#define IXS_LOAD(t0_) do { const int ta = (t0_) < ntile ? (t0_) : ntile - 1, tb_ = (t0_) + 8 < ntile ? (t0_) + 8 : ntile - 1; \
              _Pragma("unroll") for (int ks = 0; ks < 4; ++ks) { Ca[ks] = *(const bf16x8_t*)(kp + (size_t)ta * 2048 + 16 * ks); Cb[ks] = *(const bf16x8_t*)(kp + (size_t)tb_ * 2048 + 16 * ks); } } while (0)
#define IXS_TILE(BUF, tt) do { _Pragma("unroll") for (int rt = 0; rt < 4; ++rt) { f32x16_t acc; _Pragma("unroll") for (int i = 0; i < 16; ++i) acc[i] = 0.f; \
              _Pragma("unroll") for (int ks = 0; ks < 4; ++ks) acc = __builtin_amdgcn_mfma_f32_32x32x16_bf16(A[rt][ks], BUF[ks], acc, 0, 0, 0); \
              pg8::f32x2 sc2 = {0.f, 0.f}; _Pragma("unroll") for (int i = 0; i < 16; i += 2) { pg8::f32x2 rl, wq; \
                  rl[0] = __int_as_float(max(__float_as_int(acc[i]), 0)); rl[1] = __int_as_float(max(__float_as_int(acc[i + 1]), 0)); wq[0] = wv[rt][i]; wq[1] = wv[rt][i + 1]; \
                  sc2 = __builtin_elementwise_fma(wq, rl, sc2); } const float sc = sc2[0] + sc2[1];     \
              SC[(2 * rt + hh) * 4096 + 32 * (tt) + r] = sc; } } while (0)
          IXS_LOAD(wave);
          for (int t = wave; t < ntile; t += 16) {
              bf16x8_t Ba[4], Bb[4];
#pragma unroll
              for (int ks = 0; ks < 4; ++ks) { Ba[ks] = Ca[ks]; Bb[ks] = Cb[ks]; }
              IXS_LOAD(t + 16);
              IXS_TILE(Ba, t);
              if (t + 8 < ntile) IXS_TILE(Bb, t + 8);
          }
#undef IXS_LOAD
#undef IXS_TILE
        }
        __syncthreads();
        unsigned u[64];
        { const LAS float* row = SC + wave * 4096 + lane;
#pragma unroll
          for (int j = 0; j < 64; ++j) { const int jc = j < nw ? j : nw - 1; const unsigned bits = __float_as_uint(row[jc * 64]); const unsigned v = (bits & 0x80000000u) ? ~bits : (bits | 0x80000000u); u[j] = (j < nw) ? v : 0u; } }
        unsigned prefix = 0u;
#ifdef IXS_DUP_SEARCH
        for (int rep_s = 0; rep_s < 2; ++rep_s) { prefix = 0u;
#else
        {
#endif
        for (int bit = 31; bit >= 0; --bit) { const unsigned cand = prefix | (1u << bit); int cnt = 0;
            unsigned cl = 0u;
#pragma unroll
            for (int j8 = 0; j8 < 8; ++j8) if (j8 * 8 < nw) {
#pragma unroll
                for (int jj = 0; jj < 8; ++jj) cl += (u[j8 * 8 + jj] >= cand) ? 1u : 0u; }
#pragma unroll
            for (int bb = 0; bb < 7; ++bb) cnt += __popcll(__ballot((cl >> bb) & 1u)) << bb;
            if (cnt >= TOPK) prefix = cand; }
        }
        LAS unsigned long long* sm = (LAS unsigned long long*)(SC + wave * 4096);
#pragma unroll
        for (int j = 0; j < 64; ++j) { const unsigned long long w = __ballot(u[j] >= prefix); if (lane == 0) sm[j] = w; }
        myword = sm[lane];
    } else {
        myword = (lane < nw) ? ~0ull : 0ull;
    }
    MASK[((size_t)b * SEQ + s0 + wave) * 64 + lane] = myword;
    __syncthreads();
}
__device__ __forceinline__ void phase_ixs(KP P, LAS unsigned char* lds) {
    unsigned char* ws = as_global(P->ws);
    const bf16_t* QI = (const bf16_t*)(ws + WS_QI); const bf16_t* KI = (const bf16_t*)(ws + WS_KI); const float* WI = (const float*)(ws + WS_WI); unsigned long long* MASK = (unsigned long long*)(ws + WS_MASK);
    const int G = nblk_();
    for (int W = bid_(); W < 256; W += G)
        for (int kk = 0; kk < 8; ++kk) ixs_unit(QI, KI, WI, MASK, W & 3, (W >> 2) + 64 * kk, tid_(), lds);
}
#ifndef OPT_HGRN
#define OPT_HGRN 1
#endif
#ifndef OPT_IDX
#define OPT_IDX 1
#endif
#ifndef OPT_ATT
#define OPT_ATT 1
#endif
#ifndef OPT_IXS
#define OPT_IXS 0
#endif
#ifndef PHM
#define PHM 0x3fff
#endif
#ifndef DUP_MASK
#define DUP_MASK 0
#endif

__global__ void __launch_bounds__(512, 2) mega(Params P_unused) {
    extern __shared__ __attribute__((aligned(16))) unsigned char lds[];
    LAS unsigned char* L = (LAS unsigned char*)lds;
    volatile LAS unsigned* misc = (volatile LAS unsigned*)(L + MISC_OFF);
    if (threadIdx.x < 4) misc[threadIdx.x] = 0u;
    __syncthreads();
    int lo, hi; unsigned char* ws0; { KP P0 = kparams(); lo = P0->ph_lo; hi = P0->ph_hi; ws0 = as_global(P0->ws); }
    XcdBarrier bar; bar.bar = (unsigned*)(ws0 + WS_CTL); bar.x = 0; bar.st = misc;
    if (hi - lo > 1) bar = xcd_barrier_post((unsigned*)(ws0 + WS_CTL), misc);
#define WSP(T_, off) ((T_*)(ws + (off)))
#define WSL KP P = kparams(); unsigned char* ws = as_global(P->ws); const int G = nblk_(), bid = bid_(); (void)G; (void)bid

    for (int layer = 0; layer < DEPTH; ++layer) {
        const int base = layer * NPH_LAYER;
#define IN(k) (((PHM >> (k)) & 1) && lo <= base + (k) && base + (k) < hi)
#define SEAM(k) do { if (rep + 1 == ((((DUP_MASK >> (k)) & 1) ? 2 : 1)) && base + (k) + 1 < hi) xcd_barrier(bar); } while (0)
        if (layer == 0 && IN(0)) for (int rep = 0; rep < (((DUP_MASK >> 0) & 1) ? 2 : 1); ++rep) { WSL; phase_prologue(P); phase_wconv(P, 0, L); SEAM(0); }
        if (IN(1)) for (int rep = 0; rep < (((DUP_MASK >> 1) & 1) ? 2 : 1); ++rep) { WSL;
            pg8::Gemm g{WSP(const bf16_t, WS_XB), WSP(const bf16_t, WS_WIN), TOK, INP, DM}; pg8::StaticOrder S; S.init(TOK, INP, G, bid);
            pg8::EpiIn E{ws, layer};
            pg8::gemm_phase<pg8::EpiIn, pg8::StaticOrder, true, true>(L, g, S, E); SEAM(1);
        }
        if (IN(2)) for (int rep = 0; rep < (((DUP_MASK >> 2) & 1) ? 2 : 1); ++rep) { WSL; phase_ikprep(P, layer);
#if OPT_HGRN
            phase_hgrn_h1(P, L);
#ifdef DUP_H1
            phase_hgrn_h1(P, L);
#endif
#endif
            SEAM(2); }
        if (IN(3)) for (int rep = 0; rep < (((DUP_MASK >> 3) & 1) ? 2 : 1); ++rep) { WSL;
#if !OPT_HGRN
            phase_hgrn_naive(P, layer, L); __syncthreads();
#else
            phase_hgrn_h2(P);
#ifdef DUP_H2
            phase_hgrn_h2(P);
#endif
#endif
#if !OPT_IDX
            phase_idx_naive(P, L);
#else
#if OPT_IXS == 2
            __syncthreads(); phase_idxsel(P, L);
#elif OPT_IXS == 1
            __syncthreads(); phase_ixs(P, L);
#ifdef DUP_IXS
            __syncthreads(); phase_ixs(P, L);
#endif
#else
            __syncthreads(); phase_idx(P, L);
#endif
#endif
            SEAM(3); }
#if OPT_IXS == 2 && OPT_HGRN && OPT_ATT
#else
        if (IN(4)) for (int rep = 0; rep < (((DUP_MASK >> 4) & 1) ? 2 : 1); ++rep) { WSL;
#if OPT_IXS == 0
            phase_select(P, L);
#endif
#if OPT_HGRN
            __syncthreads(); phase_hgrn_h3(P, layer, L);
#ifdef DUP_H3
            __syncthreads(); phase_hgrn_h3(P, layer, L);
#endif
#endif
            SEAM(4); }
#endif
        if (IN(5)) for (int rep = 0; rep < (((DUP_MASK >> 5) & 1) ? 2 : 1); ++rep) { WSL;
#if !OPT_ATT
            phase_attn_naive(P, L);
#else
#if OPT_IXS == 2 && OPT_HGRN
            phase_hgrn_h3(P, layer, L); __syncthreads();
#endif
            phase_attn(P, L);
#endif
            SEAM(5); }
        if (IN(6)) for (int rep = 0; rep < (((DUP_MASK >> 6) & 1) ? 2 : 1); ++rep) { WSL;
            { pg8::Gemm g{WSP(const bf16_t, WS_YA), WSP(const bf16_t, WS_WA), TOK, DM, AW}; pg8::StaticOrder S; S.init(TOK, DM, G, bid);
              pg8::EpiGateA E{ws}; pg8::gemm_phase<pg8::EpiGateA, pg8::StaticOrder, true, true>(L, g, S, E); }
            { pg8::Gemm g{WSP(const bf16_t, WS_YB), WSP(const bf16_t, WS_WB), TOK, DM, BW}; pg8::StaticOrder S; S.init(TOK, DM, G, bid);
              pg8::EpiGateB E{ws}; pg8::gemm_phase<pg8::EpiGateB, pg8::StaticOrder, true, true>(L, g, S, E); }
            { pg8::Gemm g{WSP(const bf16_t, WS_PB), WSP(const bf16_t, WS_WPP), TOK, DM, PLE}; pg8::StaticOrder S; S.init(TOK, DM, G, bid);
              pg8::EpiF32P E{ws}; pg8::gemm_phase<pg8::EpiF32P, pg8::StaticOrder, true, true>(L, g, S, E); }
            SEAM(6);
        }
        if (IN(7)) for (int rep = 0; rep < (((DUP_MASK >> 7) & 1) ? 2 : 1); ++rep) { WSL;
            pg8::Gemm g{WSP(const bf16_t, WS_MG), WSP(const bf16_t, WS_WO), TOK, DM, DM}; pg8::StaticOrder S; S.init(TOK, DM, G, bid);
            if (layer == 0) { pg8::EpiRes<true> E{as_global(P->x), nullptr, nullptr, ws}; pg8::gemm_phase<pg8::EpiRes<true>, pg8::StaticOrder, true, true>(L, g, S, E); }
            else { pg8::EpiRes<false> E{nullptr, P->lnp_g + (layer - 1) * DM, P->lnp_b + (layer - 1) * DM, ws}; pg8::gemm_phase<pg8::EpiRes<false>, pg8::StaticOrder, true, true>(L, g, S, E); }
            SEAM(7);
        }
        if (IN(8)) for (int rep = 0; rep < (((DUP_MASK >> 8) & 1) ? 2 : 1); ++rep) { WSL; phase_ln(WSP(const float, WS_XPRE), nullptr, WSP(bf16_t, WS_XB), WSP(float, WS_STATS), as_global(P->lnm_g) + layer * DM, as_global(P->lnm_b) + layer * DM); SEAM(8); }
        if (IN(9)) for (int rep = 0; rep < (((DUP_MASK >> 9) & 1) ? 2 : 1); ++rep) { WSL;
            pg8::Gemm g{WSP(const bf16_t, WS_XB), WSP(const bf16_t, WS_WGU), TOK, 2 * DFF, DM}; pg8::StaticOrder S; S.init(TOK, 2 * DFF, G, bid);
            pg8::EpiSwiGLU E{ws}; pg8::gemm_phase<pg8::EpiSwiGLU, pg8::StaticOrder, true, true>(L, g, S, E); SEAM(9);
        }
        if (IN(10)) for (int rep = 0; rep < (((DUP_MASK >> 10) & 1) ? 2 : 1); ++rep) { WSL;
            pg8::Gemm g{WSP(const bf16_t, WS_H), WSP(const bf16_t, WS_WDN), TOK, DM, DFF}; pg8::StaticOrder S; S.init(TOK, DM, G, bid);
            pg8::EpiRes<false> E{nullptr, P->lnm_g + layer * DM, P->lnm_b + layer * DM, ws}; pg8::gemm_phase<pg8::EpiRes<false>, pg8::StaticOrder, true, true>(L, g, S, E); SEAM(10);
        }
        if (IN(11)) for (int rep = 0; rep < (((DUP_MASK >> 11) & 1) ? 2 : 1); ++rep) { WSL; phase_ln(WSP(const float, WS_XPRE), nullptr, WSP(bf16_t, WS_XB), WSP(float, WS_STATS), as_global(P->lnf_g) + layer * DM, as_global(P->lnf_b) + layer * DM); SEAM(11); }
        if (IN(12)) for (int rep = 0; rep < (((DUP_MASK >> 12) & 1) ? 2 : 1); ++rep) { WSL;
            pg8::Gemm g{WSP(const bf16_t, WS_XB), WSP(const bf16_t, WS_WPG), TOK, DM, DM}; pg8::StaticOrder S; S.init(TOK, DM, G, bid);
            pg8::EpiPle E{P->lnf_g + layer * DM, P->lnf_b + layer * DM, ws}; pg8::gemm_phase<pg8::EpiPle, pg8::StaticOrder, true, true>(L, g, S, E); SEAM(12);
        }
        if (IN(13)) for (int rep = 0; rep < (((DUP_MASK >> 13) & 1) ? 2 : 1); ++rep) { WSL; phase_ln(WSP(const float, WS_XPRE), layer == DEPTH - 1 ? as_global(P->out) : nullptr, WSP(bf16_t, WS_XB), WSP(float, WS_STATS), as_global(P->lnp_g) + layer * DM, as_global(P->lnp_b) + layer * DM);
            if (layer + 1 < DEPTH) { __syncthreads(); phase_wconv(P, layer + 1, L); }
            SEAM(13); }
#undef IN
#undef SEAM
    }
}

extern "C" void kernel_launch(void* const* d_in, const int* in_sizes, int n_in, void* d_out, int out_size, void* d_ws, size_t ws_size, hipStream_t stream) {
    static int grid = 0;
    if (grid == 0) {
        if (n_in != 22 || out_size != TOK * DM || ws_size < WS_END) { fprintf(stderr, "kernel_launch: unexpected shapes: n_in %d out %d ws %zu (need %zu)\n", n_in, out_size, ws_size, (size_t)WS_END); grid = -1; return; }
        int dev = 0, cus = 0, per_cu = 0;
        if (hipGetDevice(&dev) != hipSuccess || hipDeviceGetAttribute(&cus, hipDeviceAttributeMultiprocessorCount, dev) != hipSuccess) { grid = -1; return; }
        if (hipFuncSetAttribute((const void*)mega, hipFuncAttributeMaxDynamicSharedMemorySize, LDS_BYTES) != hipSuccess) { fprintf(stderr, "kernel_launch: hipFuncSetAttribute failed\n"); grid = -1; return; }
        if (hipOccupancyMaxActiveBlocksPerMultiprocessor(&per_cu, (const void*)mega, 512, LDS_BYTES) != hipSuccess || per_cu < 1) { fprintf(stderr, "kernel_launch: occupancy query says %d\n", per_cu); (void)hipGetLastError(); }
        grid = cus;
    }
    if (grid < 0) return;
    (void)hipMemsetAsync((char*)d_ws + WS_CTL, 0, 65536, stream);
    Params P{};
    P.x = (const float*)d_in[0]; P.p = (const float*)d_in[1]; P.pos = (const int*)d_in[2];
    P.w_in = (const float*)d_in[3]; P.w_a = (const float*)d_in[4]; P.w_b = (const float*)d_in[5]; P.w_out = (const float*)d_in[6];
    P.lbraw = (const float*)d_in[7]; P.hnorm_g = (const float*)d_in[8]; P.ikn_g = (const float*)d_in[9]; P.ikn_b = (const float*)d_in[10];
    P.lnm_g = (const float*)d_in[11]; P.lnm_b = (const float*)d_in[12]; P.w_fg = (const float*)d_in[13]; P.w_fu = (const float*)d_in[14]; P.w_fd = (const float*)d_in[15];
    P.lnf_g = (const float*)d_in[16]; P.lnf_b = (const float*)d_in[17]; P.w_pg = (const float*)d_in[18]; P.w_pp = (const float*)d_in[19];
    P.lnp_g = (const float*)d_in[20]; P.lnp_b = (const float*)d_in[21];
    P.out = (float*)d_out; P.ws = (unsigned char*)d_ws;
    for (int j = 0; j < 64; ++j) P.invf_h[j] = pow(10000.0, -(double)j / 64.0) / 6.283185307179586476925286766559;
    for (int j = 0; j < 32; ++j) P.invf_i[j] = pow(10000.0, -(double)j / 32.0) / 6.283185307179586476925286766559;
    P.ph_lo = 0; P.ph_hi = NPH;
    hipLaunchKernelGGL(mega, dim3(grid), dim3(512), LDS_BYTES, stream, P);
    const hipError_t le = hipPeekAtLastError();
    if (le != hipSuccess) fprintf(stderr, "kernel_launch: launch failed: %s\n", hipGetErrorName(le));
}
```

```cpp
#include <hip/hip_runtime.h>
#include <cstdio>
#include <cstdint>

constexpr int DM = 2048, NBATCH = 4, SEQ = 4096, TOK = NBATCH * SEQ, DEPTH = 4, CHUNK = 64, PLE = 256;
constexpr int AH = 8, AD = 128, AW = 1024, BH = 8, BD = 128, BW = 1024, IH = 16, IDIM = 64, TOPK = 256;
constexpr int DFF = 5632, INW = 12368, INP = 12544;
constexpr float ALPHA = 1.6817928305074290861f;
constexpr float LN_EPS = 1e-5f, RMS_EPS = 1e-6f;
constexpr float ATTN_SCALE = 0.088388347648318440f;
constexpr float IDX_SCALE = 0.03125f;

typedef unsigned short bf16_t;
__device__ __forceinline__ float bf2f(bf16_t b) { return __uint_as_float(((unsigned)b) << 16); }
__device__ __forceinline__ bf16_t f2bf(float f) { unsigned u = __float_as_uint(f); u += 0x7FFFu + ((u >> 16) & 1u); return (bf16_t)(u >> 16); }
__device__ __forceinline__ float sigmoid_f(float x) { return __builtin_amdgcn_rcpf(1.0f + __expf(-x)); }
__device__ __forceinline__ float silu_f(float x) { return x * sigmoid_f(x); }

__device__ __forceinline__ int tid_() { int t = (int)threadIdx.x; asm volatile("" : "+v"(t)); return t; }
__device__ __forceinline__ int bid_() { int b = (int)blockIdx.x; asm volatile("" : "+s"(b)); return b; }
__device__ __forceinline__ int nblk_() { int g = (int)gridDim.x; asm volatile("" : "+s"(g)); return g; }

template <class T> __device__ __forceinline__ T* as_global(T* p) { return (T*)(__attribute__((address_space(1))) T*)p; }

constexpr size_t MiB = 1048576;
constexpr size_t WS_CTL  = 0;
constexpr size_t WS_LB   = WS_CTL + 65536;
constexpr size_t WS_STATS = WS_CTL + 131072;
constexpr size_t WS_COSH = 1 * MiB;
constexpr size_t WS_SINH = WS_COSH + 4 * MiB;
constexpr size_t WS_COSI = WS_SINH + 4 * MiB;
constexpr size_t WS_SINI = WS_COSI + 2 * MiB;
constexpr size_t WS_WIN  = WS_SINI + 2 * MiB;
constexpr size_t WS_WA   = WS_WIN + 49 * MiB;
constexpr size_t WS_WB   = WS_WA + 4 * MiB;
constexpr size_t WS_WO   = WS_WB + 4 * MiB;
constexpr size_t WS_WGU  = WS_WO + 8 * MiB;
constexpr size_t WS_WDN  = WS_WGU + 44 * MiB;
constexpr size_t WS_WPG  = WS_WDN + 22 * MiB;
constexpr size_t WS_WPP  = WS_WPG + 8 * MiB;
constexpr size_t WS_S    = WS_WPP + 1 * MiB;
constexpr size_t WS_XB   = WS_S + 130 * MiB;
constexpr size_t WS_XPRE = WS_XB + 64 * MiB;
constexpr size_t WS_R1   = WS_XPRE + 130 * MiB;
constexpr size_t WS_QA   = WS_R1;
constexpr size_t WS_LF   = WS_QA + 32 * MiB;
constexpr size_t WS_KA   = WS_LF + 64 * MiB;
constexpr size_t WS_VA   = WS_KA + 32 * MiB;
constexpr size_t WS_GA   = WS_VA + 32 * MiB;
constexpr size_t WS_QB   = WS_GA + 32 * MiB;
constexpr size_t WS_KB   = WS_QB + 32 * MiB;
constexpr size_t WS_VB   = WS_KB + 32 * MiB;
constexpr size_t WS_QI   = WS_VB + 32 * MiB;
constexpr size_t WS_SGA  = WS_QI + 32 * MiB;
constexpr size_t WS_SGB  = WS_SGA + 64 * MiB;
constexpr size_t WS_IKW  = WS_SGB + 64 * MiB;
constexpr size_t WS_H    = WS_R1;
constexpr size_t WS_PP   = WS_R1 + 176 * MiB;
constexpr size_t WS_R2   = WS_IKW + 8 * MiB;
constexpr size_t WS_LT   = WS_R2;
constexpr size_t WS_MG   = WS_R2;
constexpr size_t WS_AF   = WS_R2 + 64 * MiB;
constexpr size_t WS_PT   = WS_LT + 128 * MiB;
constexpr size_t WS_DEC  = WS_PT + 64 * MiB;
constexpr size_t WS_MASK = WS_DEC + 1 * MiB;
constexpr size_t WS_YA   = WS_MASK + 8 * MiB;
constexpr size_t WS_YB   = WS_YA + 32 * MiB;
constexpr size_t WS_KI   = WS_YB + 32 * MiB;
constexpr size_t WS_WI   = WS_KI + 2 * MiB;
constexpr size_t WS_PB   = WS_WI + 1 * MiB;
constexpr size_t WS_END  = WS_PB + 8 * MiB;
static_assert(WS_END < 1360000000ull, "workspace budget");
constexpr size_t SCORE_B = (size_t)4096 * 2080;

namespace pg8 {
#define PG8_LAS __attribute__((address_space(3)))
typedef unsigned short bf16_t;
typedef short bf16x8 __attribute__((ext_vector_type(8)));
typedef float f32x4 __attribute__((ext_vector_type(4)));
typedef unsigned u32x4 __attribute__((ext_vector_type(4)));
constexpr int BM = 256, BK = 64, HALF = 128, HTB = HALF * BK * 2  , STAGE_BYTES = 8 * HTB, NXCD = 8, WGM = 8;

__host__ __device__ __forceinline__ int lds_byte(int r, int c) { const int st = (r >> 4) * 2 + (c >> 5), rr = r & 15, cc = c & 31, ob = rr * 64 + cc * 2; return st * 1024 + (ob ^ (((ob >> 9) & 1) << 5)); }
__host__ __device__ __forceinline__ void stage_rc(int b, int& R, int& C) { const int st = b / 1024, sb = b % 1024, swz = sb ^ (((sb >> 9) & 1) << 5); R = (st >> 1) * 16 + swz / 64; C = (st & 1) * 32 + (swz % 64) / 2; }
__host__ __device__ __forceinline__ int perm32(int rho) { const int n = rho >> 4, i = rho & 15; return 8 * (i >> 2) + 4 * n + (i & 3); }

struct Unit { int pm, pn; };
struct Gemm { const bf16_t* A; const bf16_t* Bt; int M, N, K; };

struct StaticOrder {
    int nM, nN, nwg, G, c;
    __host__ __device__ void init(int M, int N, int G_, int c_) { nM = M / BM; nN = N / BM; nwg = nM * nN; G = G_; c = c_; }
    __host__ __device__ bool next(int i, Unit& u) const {
        const long L = (long)i * G + c; if (L >= nwg) return false;
        int wgid = (int)L; { const int q = nwg / NXCD, r = nwg % NXCD, xcd = wgid % NXCD, off = wgid / NXCD; wgid = (xcd < r ? xcd * (q + 1) : r * (q + 1) + (xcd - r) * q) + off; }
        const int nig = WGM * nN, gid = wgid / nig, fm = gid * WGM, gsz = (nM - fm) < WGM ? (nM - fm) : WGM;
        u.pm = fm + ((wgid % nig) % gsz); u.pn = (wgid % nig) / gsz; return true;
    }
    __device__ __forceinline__ void a_ready(const Unit&) const {}
    __device__ __forceinline__ void done(const Unit&) const {}
};

typedef float pk_f32x2 __attribute__((ext_vector_type(2)));
typedef __bf16 pk_bf16x2 __attribute__((ext_vector_type(2)));
__device__ __forceinline__ unsigned cvt_pk_bf16(float lo, float hi) { const pk_f32x2 v = {lo, hi}; const pk_bf16x2 b = __builtin_convertvector(v, pk_bf16x2); return __builtin_bit_cast(unsigned, b); }
typedef unsigned u32x2 __attribute__((ext_vector_type(2)));
typedef float f32x2 __attribute__((ext_vector_type(2)));
__device__ __forceinline__ u32x4 pack8(const f32x4 a, const f32x4 b) { u32x4 w; w.x = cvt_pk_bf16(a[0], a[1]); w.y = cvt_pk_bf16(a[2], a[3]); w.z = cvt_pk_bf16(b[0], b[1]); w.w = cvt_pk_bf16(b[2], b[3]); return w; }
__device__ __forceinline__ void unpack8(const u32x4 w, f32x4& a, f32x4& b) {
    a[0] = __uint_as_float(w.x << 16); a[1] = __uint_as_float(w.x & 0xffff0000u); a[2] = __uint_as_float(w.y << 16); a[3] = __uint_as_float(w.y & 0xffff0000u);
    b[0] = __uint_as_float(w.z << 16); b[1] = __uint_as_float(w.z & 0xffff0000u); b[2] = __uint_as_float(w.w << 16); b[3] = __uint_as_float(w.w & 0xffff0000u); }
__device__ __forceinline__ float sigm(float x) { return __builtin_amdgcn_rcpf(1.0f + __expf(-x)); }
__device__ __forceinline__ f32x4 sigm4(const f32x4 x) { f32x4 r; r[0] = sigm(x[0]); r[1] = sigm(x[1]); r[2] = sigm(x[2]); r[3] = sigm(x[3]); return r; }
__device__ __forceinline__ f32x4 silu4(const f32x4 x) { return x * sigm4(x); }

#define PG8_GAS __attribute__((address_space(1)))
struct EpiIn {
    static constexpr bool PERM = true, AFTER_DRAIN = false;
    unsigned char* ws0; int layer;
    __device__ __forceinline__ void operator()(const f32x4 (&acc)[2][2][4][2], const Unit& u, int wr, int wc, int fr, int fq) const {
        unsigned char* wsq = ws0; asm volatile("" : "+s"(wsq)); PG8_GAS unsigned char* const ws = (PG8_GAS unsigned char*)wsq;
        const int pn = u.pn, row0 = u.pm * BM + wr * 64 + fr, cw = wc * 32 + 8 * fq;
        PG8_GAS bf16_t* const QA = (PG8_GAS bf16_t*)(ws + WS_QA); PG8_GAS bf16_t* const KA = (PG8_GAS bf16_t*)(ws + WS_KA); PG8_GAS bf16_t* const VA = (PG8_GAS bf16_t*)(ws + WS_VA); PG8_GAS bf16_t* const GA = (PG8_GAS bf16_t*)(ws + WS_GA);
        PG8_GAS bf16_t* const QB = (PG8_GAS bf16_t*)(ws + WS_QB); PG8_GAS bf16_t* const KB = (PG8_GAS bf16_t*)(ws + WS_KB); PG8_GAS bf16_t* const VB = (PG8_GAS bf16_t*)(ws + WS_VB); PG8_GAS bf16_t* const QI = (PG8_GAS bf16_t*)(ws + WS_QI);
        PG8_GAS bf16_t* const SGA = (PG8_GAS bf16_t*)(ws + WS_SGA); PG8_GAS bf16_t* const SGB = (PG8_GAS bf16_t*)(ws + WS_SGB); PG8_GAS float* const LF = (PG8_GAS float*)(ws + WS_LF); PG8_GAS float* const IKW = (PG8_GAS float*)(ws + WS_IKW);
        const PG8_GAS float* const lb = (const PG8_GAS float*)(ws + WS_LB) + layer * 1024; const PG8_GAS float* const cosh = (const PG8_GAS float*)(ws + WS_COSH); const PG8_GAS float* const sinh = (const PG8_GAS float*)(ws + WS_SINH);
        const PG8_GAS float* const cosi = (const PG8_GAS float*)(ws + WS_COSI); const PG8_GAS float* const sini = (const PG8_GAS float*)(ws + WS_SINI);
        if (pn < 32) {
            const int seg = pn >> 2, cb = (pn & 3) * 256;
            if (seg == 4 || seg == 5) {
                PG8_GAS bf16_t* O = (seg == 4) ? QB : KB; const int head = (pn & 3) * 2 + (wc >> 1), i0 = (wc & 1) * 32 + 8 * fq;
#pragma unroll
                for (int ai = 0; ai < 2; ++ai)
#pragma unroll
                    for (int m = 0; m < 4; ++m) { const int row = row0 + ai * HALF + m * 16;
                        const PG8_GAS float* cp = cosh + (size_t)row * 64 + i0; const PG8_GAS float* sp = sinh + (size_t)row * 64 + i0;
                        const f32x4 c0 = *(const PG8_GAS f32x4*)cp, c1 = *(const PG8_GAS f32x4*)(cp + 4), s0 = *(const PG8_GAS f32x4*)sp, s1 = *(const PG8_GAS f32x4*)(sp + 4);
                        const f32x4 xa = acc[ai][0][m][0], xb = acc[ai][0][m][1], ya = acc[ai][1][m][0], yb = acc[ai][1][m][1];
                        PG8_GAS bf16_t* rp = O + (size_t)row * 1024 + head * 128 + i0;
                        *(PG8_GAS u32x4*)rp = pack8(xa * c0 - ya * s0, xb * c1 - yb * s1);
                        *(PG8_GAS u32x4*)(rp + 64) = pack8(xa * s0 + ya * c0, xb * s1 + yb * c1); asm volatile("" ::: "memory"); }
            } else if (seg == 7) {
                const int head = (pn & 3) * 4 + wc, i0 = 8 * fq;
#pragma unroll
                for (int ai = 0; ai < 2; ++ai)
#pragma unroll
                    for (int m = 0; m < 4; ++m) { const int row = row0 + ai * HALF + m * 16;
                        const PG8_GAS float* cp = cosi + (size_t)row * 32 + i0; const PG8_GAS float* sp = sini + (size_t)row * 32 + i0;
                        const f32x4 c0 = *(const PG8_GAS f32x4*)cp, c1 = *(const PG8_GAS f32x4*)(cp + 4), s0 = *(const PG8_GAS f32x4*)sp, s1 = *(const PG8_GAS f32x4*)(sp + 4);
                        const f32x4 xa = acc[ai][0][m][0], xb = acc[ai][0][m][1], ya = acc[ai][1][m][0], yb = acc[ai][1][m][1];
                        PG8_GAS bf16_t* rp = QI + (size_t)row * 1024 + head * 64 + i0;
                        *(PG8_GAS u32x4*)rp = pack8(xa * c0 - ya * s0, xb * c1 - yb * s1);
                        *(PG8_GAS u32x4*)(rp + 32) = pack8(xa * s0 + ya * c0, xb * s1 + yb * c1); asm volatile("" ::: "memory"); }
            } else if (seg == 1) {
#pragma unroll
                for (int bj = 0; bj < 2; ++bj) { const int col = cb + bj * HALF + cw;
                    const f32x4 l0 = *(const PG8_GAS f32x4*)(lb + col), l1 = *(const PG8_GAS f32x4*)(lb + col + 4);
#pragma unroll
                    for (int ai = 0; ai < 2; ++ai)
#pragma unroll
                        for (int m = 0; m < 4; ++m) { const int row = row0 + ai * HALF + m * 16; f32x4 lf[2], kk[2];
#pragma unroll
                            for (int n = 0; n < 2; ++n) { const f32x4 x = acc[ai][bj][m][n]; const f32x4 lv = n ? l1 : l0;
#pragma unroll
                                for (int j = 0; j < 4; ++j) { const float xe = fminf(fmaxf(x[j], -80.f), 80.f), e = __expf(-xe), r = __builtin_amdgcn_rcpf(1.0f + e);
                                    const float om = 1.0f - lv[j]; lf[n][j] = logf(lv[j] + om * r); kk[n][j] = om * (e * r); } }
                            PG8_GAS float* lp = LF + (size_t)row * 1024 + col; *(PG8_GAS f32x4*)lp = lf[0]; *(PG8_GAS f32x4*)(lp + 4) = lf[1];
                            *(PG8_GAS u32x4*)(KA + (size_t)row * 1024 + col) = pack8(kk[0], kk[1]); asm volatile("" ::: "memory"); } }
            } else {
                PG8_GAS bf16_t* O = (seg == 0) ? QA : (seg == 2) ? VA : (seg == 3) ? GA : VB; const bool act = (seg == 0 || seg == 3);
#pragma unroll
                for (int ai = 0; ai < 2; ++ai)
#pragma unroll
                    for (int m = 0; m < 4; ++m) { const int row = row0 + ai * HALF + m * 16;
#pragma unroll
                        for (int bj = 0; bj < 2; ++bj) { f32x4 v0 = acc[ai][bj][m][0], v1 = acc[ai][bj][m][1];
                            if (act) { v0 = silu4(v0); v1 = silu4(v1); }
                            *(PG8_GAS u32x4*)(O + (size_t)row * 1024 + cb + bj * HALF + cw) = pack8(v0, v1); } }
            }
        } else if (pn < 48) {
            PG8_GAS bf16_t* O = (pn < 40) ? SGA : SGB; const int cb = ((pn - 32) & 7) * 256;
#pragma unroll
            for (int ai = 0; ai < 2; ++ai)
#pragma unroll
                for (int m = 0; m < 4; ++m) { const int row = row0 + ai * HALF + m * 16;
#pragma unroll
                    for (int bj = 0; bj < 2; ++bj)
                        *(PG8_GAS u32x4*)(O + (size_t)row * DM + cb + bj * HALF + cw) = pack8(sigm4(acc[ai][bj][m][0]), sigm4(acc[ai][bj][m][1])); }
        } else {
#pragma unroll
            for (int ai = 0; ai < 2; ++ai)
#pragma unroll
                for (int m = 0; m < 4; ++m) { PG8_GAS float* p = IKW + (size_t)(row0 + ai * HALF + m * 16) * 128 + cw; *(PG8_GAS f32x4*)p = acc[ai][0][m][0]; *(PG8_GAS f32x4*)(p + 4) = acc[ai][0][m][1]; }
        }
    }
};
struct EpiGateA {
    static constexpr bool PERM = true, AFTER_DRAIN = false;
    unsigned char* ws;
    __device__ __forceinline__ void operator()(const f32x4 (&acc)[2][2][4][2], const Unit& u, int wr, int wc, int fr, int fq) const {
        unsigned char* const wg = as_global(ws); const bf16_t* const SG = (const bf16_t*)(wg + WS_SGA); bf16_t* const AF = (bf16_t*)(wg + WS_AF);
        const int row0 = u.pm * BM + wr * 64 + fr, col0 = u.pn * BM + wc * 32 + 8 * fq;
#pragma unroll
        for (int ai = 0; ai < 2; ++ai)
#pragma unroll
            for (int m = 0; m < 4; ++m) { const size_t off = (size_t)(row0 + ai * HALF + m * 16) * DM + col0;
#pragma unroll
                for (int bj = 0; bj < 2; ++bj) { f32x4 g0, g1; unpack8(*(const u32x4*)(SG + off + bj * HALF), g0, g1);
                    *(u32x4*)(AF + off + bj * HALF) = pack8(g0 * acc[ai][bj][m][0], g1 * acc[ai][bj][m][1]); } asm volatile("" ::: "memory"); }
    }
};
struct EpiGateB {
    static constexpr bool PERM = true, AFTER_DRAIN = false;
    unsigned char* ws;
    __device__ __forceinline__ void operator()(const f32x4 (&acc)[2][2][4][2], const Unit& u, int wr, int wc, int fr, int fq) const {
        unsigned char* const wg = as_global(ws); const bf16_t* const SG = (const bf16_t*)(wg + WS_SGB); const bf16_t* const AF = (const bf16_t*)(wg + WS_AF); bf16_t* const MG = (bf16_t*)(wg + WS_MG);
        const int row0 = u.pm * BM + wr * 64 + fr, col0 = u.pn * BM + wc * 32 + 8 * fq;
#pragma unroll
        for (int ai = 0; ai < 2; ++ai)
#pragma unroll
            for (int m = 0; m < 4; ++m) { const size_t off = (size_t)(row0 + ai * HALF + m * 16) * DM + col0;
#pragma unroll
                for (int bj = 0; bj < 2; ++bj) { f32x4 g0, g1; unpack8(*(const u32x4*)(SG + off + bj * HALF), g0, g1);
                    f32x4 a0, a1; unpack8(*(const u32x4*)(AF + off + bj * HALF), a0, a1);
                    *(u32x4*)(MG + off + bj * HALF) = pack8(a0 + g0 * acc[ai][bj][m][0], a1 + g1 * acc[ai][bj][m][1]); } asm volatile("" ::: "memory"); }
    }
};
template <bool PLAIN> struct EpiRes {
    static constexpr bool PERM = true, AFTER_DRAIN = false;
    const float* X; const float* g; const float* b; unsigned char* ws;
    __device__ __forceinline__ void operator()(const f32x4 (&acc)[2][2][4][2], const Unit& u, int wr, int wc, int fr, int fq) const {
        unsigned char* const wg = as_global(ws); float* const XP = (float*)(wg + WS_XPRE); const float* const ST = (const float*)(wg + WS_STATS); const float* const Xg = as_global(X);
        const int row0 = u.pm * BM + wr * 64 + fr, col0 = u.pn * BM + wc * 32 + 8 * fq;
        f32x4 gv[2][2], bv[2][2];
        if (!PLAIN) { const float* gg = as_global(g); const float* bb = as_global(b);
#pragma unroll
            for (int bj = 0; bj < 2; ++bj)
#pragma unroll
                for (int n = 0; n < 2; ++n) { gv[bj][n] = *(const f32x4*)(gg + col0 + bj * HALF + 4 * n); bv[bj][n] = *(const f32x4*)(bb + col0 + bj * HALF + 4 * n); } }
#pragma unroll
        for (int ai = 0; ai < 2; ++ai)
#pragma unroll
            for (int m = 0; m < 4; ++m) { const int row = row0 + ai * HALF + m * 16; const size_t off = (size_t)row * DM + col0;
                float mean = 0.f, rstd = 1.f; if (!PLAIN) { const f32x2 s2 = *(const f32x2*)(ST + 2 * (size_t)row); mean = s2[0]; rstd = s2[1]; }
#pragma unroll
                for (int bj = 0; bj < 2; ++bj) { float* p = XP + off + bj * HALF; f32x4 x0, x1;
                    if (PLAIN) { const float* xp = Xg + off + bj * HALF; x0 = *(const f32x4*)xp; x1 = *(const f32x4*)(xp + 4); }
                    else { x0 = (*(const f32x4*)p - mean) * rstd * gv[bj][0] + bv[bj][0]; x1 = (*(const f32x4*)(p + 4) - mean) * rstd * gv[bj][1] + bv[bj][1]; }
                    *(f32x4*)p = x0 * ALPHA + acc[ai][bj][m][0]; *(f32x4*)(p + 4) = x1 * ALPHA + acc[ai][bj][m][1]; } asm volatile("" ::: "memory"); }
    }
};
struct EpiSwiGLU {
    static constexpr bool PERM = true, AFTER_DRAIN = false;
    unsigned char* ws;
    __device__ __forceinline__ void operator()(const f32x4 (&acc)[2][2][4][2], const Unit& u, int wr, int wc, int fr, int fq) const {
        bf16_t* const H = (bf16_t*)(as_global(ws) + WS_H);
        const int row0 = u.pm * BM + wr * 64 + fr, col0 = u.pn * HALF + wc * 32 + 8 * fq;
#pragma unroll
        for (int ai = 0; ai < 2; ++ai)
#pragma unroll
            for (int m = 0; m < 4; ++m)
                *(u32x4*)(H + (size_t)(row0 + ai * HALF + m * 16) * DFF + col0) = pack8(silu4(acc[ai][0][m][0]) * acc[ai][1][m][0], silu4(acc[ai][0][m][1]) * acc[ai][1][m][1]);
    }
};
struct EpiF32P {
    static constexpr bool PERM = true, AFTER_DRAIN = false;
    unsigned char* ws;
    __device__ __forceinline__ void operator()(const f32x4 (&acc)[2][2][4][2], const Unit& u, int wr, int wc, int fr, int fq) const {
        bf16_t* const C = (bf16_t*)(as_global(ws) + WS_PP);
        const int row0 = u.pm * BM + wr * 64 + fr, col0 = u.pn * BM + wc * 32 + 8 * fq;
#pragma unroll
        for (int ai = 0; ai < 2; ++ai)
#pragma unroll
            for (int m = 0; m < 4; ++m) { const size_t off = (size_t)(row0 + ai * HALF + m * 16) * DM + col0;
#pragma unroll
                for (int bj = 0; bj < 2; ++bj) *(u32x4*)(C + off + bj * HALF) = pack8(acc[ai][bj][m][0], acc[ai][bj][m][1]); }
    }
};
struct EpiPle {
    static constexpr bool PERM = true, AFTER_DRAIN = false;
    const float* g; const float* b; unsigned char* ws;
    __device__ __forceinline__ void operator()(const f32x4 (&acc)[2][2][4][2], const Unit& u, int wr, int wc, int fr, int fq) const {
        unsigned char* const wg = as_global(ws); const bf16_t* const PP = (const bf16_t*)(wg + WS_PP); float* const XP = (float*)(wg + WS_XPRE); const float* const ST = (const float*)(wg + WS_STATS);
        const int row0 = u.pm * BM + wr * 64 + fr, col0 = u.pn * BM + wc * 32 + 8 * fq;
        f32x4 gv[2][2], bv[2][2]; { const float* gg = as_global(g); const float* bb = as_global(b);
#pragma unroll
            for (int bj = 0; bj < 2; ++bj)
#pragma unroll
                for (int n = 0; n < 2; ++n) { gv[bj][n] = *(const f32x4*)(gg + col0 + bj * HALF + 4 * n); bv[bj][n] = *(const f32x4*)(bb + col0 + bj * HALF + 4 * n); } }
#pragma unroll
        for (int ai = 0; ai < 2; ++ai)
#pragma unroll
            for (int m = 0; m < 4; ++m) { const int row = row0 + ai * HALF + m * 16; const size_t off = (size_t)row * DM + col0;
                const f32x2 s2 = *(const f32x2*)(ST + 2 * (size_t)row); const float mean = s2[0], rstd = s2[1];
#pragma unroll
                for (int bj = 0; bj < 2; ++bj) { float* p = XP + off + bj * HALF; f32x4 p0, p1; unpack8(*(const u32x4*)(PP + off + bj * HALF), p0, p1);
                    const f32x4 x0 = (*(const f32x4*)p - mean) * rstd * gv[bj][0] + bv[bj][0], x1 = (*(const f32x4*)(p + 4) - mean) * rstd * gv[bj][1] + bv[bj][1];
                    *(f32x4*)p = x0 * ALPHA + sigm4(acc[ai][bj][m][0]) * p0; *(f32x4*)(p + 4) = x1 * ALPHA + sigm4(acc[ai][bj][m][1]) * p1; } asm volatile("" ::: "memory"); }
    }
};

template <class Epi, class Sched, bool ALIGN_EPI = false, bool SP2 = false>
__device__ __forceinline__ void gemm_phase(PG8_LAS unsigned char* lds, const Gemm g, const Sched& S, const Epi& E) {
    const int tid = tid_(), wid = __builtin_amdgcn_readfirstlane(tid >> 6), lane = tid & 63, wr = wid >> 2, wc = wid & 3, fr = lane & 15, fq = lane >> 4;
    int Kq = g.K; asm volatile("" : "+s"(Kq)); const int K = Kq, nt = K / BK;
    unsigned voffA[2], voffB[2];
#pragma unroll
    for (int i = 0; i < 2; ++i) { int R, C; stage_rc(tid * 16 + i * 8192, R, C); const int Rb = Epi::PERM ? ((R & ~31) + perm32(R & 31)) : R;
        voffA[i] = (unsigned)(R * K + C) * 2u; voffB[i] = (unsigned)(Rb * K + C) * 2u; }
    const size_t kstep = (size_t)(BK * 2);
    const size_t hstep = (size_t)HALF * K * 2;
    const size_t tstep = 2 * hstep;
    const unsigned ldsw = (unsigned)wid * 1024u;
    const int aoff = lds_byte(wr * 64 + fr, fq * 8), boff = lds_byte(wc * 32 + fr, fq * 8);
#define PG8_SA(b, h) (((b) * 2 + (h)) * HTB)
#define PG8_SB(b, h) ((4 + (b) * 2 + (h)) * HTB)
#define PG8_STAGE(bufoff, gbase, voff) do { _Pragma("unroll") for (int _i = 0; _i < 2; ++_i) \
        __builtin_amdgcn_global_load_lds((const unsigned*)((const char*)(gbase) + (voff)[_i]), (PG8_LAS unsigned*)(lds + (bufoff) + ldsw + _i * 8192), 16, 0, 0); } while (0)
#define PG8_LDA(dst, b, h) do { _Pragma("unroll") for (int m = 0; m < 4; ++m) _Pragma("unroll") for (int k = 0; k < 2; ++k) dst[m][k] = *(const PG8_LAS bf16x8*)(lds + PG8_SA(b, h) + aoff + m * 2048 + k * 1024); } while (0)
#define PG8_LDB(dst, b, h) do { _Pragma("unroll") for (int n = 0; n < 2; ++n) _Pragma("unroll") for (int k = 0; k < 2; ++k) dst[n][k] = *(const PG8_LAS bf16x8*)(lds + PG8_SB(b, h) + boff + n * 2048 + k * 1024); } while (0)
#define PG8_MMA(ai, bj, At, Bt) do { __builtin_amdgcn_s_setprio(1); _Pragma("unroll") for (int m = 0; m < 4; ++m) _Pragma("unroll") for (int n = 0; n < 2; ++n) _Pragma("unroll") for (int k = 0; k < 2; ++k) \
        acc[ai][bj][m][n] = __builtin_amdgcn_mfma_f32_16x16x32_bf16(Bt[n][k], At[m][k], acc[ai][bj][m][n], 0, 0, 0); __builtin_amdgcn_s_setprio(0); } while (0)
#define PG8_WAIT_V(n) asm volatile("s_waitcnt vmcnt(" #n ")" ::: "memory")
#define PG8_WAIT_L(n) asm volatile("s_waitcnt lgkmcnt(" #n ")" ::: "memory")
#define PG8_BAR __builtin_amdgcn_s_barrier()
#define PG8_SCHED __builtin_amdgcn_sched_barrier(0)
    Unit cur, nxt; int ui = 0;
    if (!S.next(0, cur)) return;
    f32x4 acc[2][2][4][2];
#pragma unroll
    for (int a = 0; a < 2; ++a)
#pragma unroll
        for (int b = 0; b < 2; ++b)
#pragma unroll
            for (int m = 0; m < 4; ++m)
#pragma unroll
                for (int n = 0; n < 2; ++n) acc[a][b][m][n] = (f32x4){0.f, 0.f, 0.f, 0.f};
    bf16x8 At[4][2], B0[2][2], B1[2][2];
    const char* cA = (const char*)g.A + (size_t)cur.pm * tstep; const char* cB = (const char*)g.Bt + (size_t)cur.pn * tstep;
    S.a_ready(cur);
    if constexpr (SP2) {
        PG8_STAGE(PG8_SB(0, 0), cB, voffB); PG8_STAGE(PG8_SB(0, 1), cB + hstep, voffB); PG8_STAGE(PG8_SA(0, 0), cA, voffA); PG8_STAGE(PG8_SA(0, 1), cA + hstep, voffA);
        if (wr == 1) PG8_BAR;
        PG8_WAIT_V(2); PG8_BAR;
        PG8_STAGE(PG8_SB(1, 0), cB + kstep, voffB); PG8_STAGE(PG8_SA(1, 0), cA + kstep, voffA); PG8_STAGE(PG8_SB(1, 1), cB + hstep + kstep, voffB);
        PG8_WAIT_V(6); PG8_BAR;
    } else {
        PG8_STAGE(PG8_SB(0, 0), cB, voffB); PG8_STAGE(PG8_SA(0, 0), cA, voffA); PG8_STAGE(PG8_SB(0, 1), cB + hstep, voffB); PG8_STAGE(PG8_SA(0, 1), cA + hstep, voffA);
        if (wr == 1) PG8_BAR;
        PG8_WAIT_V(4); PG8_BAR;
        PG8_STAGE(PG8_SB(1, 0), cB + kstep, voffB); PG8_STAGE(PG8_SA(1, 0), cA + kstep, voffA); PG8_STAGE(PG8_SB(1, 1), cB + hstep + kstep, voffB);
        PG8_WAIT_V(6); PG8_BAR;
    }
    for (;;) {
        const bool has_next = S.next(ui + 1, nxt);
        const char* nA = has_next ? (const char*)g.A + (size_t)nxt.pm * tstep : cA; const char* nB = has_next ? (const char*)g.Bt + (size_t)nxt.pn * tstep : cB;
        for (int t = 0; t < nt; t += 2) {
            const bool last = (t == nt - 2);
            const char* a1 = cA + (size_t)(t + 1) * kstep;
            const char* a2 = last ? nA : cA + (size_t)(t + 2) * kstep; const char* b2 = last ? nB : cB + (size_t)(t + 2) * kstep;
            const char* a3 = a2 + kstep; const char* b3 = b2 + kstep;
            if (last && has_next) S.a_ready(nxt);
            if constexpr (SP2) {
            PG8_LDB(B0, 0, 0); PG8_LDB(B1, 0, 1); PG8_SCHED; PG8_LDA(At, 0, 0); PG8_STAGE(PG8_SA(1, 1), a1 + hstep, voffA);
            PG8_WAIT_V(8); PG8_WAIT_L(0); PG8_BAR; PG8_MMA(0, 0, At, B0); PG8_MMA(0, 1, At, B1); PG8_BAR; PG8_SCHED;
            PG8_LDA(At, 0, 1); PG8_STAGE(PG8_SB(0, 0), b2, voffB); PG8_STAGE(PG8_SB(0, 1), b2 + hstep, voffB); PG8_STAGE(PG8_SA(0, 0), a2, voffA);
            PG8_WAIT_V(8); PG8_WAIT_L(0); PG8_BAR; PG8_MMA(1, 0, At, B0); PG8_MMA(1, 1, At, B1); PG8_BAR; PG8_SCHED;
            PG8_LDB(B0, 1, 0); PG8_LDB(B1, 1, 1); PG8_SCHED; PG8_LDA(At, 1, 0); PG8_STAGE(PG8_SA(0, 1), a2 + hstep, voffA);
            PG8_WAIT_V(8); PG8_WAIT_L(0); PG8_BAR; PG8_MMA(0, 0, At, B0); PG8_MMA(0, 1, At, B1); PG8_BAR; PG8_SCHED;
            PG8_LDA(At, 1, 1); PG8_STAGE(PG8_SB(1, 0), b3, voffB); PG8_STAGE(PG8_SB(1, 1), b3 + hstep, voffB); PG8_STAGE(PG8_SA(1, 0), a3, voffA);
            PG8_WAIT_V(8); PG8_WAIT_L(0); PG8_BAR; PG8_MMA(1, 0, At, B0); PG8_MMA(1, 1, At, B1); PG8_BAR; PG8_SCHED;
            } else {
            PG8_LDB(B0, 0, 0); PG8_SCHED; PG8_LDA(At, 0, 0); PG8_STAGE(PG8_SA(1, 1), a1 + hstep, voffA);
            PG8_WAIT_L(8); PG8_BAR; PG8_WAIT_L(0); PG8_MMA(0, 0, At, B0); PG8_BAR; PG8_SCHED;
            PG8_LDB(B1, 0, 1); PG8_STAGE(PG8_SB(0, 0), b2, voffB);
            PG8_BAR; PG8_WAIT_L(0); PG8_MMA(0, 1, At, B1); PG8_BAR;
            PG8_LDA(At, 0, 1); PG8_STAGE(PG8_SA(0, 0), a2, voffA);
            PG8_BAR; PG8_WAIT_L(0); PG8_MMA(1, 0, At, B0); PG8_BAR; PG8_SCHED;
            PG8_STAGE(PG8_SB(0, 1), b2 + hstep, voffB);
            PG8_WAIT_V(6); PG8_BAR; PG8_MMA(1, 1, At, B1); PG8_BAR;
            PG8_LDB(B0, 1, 0); PG8_SCHED; PG8_LDA(At, 1, 0); PG8_STAGE(PG8_SA(0, 1), a2 + hstep, voffA);
            PG8_WAIT_L(8); PG8_BAR; PG8_WAIT_L(0); PG8_MMA(0, 0, At, B0); PG8_BAR; PG8_SCHED;
            PG8_LDB(B1, 1, 1); PG8_STAGE(PG8_SB(1, 0), b3, voffB);
            PG8_BAR; PG8_WAIT_L(0); PG8_MMA(0, 1, At, B1); PG8_BAR;
            PG8_LDA(At, 1, 1); PG8_STAGE(PG8_SA(1, 0), a3, voffA);
            PG8_BAR; PG8_WAIT_L(0); PG8_MMA(1, 0, At, B0); PG8_BAR; PG8_SCHED;
            PG8_STAGE(PG8_SB(1, 1), b3 + hstep, voffB);
            PG8_WAIT_V(6); PG8_BAR; PG8_MMA(1, 1, At, B1); PG8_BAR;
            }
        }
        if constexpr (ALIGN_EPI) { if (wr == 0) PG8_BAR; }
        if constexpr (!Epi::AFTER_DRAIN) { E(acc, cur, wr, wc, fr, fq); S.done(cur); }
        if (!has_next) break;
#pragma unroll
        for (int a = 0; a < 2; ++a)
#pragma unroll
            for (int b = 0; b < 2; ++b)
#pragma unroll
                for (int m = 0; m < 4; ++m)
#pragma unroll
                    for (int n = 0; n < 2; ++n) acc[a][b][m][n] = (f32x4){0.f, 0.f, 0.f, 0.f};
        cur = nxt; cA = nA; cB = nB; ++ui;
        if constexpr (ALIGN_EPI) { if (wr == 1) PG8_BAR; }
    }
    PG8_WAIT_V(0);
    if constexpr (!ALIGN_EPI) { if (wr == 0) PG8_BAR; }
    PG8_BAR;
    if constexpr (Epi::AFTER_DRAIN) { E.fused(acc, cur, wr, wc, fr, fq, lds, wid, lane); S.done(cur); }
#undef PG8_SA
#undef PG8_SB
#undef PG8_STAGE
#undef PG8_LDA
#undef PG8_LDB
#undef PG8_MMA
#undef PG8_WAIT_V
#undef PG8_WAIT_L
#undef PG8_BAR
#undef PG8_SCHED
}
}
#define XB_TMO      128
#define XB_XCNT(j)  (256  + 64 * (j))
#define XB_XSUB(j)  (1280 + 64 * (j))
#define XB_XGEN(j)  (2304 + 64 * (j))
#define XB_TOP      3328
#define XB_TOPGEN   3392
#define XCD_BAR_WORDS 3456
#define XB_SPIN_CAP (1u << 18)
#define LAS __attribute__((address_space(3)))

__device__ __forceinline__ unsigned xb_ld(unsigned* p)              { return __hip_atomic_load(p, __ATOMIC_RELAXED, __HIP_MEMORY_SCOPE_AGENT); }
__device__ __forceinline__ unsigned xb_add(unsigned* p, unsigned v) { return __hip_atomic_fetch_add(p, v, __ATOMIC_RELAXED, __HIP_MEMORY_SCOPE_AGENT); }
__device__ __forceinline__ unsigned xb_xcc_id() { return (unsigned)__builtin_amdgcn_s_getreg((3 << 11) | 20) & 0xFu; }
#define XB_SPIN(cond, bar) do { unsigned _sp = 0; while (cond) { __builtin_amdgcn_s_sleep(1); \
    if ((++_sp & 255u) == 0u) { if (xb_ld(&(bar)[XB_TMO])) break; if (_sp > XB_SPIN_CAP) { atomicAdd(&(bar)[XB_TMO], 1u); break; } } } } while (0)

struct XcdBarrier {
    unsigned* bar; unsigned x;
    volatile LAS unsigned* st;
};

__device__ __forceinline__ XcdBarrier xcd_barrier_post(unsigned* bar, volatile LAS unsigned* st) {
    XcdBarrier b; b.bar = bar; b.x = xb_xcc_id(); b.st = st;
    if (threadIdx.x == 0) (void)xb_add(&bar[XB_XCNT(b.x)], 1u);
    return b;
}
__device__ __forceinline__ void xcd_barrier_complete(unsigned* bar, unsigned x, unsigned& nloc, unsigned& nx) {
    const unsigned G = gridDim.x * gridDim.y * gridDim.z;
    unsigned sum, cnt, mine, sp = 0u;
    for (;;) {
        sum = 0u; cnt = 0u; mine = 0u;
#pragma unroll
        for (unsigned j = 0; j < 16; ++j) { const unsigned c = xb_ld(&bar[XB_XCNT(j)]); sum += c; cnt += (c > 0u) ? 1u : 0u; mine = (j == x) ? c : mine; }
        if (sum == G) break;
        __builtin_amdgcn_s_sleep(1);
        if ((++sp & 255u) == 0u) { if (xb_ld(&bar[XB_TMO])) break; if (sp > XB_SPIN_CAP) { atomicAdd(&bar[XB_TMO], 1u); break; } }
    }
    nloc = mine > 0u ? mine : 1u; nx = cnt > 0u ? cnt : 1u;
}

__device__ __forceinline__ void xcd_barrier(const XcdBarrier& b) {
    asm volatile("s_waitcnt vmcnt(0)" ::: "memory");
    __syncthreads();
    if (threadIdx.x == 0) {
        unsigned* bar = b.bar;
        __builtin_amdgcn_s_waitcnt(0);
        const unsigned bx = xb_xcc_id();
        unsigned nloc = b.st[0], nx = b.st[1];
        if (nloc == 0u) { xcd_barrier_complete(bar, bx, nloc, nx); b.st[0] = nloc; b.st[1] = nx; }
        const unsigned old = xb_add(&bar[XB_XSUB(bx)], 1u);
        const unsigned gen = old / nloc;
        if (old + 1u == (gen + 1u) * nloc) {
            __builtin_amdgcn_fence(__ATOMIC_RELEASE, "agent");
            asm volatile("s_waitcnt vmcnt(0)" ::: "memory");
            const unsigned og = xb_add(&bar[XB_TOP], 1u);
            const unsigned tg = og / nx;
            if (og + 1u == (tg + 1u) * nx) xb_add(&bar[XB_TOPGEN], 1u);
            else XB_SPIN(xb_ld(&bar[XB_TOPGEN]) == tg, bar);
            __builtin_amdgcn_fence(__ATOMIC_ACQUIRE, "agent");
            xb_add(&bar[XB_XGEN(bx)], 1u);
            asm volatile("s_waitcnt vmcnt(0)" ::: "memory");
        } else {
            XB_SPIN(xb_ld(&bar[XB_XGEN(bx)]) == gen, bar);
            __builtin_amdgcn_fence(__ATOMIC_ACQUIRE, "agent");
            asm volatile("s_waitcnt vmcnt(0)" ::: "memory");
        }
    }
    __syncthreads();
}

struct Params {
    const float* x; const float* p; const int* pos;
    const float *w_in, *w_a, *w_b, *w_out, *lbraw, *hnorm_g, *ikn_g, *ikn_b, *lnm_g, *lnm_b, *w_fg, *w_fu, *w_fd, *lnf_g, *lnf_b, *w_pg, *w_pp, *lnp_g, *lnp_b;
    float* out; unsigned char* ws;
    double invf_h[64]; double invf_i[32];
    int ph_lo, ph_hi;
};
typedef const __attribute__((address_space(4))) Params* KP;
__device__ __forceinline__ KP kparams() { KP p = (KP)__builtin_amdgcn_kernarg_segment_ptr(); asm volatile("" : "+s"(p)); return p; }
constexpr int NPH_LAYER = 14, NPH = DEPTH * NPH_LAYER;
constexpr int LDS_BYTES = 131072 + 1024;
constexpr int MISC_OFF = 131072;

__device__ __forceinline__ int wsrc_col_in(int n) {
    const int tile = n >> 8, t = n & 255;
    if (tile < 16) return n;
    if (tile < 24) { const int bj = t >> 7, u = t & 127, head = u >> 6, i = u & 63; return tile * 256 + 128 * head + 64 * bj + i; }
    if (tile < 28) return n;
    if (tile < 32) { const int bj = t >> 7, u = t & 127, head = u >> 5, i = u & 31; return tile * 256 + 64 * head + 32 * bj + i; }
    if (tile < 40) return 8272 + (n - 32 * 256);
    if (tile < 48) return 10320 + (n - 40 * 256);
    return t < 80 ? 8192 + t : -1;
}
constexpr int WC_LD = 144;
template <int KIND>
__device__ __forceinline__ void wconv_wave_tile(const float* src, const float* src2, int nsrc, int K, bf16_t* dst, int n0, int k0, int lane, LAS unsigned char* img) {
    const int n = n0 + lane; int c; const float* s = src;
    if (KIND == 0) c = n;
    else if (KIND == 1) c = wsrc_col_in(n);
    else { const int tl = n >> 8, t = n & 255; c = tl * 128 + (t & 127); if (t >= 128) s = src2; }
    float f[64];
    const float* sp = s + (size_t)k0 * nsrc + (c >= 0 ? c : 0);
#pragma unroll
    for (int kk = 0; kk < 64; ++kk) f[kk] = sp[(size_t)kk * nsrc];
#pragma unroll
    for (int i = 0; i < 8; ++i) { pg8::u32x4 w;
        w.x = pg8::cvt_pk_bf16(f[8 * i], f[8 * i + 1]); w.y = pg8::cvt_pk_bf16(f[8 * i + 2], f[8 * i + 3]); w.z = pg8::cvt_pk_bf16(f[8 * i + 4], f[8 * i + 5]); w.w = pg8::cvt_pk_bf16(f[8 * i + 6], f[8 * i + 7]);
        if (c < 0) w = (pg8::u32x4){0u, 0u, 0u, 0u};
        *(LAS pg8::u32x4*)(img + lane * WC_LD + 16 * i) = w; }
#pragma unroll
    for (int i = 0; i < 8; ++i) { const int p = lane + 64 * i, row = p >> 3, seg = p & 7;
        const pg8::u32x4 w = *(const LAS pg8::u32x4*)(img + row * WC_LD + 16 * seg);
        *(pg8::u32x4*)(dst + (size_t)(n0 + row) * K + k0 + 8 * seg) = w; }
}
template <int KIND>
__device__ __forceinline__ void wconv_job(const float* src, const float* src2, int nsrc, int K, bf16_t* dst, int ndst, int W, int NWV, int lane, LAS unsigned char* img, int& tcount) {
    const int kt = K / 64, ntiles = (ndst / 64) * kt;
    const int nb = ndst / 64; int first = (W - tcount % NWV + NWV) % NWV;
    for (int t = first; t < ntiles; t += NWV) wconv_wave_tile<KIND>(src, src2, nsrc, K, dst, (t % nb) * 64, (t / nb) * 64, lane, img);
    tcount += ntiles;
}
__device__ __forceinline__ void phase_wconv(KP P, int layer, LAS unsigned char* lds) {
    unsigned char* ws = as_global(P->ws); int tc = 0;
    const int tid0 = tid_(), lane = tid0 & 63, wv0 = __builtin_amdgcn_readfirstlane(tid0 >> 6), W = bid_() * 8 + wv0, NWV = nblk_() * 8;
    LAS unsigned char* img = lds + wv0 * (64 * WC_LD);
    wconv_job<1>(as_global(P->w_in) + (size_t)layer * DM * INW, nullptr, INW, DM, (bf16_t*)(ws + WS_WIN), INP, W, NWV, lane, img, tc);
    wconv_job<0>(as_global(P->w_a) + (size_t)layer * AW * DM, nullptr, DM, AW, (bf16_t*)(ws + WS_WA), DM, W, NWV, lane, img, tc);
    wconv_job<0>(as_global(P->w_b) + (size_t)layer * BW * DM, nullptr, DM, BW, (bf16_t*)(ws + WS_WB), DM, W, NWV, lane, img, tc);
    wconv_job<0>(as_global(P->w_out) + (size_t)layer * DM * DM, nullptr, DM, DM, (bf16_t*)(ws + WS_WO), DM, W, NWV, lane, img, tc);
    wconv_job<2>(as_global(P->w_fg) + (size_t)layer * DM * DFF, as_global(P->w_fu) + (size_t)layer * DM * DFF, DFF, DM, (bf16_t*)(ws + WS_WGU), 2 * DFF, W, NWV, lane, img, tc);
    wconv_job<0>(as_global(P->w_fd) + (size_t)layer * DFF * DM, nullptr, DM, DFF, (bf16_t*)(ws + WS_WDN), DM, W, NWV, lane, img, tc);
    wconv_job<0>(as_global(P->w_pg) + (size_t)layer * DM * DM, nullptr, DM, DM, (bf16_t*)(ws + WS_WPG), DM, W, NWV, lane, img, tc);
    wconv_job<0>(as_global(P->w_pp) + (size_t)layer * PLE * DM, nullptr, DM, PLE, (bf16_t*)(ws + WS_WPP), DM, W, NWV, lane, img, tc);
    const float* ps = as_global(P->p) + (size_t)layer * TOK * PLE; bf16_t* pb = (bf16_t*)(ws + WS_PB);
    for (size_t i = ((size_t)bid_() * 512 + tid_()) * 8; i < (size_t)TOK * PLE; i += (size_t)nblk_() * 512 * 8)
        *(pg8::u32x4*)(pb + i) = pg8::pack8(*(const pg8::f32x4*)(ps + i), *(const pg8::f32x4*)(ps + i + 4));
}
__device__ __forceinline__ void phase_prologue(KP P) {
    unsigned char* ws = as_global(P->ws); const size_t gtid = (size_t)bid_() * 512 + tid_(), gsz = (size_t)nblk_() * 512;
    bf16_t* xb = (bf16_t*)(ws + WS_XB); const float* xin = as_global(P->x); const int* posg = as_global(P->pos); const float* lbr = as_global(P->lbraw);
    for (size_t i = gtid * 8; i < (size_t)TOK * DM; i += gsz * 8) *(pg8::u32x4*)(xb + i) = pg8::pack8(*(const pg8::f32x4*)(xin + i), *(const pg8::f32x4*)(xin + i + 4));
    float* ch = (float*)(ws + WS_COSH); float* sh = (float*)(ws + WS_SINH); float* ci = (float*)(ws + WS_COSI); float* si = (float*)(ws + WS_SINI);
    for (size_t i = gtid; i < (size_t)TOK * 64; i += gsz) { const int t = (int)(i >> 6), j = (int)(i & 63); const double rev = (double)posg[t] * P->invf_h[j]; const float fr = (float)(rev - rint(rev));
        ch[i] = __builtin_amdgcn_cosf(fr); sh[i] = __builtin_amdgcn_sinf(fr); }
    for (size_t i = gtid; i < (size_t)TOK * 32; i += gsz) { const int t = (int)(i >> 5), j = (int)(i & 31); const double rev = (double)posg[t] * P->invf_i[j]; const float fr = (float)(rev - rint(rev));
        ci[i] = __builtin_amdgcn_cosf(fr); si[i] = __builtin_amdgcn_sinf(fr); }
    float* lb = (float*)(ws + WS_LB);
    for (size_t c = gtid; c < 1024; c += gsz) { float v[4], mx = -1e30f; for (int l = 0; l < 4; ++l) { v[l] = lbr[l * 1024 + c]; mx = fmaxf(mx, v[l]); }
        float s = 0.f; for (int l = 0; l < 4; ++l) { v[l] = expf(v[l] - mx); s += v[l]; }
        float cum = 0.f; const float inv = 1.0f / s; for (int l = 0; l < 4; ++l) { cum += v[l] * inv; lb[l * 1024 + c] = cum - v[0] * inv; } }
}
__device__ __forceinline__ void phase_ln(const float* XP, float* OUT, bf16_t* XB, float* ST, const float* g, const float* b) {
    const int tid = tid_(), wave = __builtin_amdgcn_readfirstlane(tid >> 6), lane = tid & 63, nb16 = nblk_() * 16;
    for (int row0 = bid_() * 16 + 2 * wave; row0 < TOK; row0 += nb16) {
        pg8::f32x4 v[2][8]; float s[2] = {0.f, 0.f};
#pragma unroll
        for (int rr = 0; rr < 2; ++rr)
#pragma unroll
            for (int c = 0; c < 8; ++c) v[rr][c] = *(const pg8::f32x4*)(XP + (size_t)(row0 + rr) * DM + c * 256 + lane * 4);
#pragma unroll
        for (int rr = 0; rr < 2; ++rr) {
#pragma unroll
            for (int c = 0; c < 8; ++c) s[rr] += (v[rr][c][0] + v[rr][c][1]) + (v[rr][c][2] + v[rr][c][3]);
#pragma unroll
            for (int o = 32; o >= 1; o >>= 1) s[rr] += __shfl_xor(s[rr], o); }
#pragma unroll
        for (int rr = 0; rr < 2; ++rr) { const int row = row0 + rr;
            const float mean = s[rr] * (1.0f / DM); float q = 0.f;
#pragma unroll
            for (int c = 0; c < 8; ++c) { v[rr][c] = v[rr][c] - mean; q += (v[rr][c][0] * v[rr][c][0] + v[rr][c][1] * v[rr][c][1]) + (v[rr][c][2] * v[rr][c][2] + v[rr][c][3] * v[rr][c][3]); }
#pragma unroll
            for (int o = 32; o >= 1; o >>= 1) q += __shfl_xor(q, o);
            const float rstd = 1.0f / sqrtf(q * (1.0f / DM) + LN_EPS);
            if (lane == 0) { pg8::f32x2 s2; s2[0] = mean; s2[1] = rstd; *(pg8::f32x2*)(ST + 2 * (size_t)row) = s2; }
#pragma unroll
            for (int c = 0; c < 8; ++c) { const int col = c * 256 + lane * 4; const pg8::f32x4 gg = *(const pg8::f32x4*)(g + col), bb = *(const pg8::f32x4*)(b + col);
                const pg8::f32x4 y = v[rr][c] * rstd * gg + bb; if (OUT) *(pg8::f32x4*)(OUT + (size_t)row * DM + col) = y;
                pg8::u32x2 w; w.x = pg8::cvt_pk_bf16(y[0], y[1]); w.y = pg8::cvt_pk_bf16(y[2], y[3]); *(pg8::u32x2*)(XB + (size_t)row * DM + col) = w; } }
    }
}
__device__ __forceinline__ void phase_ikprep(KP P, int layer) {
    unsigned char* ws = as_global(P->ws); const float* ikw = (const float*)(ws + WS_IKW); bf16_t* ki = (bf16_t*)(ws + WS_KI); float* wi = (float*)(ws + WS_WI);
    const float* ci = (const float*)(ws + WS_COSI); const float* si = (const float*)(ws + WS_SINI);
    const int tid = tid_(), wave = __builtin_amdgcn_readfirstlane(tid >> 6), lane = tid & 63, nb8 = nblk_() * 8;
    const float g = as_global(P->ikn_g)[layer * 64 + lane], b = as_global(P->ikn_b)[layer * 64 + lane];
    for (int t = bid_() * 8 + wave; t < TOK; t += nb8) {
        const float x = ikw[(size_t)t * 128 + lane]; float s = x;
#pragma unroll
        for (int o = 32; o >= 1; o >>= 1) s += __shfl_xor(s, o);
        const float mean = s * (1.0f / 64.0f), xc = x - mean; float q = xc * xc;
#pragma unroll
        for (int o = 32; o >= 1; o >>= 1) q += __shfl_xor(q, o);
        const float y = xc * (1.0f / sqrtf(q * (1.0f / 64.0f) + LN_EPS)) * g + b;
        const float other = __shfl_xor(y, 32); const int j = lane & 31; const float c = ci[(size_t)t * 32 + j], sn = si[(size_t)t * 32 + j];
        const float r = (lane < 32) ? (y * c - other * sn) : (other * sn + y * c);
        ki[(size_t)t * 64 + lane] = f2bf(r);
        if (lane < 16) wi[(size_t)t * 16 + lane] = ikw[(size_t)t * 128 + 64 + lane] * IDX_SCALE;
    }
}
typedef short bf16x8_t __attribute__((ext_vector_type(8)));
typedef short bf16x4_t __attribute__((ext_vector_type(4)));
typedef float f32x16_t __attribute__((ext_vector_type(16)));
constexpr int CUM_LD = 132;
constexpr int OPK_LD = 136;
constexpr int OPS_LD = 72;

__device__ __forceinline__ void hgrn_scan_load(const float* LF, int tok0, int h, int tid, float (&v)[16]) {
    const int k = tid & 127, qd = tid >> 7;
#pragma unroll
    for (int i = 0; i < 16; ++i) v[i] = LF[(size_t)(tok0 + qd * 16 + i) * 1024 + h * 128 + k];
}
__device__ __forceinline__ void hgrn_scan_cum(float (&v)[16], LAS float* cum, LAS float* tot, int tid) {
    const int k = tid & 127, qd = tid >> 7;
    float run = 0.f;
#pragma unroll
    for (int i = 0; i < 16; ++i) { run += v[i]; v[i] = run; }
    tot[qd * 128 + k] = run;
    __syncthreads();
    float off = 0.f;
#pragma unroll
    for (int q = 0; q < 3; ++q) off += (q < qd) ? tot[q * 128 + k] : 0.f;
#pragma unroll
    for (int i = 0; i < 16; ++i) cum[(qd * 16 + i) * CUM_LD + k] = v[i] + off;
    __syncthreads();
}

struct H1Pre { float lf[16]; unsigned ka[8], va[8]; };
__device__ __forceinline__ void h1_load(const bf16_t* KA, const bf16_t* VA, const float* LF, int unit, int tid, H1Pre& p) {
    const int c = unit & 63, h = (unit >> 6) & 7, b = unit >> 9, tok0 = b * SEQ + c * 64;
    hgrn_scan_load(LF, tok0, h, tid, p.lf);
#pragma unroll
    for (int it = 0; it < 8; ++it) { const int idx = tid + 512 * it, k = idx & 127, s = 2 * (idx >> 7); const size_t g0 = (size_t)(tok0 + s) * 1024 + h * 128 + k;
        p.ka[it] = (unsigned)KA[g0] | ((unsigned)KA[g0 + 1024] << 16); p.va[it] = (unsigned)VA[g0] | ((unsigned)VA[g0 + 1024] << 16); }
}
__device__ __forceinline__ void phase_hgrn_h1(KP P, LAS unsigned char* lds) {
    unsigned char* ws = as_global(P->ws);
    const bf16_t* KA = (const bf16_t*)(ws + WS_KA); const bf16_t* VA = (const bf16_t*)(ws + WS_VA); const float* LF = (const float*)(ws + WS_LF);
    bf16_t* LT = (bf16_t*)(ws + WS_LT); float* DEC = (float*)(ws + WS_DEC);
    const int tid = tid_(), lane = tid & 63, wave = __builtin_amdgcn_readfirstlane(tid >> 6), r = lane & 31, hh = lane >> 5, G = nblk_();
    LAS float* cum = (LAS float*)lds; LAS float* tot = cum + 64 * CUM_LD;
    LAS bf16_t* kdT = (LAS bf16_t*)(tot + 512); LAS bf16_t* vT = kdT + 128 * OPS_LD;
    constexpr int NU = NBATCH * AH * 64;
    H1Pre pre; int unit = bid_();
    if (unit < NU) h1_load(KA, VA, LF, unit, tid, pre);
    for (; unit < NU; unit += G) {
        hgrn_scan_cum(pre.lf, cum, tot, tid);
#pragma unroll
        for (int it = 0; it < 8; ++it) { const int idx = tid + 512 * it, k = idx & 127, sp = idx >> 7, s = 2 * sp;
            const float last = cum[63 * CUM_LD + k];
            const float k0 = __uint_as_float(pre.ka[it] << 16) * __expf(last - cum[s * CUM_LD + k]), k1 = __uint_as_float(pre.ka[it] & 0xffff0000u) * __expf(last - cum[(s + 1) * CUM_LD + k]);
            *(LAS unsigned*)(kdT + k * OPS_LD + s) = pg8::cvt_pk_bf16(k0, k1);
            *(LAS unsigned*)(vT + k * OPS_LD + s) = pre.va[it]; }
        if (tid < 128) DEC[(size_t)unit * 128 + tid] = __expf(cum[63 * CUM_LD + tid]);
        if (unit + G < NU) h1_load(KA, VA, LF, unit + G, tid, pre);
        __syncthreads();
        const int mb = wave >> 1, nb0 = (wave & 1) * 2;
        f32x16_t acc[2];
#pragma unroll
        for (int n = 0; n < 2; ++n)
#pragma unroll
            for (int i = 0; i < 16; ++i) acc[n][i] = 0.f;
#pragma unroll
        for (int ks = 0; ks < 4; ++ks) { const bf16x8_t a = *(const LAS bf16x8_t*)(kdT + (32 * mb + r) * OPS_LD + 16 * ks + 8 * hh);
#pragma unroll
            for (int n = 0; n < 2; ++n) { const bf16x8_t bb = *(const LAS bf16x8_t*)(vT + (32 * (nb0 + n) + r) * OPS_LD + 16 * ks + 8 * hh);
                acc[n] = __builtin_amdgcn_mfma_f32_32x32x16_bf16(a, bb, acc[n], 0, 0, 0); } }
#pragma unroll
        for (int n = 0; n < 2; ++n) { bf16_t* dst = LT + (size_t)unit * 16384 + (size_t)(32 * (nb0 + n) + r) * 128 + 32 * mb + 4 * hh;
#pragma unroll
            for (int g = 0; g < 4; ++g) { pg8::u32x2 o; o.x = pg8::cvt_pk_bf16(acc[n][4 * g], acc[n][4 * g + 1]); o.y = pg8::cvt_pk_bf16(acc[n][4 * g + 2], acc[n][4 * g + 3]); *(pg8::u32x2*)(dst + 8 * g) = o; } }
        __syncthreads();
    }
}

__device__ __forceinline__ void phase_hgrn_h2(KP P) {
    unsigned char* ws = as_global(P->ws);
    const bf16_t* LT = (const bf16_t*)(ws + WS_LT); const float* DEC = (const float*)(ws + WS_DEC); bf16_t* PT = (bf16_t*)(ws + WS_PT);
    const int tid = tid_(), G = nblk_();
    for (int oct = bid_() * 512 + tid; oct < NBATCH * AH * 2048; oct += G * 512) {
        const int bh = oct >> 11, rem = oct & 2047, v = rem >> 4, k0 = (rem & 15) * 8;
        const size_t e0 = (size_t)bh * 64 * 16384 + (size_t)v * 128 + k0; const size_t d0 = (size_t)bh * 64 * 128 + k0;
        pg8::f32x4 S0 = {0.f, 0.f, 0.f, 0.f}, S1 = {0.f, 0.f, 0.f, 0.f};
        for (int c0 = 0; c0 < 64; c0 += 4) { pg8::u32x4 Lc[4]; pg8::f32x4 Da[4], Db[4];
#pragma unroll
            for (int j = 0; j < 4; ++j) { Lc[j] = *(const pg8::u32x4*)(LT + e0 + (size_t)(c0 + j) * 16384); Da[j] = *(const pg8::f32x4*)(DEC + d0 + (size_t)(c0 + j) * 128); Db[j] = *(const pg8::f32x4*)(DEC + d0 + (size_t)(c0 + j) * 128 + 4); }
#pragma unroll
            for (int j = 0; j < 4; ++j) { *(pg8::u32x4*)(PT + e0 + (size_t)(c0 + j) * 16384) = pg8::pack8(S0, S1);
                pg8::f32x4 l0, l1; pg8::unpack8(Lc[j], l0, l1); S0 = Da[j] * S0 + l0; S1 = Db[j] * S1 + l1; } }
    }
}

struct H3Pre { float lf[16]; unsigned qw[8], kw[8], vv[8]; bf16x8_t pt[8]; pg8::u32x2 ga[4]; };
__device__ __forceinline__ void h3_load(const bf16_t* QA, const bf16_t* KA, const bf16_t* VA, const bf16_t* GA, const float* LF, const bf16_t* PT, int unit, int tid, H3Pre& p) {
    const int c = unit & 63, h = (unit >> 6) & 7, b = unit >> 9, tok0 = b * SEQ + c * 64;
    const int lane = tid & 63, wave = __builtin_amdgcn_readfirstlane(tid >> 6), r = lane & 31, hh = lane >> 5, mb = wave >> 1, tb = wave & 1;
    hgrn_scan_load(LF, tok0, h, tid, p.lf);
#pragma unroll
    for (int it = 0; it < 8; ++it) { const int idx = tid + 512 * it, kp = (idx & 63) * 2, t = idx >> 6; const size_t g0 = (size_t)(tok0 + t) * 1024 + h * 128 + kp;
        p.qw[it] = *(const unsigned*)(QA + g0); p.kw[it] = *(const unsigned*)(KA + g0); }
#pragma unroll
    for (int it = 0; it < 8; ++it) { const int idx = tid + 512 * it, v = idx & 127, s = 2 * (idx >> 7); const size_t g0 = (size_t)(tok0 + s) * 1024 + h * 128 + v;
        p.vv[it] = (unsigned)VA[g0] | ((unsigned)VA[g0 + 1024] << 16); }
    const bf16_t* prow = PT + (size_t)unit * 16384 + (size_t)(32 * mb + r) * 128 + 8 * hh;
#pragma unroll
    for (int k8 = 0; k8 < 8; ++k8) p.pt[k8] = *(const bf16x8_t*)(prow + 16 * k8);
    const size_t orow = (size_t)(tok0 + 32 * tb + r) * 1024 + h * 128;
#pragma unroll
    for (int g = 0; g < 4; ++g) p.ga[g] = *(const pg8::u32x2*)(GA + orow + 32 * mb + 8 * g + 4 * hh);
}
__device__ __forceinline__ void phase_hgrn_h3(KP P, int layer, LAS unsigned char* lds) {
    unsigned char* ws = as_global(P->ws);
    const bf16_t* QA = (const bf16_t*)(ws + WS_QA); const bf16_t* KA = (const bf16_t*)(ws + WS_KA); const bf16_t* VA = (const bf16_t*)(ws + WS_VA); const bf16_t* GA = (const bf16_t*)(ws + WS_GA);
    const float* LF = (const float*)(ws + WS_LF); const bf16_t* PT = (const bf16_t*)(ws + WS_PT); bf16_t* YA = (bf16_t*)(ws + WS_YA);
    const float* ng = as_global(P->hnorm_g) + layer * 128;
    const int tid = tid_(), lane = tid & 63, wave = __builtin_amdgcn_readfirstlane(tid >> 6), r = lane & 31, hh = lane >> 5, G = nblk_();
    LAS float* cum = (LAS float*)lds; LAS float* tot = cum + 64 * CUM_LD; LAS float* ssq = tot + 512;
    LAS bf16_t* qd = (LAS bf16_t*)(ssq + 256); LAS bf16_t* qs = qd + 64 * OPK_LD; LAS bf16_t* ks = qs + 64 * OPK_LD; LAS bf16_t* vT = ks + 64 * OPK_LD;
    constexpr int NU = NBATCH * AH * 64;
    const int mb = wave >> 1, tb = wave & 1;
    H3Pre pre; int unit = bid_();
    if (unit < NU) h3_load(QA, KA, VA, GA, LF, PT, unit, tid, pre);
    for (; unit < NU; unit += G) {
        const int c = unit & 63, h = (unit >> 6) & 7, b = unit >> 9, tok0 = b * SEQ + c * 64;
#ifdef H3_DUP_SCAN
        { float tmp[16];
#pragma unroll
          for (int i = 0; i < 16; ++i) tmp[i] = pre.lf[i];
          hgrn_scan_cum(tmp, cum, tot, tid); }
#endif
        hgrn_scan_cum(pre.lf, cum, tot, tid);
#ifdef H3_DUP_BUILD
        for (int rep_b = 0; rep_b < 2; ++rep_b) {
#else
        {
#endif
#pragma unroll
        for (int it = 0; it < 8; ++it) { const int idx = tid + 512 * it, kp = (idx & 63) * 2, t = idx >> 6;
            const unsigned qw = pre.qw[it], kw = pre.kw[it];
            const float c0 = cum[t * CUM_LD + kp], c1 = cum[t * CUM_LD + kp + 1], r0 = cum[31 * CUM_LD + kp], r1 = cum[31 * CUM_LD + kp + 1];
            const float q0 = __uint_as_float(qw << 16), q1 = __uint_as_float(qw & 0xffff0000u), k0 = __uint_as_float(kw << 16), k1 = __uint_as_float(kw & 0xffff0000u);
            *(LAS unsigned*)(qd + t * OPK_LD + kp) = pg8::cvt_pk_bf16(q0 * __expf(c0), q1 * __expf(c1));
            *(LAS unsigned*)(qs + t * OPK_LD + kp) = pg8::cvt_pk_bf16(q0 * __expf(c0 - r0), q1 * __expf(c1 - r1));
            *(LAS unsigned*)(ks + t * OPK_LD + kp) = pg8::cvt_pk_bf16(k0 * __expf(r0 - c0), k1 * __expf(r1 - c1)); }
#pragma unroll
        for (int it = 0; it < 8; ++it) { const int idx = tid + 512 * it, v = idx & 127, s = 2 * (idx >> 7); *(LAS unsigned*)(vT + v * OPS_LD + s) = pre.vv[it]; }
        }
        bf16x8_t ptc[8]; pg8::u32x2 gac[4];
#pragma unroll
        for (int k8 = 0; k8 < 8; ++k8) ptc[k8] = pre.pt[k8];
#pragma unroll
        for (int g = 0; g < 4; ++g) gac[g] = pre.ga[g];
        if (unit + G < NU) h3_load(QA, KA, VA, GA, LF, PT, unit + G, tid, pre);
        __syncthreads();
        f32x16_t acc;
#ifdef H3_DUP_MMA
        for (int rep_m = 0; rep_m < 2; ++rep_m) {
#else
        {
#endif
#pragma unroll
        for (int i = 0; i < 16; ++i) acc[i] = 0.f;
#pragma unroll
        for (int k8 = 0; k8 < 8; ++k8) { const bf16x8_t bq = *(const LAS bf16x8_t*)(qd + (32 * tb + r) * OPK_LD + 16 * k8 + 8 * hh);
            acc = __builtin_amdgcn_mfma_f32_32x32x16_bf16(ptc[k8], bq, acc, 0, 0, 0); }
#pragma unroll
        for (int sb = 0; sb < 2; ++sb) if (sb <= tb) {
            f32x16_t sc;
#pragma unroll
            for (int i = 0; i < 16; ++i) sc[i] = 0.f;
#pragma unroll
            for (int k8 = 0; k8 < 8; ++k8) { const bf16x8_t a = *(const LAS bf16x8_t*)(ks + (32 * sb + r) * OPK_LD + 16 * k8 + 8 * hh); const bf16x8_t bq = *(const LAS bf16x8_t*)(qs + (32 * tb + r) * OPK_LD + 16 * k8 + 8 * hh);
                sc = __builtin_amdgcn_mfma_f32_32x32x16_bf16(a, bq, sc, 0, 0, 0); }
            if (sb == tb) {
#pragma unroll
                for (int i = 0; i < 16; ++i) { const int sl = 8 * (i >> 2) + 4 * hh + (i & 3); sc[i] = (sl <= r) ? sc[i] : 0.f; } }
#pragma unroll
            for (int u = 0; u < 2; ++u) {
                pg8::u32x4 pw; pw.x = pg8::cvt_pk_bf16(sc[8 * u], sc[8 * u + 1]); pw.y = pg8::cvt_pk_bf16(sc[8 * u + 2], sc[8 * u + 3]); pw.z = pg8::cvt_pk_bf16(sc[8 * u + 4], sc[8 * u + 5]); pw.w = pg8::cvt_pk_bf16(sc[8 * u + 6], sc[8 * u + 7]);
                const bf16x8_t pb = __builtin_bit_cast(bf16x8_t, pw);
                const LAS bf16_t* vrow = vT + (32 * mb + r) * OPS_LD + 32 * sb + 16 * u + 4 * hh;
                const bf16x4_t lo = *(const LAS bf16x4_t*)vrow, hi4 = *(const LAS bf16x4_t*)(vrow + 8);
                const bf16x8_t va = {lo[0], lo[1], lo[2], lo[3], hi4[0], hi4[1], hi4[2], hi4[3]};
                acc = __builtin_amdgcn_mfma_f32_32x32x16_bf16(va, pb, acc, 0, 0, 0); }
        }
        }
        float ss = 0.f;
#pragma unroll
        for (int i = 0; i < 16; ++i) ss += acc[i] * acc[i];
        ss += __shfl_xor(ss, 32);
        if (hh == 0) ssq[mb * 64 + 32 * tb + r] = ss;
        __syncthreads();
        const int t = 32 * tb + r;
        const float tot2 = (ssq[t] + ssq[64 + t]) + (ssq[128 + t] + ssq[192 + t]);
        const float rs = 1.0f / sqrtf(tot2 * (1.0f / 128.0f) + RMS_EPS);
        const size_t orow = (size_t)(tok0 + t) * 1024 + h * 128;
#pragma unroll
        for (int g = 0; g < 4; ++g) { const int v0 = 32 * mb + 8 * g + 4 * hh;
            const pg8::u32x2 gw = gac[g]; const pg8::f32x4 nv = *(const pg8::f32x4*)(ng + v0);
            const float y0 = acc[4 * g] * rs * nv[0] * __uint_as_float(gw.x << 16), y1 = acc[4 * g + 1] * rs * nv[1] * __uint_as_float(gw.x & 0xffff0000u);
            const float y2 = acc[4 * g + 2] * rs * nv[2] * __uint_as_float(gw.y << 16), y3 = acc[4 * g + 3] * rs * nv[3] * __uint_as_float(gw.y & 0xffff0000u);
            pg8::u32x2 w; w.x = pg8::cvt_pk_bf16(y0, y1); w.y = pg8::cvt_pk_bf16(y2, y3); *(pg8::u32x2*)(YA + orow + v0) = w; }
        __syncthreads();
    }
}
namespace at {
constexpr int D = 128, NW = 8, QBLK = 32, KVBLK = 64, LDQ = 1024, LDK = 1024;
constexpr float SCALE = ATTN_SCALE, THR = 8.f;
constexpr size_t SHM_V = KVBLK * D * 2, SHM_K = KVBLK * D * 2, SHM_ATTN = 2 * SHM_V + 2 * SHM_K + NW * 64 * 4;
using bf16x8 = __attribute__((ext_vector_type(8))) short;
using s16x4  = __attribute__((ext_vector_type(4))) short;
using f32x16 = __attribute__((ext_vector_type(16))) float;
using u32x4  = __attribute__((ext_vector_type(4))) unsigned;
#define AT_KSWZ(row, colB) ((row) * 256 + ((colB) ^ (((row) & 7) << 4)))
#define AT_SBAR() __builtin_amdgcn_sched_barrier(0)
__device__ __forceinline__ int crow(int r, int hi) { return (r & 3) + 8 * (r >> 2) + 4 * hi; }
__device__ __forceinline__ unsigned cvtpk(float lo, float hi) { return pg8::cvt_pk_bf16(lo, hi); }

__device__ __forceinline__ void partialSM(f32x16& p0, f32x16& p1, float& m_reg, float& mn, float& alpha) {
  constexpr float C = SCALE * 1.4426950408889634f;
  float pmax = p0[0];
#pragma unroll
  for (int r = 1; r < 16; ++r) pmax = fmaxf(pmax, p0[r]);
#pragma unroll
  for (int r = 0; r < 16; ++r) pmax = fmaxf(pmax, p1[r]);
  { auto rr = __builtin_amdgcn_permlane32_swap(__float_as_uint(pmax), __float_as_uint(pmax), false, false);
    pmax = fmaxf(__uint_as_float(rr[0]), __uint_as_float(rr[1])); }
  if (__builtin_expect(__all(pmax - m_reg <= THR / SCALE), 1)) { mn = m_reg; alpha = 1.f; }
  else { mn = fmaxf(m_reg, pmax); alpha = __builtin_amdgcn_exp2f((m_reg - mn) * C); m_reg = mn; }
  float mnC = -mn * C;
#pragma unroll
  for (int r = 0; r < 16; ++r) p0[r] = fmaf(p0[r], C, mnC);
#pragma unroll
  for (int r = 0; r < 16; ++r) p1[r] = fmaf(p1[r], C, mnC);
#pragma unroll
  for (int r = 0; r < 16; ++r) p0[r] = __builtin_amdgcn_exp2f(p0[r]);
}
__device__ __forceinline__ void finishSM(f32x16& p0, f32x16& p1, float alpha, float& l_reg, int mlo, int mhi, bf16x8& pa0, bf16x8& pa1, bf16x8& pa2, bf16x8& pa3) {
#pragma unroll
  for (int r = 0; r < 16; ++r) p1[r] = __builtin_amdgcn_exp2f(p1[r]);
#pragma unroll
  for (int r = 0; r < 16; ++r) { const int bit = (r & 3) + 8 * (r >> 2);
    p0[r] = __uint_as_float(__float_as_uint(p0[r]) & (unsigned)__builtin_amdgcn_sbfe(mlo, bit, 1));
    p1[r] = __uint_as_float(__float_as_uint(p1[r]) & (unsigned)__builtin_amdgcn_sbfe(mhi, bit, 1)); }
  float ps = 0;
#pragma unroll
  for (int r = 0; r < 16; ++r) ps += p0[r];
#pragma unroll
  for (int r = 0; r < 16; ++r) ps += p1[r];
  { auto rr = __builtin_amdgcn_permlane32_swap(__float_as_uint(ps), __float_as_uint(ps), false, false);
    ps = __uint_as_float(rr[0]) + __uint_as_float(rr[1]); }
  l_reg = l_reg * alpha + ps;
#define AT_PK4(P, BASE, OUT) do { unsigned a0 = cvtpk(P[BASE + 0], P[BASE + 1]), a1 = cvtpk(P[BASE + 2], P[BASE + 3]);   \
    unsigned b0 = cvtpk(P[BASE + 4], P[BASE + 5]), b1 = cvtpk(P[BASE + 6], P[BASE + 7]);                              \
    auto r0 = __builtin_amdgcn_permlane32_swap(a0, b0, false, false); auto r1 = __builtin_amdgcn_permlane32_swap(a1, b1, false, false); \
    u32x4 w = {r0[0], r1[0], r0[1], r1[1]}; OUT = *reinterpret_cast<bf16x8*>(&w); } while (0)
  AT_PK4(p0, 0, pa0); AT_PK4(p0, 8, pa1); AT_PK4(p1, 0, pa2); AT_PK4(p1, 8, pa3);
#undef AT_PK4
}
__device__ __forceinline__ void qkt(f32x16& p0, f32x16& p1, const LAS char* Ks, const bf16x8* qr, int r32, int hi) {
  p0 = f32x16{}; p1 = f32x16{};
#pragma unroll
  for (int d0 = 0; d0 < 8; ++d0) { int cb = (d0 * 16 + hi * 8) * 2;
    bf16x8 b0 = *reinterpret_cast<const LAS bf16x8*>(Ks + AT_KSWZ(r32, cb));
    bf16x8 b1 = *reinterpret_cast<const LAS bf16x8*>(Ks + AT_KSWZ(32 + r32, cb));
    p0 = __builtin_amdgcn_mfma_f32_32x32x16_bf16(b0, qr[d0], p0, 0, 0, 0);
    p1 = __builtin_amdgcn_mfma_f32_32x32x16_bf16(b1, qr[d0], p1, 0, 0, 0); }
}
__device__ __forceinline__ int v_st(int k, int c) { const int kk = (k & ~0xC) | ((k & 4) << 1) | ((k & 8) >> 1); return ((kk >> 3) * 4 + (c >> 5)) * 512 + ((kk & 7) * 32 + (c & 31)) * 2; }
__device__ __forceinline__ int v_rd_base(int lane) { return ((lane & 3) << 3) | (((lane >> 2) & 3) << 6) | (((lane >> 4) & 1) << 5) | (((lane >> 5) & 1) << 8); }
constexpr int v_rd_off(int d0, int ks, int half) { return d0 * 512 + ks * 4096 + half * 2048; }
template <int OFF> __device__ __forceinline__ s16x4 tr_read(int vb) {
  s16x4 r; asm volatile("ds_read_b64_tr_b16 %0, %1 offset:%2" : "=&v"(r) : "v"(vb), "i"(OFF) : "memory"); return r;
}
template <int D0> __device__ __forceinline__ void pv_one(f32x16& od, int vb, bf16x8 pa0, bf16x8 pa1, bf16x8 pa2, bf16x8 pa3) {
  const s16x4 l0 = tr_read<v_rd_off(D0, 0, 0)>(vb), h0 = tr_read<v_rd_off(D0, 0, 1)>(vb), l1 = tr_read<v_rd_off(D0, 1, 0)>(vb), h1 = tr_read<v_rd_off(D0, 1, 1)>(vb);
  const s16x4 l2 = tr_read<v_rd_off(D0, 2, 0)>(vb), h2 = tr_read<v_rd_off(D0, 2, 1)>(vb), l3 = tr_read<v_rd_off(D0, 3, 0)>(vb), h3 = tr_read<v_rd_off(D0, 3, 1)>(vb);
  asm volatile("s_waitcnt lgkmcnt(0)" ::: "memory"); AT_SBAR();
#define AT_PK(L_, H_) (bf16x8){L_[0], L_[1], L_[2], L_[3], H_[0], H_[1], H_[2], H_[3]}
  od = __builtin_amdgcn_mfma_f32_32x32x16_bf16(pa0, AT_PK(l0, h0), od, 0, 0, 0);
  od = __builtin_amdgcn_mfma_f32_32x32x16_bf16(pa1, AT_PK(l1, h1), od, 0, 0, 0);
  od = __builtin_amdgcn_mfma_f32_32x32x16_bf16(pa2, AT_PK(l2, h2), od, 0, 0, 0);
  od = __builtin_amdgcn_mfma_f32_32x32x16_bf16(pa3, AT_PK(l3, h3), od, 0, 0, 0);
#undef AT_PK
}
__device__ __forceinline__ void pv_d0(f32x16* o, int vb, bf16x8 pa0, bf16x8 pa1, bf16x8 pa2, bf16x8 pa3) {
  pv_one<0>(o[0], vb, pa0, pa1, pa2, pa3); pv_one<1>(o[1], vb, pa0, pa1, pa2, pa3); pv_one<2>(o[2], vb, pa0, pa1, pa2, pa3); pv_one<3>(o[3], vb, pa0, pa1, pa2, pa3);
}

__device__ __forceinline__ void attn_masked_body(const bf16_t* __restrict__ Qb, const bf16_t* __restrict__ Kh, const bf16_t* __restrict__ Vh, const unsigned long long* __restrict__ Mq,
                                                 bf16_t* __restrict__ Ob, int seq, LAS char* lds, int tid) {
  const int wid = __builtin_amdgcn_readfirstlane(tid >> 6), lane = tid & 63, r32 = lane & 31, hi = lane >> 5;
  LAS char* V_lds = lds; LAS char* K_lds = lds + 2 * SHM_V;
  LAS float* wsf = (LAS float*)(lds + 2 * SHM_V + 2 * SHM_K) + wid * 64; LAS float* li_l = wsf; LAS float* al_l = wsf + 32;
  float m_reg = -1e30f, l_reg = 0; f32x16 o[4] = {}; bf16x8 qr[8];
  const bf16_t* Qw = Qb + (long)(wid * QBLK + r32) * LDQ + hi * 8;
#pragma unroll
  for (int d0 = 0; d0 < 8; ++d0) qr[d0] = *reinterpret_cast<const bf16x8*>(Qw + d0 * 16);
  const unsigned long long* mrow = Mq + (size_t)(wid * QBLK + r32) * 64;
  const int sr = tid >> 4, sc = (tid & 15) * 8, vst0 = v_st(sr, sc), vst1 = v_st(32 + sr, sc);
  const int vb0 = (int)(uintptr_t)V_lds + v_rd_base(lane);
  struct { bf16x8 vs0, vs1, ks0, ks1; } sr_[2];
#define AT_SLOAD(i, k0) do { sr_[i].vs0 = *reinterpret_cast<const bf16x8*>(&Vh[(long)((k0) + sr) * LDK + sc]); sr_[i].vs1 = *reinterpret_cast<const bf16x8*>(&Vh[(long)((k0) + 32 + sr) * LDK + sc]); \
    sr_[i].ks0 = *reinterpret_cast<const bf16x8*>(&Kh[(long)((k0) + sr) * LDK + sc]); sr_[i].ks1 = *reinterpret_cast<const bf16x8*>(&Kh[(long)((k0) + 32 + sr) * LDK + sc]); } while (0)
#define AT_SWRITE(b, i) do { *(LAS bf16x8*)(V_lds + (b) * SHM_V + vst0) = sr_[i].vs0;          \
    *(LAS bf16x8*)(V_lds + (b) * SHM_V + vst1) = sr_[i].vs1; int kc = sc * 2;               \
    *(LAS bf16x8*)(K_lds + (b) * SHM_K + AT_KSWZ(sr, kc)) = sr_[i].ks0;                       \
    *(LAS bf16x8*)(K_lds + (b) * SHM_K + AT_KSWZ(32 + sr, kc)) = sr_[i].ks1; } while (0)
#define AT_SWAIT() asm volatile("s_waitcnt vmcnt(4)" ::: "memory")
#define AT_RESC(a) do { if (__any((a) < 1.f)) { if (hi == 0) al_l[r32] = (a); asm volatile("s_waitcnt lgkmcnt(0)" ::: "memory"); \
    _Pragma("unroll") for (int d = 0; d < 4; ++d) _Pragma("unroll") for (int r = 0; r < 16; ++r) o[d][r] *= al_l[crow(r, hi)]; } } while (0)
#define AT_MLOAD(mw, j) do { const unsigned long long _w = mrow[(j)]; (mw##lo) = (int)((unsigned)_w >> (4 * hi)); (mw##hi) = (int)((unsigned)(_w >> 32) >> (4 * hi)); } while (0)
  f32x16 pA0, pA1, pB0, pB1; float mnA, mnB, alA, alB; bf16x8 pa0, pa1, pa2, pa3; const int NT = seq / KVBLK;
  int mAlo, mAhi, mBlo, mBhi;
  constexpr int SE = 0, SO = 1;
  AT_SLOAD(SE, 0); AT_MLOAD(mA, 0); asm volatile("s_waitcnt vmcnt(0)" ::: "memory"); AT_SWRITE(0, SE); __syncthreads();
  qkt(pA0, pA1, K_lds, qr, r32, hi); partialSM(pA0, pA1, m_reg, mnA, alA);
  AT_SLOAD(SO, KVBLK); if (2 < NT) AT_SLOAD(SE, 2 * KVBLK);
  AT_SWAIT(); AT_SWRITE(1, SO); __syncthreads();
  for (int j = 1; j + 1 < NT; j += 2) {
    AT_SBAR(); AT_MLOAD(mB, j); qkt(pB0, pB1, K_lds + SHM_K, qr, r32, hi);
    finishSM(pA0, pA1, alA, l_reg, mAlo, mAhi, pa0, pa1, pa2, pa3); AT_SBAR();
    AT_SLOAD(SO, (j + 2) * KVBLK); AT_SBAR();
    pv_d0(o, vb0, pa0, pa1, pa2, pa3); partialSM(pB0, pB1, m_reg, mnB, alB);
    __syncthreads(); AT_SWAIT(); AT_SWRITE(0, SE);
    AT_RESC(alB); __syncthreads();
    AT_SBAR(); AT_MLOAD(mA, j + 1); qkt(pA0, pA1, K_lds, qr, r32, hi);
    finishSM(pB0, pB1, alB, l_reg, mBlo, mBhi, pa0, pa1, pa2, pa3); AT_SBAR();
    if (j + 3 < NT) AT_SLOAD(SE, (j + 3) * KVBLK); AT_SBAR();
    pv_d0(o, vb0 + (int)SHM_V, pa0, pa1, pa2, pa3); partialSM(pA0, pA1, m_reg, mnA, alA);
    __syncthreads(); AT_SWAIT(); AT_SWRITE(1, SO);
    AT_RESC(alA); __syncthreads();
  }
  AT_SBAR(); AT_MLOAD(mB, NT - 1); qkt(pB0, pB1, K_lds + SHM_K, qr, r32, hi);
  finishSM(pA0, pA1, alA, l_reg, mAlo, mAhi, pa0, pa1, pa2, pa3); AT_SBAR();
  pv_d0(o, vb0, pa0, pa1, pa2, pa3); partialSM(pB0, pB1, m_reg, mnB, alB);
  __syncthreads(); AT_RESC(alB);
  finishSM(pB0, pB1, alB, l_reg, mBlo, mBhi, pa0, pa1, pa2, pa3); AT_SBAR();
  pv_d0(o, vb0 + (int)SHM_V, pa0, pa1, pa2, pa3);
  if (hi == 0) li_l[r32] = l_reg; asm volatile("s_waitcnt lgkmcnt(0)" ::: "memory");
  float rli[16];
#pragma unroll
  for (int r = 0; r < 16; ++r) rli[r] = __builtin_amdgcn_rcpf(li_l[crow(r, hi)]);
  bf16_t* Ow = Ob + (long)(wid * QBLK) * LDQ;
#pragma unroll
  for (int r = 0; r < 16; ++r) { const int orow = crow(r, hi);
#pragma unroll
    for (int d0 = 0; d0 < 4; ++d0) Ow[(long)orow * LDQ + d0 * 32 + r32] = f2bf(o[d0][r] * rli[r]); }
#undef AT_SLOAD
#undef AT_SWRITE
#undef AT_SWAIT
#undef AT_RESC
#undef AT_MLOAD
}
}

__device__ __forceinline__ void phase_attn(KP P, LAS unsigned char* lds) {
    unsigned char* ws = as_global(P->ws);
    const bf16_t* QB = (const bf16_t*)(ws + WS_QB); const bf16_t* KB = (const bf16_t*)(ws + WS_KB); const bf16_t* VB = (const bf16_t*)(ws + WS_VB);
    const unsigned long long* MASK = (const unsigned long long*)(ws + WS_MASK); bf16_t* YB = (bf16_t*)(ws + WS_YB);
    const int G = nblk_();
    for (int p = bid_(); p < 256; p += G) {
        const int bh = p >> 3, b = bh >> 3, h = bh & 7, x = p & 7;
#pragma unroll 1
        for (int half = 0; half < 2; ++half) { const int qb = half ? 15 - x : x; const size_t row0 = (size_t)b * SEQ + (size_t)qb * 256;
            at::attn_masked_body(QB + row0 * 1024 + h * 128, KB + (size_t)b * SEQ * 1024 + h * 128, VB + (size_t)b * SEQ * 1024 + h * 128, MASK + row0 * 64,
                                 YB + row0 * 1024 + h * 128, 256 * (qb + 1), (LAS char*)lds, tid_());
            __syncthreads(); }
    }
}
__device__ __forceinline__ const float* sel_row(const float* S, int q, int& nw) {
    const int b = q >> 12, s = q & 4095, c = s >> 6; nw = c + 1;
    return S + (size_t)b * SCORE_B + (size_t)2048 * c * (c + 1) + (size_t)(s & 63) * (nw * 64);
}
__device__ __forceinline__ void sel_load(const float* row, int nw, int lane, float (&f)[64]) {
    if (nw > 32) {
#pragma unroll
        for (int j = 0; j < 64; ++j) { const int jc = j < nw ? j : nw - 1; f[j] = row[jc * 64 + lane]; }
    } else {
#pragma unroll
        for (int j = 0; j < 32; ++j) { const int jc = j < nw ? j : nw - 1; f[j] = row[jc * 64 + lane]; }
#pragma unroll
        for (int j = 32; j < 64; ++j) f[j] = 0.f;
    }
}
__device__ __forceinline__ void phase_select(KP P, LAS unsigned char* lds) {
    unsigned char* ws = as_global(P->ws); const float* S = (const float*)(ws + WS_S); unsigned long long* MASK = (unsigned long long*)(ws + WS_MASK);
    const int tid = tid_(), wave = __builtin_amdgcn_readfirstlane(tid >> 6), lane = tid & 63, nb8 = nblk_() * 8;
    LAS unsigned long long* sm = (LAS unsigned long long*)lds + wave * 64;
    float f[64]; int it = (bid_() * 8 + wave) * 8, nw = 0; const float* row = nullptr;
    const int itstep = nb8 * 8 - 7;
#define SEL_Q(it_) ((((it_) >> 3) & 3) * 4096 + ((it_) >> 5) + 512 * ((it_) & 7))
    int q = it < TOK ? SEL_Q(it) : TOK;
    if (q < TOK) { row = sel_row(S, q, nw); if (nw > TOPK / 64) sel_load(row, nw, lane, f); }
    while (q < TOK) {
        unsigned long long myword = 0ull;
        const int itn = ((it & 7) == 7) ? it + itstep : it + 1; const int qn = itn < TOK ? SEL_Q(itn) : TOK; int nwn = 0; const float* rown = nullptr;
        if (nw <= TOPK / 64) {
            myword = (lane < nw) ? ~0ull : 0ull;
            if (qn < TOK) { rown = sel_row(S, qn, nwn); if (nwn > TOPK / 64) sel_load(rown, nwn, lane, f); }
        } else {
            unsigned u[64];
#pragma unroll
            for (int j = 0; j < 64; ++j) { const unsigned bits = __float_as_uint(f[j]); const unsigned v = (bits & 0x80000000u) ? ~bits : (bits | 0x80000000u); u[j] = (j < nw) ? v : 0u; }
            if (qn < TOK) { rown = sel_row(S, qn, nwn); if (nwn > TOPK / 64) sel_load(rown, nwn, lane, f); }
            unsigned prefix = 0u;
            for (int bit = 31; bit >= 0; --bit) { const unsigned cand = prefix | (1u << bit); int cnt = 0;
#pragma unroll
                for (int j8 = 0; j8 < 8; ++j8) if (j8 * 8 < nw) { unsigned long long bl[8];
#pragma unroll
                    for (int jj = 0; jj < 8; ++jj) bl[jj] = __ballot(u[j8 * 8 + jj] >= cand);
                    asm volatile("" : "+s"(bl[0]), "+s"(bl[1]), "+s"(bl[2]), "+s"(bl[3]), "+s"(bl[4]), "+s"(bl[5]), "+s"(bl[6]), "+s"(bl[7]));
#pragma unroll
                    for (int jj = 0; jj < 8; ++jj) cnt += __popcll(bl[jj]); }
                if (cnt >= TOPK) prefix = cand; }
#pragma unroll
            for (int j = 0; j < 64; ++j) { const unsigned long long w = __ballot(u[j] >= prefix); if (lane == 0) sm[j] = w; }
            myword = sm[lane];
        }
        MASK[(size_t)q * 64 + lane] = myword;
        q = qn; it = itn; nw = nwn; row = rown;
    }
#undef SEL_Q
}

__device__ __forceinline__ void phase_hgrn_naive(KP P, int layer, LAS unsigned char* lds) {
    unsigned char* ws = as_global(P->ws);
    const bf16_t* QA = (const bf16_t*)(ws + WS_QA); const bf16_t* KA = (const bf16_t*)(ws + WS_KA); const bf16_t* VA = (const bf16_t*)(ws + WS_VA); const bf16_t* GA = (const bf16_t*)(ws + WS_GA);
    const float* LF = (const float*)(ws + WS_LF); bf16_t* YA = (bf16_t*)(ws + WS_YA);
    const int tid = tid_(), bh = bid_(), b = bh >> 3, h = bh & 7, v = tid & 127; const bool act = (bh < 32) && (tid < 128);
    if (bh >= 32) return;
    LAS float* sf = (LAS float*)lds; LAS float* sk = sf + 16 * 128; LAS float* sq = sk + 16 * 128; LAS float* red = sq + 16 * 128;
    float S[128];
#pragma unroll
    for (int k = 0; k < 128; ++k) S[k] = 0.f;
    const float ng = as_global(P->hnorm_g)[layer * 128 + v];
    for (int t0 = 0; t0 < SEQ; t0 += 16) {
        if (act) for (int i = 0; i < 16; ++i) { const size_t idx = ((size_t)(b * SEQ + t0 + i)) * 1024 + h * 128 + v; sf[i * 128 + v] = expf(LF[idx]); sk[i * 128 + v] = bf2f(KA[idx]); sq[i * 128 + v] = bf2f(QA[idx]); }
        __syncthreads();
        for (int i = 0; i < 16; ++i) { const size_t idx = ((size_t)(b * SEQ + t0 + i)) * 1024 + h * 128 + v; float o = 0.f;
            if (act) { const float vt = bf2f(VA[idx]);
#pragma unroll
                for (int k = 0; k < 128; ++k) { S[k] = sf[i * 128 + k] * S[k] + sk[i * 128 + k] * vt; o += S[k] * sq[i * 128 + k]; } }
            float ss = o * o;
#pragma unroll
            for (int m = 32; m >= 1; m >>= 1) ss += __shfl_xor(ss, m);
            if (act && (v & 63) == 0) red[v >> 6] = ss;
            __syncthreads();
            if (act) { const float tot = red[0] + red[1]; YA[idx] = f2bf(o * (1.0f / sqrtf(tot * (1.0f / 128.0f) + RMS_EPS)) * ng * bf2f(GA[idx])); }
            __syncthreads(); }
    }
}
__device__ __forceinline__ void phase_idx_naive(KP P, LAS unsigned char* lds) {
    unsigned char* ws = as_global(P->ws);
    const bf16_t* QI = (const bf16_t*)(ws + WS_QI); const bf16_t* KI = (const bf16_t*)(ws + WS_KI); const float* WI = (const float*)(ws + WS_WI); float* Sc = (float*)(ws + WS_S);
    const int tid = tid_(), G = nblk_();
    LAS float* qs = (LAS float*)lds; LAS float* wsh = qs + 1024;
    for (int q = bid_(); q < TOK; q += G) {
        const int b = q >> 12, s = q & 4095, c = s >> 6, nw = c + 1, nk = nw * 64;
        if (nw <= TOPK / 64) continue;
        __syncthreads();
        for (int i = tid; i < 1024; i += 512) qs[i] = bf2f(QI[(size_t)q * 1024 + i]);
        if (tid < 16) wsh[tid] = WI[(size_t)q * 16 + tid];
        __syncthreads();
        float* row = Sc + (size_t)b * SCORE_B + (size_t)2048 * c * (c + 1) + (size_t)(s & 63) * nk;
        for (int key = tid; key < nk; key += 512) {
            float kf[64]; const pg8::u32x4* kp = (const pg8::u32x4*)(KI + ((size_t)b * SEQ + key) * 64);
#pragma unroll
            for (int d8 = 0; d8 < 8; ++d8) { const pg8::u32x4 w = kp[d8]; pg8::f32x4 a, bb; pg8::unpack8(w, a, bb);
#pragma unroll
                for (int j = 0; j < 4; ++j) { kf[d8 * 8 + j] = a[j]; kf[d8 * 8 + 4 + j] = bb[j]; } }
            float sc = 0.f;
            for (int h = 0; h < 16; ++h) { float dot = 0.f;
#pragma unroll
                for (int d = 0; d < 64; ++d) dot += qs[h * 64 + d] * kf[d];
                sc += wsh[h] * fmaxf(dot, 0.f); }
            row[key] = sc;
        }
    }
}
__device__ __forceinline__ void phase_attn_naive(KP P, LAS unsigned char* lds) {
    unsigned char* ws = as_global(P->ws);
    const bf16_t* QB = (const bf16_t*)(ws + WS_QB); const bf16_t* KB = (const bf16_t*)(ws + WS_KB); const bf16_t* VB = (const bf16_t*)(ws + WS_VB);
    const unsigned long long* MASK = (const unsigned long long*)(ws + WS_MASK); bf16_t* YB = (bf16_t*)(ws + WS_YB);
    const int tid = tid_(), h = tid >> 6, lane = tid & 63, G = nblk_();
    LAS float* qs = (LAS float*)lds + h * 128; LAS int* keys = (LAS int*)((LAS float*)lds + 1024) + h * 320; LAS float* lg = (LAS float*)lds + 1024 + 8 * 320 + h * 320;
    for (int q = bid_(); q < TOK; q += G) {
        const int b = q >> 12, s = q & 4095, nw = (s >> 6) + 1;
        qs[lane] = bf2f(QB[(size_t)q * 1024 + h * 128 + lane]); qs[lane + 64] = bf2f(QB[(size_t)q * 1024 + h * 128 + 64 + lane]);
        int cnt = 0;
        for (int j = 0; j < nw; ++j) { const unsigned long long w = MASK[(size_t)q * 64 + j]; const bool on = (w >> lane) & 1ull; const int key = j * 64 + lane;
            if (on) { const pg8::u32x4* kp = (const pg8::u32x4*)(KB + ((size_t)b * SEQ + key) * 1024 + h * 128); float dot = 0.f;
                for (int d8 = 0; d8 < 16; ++d8) { pg8::f32x4 a, bb; pg8::unpack8(kp[d8], a, bb);
#pragma unroll
                    for (int j2 = 0; j2 < 4; ++j2) dot += qs[d8 * 8 + j2] * a[j2] + qs[d8 * 8 + 4 + j2] * bb[j2]; }
                const int pos = cnt + __popcll(w & ((1ull << lane) - 1ull));
                if (pos < 320) { keys[pos] = key; lg[pos] = dot * ATTN_SCALE; } }
            cnt += __popcll(w); }
        if (cnt > 320) cnt = 320;
        float mx = -1e30f; for (int e = lane; e < cnt; e += 64) mx = fmaxf(mx, lg[e]);
#pragma unroll
        for (int m = 32; m >= 1; m >>= 1) mx = fmaxf(mx, __shfl_xor(mx, m));
        float sum = 0.f; for (int e = lane; e < cnt; e += 64) { const float pe = expf(lg[e] - mx); lg[e] = pe; sum += pe; }
#pragma unroll
        for (int m = 32; m >= 1; m >>= 1) sum += __shfl_xor(sum, m);
        float a0 = 0.f, a1 = 0.f;
        for (int e = 0; e < cnt; ++e) { const float pe = lg[e]; const bf16_t* vp = VB + ((size_t)b * SEQ + keys[e]) * 1024 + h * 128 + 2 * lane; a0 += pe * bf2f(vp[0]); a1 += pe * bf2f(vp[1]); }
        const float inv = 1.0f / sum;
        *(unsigned*)(YB + (size_t)q * 1024 + h * 128 + 2 * lane) = pg8::cvt_pk_bf16(a0 * inv, a1 * inv);
    }
}

constexpr int IXK = 512, IX_LD = 144;
__device__ __forceinline__ void idx_unit(const bf16_t* QI, const bf16_t* KI, const float* WI, float* Sc, int b, int c, int half, int tid, LAS unsigned char* lds) {
    const int lane = tid & 63, wave = __builtin_amdgcn_readfirstlane(tid >> 6), r = lane & 31, hh = lane >> 5, nk = 64 * (c + 1);
    const int s0 = c * 64 + half * 32 + wave * 4;
    const int aq = (r >> 2) & 1, ahead = (r & 3) + 4 * (r >> 3);
    bf16x8_t A[2][4]; float wv[2][16];
#pragma unroll
    for (int rt = 0; rt < 2; ++rt) { const size_t qrow = (size_t)b * SEQ + s0 + 2 * rt + aq;
#pragma unroll
        for (int ks = 0; ks < 4; ++ks) A[rt][ks] = *(const bf16x8_t*)(QI + qrow * 1024 + ahead * 64 + 16 * ks + 8 * hh);
        const float* wp = WI + ((size_t)b * SEQ + s0 + 2 * rt + hh) * 16;
#pragma unroll
        for (int i4 = 0; i4 < 4; ++i4) { const pg8::f32x4 w4 = *(const pg8::f32x4*)(wp + 4 * i4); wv[rt][4 * i4] = w4[0]; wv[rt][4 * i4 + 1] = w4[1]; wv[rt][4 * i4 + 2] = w4[2]; wv[rt][4 * i4 + 3] = w4[3]; } }
    float* srow[2];
#pragma unroll
    for (int rt = 0; rt < 2; ++rt) srow[rt] = Sc + (size_t)b * SCORE_B + (size_t)2048 * c * (c + 1) + (size_t)((s0 + 2 * rt + hh) & 63) * nk + r;
    const bf16_t* kbase = KI + (size_t)b * SEQ * 64;
    const int nblk = (nk + IXK - 1) / IXK;
    pg8::u32x4 stg[8];
#define IX_LOAD(kb) do { _Pragma("unroll") for (int i = 0; i < 8; ++i) { const int p = tid + 512 * i; int key = (kb) * IXK + (p >> 3); key = key < nk ? key : nk - 1; \
        stg[i] = *(const pg8::u32x4*)(kbase + (size_t)key * 64 + (p & 7) * 8); } } while (0)
#define IX_STORE() do { _Pragma("unroll") for (int i = 0; i < 8; ++i) { const int p = tid + 512 * i; *(LAS pg8::u32x4*)(lds + (p >> 3) * IX_LD + (p & 7) * 16) = stg[i]; } } while (0)
    IX_LOAD(0);
    for (int kb = 0; kb < nblk; ++kb) {
        __syncthreads();
        IX_STORE();
        __syncthreads();
        if (kb + 1 < nblk) IX_LOAD(kb + 1);
        const int ntile = (nk - kb * IXK < IXK ? nk - kb * IXK : IXK) / 32;
        for (int t = 0; t < ntile; ++t) { bf16x8_t Bc[4];
#pragma unroll
            for (int ks = 0; ks < 4; ++ks) Bc[ks] = *(const LAS bf16x8_t*)(lds + (32 * t + r) * IX_LD + (16 * ks + 8 * hh) * 2);
#pragma unroll
            for (int rt = 0; rt < 2; ++rt) { f32x16_t acc;
#pragma unroll
                for (int i = 0; i < 16; ++i) acc[i] = 0.f;
#pragma unroll
                for (int ks = 0; ks < 4; ++ks) acc = __builtin_amdgcn_mfma_f32_32x32x16_bf16(A[rt][ks], Bc[ks], acc, 0, 0, 0);
                pg8::f32x2 sc2 = {0.f, 0.f};
#pragma unroll
                for (int i = 0; i < 16; i += 2) { pg8::f32x2 rl, wq; rl[0] = __int_as_float(max(__float_as_int(acc[i]), 0)); rl[1] = __int_as_float(max(__float_as_int(acc[i + 1]), 0));
                    wq[0] = wv[rt][i]; wq[1] = wv[rt][i + 1]; sc2 = __builtin_elementwise_fma(wq, rl, sc2); }
                srow[rt][kb * IXK + t * 32] = sc2[0] + sc2[1]; } }
    }
#undef IX_LOAD
#undef IX_STORE
}
__device__ __forceinline__ void phase_idx(KP P, LAS unsigned char* lds) {
    unsigned char* ws = as_global(P->ws);
    const bf16_t* QI = (const bf16_t*)(ws + WS_QI); const bf16_t* KI = (const bf16_t*)(ws + WS_KI); const float* WI = (const float*)(ws + WS_WI); float* Sc = (float*)(ws + WS_S);
    const int G = nblk_();
    for (int item = bid_(); item < 240; item += G) {
        const int pi = item % 30, combo = item / 30, b = combo >> 1, half = combo & 1;
        idx_unit(QI, KI, WI, Sc, b, 4 + pi, half, tid_(), lds); __syncthreads();
        idx_unit(QI, KI, WI, Sc, b, 63 - pi, half, tid_(), lds); __syncthreads();
    }
}

__device__ __forceinline__ void sel_unit(const float* S, unsigned long long* MASK, int b, int c, int half, int tid, LAS unsigned char* lds) {
    const int lane = tid & 63, wave = __builtin_amdgcn_readfirstlane(tid >> 6), nw = c + 1;
    LAS unsigned long long* sm = (LAS unsigned long long*)lds + wave * 64;
    float f[64]; const int s0 = c * 64 + half * 32 + wave * 4;
    const float* rowbase = S + (size_t)b * SCORE_B + (size_t)2048 * c * (c + 1);
#pragma unroll 1
    for (int i = 0; i < 4; ++i) {
        unsigned u[64];
        sel_load(rowbase + (size_t)((s0 + i) & 63) * (nw * 64), nw, lane, f);
#pragma unroll
        for (int j = 0; j < 64; ++j) { const unsigned bits = __float_as_uint(f[j]); const unsigned v = (bits & 0x80000000u) ? ~bits : (bits | 0x80000000u); u[j] = (j < nw) ? v : 0u; }
        unsigned prefix = 0u;
        for (int bit = 31; bit >= 0; --bit) { const unsigned cand = prefix | (1u << bit); int cnt = 0;
#pragma unroll
            for (int j8 = 0; j8 < 8; ++j8) if (j8 * 8 < nw) { unsigned long long bl[8];
#pragma unroll
                for (int jj = 0; jj < 8; ++jj) bl[jj] = __ballot(u[j8 * 8 + jj] >= cand);
                asm volatile("" : "+s"(bl[0]), "+s"(bl[1]), "+s"(bl[2]), "+s"(bl[3]), "+s"(bl[4]), "+s"(bl[5]), "+s"(bl[6]), "+s"(bl[7]));
#pragma unroll
                for (int jj = 0; jj < 8; ++jj) cnt += __popcll(bl[jj]); }
            if (cnt >= TOPK) prefix = cand; }
#pragma unroll
        for (int j = 0; j < 64; ++j) { const unsigned long long w = __ballot(u[j] >= prefix); if (lane == 0) sm[j] = w; }
        MASK[((size_t)b * SEQ + s0 + i) * 64 + lane] = sm[lane];
    }
}
__device__ __forceinline__ void phase_idxsel(KP P, LAS unsigned char* lds) {
    unsigned char* ws = as_global(P->ws);
    const bf16_t* QI = (const bf16_t*)(ws + WS_QI); const bf16_t* KI = (const bf16_t*)(ws + WS_KI); const float* WI = (const float*)(ws + WS_WI); float* Sc = (float*)(ws + WS_S);
    unsigned long long* MASK = (unsigned long long*)(ws + WS_MASK);
    const int G = nblk_();
    { const int tid = tid_(), lane = tid & 63, gw = bid_() * 8 + __builtin_amdgcn_readfirstlane(tid >> 6);
      for (int qq = gw; qq < NBATCH * 256; qq += G * 8) { const int b = qq >> 8, s = qq & 255, nw = (s >> 6) + 1; MASK[((size_t)b * SEQ + s) * 64 + lane] = (lane < nw) ? ~0ull : 0ull; } }
    for (int item = bid_(); item < 240; item += G) {
        const int pi = item % 30, combo = item / 30, b = combo >> 1, half = combo & 1;
#pragma unroll 1
        for (int which = 0; which < 2; ++which) { const int c = which ? 63 - pi : 4 + pi;
            idx_unit(QI, KI, WI, Sc, b, c, half, tid_(), lds);
            asm volatile("s_waitcnt vmcnt(0)" ::: "memory"); __syncthreads();
            sel_unit(Sc, MASK, b, c, half, tid_(), lds);
            __syncthreads(); }
    }
}
__device__ __forceinline__ void ixs_unit(const bf16_t* QI, const bf16_t* KI, const float* WI, unsigned long long* MASK, int b, int u8, int tid, LAS unsigned char* lds) {
    const int lane = tid & 63, wave = __builtin_amdgcn_readfirstlane(tid >> 6), r = lane & 31, hh = lane >> 5;
    const int s0 = 8 * u8, c = s0 >> 6, nw = c + 1, nk = 64 * nw;
    LAS float* SC = (LAS float*)lds;
    unsigned long long myword;
    if (nw > TOPK / 64) {
        { const int aq = (r >> 2) & 1, ahead = (r & 3) + 4 * (r >> 3);
          bf16x8_t A[4][4]; float wv[4][16];
#pragma unroll
          for (int rt = 0; rt < 4; ++rt) { const size_t qrow = (size_t)b * SEQ + s0 + 2 * rt + aq;
#pragma unroll
              for (int ks = 0; ks < 4; ++ks) A[rt][ks] = *(const bf16x8_t*)(QI + qrow * 1024 + ahead * 64 + 16 * ks + 8 * hh);
              const float* wp = WI + ((size_t)b * SEQ + s0 + 2 * rt + hh) * 16;
#pragma unroll
              for (int i4 = 0; i4 < 4; ++i4) { const pg8::f32x4 w4 = *(const pg8::f32x4*)(wp + 4 * i4); wv[rt][4 * i4] = w4[0]; wv[rt][4 * i4 + 1] = w4[1]; wv[rt][4 * i4 + 2] = w4[2]; wv[rt][4 * i4 + 3] = w4[3]; } }
          const bf16_t* kp = KI + ((size_t)b * SEQ + r) * 64 + 8 * hh;
          const int ntile = nk / 32;
          bf16x8_t Ca[4], Cb[4];
#define IXS_LOAD(t0_) do { const int ta = (t0_) < ntile ? (t0_) : ntile - 1, tb_ = (t0_) + 8 < ntile ? (t0_) + 8 : ntile - 1; \
              _Pragma("unroll") for (int ks = 0; ks < 4; ++ks) { Ca[ks] = *(const bf16x8_t*)(kp + (size_t)ta * 2048 + 16 * ks); Cb[ks] = *(const bf16x8_t*)(kp + (size_t)tb_ * 2048 + 16 * ks); } } while (0)
#define IXS_TILE(BUF, tt) do { _Pragma("unroll") for (int rt = 0; rt < 4; ++rt) { f32x16_t acc; _Pragma("unroll") for (int i = 0; i < 16; ++i) acc[i] = 0.f; \
              _Pragma("unroll") for (int ks = 0; ks < 4; ++ks) acc = __builtin_amdgcn_mfma_f32_32x32x16_bf16(A[rt][ks], BUF[ks], acc, 0, 0, 0); \
              pg8::f32x2 sc2 = {0.f, 0.f}; _Pragma("unroll") for (int i = 0; i < 16; i += 2) { pg8::f32x2 rl, wq; \
                  rl[0] = __int_as_float(max(__float_as_int(acc[i]), 0)); rl[1] = __int_as_float(max(__float_as_int(acc[i + 1]), 0)); wq[0] = wv[rt][i]; wq[1] = wv[rt][i + 1]; \
                  sc2 = __builtin_elementwise_fma(wq, rl, sc2); } const float sc = sc2[0] + sc2[1];     \
              SC[(2 * rt + hh) * 4096 + 32 * (tt) + r] = sc; } } while (0)
          IXS_LOAD(wave);
          for (int t = wave; t < ntile; t += 16) {
              bf16x8_t Ba[4], Bb[4];
#pragma unroll
              for (int ks = 0; ks < 4; ++ks) { Ba[ks] = Ca[ks]; Bb[ks] = Cb[ks]; }
              IXS_LOAD(t + 16);
              IXS_TILE(Ba, t);
              if (t + 8 < ntile) IXS_TILE(Bb, t + 8);
          }
#undef IXS_LOAD
#undef IXS_TILE
        }
        __syncthreads();
        unsigned u[64];
        { const LAS float* row = SC + wave * 4096 + lane;
#pragma unroll
          for (int j = 0; j < 64; ++j) { const int jc = j < nw ? j : nw - 1; const unsigned bits = __float_as_uint(row[jc * 64]); const unsigned v = (bits & 0x80000000u) ? ~bits : (bits | 0x80000000u); u[j] = (j < nw) ? v : 0u; } }
        unsigned prefix = 0u;
#ifdef IXS_DUP_SEARCH
        for (int rep_s = 0; rep_s < 2; ++rep_s) { prefix = 0u;
#else
        {
#endif
        for (int bit = 31; bit >= 0; --bit) { const unsigned cand = prefix | (1u << bit); int cnt = 0;
            unsigned cl = 0u;
#pragma unroll
            for (int j8 = 0; j8 < 8; ++j8) if (j8 * 8 < nw) {
#pragma unroll
                for (int jj = 0; jj < 8; ++jj) cl += (u[j8 * 8 + jj] >= cand) ? 1u : 0u; }
#pragma unroll
            for (int bb = 0; bb < 7; ++bb) cnt += __popcll(__ballot((cl >> bb) & 1u)) << bb;
            if (cnt >= TOPK) prefix = cand; }
        }
        LAS unsigned long long* sm = (LAS unsigned long long*)(SC + wave * 4096);
#pragma unroll
        for (int j = 0; j < 64; ++j) { const unsigned long long w = __ballot(u[j] >= prefix); if (lane == 0) sm[j] = w; }
        myword = sm[lane];
    } else {
        myword = (lane < nw) ? ~0ull : 0ull;
    }
    MASK[((size_t)b * SEQ + s0 + wave) * 64 + lane] = myword;
    __syncthreads();
}
__device__ __forceinline__ void phase_ixs(KP P, LAS unsigned char* lds) {
    unsigned char* ws = as_global(P->ws);
    const bf16_t* QI = (const bf16_t*)(ws + WS_QI); const bf16_t* KI = (const bf16_t*)(ws + WS_KI); const float* WI = (const float*)(ws + WS_WI); unsigned long long* MASK = (unsigned long long*)(ws + WS_MASK);
    const int G = nblk_();
    for (int W = bid_(); W < 256; W += G)
        for (int kk = 0; kk < 8; ++kk) ixs_unit(QI, KI, WI, MASK, W & 3, (W >> 2) + 64 * kk, tid_(), lds);
}
#ifndef OPT_HGRN
#define OPT_HGRN 1
#endif
#ifndef OPT_IDX
#define OPT_IDX 1
#endif
#ifndef OPT_ATT
#define OPT_ATT 1
#endif
#ifndef OPT_IXS
#define OPT_IXS 0
#endif
#ifndef PHM
#define PHM 0x3fff
#endif
#ifndef DUP_MASK
#define DUP_MASK 0
#endif

__global__ void __launch_bounds__(512, 2) mega(Params P_unused) {
    extern __shared__ __attribute__((aligned(16))) unsigned char lds[];
    LAS unsigned char* L = (LAS unsigned char*)lds;
    volatile LAS unsigned* misc = (volatile LAS unsigned*)(L + MISC_OFF);
    if (threadIdx.x < 4) misc[threadIdx.x] = 0u;
    __syncthreads();
    int lo, hi; unsigned char* ws0; { KP P0 = kparams(); lo = P0->ph_lo; hi = P0->ph_hi; ws0 = as_global(P0->ws); }
    XcdBarrier bar; bar.bar = (unsigned*)(ws0 + WS_CTL); bar.x = 0; bar.st = misc;
    if (hi - lo > 1) bar = xcd_barrier_post((unsigned*)(ws0 + WS_CTL), misc);
#define WSP(T_, off) ((T_*)(ws + (off)))
#define WSL KP P = kparams(); unsigned char* ws = as_global(P->ws); const int G = nblk_(), bid = bid_(); (void)G; (void)bid

    for (int layer = 0; layer < DEPTH; ++layer) {
        const int base = layer * NPH_LAYER;
#define IN(k) (((PHM >> (k)) & 1) && lo <= base + (k) && base + (k) < hi)
#define SEAM(k) do { if (rep + 1 == ((((DUP_MASK >> (k)) & 1) ? 2 : 1)) && base + (k) + 1 < hi) xcd_barrier(bar); } while (0)
        if (layer == 0 && IN(0)) for (int rep = 0; rep < (((DUP_MASK >> 0) & 1) ? 2 : 1); ++rep) { WSL; phase_prologue(P); phase_wconv(P, 0, L); SEAM(0); }
        if (IN(1)) for (int rep = 0; rep < (((DUP_MASK >> 1) & 1) ? 2 : 1); ++rep) { WSL;
            pg8::Gemm g{WSP(const bf16_t, WS_XB), WSP(const bf16_t, WS_WIN), TOK, INP, DM}; pg8::StaticOrder S; S.init(TOK, INP, G, bid);
            pg8::EpiIn E{ws, layer};
            pg8::gemm_phase<pg8::EpiIn, pg8::StaticOrder, true, true>(L, g, S, E); SEAM(1);
        }
        if (IN(2)) for (int rep = 0; rep < (((DUP_MASK >> 2) & 1) ? 2 : 1); ++rep) { WSL; phase_ikprep(P, layer);
#if OPT_HGRN
            phase_hgrn_h1(P, L);
#ifdef DUP_H1
            phase_hgrn_h1(P, L);
#endif
#endif
            SEAM(2); }
        if (IN(3)) for (int rep = 0; rep < (((DUP_MASK >> 3) & 1) ? 2 : 1); ++rep) { WSL;
#if !OPT_HGRN
            phase_hgrn_naive(P, layer, L); __syncthreads();
#else
            phase_hgrn_h2(P);
#ifdef DUP_H2
            phase_hgrn_h2(P);
#endif
#endif
#if !OPT_IDX
            phase_idx_naive(P, L);
#else
#if OPT_IXS == 2
            __syncthreads(); phase_idxsel(P, L);
#elif OPT_IXS == 1
            __syncthreads(); phase_ixs(P, L);
#ifdef DUP_IXS
            __syncthreads(); phase_ixs(P, L);
#endif
#else
            __syncthreads(); phase_idx(P, L);
#endif
#endif
            SEAM(3); }
#if OPT_IXS == 2 && OPT_HGRN && OPT_ATT
#else
        if (IN(4)) for (int rep = 0; rep < (((DUP_MASK >> 4) & 1) ? 2 : 1); ++rep) { WSL;
#if OPT_IXS == 0
            phase_select(P, L);
#endif
#if OPT_HGRN
            __syncthreads(); phase_hgrn_h3(P, layer, L);
#ifdef DUP_H3
            __syncthreads(); phase_hgrn_h3(P, layer, L);
#endif
#endif
            SEAM(4); }
#endif
        if (IN(5)) for (int rep = 0; rep < (((DUP_MASK >> 5) & 1) ? 2 : 1); ++rep) { WSL;
#if !OPT_ATT
            phase_attn_naive(P, L);
#else
#if OPT_IXS == 2 && OPT_HGRN
            phase_hgrn_h3(P, layer, L); __syncthreads();
#endif
            phase_attn(P, L);
#endif
            SEAM(5); }
        if (IN(6)) for (int rep = 0; rep < (((DUP_MASK >> 6) & 1) ? 2 : 1); ++rep) { WSL;
            { pg8::Gemm g{WSP(const bf16_t, WS_YA), WSP(const bf16_t, WS_WA), TOK, DM, AW}; pg8::StaticOrder S; S.init(TOK, DM, G, bid);
              pg8::EpiGateA E{ws}; pg8::gemm_phase<pg8::EpiGateA, pg8::StaticOrder, true, true>(L, g, S, E); }
            { pg8::Gemm g{WSP(const bf16_t, WS_YB), WSP(const bf16_t, WS_WB), TOK, DM, BW}; pg8::StaticOrder S; S.init(TOK, DM, G, bid);
              pg8::EpiGateB E{ws}; pg8::gemm_phase<pg8::EpiGateB, pg8::StaticOrder, true, true>(L, g, S, E); }
            { pg8::Gemm g{WSP(const bf16_t, WS_PB), WSP(const bf16_t, WS_WPP), TOK, DM, PLE}; pg8::StaticOrder S; S.init(TOK, DM, G, bid);
              pg8::EpiF32P E{ws}; pg8::gemm_phase<pg8::EpiF32P, pg8::StaticOrder, true, true>(L, g, S, E); }
            SEAM(6);
        }
        if (IN(7)) for (int rep = 0; rep < (((DUP_MASK >> 7) & 1) ? 2 : 1); ++rep) { WSL;
            pg8::Gemm g{WSP(const bf16_t, WS_MG), WSP(const bf16_t, WS_WO), TOK, DM, DM}; pg8::StaticOrder S; S.init(TOK, DM, G, bid);
            if (layer == 0) { pg8::EpiRes<true> E{as_global(P->x), nullptr, nullptr, ws}; pg8::gemm_phase<pg8::EpiRes<true>, pg8::StaticOrder, true, true>(L, g, S, E); }
            else { pg8::EpiRes<false> E{nullptr, P->lnp_g + (layer - 1) * DM, P->lnp_b + (layer - 1) * DM, ws}; pg8::gemm_phase<pg8::EpiRes<false>, pg8::StaticOrder, true, true>(L, g, S, E); }
            SEAM(7);
        }
        if (IN(8)) for (int rep = 0; rep < (((DUP_MASK >> 8) & 1) ? 2 : 1); ++rep) { WSL; phase_ln(WSP(const float, WS_XPRE), nullptr, WSP(bf16_t, WS_XB), WSP(float, WS_STATS), as_global(P->lnm_g) + layer * DM, as_global(P->lnm_b) + layer * DM); SEAM(8); }
        if (IN(9)) for (int rep = 0; rep < (((DUP_MASK >> 9) & 1) ? 2 : 1); ++rep) { WSL;
            pg8::Gemm g{WSP(const bf16_t, WS_XB), WSP(const bf16_t, WS_WGU), TOK, 2 * DFF, DM}; pg8::StaticOrder S; S.init(TOK, 2 * DFF, G, bid);
            pg8::EpiSwiGLU E{ws}; pg8::gemm_phase<pg8::EpiSwiGLU, pg8::StaticOrder, true, true>(L, g, S, E); SEAM(9);
        }
        if (IN(10)) for (int rep = 0; rep < (((DUP_MASK >> 10) & 1) ? 2 : 1); ++rep) { WSL;
            pg8::Gemm g{WSP(const bf16_t, WS_H), WSP(const bf16_t, WS_WDN), TOK, DM, DFF}; pg8::StaticOrder S; S.init(TOK, DM, G, bid);
            pg8::EpiRes<false> E{nullptr, P->lnm_g + layer * DM, P->lnm_b + layer * DM, ws}; pg8::gemm_phase<pg8::EpiRes<false>, pg8::StaticOrder, true, true>(L, g, S, E); SEAM(10);
        }
        if (IN(11)) for (int rep = 0; rep < (((DUP_MASK >> 11) & 1) ? 2 : 1); ++rep) { WSL; phase_ln(WSP(const float, WS_XPRE), nullptr, WSP(bf16_t, WS_XB), WSP(float, WS_STATS), as_global(P->lnf_g) + layer * DM, as_global(P->lnf_b) + layer * DM); SEAM(11); }
        if (IN(12)) for (int rep = 0; rep < (((DUP_MASK >> 12) & 1) ? 2 : 1); ++rep) { WSL;
            pg8::Gemm g{WSP(const bf16_t, WS_XB), WSP(const bf16_t, WS_WPG), TOK, DM, DM}; pg8::StaticOrder S; S.init(TOK, DM, G, bid);
            pg8::EpiPle E{P->lnf_g + layer * DM, P->lnf_b + layer * DM, ws}; pg8::gemm_phase<pg8::EpiPle, pg8::StaticOrder, true, true>(L, g, S, E); SEAM(12);
        }
        if (IN(13)) for (int rep = 0; rep < (((DUP_MASK >> 13) & 1) ? 2 : 1); ++rep) { WSL; phase_ln(WSP(const float, WS_XPRE), layer == DEPTH - 1 ? as_global(P->out) : nullptr, WSP(bf16_t, WS_XB), WSP(float, WS_STATS), as_global(P->lnp_g) + layer * DM, as_global(P->lnp_b) + layer * DM);
            if (layer + 1 < DEPTH) { __syncthreads(); phase_wconv(P, layer + 1, L); }
            SEAM(13); }
#undef IN
#undef SEAM
    }
}

extern "C" void kernel_launch(void* const* d_in, const int* in_sizes, int n_in, void* d_out, int out_size, void* d_ws, size_t ws_size, hipStream_t stream) {
    static int grid = 0;
    if (grid == 0) {
        if (n_in != 22 || out_size != TOK * DM || ws_size < WS_END) { fprintf(stderr, "kernel_launch: unexpected shapes: n_in %d out %d ws %zu (need %zu)\n", n_in, out_size, ws_size, (size_t)WS_END); grid = -1; return; }
        int dev = 0, cus = 0, per_cu = 0;
        if (hipGetDevice(&dev) != hipSuccess || hipDeviceGetAttribute(&cus, hipDeviceAttributeMultiprocessorCount, dev) != hipSuccess) { grid = -1; return; }
        if (hipFuncSetAttribute((const void*)mega, hipFuncAttributeMaxDynamicSharedMemorySize, LDS_BYTES) != hipSuccess) { fprintf(stderr, "kernel_launch: hipFuncSetAttribute failed\n"); grid = -1; return; }
        if (hipOccupancyMaxActiveBlocksPerMultiprocessor(&per_cu, (const void*)mega, 512, LDS_BYTES) != hipSuccess || per_cu < 1) { fprintf(stderr, "kernel_launch: occupancy query says %d\n", per_cu); (void)hipGetLastError(); }
        grid = cus;
    }
    if (grid < 0) return;
    (void)hipMemsetAsync((char*)d_ws + WS_CTL, 0, 65536, stream);
    Params P{};
    P.x = (const float*)d_in[0]; P.p = (const float*)d_in[1]; P.pos = (const int*)d_in[2];
    P.w_in = (const float*)d_in[3]; P.w_a = (const float*)d_in[4]; P.w_b = (const float*)d_in[5]; P.w_out = (const float*)d_in[6];
    P.lbraw = (const float*)d_in[7]; P.hnorm_g = (const float*)d_in[8]; P.ikn_g = (const float*)d_in[9]; P.ikn_b = (const float*)d_in[10];
    P.lnm_g = (const float*)d_in[11]; P.lnm_b = (const float*)d_in[12]; P.w_fg = (const float*)d_in[13]; P.w_fu = (const float*)d_in[14]; P.w_fd = (const float*)d_in[15];
    P.lnf_g = (const float*)d_in[16]; P.lnf_b = (const float*)d_in[17]; P.w_pg = (const float*)d_in[18]; P.w_pp = (const float*)d_in[19];
    P.lnp_g = (const float*)d_in[20]; P.lnp_b = (const float*)d_in[21];
    P.out = (float*)d_out; P.ws = (unsigned char*)d_ws;
    for (int j = 0; j < 64; ++j) P.invf_h[j] = pow(10000.0, -(double)j / 64.0) / 6.283185307179586476925286766559;
    for (int j = 0; j < 32; ++j) P.invf_i[j] = pow(10000.0, -(double)j / 32.0) / 6.283185307179586476925286766559;
    P.ph_lo = 0; P.ph_hi = NPH;
    hipLaunchKernelGGL(mega, dim3(grid), dim3(512), LDS_BYTES, stream, P);
    const hipError_t le = hipPeekAtLastError();
    if (le != hipSuccess) fprintf(stderr, "kernel_launch: launch failed: %s\n", hipGetErrorName(le));
}
```

```cpp
#include <hip/hip_runtime.h>
#include <cstdio>
#include <cstdint>

constexpr int DM = 2048, NBATCH = 4, SEQ = 4096, TOK = NBATCH * SEQ, DEPTH = 4, CHUNK = 64, PLE = 256;
constexpr int AH = 8, AD = 128, AW = 1024, BH = 8, BD = 128, BW = 1024, IH = 16, IDIM = 64, TOPK = 256;
constexpr int DFF = 5632, INW = 12368, INP = 12544;
constexpr float ALPHA = 1.6817928305074290861f;
constexpr float LN_EPS = 1e-5f, RMS_EPS = 1e-6f;
constexpr float ATTN_SCALE = 0.088388347648318440f;
constexpr float IDX_SCALE = 0.03125f;

typedef unsigned short bf16_t;
__device__ __forceinline__ float bf2f(bf16_t b) { return __uint_as_float(((unsigned)b) << 16); }
__device__ __forceinline__ bf16_t f2bf(float f) { unsigned u = __float_as_uint(f); u += 0x7FFFu + ((u >> 16) & 1u); return (bf16_t)(u >> 16); }
__device__ __forceinline__ float sigmoid_f(float x) { return __builtin_amdgcn_rcpf(1.0f + __expf(-x)); }
__device__ __forceinline__ float silu_f(float x) { return x * sigmoid_f(x); }

__device__ __forceinline__ int tid_() { int t = (int)threadIdx.x; asm volatile("" : "+v"(t)); return t; }
__device__ __forceinline__ int bid_() { int b = (int)blockIdx.x; asm volatile("" : "+s"(b)); return b; }
__device__ __forceinline__ int nblk_() { int g = (int)gridDim.x; asm volatile("" : "+s"(g)); return g; }

template <class T> __device__ __forceinline__ T* as_global(T* p) { return (T*)(__attribute__((address_space(1))) T*)p; }

constexpr size_t MiB = 1048576;
constexpr size_t WS_CTL  = 0;
constexpr size_t WS_LB   = WS_CTL + 65536;
constexpr size_t WS_STATS = WS_CTL + 131072;
constexpr size_t WS_COSH = 1 * MiB;
constexpr size_t WS_SINH = WS_COSH + 4 * MiB;
constexpr size_t WS_COSI = WS_SINH + 4 * MiB;
constexpr size_t WS_SINI = WS_COSI + 2 * MiB;
constexpr size_t WS_WIN  = WS_SINI + 2 * MiB;
constexpr size_t WS_WA   = WS_WIN + 49 * MiB;
constexpr size_t WS_WB   = WS_WA + 4 * MiB;
constexpr size_t WS_WO   = WS_WB + 4 * MiB;
constexpr size_t WS_WGU  = WS_WO + 8 * MiB;
constexpr size_t WS_WDN  = WS_WGU + 44 * MiB;
constexpr size_t WS_WPG  = WS_WDN + 22 * MiB;
constexpr size_t WS_WPP  = WS_WPG + 8 * MiB;
constexpr size_t WS_S    = WS_WPP + 1 * MiB;
constexpr size_t WS_XB   = WS_S + 130 * MiB;
constexpr size_t WS_XPRE = WS_XB + 64 * MiB;
constexpr size_t WS_R1   = WS_XPRE + 130 * MiB;
constexpr size_t WS_QA   = WS_R1;
constexpr size_t WS_LF   = WS_QA + 32 * MiB;
constexpr size_t WS_KA   = WS_LF + 64 * MiB;
constexpr size_t WS_VA   = WS_KA + 32 * MiB;
constexpr size_t WS_GA   = WS_VA + 32 * MiB;
constexpr size_t WS_QB   = WS_GA + 32 * MiB;
constexpr size_t WS_KB   = WS_QB + 32 * MiB;
constexpr size_t WS_VB   = WS_KB + 32 * MiB;
constexpr size_t WS_QI   = WS_VB + 32 * MiB;
constexpr size_t WS_SGA  = WS_QI + 32 * MiB;
constexpr size_t WS_SGB  = WS_SGA + 64 * MiB;
constexpr size_t WS_IKW  = WS_SGB + 64 * MiB;
constexpr size_t WS_H    = WS_R1;
constexpr size_t WS_PP   = WS_R1 + 176 * MiB;
constexpr size_t WS_R2   = WS_IKW + 8 * MiB;
constexpr size_t WS_LT   = WS_R2;
constexpr size_t WS_MG   = WS_R2;
constexpr size_t WS_AF   = WS_R2 + 64 * MiB;
constexpr size_t WS_PT   = WS_LT + 128 * MiB;
constexpr size_t WS_DEC  = WS_PT + 64 * MiB;
constexpr size_t WS_MASK = WS_DEC + 1 * MiB;
constexpr size_t WS_YA   = WS_MASK + 8 * MiB;
constexpr size_t WS_YB   = WS_YA + 32 * MiB;
constexpr size_t WS_KI   = WS_YB + 32 * MiB;
constexpr size_t WS_WI   = WS_KI + 2 * MiB;
constexpr size_t WS_PB   = WS_WI + 1 * MiB;
constexpr size_t WS_END  = WS_PB + 8 * MiB;
static_assert(WS_END < 1360000000ull, "workspace budget");
constexpr size_t SCORE_B = (size_t)4096 * 2080;

namespace pg8 {
#define PG8_LAS __attribute__((address_space(3)))
typedef unsigned short bf16_t;
typedef short bf16x8 __attribute__((ext_vector_type(8)));
typedef float f32x4 __attribute__((ext_vector_type(4)));
typedef unsigned u32x4 __attribute__((ext_vector_type(4)));
constexpr int BM = 256, BK = 64, HALF = 128, HTB = HALF * BK * 2  , STAGE_BYTES = 8 * HTB, NXCD = 8, WGM = 8;

__host__ __device__ __forceinline__ int lds_byte(int r, int c) { const int st = (r >> 4) * 2 + (c >> 5), rr = r & 15, cc = c & 31, ob = rr * 64 + cc * 2; return st * 1024 + (ob ^ (((ob >> 9) & 1) << 5)); }
__host__ __device__ __forceinline__ void stage_rc(int b, int& R, int& C) { const int st = b / 1024, sb = b % 1024, swz = sb ^ (((sb >> 9) & 1) << 5); R = (st >> 1) * 16 + swz / 64; C = (st & 1) * 32 + (swz % 64) / 2; }
__host__ __device__ __forceinline__ int perm32(int rho) { const int n = rho >> 4, i = rho & 15; return 8 * (i >> 2) + 4 * n + (i & 3); }

struct Unit { int pm, pn; };
struct Gemm { const bf16_t* A; const bf16_t* Bt; int M, N, K; };

struct StaticOrder {
    int nM, nN, nwg, G, c;
    __host__ __device__ void init(int M, int N, int G_, int c_) { nM = M / BM; nN = N / BM; nwg = nM * nN; G = G_; c = c_; }
    __host__ __device__ bool next(int i, Unit& u) const {
        const long L = (long)i * G + c; if (L >= nwg) return false;
        int wgid = (int)L; { const int q = nwg / NXCD, r = nwg % NXCD, xcd = wgid % NXCD, off = wgid / NXCD; wgid = (xcd < r ? xcd * (q + 1) : r * (q + 1) + (xcd - r) * q) + off; }
        const int nig = WGM * nN, gid = wgid / nig, fm = gid * WGM, gsz = (nM - fm) < WGM ? (nM - fm) : WGM;
        u.pm = fm + ((wgid % nig) % gsz); u.pn = (wgid % nig) / gsz; return true;
    }
    __device__ __forceinline__ void a_ready(const Unit&) const {}
    __device__ __forceinline__ void done(const Unit&) const {}
};

typedef float pk_f32x2 __attribute__((ext_vector_type(2)));
typedef __bf16 pk_bf16x2 __attribute__((ext_vector_type(2)));
__device__ __forceinline__ unsigned cvt_pk_bf16(float lo, float hi) { const pk_f32x2 v = {lo, hi}; const pk_bf16x2 b = __builtin_convertvector(v, pk_bf16x2); return __builtin_bit_cast(unsigned, b); }
typedef unsigned u32x2 __attribute__((ext_vector_type(2)));
typedef float f32x2 __attribute__((ext_vector_type(2)));
__device__ __forceinline__ u32x4 pack8(const f32x4 a, const f32x4 b) { u32x4 w; w.x = cvt_pk_bf16(a[0], a[1]); w.y = cvt_pk_bf16(a[2], a[3]); w.z = cvt_pk_bf16(b[0], b[1]); w.w = cvt_pk_bf16(b[2], b[3]); return w; }
__device__ __forceinline__ void unpack8(const u32x4 w, f32x4& a, f32x4& b) {
    a[0] = __uint_as_float(w.x << 16); a[1] = __uint_as_float(w.x & 0xffff0000u); a[2] = __uint_as_float(w.y << 16); a[3] = __uint_as_float(w.y & 0xffff0000u);
    b[0] = __uint_as_float(w.z << 16); b[1] = __uint_as_float(w.z & 0xffff0000u); b[2] = __uint_as_float(w.w << 16); b[3] = __uint_as_float(w.w & 0xffff0000u); }
__device__ __forceinline__ float sigm(float x) { return __builtin_amdgcn_rcpf(1.0f + __expf(-x)); }
__device__ __forceinline__ f32x4 sigm4(const f32x4 x) { f32x4 r; r[0] = sigm(x[0]); r[1] = sigm(x[1]); r[2] = sigm(x[2]); r[3] = sigm(x[3]); return r; }
__device__ __forceinline__ f32x4 silu4(const f32x4 x) { return x * sigm4(x); }

#define PG8_GAS __attribute__((address_space(1)))
struct EpiIn {
    static constexpr bool PERM = true, AFTER_DRAIN = false;
    unsigned char* ws0; int layer;
    __device__ __forceinline__ void operator()(const f32x4 (&acc)[2][2][4][2], const Unit& u, int wr, int wc, int fr, int fq) const {
        unsigned char* wsq = ws0; asm volatile("" : "+s"(wsq)); PG8_GAS unsigned char* const ws = (PG8_GAS unsigned char*)wsq;
        const int pn = u.pn, row0 = u.pm * BM + wr * 64 + fr, cw = wc * 32 + 8 * fq;
        PG8_GAS bf16_t* const QA = (PG8_GAS bf16_t*)(ws + WS_QA); PG8_GAS bf16_t* const KA = (PG8_GAS bf16_t*)(ws + WS_KA); PG8_GAS bf16_t* const VA = (PG8_GAS bf16_t*)(ws + WS_VA); PG8_GAS bf16_t* const GA = (PG8_GAS bf16_t*)(ws + WS_GA);
        PG8_GAS bf16_t* const QB = (PG8_GAS bf16_t*)(ws + WS_QB); PG8_GAS bf16_t* const KB = (PG8_GAS bf16_t*)(ws + WS_KB); PG8_GAS bf16_t* const VB = (PG8_GAS bf16_t*)(ws + WS_VB); PG8_GAS bf16_t* const QI = (PG8_GAS bf16_t*)(ws + WS_QI);
        PG8_GAS bf16_t* const SGA = (PG8_GAS bf16_t*)(ws + WS_SGA); PG8_GAS bf16_t* const SGB = (PG8_GAS bf16_t*)(ws + WS_SGB); PG8_GAS float* const LF = (PG8_GAS float*)(ws + WS_LF); PG8_GAS float* const IKW = (PG8_GAS float*)(ws + WS_IKW);
        const PG8_GAS float* const lb = (const PG8_GAS float*)(ws + WS_LB) + layer * 1024; const PG8_GAS float* const cosh = (const PG8_GAS float*)(ws + WS_COSH); const PG8_GAS float* const sinh = (const PG8_GAS float*)(ws + WS_SINH);
        const PG8_GAS float* const cosi = (const PG8_GAS float*)(ws + WS_COSI); const PG8_GAS float* const sini = (const PG8_GAS float*)(ws + WS_SINI);
        if (pn < 32) {
            const int seg = pn >> 2, cb = (pn & 3) * 256;
            if (seg == 4 || seg == 5) {
                PG8_GAS bf16_t* O = (seg == 4) ? QB : KB; const int head = (pn & 3) * 2 + (wc >> 1), i0 = (wc & 1) * 32 + 8 * fq;
#pragma unroll
                for (int ai = 0; ai < 2; ++ai)
#pragma unroll
                    for (int m = 0; m < 4; ++m) { const int row = row0 + ai * HALF + m * 16;
                        const PG8_GAS float* cp = cosh + (size_t)row * 64 + i0; const PG8_GAS float* sp = sinh + (size_t)row * 64 + i0;
                        const f32x4 c0 = *(const PG8_GAS f32x4*)cp, c1 = *(const PG8_GAS f32x4*)(cp + 4), s0 = *(const PG8_GAS f32x4*)sp, s1 = *(const PG8_GAS f32x4*)(sp + 4);
                        const f32x4 xa = acc[ai][0][m][0], xb = acc[ai][0][m][1], ya = acc[ai][1][m][0], yb = acc[ai][1][m][1];
                        PG8_GAS bf16_t* rp = O + (size_t)row * 1024 + head * 128 + i0;
                        *(PG8_GAS u32x4*)rp = pack8(xa * c0 - ya * s0, xb * c1 - yb * s1);
                        *(PG8_GAS u32x4*)(rp + 64) = pack8(xa * s0 + ya * c0, xb * s1 + yb * c1); asm volatile("" ::: "memory"); }
            } else if (seg == 7) {
                const int head = (pn & 3) * 4 + wc, i0 = 8 * fq;
#pragma unroll
                for (int ai = 0; ai < 2; ++ai)
#pragma unroll
                    for (int m = 0; m < 4; ++m) { const int row = row0 + ai * HALF + m * 16;
                        const PG8_GAS float* cp = cosi + (size_t)row * 32 + i0; const PG8_GAS float* sp = sini + (size_t)row * 32 + i0;
                        const f32x4 c0 = *(const PG8_GAS f32x4*)cp, c1 = *(const PG8_GAS f32x4*)(cp + 4), s0 = *(const PG8_GAS f32x4*)sp, s1 = *(const PG8_GAS f32x4*)(sp + 4);
                        const f32x4 xa = acc[ai][0][m][0], xb = acc[ai][0][m][1], ya = acc[ai][1][m][0], yb = acc[ai][1][m][1];
                        PG8_GAS bf16_t* rp = QI + (size_t)row * 1024 + head * 64 + i0;
                        *(PG8_GAS u32x4*)rp = pack8(xa * c0 - ya * s0, xb * c1 - yb * s1);
                        *(PG8_GAS u32x4*)(rp + 32) = pack8(xa * s0 + ya * c0, xb * s1 + yb * c1); asm volatile("" ::: "memory"); }
            } else if (seg == 1) {
#pragma unroll
                for (int bj = 0; bj < 2; ++bj) { const int col = cb + bj * HALF + cw;
                    const f32x4 l0 = *(const PG8_GAS f32x4*)(lb + col), l1 = *(const PG8_GAS f32x4*)(lb + col + 4);
#pragma unroll
                    for (int ai = 0; ai < 2; ++ai)
#pragma unroll
                        for (int m = 0; m < 4; ++m) { const int row = row0 + ai * HALF + m * 16; f32x4 lf[2], kk[2];
#pragma unroll
                            for (int n = 0; n < 2; ++n) { const f32x4 x = acc[ai][bj][m][n]; const f32x4 lv = n ? l1 : l0;
#pragma unroll
                                for (int j = 0; j < 4; ++j) { const float xe = fminf(fmaxf(x[j], -80.f), 80.f), e = __expf(-xe), r = __builtin_amdgcn_rcpf(1.0f + e);
                                    const float om = 1.0f - lv[j]; lf[n][j] = logf(lv[j] + om * r); kk[n][j] = om * (e * r); } }
                            PG8_GAS float* lp = LF + (size_t)row * 1024 + col; *(PG8_GAS f32x4*)lp = lf[0]; *(PG8_GAS f32x4*)(lp + 4) = lf[1];
                            *(PG8_GAS u32x4*)(KA + (size_t)row * 1024 + col) = pack8(kk[0], kk[1]); asm volatile("" ::: "memory"); } }
            } else {
                PG8_GAS bf16_t* O = (seg == 0) ? QA : (seg == 2) ? VA : (seg == 3) ? GA : VB; const bool act = (seg == 0 || seg == 3);
#pragma unroll
                for (int ai = 0; ai < 2; ++ai)
#pragma unroll
                    for (int m = 0; m < 4; ++m) { const int row = row0 + ai * HALF + m * 16;
#pragma unroll
                        for (int bj = 0; bj < 2; ++bj) { f32x4 v0 = acc[ai][bj][m][0], v1 = acc[ai][bj][m][1];
                            if (act) { v0 = silu4(v0); v1 = silu4(v1); }
                            *(PG8_GAS u32x4*)(O + (size_t)row * 1024 + cb + bj * HALF + cw) = pack8(v0, v1); } }
            }
        } else if (pn < 48) {
            PG8_GAS bf16_t* O = (pn < 40) ? SGA : SGB; const int cb = ((pn - 32) & 7) * 256;
#pragma unroll
            for (int ai = 0; ai < 2; ++ai)
#pragma unroll
                for (int m = 0; m < 4; ++m) { const int row = row0 + ai * HALF + m * 16;
#pragma unroll
                    for (int bj = 0; bj < 2; ++bj)
                        *(PG8_GAS u32x4*)(O + (size_t)row * DM + cb + bj * HALF + cw) = pack8(sigm4(acc[ai][bj][m][0]), sigm4(acc[ai][bj][m][1])); }
        } else {
#pragma unroll
            for (int ai = 0; ai < 2; ++ai)
#pragma unroll
                for (int m = 0; m < 4; ++m) { PG8_GAS float* p = IKW + (size_t)(row0 + ai * HALF + m * 16) * 128 + cw; *(PG8_GAS f32x4*)p = acc[ai][0][m][0]; *(PG8_GAS f32x4*)(p + 4) = acc[ai][0][m][1]; }
        }
    }
};
struct EpiGateA {
    static constexpr bool PERM = true, AFTER_DRAIN = false;
    unsigned char* ws;
    __device__ __forceinline__ void operator()(const f32x4 (&acc)[2][2][4][2], const Unit& u, int wr, int wc, int fr, int fq) const {
        unsigned char* const wg = as_global(ws); const bf16_t* const SG = (const bf16_t*)(wg + WS_SGA); bf16_t* const AF = (bf16_t*)(wg + WS_AF);
        const int row0 = u.pm * BM + wr * 64 + fr, col0 = u.pn * BM + wc * 32 + 8 * fq;
#pragma unroll
        for (int ai = 0; ai < 2; ++ai)
#pragma unroll
            for (int m = 0; m < 4; ++m) { const size_t off = (size_t)(row0 + ai * HALF + m * 16) * DM + col0;
#pragma unroll
                for (int bj = 0; bj < 2; ++bj) { f32x4 g0, g1; unpack8(*(const u32x4*)(SG + off + bj * HALF), g0, g1);
                    *(u32x4*)(AF + off + bj * HALF) = pack8(g0 * acc[ai][bj][m][0], g1 * acc[ai][bj][m][1]); } asm volatile("" ::: "memory"); }
    }
};
struct EpiGateB {
    static constexpr bool PERM = true, AFTER_DRAIN = false;
    unsigned char* ws;
    __device__ __forceinline__ void operator()(const f32x4 (&acc)[2][2][4][2], const Unit& u, int wr, int wc, int fr, int fq) const {
        unsigned char* const wg = as_global(ws); const bf16_t* const SG = (const bf16_t*)(wg + WS_SGB); const bf16_t* const AF = (const bf16_t*)(wg + WS_AF); bf16_t* const MG = (bf16_t*)(wg + WS_MG);
        const int row0 = u.pm * BM + wr * 64 + fr, col0 = u.pn * BM + wc * 32 + 8 * fq;
#pragma unroll
        for (int ai = 0; ai < 2; ++ai)
#pragma unroll
            for (int m = 0; m < 4; ++m) { const size_t off = (size_t)(row0 + ai * HALF + m * 16) * DM + col0;
#pragma unroll
                for (int bj = 0; bj < 2; ++bj) { f32x4 g0, g1; unpack8(*(const u32x4*)(SG + off + bj * HALF), g0, g1);
                    f32x4 a0, a1; unpack8(*(const u32x4*)(AF + off + bj * HALF), a0, a1);
                    *(u32x4*)(MG + off + bj * HALF) = pack8(a0 + g0 * acc[ai][bj][m][0], a1 + g1 * acc[ai][bj][m][1]); } asm volatile("" ::: "memory"); }
    }
};
template <bool PLAIN> struct EpiRes {
    static constexpr bool PERM = true, AFTER_DRAIN = false;
    const float* X; const float* g; const float* b; unsigned char* ws;
    __device__ __forceinline__ void operator()(const f32x4 (&acc)[2][2][4][2], const Unit& u, int wr, int wc, int fr, int fq) const {
        unsigned char* const wg = as_global(ws); float* const XP = (float*)(wg + WS_XPRE); const float* const ST = (const float*)(wg + WS_STATS); const float* const Xg = as_global(X);
        const int row0 = u.pm * BM + wr * 64 + fr, col0 = u.pn * BM + wc * 32 + 8 * fq;
        f32x4 gv[2][2], bv[2][2];
        if (!PLAIN) { const float* gg = as_global(g); const float* bb = as_global(b);
#pragma unroll
            for (int bj = 0; bj < 2; ++bj)
#pragma unroll
                for (int n = 0; n < 2; ++n) { gv[bj][n] = *(const f32x4*)(gg + col0 + bj * HALF + 4 * n); bv[bj][n] = *(const f32x4*)(bb + col0 + bj * HALF + 4 * n); } }
#pragma unroll
        for (int ai = 0; ai < 2; ++ai)
#pragma unroll
            for (int m = 0; m < 4; ++m) { const int row = row0 + ai * HALF + m * 16; const size_t off = (size_t)row * DM + col0;
                float mean = 0.f, rstd = 1.f; if (!PLAIN) { const f32x2 s2 = *(const f32x2*)(ST + 2 * (size_t)row); mean = s2[0]; rstd = s2[1]; }
#pragma unroll
                for (int bj = 0; bj < 2; ++bj) { float* p = XP + off + bj * HALF; f32x4 x0, x1;
                    if (PLAIN) { const float* xp = Xg + off + bj * HALF; x0 = *(const f32x4*)xp; x1 = *(const f32x4*)(xp + 4); }
                    else { x0 = (*(const f32x4*)p - mean) * rstd * gv[bj][0] + bv[bj][0]; x1 = (*(const f32x4*)(p + 4) - mean) * rstd * gv[bj][1] + bv[bj][1]; }
                    *(f32x4*)p = x0 * ALPHA + acc[ai][bj][m][0]; *(f32x4*)(p + 4) = x1 * ALPHA + acc[ai][bj][m][1]; } asm volatile("" ::: "memory"); }
    }
};
struct EpiSwiGLU {
    static constexpr bool PERM = true, AFTER_DRAIN = false;
    unsigned char* ws;
    __device__ __forceinline__ void operator()(const f32x4 (&acc)[2][2][4][2], const Unit& u, int wr, int wc, int fr, int fq) const {
        bf16_t* const H = (bf16_t*)(as_global(ws) + WS_H);
        const int row0 = u.pm * BM + wr * 64 + fr, col0 = u.pn * HALF + wc * 32 + 8 * fq;
#pragma unroll
        for (int ai = 0; ai < 2; ++ai)
#pragma unroll
            for (int m = 0; m < 4; ++m)
                *(u32x4*)(H + (size_t)(row0 + ai * HALF + m * 16) * DFF + col0) = pack8(silu4(acc[ai][0][m][0]) * acc[ai][1][m][0], silu4(acc[ai][0][m][1]) * acc[ai][1][m][1]);
    }
};
struct EpiF32P {
    static constexpr bool PERM = true, AFTER_DRAIN = false;
    unsigned char* ws;
    __device__ __forceinline__ void operator()(const f32x4 (&acc)[2][2][4][2], const Unit& u, int wr, int wc, int fr, int fq) const {
        bf16_t* const C = (bf16_t*)(as_global(ws) + WS_PP);
        const int row0 = u.pm * BM + wr * 64 + fr, col0 = u.pn * BM + wc * 32 + 8 * fq;
#pragma unroll
        for (int ai = 0; ai < 2; ++ai)
#pragma unroll
            for (int m = 0; m < 4; ++m) { const size_t off = (size_t)(row0 + ai * HALF + m * 16) * DM + col0;
#pragma unroll
                for (int bj = 0; bj < 2; ++bj) *(u32x4*)(C + off + bj * HALF) = pack8(acc[ai][bj][m][0], acc[ai][bj][m][1]); }
    }
};
struct EpiPle {
    static constexpr bool PERM = true, AFTER_DRAIN = false;
    const float* g; const float* b; unsigned char* ws;
    __device__ __forceinline__ void operator()(const f32x4 (&acc)[2][2][4][2], const Unit& u, int wr, int wc, int fr, int fq) const {
        unsigned char* const wg = as_global(ws); const bf16_t* const PP = (const bf16_t*)(wg + WS_PP); float* const XP = (float*)(wg + WS_XPRE); const float* const ST = (const float*)(wg + WS_STATS);
        const int row0 = u.pm * BM + wr * 64 + fr, col0 = u.pn * BM + wc * 32 + 8 * fq;
        f32x4 gv[2][2], bv[2][2]; { const float* gg = as_global(g); const float* bb = as_global(b);
#pragma unroll
            for (int bj = 0; bj < 2; ++bj)
#pragma unroll
                for (int n = 0; n < 2; ++n) { gv[bj][n] = *(const f32x4*)(gg + col0 + bj * HALF + 4 * n); bv[bj][n] = *(const f32x4*)(bb + col0 + bj * HALF + 4 * n); } }
#pragma unroll
        for (int ai = 0; ai < 2; ++ai)
#pragma unroll
            for (int m = 0; m < 4; ++m) { const int row = row0 + ai * HALF + m * 16; const size_t off = (size_t)row * DM + col0;
                const f32x2 s2 = *(const f32x2*)(ST + 2 * (size_t)row); const float mean = s2[0], rstd = s2[1];
#pragma unroll
                for (int bj = 0; bj < 2; ++bj) { float* p = XP + off + bj * HALF; f32x4 p0, p1; unpack8(*(const u32x4*)(PP + off + bj * HALF), p0, p1);
                    const f32x4 x0 = (*(const f32x4*)p - mean) * rstd * gv[bj][0] + bv[bj][0], x1 = (*(const f32x4*)(p + 4) - mean) * rstd * gv[bj][1] + bv[bj][1];
                    *(f32x4*)p = x0 * ALPHA + sigm4(acc[ai][bj][m][0]) * p0; *(f32x4*)(p + 4) = x1 * ALPHA + sigm4(acc[ai][bj][m][1]) * p1; } asm volatile("" ::: "memory"); }
    }
};

template <class Epi, class Sched, bool ALIGN_EPI = false, bool SP2 = false>
__device__ __forceinline__ void gemm_phase(PG8_LAS unsigned char* lds, const Gemm g, const Sched& S, const Epi& E) {
    const int tid = tid_(), wid = __builtin_amdgcn_readfirstlane(tid >> 6), lane = tid & 63, wr = wid >> 2, wc = wid & 3, fr = lane & 15, fq = lane >> 4;
    int Kq = g.K; asm volatile("" : "+s"(Kq)); const int K = Kq, nt = K / BK;
    unsigned voffA[2], voffB[2];
#pragma unroll
    for (int i = 0; i < 2; ++i) { int R, C; stage_rc(tid * 16 + i * 8192, R, C); const int Rb = Epi::PERM ? ((R & ~31) + perm32(R & 31)) : R;
        voffA[i] = (unsigned)(R * K + C) * 2u; voffB[i] = (unsigned)(Rb * K + C) * 2u; }
    const size_t kstep = (size_t)(BK * 2);
    const size_t hstep = (size_t)HALF * K * 2;
    const size_t tstep = 2 * hstep;
    const unsigned ldsw = (unsigned)wid * 1024u;
    const int aoff = lds_byte(wr * 64 + fr, fq * 8), boff = lds_byte(wc * 32 + fr, fq * 8);
#define PG8_SA(b, h) (((b) * 2 + (h)) * HTB)
#define PG8_SB(b, h) ((4 + (b) * 2 + (h)) * HTB)
#define PG8_STAGE(bufoff, gbase, voff) do { _Pragma("unroll") for (int _i = 0; _i < 2; ++_i) \
        __builtin_amdgcn_global_load_lds((const unsigned*)((const char*)(gbase) + (voff)[_i]), (PG8_LAS unsigned*)(lds + (bufoff) + ldsw + _i * 8192), 16, 0, 0); } while (0)
#define PG8_LDA(dst, b, h) do { _Pragma("unroll") for (int m = 0; m < 4; ++m) _Pragma("unroll") for (int k = 0; k < 2; ++k) dst[m][k] = *(const PG8_LAS bf16x8*)(lds + PG8_SA(b, h) + aoff + m * 2048 + k * 1024); } while (0)
#define PG8_LDB(dst, b, h) do { _Pragma("unroll") for (int n = 0; n < 2; ++n) _Pragma("unroll") for (int k = 0; k < 2; ++k) dst[n][k] = *(const PG8_LAS bf16x8*)(lds + PG8_SB(b, h) + boff + n * 2048 + k * 1024); } while (0)
#define PG8_MMA(ai, bj, At, Bt) do { __builtin_amdgcn_s_setprio(1); _Pragma("unroll") for (int m = 0; m < 4; ++m) _Pragma("unroll") for (int n = 0; n < 2; ++n) _Pragma("unroll") for (int k = 0; k < 2; ++k) \
        acc[ai][bj][m][n] = __builtin_amdgcn_mfma_f32_16x16x32_bf16(Bt[n][k], At[m][k], acc[ai][bj][m][n], 0, 0, 0); __builtin_amdgcn_s_setprio(0); } while (0)
#define PG8_WAIT_V(n) asm volatile("s_waitcnt vmcnt(" #n ")" ::: "memory")
#define PG8_WAIT_L(n) asm volatile("s_waitcnt lgkmcnt(" #n ")" ::: "memory")
#define PG8_BAR __builtin_amdgcn_s_barrier()
#define PG8_SCHED __builtin_amdgcn_sched_barrier(0)
    Unit cur, nxt; int ui = 0;
    if (!S.next(0, cur)) return;
    f32x4 acc[2][2][4][2];
#pragma unroll
    for (int a = 0; a < 2; ++a)
#pragma unroll
        for (int b = 0; b < 2; ++b)
#pragma unroll
            for (int m = 0; m < 4; ++m)
#pragma unroll
                for (int n = 0; n < 2; ++n) acc[a][b][m][n] = (f32x4){0.f, 0.f, 0.f, 0.f};
    bf16x8 At[4][2], B0[2][2], B1[2][2];
    const char* cA = (const char*)g.A + (size_t)cur.pm * tstep; const char* cB = (const char*)g.Bt + (size_t)cur.pn * tstep;
    S.a_ready(cur);
    if constexpr (SP2) {
        PG8_STAGE(PG8_SB(0, 0), cB, voffB); PG8_STAGE(PG8_SB(0, 1), cB + hstep, voffB); PG8_STAGE(PG8_SA(0, 0), cA, voffA); PG8_STAGE(PG8_SA(0, 1), cA + hstep, voffA);
        if (wr == 1) PG8_BAR;
        PG8_WAIT_V(2); PG8_BAR;
        PG8_STAGE(PG8_SB(1, 0), cB + kstep, voffB); PG8_STAGE(PG8_SA(1, 0), cA + kstep, voffA); PG8_STAGE(PG8_SB(1, 1), cB + hstep + kstep, voffB);
        PG8_WAIT_V(6); PG8_BAR;
    } else {
        PG8_STAGE(PG8_SB(0, 0), cB, voffB); PG8_STAGE(PG8_SA(0, 0), cA, voffA); PG8_STAGE(PG8_SB(0, 1), cB + hstep, voffB); PG8_STAGE(PG8_SA(0, 1), cA + hstep, voffA);
        if (wr == 1) PG8_BAR;
        PG8_WAIT_V(4); PG8_BAR;
        PG8_STAGE(PG8_SB(1, 0), cB + kstep, voffB); PG8_STAGE(PG8_SA(1, 0), cA + kstep, voffA); PG8_STAGE(PG8_SB(1, 1), cB + hstep + kstep, voffB);
        PG8_WAIT_V(6); PG8_BAR;
    }
    for (;;) {
        const bool has_next = S.next(ui + 1, nxt);
        const char* nA = has_next ? (const char*)g.A + (size_t)nxt.pm * tstep : cA; const char* nB = has_next ? (const char*)g.Bt + (size_t)nxt.pn * tstep : cB;
        for (int t = 0; t < nt; t += 2) {
            const bool last = (t == nt - 2);
            const char* a1 = cA + (size_t)(t + 1) * kstep;
            const char* a2 = last ? nA : cA + (size_t)(t + 2) * kstep; const char* b2 = last ? nB : cB + (size_t)(t + 2) * kstep;
            const char* a3 = a2 + kstep; const char* b3 = b2 + kstep;
            if (last && has_next) S.a_ready(nxt);
            if constexpr (SP2) {
            PG8_LDB(B0, 0, 0); PG8_LDB(B1, 0, 1); PG8_SCHED; PG8_LDA(At, 0, 0); PG8_STAGE(PG8_SA(1, 1), a1 + hstep, voffA);
            PG8_WAIT_V(8); PG8_WAIT_L(0); PG8_BAR; PG8_MMA(0, 0, At, B0); PG8_MMA(0, 1, At, B1); PG8_BAR; PG8_SCHED;
            PG8_LDA(At, 0, 1); PG8_STAGE(PG8_SB(0, 0), b2, voffB); PG8_STAGE(PG8_SB(0, 1), b2 + hstep, voffB); PG8_STAGE(PG8_SA(0, 0), a2, voffA);
            PG8_WAIT_V(8); PG8_WAIT_L(0); PG8_BAR; PG8_MMA(1, 0, At, B0); PG8_MMA(1, 1, At, B1); PG8_BAR; PG8_SCHED;
            PG8_LDB(B0, 1, 0); PG8_LDB(B1, 1, 1); PG8_SCHED; PG8_LDA(At, 1, 0); PG8_STAGE(PG8_SA(0, 1), a2 + hstep, voffA);
            PG8_WAIT_V(8); PG8_WAIT_L(0); PG8_BAR; PG8_MMA(0, 0, At, B0); PG8_MMA(0, 1, At, B1); PG8_BAR; PG8_SCHED;
            PG8_LDA(At, 1, 1); PG8_STAGE(PG8_SB(1, 0), b3, voffB); PG8_STAGE(PG8_SB(1, 1), b3 + hstep, voffB); PG8_STAGE(PG8_SA(1, 0), a3, voffA);
            PG8_WAIT_V(8); PG8_WAIT_L(0); PG8_BAR; PG8_MMA(1, 0, At, B0); PG8_MMA(1, 1, At, B1); PG8_BAR; PG8_SCHED;
            } else {
            PG8_LDB(B0, 0, 0); PG8_SCHED; PG8_LDA(At, 0, 0); PG8_STAGE(PG8_SA(1, 1), a1 + hstep, voffA);
            PG8_WAIT_L(8); PG8_BAR; PG8_WAIT_L(0); PG8_MMA(0, 0, At, B0); PG8_BAR; PG8_SCHED;
            PG8_LDB(B1, 0, 1); PG8_STAGE(PG8_SB(0, 0), b2, voffB);
            PG8_BAR; PG8_WAIT_L(0); PG8_MMA(0, 1, At, B1); PG8_BAR;
            PG8_LDA(At, 0, 1); PG8_STAGE(PG8_SA(0, 0), a2, voffA);
            PG8_BAR; PG8_WAIT_L(0); PG8_MMA(1, 0, At, B0); PG8_BAR; PG8_SCHED;
            PG8_STAGE(PG8_SB(0, 1), b2 + hstep, voffB);
            PG8_WAIT_V(6); PG8_BAR; PG8_MMA(1, 1, At, B1); PG8_BAR;
            PG8_LDB(B0, 1, 0); PG8_SCHED; PG8_LDA(At, 1, 0); PG8_STAGE(PG8_SA(0, 1), a2 + hstep, voffA);
            PG8_WAIT_L(8); PG8_BAR; PG8_WAIT_L(0); PG8_MMA(0, 0, At, B0); PG8_BAR; PG8_SCHED;
            PG8_LDB(B1, 1, 1); PG8_STAGE(PG8_SB(1, 0), b3, voffB);
            PG8_BAR; PG8_WAIT_L(0); PG8_MMA(0, 1, At, B1); PG8_BAR;
            PG8_LDA(At, 1, 1); PG8_STAGE(PG8_SA(1, 0), a3, voffA);
            PG8_BAR; PG8_WAIT_L(0); PG8_MMA(1, 0, At, B0); PG8_BAR; PG8_SCHED;
            PG8_STAGE(PG8_SB(1, 1), b3 + hstep, voffB);
            PG8_WAIT_V(6); PG8_BAR; PG8_MMA(1, 1, At, B1); PG8_BAR;
            }
        }
        if constexpr (ALIGN_EPI) { if (wr == 0) PG8_BAR; }
        if constexpr (!Epi::AFTER_DRAIN) { E(acc, cur, wr, wc, fr, fq); S.done(cur); }
        if (!has_next) break;
#pragma unroll
        for (int a = 0; a < 2; ++a)
#pragma unroll
            for (int b = 0; b < 2; ++b)
#pragma unroll
                for (int m = 0; m < 4; ++m)
#pragma unroll
                    for (int n = 0; n < 2; ++n) acc[a][b][m][n] = (f32x4){0.f, 0.f, 0.f, 0.f};
        cur = nxt; cA = nA; cB = nB; ++ui;
        if constexpr (ALIGN_EPI) { if (wr == 1) PG8_BAR; }
    }
    PG8_WAIT_V(0);
    if constexpr (!ALIGN_EPI) { if (wr == 0) PG8_BAR; }
    PG8_BAR;
    if constexpr (Epi::AFTER_DRAIN) { E.fused(acc, cur, wr, wc, fr, fq, lds, wid, lane); S.done(cur); }
#undef PG8_SA
#undef PG8_SB
#undef PG8_STAGE
#undef PG8_LDA
#undef PG8_LDB
#undef PG8_MMA
#undef PG8_WAIT_V
#undef PG8_WAIT_L
#undef PG8_BAR
#undef PG8_SCHED
}
}
#define XB_TMO      128
#define XB_XCNT(j)  (256  + 64 * (j))
#define XB_XSUB(j)  (1280 + 64 * (j))
#define XB_XGEN(j)  (2304 + 64 * (j))
#define XB_TOP      3328
#define XB_TOPGEN   3392
#define XCD_BAR_WORDS 3456
#define XB_SPIN_CAP (1u << 18)
#define LAS __attribute__((address_space(3)))

__device__ __forceinline__ unsigned xb_ld(unsigned* p)              { return __hip_atomic_load(p, __ATOMIC_RELAXED, __HIP_MEMORY_SCOPE_AGENT); }
__device__ __forceinline__ unsigned xb_add(unsigned* p, unsigned v) { return __hip_atomic_fetch_add(p, v, __ATOMIC_RELAXED, __HIP_MEMORY_SCOPE_AGENT); }
__device__ __forceinline__ unsigned xb_xcc_id() { return (unsigned)__builtin_amdgcn_s_getreg((3 << 11) | 20) & 0xFu; }
#define XB_SPIN(cond, bar) do { unsigned _sp = 0; while (cond) { __builtin_amdgcn_s_sleep(1); \
    if ((++_sp & 255u) == 0u) { if (xb_ld(&(bar)[XB_TMO])) break; if (_sp > XB_SPIN_CAP) { atomicAdd(&(bar)[XB_TMO], 1u); break; } } } } while (0)

struct XcdBarrier {
    unsigned* bar; unsigned x;
    volatile LAS unsigned* st;
};

__device__ __forceinline__ XcdBarrier xcd_barrier_post(unsigned* bar, volatile LAS unsigned* st) {
    XcdBarrier b; b.bar = bar; b.x = xb_xcc_id(); b.st = st;
    if (threadIdx.x == 0) (void)xb_add(&bar[XB_XCNT(b.x)], 1u);
    return b;
}
__device__ __forceinline__ void xcd_barrier_complete(unsigned* bar, unsigned x, unsigned& nloc, unsigned& nx) {
    const unsigned G = gridDim.x * gridDim.y * gridDim.z;
    unsigned sum, cnt, mine, sp = 0u;
    for (;;) {
        sum = 0u; cnt = 0u; mine = 0u;
#pragma unroll
        for (unsigned j = 0; j < 16; ++j) { const unsigned c = xb_ld(&bar[XB_XCNT(j)]); sum += c; cnt += (c > 0u) ? 1u : 0u; mine = (j == x) ? c : mine; }
        if (sum == G) break;
        __builtin_amdgcn_s_sleep(1);
        if ((++sp & 255u) == 0u) { if (xb_ld(&bar[XB_TMO])) break; if (sp > XB_SPIN_CAP) { atomicAdd(&bar[XB_TMO], 1u); break; } }
    }
    nloc = mine > 0u ? mine : 1u; nx = cnt > 0u ? cnt : 1u;
}

__device__ __forceinline__ void xcd_barrier(const XcdBarrier& b) {
    asm volatile("s_waitcnt vmcnt(0)" ::: "memory");
    __syncthreads();
    if (threadIdx.x == 0) {
        unsigned* bar = b.bar;
        __builtin_amdgcn_s_waitcnt(0);
        const unsigned bx = xb_xcc_id();
        unsigned nloc = b.st[0], nx = b.st[1];
        if (nloc == 0u) { xcd_barrier_complete(bar, bx, nloc, nx); b.st[0] = nloc; b.st[1] = nx; }
        const unsigned old = xb_add(&bar[XB_XSUB(bx)], 1u);
        const unsigned gen = old / nloc;
        if (old + 1u == (gen + 1u) * nloc) {
            __builtin_amdgcn_fence(__ATOMIC_RELEASE, "agent");
            asm volatile("s_waitcnt vmcnt(0)" ::: "memory");
            const unsigned og = xb_add(&bar[XB_TOP], 1u);
            const unsigned tg = og / nx;
            if (og + 1u == (tg + 1u) * nx) xb_add(&bar[XB_TOPGEN], 1u);
            else XB_SPIN(xb_ld(&bar[XB_TOPGEN]) == tg, bar);
            __builtin_amdgcn_fence(__ATOMIC_ACQUIRE, "agent");
            xb_add(&bar[XB_XGEN(bx)], 1u);
            asm volatile("s_waitcnt vmcnt(0)" ::: "memory");
        } else {
            XB_SPIN(xb_ld(&bar[XB_XGEN(bx)]) == gen, bar);
            __builtin_amdgcn_fence(__ATOMIC_ACQUIRE, "agent");
            asm volatile("s_waitcnt vmcnt(0)" ::: "memory");
        }
    }
    __syncthreads();
}

struct Params {
    const float* x; const float* p; const int* pos;
    const float *w_in, *w_a, *w_b, *w_out, *lbraw, *hnorm_g, *ikn_g, *ikn_b, *lnm_g, *lnm_b, *w_fg, *w_fu, *w_fd, *lnf_g, *lnf_b, *w_pg, *w_pp, *lnp_g, *lnp_b;
    float* out; unsigned char* ws;
    double invf_h[64]; double invf_i[32];
    int ph_lo, ph_hi;
};
typedef const __attribute__((address_space(4))) Params* KP;
__device__ __forceinline__ KP kparams() { KP p = (KP)__builtin_amdgcn_kernarg_segment_ptr(); asm volatile("" : "+s"(p)); return p; }
constexpr int NPH_LAYER = 14, NPH = DEPTH * NPH_LAYER;
constexpr int LDS_BYTES = 131072 + 1024;
constexpr int MISC_OFF = 131072;

__device__ __forceinline__ int wsrc_col_in(int n) {
    const int tile = n >> 8, t = n & 255;
    if (tile < 16) return n;
    if (tile < 24) { const int bj = t >> 7, u = t & 127, head = u >> 6, i = u & 63; return tile * 256 + 128 * head + 64 * bj + i; }
    if (tile < 28) return n;
    if (tile < 32) { const int bj = t >> 7, u = t & 127, head = u >> 5, i = u & 31; return tile * 256 + 64 * head + 32 * bj + i; }
    if (tile < 40) return 8272 + (n - 32 * 256);
    if (tile < 48) return 10320 + (n - 40 * 256);
    return t < 80 ? 8192 + t : -1;
}
constexpr int WC_LD = 144;
template <int KIND>
__device__ __forceinline__ void wconv_wave_tile(const float* src, const float* src2, int nsrc, int K, bf16_t* dst, int n0, int k0, int lane, LAS unsigned char* img) {
    const int n = n0 + lane; int c; const float* s = src;
    if (KIND == 0) c = n;
    else if (KIND == 1) c = wsrc_col_in(n);
    else { const int tl = n >> 8, t = n & 255; c = tl * 128 + (t & 127); if (t >= 128) s = src2; }
    float f[64];
    const float* sp = s + (size_t)k0 * nsrc + (c >= 0 ? c : 0);
#pragma unroll
    for (int kk = 0; kk < 64; ++kk) f[kk] = sp[(size_t)kk * nsrc];
#pragma unroll
    for (int i = 0; i < 8; ++i) { pg8::u32x4 w;
        w.x = pg8::cvt_pk_bf16(f[8 * i], f[8 * i + 1]); w.y = pg8::cvt_pk_bf16(f[8 * i + 2], f[8 * i + 3]); w.z = pg8::cvt_pk_bf16(f[8 * i + 4], f[8 * i + 5]); w.w = pg8::cvt_pk_bf16(f[8 * i + 6], f[8 * i + 7]);
        if (c < 0) w = (pg8::u32x4){0u, 0u, 0u, 0u};
        *(LAS pg8::u32x4*)(img + lane * WC_LD + 16 * i) = w; }
#pragma unroll
    for (int i = 0; i < 8; ++i) { const int p = lane + 64 * i, row = p >> 3, seg = p & 7;
        const pg8::u32x4 w = *(const LAS pg8::u32x4*)(img + row * WC_LD + 16 * seg);
        *(pg8::u32x4*)(dst + (size_t)(n0 + row) * K + k0 + 8 * seg) = w; }
}
template <int KIND>
__device__ __forceinline__ void wconv_job(const float* src, const float* src2, int nsrc, int K, bf16_t* dst, int ndst, int W, int NWV, int lane, LAS unsigned char* img, int& tcount) {
    const int kt = K / 64, ntiles = (ndst / 64) * kt;
    const int nb = ndst / 64; int first = (W - tcount % NWV + NWV) % NWV;
    for (int t = first; t < ntiles; t += NWV) wconv_wave_tile<KIND>(src, src2, nsrc, K, dst, (t % nb) * 64, (t / nb) * 64, lane, img);
    tcount += ntiles;
}
__device__ __forceinline__ void phase_wconv(KP P, int layer, LAS unsigned char* lds) {
    unsigned char* ws = as_global(P->ws); int tc = 0;
    const int tid0 = tid_(), lane = tid0 & 63, wv0 = __builtin_amdgcn_readfirstlane(tid0 >> 6), W = bid_() * 8 + wv0, NWV = nblk_() * 8;
    LAS unsigned char* img = lds + wv0 * (64 * WC_LD);
    wconv_job<1>(as_global(P->w_in) + (size_t)layer * DM * INW, nullptr, INW, DM, (bf16_t*)(ws + WS_WIN), INP, W, NWV, lane, img, tc);
    wconv_job<0>(as_global(P->w_a) + (size_t)layer * AW * DM, nullptr, DM, AW, (bf16_t*)(ws + WS_WA), DM, W, NWV, lane, img, tc);
    wconv_job<0>(as_global(P->w_b) + (size_t)layer * BW * DM, nullptr, DM, BW, (bf16_t*)(ws + WS_WB), DM, W, NWV, lane, img, tc);
    wconv_job<0>(as_global(P->w_out) + (size_t)layer * DM * DM, nullptr, DM, DM, (bf16_t*)(ws + WS_WO), DM, W, NWV, lane, img, tc);
    wconv_job<2>(as_global(P->w_fg) + (size_t)layer * DM * DFF, as_global(P->w_fu) + (size_t)layer * DM * DFF, DFF, DM, (bf16_t*)(ws + WS_WGU), 2 * DFF, W, NWV, lane, img, tc);
    wconv_job<0>(as_global(P->w_fd) + (size_t)layer * DFF * DM, nullptr, DM, DFF, (bf16_t*)(ws + WS_WDN), DM, W, NWV, lane, img, tc);
    wconv_job<0>(as_global(P->w_pg) + (size_t)layer * DM * DM, nullptr, DM, DM, (bf16_t*)(ws + WS_WPG), DM, W, NWV, lane, img, tc);
    wconv_job<0>(as_global(P->w_pp) + (size_t)layer * PLE * DM, nullptr, DM, PLE, (bf16_t*)(ws + WS_WPP), DM, W, NWV, lane, img, tc);
    const float* ps = as_global(P->p) + (size_t)layer * TOK * PLE; bf16_t* pb = (bf16_t*)(ws + WS_PB);
    for (size_t i = ((size_t)bid_() * 512 + tid_()) * 8; i < (size_t)TOK * PLE; i += (size_t)nblk_() * 512 * 8)
        *(pg8::u32x4*)(pb + i) = pg8::pack8(*(const pg8::f32x4*)(ps + i), *(const pg8::f32x4*)(ps + i + 4));
}
__device__ __forceinline__ void phase_prologue(KP P) {
    unsigned char* ws = as_global(P->ws); const size_t gtid = (size_t)bid_() * 512 + tid_(), gsz = (size_t)nblk_() * 512;
    bf16_t* xb = (bf16_t*)(ws + WS_XB); const float* xin = as_global(P->x); const int* posg = as_global(P->pos); const float* lbr = as_global(P->lbraw);
    for (size_t i = gtid * 8; i < (size_t)TOK * DM; i += gsz * 8) *(pg8::u32x4*)(xb + i) = pg8::pack8(*(const pg8::f32x4*)(xin + i), *(const pg8::f32x4*)(xin + i + 4));
    float* ch = (float*)(ws + WS_COSH); float* sh = (float*)(ws + WS_SINH); float* ci = (float*)(ws + WS_COSI); float* si = (float*)(ws + WS_SINI);
    for (size_t i = gtid; i < (size_t)TOK * 64; i += gsz) { const int t = (int)(i >> 6), j = (int)(i & 63); const double rev = (double)posg[t] * P->invf_h[j]; const float fr = (float)(rev - rint(rev));
        ch[i] = __builtin_amdgcn_cosf(fr); sh[i] = __builtin_amdgcn_sinf(fr); }
    for (size_t i = gtid; i < (size_t)TOK * 32; i += gsz) { const int t = (int)(i >> 5), j = (int)(i & 31); const double rev = (double)posg[t] * P->invf_i[j]; const float fr = (float)(rev - rint(rev));
        ci[i] = __builtin_amdgcn_cosf(fr); si[i] = __builtin_amdgcn_sinf(fr); }
    float* lb = (float*)(ws + WS_LB);
    for (size_t c = gtid; c < 1024; c += gsz) { float v[4], mx = -1e30f; for (int l = 0; l < 4; ++l) { v[l] = lbr[l * 1024 + c]; mx = fmaxf(mx, v[l]); }
        float s = 0.f; for (int l = 0; l < 4; ++l) { v[l] = expf(v[l] - mx); s += v[l]; }
        float cum = 0.f; const float inv = 1.0f / s; for (int l = 0; l < 4; ++l) { cum += v[l] * inv; lb[l * 1024 + c] = cum - v[0] * inv; } }
}
__device__ __forceinline__ void phase_ln(const float* XP, float* OUT, bf16_t* XB, float* ST, const float* g, const float* b) {
    const int tid = tid_(), wave = __builtin_amdgcn_readfirstlane(tid >> 6), lane = tid & 63, nb16 = nblk_() * 16;
    for (int row0 = bid_() * 16 + 2 * wave; row0 < TOK; row0 += nb16) {
        pg8::f32x4 v[2][8]; float s[2] = {0.f, 0.f};
#pragma unroll
        for (int rr = 0; rr < 2; ++rr)
#pragma unroll
            for (int c = 0; c < 8; ++c) v[rr][c] = *(const pg8::f32x4*)(XP + (size_t)(row0 + rr) * DM + c * 256 + lane * 4);
#pragma unroll
        for (int rr = 0; rr < 2; ++rr) {
#pragma unroll
            for (int c = 0; c < 8; ++c) s[rr] += (v[rr][c][0] + v[rr][c][1]) + (v[rr][c][2] + v[rr][c][3]);
#pragma unroll
            for (int o = 32; o >= 1; o >>= 1) s[rr] += __shfl_xor(s[rr], o); }
#pragma unroll
        for (int rr = 0; rr < 2; ++rr) { const int row = row0 + rr;
            const float mean = s[rr] * (1.0f / DM); float q = 0.f;
#pragma unroll
            for (int c = 0; c < 8; ++c) { v[rr][c] = v[rr][c] - mean; q += (v[rr][c][0] * v[rr][c][0] + v[rr][c][1] * v[rr][c][1]) + (v[rr][c][2] * v[rr][c][2] + v[rr][c][3] * v[rr][c][3]); }
#pragma unroll
            for (int o = 32; o >= 1; o >>= 1) q += __shfl_xor(q, o);
            const float rstd = 1.0f / sqrtf(q * (1.0f / DM) + LN_EPS);
            if (lane == 0) { pg8::f32x2 s2; s2[0] = mean; s2[1] = rstd; *(pg8::f32x2*)(ST + 2 * (size_t)row) = s2; }
#pragma unroll
            for (int c = 0; c < 8; ++c) { const int col = c * 256 + lane * 4; const pg8::f32x4 gg = *(const pg8::f32x4*)(g + col), bb = *(const pg8::f32x4*)(b + col);
                const pg8::f32x4 y = v[rr][c] * rstd * gg + bb; if (OUT) *(pg8::f32x4*)(OUT + (size_t)row * DM + col) = y;
                pg8::u32x2 w; w.x = pg8::cvt_pk_bf16(y[0], y[1]); w.y = pg8::cvt_pk_bf16(y[2], y[3]); *(pg8::u32x2*)(XB + (size_t)row * DM + col) = w; } }
    }
}
__device__ __forceinline__ void phase_ikprep(KP P, int layer) {
    unsigned char* ws = as_global(P->ws); const float* ikw = (const float*)(ws + WS_IKW); bf16_t* ki = (bf16_t*)(ws + WS_KI); float* wi = (float*)(ws + WS_WI);
    const float* ci = (const float*)(ws + WS_COSI); const float* si = (const float*)(ws + WS_SINI);
    const int tid = tid_(), wave = __builtin_amdgcn_readfirstlane(tid >> 6), lane = tid & 63, nb8 = nblk_() * 8;
    const float g = as_global(P->ikn_g)[layer * 64 + lane], b = as_global(P->ikn_b)[layer * 64 + lane];
    for (int t = bid_() * 8 + wave; t < TOK; t += nb8) {
        const float x = ikw[(size_t)t * 128 + lane]; float s = x;
#pragma unroll
        for (int o = 32; o >= 1; o >>= 1) s += __shfl_xor(s, o);
        const float mean = s * (1.0f / 64.0f), xc = x - mean; float q = xc * xc;
#pragma unroll
        for (int o = 32; o >= 1; o >>= 1) q += __shfl_xor(q, o);
        const float y = xc * (1.0f / sqrtf(q * (1.0f / 64.0f) + LN_EPS)) * g + b;
        const float other = __shfl_xor(y, 32); const int j = lane & 31; const float c = ci[(size_t)t * 32 + j], sn = si[(size_t)t * 32 + j];
        const float r = (lane < 32) ? (y * c - other * sn) : (other * sn + y * c);
        ki[(size_t)t * 64 + lane] = f2bf(r);
        if (lane < 16) wi[(size_t)t * 16 + lane] = ikw[(size_t)t * 128 + 64 + lane] * IDX_SCALE;
    }
}
typedef short bf16x8_t __attribute__((ext_vector_type(8)));
typedef short bf16x4_t __attribute__((ext_vector_type(4)));
typedef float f32x16_t __attribute__((ext_vector_type(16)));
constexpr int CUM_LD = 132;
constexpr int OPK_LD = 136;
constexpr int OPS_LD = 72;

__device__ __forceinline__ void hgrn_scan_load(const float* LF, int tok0, int h, int tid, float (&v)[16]) {
    const int k = tid & 127, qd = tid >> 7;
#pragma unroll
    for (int i = 0; i < 16; ++i) v[i] = LF[(size_t)(tok0 + qd * 16 + i) * 1024 + h * 128 + k];
}
__device__ __forceinline__ void hgrn_scan_cum(float (&v)[16], LAS float* cum, LAS float* tot, int tid) {
    const int k = tid & 127, qd = tid >> 7;
    float run = 0.f;
#pragma unroll
    for (int i = 0; i < 16; ++i) { run += v[i]; v[i] = run; }
    tot[qd * 128 + k] = run;
    __syncthreads();
    float off = 0.f;
#pragma unroll
    for (int q = 0; q < 3; ++q) off += (q < qd) ? tot[q * 128 + k] : 0.f;
#pragma unroll
    for (int i = 0; i < 16; ++i) cum[(qd * 16 + i) * CUM_LD + k] = v[i] + off;
    __syncthreads();
}

struct H1Pre { float lf[16]; unsigned ka[8], va[8]; };
__device__ __forceinline__ void h1_load(const bf16_t* KA, const bf16_t* VA, const float* LF, int unit, int tid, H1Pre& p) {
    const int c = unit & 63, h = (unit >> 6) & 7, b = unit >> 9, tok0 = b * SEQ + c * 64;
    hgrn_scan_load(LF, tok0, h, tid, p.lf);
#pragma unroll
    for (int it = 0; it < 8; ++it) { const int idx = tid + 512 * it, k = idx & 127, s = 2 * (idx >> 7); const size_t g0 = (size_t)(tok0 + s) * 1024 + h * 128 + k;
        p.ka[it] = (unsigned)KA[g0] | ((unsigned)KA[g0 + 1024] << 16); p.va[it] = (unsigned)VA[g0] | ((unsigned)VA[g0 + 1024] << 16); }
}
__device__ __forceinline__ void phase_hgrn_h1(KP P, LAS unsigned char* lds) {
    unsigned char* ws = as_global(P->ws);
    const bf16_t* KA = (const bf16_t*)(ws + WS_KA); const bf16_t* VA = (const bf16_t*)(ws + WS_VA); const float* LF = (const float*)(ws + WS_LF);
    bf16_t* LT = (bf16_t*)(ws + WS_LT); float* DEC = (float*)(ws + WS_DEC);
    const int tid = tid_(), lane = tid & 63, wave = __builtin_amdgcn_readfirstlane(tid >> 6), r = lane & 31, hh = lane >> 5, G = nblk_();
    LAS float* cum = (LAS float*)lds; LAS float* tot = cum + 64 * CUM_LD;
    LAS bf16_t* kdT = (LAS bf16_t*)(tot + 512); LAS bf16_t* vT = kdT + 128 * OPS_LD;
    constexpr int NU = NBATCH * AH * 64;
    H1Pre pre; int unit = bid_();
    if (unit < NU) h1_load(KA, VA, LF, unit, tid, pre);
    for (; unit < NU; unit += G) {
        hgrn_scan_cum(pre.lf, cum, tot, tid);
#pragma unroll
        for (int it = 0; it < 8; ++it) { const int idx = tid + 512 * it, k = idx & 127, sp = idx >> 7, s = 2 * sp;
            const float last = cum[63 * CUM_LD + k];
            const float k0 = __uint_as_float(pre.ka[it] << 16) * __expf(last - cum[s * CUM_LD + k]), k1 = __uint_as_float(pre.ka[it] & 0xffff0000u) * __expf(last - cum[(s + 1) * CUM_LD + k]);
            *(LAS unsigned*)(kdT + k * OPS_LD + s) = pg8::cvt_pk_bf16(k0, k1);
            *(LAS unsigned*)(vT + k * OPS_LD + s) = pre.va[it]; }
        if (tid < 128) DEC[(size_t)unit * 128 + tid] = __expf(cum[63 * CUM_LD + tid]);
        if (unit + G < NU) h1_load(KA, VA, LF, unit + G, tid, pre);
        __syncthreads();
        const int mb = wave >> 1, nb0 = (wave & 1) * 2;
        f32x16_t acc[2];
#pragma unroll
        for (int n = 0; n < 2; ++n)
#pragma unroll
            for (int i = 0; i < 16; ++i) acc[n][i] = 0.f;
#pragma unroll
        for (int ks = 0; ks < 4; ++ks) { const bf16x8_t a = *(const LAS bf16x8_t*)(kdT + (32 * mb + r) * OPS_LD + 16 * ks + 8 * hh);
#pragma unroll
            for (int n = 0; n < 2; ++n) { const bf16x8_t bb = *(const LAS bf16x8_t*)(vT + (32 * (nb0 + n) + r) * OPS_LD + 16 * ks + 8 * hh);
                acc[n] = __builtin_amdgcn_mfma_f32_32x32x16_bf16(a, bb, acc[n], 0, 0, 0); } }
#pragma unroll
        for (int n = 0; n < 2; ++n) { bf16_t* dst = LT + (size_t)unit * 16384 + (size_t)(32 * (nb0 + n) + r) * 128 + 32 * mb + 4 * hh;
#pragma unroll
            for (int g = 0; g < 4; ++g) { pg8::u32x2 o; o.x = pg8::cvt_pk_bf16(acc[n][4 * g], acc[n][4 * g + 1]); o.y = pg8::cvt_pk_bf16(acc[n][4 * g + 2], acc[n][4 * g + 3]); *(pg8::u32x2*)(dst + 8 * g) = o; } }
        __syncthreads();
    }
}

__device__ __forceinline__ void phase_hgrn_h2(KP P) {
    unsigned char* ws = as_global(P->ws);
    const bf16_t* LT = (const bf16_t*)(ws + WS_LT); const float* DEC = (const float*)(ws + WS_DEC); bf16_t* PT = (bf16_t*)(ws + WS_PT);
    const int tid = tid_(), G = nblk_();
    for (int oct = bid_() * 512 + tid; oct < NBATCH * AH * 2048; oct += G * 512) {
        const int bh = oct >> 11, rem = oct & 2047, v = rem >> 4, k0 = (rem & 15) * 8;
        const size_t e0 = (size_t)bh * 64 * 16384 + (size_t)v * 128 + k0; const size_t d0 = (size_t)bh * 64 * 128 + k0;
        pg8::f32x4 S0 = {0.f, 0.f, 0.f, 0.f}, S1 = {0.f, 0.f, 0.f, 0.f};
        for (int c0 = 0; c0 < 64; c0 += 4) { pg8::u32x4 Lc[4]; pg8::f32x4 Da[4], Db[4];
#pragma unroll
            for (int j = 0; j < 4; ++j) { Lc[j] = *(const pg8::u32x4*)(LT + e0 + (size_t)(c0 + j) * 16384); Da[j] = *(const pg8::f32x4*)(DEC + d0 + (size_t)(c0 + j) * 128); Db[j] = *(const pg8::f32x4*)(DEC + d0 + (size_t)(c0 + j) * 128 + 4); }
#pragma unroll
            for (int j = 0; j < 4; ++j) { *(pg8::u32x4*)(PT + e0 + (size_t)(c0 + j) * 16384) = pg8::pack8(S0, S1);
                pg8::f32x4 l0, l1; pg8::unpack8(Lc[j], l0, l1); S0 = Da[j] * S0 + l0; S1 = Db[j] * S1 + l1; } }
    }
}

struct H3Pre { float lf[16]; unsigned qw[8], kw[8], vv[8]; bf16x8_t pt[8]; pg8::u32x2 ga[4]; };
__device__ __forceinline__ void h3_load(const bf16_t* QA, const bf16_t* KA, const bf16_t* VA, const bf16_t* GA, const float* LF, const bf16_t* PT, int unit, int tid, H3Pre& p) {
    const int c = unit & 63, h = (unit >> 6) & 7, b = unit >> 9, tok0 = b * SEQ + c * 64;
    const int lane = tid & 63, wave = __builtin_amdgcn_readfirstlane(tid >> 6), r = lane & 31, hh = lane >> 5, mb = wave >> 1, tb = wave & 1;
    hgrn_scan_load(LF, tok0, h, tid, p.lf);
#pragma unroll
    for (int it = 0; it < 8; ++it) { const int idx = tid + 512 * it, kp = (idx & 63) * 2, t = idx >> 6; const size_t g0 = (size_t)(tok0 + t) * 1024 + h * 128 + kp;
        p.qw[it] = *(const unsigned*)(QA + g0); p.kw[it] = *(const unsigned*)(KA + g0); }
#pragma unroll
    for (int it = 0; it < 8; ++it) { const int idx = tid + 512 * it, v = idx & 127, s = 2 * (idx >> 7); const size_t g0 = (size_t)(tok0 + s) * 1024 + h * 128 + v;
        p.vv[it] = (unsigned)VA[g0] | ((unsigned)VA[g0 + 1024] << 16); }
    const bf16_t* prow = PT + (size_t)unit * 16384 + (size_t)(32 * mb + r) * 128 + 8 * hh;
#pragma unroll
    for (int k8 = 0; k8 < 8; ++k8) p.pt[k8] = *(const bf16x8_t*)(prow + 16 * k8);
    const size_t orow = (size_t)(tok0 + 32 * tb + r) * 1024 + h * 128;
#pragma unroll
    for (int g = 0; g < 4; ++g) p.ga[g] = *(const pg8::u32x2*)(GA + orow + 32 * mb + 8 * g + 4 * hh);
}
__device__ __forceinline__ void phase_hgrn_h3(KP P, int layer, LAS unsigned char* lds) {
    unsigned char* ws = as_global(P->ws);
    const bf16_t* QA = (const bf16_t*)(ws + WS_QA); const bf16_t* KA = (const bf16_t*)(ws + WS_KA); const bf16_t* VA = (const bf16_t*)(ws + WS_VA); const bf16_t* GA = (const bf16_t*)(ws + WS_GA);
    const float* LF = (const float*)(ws + WS_LF); const bf16_t* PT = (const bf16_t*)(ws + WS_PT); bf16_t* YA = (bf16_t*)(ws + WS_YA);
    const float* ng = as_global(P->hnorm_g) + layer * 128;
    const int tid = tid_(), lane = tid & 63, wave = __builtin_amdgcn_readfirstlane(tid >> 6), r = lane & 31, hh = lane >> 5, G = nblk_();
    LAS float* cum = (LAS float*)lds; LAS float* tot = cum + 64 * CUM_LD; LAS float* ssq = tot + 512;
    LAS bf16_t* qd = (LAS bf16_t*)(ssq + 256); LAS bf16_t* qs = qd + 64 * OPK_LD; LAS bf16_t* ks = qs + 64 * OPK_LD; LAS bf16_t* vT = ks + 64 * OPK_LD;
    constexpr int NU = NBATCH * AH * 64;
    const int mb = wave >> 1, tb = wave & 1;
    H3Pre pre; int unit = bid_();
    if (unit < NU) h3_load(QA, KA, VA, GA, LF, PT, unit, tid, pre);
    for (; unit < NU; unit += G) {
        const int c = unit & 63, h = (unit >> 6) & 7, b = unit >> 9, tok0 = b * SEQ + c * 64;
#ifdef H3_DUP_SCAN
        { float tmp[16];
#pragma unroll
          for (int i = 0; i < 16; ++i) tmp[i] = pre.lf[i];
          hgrn_scan_cum(tmp, cum, tot, tid); }
#endif
        hgrn_scan_cum(pre.lf, cum, tot, tid);
#ifdef H3_DUP_BUILD
        for (int rep_b = 0; rep_b < 2; ++rep_b) {
#else
        {
#endif
#pragma unroll
        for (int it = 0; it < 8; ++it) { const int idx = tid + 512 * it, kp = (idx & 63) * 2, t = idx >> 6;
            const unsigned qw = pre.qw[it], kw = pre.kw[it];
            const float c0 = cum[t * CUM_LD + kp], c1 = cum[t * CUM_LD + kp + 1], r0 = cum[31 * CUM_LD + kp], r1 = cum[31 * CUM_LD + kp + 1];
            const float q0 = __uint_as_float(qw << 16), q1 = __uint_as_float(qw & 0xffff0000u), k0 = __uint_as_float(kw << 16), k1 = __uint_as_float(kw & 0xffff0000u);
            *(LAS unsigned*)(qd + t * OPK_LD + kp) = pg8::cvt_pk_bf16(q0 * __expf(c0), q1 * __expf(c1));
            *(LAS unsigned*)(qs + t * OPK_LD + kp) = pg8::cvt_pk_bf16(q0 * __expf(c0 - r0), q1 * __expf(c1 - r1));
            *(LAS unsigned*)(ks + t * OPK_LD + kp) = pg8::cvt_pk_bf16(k0 * __expf(r0 - c0), k1 * __expf(r1 - c1)); }
#pragma unroll
        for (int it = 0; it < 8; ++it) { const int idx = tid + 512 * it, v = idx & 127, s = 2 * (idx >> 7); *(LAS unsigned*)(vT + v * OPS_LD + s) = pre.vv[it]; }
        }
        bf16x8_t ptc[8]; pg8::u32x2 gac[4];
#pragma unroll
        for (int k8 = 0; k8 < 8; ++k8) ptc[k8] = pre.pt[k8];
#pragma unroll
        for (int g = 0; g < 4; ++g) gac[g] = pre.ga[g];
        if (unit + G < NU) h3_load(QA, KA, VA, GA, LF, PT, unit + G, tid, pre);
        __syncthreads();
        f32x16_t acc;
#ifdef H3_DUP_MMA
        for (int rep_m = 0; rep_m < 2; ++rep_m) {
#else
        {
#endif
#pragma unroll
        for (int i = 0; i < 16; ++i) acc[i] = 0.f;
#pragma unroll
        for (int k8 = 0; k8 < 8; ++k8) { const bf16x8_t bq = *(const LAS bf16x8_t*)(qd + (32 * tb + r) * OPK_LD + 16 * k8 + 8 * hh);
            acc = __builtin_amdgcn_mfma_f32_32x32x16_bf16(ptc[k8], bq, acc, 0, 0, 0); }
#pragma unroll
        for (int sb = 0; sb < 2; ++sb) if (sb <= tb) {
            f32x16_t sc;
#pragma unroll
            for (int i = 0; i < 16; ++i) sc[i] = 0.f;
#pragma unroll
            for (int k8 = 0; k8 < 8; ++k8) { const bf16x8_t a = *(const LAS bf16x8_t*)(ks + (32 * sb + r) * OPK_LD + 16 * k8 + 8 * hh); const bf16x8_t bq = *(const LAS bf16x8_t*)(qs + (32 * tb + r) * OPK_LD + 16 * k8 + 8 * hh);
                sc = __builtin_amdgcn_mfma_f32_32x32x16_bf16(a, bq, sc, 0, 0, 0); }
            if (sb == tb) {
#pragma unroll
                for (int i = 0; i < 16; ++i) { const int sl = 8 * (i >> 2) + 4 * hh + (i & 3); sc[i] = (sl <= r) ? sc[i] : 0.f; } }
#pragma unroll
            for (int u = 0; u < 2; ++u) {
                pg8::u32x4 pw; pw.x = pg8::cvt_pk_bf16(sc[8 * u], sc[8 * u + 1]); pw.y = pg8::cvt_pk_bf16(sc[8 * u + 2], sc[8 * u + 3]); pw.z = pg8::cvt_pk_bf16(sc[8 * u + 4], sc[8 * u + 5]); pw.w = pg8::cvt_pk_bf16(sc[8 * u + 6], sc[8 * u + 7]);
                const bf16x8_t pb = __builtin_bit_cast(bf16x8_t, pw);
                const LAS bf16_t* vrow = vT + (32 * mb + r) * OPS_LD + 32 * sb + 16 * u + 4 * hh;
                const bf16x4_t lo = *(const LAS bf16x4_t*)vrow, hi4 = *(const LAS bf16x4_t*)(vrow + 8);
                const bf16x8_t va = {lo[0], lo[1], lo[2], lo[3], hi4[0], hi4[1], hi4[2], hi4[3]};
                acc = __builtin_amdgcn_mfma_f32_32x32x16_bf16(va, pb, acc, 0, 0, 0); }
        }
        }
        float ss = 0.f;
#pragma unroll
        for (int i = 0; i < 16; ++i) ss += acc[i] * acc[i];
        ss += __shfl_xor(ss, 32);
        if (hh == 0) ssq[mb * 64 + 32 * tb + r] = ss;
        __syncthreads();
        const int t = 32 * tb + r;
        const float tot2 = (ssq[t] + ssq[64 + t]) + (ssq[128 + t] + ssq[192 + t]);
        const float rs = 1.0f / sqrtf(tot2 * (1.0f / 128.0f) + RMS_EPS);
        const size_t orow = (size_t)(tok0 + t) * 1024 + h * 128;
#pragma unroll
        for (int g = 0; g < 4; ++g) { const int v0 = 32 * mb + 8 * g + 4 * hh;
            const pg8::u32x2 gw = gac[g]; const pg8::f32x4 nv = *(const pg8::f32x4*)(ng + v0);
            const float y0 = acc[4 * g] * rs * nv[0] * __uint_as_float(gw.x << 16), y1 = acc[4 * g + 1] * rs * nv[1] * __uint_as_float(gw.x & 0xffff0000u);
            const float y2 = acc[4 * g + 2] * rs * nv[2] * __uint_as_float(gw.y << 16), y3 = acc[4 * g + 3] * rs * nv[3] * __uint_as_float(gw.y & 0xffff0000u);
            pg8::u32x2 w; w.x = pg8::cvt_pk_bf16(y0, y1); w.y = pg8::cvt_pk_bf16(y2, y3); *(pg8::u32x2*)(YA + orow + v0) = w; }
        __syncthreads();
    }
}
namespace at {
constexpr int D = 128, NW = 8, QBLK = 32, KVBLK = 64, LDQ = 1024, LDK = 1024;
constexpr float SCALE = ATTN_SCALE, THR = 8.f;
constexpr size_t SHM_V = KVBLK * D * 2, SHM_K = KVBLK * D * 2, SHM_ATTN = 2 * SHM_V + 2 * SHM_K + NW * 64 * 4;
using bf16x8 = __attribute__((ext_vector_type(8))) short;
using s16x4  = __attribute__((ext_vector_type(4))) short;
using f32x16 = __attribute__((ext_vector_type(16))) float;
using u32x4  = __attribute__((ext_vector_type(4))) unsigned;
#define AT_KSWZ(row, colB) ((row) * 256 + ((colB) ^ (((row) & 7) << 4)))
#define AT_SBAR() __builtin_amdgcn_sched_barrier(0)
__device__ __forceinline__ int crow(int r, int hi) { return (r & 3) + 8 * (r >> 2) + 4 * hi; }
__device__ __forceinline__ unsigned cvtpk(float lo, float hi) { return pg8::cvt_pk_bf16(lo, hi); }

__device__ __forceinline__ void partialSM(f32x16& p0, f32x16& p1, float& m_reg, float& mn, float& alpha) {
  constexpr float C = SCALE * 1.4426950408889634f;
  float pmax = p0[0];
#pragma unroll
  for (int r = 1; r < 16; ++r) pmax = fmaxf(pmax, p0[r]);
#pragma unroll
  for (int r = 0; r < 16; ++r) pmax = fmaxf(pmax, p1[r]);
  { auto rr = __builtin_amdgcn_permlane32_swap(__float_as_uint(pmax), __float_as_uint(pmax), false, false);
    pmax = fmaxf(__uint_as_float(rr[0]), __uint_as_float(rr[1])); }
  if (__builtin_expect(__all(pmax - m_reg <= THR / SCALE), 1)) { mn = m_reg; alpha = 1.f; }
  else { mn = fmaxf(m_reg, pmax); alpha = __builtin_amdgcn_exp2f((m_reg - mn) * C); m_reg = mn; }
  float mnC = -mn * C;
#pragma unroll
  for (int r = 0; r < 16; ++r) p0[r] = fmaf(p0[r], C, mnC);
#pragma unroll
  for (int r = 0; r < 16; ++r) p1[r] = fmaf(p1[r], C, mnC);
#pragma unroll
  for (int r = 0; r < 16; ++r) p0[r] = __builtin_amdgcn_exp2f(p0[r]);
}
__device__ __forceinline__ void finishSM(f32x16& p0, f32x16& p1, float alpha, float& l_reg, int mlo, int mhi, bf16x8& pa0, bf16x8& pa1, bf16x8& pa2, bf16x8& pa3) {
#pragma unroll
  for (int r = 0; r < 16; ++r) p1[r] = __builtin_amdgcn_exp2f(p1[r]);
#pragma unroll
  for (int r = 0; r < 16; ++r) { const int bit = (r & 3) + 8 * (r >> 2);
    p0[r] = __uint_as_float(__float_as_uint(p0[r]) & (unsigned)__builtin_amdgcn_sbfe(mlo, bit, 1));
    p1[r] = __uint_as_float(__float_as_uint(p1[r]) & (unsigned)__builtin_amdgcn_sbfe(mhi, bit, 1)); }
  float ps = 0;
#pragma unroll
  for (int r = 0; r < 16; ++r) ps += p0[r];
#pragma unroll
  for (int r = 0; r < 16; ++r) ps += p1[r];
  { auto rr = __builtin_amdgcn_permlane32_swap(__float_as_uint(ps), __float_as_uint(ps), false, false);
    ps = __uint_as_float(rr[0]) + __uint_as_float(rr[1]); }
  l_reg = l_reg * alpha + ps;
#define AT_PK4(P, BASE, OUT) do { unsigned a0 = cvtpk(P[BASE + 0], P[BASE + 1]), a1 = cvtpk(P[BASE + 2], P[BASE + 3]);   \
    unsigned b0 = cvtpk(P[BASE + 4], P[BASE + 5]), b1 = cvtpk(P[BASE + 6], P[BASE + 7]);                              \
    auto r0 = __builtin_amdgcn_permlane32_swap(a0, b0, false, false); auto r1 = __builtin_amdgcn_permlane32_swap(a1, b1, false, false); \
    u32x4 w = {r0[0], r1[0], r0[1], r1[1]}; OUT = *reinterpret_cast<bf16x8*>(&w); } while (0)
  AT_PK4(p0, 0, pa0); AT_PK4(p0, 8, pa1); AT_PK4(p1, 0, pa2); AT_PK4(p1, 8, pa3);
#undef AT_PK4
}
__device__ __forceinline__ void qkt(f32x16& p0, f32x16& p1, const LAS char* Ks, const bf16x8* qr, int r32, int hi) {
  p0 = f32x16{}; p1 = f32x16{};
#pragma unroll
  for (int d0 = 0; d0 < 8; ++d0) { int cb = (d0 * 16 + hi * 8) * 2;
    bf16x8 b0 = *reinterpret_cast<const LAS bf16x8*>(Ks + AT_KSWZ(r32, cb));
    bf16x8 b1 = *reinterpret_cast<const LAS bf16x8*>(Ks + AT_KSWZ(32 + r32, cb));
    p0 = __builtin_amdgcn_mfma_f32_32x32x16_bf16(b0, qr[d0], p0, 0, 0, 0);
    p1 = __builtin_amdgcn_mfma_f32_32x32x16_bf16(b1, qr[d0], p1, 0, 0, 0); }
}
__device__ __forceinline__ int v_st(int k, int c) { const int kk = (k & ~0xC) | ((k & 4) << 1) | ((k & 8) >> 1); return ((kk >> 3) * 4 + (c >> 5)) * 512 + ((kk & 7) * 32 + (c & 31)) * 2; }
__device__ __forceinline__ int v_rd_base(int lane) { return ((lane & 3) << 3) | (((lane >> 2) & 3) << 6) | (((lane >> 4) & 1) << 5) | (((lane >> 5) & 1) << 8); }
constexpr int v_rd_off(int d0, int ks, int half) { return d0 * 512 + ks * 4096 + half * 2048; }
template <int OFF> __device__ __forceinline__ s16x4 tr_read(int vb) {
  s16x4 r; asm volatile("ds_read_b64_tr_b16 %0, %1 offset:%2" : "=&v"(r) : "v"(vb), "i"(OFF) : "memory"); return r;
}
template <int D0> __device__ __forceinline__ void pv_one(f32x16& od, int vb, bf16x8 pa0, bf16x8 pa1, bf16x8 pa2, bf16x8 pa3) {
  const s16x4 l0 = tr_read<v_rd_off(D0, 0, 0)>(vb), h0 = tr_read<v_rd_off(D0, 0, 1)>(vb), l1 = tr_read<v_rd_off(D0, 1, 0)>(vb), h1 = tr_read<v_rd_off(D0, 1, 1)>(vb);
  const s16x4 l2 = tr_read<v_rd_off(D0, 2, 0)>(vb), h2 = tr_read<v_rd_off(D0, 2, 1)>(vb), l3 = tr_read<v_rd_off(D0, 3, 0)>(vb), h3 = tr_read<v_rd_off(D0, 3, 1)>(vb);
  asm volatile("s_waitcnt lgkmcnt(0)" ::: "memory"); AT_SBAR();
#define AT_PK(L_, H_) (bf16x8){L_[0], L_[1], L_[2], L_[3], H_[0], H_[1], H_[2], H_[3]}
  od = __builtin_amdgcn_mfma_f32_32x32x16_bf16(pa0, AT_PK(l0, h0), od, 0, 0, 0);
  od = __builtin_amdgcn_mfma_f32_32x32x16_bf16(pa1, AT_PK(l1, h1), od, 0, 0, 0);
  od = __builtin_amdgcn_mfma_f32_32x32x16_bf16(pa2, AT_PK(l2, h2), od, 0, 0, 0);
  od = __builtin_amdgcn_mfma_f32_32x32x16_bf16(pa3, AT_PK(l3, h3), od, 0, 0, 0);
#undef AT_PK
}
__device__ __forceinline__ void pv_d0(f32x16* o, int vb, bf16x8 pa0, bf16x8 pa1, bf16x8 pa2, bf16x8 pa3) {
  pv_one<0>(o[0], vb, pa0, pa1, pa2, pa3); pv_one<1>(o[1], vb, pa0, pa1, pa2, pa3); pv_one<2>(o[2], vb, pa0, pa1, pa2, pa3); pv_one<3>(o[3], vb, pa0, pa1, pa2, pa3);
}

__device__ __forceinline__ void attn_masked_body(const bf16_t* __restrict__ Qb, const bf16_t* __restrict__ Kh, const bf16_t* __restrict__ Vh, const unsigned long long* __restrict__ Mq,
                                                 bf16_t* __restrict__ Ob, int seq, LAS char* lds, int tid) {
  const int wid = __builtin_amdgcn_readfirstlane(tid >> 6), lane = tid & 63, r32 = lane & 31, hi = lane >> 5;
  LAS char* V_lds = lds; LAS char* K_lds = lds + 2 * SHM_V;
  LAS float* wsf = (LAS float*)(lds + 2 * SHM_V + 2 * SHM_K) + wid * 64; LAS float* li_l = wsf; LAS float* al_l = wsf + 32;
  float m_reg = -1e30f, l_reg = 0; f32x16 o[4] = {}; bf16x8 qr[8];
  const bf16_t* Qw = Qb + (long)(wid * QBLK + r32) * LDQ + hi * 8;
#pragma unroll
  for (int d0 = 0; d0 < 8; ++d0) qr[d0] = *reinterpret_cast<const bf16x8*>(Qw + d0 * 16);
  const unsigned long long* mrow = Mq + (size_t)(wid * QBLK + r32) * 64;
  const int sr = tid >> 4, sc = (tid & 15) * 8, vst0 = v_st(sr, sc), vst1 = v_st(32 + sr, sc);
  const int vb0 = (int)(uintptr_t)V_lds + v_rd_base(lane);
  struct { bf16x8 vs0, vs1, ks0, ks1; } sr_[2];
#define AT_SLOAD(i, k0) do { sr_[i].vs0 = *reinterpret_cast<const bf16x8*>(&Vh[(long)((k0) + sr) * LDK + sc]); sr_[i].vs1 = *reinterpret_cast<const bf16x8*>(&Vh[(long)((k0) + 32 + sr) * LDK + sc]); \
    sr_[i].ks0 = *reinterpret_cast<const bf16x8*>(&Kh[(long)((k0) + sr) * LDK + sc]); sr_[i].ks1 = *reinterpret_cast<const bf16x8*>(&Kh[(long)((k0) + 32 + sr) * LDK + sc]); } while (0)
#define AT_SWRITE(b, i) do { *(LAS bf16x8*)(V_lds + (b) * SHM_V + vst0) = sr_[i].vs0;          \
    *(LAS bf16x8*)(V_lds + (b) * SHM_V + vst1) = sr_[i].vs1; int kc = sc * 2;               \
    *(LAS bf16x8*)(K_lds + (b) * SHM_K + AT_KSWZ(sr, kc)) = sr_[i].ks0;                       \
    *(LAS bf16x8*)(K_lds + (b) * SHM_K + AT_KSWZ(32 + sr, kc)) = sr_[i].ks1; } while (0)
#define AT_SWAIT() asm volatile("s_waitcnt vmcnt(4)" ::: "memory")
#define AT_RESC(a) do { if (__any((a) < 1.f)) { if (hi == 0) al_l[r32] = (a); asm volatile("s_waitcnt lgkmcnt(0)" ::: "memory"); \
    _Pragma("unroll") for (int d = 0; d < 4; ++d) _Pragma("unroll") for (int r = 0; r < 16; ++r) o[d][r] *= al_l[crow(r, hi)]; } } while (0)
#define AT_MLOAD(mw, j) do { const unsigned long long _w = mrow[(j)]; (mw##lo) = (int)((unsigned)_w >> (4 * hi)); (mw##hi) = (int)((unsigned)(_w >> 32) >> (4 * hi)); } while (0)
  f32x16 pA0, pA1, pB0, pB1; float mnA, mnB, alA, alB; bf16x8 pa0, pa1, pa2, pa3; const int NT = seq / KVBLK;
  int mAlo, mAhi, mBlo, mBhi;
  constexpr int SE = 0, SO = 1;
  AT_SLOAD(SE, 0); AT_MLOAD(mA, 0); asm volatile("s_waitcnt vmcnt(0)" ::: "memory"); AT_SWRITE(0, SE); __syncthreads();
  qkt(pA0, pA1, K_lds, qr, r32, hi); partialSM(pA0, pA1, m_reg, mnA, alA);
  AT_SLOAD(SO, KVBLK); if (2 < NT) AT_SLOAD(SE, 2 * KVBLK);
  AT_SWAIT(); AT_SWRITE(1, SO); __syncthreads();
  for (int j = 1; j + 1 < NT; j += 2) {
    AT_SBAR(); AT_MLOAD(mB, j); qkt(pB0, pB1, K_lds + SHM_K, qr, r32, hi);
    finishSM(pA0, pA1, alA, l_reg, mAlo, mAhi, pa0, pa1, pa2, pa3); AT_SBAR();
    AT_SLOAD(SO, (j + 2) * KVBLK); AT_SBAR();
    pv_d0(o, vb0, pa0, pa1, pa2, pa3); partialSM(pB0, pB1, m_reg, mnB, alB);
    __syncthreads(); AT_SWAIT(); AT_SWRITE(0, SE);
    AT_RESC(alB); __syncthreads();
    AT_SBAR(); AT_MLOAD(mA, j + 1); qkt(pA0, pA1, K_lds, qr, r32, hi);
    finishSM(pB0, pB1, alB, l_reg, mBlo, mBhi, pa0, pa1, pa2, pa3); AT_SBAR();
    if (j + 3 < NT) AT_SLOAD(SE, (j + 3) * KVBLK); AT_SBAR();
    pv_d0(o, vb0 + (int)SHM_V, pa0, pa1, pa2, pa3); partialSM(pA0, pA1, m_reg, mnA, alA);
    __syncthreads(); AT_SWAIT(); AT_SWRITE(1, SO);
    AT_RESC(alA); __syncthreads();
  }
  AT_SBAR(); AT_MLOAD(mB, NT - 1); qkt(pB0, pB1, K_lds + SHM_K, qr, r32, hi);
  finishSM(pA0, pA1, alA, l_reg, mAlo, mAhi, pa0, pa1, pa2, pa3); AT_SBAR();
  pv_d0(o, vb0, pa0, pa1, pa2, pa3); partialSM(pB0, pB1, m_reg, mnB, alB);
  __syncthreads(); AT_RESC(alB);
  finishSM(pB0, pB1, alB, l_reg, mBlo, mBhi, pa0, pa1, pa2, pa3); AT_SBAR();
  pv_d0(o, vb0 + (int)SHM_V, pa0, pa1, pa2, pa3);
  if (hi == 0) li_l[r32] = l_reg; asm volatile("s_waitcnt lgkmcnt(0)" ::: "memory");
  float rli[16];
#pragma unroll
  for (int r = 0; r < 16; ++r) rli[r] = __builtin_amdgcn_rcpf(li_l[crow(r, hi)]);
  bf16_t* Ow = Ob + (long)(wid * QBLK) * LDQ;
#pragma unroll
  for (int r = 0; r < 16; ++r) { const int orow = crow(r, hi);
#pragma unroll
    for (int d0 = 0; d0 < 4; ++d0) Ow[(long)orow * LDQ + d0 * 32 + r32] = f2bf(o[d0][r] * rli[r]); }
#undef AT_SLOAD
#undef AT_SWRITE
#undef AT_SWAIT
#undef AT_RESC
#undef AT_MLOAD
}
}

__device__ __forceinline__ void phase_attn(KP P, LAS unsigned char* lds) {
    unsigned char* ws = as_global(P->ws);
    const bf16_t* QB = (const bf16_t*)(ws + WS_QB); const bf16_t* KB = (const bf16_t*)(ws + WS_KB); const bf16_t* VB = (const bf16_t*)(ws + WS_VB);
    const unsigned long long* MASK = (const unsigned long long*)(ws + WS_MASK); bf16_t* YB = (bf16_t*)(ws + WS_YB);
    const int G = nblk_();
    for (int p = bid_(); p < 256; p += G) {
        const int bh = p >> 3, b = bh >> 3, h = bh & 7, x = p & 7;
#pragma unroll 1
        for (int half = 0; half < 2; ++half) { const int qb = half ? 15 - x : x; const size_t row0 = (size_t)b * SEQ + (size_t)qb * 256;
            at::attn_masked_body(QB + row0 * 1024 + h * 128, KB + (size_t)b * SEQ * 1024 + h * 128, VB + (size_t)b * SEQ * 1024 + h * 128, MASK + row0 * 64,
                                 YB + row0 * 1024 + h * 128, 256 * (qb + 1), (LAS char*)lds, tid_());
            __syncthreads(); }
    }
}
__device__ __forceinline__ const float* sel_row(const float* S, int q, int& nw) {
    const int b = q >> 12, s = q & 4095, c = s >> 6; nw = c + 1;
    return S + (size_t)b * SCORE_B + (size_t)2048 * c * (c + 1) + (size_t)(s & 63) * (nw * 64);
}
__device__ __forceinline__ void sel_load(const float* row, int nw, int lane, float (&f)[64]) {
    if (nw > 32) {
#pragma unroll
        for (int j = 0; j < 64; ++j) { const int jc = j < nw ? j : nw - 1; f[j] = row[jc * 64 + lane]; }
    } else {
#pragma unroll
        for (int j = 0; j < 32; ++j) { const int jc = j < nw ? j : nw - 1; f[j] = row[jc * 64 + lane]; }
#pragma unroll
        for (int j = 32; j < 64; ++j) f[j] = 0.f;
    }
}
__device__ __forceinline__ void phase_select(KP P, LAS unsigned char* lds) {
    unsigned char* ws = as_global(P->ws); const float* S = (const float*)(ws + WS_S); unsigned long long* MASK = (unsigned long long*)(ws + WS_MASK);
    const int tid = tid_(), wave = __builtin_amdgcn_readfirstlane(tid >> 6), lane = tid & 63, nb8 = nblk_() * 8;
    LAS unsigned long long* sm = (LAS unsigned long long*)lds + wave * 64;
    float f[64]; int it = (bid_() * 8 + wave) * 8, nw = 0; const float* row = nullptr;
    const int itstep = nb8 * 8 - 7;
#define SEL_Q(it_) ((((it_) >> 3) & 3) * 4096 + ((it_) >> 5) + 512 * ((it_) & 7))
    int q = it < TOK ? SEL_Q(it) : TOK;
    if (q < TOK) { row = sel_row(S, q, nw); if (nw > TOPK / 64) sel_load(row, nw, lane, f); }
    while (q < TOK) {
        unsigned long long myword = 0ull;
        const int itn = ((it & 7) == 7) ? it + itstep : it + 1; const int qn = itn < TOK ? SEL_Q(itn) : TOK; int nwn = 0; const float* rown = nullptr;
        if (nw <= TOPK / 64) {
            myword = (lane < nw) ? ~0ull : 0ull;
            if (qn < TOK) { rown = sel_row(S, qn, nwn); if (nwn > TOPK / 64) sel_load(rown, nwn, lane, f); }
        } else {
            unsigned u[64];
#pragma unroll
            for (int j = 0; j < 64; ++j) { const unsigned bits = __float_as_uint(f[j]); const unsigned v = (bits & 0x80000000u) ? ~bits : (bits | 0x80000000u); u[j] = (j < nw) ? v : 0u; }
            if (qn < TOK) { rown = sel_row(S, qn, nwn); if (nwn > TOPK / 64) sel_load(rown, nwn, lane, f); }
            unsigned prefix = 0u;
            for (int bit = 31; bit >= 0; --bit) { const unsigned cand = prefix | (1u << bit); int cnt = 0;
#pragma unroll
                for (int j8 = 0; j8 < 8; ++j8) if (j8 * 8 < nw) { unsigned long long bl[8];
#pragma unroll
                    for (int jj = 0; jj < 8; ++jj) bl[jj] = __ballot(u[j8 * 8 + jj] >= cand);
                    asm volatile("" : "+s"(bl[0]), "+s"(bl[1]), "+s"(bl[2]), "+s"(bl[3]), "+s"(bl[4]), "+s"(bl[5]), "+s"(bl[6]), "+s"(bl[7]));
#pragma unroll
                    for (int jj = 0; jj < 8; ++jj) cnt += __popcll(bl[jj]); }
                if (cnt >= TOPK) prefix = cand;
                if (cnt == TOPK) break; }
#pragma unroll
            for (int j = 0; j < 64; ++j) { const unsigned long long w = __ballot(u[j] >= prefix); if (lane == 0) sm[j] = w; }
            myword = sm[lane];
        }
        MASK[(size_t)q * 64 + lane] = myword;
        q = qn; it = itn; nw = nwn; row = rown;
    }
#undef SEL_Q
}

__device__ __forceinline__ void phase_hgrn_naive(KP P, int layer, LAS unsigned char* lds) {
    unsigned char* ws = as_global(P->ws);
    const bf16_t* QA = (const bf16_t*)(ws + WS_QA); const bf16_t* KA = (const bf16_t*)(ws + WS_KA); const bf16_t* VA = (const bf16_t*)(ws + WS_VA); const bf16_t* GA = (const bf16_t*)(ws + WS_GA);
    const float* LF = (const float*)(ws + WS_LF); bf16_t* YA = (bf16_t*)(ws + WS_YA);
    const int tid = tid_(), bh = bid_(), b = bh >> 3, h = bh & 7, v = tid & 127; const bool act = (bh < 32) && (tid < 128);
    if (bh >= 32) return;
    LAS float* sf = (LAS float*)lds; LAS float* sk = sf + 16 * 128; LAS float* sq = sk + 16 * 128; LAS float* red = sq + 16 * 128;
    float S[128];
#pragma unroll
    for (int k = 0; k < 128; ++k) S[k] = 0.f;
    const float ng = as_global(P->hnorm_g)[layer * 128 + v];
    for (int t0 = 0; t0 < SEQ; t0 += 16) {
        if (act) for (int i = 0; i < 16; ++i) { const size_t idx = ((size_t)(b * SEQ + t0 + i)) * 1024 + h * 128 + v; sf[i * 128 + v] = expf(LF[idx]); sk[i * 128 + v] = bf2f(KA[idx]); sq[i * 128 + v] = bf2f(QA[idx]); }
        __syncthreads();
        for (int i = 0; i < 16; ++i) { const size_t idx = ((size_t)(b * SEQ + t0 + i)) * 1024 + h * 128 + v; float o = 0.f;
            if (act) { const float vt = bf2f(VA[idx]);
#pragma unroll
                for (int k = 0; k < 128; ++k) { S[k] = sf[i * 128 + k] * S[k] + sk[i * 128 + k] * vt; o += S[k] * sq[i * 128 + k]; } }
            float ss = o * o;
#pragma unroll
            for (int m = 32; m >= 1; m >>= 1) ss += __shfl_xor(ss, m);
            if (act && (v & 63) == 0) red[v >> 6] = ss;
            __syncthreads();
            if (act) { const float tot = red[0] + red[1]; YA[idx] = f2bf(o * (1.0f / sqrtf(tot * (1.0f / 128.0f) + RMS_EPS)) * ng * bf2f(GA[idx])); }
            __syncthreads(); }
    }
}
__device__ __forceinline__ void phase_idx_naive(KP P, LAS unsigned char* lds) {
    unsigned char* ws = as_global(P->ws);
    const bf16_t* QI = (const bf16_t*)(ws + WS_QI); const bf16_t* KI = (const bf16_t*)(ws + WS_KI); const float* WI = (const float*)(ws + WS_WI); float* Sc = (float*)(ws + WS_S);
    const int tid = tid_(), G = nblk_();
    LAS float* qs = (LAS float*)lds; LAS float* wsh = qs + 1024;
    for (int q = bid_(); q < TOK; q += G) {
        const int b = q >> 12, s = q & 4095, c = s >> 6, nw = c + 1, nk = nw * 64;
        if (nw <= TOPK / 64) continue;
        __syncthreads();
        for (int i = tid; i < 1024; i += 512) qs[i] = bf2f(QI[(size_t)q * 1024 + i]);
        if (tid < 16) wsh[tid] = WI[(size_t)q * 16 + tid];
        __syncthreads();
        float* row = Sc + (size_t)b * SCORE_B + (size_t)2048 * c * (c + 1) + (size_t)(s & 63) * nk;
        for (int key = tid; key < nk; key += 512) {
            float kf[64]; const pg8::u32x4* kp = (const pg8::u32x4*)(KI + ((size_t)b * SEQ + key) * 64);
#pragma unroll
            for (int d8 = 0; d8 < 8; ++d8) { const pg8::u32x4 w = kp[d8]; pg8::f32x4 a, bb; pg8::unpack8(w, a, bb);
#pragma unroll
                for (int j = 0; j < 4; ++j) { kf[d8 * 8 + j] = a[j]; kf[d8 * 8 + 4 + j] = bb[j]; } }
            float sc = 0.f;
            for (int h = 0; h < 16; ++h) { float dot = 0.f;
#pragma unroll
                for (int d = 0; d < 64; ++d) dot += qs[h * 64 + d] * kf[d];
                sc += wsh[h] * fmaxf(dot, 0.f); }
            row[key] = sc;
        }
    }
}
__device__ __forceinline__ void phase_attn_naive(KP P, LAS unsigned char* lds) {
    unsigned char* ws = as_global(P->ws);
    const bf16_t* QB = (const bf16_t*)(ws + WS_QB); const bf16_t* KB = (const bf16_t*)(ws + WS_KB); const bf16_t* VB = (const bf16_t*)(ws + WS_VB);
    const unsigned long long* MASK = (const unsigned long long*)(ws + WS_MASK); bf16_t* YB = (bf16_t*)(ws + WS_YB);
    const int tid = tid_(), h = tid >> 6, lane = tid & 63, G = nblk_();
    LAS float* qs = (LAS float*)lds + h * 128; LAS int* keys = (LAS int*)((LAS float*)lds + 1024) + h * 320; LAS float* lg = (LAS float*)lds + 1024 + 8 * 320 + h * 320;
    for (int q = bid_(); q < TOK; q += G) {
        const int b = q >> 12, s = q & 4095, nw = (s >> 6) + 1;
        qs[lane] = bf2f(QB[(size_t)q * 1024 + h * 128 + lane]); qs[lane + 64] = bf2f(QB[(size_t)q * 1024 + h * 128 + 64 + lane]);
        int cnt = 0;
        for (int j = 0; j < nw; ++j) { const unsigned long long w = MASK[(size_t)q * 64 + j]; const bool on = (w >> lane) & 1ull; const int key = j * 64 + lane;
            if (on) { const pg8::u32x4* kp = (const pg8::u32x4*)(KB + ((size_t)b * SEQ + key) * 1024 + h * 128); float dot = 0.f;
                for (int d8 = 0; d8 < 16; ++d8) { pg8::f32x4 a, bb; pg8::unpack8(kp[d8], a, bb);
#pragma unroll
                    for (int j2 = 0; j2 < 4; ++j2) dot += qs[d8 * 8 + j2] * a[j2] + qs[d8 * 8 + 4 + j2] * bb[j2]; }
                const int pos = cnt + __popcll(w & ((1ull << lane) - 1ull));
                if (pos < 320) { keys[pos] = key; lg[pos] = dot * ATTN_SCALE; } }
            cnt += __popcll(w); }
        if (cnt > 320) cnt = 320;
        float mx = -1e30f; for (int e = lane; e < cnt; e += 64) mx = fmaxf(mx, lg[e]);
#pragma unroll
        for (int m = 32; m >= 1; m >>= 1) mx = fmaxf(mx, __shfl_xor(mx, m));
        float sum = 0.f; for (int e = lane; e < cnt; e += 64) { const float pe = expf(lg[e] - mx); lg[e] = pe; sum += pe; }
#pragma unroll
        for (int m = 32; m >= 1; m >>= 1) sum += __shfl_xor(sum, m);
        float a0 = 0.f, a1 = 0.f;
        for (int e = 0; e < cnt; ++e) { const float pe = lg[e]; const bf16_t* vp = VB + ((size_t)b * SEQ + keys[e]) * 1024 + h * 128 + 2 * lane; a0 += pe * bf2f(vp[0]); a1 += pe * bf2f(vp[1]); }
        const float inv = 1.0f / sum;
        *(unsigned*)(YB + (size_t)q * 1024 + h * 128 + 2 * lane) = pg8::cvt_pk_bf16(a0 * inv, a1 * inv);
    }
}

constexpr int IXK = 512, IX_LD = 144;
__device__ __forceinline__ void idx_unit(const bf16_t* QI, const bf16_t* KI, const float* WI, float* Sc, int b, int c, int half, int tid, LAS unsigned char* lds) {
    const int lane = tid & 63, wave = __builtin_amdgcn_readfirstlane(tid >> 6), r = lane & 31, hh = lane >> 5, nk = 64 * (c + 1);
    const int s0 = c * 64 + half * 32 + wave * 4;
    const int aq = (r >> 2) & 1, ahead = (r & 3) + 4 * (r >> 3);
    bf16x8_t A[2][4]; float wv[2][16];
#pragma unroll
    for (int rt = 0; rt < 2; ++rt) { const size_t qrow = (size_t)b * SEQ + s0 + 2 * rt + aq;
#pragma unroll
        for (int ks = 0; ks < 4; ++ks) A[rt][ks] = *(const bf16x8_t*)(QI + qrow * 1024 + ahead * 64 + 16 * ks + 8 * hh);
        const float* wp = WI + ((size_t)b * SEQ + s0 + 2 * rt + hh) * 16;
#pragma unroll
        for (int i4 = 0; i4 < 4; ++i4) { const pg8::f32x4 w4 = *(const pg8::f32x4*)(wp + 4 * i4); wv[rt][4 * i4] = w4[0]; wv[rt][4 * i4 + 1] = w4[1]; wv[rt][4 * i4 + 2] = w4[2]; wv[rt][4 * i4 + 3] = w4[3]; } }
    float* srow[2];
#pragma unroll
    for (int rt = 0; rt < 2; ++rt) srow[rt] = Sc + (size_t)b * SCORE_B + (size_t)2048 * c * (c + 1) + (size_t)((s0 + 2 * rt + hh) & 63) * nk + r;
    const bf16_t* kbase = KI + (size_t)b * SEQ * 64;
    const int nblk = (nk + IXK - 1) / IXK;
    pg8::u32x4 stg[8];
#define IX_LOAD(kb) do { _Pragma("unroll") for (int i = 0; i < 8; ++i) { const int p = tid + 512 * i; int key = (kb) * IXK + (p >> 3); key = key < nk ? key : nk - 1; \
        stg[i] = *(const pg8::u32x4*)(kbase + (size_t)key * 64 + (p & 7) * 8); } } while (0)
#define IX_STORE() do { _Pragma("unroll") for (int i = 0; i < 8; ++i) { const int p = tid + 512 * i; *(LAS pg8::u32x4*)(lds + (p >> 3) * IX_LD + (p & 7) * 16) = stg[i]; } } while (0)
    IX_LOAD(0);
    for (int kb = 0; kb < nblk; ++kb) {
        __syncthreads();
        IX_STORE();
        __syncthreads();
        if (kb + 1 < nblk) IX_LOAD(kb + 1);
        const int ntile = (nk - kb * IXK < IXK ? nk - kb * IXK : IXK) / 32;
        for (int t = 0; t < ntile; ++t) { bf16x8_t Bc[4];
#pragma unroll
            for (int ks = 0; ks < 4; ++ks) Bc[ks] = *(const LAS bf16x8_t*)(lds + (32 * t + r) * IX_LD + (16 * ks + 8 * hh) * 2);
#pragma unroll
            for (int rt = 0; rt < 2; ++rt) { f32x16_t acc;
#pragma unroll
                for (int i = 0; i < 16; ++i) acc[i] = 0.f;
#pragma unroll
                for (int ks = 0; ks < 4; ++ks) acc = __builtin_amdgcn_mfma_f32_32x32x16_bf16(A[rt][ks], Bc[ks], acc, 0, 0, 0);
                pg8::f32x2 sc2 = {0.f, 0.f};
#pragma unroll
                for (int i = 0; i < 16; i += 2) { pg8::f32x2 rl, wq; rl[0] = __int_as_float(max(__float_as_int(acc[i]), 0)); rl[1] = __int_as_float(max(__float_as_int(acc[i + 1]), 0));
                    wq[0] = wv[rt][i]; wq[1] = wv[rt][i + 1]; sc2 = __builtin_elementwise_fma(wq, rl, sc2); }
                srow[rt][kb * IXK + t * 32] = sc2[0] + sc2[1]; } }
    }
#undef IX_LOAD
#undef IX_STORE
}
__device__ __forceinline__ void phase_idx(KP P, LAS unsigned char* lds) {
    unsigned char* ws = as_global(P->ws);
    const bf16_t* QI = (const bf16_t*)(ws + WS_QI); const bf16_t* KI = (const bf16_t*)(ws + WS_KI); const float* WI = (const float*)(ws + WS_WI); float* Sc = (float*)(ws + WS_S);
    const int G = nblk_();
    for (int item = bid_(); item < 240; item += G) {
        const int pi = item % 30, combo = item / 30, b = combo >> 1, half = combo & 1;
        idx_unit(QI, KI, WI, Sc, b, 4 + pi, half, tid_(), lds); __syncthreads();
        idx_unit(QI, KI, WI, Sc, b, 63 - pi, half, tid_(), lds); __syncthreads();
    }
}

__device__ __forceinline__ void sel_unit(const float* S, unsigned long long* MASK, int b, int c, int half, int tid, LAS unsigned char* lds) {
    const int lane = tid & 63, wave = __builtin_amdgcn_readfirstlane(tid >> 6), nw = c + 1;
    LAS unsigned long long* sm = (LAS unsigned long long*)lds + wave * 64;
    float f[64]; const int s0 = c * 64 + half * 32 + wave * 4;
    const float* rowbase = S + (size_t)b * SCORE_B + (size_t)2048 * c * (c + 1);
#pragma unroll 1
    for (int i = 0; i < 4; ++i) {
        unsigned u[64];
        sel_load(rowbase + (size_t)((s0 + i) & 63) * (nw * 64), nw, lane, f);
#pragma unroll
        for (int j = 0; j < 64; ++j) { const unsigned bits = __float_as_uint(f[j]); const unsigned v = (bits & 0x80000000u) ? ~bits : (bits | 0x80000000u); u[j] = (j < nw) ? v : 0u; }
        unsigned prefix = 0u;
        for (int bit = 31; bit >= 0; --bit) { const unsigned cand = prefix | (1u << bit); int cnt = 0;
#pragma unroll
            for (int j8 = 0; j8 < 8; ++j8) if (j8 * 8 < nw) { unsigned long long bl[8];
#pragma unroll
                for (int jj = 0; jj < 8; ++jj) bl[jj] = __ballot(u[j8 * 8 + jj] >= cand);
                asm volatile("" : "+s"(bl[0]), "+s"(bl[1]), "+s"(bl[2]), "+s"(bl[3]), "+s"(bl[4]), "+s"(bl[5]), "+s"(bl[6]), "+s"(bl[7]));
#pragma unroll
                for (int jj = 0; jj < 8; ++jj) cnt += __popcll(bl[jj]); }
            if (cnt >= TOPK) prefix = cand; }
#pragma unroll
        for (int j = 0; j < 64; ++j) { const unsigned long long w = __ballot(u[j] >= prefix); if (lane == 0) sm[j] = w; }
        MASK[((size_t)b * SEQ + s0 + i) * 64 + lane] = sm[lane];
    }
}
__device__ __forceinline__ void phase_idxsel(KP P, LAS unsigned char* lds) {
    unsigned char* ws = as_global(P->ws);
    const bf16_t* QI = (const bf16_t*)(ws + WS_QI); const bf16_t* KI = (const bf16_t*)(ws + WS_KI); const float* WI = (const float*)(ws + WS_WI); float* Sc = (float*)(ws + WS_S);
    unsigned long long* MASK = (unsigned long long*)(ws + WS_MASK);
    const int G = nblk_();
    { const int tid = tid_(), lane = tid & 63, gw = bid_() * 8 + __builtin_amdgcn_readfirstlane(tid >> 6);
      for (int qq = gw; qq < NBATCH * 256; qq += G * 8) { const int b = qq >> 8, s = qq & 255, nw = (s >> 6) + 1; MASK[((size_t)b * SEQ + s) * 64 + lane] = (lane < nw) ? ~0ull : 0ull; } }
    for (int item = bid_(); item < 240; item += G) {
        const int pi = item % 30, combo = item / 30, b = combo >> 1, half = combo & 1;
#pragma unroll 1
        for (int which = 0; which < 2; ++which) { const int c = which ? 63 - pi : 4 + pi;
            idx_unit(QI, KI, WI, Sc, b, c, half, tid_(), lds);
            asm volatile("s_waitcnt vmcnt(0)" ::: "memory"); __syncthreads();
            sel_unit(Sc, MASK, b, c, half, tid_(), lds);
            __syncthreads(); }
    }
}
__device__ __forceinline__ void ixs_unit(const bf16_t* QI, const bf16_t* KI, const float* WI, unsigned long long* MASK, int b, int u8, int tid, LAS unsigned char* lds) {
    const int lane = tid & 63, wave = __builtin_amdgcn_readfirstlane(tid >> 6), r = lane & 31, hh = lane >> 5;
    const int s0 = 8 * u8, c = s0 >> 6, nw = c + 1, nk = 64 * nw;
    LAS float* SC = (LAS float*)lds;
    unsigned long long myword;
    if (nw > TOPK / 64) {
        { const int aq = (r >> 2) & 1, ahead = (r & 3) + 4 * (r >> 3);
          bf16x8_t A[4][4]; float wv[4][16];
#pragma unroll
          for (int rt = 0; rt < 4; ++rt) { const size_t qrow = (size_t)b * SEQ + s0 + 2 * rt + aq;
#pragma unroll
              for (int ks = 0; ks < 4; ++ks) A[rt][ks] = *(const bf16x8_t*)(QI + qrow * 1024 + ahead * 64 + 16 * ks + 8 * hh);
              const float* wp = WI + ((size_t)b * SEQ + s0 + 2 * rt + hh) * 16;
#pragma unroll
              for (int i4 = 0; i4 < 4; ++i4) { const pg8::f32x4 w4 = *(const pg8::f32x4*)(wp + 4 * i4); wv[rt][4 * i4] = w4[0]; wv[rt][4 * i4 + 1] = w4[1]; wv[rt][4 * i4 + 2] = w4[2]; wv[rt][4 * i4 + 3] = w4[3]; } }
          const bf16_t* kp = KI + ((size_t)b * SEQ + r) * 64 + 8 * hh;
          const int ntile = nk / 32;
          bf16x8_t Ca[4], Cb[4];
#define IXS_LOAD(t0_) do { const int ta = (t0_) < ntile ? (t0_) : ntile - 1, tb_ = (t0_) + 8 < ntile ? (t0_) + 8 : ntile - 1; \
              _Pragma("unroll") for (int ks = 0; ks < 4; ++ks) { Ca[ks] = *(const bf16x8_t*)(kp + (size_t)ta * 2048 + 16 * ks); Cb[ks] = *(const bf16x8_t*)(kp + (size_t)tb_ * 2048 + 16 * ks); } } while (0)
#define IXS_TILE(BUF, tt) do { _Pragma("unroll") for (int rt = 0; rt < 4; ++rt) { f32x16_t acc; _Pragma("unroll") for (int i = 0; i < 16; ++i) acc[i] = 0.f; \
              _Pragma("unroll") for (int ks = 0; ks < 4; ++ks) acc = __builtin_amdgcn_mfma_f32_32x32x16_bf16(A[rt][ks], BUF[ks], acc, 0, 0, 0); \
              pg8::f32x2 sc2 = {0.f, 0.f}; _Pragma("unroll") for (int i = 0; i < 16; i += 2) { pg8::f32x2 rl, wq; \
                  rl[0] = __int_as_float(max(__float_as_int(acc[i]), 0)); rl[1] = __int_as_float(max(__float_as_int(acc[i + 1]), 0)); wq[0] = wv[rt][i]; wq[1] = wv[rt][i + 1]; \
                  sc2 = __builtin_elementwise_fma(wq, rl, sc2); } const float sc = sc2[0] + sc2[1];     \
              SC[(2 * rt + hh) * 4096 + 32 * (tt) + r] = sc; } } while (0)
          IXS_LOAD(wave);
          for (int t = wave; t < ntile; t += 16) {
              bf16x8_t Ba[4], Bb[4];
#pragma unroll
              for (int ks = 0; ks < 4; ++ks) { Ba[ks] = Ca[ks]; Bb[ks] = Cb[ks]; }
              IXS_LOAD(t + 16);
              IXS_TILE(Ba, t);
              if (t + 8 < ntile) IXS_TILE(Bb, t + 8);
          }
#undef IXS_LOAD
#undef IXS_TILE
        }
        __syncthreads();
        unsigned u[64];
        { const LAS float* row = SC + wave * 4096 + lane;
#pragma unroll
          for (int j = 0; j < 64; ++j) { const int jc = j < nw ? j : nw - 1; const unsigned bits = __float_as_uint(row[jc * 64]); const unsigned v = (bits & 0x80000000u) ? ~bits : (bits | 0x80000000u); u[j] = (j < nw) ? v : 0u; } }
        unsigned prefix = 0u;
#ifdef IXS_DUP_SEARCH
        for (int rep_s = 0; rep_s < 2; ++rep_s) { prefix = 0u;
#else
        {
#endif
        for (int bit = 31; bit >= 0; --bit) { const unsigned cand = prefix | (1u << bit); int cnt = 0;
            unsigned cl = 0u;
#pragma unroll
            for (int j8 = 0; j8 < 8; ++j8) if (j8 * 8 < nw) {
#pragma unroll
                for (int jj = 0; jj < 8; ++jj) cl += (u[j8 * 8 + jj] >= cand) ? 1u : 0u; }
#pragma unroll
            for (int bb = 0; bb < 7; ++bb) cnt += __popcll(__ballot((cl >> bb) & 1u)) << bb;
            if (cnt >= TOPK) prefix = cand; }
        }
        LAS unsigned long long* sm = (LAS unsigned long long*)(SC + wave * 4096);
#pragma unroll
        for (int j = 0; j < 64; ++j) { const unsigned long long w = __ballot(u[j] >= prefix); if (lane == 0) sm[j] = w; }
        myword = sm[lane];
    } else {
        myword = (lane < nw) ? ~0ull : 0ull;
    }
    MASK[((size_t)b * SEQ + s0 + wave) * 64 + lane] = myword;
    __syncthreads();
}
__device__ __forceinline__ void phase_ixs(KP P, LAS unsigned char* lds) {
    unsigned char* ws = as_global(P->ws);
    const bf16_t* QI = (const bf16_t*)(ws + WS_QI); const bf16_t* KI = (const bf16_t*)(ws + WS_KI); const float* WI = (const float*)(ws + WS_WI); unsigned long long* MASK = (unsigned long long*)(ws + WS_MASK);
    const int G = nblk_();
    for (int W = bid_(); W < 256; W += G)
        for (int kk = 0; kk < 8; ++kk) ixs_unit(QI, KI, WI, MASK, W & 3, (W >> 2) + 64 * kk, tid_(), lds);
}
#ifndef OPT_HGRN
#define OPT_HGRN 1
#endif
#ifndef OPT_IDX
#define OPT_IDX 1
#endif
#ifndef OPT_ATT
#define OPT_ATT 1
#endif
#ifndef OPT_IXS
#define OPT_IXS 0
#endif
#ifndef PHM
#define PHM 0x3fff
#endif
#ifndef DUP_MASK
#define DUP_MASK 0
#endif

__global__ void __launch_bounds__(512, 2) mega(Params P_unused) {
    extern __shared__ __attribute__((aligned(16))) unsigned char lds[];
    LAS unsigned char* L = (LAS unsigned char*)lds;
    volatile LAS unsigned* misc = (volatile LAS unsigned*)(L + MISC_OFF);
    if (threadIdx.x < 4) misc[threadIdx.x] = 0u;
    __syncthreads();
    int lo, hi; unsigned char* ws0; { KP P0 = kparams(); lo = P0->ph_lo; hi = P0->ph_hi; ws0 = as_global(P0->ws); }
    XcdBarrier bar; bar.bar = (unsigned*)(ws0 + WS_CTL); bar.x = 0; bar.st = misc;
    if (hi - lo > 1) bar = xcd_barrier_post((unsigned*)(ws0 + WS_CTL), misc);
#define WSP(T_, off) ((T_*)(ws + (off)))
#define WSL KP P = kparams(); unsigned char* ws = as_global(P->ws); const int G = nblk_(), bid = bid_(); (void)G; (void)bid

    for (int layer = 0; layer < DEPTH; ++layer) {
        const int base = layer * NPH_LAYER;
#define IN(k) (((PHM >> (k)) & 1) && lo <= base + (k) && base + (k) < hi)
#define SEAM(k) do { if (rep + 1 == ((((DUP_MASK >> (k)) & 1) ? 2 : 1)) && base + (k) + 1 < hi) xcd_barrier(bar); } while (0)
        if (layer == 0 && IN(0)) for (int rep = 0; rep < (((DUP_MASK >> 0) & 1) ? 2 : 1); ++rep) { WSL; phase_prologue(P); phase_wconv(P, 0, L); SEAM(0); }
        if (IN(1)) for (int rep = 0; rep < (((DUP_MASK >> 1) & 1) ? 2 : 1); ++rep) { WSL;
            pg8::Gemm g{WSP(const bf16_t, WS_XB), WSP(const bf16_t, WS_WIN), TOK, INP, DM}; pg8::StaticOrder S; S.init(TOK, INP, G, bid);
            pg8::EpiIn E{ws, layer};
            pg8::gemm_phase<pg8::EpiIn, pg8::StaticOrder, true, true>(L, g, S, E); SEAM(1);
        }
        if (IN(2)) for (int rep = 0; rep < (((DUP_MASK >> 2) & 1) ? 2 : 1); ++rep) { WSL; phase_ikprep(P, layer);
#if OPT_HGRN
            phase_hgrn_h1(P, L);
#ifdef DUP_H1
            phase_hgrn_h1(P, L);
#endif
#endif
            SEAM(2); }
        if (IN(3)) for (int rep = 0; rep < (((DUP_MASK >> 3) & 1) ? 2 : 1); ++rep) { WSL;
#if !OPT_HGRN
            phase_hgrn_naive(P, layer, L); __syncthreads();
#else
            phase_hgrn_h2(P);
#ifdef DUP_H2
            phase_hgrn_h2(P);
#endif
#endif
#if !OPT_IDX
            phase_idx_naive(P, L);
#else
#if OPT_IXS == 2
            __syncthreads(); phase_idxsel(P, L);
#elif OPT_IXS == 1
            __syncthreads(); phase_ixs(P, L);
#ifdef DUP_IXS
            __syncthreads(); phase_ixs(P, L);
#endif
#else
            __syncthreads(); phase_idx(P, L);
#endif
#endif
            SEAM(3); }
#if OPT_IXS == 2 && OPT_HGRN && OPT_ATT
#else
        if (IN(4)) for (int rep = 0; rep < (((DUP_MASK >> 4) & 1) ? 2 : 1); ++rep) { WSL;
#if OPT_IXS == 0
            phase_select(P, L);
#endif
#if OPT_HGRN
            __syncthreads(); phase_hgrn_h3(P, layer, L);
#ifdef DUP_H3
            __syncthreads(); phase_hgrn_h3(P, layer, L);
#endif
#endif
            SEAM(4); }
#endif
        if (IN(5)) for (int rep = 0; rep < (((DUP_MASK >> 5) & 1) ? 2 : 1); ++rep) { WSL;
#if !OPT_ATT
            phase_attn_naive(P, L);
#else
#if OPT_IXS == 2 && OPT_HGRN
            phase_hgrn_h3(P, layer, L); __syncthreads();
#endif
            phase_attn(P, L);
#endif
            SEAM(5); }
        if (IN(6)) for (int rep = 0; rep < (((DUP_MASK >> 6) & 1) ? 2 : 1); ++rep) { WSL;
            { pg8::Gemm g{WSP(const bf16_t, WS_YA), WSP(const bf16_t, WS_WA), TOK, DM, AW}; pg8::StaticOrder S; S.init(TOK, DM, G, bid);
              pg8::EpiGateA E{ws}; pg8::gemm_phase<pg8::EpiGateA, pg8::StaticOrder, true, true>(L, g, S, E); }
            { pg8::Gemm g{WSP(const bf16_t, WS_YB), WSP(const bf16_t, WS_WB), TOK, DM, BW}; pg8::StaticOrder S; S.init(TOK, DM, G, bid);
              pg8::EpiGateB E{ws}; pg8::gemm_phase<pg8::EpiGateB, pg8::StaticOrder, true, true>(L, g, S, E); }
            { pg8::Gemm g{WSP(const bf16_t, WS_PB), WSP(const bf16_t, WS_WPP), TOK, DM, PLE}; pg8::StaticOrder S; S.init(TOK, DM, G, bid);
              pg8::EpiF32P E{ws}; pg8::gemm_phase<pg8::EpiF32P, pg8::StaticOrder, true, true>(L, g, S, E); }
            SEAM(6);
        }
        if (IN(7)) for (int rep = 0; rep < (((DUP_MASK >> 7) & 1) ? 2 : 1); ++rep) { WSL;
            pg8::Gemm g{WSP(const bf16_t, WS_MG), WSP(const bf16_t, WS_WO), TOK, DM, DM}; pg8::StaticOrder S; S.init(TOK, DM, G, bid);
            if (layer == 0) { pg8::EpiRes<true> E{as_global(P->x), nullptr, nullptr, ws}; pg8::gemm_phase<pg8::EpiRes<true>, pg8::StaticOrder, true, true>(L, g, S, E); }
            else { pg8::EpiRes<false> E{nullptr, P->lnp_g + (layer - 1) * DM, P->lnp_b + (layer - 1) * DM, ws}; pg8::gemm_phase<pg8::EpiRes<false>, pg8::StaticOrder, true, true>(L, g, S, E); }
            SEAM(7);
        }
        if (IN(8)) for (int rep = 0; rep < (((DUP_MASK >> 8) & 1) ? 2 : 1); ++rep) { WSL; phase_ln(WSP(const float, WS_XPRE), nullptr, WSP(bf16_t, WS_XB), WSP(float, WS_STATS), as_global(P->lnm_g) + layer * DM, as_global(P->lnm_b) + layer * DM); SEAM(8); }
        if (IN(9)) for (int rep = 0; rep < (((DUP_MASK >> 9) & 1) ? 2 : 1); ++rep) { WSL;
            pg8::Gemm g{WSP(const bf16_t, WS_XB), WSP(const bf16_t, WS_WGU), TOK, 2 * DFF, DM}; pg8::StaticOrder S; S.init(TOK, 2 * DFF, G, bid);
            pg8::EpiSwiGLU E{ws}; pg8::gemm_phase<pg8::EpiSwiGLU, pg8::StaticOrder, true, true>(L, g, S, E); SEAM(9);
        }
        if (IN(10)) for (int rep = 0; rep < (((DUP_MASK >> 10) & 1) ? 2 : 1); ++rep) { WSL;
            pg8::Gemm g{WSP(const bf16_t, WS_H), WSP(const bf16_t, WS_WDN), TOK, DM, DFF}; pg8::StaticOrder S; S.init(TOK, DM, G, bid);
            pg8::EpiRes<false> E{nullptr, P->lnm_g + layer * DM, P->lnm_b + layer * DM, ws}; pg8::gemm_phase<pg8::EpiRes<false>, pg8::StaticOrder, true, true>(L, g, S, E); SEAM(10);
        }
        if (IN(11)) for (int rep = 0; rep < (((DUP_MASK >> 11) & 1) ? 2 : 1); ++rep) { WSL; phase_ln(WSP(const float, WS_XPRE), nullptr, WSP(bf16_t, WS_XB), WSP(float, WS_STATS), as_global(P->lnf_g) + layer * DM, as_global(P->lnf_b) + layer * DM); SEAM(11); }
        if (IN(12)) for (int rep = 0; rep < (((DUP_MASK >> 12) & 1) ? 2 : 1); ++rep) { WSL;
            pg8::Gemm g{WSP(const bf16_t, WS_XB), WSP(const bf16_t, WS_WPG), TOK, DM, DM}; pg8::StaticOrder S; S.init(TOK, DM, G, bid);
            pg8::EpiPle E{P->lnf_g + layer * DM, P->lnf_b + layer * DM, ws}; pg8::gemm_phase<pg8::EpiPle, pg8::StaticOrder, true, true>(L, g, S, E); SEAM(12);
        }
        if (IN(13)) for (int rep = 0; rep < (((DUP_MASK >> 13) & 1) ? 2 : 1); ++rep) { WSL; phase_ln(WSP(const float, WS_XPRE), layer == DEPTH - 1 ? as_global(P->out) : nullptr, WSP(bf16_t, WS_XB), WSP(float, WS_STATS), as_global(P->lnp_g) + layer * DM, as_global(P->lnp_b) + layer * DM);
            if (layer + 1 < DEPTH) { __syncthreads(); phase_wconv(P, layer + 1, L); }
            SEAM(13); }
#undef IN
#undef SEAM
    }
}

extern "C" void kernel_launch(void* const* d_in, const int* in_sizes, int n_in, void* d_out, int out_size, void* d_ws, size_t ws_size, hipStream_t stream) {
    static int grid = 0;
    if (grid == 0) {
        if (n_in != 22 || out_size != TOK * DM || ws_size < WS_END) { fprintf(stderr, "kernel_launch: unexpected shapes: n_in %d out %d ws %zu (need %zu)\n", n_in, out_size, ws_size, (size_t)WS_END); grid = -1; return; }
        int dev = 0, cus = 0, per_cu = 0;
        if (hipGetDevice(&dev) != hipSuccess || hipDeviceGetAttribute(&cus, hipDeviceAttributeMultiprocessorCount, dev) != hipSuccess) { grid = -1; return; }
        if (hipFuncSetAttribute((const void*)mega, hipFuncAttributeMaxDynamicSharedMemorySize, LDS_BYTES) != hipSuccess) { fprintf(stderr, "kernel_launch: hipFuncSetAttribute failed\n"); grid = -1; return; }
        if (hipOccupancyMaxActiveBlocksPerMultiprocessor(&per_cu, (const void*)mega, 512, LDS_BYTES) != hipSuccess || per_cu < 1) { fprintf(stderr, "kernel_launch: occupancy query says %d\n", per_cu); (void)hipGetLastError(); }
        grid = cus;
    }
    if (grid < 0) return;
    (void)hipMemsetAsync((char*)d_ws + WS_CTL, 0, 65536, stream);
    Params P{};
    P.x = (const float*)d_in[0]; P.p = (const float*)d_in[1]; P.pos = (const int*)d_in[2];
    P.w_in = (const float*)d_in[3]; P.w_a = (const float*)d_in[4]; P.w_b = (const float*)d_in[5]; P.w_out = (const float*)d_in[6];
    P.lbraw = (const float*)d_in[7]; P.hnorm_g = (const float*)d_in[8]; P.ikn_g = (const float*)d_in[9]; P.ikn_b = (const float*)d_in[10];
    P.lnm_g = (const float*)d_in[11]; P.lnm_b = (const float*)d_in[12]; P.w_fg = (const float*)d_in[13]; P.w_fu = (const float*)d_in[14]; P.w_fd = (const float*)d_in[15];
    P.lnf_g = (const float*)d_in[16]; P.lnf_b = (const float*)d_in[17]; P.w_pg = (const float*)d_in[18]; P.w_pp = (const float*)d_in[19];
    P.lnp_g = (const float*)d_in[20]; P.lnp_b = (const float*)d_in[21];
    P.out = (float*)d_out; P.ws = (unsigned char*)d_ws;
    for (int j = 0; j < 64; ++j) P.invf_h[j] = pow(10000.0, -(double)j / 64.0) / 6.283185307179586476925286766559;
    for (int j = 0; j < 32; ++j) P.invf_i[j] = pow(10000.0, -(double)j / 32.0) / 6.283185307179586476925286766559;
    P.ph_lo = 0; P.ph_hi = NPH;
    hipLaunchKernelGGL(mega, dim3(grid), dim3(512), LDS_BYTES, stream, P);
    const hipError_t le = hipPeekAtLastError();
    if (le != hipSuccess) fprintf(stderr, "kernel_launch: launch failed: %s\n", hipGetErrorName(le));
}
```

```cpp
#include <hip/hip_runtime.h>
#include <cstdio>
#include <cstdint>

constexpr int DM = 2048, NBATCH = 4, SEQ = 4096, TOK = NBATCH * SEQ, DEPTH = 4, CHUNK = 64, PLE = 256;
constexpr int AH = 8, AD = 128, AW = 1024, BH = 8, BD = 128, BW = 1024, IH = 16, IDIM = 64, TOPK = 256;
constexpr int DFF = 5632, INW = 12368, INP = 12544;
constexpr float ALPHA = 1.6817928305074290861f;
constexpr float LN_EPS = 1e-5f, RMS_EPS = 1e-6f;
constexpr float ATTN_SCALE = 0.088388347648318440f;
constexpr float IDX_SCALE = 0.03125f;

typedef unsigned short bf16_t;
__device__ __forceinline__ float bf2f(bf16_t b) { return __uint_as_float(((unsigned)b) << 16); }
__device__ __forceinline__ bf16_t f2bf(float f) { unsigned u = __float_as_uint(f); u += 0x7FFFu + ((u >> 16) & 1u); return (bf16_t)(u >> 16); }
__device__ __forceinline__ float sigmoid_f(float x) { return __builtin_amdgcn_rcpf(1.0f + __expf(-x)); }
__device__ __forceinline__ float silu_f(float x) { return x * sigmoid_f(x); }

__device__ __forceinline__ int tid_() { int t = (int)threadIdx.x; asm volatile("" : "+v"(t)); return t; }
__device__ __forceinline__ int bid_() { int b = (int)blockIdx.x; asm volatile("" : "+s"(b)); return b; }
__device__ __forceinline__ int nblk_() { int g = (int)gridDim.x; asm volatile("" : "+s"(g)); return g; }

template <class T> __device__ __forceinline__ T* as_global(T* p) { return (T*)(__attribute__((address_space(1))) T*)p; }

constexpr size_t MiB = 1048576;
constexpr size_t WS_CTL  = 0;
constexpr size_t WS_LB   = WS_CTL + 65536;
constexpr size_t WS_STATS = WS_CTL + 131072;
constexpr size_t WS_COSH = 1 * MiB;
constexpr size_t WS_SINH = WS_COSH + 4 * MiB;
constexpr size_t WS_COSI = WS_SINH + 4 * MiB;
constexpr size_t WS_SINI = WS_COSI + 2 * MiB;
constexpr size_t WS_WIN  = WS_SINI + 2 * MiB;
constexpr size_t WS_WA   = WS_WIN + 49 * MiB;
constexpr size_t WS_WB   = WS_WA + 4 * MiB;
constexpr size_t WS_WO   = WS_WB + 4 * MiB;
constexpr size_t WS_WGU  = WS_WO + 8 * MiB;
constexpr size_t WS_WDN  = WS_WGU + 44 * MiB;
constexpr size_t WS_WPG  = WS_WDN + 22 * MiB;
constexpr size_t WS_WPP  = WS_WPG + 8 * MiB;
constexpr size_t WS_S    = WS_WPP + 1 * MiB;
constexpr size_t WS_XB   = WS_S + 130 * MiB;
constexpr size_t WS_XPRE = WS_XB + 64 * MiB;
constexpr size_t WS_R1   = WS_XPRE + 130 * MiB;
constexpr size_t WS_QA   = WS_R1;
constexpr size_t WS_LF   = WS_QA + 32 * MiB;
constexpr size_t WS_KA   = WS_LF + 64 * MiB;
constexpr size_t WS_VA   = WS_KA + 32 * MiB;
constexpr size_t WS_GA   = WS_VA + 32 * MiB;
constexpr size_t WS_QB   = WS_GA + 32 * MiB;
constexpr size_t WS_KB   = WS_QB + 32 * MiB;
constexpr size_t WS_VB   = WS_KB + 32 * MiB;
constexpr size_t WS_QI   = WS_VB + 32 * MiB;
constexpr size_t WS_SGA  = WS_QI + 32 * MiB;
constexpr size_t WS_SGB  = WS_SGA + 64 * MiB;
constexpr size_t WS_IKW  = WS_SGB + 64 * MiB;
constexpr size_t WS_H    = WS_R1;
constexpr size_t WS_PP   = WS_R1 + 176 * MiB;
constexpr size_t WS_R2   = WS_IKW + 8 * MiB;
constexpr size_t WS_LT   = WS_R2;
constexpr size_t WS_MG   = WS_R2;
constexpr size_t WS_AF   = WS_R2 + 64 * MiB;
constexpr size_t WS_PT   = WS_LT + 128 * MiB;
constexpr size_t WS_DEC  = WS_PT + 64 * MiB;
constexpr size_t WS_MASK = WS_DEC + 1 * MiB;
constexpr size_t WS_YA   = WS_MASK + 8 * MiB;
constexpr size_t WS_YB   = WS_YA + 32 * MiB;
constexpr size_t WS_KI   = WS_YB + 32 * MiB;
constexpr size_t WS_WI   = WS_KI + 2 * MiB;
constexpr size_t WS_PB   = WS_WI + 1 * MiB;
constexpr size_t WS_END  = WS_PB + 8 * MiB;
static_assert(WS_END < 1360000000ull, "workspace budget");
constexpr size_t SCORE_B = (size_t)4096 * 2080;

namespace pg8 {
#define PG8_LAS __attribute__((address_space(3)))
typedef unsigned short bf16_t;
typedef short bf16x8 __attribute__((ext_vector_type(8)));
typedef float f32x4 __attribute__((ext_vector_type(4)));
typedef unsigned u32x4 __attribute__((ext_vector_type(4)));
constexpr int BM = 256, BK = 64, HALF = 128, HTB = HALF * BK * 2  , STAGE_BYTES = 8 * HTB, NXCD = 8, WGM = 8;

__host__ __device__ __forceinline__ int lds_byte(int r, int c) { const int st = (r >> 4) * 2 + (c >> 5), rr = r & 15, cc = c & 31, ob = rr * 64 + cc * 2; return st * 1024 + (ob ^ (((ob >> 9) & 1) << 5)); }
__host__ __device__ __forceinline__ void stage_rc(int b, int& R, int& C) { const int st = b / 1024, sb = b % 1024, swz = sb ^ (((sb >> 9) & 1) << 5); R = (st >> 1) * 16 + swz / 64; C = (st & 1) * 32 + (swz % 64) / 2; }
__host__ __device__ __forceinline__ int perm32(int rho) { const int n = rho >> 4, i = rho & 15; return 8 * (i >> 2) + 4 * n + (i & 3); }

struct Unit { int pm, pn; };
struct Gemm { const bf16_t* A; const bf16_t* Bt; int M, N, K; };

struct StaticOrder {
    int nM, nN, nwg, G, c;
    __host__ __device__ void init(int M, int N, int G_, int c_) { nM = M / BM; nN = N / BM; nwg = nM * nN; G = G_; c = c_; }
    __host__ __device__ bool next(int i, Unit& u) const {
        const long L = (long)i * G + c; if (L >= nwg) return false;
        int wgid = (int)L; { const int q = nwg / NXCD, r = nwg % NXCD, xcd = wgid % NXCD, off = wgid / NXCD; wgid = (xcd < r ? xcd * (q + 1) : r * (q + 1) + (xcd - r) * q) + off; }
        const int nig = WGM * nN, gid = wgid / nig, fm = gid * WGM, gsz = (nM - fm) < WGM ? (nM - fm) : WGM;
        u.pm = fm + ((wgid % nig) % gsz); u.pn = (wgid % nig) / gsz; return true;
    }
    __device__ __forceinline__ void a_ready(const Unit&) const {}
    __device__ __forceinline__ void done(const Unit&) const {}
};

typedef float pk_f32x2 __attribute__((ext_vector_type(2)));
typedef __bf16 pk_bf16x2 __attribute__((ext_vector_type(2)));
__device__ __forceinline__ unsigned cvt_pk_bf16(float lo, float hi) { const pk_f32x2 v = {lo, hi}; const pk_bf16x2 b = __builtin_convertvector(v, pk_bf16x2); return __builtin_bit_cast(unsigned, b); }
typedef unsigned u32x2 __attribute__((ext_vector_type(2)));
typedef float f32x2 __attribute__((ext_vector_type(2)));
__device__ __forceinline__ u32x4 pack8(const f32x4 a, const f32x4 b) { u32x4 w; w.x = cvt_pk_bf16(a[0], a[1]); w.y = cvt_pk_bf16(a[2], a[3]); w.z = cvt_pk_bf16(b[0], b[1]); w.w = cvt_pk_bf16(b[2], b[3]); return w; }
__device__ __forceinline__ void unpack8(const u32x4 w, f32x4& a, f32x4& b) {
    a[0] = __uint_as_float(w.x << 16); a[1] = __uint_as_float(w.x & 0xffff0000u); a[2] = __uint_as_float(w.y << 16); a[3] = __uint_as_float(w.y & 0xffff0000u);
    b[0] = __uint_as_float(w.z << 16); b[1] = __uint_as_float(w.z & 0xffff0000u); b[2] = __uint_as_float(w.w << 16); b[3] = __uint_as_float(w.w & 0xffff0000u); }
__device__ __forceinline__ float sigm(float x) { return __builtin_amdgcn_rcpf(1.0f + __expf(-x)); }
__device__ __forceinline__ f32x4 sigm4(const f32x4 x) { f32x4 r; r[0] = sigm(x[0]); r[1] = sigm(x[1]); r[2] = sigm(x[2]); r[3] = sigm(x[3]); return r; }
__device__ __forceinline__ f32x4 silu4(const f32x4 x) { return x * sigm4(x); }

#define PG8_GAS __attribute__((address_space(1)))
struct EpiIn {
    static constexpr bool PERM = true, AFTER_DRAIN = false;
    unsigned char* ws0; int layer;
    __device__ __forceinline__ void operator()(const f32x4 (&acc)[2][2][4][2], const Unit& u, int wr, int wc, int fr, int fq) const {
        unsigned char* wsq = ws0; asm volatile("" : "+s"(wsq)); PG8_GAS unsigned char* const ws = (PG8_GAS unsigned char*)wsq;
        const int pn = u.pn, row0 = u.pm * BM + wr * 64 + fr, cw = wc * 32 + 8 * fq;
        PG8_GAS bf16_t* const QA = (PG8_GAS bf16_t*)(ws + WS_QA); PG8_GAS bf16_t* const KA = (PG8_GAS bf16_t*)(ws + WS_KA); PG8_GAS bf16_t* const VA = (PG8_GAS bf16_t*)(ws + WS_VA); PG8_GAS bf16_t* const GA = (PG8_GAS bf16_t*)(ws + WS_GA);
        PG8_GAS bf16_t* const QB = (PG8_GAS bf16_t*)(ws + WS_QB); PG8_GAS bf16_t* const KB = (PG8_GAS bf16_t*)(ws + WS_KB); PG8_GAS bf16_t* const VB = (PG8_GAS bf16_t*)(ws + WS_VB); PG8_GAS bf16_t* const QI = (PG8_GAS bf16_t*)(ws + WS_QI);
        PG8_GAS bf16_t* const SGA = (PG8_GAS bf16_t*)(ws + WS_SGA); PG8_GAS bf16_t* const SGB = (PG8_GAS bf16_t*)(ws + WS_SGB); PG8_GAS float* const LF = (PG8_GAS float*)(ws + WS_LF); PG8_GAS float* const IKW = (PG8_GAS float*)(ws + WS_IKW);
        const PG8_GAS float* const lb = (const PG8_GAS float*)(ws + WS_LB) + layer * 1024; const PG8_GAS float* const cosh = (const PG8_GAS float*)(ws + WS_COSH); const PG8_GAS float* const sinh = (const PG8_GAS float*)(ws + WS_SINH);
        const PG8_GAS float* const cosi = (const PG8_GAS float*)(ws + WS_COSI); const PG8_GAS float* const sini = (const PG8_GAS float*)(ws + WS_SINI);
        if (pn < 32) {
            const int seg = pn >> 2, cb = (pn & 3) * 256;
            if (seg == 4 || seg == 5) {
                PG8_GAS bf16_t* O = (seg == 4) ? QB : KB; const int head = (pn & 3) * 2 + (wc >> 1), i0 = (wc & 1) * 32 + 8 * fq;
#pragma unroll
                for (int ai = 0; ai < 2; ++ai)
#pragma unroll
                    for (int m = 0; m < 4; ++m) { const int row = row0 + ai * HALF + m * 16;
                        const PG8_GAS float* cp = cosh + (size_t)row * 64 + i0; const PG8_GAS float* sp = sinh + (size_t)row * 64 + i0;
                        const f32x4 c0 = *(const PG8_GAS f32x4*)cp, c1 = *(const PG8_GAS f32x4*)(cp + 4), s0 = *(const PG8_GAS f32x4*)sp, s1 = *(const PG8_GAS f32x4*)(sp + 4);
                        const f32x4 xa = acc[ai][0][m][0], xb = acc[ai][0][m][1], ya = acc[ai][1][m][0], yb = acc[ai][1][m][1];
                        PG8_GAS bf16_t* rp = O + (size_t)row * 1024 + head * 128 + i0;
                        *(PG8_GAS u32x4*)rp = pack8(xa * c0 - ya * s0, xb * c1 - yb * s1);
                        *(PG8_GAS u32x4*)(rp + 64) = pack8(xa * s0 + ya * c0, xb * s1 + yb * c1); asm volatile("" ::: "memory"); }
            } else if (seg == 7) {
                const int head = (pn & 3) * 4 + wc, i0 = 8 * fq;
#pragma unroll
                for (int ai = 0; ai < 2; ++ai)
#pragma unroll
                    for (int m = 0; m < 4; ++m) { const int row = row0 + ai * HALF + m * 16;
                        const PG8_GAS float* cp = cosi + (size_t)row * 32 + i0; const PG8_GAS float* sp = sini + (size_t)row * 32 + i0;
                        const f32x4 c0 = *(const PG8_GAS f32x4*)cp, c1 = *(const PG8_GAS f32x4*)(cp + 4), s0 = *(const PG8_GAS f32x4*)sp, s1 = *(const PG8_GAS f32x4*)(sp + 4);
                        const f32x4 xa = acc[ai][0][m][0], xb = acc[ai][0][m][1], ya = acc[ai][1][m][0], yb = acc[ai][1][m][1];
                        PG8_GAS bf16_t* rp = QI + (size_t)row * 1024 + head * 64 + i0;
                        *(PG8_GAS u32x4*)rp = pack8(xa * c0 - ya * s0, xb * c1 - yb * s1);
                        *(PG8_GAS u32x4*)(rp + 32) = pack8(xa * s0 + ya * c0, xb * s1 + yb * c1); asm volatile("" ::: "memory"); }
            } else if (seg == 1) {
#pragma unroll
                for (int bj = 0; bj < 2; ++bj) { const int col = cb + bj * HALF + cw;
                    const f32x4 l0 = *(const PG8_GAS f32x4*)(lb + col), l1 = *(const PG8_GAS f32x4*)(lb + col + 4);
#pragma unroll
                    for (int ai = 0; ai < 2; ++ai)
#pragma unroll
                        for (int m = 0; m < 4; ++m) { const int row = row0 + ai * HALF + m * 16; f32x4 lf[2], kk[2];
#pragma unroll
                            for (int n = 0; n < 2; ++n) { const f32x4 x = acc[ai][bj][m][n]; const f32x4 lv = n ? l1 : l0;
#pragma unroll
                                for (int j = 0; j < 4; ++j) { const float xe = fminf(fmaxf(x[j], -80.f), 80.f), e = __expf(-xe), r = __builtin_amdgcn_rcpf(1.0f + e);
                                    const float om = 1.0f - lv[j]; lf[n][j] = logf(lv[j] + om * r); kk[n][j] = om * (e * r); } }
                            PG8_GAS float* lp = LF + (size_t)row * 1024 + col; *(PG8_GAS f32x4*)lp = lf[0]; *(PG8_GAS f32x4*)(lp + 4) = lf[1];
                            *(PG8_GAS u32x4*)(KA + (size_t)row * 1024 + col) = pack8(kk[0], kk[1]); asm volatile("" ::: "memory"); } }
            } else {
                PG8_GAS bf16_t* O = (seg == 0) ? QA : (seg == 2) ? VA : (seg == 3) ? GA : VB; const bool act = (seg == 0 || seg == 3);
#pragma unroll
                for (int ai = 0; ai < 2; ++ai)
#pragma unroll
                    for (int m = 0; m < 4; ++m) { const int row = row0 + ai * HALF + m * 16;
#pragma unroll
                        for (int bj = 0; bj < 2; ++bj) { f32x4 v0 = acc[ai][bj][m][0], v1 = acc[ai][bj][m][1];
                            if (act) { v0 = silu4(v0); v1 = silu4(v1); }
                            *(PG8_GAS u32x4*)(O + (size_t)row * 1024 + cb + bj * HALF + cw) = pack8(v0, v1); } }
            }
        } else if (pn < 48) {
            PG8_GAS bf16_t* O = (pn < 40) ? SGA : SGB; const int cb = ((pn - 32) & 7) * 256;
#pragma unroll
            for (int ai = 0; ai < 2; ++ai)
#pragma unroll
                for (int m = 0; m < 4; ++m) { const int row = row0 + ai * HALF + m * 16;
#pragma unroll
                    for (int bj = 0; bj < 2; ++bj)
                        *(PG8_GAS u32x4*)(O + (size_t)row * DM + cb + bj * HALF + cw) = pack8(sigm4(acc[ai][bj][m][0]), sigm4(acc[ai][bj][m][1])); }
        } else {
#pragma unroll
            for (int ai = 0; ai < 2; ++ai)
#pragma unroll
                for (int m = 0; m < 4; ++m) { PG8_GAS float* p = IKW + (size_t)(row0 + ai * HALF + m * 16) * 128 + cw; *(PG8_GAS f32x4*)p = acc[ai][0][m][0]; *(PG8_GAS f32x4*)(p + 4) = acc[ai][0][m][1]; }
        }
    }
};
struct EpiGateA {
    static constexpr bool PERM = true, AFTER_DRAIN = false;
    unsigned char* ws;
    __device__ __forceinline__ void operator()(const f32x4 (&acc)[2][2][4][2], const Unit& u, int wr, int wc, int fr, int fq) const {
        unsigned char* const wg = as_global(ws); const bf16_t* const SG = (const bf16_t*)(wg + WS_SGA); bf16_t* const AF = (bf16_t*)(wg + WS_AF);
        const int row0 = u.pm * BM + wr * 64 + fr, col0 = u.pn * BM + wc * 32 + 8 * fq;
#pragma unroll
        for (int ai = 0; ai < 2; ++ai)
#pragma unroll
            for (int m = 0; m < 4; ++m) { const size_t off = (size_t)(row0 + ai * HALF + m * 16) * DM + col0;
#pragma unroll
                for (int bj = 0; bj < 2; ++bj) { f32x4 g0, g1; unpack8(*(const u32x4*)(SG + off + bj * HALF), g0, g1);
                    *(u32x4*)(AF + off + bj * HALF) = pack8(g0 * acc[ai][bj][m][0], g1 * acc[ai][bj][m][1]); } asm volatile("" ::: "memory"); }
    }
};
struct EpiGateB {
    static constexpr bool PERM = true, AFTER_DRAIN = false;
    unsigned char* ws;
    __device__ __forceinline__ void operator()(const f32x4 (&acc)[2][2][4][2], const Unit& u, int wr, int wc, int fr, int fq) const {
        unsigned char* const wg = as_global(ws); const bf16_t* const SG = (const bf16_t*)(wg + WS_SGB); const bf16_t* const AF = (const bf16_t*)(wg + WS_AF); bf16_t* const MG = (bf16_t*)(wg + WS_MG);
        const int row0 = u.pm * BM + wr * 64 + fr, col0 = u.pn * BM + wc * 32 + 8 * fq;
#pragma unroll
        for (int ai = 0; ai < 2; ++ai)
#pragma unroll
            for (int m = 0; m < 4; ++m) { const size_t off = (size_t)(row0 + ai * HALF + m * 16) * DM + col0;
#pragma unroll
                for (int bj = 0; bj < 2; ++bj) { f32x4 g0, g1; unpack8(*(const u32x4*)(SG + off + bj * HALF), g0, g1);
                    f32x4 a0, a1; unpack8(*(const u32x4*)(AF + off + bj * HALF), a0, a1);
                    *(u32x4*)(MG + off + bj * HALF) = pack8(a0 + g0 * acc[ai][bj][m][0], a1 + g1 * acc[ai][bj][m][1]); } asm volatile("" ::: "memory"); }
    }
};
template <bool PLAIN> struct EpiRes {
    static constexpr bool PERM = true, AFTER_DRAIN = false;
    const float* X; const float* g; const float* b; unsigned char* ws;
    __device__ __forceinline__ void operator()(const f32x4 (&acc)[2][2][4][2], const Unit& u, int wr, int wc, int fr, int fq) const {
        unsigned char* const wg = as_global(ws); float* const XP = (float*)(wg + WS_XPRE); const float* const ST = (const float*)(wg + WS_STATS); const float* const Xg = as_global(X);
        const int row0 = u.pm * BM + wr * 64 + fr, col0 = u.pn * BM + wc * 32 + 8 * fq;
        f32x4 gv[2][2], bv[2][2];
        if (!PLAIN) { const float* gg = as_global(g); const float* bb = as_global(b);
#pragma unroll
            for (int bj = 0; bj < 2; ++bj)
#pragma unroll
                for (int n = 0; n < 2; ++n) { gv[bj][n] = *(const f32x4*)(gg + col0 + bj * HALF + 4 * n); bv[bj][n] = *(const f32x4*)(bb + col0 + bj * HALF + 4 * n); } }
#pragma unroll
        for (int ai = 0; ai < 2; ++ai)
#pragma unroll
            for (int m = 0; m < 4; ++m) { const int row = row0 + ai * HALF + m * 16; const size_t off = (size_t)row * DM + col0;
                float mean = 0.f, rstd = 1.f; if (!PLAIN) { const f32x2 s2 = *(const f32x2*)(ST + 2 * (size_t)row); mean = s2[0]; rstd = s2[1]; }
#pragma unroll
                for (int bj = 0; bj < 2; ++bj) { float* p = XP + off + bj * HALF; f32x4 x0, x1;
                    if (PLAIN) { const float* xp = Xg + off + bj * HALF; x0 = *(const f32x4*)xp; x1 = *(const f32x4*)(xp + 4); }
                    else { x0 = (*(const f32x4*)p - mean) * rstd * gv[bj][0] + bv[bj][0]; x1 = (*(const f32x4*)(p + 4) - mean) * rstd * gv[bj][1] + bv[bj][1]; }
                    *(f32x4*)p = x0 * ALPHA + acc[ai][bj][m][0]; *(f32x4*)(p + 4) = x1 * ALPHA + acc[ai][bj][m][1]; } asm volatile("" ::: "memory"); }
    }
};
struct EpiSwiGLU {
    static constexpr bool PERM = true, AFTER_DRAIN = false;
    unsigned char* ws;
    __device__ __forceinline__ void operator()(const f32x4 (&acc)[2][2][4][2], const Unit& u, int wr, int wc, int fr, int fq) const {
        bf16_t* const H = (bf16_t*)(as_global(ws) + WS_H);
        const int row0 = u.pm * BM + wr * 64 + fr, col0 = u.pn * HALF + wc * 32 + 8 * fq;
#pragma unroll
        for (int ai = 0; ai < 2; ++ai)
#pragma unroll
            for (int m = 0; m < 4; ++m)
                *(u32x4*)(H + (size_t)(row0 + ai * HALF + m * 16) * DFF + col0) = pack8(silu4(acc[ai][0][m][0]) * acc[ai][1][m][0], silu4(acc[ai][0][m][1]) * acc[ai][1][m][1]);
    }
};
struct EpiF32P {
    static constexpr bool PERM = true, AFTER_DRAIN = false;
    unsigned char* ws;
    __device__ __forceinline__ void operator()(const f32x4 (&acc)[2][2][4][2], const Unit& u, int wr, int wc, int fr, int fq) const {
        bf16_t* const C = (bf16_t*)(as_global(ws) + WS_PP);
        const int row0 = u.pm * BM + wr * 64 + fr, col0 = u.pn * BM + wc * 32 + 8 * fq;
#pragma unroll
        for (int ai = 0; ai < 2; ++ai)
#pragma unroll
            for (int m = 0; m < 4; ++m) { const size_t off = (size_t)(row0 + ai * HALF + m * 16) * DM + col0;
#pragma unroll
                for (int bj = 0; bj < 2; ++bj) *(u32x4*)(C + off + bj * HALF) = pack8(acc[ai][bj][m][0], acc[ai][bj][m][1]); }
    }
};
struct EpiPle {
    static constexpr bool PERM = true, AFTER_DRAIN = false;
    const float* g; const float* b; unsigned char* ws;
    __device__ __forceinline__ void operator()(const f32x4 (&acc)[2][2][4][2], const Unit& u, int wr, int wc, int fr, int fq) const {
        unsigned char* const wg = as_global(ws); const bf16_t* const PP = (const bf16_t*)(wg + WS_PP); float* const XP = (float*)(wg + WS_XPRE); const float* const ST = (const float*)(wg + WS_STATS);
        const int row0 = u.pm * BM + wr * 64 + fr, col0 = u.pn * BM + wc * 32 + 8 * fq;
        f32x4 gv[2][2], bv[2][2]; { const float* gg = as_global(g); const float* bb = as_global(b);
#pragma unroll
            for (int bj = 0; bj < 2; ++bj)
#pragma unroll
                for (int n = 0; n < 2; ++n) { gv[bj][n] = *(const f32x4*)(gg + col0 + bj * HALF + 4 * n); bv[bj][n] = *(const f32x4*)(bb + col0 + bj * HALF + 4 * n); } }
#pragma unroll
        for (int ai = 0; ai < 2; ++ai)
#pragma unroll
            for (int m = 0; m < 4; ++m) { const int row = row0 + ai * HALF + m * 16; const size_t off = (size_t)row * DM + col0;
                const f32x2 s2 = *(const f32x2*)(ST + 2 * (size_t)row); const float mean = s2[0], rstd = s2[1];
#pragma unroll
                for (int bj = 0; bj < 2; ++bj) { float* p = XP + off + bj * HALF; f32x4 p0, p1; unpack8(*(const u32x4*)(PP + off + bj * HALF), p0, p1);
                    const f32x4 x0 = (*(const f32x4*)p - mean) * rstd * gv[bj][0] + bv[bj][0], x1 = (*(const f32x4*)(p + 4) - mean) * rstd * gv[bj][1] + bv[bj][1];
                    *(f32x4*)p = x0 * ALPHA + sigm4(acc[ai][bj][m][0]) * p0; *(f32x4*)(p + 4) = x1 * ALPHA + sigm4(acc[ai][bj][m][1]) * p1; } asm volatile("" ::: "memory"); }
    }
};

template <class Epi, class Sched, bool ALIGN_EPI = false, bool SP2 = false>
__device__ __forceinline__ void gemm_phase(PG8_LAS unsigned char* lds, const Gemm g, const Sched& S, const Epi& E) {
    const int tid = tid_(), wid = __builtin_amdgcn_readfirstlane(tid >> 6), lane = tid & 63, wr = wid >> 2, wc = wid & 3, fr = lane & 15, fq = lane >> 4;
    int Kq = g.K; asm volatile("" : "+s"(Kq)); const int K = Kq, nt = K / BK;
    unsigned voffA[2], voffB[2];
#pragma unroll
    for (int i = 0; i < 2; ++i) { int R, C; stage_rc(tid * 16 + i * 8192, R, C); const int Rb = Epi::PERM ? ((R & ~31) + perm32(R & 31)) : R;
        voffA[i] = (unsigned)(R * K + C) * 2u; voffB[i] = (unsigned)(Rb * K + C) * 2u; }
    const size_t kstep = (size_t)(BK * 2);
    const size_t hstep = (size_t)HALF * K * 2;
    const size_t tstep = 2 * hstep;
    const unsigned ldsw = (unsigned)wid * 1024u;
    const int aoff = lds_byte(wr * 64 + fr, fq * 8), boff = lds_byte(wc * 32 + fr, fq * 8);
#define PG8_SA(b, h) (((b) * 2 + (h)) * HTB)
#define PG8_SB(b, h) ((4 + (b) * 2 + (h)) * HTB)
#define PG8_STAGE(bufoff, gbase, voff) do { _Pragma("unroll") for (int _i = 0; _i < 2; ++_i) \
        __builtin_amdgcn_global_load_lds((const unsigned*)((const char*)(gbase) + (voff)[_i]), (PG8_LAS unsigned*)(lds + (bufoff) + ldsw + _i * 8192), 16, 0, 0); } while (0)
#define PG8_LDA(dst, b, h) do { _Pragma("unroll") for (int m = 0; m < 4; ++m) _Pragma("unroll") for (int k = 0; k < 2; ++k) dst[m][k] = *(const PG8_LAS bf16x8*)(lds + PG8_SA(b, h) + aoff + m * 2048 + k * 1024); } while (0)
#define PG8_LDB(dst, b, h) do { _Pragma("unroll") for (int n = 0; n < 2; ++n) _Pragma("unroll") for (int k = 0; k < 2; ++k) dst[n][k] = *(const PG8_LAS bf16x8*)(lds + PG8_SB(b, h) + boff + n * 2048 + k * 1024); } while (0)
#define PG8_MMA(ai, bj, At, Bt) do { __builtin_amdgcn_s_setprio(1); _Pragma("unroll") for (int m = 0; m < 4; ++m) _Pragma("unroll") for (int n = 0; n < 2; ++n) _Pragma("unroll") for (int k = 0; k < 2; ++k) \
        acc[ai][bj][m][n] = __builtin_amdgcn_mfma_f32_16x16x32_bf16(Bt[n][k], At[m][k], acc[ai][bj][m][n], 0, 0, 0); __builtin_amdgcn_s_setprio(0); } while (0)
#define PG8_WAIT_V(n) asm volatile("s_waitcnt vmcnt(" #n ")" ::: "memory")
#define PG8_WAIT_L(n) asm volatile("s_waitcnt lgkmcnt(" #n ")" ::: "memory")
#define PG8_BAR __builtin_amdgcn_s_barrier()
#define PG8_SCHED __builtin_amdgcn_sched_barrier(0)
    Unit cur, nxt; int ui = 0;
    if (!S.next(0, cur)) return;
    f32x4 acc[2][2][4][2];
#pragma unroll
    for (int a = 0; a < 2; ++a)
#pragma unroll
        for (int b = 0; b < 2; ++b)
#pragma unroll
            for (int m = 0; m < 4; ++m)
#pragma unroll
                for (int n = 0; n < 2; ++n) acc[a][b][m][n] = (f32x4){0.f, 0.f, 0.f, 0.f};
    bf16x8 At[4][2], B0[2][2], B1[2][2];
    const char* cA = (const char*)g.A + (size_t)cur.pm * tstep; const char* cB = (const char*)g.Bt + (size_t)cur.pn * tstep;
    S.a_ready(cur);
    if constexpr (SP2) {
        PG8_STAGE(PG8_SB(0, 0), cB, voffB); PG8_STAGE(PG8_SB(0, 1), cB + hstep, voffB); PG8_STAGE(PG8_SA(0, 0), cA, voffA); PG8_STAGE(PG8_SA(0, 1), cA + hstep, voffA);
        if (wr == 1) PG8_BAR;
        PG8_WAIT_V(2); PG8_BAR;
        PG8_STAGE(PG8_SB(1, 0), cB + kstep, voffB); PG8_STAGE(PG8_SA(1, 0), cA + kstep, voffA); PG8_STAGE(PG8_SB(1, 1), cB + hstep + kstep, voffB);
        PG8_WAIT_V(6); PG8_BAR;
    } else {
        PG8_STAGE(PG8_SB(0, 0), cB, voffB); PG8_STAGE(PG8_SA(0, 0), cA, voffA); PG8_STAGE(PG8_SB(0, 1), cB + hstep, voffB); PG8_STAGE(PG8_SA(0, 1), cA + hstep, voffA);
        if (wr == 1) PG8_BAR;
        PG8_WAIT_V(4); PG8_BAR;
        PG8_STAGE(PG8_SB(1, 0), cB + kstep, voffB); PG8_STAGE(PG8_SA(1, 0), cA + kstep, voffA); PG8_STAGE(PG8_SB(1, 1), cB + hstep + kstep, voffB);
        PG8_WAIT_V(6); PG8_BAR;
    }
    for (;;) {
        const bool has_next = S.next(ui + 1, nxt);
        const char* nA = has_next ? (const char*)g.A + (size_t)nxt.pm * tstep : cA; const char* nB = has_next ? (const char*)g.Bt + (size_t)nxt.pn * tstep : cB;
        for (int t = 0; t < nt; t += 2) {
            const bool last = (t == nt - 2);
            const char* a1 = cA + (size_t)(t + 1) * kstep;
            const char* a2 = last ? nA : cA + (size_t)(t + 2) * kstep; const char* b2 = last ? nB : cB + (size_t)(t + 2) * kstep;
            const char* a3 = a2 + kstep; const char* b3 = b2 + kstep;
            if (last && has_next) S.a_ready(nxt);
            if constexpr (SP2) {
            PG8_LDB(B0, 0, 0); PG8_LDB(B1, 0, 1); PG8_SCHED; PG8_LDA(At, 0, 0); PG8_STAGE(PG8_SA(1, 1), a1 + hstep, voffA);
            PG8_WAIT_V(8); PG8_WAIT_L(0); PG8_BAR; PG8_MMA(0, 0, At, B0); PG8_MMA(0, 1, At, B1); PG8_BAR; PG8_SCHED;
            PG8_LDA(At, 0, 1); PG8_STAGE(PG8_SB(0, 0), b2, voffB); PG8_STAGE(PG8_SB(0, 1), b2 + hstep, voffB); PG8_STAGE(PG8_SA(0, 0), a2, voffA);
            PG8_WAIT_V(8); PG8_WAIT_L(0); PG8_BAR; PG8_MMA(1, 0, At, B0); PG8_MMA(1, 1, At, B1); PG8_BAR; PG8_SCHED;
            PG8_LDB(B0, 1, 0); PG8_LDB(B1, 1, 1); PG8_SCHED; PG8_LDA(At, 1, 0); PG8_STAGE(PG8_SA(0, 1), a2 + hstep, voffA);
            PG8_WAIT_V(8); PG8_WAIT_L(0); PG8_BAR; PG8_MMA(0, 0, At, B0); PG8_MMA(0, 1, At, B1); PG8_BAR; PG8_SCHED;
            PG8_LDA(At, 1, 1); PG8_STAGE(PG8_SB(1, 0), b3, voffB); PG8_STAGE(PG8_SB(1, 1), b3 + hstep, voffB); PG8_STAGE(PG8_SA(1, 0), a3, voffA);
            PG8_WAIT_V(8); PG8_WAIT_L(0); PG8_BAR; PG8_MMA(1, 0, At, B0); PG8_MMA(1, 1, At, B1); PG8_BAR; PG8_SCHED;
            } else {
            PG8_LDB(B0, 0, 0); PG8_SCHED; PG8_LDA(At, 0, 0); PG8_STAGE(PG8_SA(1, 1), a1 + hstep, voffA);
            PG8_WAIT_L(8); PG8_BAR; PG8_WAIT_L(0); PG8_MMA(0, 0, At, B0); PG8_BAR; PG8_SCHED;
            PG8_LDB(B1, 0, 1); PG8_STAGE(PG8_SB(0, 0), b2, voffB);
            PG8_BAR; PG8_WAIT_L(0); PG8_MMA(0, 1, At, B1); PG8_BAR;
            PG8_LDA(At, 0, 1); PG8_STAGE(PG8_SA(0, 0), a2, voffA);
            PG8_BAR; PG8_WAIT_L(0); PG8_MMA(1, 0, At, B0); PG8_BAR; PG8_SCHED;
            PG8_STAGE(PG8_SB(0, 1), b2 + hstep, voffB);
            PG8_WAIT_V(6); PG8_BAR; PG8_MMA(1, 1, At, B1); PG8_BAR;
            PG8_LDB(B0, 1, 0); PG8_SCHED; PG8_LDA(At, 1, 0); PG8_STAGE(PG8_SA(0, 1), a2 + hstep, voffA);
            PG8_WAIT_L(8); PG8_BAR; PG8_WAIT_L(0); PG8_MMA(0, 0, At, B0); PG8_BAR; PG8_SCHED;
            PG8_LDB(B1, 1, 1); PG8_STAGE(PG8_SB(1, 0), b3, voffB);
            PG8_BAR; PG8_WAIT_L(0); PG8_MMA(0, 1, At, B1); PG8_BAR;
            PG8_LDA(At, 1, 1); PG8_STAGE(PG8_SA(1, 0), a3, voffA);
            PG8_BAR; PG8_WAIT_L(0); PG8_MMA(1, 0, At, B0); PG8_BAR; PG8_SCHED;
            PG8_STAGE(PG8_SB(1, 1), b3 + hstep, voffB);
            PG8_WAIT_V(6); PG8_BAR; PG8_MMA(1, 1, At, B1); PG8_BAR;
            }
        }
        if constexpr (ALIGN_EPI) { if (wr == 0) PG8_BAR; }
        if constexpr (!Epi::AFTER_DRAIN) { E(acc, cur, wr, wc, fr, fq); S.done(cur); }
        if (!has_next) break;
#pragma unroll
        for (int a = 0; a < 2; ++a)
#pragma unroll
            for (int b = 0; b < 2; ++b)
#pragma unroll
                for (int m = 0; m < 4; ++m)
#pragma unroll
                    for (int n = 0; n < 2; ++n) acc[a][b][m][n] = (f32x4){0.f, 0.f, 0.f, 0.f};
        cur = nxt; cA = nA; cB = nB; ++ui;
        if constexpr (ALIGN_EPI) { if (wr == 1) PG8_BAR; }
    }
    PG8_WAIT_V(0);
    if constexpr (!ALIGN_EPI) { if (wr == 0) PG8_BAR; }
    PG8_BAR;
    if constexpr (Epi::AFTER_DRAIN) { E.fused(acc, cur, wr, wc, fr, fq, lds, wid, lane); S.done(cur); }
#undef PG8_SA
#undef PG8_SB
#undef PG8_STAGE
#undef PG8_LDA
#undef PG8_LDB
#undef PG8_MMA
#undef PG8_WAIT_V
#undef PG8_WAIT_L
#undef PG8_BAR
#undef PG8_SCHED
}
}
#define XB_TMO      128
#define XB_XCNT(j)  (256  + 64 * (j))
#define XB_XSUB(j)  (1280 + 64 * (j))
#define XB_XGEN(j)  (2304 + 64 * (j))
#define XB_TOP      3328
#define XB_TOPGEN   3392
#define XCD_BAR_WORDS 3456
#define XB_SPIN_CAP (1u << 18)
#define LAS __attribute__((address_space(3)))

__device__ __forceinline__ unsigned xb_ld(unsigned* p)              { return __hip_atomic_load(p, __ATOMIC_RELAXED, __HIP_MEMORY_SCOPE_AGENT); }
__device__ __forceinline__ unsigned xb_add(unsigned* p, unsigned v) { return __hip_atomic_fetch_add(p, v, __ATOMIC_RELAXED, __HIP_MEMORY_SCOPE_AGENT); }
__device__ __forceinline__ unsigned xb_xcc_id() { return (unsigned)__builtin_amdgcn_s_getreg((3 << 11) | 20) & 0xFu; }
#define XB_SPIN(cond, bar) do { unsigned _sp = 0; while (cond) { __builtin_amdgcn_s_sleep(1); \
    if ((++_sp & 255u) == 0u) { if (xb_ld(&(bar)[XB_TMO])) break; if (_sp > XB_SPIN_CAP) { atomicAdd(&(bar)[XB_TMO], 1u); break; } } } } while (0)

struct XcdBarrier {
    unsigned* bar; unsigned x;
    volatile LAS unsigned* st;
};

__device__ __forceinline__ XcdBarrier xcd_barrier_post(unsigned* bar, volatile LAS unsigned* st) {
    XcdBarrier b; b.bar = bar; b.x = xb_xcc_id(); b.st = st;
    if (threadIdx.x == 0) (void)xb_add(&bar[XB_XCNT(b.x)], 1u);
    return b;
}
__device__ __forceinline__ void xcd_barrier_complete(unsigned* bar, unsigned x, unsigned& nloc, unsigned& nx) {
    const unsigned G = gridDim.x * gridDim.y * gridDim.z;
    unsigned sum, cnt, mine, sp = 0u;
    for (;;) {
        sum = 0u; cnt = 0u; mine = 0u;
#pragma unroll
        for (unsigned j = 0; j < 16; ++j) { const unsigned c = xb_ld(&bar[XB_XCNT(j)]); sum += c; cnt += (c > 0u) ? 1u : 0u; mine = (j == x) ? c : mine; }
        if (sum == G) break;
        __builtin_amdgcn_s_sleep(1);
        if ((++sp & 255u) == 0u) { if (xb_ld(&bar[XB_TMO])) break; if (sp > XB_SPIN_CAP) { atomicAdd(&bar[XB_TMO], 1u); break; } }
    }
    nloc = mine > 0u ? mine : 1u; nx = cnt > 0u ? cnt : 1u;
}

__device__ __forceinline__ void xcd_barrier(const XcdBarrier& b) {
    asm volatile("s_waitcnt vmcnt(0)" ::: "memory");
    __syncthreads();
    if (threadIdx.x == 0) {
        unsigned* bar = b.bar;
        __builtin_amdgcn_s_waitcnt(0);
        const unsigned bx = xb_xcc_id();
        unsigned nloc = b.st[0], nx = b.st[1];
        if (nloc == 0u) { xcd_barrier_complete(bar, bx, nloc, nx); b.st[0] = nloc; b.st[1] = nx; }
        const unsigned old = xb_add(&bar[XB_XSUB(bx)], 1u);
        const unsigned gen = old / nloc;
        if (old + 1u == (gen + 1u) * nloc) {
            __builtin_amdgcn_fence(__ATOMIC_RELEASE, "agent");
            asm volatile("s_waitcnt vmcnt(0)" ::: "memory");
            const unsigned og = xb_add(&bar[XB_TOP], 1u);
            const unsigned tg = og / nx;
            if (og + 1u == (tg + 1u) * nx) xb_add(&bar[XB_TOPGEN], 1u);
            else XB_SPIN(xb_ld(&bar[XB_TOPGEN]) == tg, bar);
            __builtin_amdgcn_fence(__ATOMIC_ACQUIRE, "agent");
            xb_add(&bar[XB_XGEN(bx)], 1u);
            asm volatile("s_waitcnt vmcnt(0)" ::: "memory");
        } else {
            XB_SPIN(xb_ld(&bar[XB_XGEN(bx)]) == gen, bar);
            __builtin_amdgcn_fence(__ATOMIC_ACQUIRE, "agent");
            asm volatile("s_waitcnt vmcnt(0)" ::: "memory");
        }
    }
    __syncthreads();
}

struct Params {
    const float* x; const float* p; const int* pos;
    const float *w_in, *w_a, *w_b, *w_out, *lbraw, *hnorm_g, *ikn_g, *ikn_b, *lnm_g, *lnm_b, *w_fg, *w_fu, *w_fd, *lnf_g, *lnf_b, *w_pg, *w_pp, *lnp_g, *lnp_b;
    float* out; unsigned char* ws;
    double invf_h[64]; double invf_i[32];
    int ph_lo, ph_hi;
};
typedef const __attribute__((address_space(4))) Params* KP;
__device__ __forceinline__ KP kparams() { KP p = (KP)__builtin_amdgcn_kernarg_segment_ptr(); asm volatile("" : "+s"(p)); return p; }
constexpr int NPH_LAYER = 14, NPH = DEPTH * NPH_LAYER;
constexpr int LDS_BYTES = 131072 + 1024;
constexpr int MISC_OFF = 131072;

__device__ __forceinline__ int wsrc_col_in(int n) {
    const int tile = n >> 8, t = n & 255;
    if (tile < 16) return n;
    if (tile < 24) { const int bj = t >> 7, u = t & 127, head = u >> 6, i = u & 63; return tile * 256 + 128 * head + 64 * bj + i; }
    if (tile < 28) return n;
    if (tile < 32) { const int bj = t >> 7, u = t & 127, head = u >> 5, i = u & 31; return tile * 256 + 64 * head + 32 * bj + i; }
    if (tile < 40) return 8272 + (n - 32 * 256);
    if (tile < 48) return 10320 + (n - 40 * 256);
    return t < 80 ? 8192 + t : -1;
}
constexpr int WC_LD = 144;
template <int KIND>
__device__ __forceinline__ void wconv_wave_tile(const float* src, const float* src2, int nsrc, int K, bf16_t* dst, int n0, int k0, int lane, LAS unsigned char* img) {
    const int n = n0 + lane; int c; const float* s = src;
    if (KIND == 0) c = n;
    else if (KIND == 1) c = wsrc_col_in(n);
    else { const int tl = n >> 8, t = n & 255; c = tl * 128 + (t & 127); if (t >= 128) s = src2; }
    float f[64];
    const float* sp = s + (size_t)k0 * nsrc + (c >= 0 ? c : 0);
#pragma unroll
    for (int kk = 0; kk < 64; ++kk) f[kk] = sp[(size_t)kk * nsrc];
#pragma unroll
    for (int i = 0; i < 8; ++i) { pg8::u32x4 w;
        w.x = pg8::cvt_pk_bf16(f[8 * i], f[8 * i + 1]); w.y = pg8::cvt_pk_bf16(f[8 * i + 2], f[8 * i + 3]); w.z = pg8::cvt_pk_bf16(f[8 * i + 4], f[8 * i + 5]); w.w = pg8::cvt_pk_bf16(f[8 * i + 6], f[8 * i + 7]);
        if (c < 0) w = (pg8::u32x4){0u, 0u, 0u, 0u};
        *(LAS pg8::u32x4*)(img + lane * WC_LD + 16 * i) = w; }
#pragma unroll
    for (int i = 0; i < 8; ++i) { const int p = lane + 64 * i, row = p >> 3, seg = p & 7;
        const pg8::u32x4 w = *(const LAS pg8::u32x4*)(img + row * WC_LD + 16 * seg);
        *(pg8::u32x4*)(dst + (size_t)(n0 + row) * K + k0 + 8 * seg) = w; }
}
template <int KIND>
__device__ __forceinline__ void wconv_job(const float* src, const float* src2, int nsrc, int K, bf16_t* dst, int ndst, int W, int NWV, int lane, LAS unsigned char* img, int& tcount) {
    const int kt = K / 64, ntiles = (ndst / 64) * kt;
    const int nb = ndst / 64; int first = (W - tcount % NWV + NWV) % NWV;
    for (int t = first; t < ntiles; t += NWV) wconv_wave_tile<KIND>(src, src2, nsrc, K, dst, (t % nb) * 64, (t / nb) * 64, lane, img);
    tcount += ntiles;
}
__device__ __forceinline__ void phase_wconv(KP P, int layer, LAS unsigned char* lds) {
    unsigned char* ws = as_global(P->ws); int tc = 0;
    const int tid0 = tid_(), lane = tid0 & 63, wv0 = __builtin_amdgcn_readfirstlane(tid0 >> 6), W = bid_() * 8 + wv0, NWV = nblk_() * 8;
    LAS unsigned char* img = lds + wv0 * (64 * WC_LD);
    wconv_job<1>(as_global(P->w_in) + (size_t)layer * DM * INW, nullptr, INW, DM, (bf16_t*)(ws + WS_WIN), INP, W, NWV, lane, img, tc);
    wconv_job<0>(as_global(P->w_a) + (size_t)layer * AW * DM, nullptr, DM, AW, (bf16_t*)(ws + WS_WA), DM, W, NWV, lane, img, tc);
    wconv_job<0>(as_global(P->w_b) + (size_t)layer * BW * DM, nullptr, DM, BW, (bf16_t*)(ws + WS_WB), DM, W, NWV, lane, img, tc);
    wconv_job<0>(as_global(P->w_out) + (size_t)layer * DM * DM, nullptr, DM, DM, (bf16_t*)(ws + WS_WO), DM, W, NWV, lane, img, tc);
    wconv_job<2>(as_global(P->w_fg) + (size_t)layer * DM * DFF, as_global(P->w_fu) + (size_t)layer * DM * DFF, DFF, DM, (bf16_t*)(ws + WS_WGU), 2 * DFF, W, NWV, lane, img, tc);
    wconv_job<0>(as_global(P->w_fd) + (size_t)layer * DFF * DM, nullptr, DM, DFF, (bf16_t*)(ws + WS_WDN), DM, W, NWV, lane, img, tc);
    wconv_job<0>(as_global(P->w_pg) + (size_t)layer * DM * DM, nullptr, DM, DM, (bf16_t*)(ws + WS_WPG), DM, W, NWV, lane, img, tc);
    wconv_job<0>(as_global(P->w_pp) + (size_t)layer * PLE * DM, nullptr, DM, PLE, (bf16_t*)(ws + WS_WPP), DM, W, NWV, lane, img, tc);
    const float* ps = as_global(P->p) + (size_t)layer * TOK * PLE; bf16_t* pb = (bf16_t*)(ws + WS_PB);
    for (size_t i = ((size_t)bid_() * 512 + tid_()) * 8; i < (size_t)TOK * PLE; i += (size_t)nblk_() * 512 * 8)
        *(pg8::u32x4*)(pb + i) = pg8::pack8(*(const pg8::f32x4*)(ps + i), *(const pg8::f32x4*)(ps + i + 4));
}
__device__ __forceinline__ void phase_prologue(KP P) {
    unsigned char* ws = as_global(P->ws); const size_t gtid = (size_t)bid_() * 512 + tid_(), gsz = (size_t)nblk_() * 512;
    bf16_t* xb = (bf16_t*)(ws + WS_XB); const float* xin = as_global(P->x); const int* posg = as_global(P->pos); const float* lbr = as_global(P->lbraw);
    for (size_t i = gtid * 8; i < (size_t)TOK * DM; i += gsz * 8) *(pg8::u32x4*)(xb + i) = pg8::pack8(*(const pg8::f32x4*)(xin + i), *(const pg8::f32x4*)(xin + i + 4));
    float* ch = (float*)(ws + WS_COSH); float* sh = (float*)(ws + WS_SINH); float* ci = (float*)(ws + WS_COSI); float* si = (float*)(ws + WS_SINI);
    for (size_t i = gtid; i < (size_t)TOK * 64; i += gsz) { const int t = (int)(i >> 6), j = (int)(i & 63); const double rev = (double)posg[t] * P->invf_h[j]; const float fr = (float)(rev - rint(rev));
        ch[i] = __builtin_amdgcn_cosf(fr); sh[i] = __builtin_amdgcn_sinf(fr); }
    for (size_t i = gtid; i < (size_t)TOK * 32; i += gsz) { const int t = (int)(i >> 5), j = (int)(i & 31); const double rev = (double)posg[t] * P->invf_i[j]; const float fr = (float)(rev - rint(rev));
        ci[i] = __builtin_amdgcn_cosf(fr); si[i] = __builtin_amdgcn_sinf(fr); }
    float* lb = (float*)(ws + WS_LB);
    for (size_t c = gtid; c < 1024; c += gsz) { float v[4], mx = -1e30f; for (int l = 0; l < 4; ++l) { v[l] = lbr[l * 1024 + c]; mx = fmaxf(mx, v[l]); }
        float s = 0.f; for (int l = 0; l < 4; ++l) { v[l] = expf(v[l] - mx); s += v[l]; }
        float cum = 0.f; const float inv = 1.0f / s; for (int l = 0; l < 4; ++l) { cum += v[l] * inv; lb[l * 1024 + c] = cum - v[0] * inv; } }
}
__device__ __forceinline__ void phase_ln(const float* XP, float* OUT, bf16_t* XB, float* ST, const float* g, const float* b) {
    const int tid = tid_(), wave = __builtin_amdgcn_readfirstlane(tid >> 6), lane = tid & 63, nb16 = nblk_() * 16;
    for (int row0 = bid_() * 16 + 2 * wave; row0 < TOK; row0 += nb16) {
        pg8::f32x4 v[2][8]; float s[2] = {0.f, 0.f};
#pragma unroll
        for (int rr = 0; rr < 2; ++rr)
#pragma unroll
            for (int c = 0; c < 8; ++c) v[rr][c] = *(const pg8::f32x4*)(XP + (size_t)(row0 + rr) * DM + c * 256 + lane * 4);
#pragma unroll
        for (int rr = 0; rr < 2; ++rr) {
#pragma unroll
            for (int c = 0; c < 8; ++c) s[rr] += (v[rr][c][0] + v[rr][c][1]) + (v[rr][c][2] + v[rr][c][3]);
#pragma unroll
            for (int o = 32; o >= 1; o >>= 1) s[rr] += __shfl_xor(s[rr], o); }
#pragma unroll
        for (int rr = 0; rr < 2; ++rr) { const int row = row0 + rr;
            const float mean = s[rr] * (1.0f / DM); float q = 0.f;
#pragma unroll
            for (int c = 0; c < 8; ++c) { v[rr][c] = v[rr][c] - mean; q += (v[rr][c][0] * v[rr][c][0] + v[rr][c][1] * v[rr][c][1]) + (v[rr][c][2] * v[rr][c][2] + v[rr][c][3] * v[rr][c][3]); }
#pragma unroll
            for (int o = 32; o >= 1; o >>= 1) q += __shfl_xor(q, o);
            const float rstd = 1.0f / sqrtf(q * (1.0f / DM) + LN_EPS);
            if (lane == 0) { pg8::f32x2 s2; s2[0] = mean; s2[1] = rstd; *(pg8::f32x2*)(ST + 2 * (size_t)row) = s2; }
#pragma unroll
            for (int c = 0; c < 8; ++c) { const int col = c * 256 + lane * 4; const pg8::f32x4 gg = *(const pg8::f32x4*)(g + col), bb = *(const pg8::f32x4*)(b + col);
                const pg8::f32x4 y = v[rr][c] * rstd * gg + bb; if (OUT) *(pg8::f32x4*)(OUT + (size_t)row * DM + col) = y;
                pg8::u32x2 w; w.x = pg8::cvt_pk_bf16(y[0], y[1]); w.y = pg8::cvt_pk_bf16(y[2], y[3]); *(pg8::u32x2*)(XB + (size_t)row * DM + col) = w; } }
    }
}
__device__ __forceinline__ void phase_ikprep(KP P, int layer) {
    unsigned char* ws = as_global(P->ws); const float* ikw = (const float*)(ws + WS_IKW); bf16_t* ki = (bf16_t*)(ws + WS_KI); float* wi = (float*)(ws + WS_WI);
    const float* ci = (const float*)(ws + WS_COSI); const float* si = (const float*)(ws + WS_SINI);
    const int tid = tid_(), wave = __builtin_amdgcn_readfirstlane(tid >> 6), lane = tid & 63, nb8 = nblk_() * 8;
    const float g = as_global(P->ikn_g)[layer * 64 + lane], b = as_global(P->ikn_b)[layer * 64 + lane];
    for (int t = bid_() * 8 + wave; t < TOK; t += nb8) {
        const float x = ikw[(size_t)t * 128 + lane]; float s = x;
#pragma unroll
        for (int o = 32; o >= 1; o >>= 1) s += __shfl_xor(s, o);
        const float mean = s * (1.0f / 64.0f), xc = x - mean; float q = xc * xc;
#pragma unroll
        for (int o = 32; o >= 1; o >>= 1) q += __shfl_xor(q, o);
        const float y = xc * (1.0f / sqrtf(q * (1.0f / 64.0f) + LN_EPS)) * g + b;
        const float other = __shfl_xor(y, 32); const int j = lane & 31; const float c = ci[(size_t)t * 32 + j], sn = si[(size_t)t * 32 + j];
        const float r = (lane < 32) ? (y * c - other * sn) : (other * sn + y * c);
        ki[(size_t)t * 64 + lane] = f2bf(r);
        if (lane < 16) wi[(size_t)t * 16 + lane] = ikw[(size_t)t * 128 + 64 + lane] * IDX_SCALE;
    }
}
typedef short bf16x8_t __attribute__((ext_vector_type(8)));
typedef short bf16x4_t __attribute__((ext_vector_type(4)));
typedef float f32x16_t __attribute__((ext_vector_type(16)));
constexpr int CUM_LD = 132;
constexpr int OPK_LD = 136;
constexpr int OPS_LD = 72;

__device__ __forceinline__ void hgrn_scan_load(const float* LF, int tok0, int h, int tid, float (&v)[16]) {
    const int k = tid & 127, qd = tid >> 7;
#pragma unroll
    for (int i = 0; i < 16; ++i) v[i] = LF[(size_t)(tok0 + qd * 16 + i) * 1024 + h * 128 + k];
}
__device__ __forceinline__ void hgrn_scan_cum(float (&v)[16], LAS float* cum, LAS float* tot, int tid) {
    const int k = tid & 127, qd = tid >> 7;
    float run = 0.f;
#pragma unroll
    for (int i = 0; i < 16; ++i) { run += v[i]; v[i] = run; }
    tot[qd * 128 + k] = run;
    __syncthreads();
    float off = 0.f;
#pragma unroll
    for (int q = 0; q < 3; ++q) off += (q < qd) ? tot[q * 128 + k] : 0.f;
#pragma unroll
    for (int i = 0; i < 16; ++i) cum[(qd * 16 + i) * CUM_LD + k] = v[i] + off;
    __syncthreads();
}

struct H1Pre { float lf[16]; unsigned ka[8], va[8]; };
__device__ __forceinline__ void h1_load(const bf16_t* KA, const bf16_t* VA, const float* LF, int unit, int tid, H1Pre& p) {
    const int c = unit & 63, h = (unit >> 6) & 7, b = unit >> 9, tok0 = b * SEQ + c * 64;
    hgrn_scan_load(LF, tok0, h, tid, p.lf);
#pragma unroll
    for (int it = 0; it < 8; ++it) { const int idx = tid + 512 * it, k = idx & 127, s = 2 * (idx >> 7); const size_t g0 = (size_t)(tok0 + s) * 1024 + h * 128 + k;
        p.ka[it] = (unsigned)KA[g0] | ((unsigned)KA[g0 + 1024] << 16); p.va[it] = (unsigned)VA[g0] | ((unsigned)VA[g0 + 1024] << 16); }
}
__device__ __forceinline__ void phase_hgrn_h1(KP P, LAS unsigned char* lds) {
    unsigned char* ws = as_global(P->ws);
    const bf16_t* KA = (const bf16_t*)(ws + WS_KA); const bf16_t* VA = (const bf16_t*)(ws + WS_VA); const float* LF = (const float*)(ws + WS_LF);
    bf16_t* LT = (bf16_t*)(ws + WS_LT); float* DEC = (float*)(ws + WS_DEC);
    const int tid = tid_(), lane = tid & 63, wave = __builtin_amdgcn_readfirstlane(tid >> 6), r = lane & 31, hh = lane >> 5, G = nblk_();
    LAS float* cum = (LAS float*)lds; LAS float* tot = cum + 64 * CUM_LD;
    LAS bf16_t* kdT = (LAS bf16_t*)(tot + 512); LAS bf16_t* vT = kdT + 128 * OPS_LD;
    constexpr int NU = NBATCH * AH * 64;
    H1Pre pre; int unit = bid_();
    if (unit < NU) h1_load(KA, VA, LF, unit, tid, pre);
    for (; unit < NU; unit += G) {
        hgrn_scan_cum(pre.lf, cum, tot, tid);
#pragma unroll
        for (int it = 0; it < 8; ++it) { const int idx = tid + 512 * it, k = idx & 127, sp = idx >> 7, s = 2 * sp;
            const float last = cum[63 * CUM_LD + k];
            const float k0 = __uint_as_float(pre.ka[it] << 16) * __expf(last - cum[s * CUM_LD + k]), k1 = __uint_as_float(pre.ka[it] & 0xffff0000u) * __expf(last - cum[(s + 1) * CUM_LD + k]);
            *(LAS unsigned*)(kdT + k * OPS_LD + s) = pg8::cvt_pk_bf16(k0, k1);
            *(LAS unsigned*)(vT + k * OPS_LD + s) = pre.va[it]; }
        if (tid < 128) DEC[(size_t)unit * 128 + tid] = __expf(cum[63 * CUM_LD + tid]);
        if (unit + G < NU) h1_load(KA, VA, LF, unit + G, tid, pre);
        __syncthreads();
        const int mb = wave >> 1, nb0 = (wave & 1) * 2;
        f32x16_t acc[2];
#pragma unroll
        for (int n = 0; n < 2; ++n)
#pragma unroll
            for (int i = 0; i < 16; ++i) acc[n][i] = 0.f;
#pragma unroll
        for (int ks = 0; ks < 4; ++ks) { const bf16x8_t a = *(const LAS bf16x8_t*)(kdT + (32 * mb + r) * OPS_LD + 16 * ks + 8 * hh);
#pragma unroll
            for (int n = 0; n < 2; ++n) { const bf16x8_t bb = *(const LAS bf16x8_t*)(vT + (32 * (nb0 + n) + r) * OPS_LD + 16 * ks + 8 * hh);
                acc[n] = __builtin_amdgcn_mfma_f32_32x32x16_bf16(a, bb, acc[n], 0, 0, 0); } }
#pragma unroll
        for (int n = 0; n < 2; ++n) { bf16_t* dst = LT + (size_t)unit * 16384 + (size_t)(32 * (nb0 + n) + r) * 128 + 32 * mb + 4 * hh;
#pragma unroll
            for (int g = 0; g < 4; ++g) { pg8::u32x2 o; o.x = pg8::cvt_pk_bf16(acc[n][4 * g], acc[n][4 * g + 1]); o.y = pg8::cvt_pk_bf16(acc[n][4 * g + 2], acc[n][4 * g + 3]); *(pg8::u32x2*)(dst + 8 * g) = o; } }
        __syncthreads();
    }
}

__device__ __forceinline__ void phase_hgrn_h2(KP P) {
    unsigned char* ws = as_global(P->ws);
    const bf16_t* LT = (const bf16_t*)(ws + WS_LT); const float* DEC = (const float*)(ws + WS_DEC); bf16_t* PT = (bf16_t*)(ws + WS_PT);
    const int tid = tid_(), G = nblk_();
    for (int oct = bid_() * 512 + tid; oct < NBATCH * AH * 2048; oct += G * 512) {
        const int bh = oct >> 11, rem = oct & 2047, v = rem >> 4, k0 = (rem & 15) * 8;
        const size_t e0 = (size_t)bh * 64 * 16384 + (size_t)v * 128 + k0; const size_t d0 = (size_t)bh * 64 * 128 + k0;
        pg8::f32x4 S0 = {0.f, 0.f, 0.f, 0.f}, S1 = {0.f, 0.f, 0.f, 0.f};
        for (int c0 = 0; c0 < 64; c0 += 4) { pg8::u32x4 Lc[4]; pg8::f32x4 Da[4], Db[4];
#pragma unroll
            for (int j = 0; j < 4; ++j) { Lc[j] = *(const pg8::u32x4*)(LT + e0 + (size_t)(c0 + j) * 16384); Da[j] = *(const pg8::f32x4*)(DEC + d0 + (size_t)(c0 + j) * 128); Db[j] = *(const pg8::f32x4*)(DEC + d0 + (size_t)(c0 + j) * 128 + 4); }
#pragma unroll
            for (int j = 0; j < 4; ++j) { *(pg8::u32x4*)(PT + e0 + (size_t)(c0 + j) * 16384) = pg8::pack8(S0, S1);
                pg8::f32x4 l0, l1; pg8::unpack8(Lc[j], l0, l1); S0 = Da[j] * S0 + l0; S1 = Db[j] * S1 + l1; } }
    }
}

struct H3Pre { float lf[16]; unsigned qw[8], kw[8], vv[8]; bf16x8_t pt[8]; pg8::u32x2 ga[4]; };
__device__ __forceinline__ void h3_load(const bf16_t* QA, const bf16_t* KA, const bf16_t* VA, const bf16_t* GA, const float* LF, const bf16_t* PT, int unit, int tid, H3Pre& p) {
    const int c = unit & 63, h = (unit >> 6) & 7, b = unit >> 9, tok0 = b * SEQ + c * 64;
    const int lane = tid & 63, wave = __builtin_amdgcn_readfirstlane(tid >> 6), r = lane & 31, hh = lane >> 5, mb = wave >> 1, tb = wave & 1;
    hgrn_scan_load(LF, tok0, h, tid, p.lf);
#pragma unroll
    for (int it = 0; it < 8; ++it) { const int idx = tid + 512 * it, kp = (idx & 63) * 2, t = idx >> 6; const size_t g0 = (size_t)(tok0 + t) * 1024 + h * 128 + kp;
        p.qw[it] = *(const unsigned*)(QA + g0); p.kw[it] = *(const unsigned*)(KA + g0); }
#pragma unroll
    for (int it = 0; it < 8; ++it) { const int idx = tid + 512 * it, v = idx & 127, s = 2 * (idx >> 7); const size_t g0 = (size_t)(tok0 + s) * 1024 + h * 128 + v;
        p.vv[it] = (unsigned)VA[g0] | ((unsigned)VA[g0 + 1024] << 16); }
    const bf16_t* prow = PT + (size_t)unit * 16384 + (size_t)(32 * mb + r) * 128 + 8 * hh;
#pragma unroll
    for (int k8 = 0; k8 < 8; ++k8) p.pt[k8] = *(const bf16x8_t*)(prow + 16 * k8);
    const size_t orow = (size_t)(tok0 + 32 * tb + r) * 1024 + h * 128;
#pragma unroll
    for (int g = 0; g < 4; ++g) p.ga[g] = *(const pg8::u32x2*)(GA + orow + 32 * mb + 8 * g + 4 * hh);
}
__device__ __forceinline__ void phase_hgrn_h3(KP P, int layer, LAS unsigned char* lds) {
    unsigned char* ws = as_global(P->ws);
    const bf16_t* QA = (const bf16_t*)(ws + WS_QA); const bf16_t* KA = (const bf16_t*)(ws + WS_KA); const bf16_t* VA = (const bf16_t*)(ws + WS_VA); const bf16_t* GA = (const bf16_t*)(ws + WS_GA);
    const float* LF = (const float*)(ws + WS_LF); const bf16_t* PT = (const bf16_t*)(ws + WS_PT); bf16_t* YA = (bf16_t*)(ws + WS_YA);
    const float* ng = as_global(P->hnorm_g) + layer * 128;
    const int tid = tid_(), lane = tid & 63, wave = __builtin_amdgcn_readfirstlane(tid >> 6), r = lane & 31, hh = lane >> 5, G = nblk_();
    LAS float* cum = (LAS float*)lds; LAS float* tot = cum + 64 * CUM_LD; LAS float* ssq = tot + 512;
    LAS bf16_t* qd = (LAS bf16_t*)(ssq + 256); LAS bf16_t* qs = qd + 64 * OPK_LD; LAS bf16_t* ks = qs + 64 * OPK_LD; LAS bf16_t* vT = ks + 64 * OPK_LD;
    constexpr int NU = NBATCH * AH * 64;
    const int mb = wave >> 1, tb = wave & 1;
    H3Pre pre; int unit = bid_();
    if (unit < NU) h3_load(QA, KA, VA, GA, LF, PT, unit, tid, pre);
    for (; unit < NU; unit += G) {
        const int c = unit & 63, h = (unit >> 6) & 7, b = unit >> 9, tok0 = b * SEQ + c * 64;
#ifdef H3_DUP_SCAN
        { float tmp[16];
#pragma unroll
          for (int i = 0; i < 16; ++i) tmp[i] = pre.lf[i];
          hgrn_scan_cum(tmp, cum, tot, tid); }
#endif
        hgrn_scan_cum(pre.lf, cum, tot, tid);
#ifdef H3_DUP_BUILD
        for (int rep_b = 0; rep_b < 2; ++rep_b) {
#else
        {
#endif
#pragma unroll
        for (int it = 0; it < 8; ++it) { const int idx = tid + 512 * it, kp = (idx & 63) * 2, t = idx >> 6;
            const unsigned qw = pre.qw[it], kw = pre.kw[it];
            const float c0 = cum[t * CUM_LD + kp], c1 = cum[t * CUM_LD + kp + 1], r0 = cum[31 * CUM_LD + kp], r1 = cum[31 * CUM_LD + kp + 1];
            const float q0 = __uint_as_float(qw << 16), q1 = __uint_as_float(qw & 0xffff0000u), k0 = __uint_as_float(kw << 16), k1 = __uint_as_float(kw & 0xffff0000u);
            *(LAS unsigned*)(qd + t * OPK_LD + kp) = pg8::cvt_pk_bf16(q0 * __expf(c0), q1 * __expf(c1));
            *(LAS unsigned*)(qs + t * OPK_LD + kp) = pg8::cvt_pk_bf16(q0 * __expf(c0 - r0), q1 * __expf(c1 - r1));
            *(LAS unsigned*)(ks + t * OPK_LD + kp) = pg8::cvt_pk_bf16(k0 * __expf(r0 - c0), k1 * __expf(r1 - c1)); }
#pragma unroll
        for (int it = 0; it < 8; ++it) { const int idx = tid + 512 * it, v = idx & 127, s = 2 * (idx >> 7); *(LAS unsigned*)(vT + v * OPS_LD + s) = pre.vv[it]; }
        }
        bf16x8_t ptc[8]; pg8::u32x2 gac[4];
#pragma unroll
        for (int k8 = 0; k8 < 8; ++k8) ptc[k8] = pre.pt[k8];
#pragma unroll
        for (int g = 0; g < 4; ++g) gac[g] = pre.ga[g];
        if (unit + G < NU) h3_load(QA, KA, VA, GA, LF, PT, unit + G, tid, pre);
        __syncthreads();
        f32x16_t acc;
#ifdef H3_DUP_MMA
        for (int rep_m = 0; rep_m < 2; ++rep_m) {
#else
        {
#endif
#pragma unroll
        for (int i = 0; i < 16; ++i) acc[i] = 0.f;
#pragma unroll
        for (int k8 = 0; k8 < 8; ++k8) { const bf16x8_t bq = *(const LAS bf16x8_t*)(qd + (32 * tb + r) * OPK_LD + 16 * k8 + 8 * hh);
            acc = __builtin_amdgcn_mfma_f32_32x32x16_bf16(ptc[k8], bq, acc, 0, 0, 0); }
#pragma unroll
        for (int sb = 0; sb < 2; ++sb) if (sb <= tb) {
            f32x16_t sc;
#pragma unroll
            for (int i = 0; i < 16; ++i) sc[i] = 0.f;
#pragma unroll
            for (int k8 = 0; k8 < 8; ++k8) { const bf16x8_t a = *(const LAS bf16x8_t*)(ks + (32 * sb + r) * OPK_LD + 16 * k8 + 8 * hh); const bf16x8_t bq = *(const LAS bf16x8_t*)(qs + (32 * tb + r) * OPK_LD + 16 * k8 + 8 * hh);
                sc = __builtin_amdgcn_mfma_f32_32x32x16_bf16(a, bq, sc, 0, 0, 0); }
            if (sb == tb) {
#pragma unroll
                for (int i = 0; i < 16; ++i) { const int sl = 8 * (i >> 2) + 4 * hh + (i & 3); sc[i] = (sl <= r) ? sc[i] : 0.f; } }
#pragma unroll
            for (int u = 0; u < 2; ++u) {
                pg8::u32x4 pw; pw.x = pg8::cvt_pk_bf16(sc[8 * u], sc[8 * u + 1]); pw.y = pg8::cvt_pk_bf16(sc[8 * u + 2], sc[8 * u + 3]); pw.z = pg8::cvt_pk_bf16(sc[8 * u + 4], sc[8 * u + 5]); pw.w = pg8::cvt_pk_bf16(sc[8 * u + 6], sc[8 * u + 7]);
                const bf16x8_t pb = __builtin_bit_cast(bf16x8_t, pw);
                const LAS bf16_t* vrow = vT + (32 * mb + r) * OPS_LD + 32 * sb + 16 * u + 4 * hh;
                const bf16x4_t lo = *(const LAS bf16x4_t*)vrow, hi4 = *(const LAS bf16x4_t*)(vrow + 8);
                const bf16x8_t va = {lo[0], lo[1], lo[2], lo[3], hi4[0], hi4[1], hi4[2], hi4[3]};
                acc = __builtin_amdgcn_mfma_f32_32x32x16_bf16(va, pb, acc, 0, 0, 0); }
        }
        }
        float ss = 0.f;
#pragma unroll
        for (int i = 0; i < 16; ++i) ss += acc[i] * acc[i];
        ss += __shfl_xor(ss, 32);
        if (hh == 0) ssq[mb * 64 + 32 * tb + r] = ss;
        __syncthreads();
        const int t = 32 * tb + r;
        const float tot2 = (ssq[t] + ssq[64 + t]) + (ssq[128 + t] + ssq[192 + t]);
        const float rs = 1.0f / sqrtf(tot2 * (1.0f / 128.0f) + RMS_EPS);
        const size_t orow = (size_t)(tok0 + t) * 1024 + h * 128;
#pragma unroll
        for (int g = 0; g < 4; ++g) { const int v0 = 32 * mb + 8 * g + 4 * hh;
            const pg8::u32x2 gw = gac[g]; const pg8::f32x4 nv = *(const pg8::f32x4*)(ng + v0);
            const float y0 = acc[4 * g] * rs * nv[0] * __uint_as_float(gw.x << 16), y1 = acc[4 * g + 1] * rs * nv[1] * __uint_as_float(gw.x & 0xffff0000u);
            const float y2 = acc[4 * g + 2] * rs * nv[2] * __uint_as_float(gw.y << 16), y3 = acc[4 * g + 3] * rs * nv[3] * __uint_as_float(gw.y & 0xffff0000u);
            pg8::u32x2 w; w.x = pg8::cvt_pk_bf16(y0, y1); w.y = pg8::cvt_pk_bf16(y2, y3); *(pg8::u32x2*)(YA + orow + v0) = w; }
        __syncthreads();
    }
}
namespace at {
constexpr int D = 128, NW = 8, QBLK = 32, KVBLK = 64, LDQ = 1024, LDK = 1024;
constexpr float SCALE = ATTN_SCALE, THR = 8.f;
constexpr size_t SHM_V = KVBLK * D * 2, SHM_K = KVBLK * D * 2, SHM_ATTN = 2 * SHM_V + 2 * SHM_K + NW * 64 * 4;
using bf16x8 = __attribute__((ext_vector_type(8))) short;
using s16x4  = __attribute__((ext_vector_type(4))) short;
using f32x16 = __attribute__((ext_vector_type(16))) float;
using u32x4  = __attribute__((ext_vector_type(4))) unsigned;
#define AT_KSWZ(row, colB) ((row) * 256 + ((colB) ^ (((row) & 7) << 4)))
#define AT_SBAR() __builtin_amdgcn_sched_barrier(0)
__device__ __forceinline__ int crow(int r, int hi) { return (r & 3) + 8 * (r >> 2) + 4 * hi; }
__device__ __forceinline__ unsigned cvtpk(float lo, float hi) { return pg8::cvt_pk_bf16(lo, hi); }

__device__ __forceinline__ void partialSM(f32x16& p0, f32x16& p1, float& m_reg, float& mn, float& alpha) {
  constexpr float C = SCALE * 1.4426950408889634f;
  float pmax = p0[0];
#pragma unroll
  for (int r = 1; r < 16; ++r) pmax = fmaxf(pmax, p0[r]);
#pragma unroll
  for (int r = 0; r < 16; ++r) pmax = fmaxf(pmax, p1[r]);
  { auto rr = __builtin_amdgcn_permlane32_swap(__float_as_uint(pmax), __float_as_uint(pmax), false, false);
    pmax = fmaxf(__uint_as_float(rr[0]), __uint_as_float(rr[1])); }
  if (__builtin_expect(__all(pmax - m_reg <= THR / SCALE), 1)) { mn = m_reg; alpha = 1.f; }
  else { mn = fmaxf(m_reg, pmax); alpha = __builtin_amdgcn_exp2f((m_reg - mn) * C); m_reg = mn; }
  float mnC = -mn * C;
#pragma unroll
  for (int r = 0; r < 16; ++r) p0[r] = fmaf(p0[r], C, mnC);
#pragma unroll
  for (int r = 0; r < 16; ++r) p1[r] = fmaf(p1[r], C, mnC);
#pragma unroll
  for (int r = 0; r < 16; ++r) p0[r] = __builtin_amdgcn_exp2f(p0[r]);
}
__device__ __forceinline__ void finishSM(f32x16& p0, f32x16& p1, float alpha, float& l_reg, int mlo, int mhi, bf16x8& pa0, bf16x8& pa1, bf16x8& pa2, bf16x8& pa3) {
#pragma unroll
  for (int r = 0; r < 16; ++r) p1[r] = __builtin_amdgcn_exp2f(p1[r]);
#pragma unroll
  for (int r = 0; r < 16; ++r) { const int bit = (r & 3) + 8 * (r >> 2);
    p0[r] = __uint_as_float(__float_as_uint(p0[r]) & (unsigned)__builtin_amdgcn_sbfe(mlo, bit, 1));
    p1[r] = __uint_as_float(__float_as_uint(p1[r]) & (unsigned)__builtin_amdgcn_sbfe(mhi, bit, 1)); }
  float ps = 0;
#pragma unroll
  for (int r = 0; r < 16; ++r) ps += p0[r];
#pragma unroll
  for (int r = 0; r < 16; ++r) ps += p1[r];
  { auto rr = __builtin_amdgcn_permlane32_swap(__float_as_uint(ps), __float_as_uint(ps), false, false);
    ps = __uint_as_float(rr[0]) + __uint_as_float(rr[1]); }
  l_reg = l_reg * alpha + ps;
#define AT_PK4(P, BASE, OUT) do { unsigned a0 = cvtpk(P[BASE + 0], P[BASE + 1]), a1 = cvtpk(P[BASE + 2], P[BASE + 3]);   \
    unsigned b0 = cvtpk(P[BASE + 4], P[BASE + 5]), b1 = cvtpk(P[BASE + 6], P[BASE + 7]);                              \
    auto r0 = __builtin_amdgcn_permlane32_swap(a0, b0, false, false); auto r1 = __builtin_amdgcn_permlane32_swap(a1, b1, false, false); \
    u32x4 w = {r0[0], r1[0], r0[1], r1[1]}; OUT = *reinterpret_cast<bf16x8*>(&w); } while (0)
  AT_PK4(p0, 0, pa0); AT_PK4(p0, 8, pa1); AT_PK4(p1, 0, pa2); AT_PK4(p1, 8, pa3);
#undef AT_PK4
}
__device__ __forceinline__ void qkt(f32x16& p0, f32x16& p1, const LAS char* Ks, const bf16x8* qr, int r32, int hi) {
  p0 = f32x16{}; p1 = f32x16{};
#pragma unroll
  for (int d0 = 0; d0 < 8; ++d0) { int cb = (d0 * 16 + hi * 8) * 2;
    bf16x8 b0 = *reinterpret_cast<const LAS bf16x8*>(Ks + AT_KSWZ(r32, cb));
    bf16x8 b1 = *reinterpret_cast<const LAS bf16x8*>(Ks + AT_KSWZ(32 + r32, cb));
    p0 = __builtin_amdgcn_mfma_f32_32x32x16_bf16(b0, qr[d0], p0, 0, 0, 0);
    p1 = __builtin_amdgcn_mfma_f32_32x32x16_bf16(b1, qr[d0], p1, 0, 0, 0); }
}
__device__ __forceinline__ int v_st(int k, int c) { const int kk = (k & ~0xC) | ((k & 4) << 1) | ((k & 8) >> 1); return ((kk >> 3) * 4 + (c >> 5)) * 512 + ((kk & 7) * 32 + (c & 31)) * 2; }
__device__ __forceinline__ int v_rd_base(int lane) { return ((lane & 3) << 3) | (((lane >> 2) & 3) << 6) | (((lane >> 4) & 1) << 5) | (((lane >> 5) & 1) << 8); }
constexpr int v_rd_off(int d0, int ks, int half) { return d0 * 512 + ks * 4096 + half * 2048; }
template <int OFF> __device__ __forceinline__ s16x4 tr_read(int vb) {
  s16x4 r; asm volatile("ds_read_b64_tr_b16 %0, %1 offset:%2" : "=&v"(r) : "v"(vb), "i"(OFF) : "memory"); return r;
}
template <int D0> __device__ __forceinline__ void pv_one(f32x16& od, int vb, bf16x8 pa0, bf16x8 pa1, bf16x8 pa2, bf16x8 pa3) {
  const s16x4 l0 = tr_read<v_rd_off(D0, 0, 0)>(vb), h0 = tr_read<v_rd_off(D0, 0, 1)>(vb), l1 = tr_read<v_rd_off(D0, 1, 0)>(vb), h1 = tr_read<v_rd_off(D0, 1, 1)>(vb);
  const s16x4 l2 = tr_read<v_rd_off(D0, 2, 0)>(vb), h2 = tr_read<v_rd_off(D0, 2, 1)>(vb), l3 = tr_read<v_rd_off(D0, 3, 0)>(vb), h3 = tr_read<v_rd_off(D0, 3, 1)>(vb);
  asm volatile("s_waitcnt lgkmcnt(0)" ::: "memory"); AT_SBAR();
#define AT_PK(L_, H_) (bf16x8){L_[0], L_[1], L_[2], L_[3], H_[0], H_[1], H_[2], H_[3]}
  od = __builtin_amdgcn_mfma_f32_32x32x16_bf16(pa0, AT_PK(l0, h0), od, 0, 0, 0);
  od = __builtin_amdgcn_mfma_f32_32x32x16_bf16(pa1, AT_PK(l1, h1), od, 0, 0, 0);
  od = __builtin_amdgcn_mfma_f32_32x32x16_bf16(pa2, AT_PK(l2, h2), od, 0, 0, 0);
  od = __builtin_amdgcn_mfma_f32_32x32x16_bf16(pa3, AT_PK(l3, h3), od, 0, 0, 0);
#undef AT_PK
}
__device__ __forceinline__ void pv_d0(f32x16* o, int vb, bf16x8 pa0, bf16x8 pa1, bf16x8 pa2, bf16x8 pa3) {
  pv_one<0>(o[0], vb, pa0, pa1, pa2, pa3); pv_one<1>(o[1], vb, pa0, pa1, pa2, pa3); pv_one<2>(o[2], vb, pa0, pa1, pa2, pa3); pv_one<3>(o[3], vb, pa0, pa1, pa2, pa3);
}

__device__ __forceinline__ void attn_masked_body(const bf16_t* __restrict__ Qb, const bf16_t* __restrict__ Kh, const bf16_t* __restrict__ Vh, const unsigned long long* __restrict__ Mq,
                                                 bf16_t* __restrict__ Ob, int seq, LAS char* lds, int tid) {
  const int wid = __builtin_amdgcn_readfirstlane(tid >> 6), lane = tid & 63, r32 = lane & 31, hi = lane >> 5;
  LAS char* V_lds = lds; LAS char* K_lds = lds + 2 * SHM_V;
  LAS float* wsf = (LAS float*)(lds + 2 * SHM_V + 2 * SHM_K) + wid * 64; LAS float* li_l = wsf; LAS float* al_l = wsf + 32;
  float m_reg = -1e30f, l_reg = 0; f32x16 o[4] = {}; bf16x8 qr[8];
  const bf16_t* Qw = Qb + (long)(wid * QBLK + r32) * LDQ + hi * 8;
#pragma unroll
  for (int d0 = 0; d0 < 8; ++d0) qr[d0] = *reinterpret_cast<const bf16x8*>(Qw + d0 * 16);
  const unsigned long long* mrow = Mq + (size_t)(wid * QBLK + r32) * 64;
  const int sr = tid >> 4, sc = (tid & 15) * 8, vst0 = v_st(sr, sc), vst1 = v_st(32 + sr, sc);
  const int vb0 = (int)(uintptr_t)V_lds + v_rd_base(lane);
  struct { bf16x8 vs0, vs1, ks0, ks1; } sr_[2];
#define AT_SLOAD(i, k0) do { sr_[i].vs0 = *reinterpret_cast<const bf16x8*>(&Vh[(long)((k0) + sr) * LDK + sc]); sr_[i].vs1 = *reinterpret_cast<const bf16x8*>(&Vh[(long)((k0) + 32 + sr) * LDK + sc]); \
    sr_[i].ks0 = *reinterpret_cast<const bf16x8*>(&Kh[(long)((k0) + sr) * LDK + sc]); sr_[i].ks1 = *reinterpret_cast<const bf16x8*>(&Kh[(long)((k0) + 32 + sr) * LDK + sc]); } while (0)
#define AT_SWRITE(b, i) do { *(LAS bf16x8*)(V_lds + (b) * SHM_V + vst0) = sr_[i].vs0;          \
    *(LAS bf16x8*)(V_lds + (b) * SHM_V + vst1) = sr_[i].vs1; int kc = sc * 2;               \
    *(LAS bf16x8*)(K_lds + (b) * SHM_K + AT_KSWZ(sr, kc)) = sr_[i].ks0;                       \
    *(LAS bf16x8*)(K_lds + (b) * SHM_K + AT_KSWZ(32 + sr, kc)) = sr_[i].ks1; } while (0)
#define AT_SWAIT() asm volatile("s_waitcnt vmcnt(4)" ::: "memory")
#define AT_RESC(a) do { if (__any((a) < 1.f)) { if (hi == 0) al_l[r32] = (a); asm volatile("s_waitcnt lgkmcnt(0)" ::: "memory"); \
    _Pragma("unroll") for (int d = 0; d < 4; ++d) _Pragma("unroll") for (int r = 0; r < 16; ++r) o[d][r] *= al_l[crow(r, hi)]; } } while (0)
#define AT_MLOAD(mw, j) do { const unsigned long long _w = mrow[(j)]; (mw##lo) = (int)((unsigned)_w >> (4 * hi)); (mw##hi) = (int)((unsigned)(_w >> 32) >> (4 * hi)); } while (0)
  f32x16 pA0, pA1, pB0, pB1; float mnA, mnB, alA, alB; bf16x8 pa0, pa1, pa2, pa3; const int NT = seq / KVBLK;
  int mAlo, mAhi, mBlo, mBhi;
  constexpr int SE = 0, SO = 1;
  AT_SLOAD(SE, 0); AT_MLOAD(mA, 0); asm volatile("s_waitcnt vmcnt(0)" ::: "memory"); AT_SWRITE(0, SE); __syncthreads();
  qkt(pA0, pA1, K_lds, qr, r32, hi); partialSM(pA0, pA1, m_reg, mnA, alA);
  AT_SLOAD(SO, KVBLK); if (2 < NT) AT_SLOAD(SE, 2 * KVBLK);
  AT_SWAIT(); AT_SWRITE(1, SO); __syncthreads();
  for (int j = 1; j + 1 < NT; j += 2) {
    AT_SBAR(); AT_MLOAD(mB, j); qkt(pB0, pB1, K_lds + SHM_K, qr, r32, hi);
    finishSM(pA0, pA1, alA, l_reg, mAlo, mAhi, pa0, pa1, pa2, pa3); AT_SBAR();
    AT_SLOAD(SO, (j + 2) * KVBLK); AT_SBAR();
    pv_d0(o, vb0, pa0, pa1, pa2, pa3); partialSM(pB0, pB1, m_reg, mnB, alB);
    __syncthreads(); AT_SWAIT(); AT_SWRITE(0, SE);
    AT_RESC(alB); __syncthreads();
    AT_SBAR(); AT_MLOAD(mA, j + 1); qkt(pA0, pA1, K_lds, qr, r32, hi);
    finishSM(pB0, pB1, alB, l_reg, mBlo, mBhi, pa0, pa1, pa2, pa3); AT_SBAR();
    if (j + 3 < NT) AT_SLOAD(SE, (j + 3) * KVBLK); AT_SBAR();
    pv_d0(o, vb0 + (int)SHM_V, pa0, pa1, pa2, pa3); partialSM(pA0, pA1, m_reg, mnA, alA);
    __syncthreads(); AT_SWAIT(); AT_SWRITE(1, SO);
    AT_RESC(alA); __syncthreads();
  }
  AT_SBAR(); AT_MLOAD(mB, NT - 1); qkt(pB0, pB1, K_lds + SHM_K, qr, r32, hi);
  finishSM(pA0, pA1, alA, l_reg, mAlo, mAhi, pa0, pa1, pa2, pa3); AT_SBAR();
  pv_d0(o, vb0, pa0, pa1, pa2, pa3); partialSM(pB0, pB1, m_reg, mnB, alB);
  __syncthreads(); AT_RESC(alB);
  finishSM(pB0, pB1, alB, l_reg, mBlo, mBhi, pa0, pa1, pa2, pa3); AT_SBAR();
  pv_d0(o, vb0 + (int)SHM_V, pa0, pa1, pa2, pa3);
  if (hi == 0) li_l[r32] = l_reg; asm volatile("s_waitcnt lgkmcnt(0)" ::: "memory");
  float rli[16];
#pragma unroll
  for (int r = 0; r < 16; ++r) rli[r] = __builtin_amdgcn_rcpf(li_l[crow(r, hi)]);
  bf16_t* Ow = Ob + (long)(wid * QBLK) * LDQ;
#pragma unroll
  for (int r = 0; r < 16; ++r) { const int orow = crow(r, hi);
#pragma unroll
    for (int d0 = 0; d0 < 4; ++d0) Ow[(long)orow * LDQ + d0 * 32 + r32] = f2bf(o[d0][r] * rli[r]); }
#undef AT_SLOAD
#undef AT_SWRITE
#undef AT_SWAIT
#undef AT_RESC
#undef AT_MLOAD
}
}

__device__ __forceinline__ void phase_attn(KP P, LAS unsigned char* lds) {
    unsigned char* ws = as_global(P->ws);
    const bf16_t* QB = (const bf16_t*)(ws + WS_QB); const bf16_t* KB = (const bf16_t*)(ws + WS_KB); const bf16_t* VB = (const bf16_t*)(ws + WS_VB);
    const unsigned long long* MASK = (const unsigned long long*)(ws + WS_MASK); bf16_t* YB = (bf16_t*)(ws + WS_YB);
    const int G = nblk_();
    for (int p = bid_(); p < 256; p += G) {
        const int bh = p >> 3, b = bh >> 3, h = bh & 7, x = p & 7;
#pragma unroll 1
        for (int half = 0; half < 2; ++half) { const int qb = half ? 15 - x : x; const size_t row0 = (size_t)b * SEQ + (size_t)qb * 256;
            at::attn_masked_body(QB + row0 * 1024 + h * 128, KB + (size_t)b * SEQ * 1024 + h * 128, VB + (size_t)b * SEQ * 1024 + h * 128, MASK + row0 * 64,
                                 YB + row0 * 1024 + h * 128, 256 * (qb + 1), (LAS char*)lds, tid_());
            __syncthreads(); }
    }
}
__device__ __forceinline__ const float* sel_row(const float* S, int q, int& nw) {
    const int b = q >> 12, s = q & 4095, c = s >> 6; nw = c + 1;
    return S + (size_t)b * SCORE_B + (size_t)2048 * c * (c + 1) + (size_t)(s & 63) * (nw * 64);
}
__device__ __forceinline__ void sel_load(const float* row, int nw, int lane, float (&f)[64]) {
    if (nw > 32) {
#pragma unroll
        for (int j = 0; j < 64; ++j) { const int jc = j < nw ? j : nw - 1; f[j] = row[jc * 64 + lane]; }
    } else {
#pragma unroll
        for (int j = 0; j < 32; ++j) { const int jc = j < nw ? j : nw - 1; f[j] = row[jc * 64 + lane]; }
#pragma unroll
        for (int j = 32; j < 64; ++j) f[j] = 0.f;
    }
}
__device__ __forceinline__ void phase_select(KP P, LAS unsigned char* lds) {
    unsigned char* ws = as_global(P->ws); const float* S = (const float*)(ws + WS_S); unsigned long long* MASK = (unsigned long long*)(ws + WS_MASK);
    const int tid = tid_(), wave = __builtin_amdgcn_readfirstlane(tid >> 6), lane = tid & 63, nb8 = nblk_() * 8;
    LAS unsigned long long* sm = (LAS unsigned long long*)lds + wave * 64;
    float f[64]; int it = (bid_() * 8 + wave) * 8, nw = 0; const float* row = nullptr;
    const int itstep = nb8 * 8 - 7;
#define SEL_Q(it_) ((((it_) >> 3) & 3) * 4096 + ((it_) >> 5) + 512 * ((it_) & 7))
    int q = it < TOK ? SEL_Q(it) : TOK;
    if (q < TOK) { row = sel_row(S, q, nw); if (nw > TOPK / 64) sel_load(row, nw, lane, f); }
    while (q < TOK) {
        unsigned long long myword = 0ull;
        const int itn = ((it & 7) == 7) ? it + itstep : it + 1; const int qn = itn < TOK ? SEL_Q(itn) : TOK; int nwn = 0; const float* rown = nullptr;
        if (nw <= TOPK / 64) {
            myword = (lane < nw) ? ~0ull : 0ull;
            if (qn < TOK) { rown = sel_row(S, qn, nwn); if (nwn > TOPK / 64) sel_load(rown, nwn, lane, f); }
        } else {
            unsigned u[64];
#pragma unroll
            for (int j = 0; j < 64; ++j) { const unsigned bits = __float_as_uint(f[j]); const unsigned v = (bits & 0x80000000u) ? ~bits : (bits | 0x80000000u); u[j] = (j < nw) ? v : 0u; }
            if (qn < TOK) { rown = sel_row(S, qn, nwn); if (nwn > TOPK / 64) sel_load(rown, nwn, lane, f); }
            unsigned prefix = 0u;
            for (int bit = 31; bit >= 0; --bit) { const unsigned cand = prefix | (1u << bit); int cnt = 0;
#pragma unroll
                for (int j8 = 0; j8 < 8; ++j8) if (j8 * 8 < nw) { unsigned long long bl[8];
#pragma unroll
                    for (int jj = 0; jj < 8; ++jj) bl[jj] = __ballot(u[j8 * 8 + jj] >= cand);
                    asm volatile("" : "+s"(bl[0]), "+s"(bl[1]), "+s"(bl[2]), "+s"(bl[3]), "+s"(bl[4]), "+s"(bl[5]), "+s"(bl[6]), "+s"(bl[7]));
#pragma unroll
                    for (int jj = 0; jj < 8; ++jj) cnt += __popcll(bl[jj]); }
                if (cnt >= TOPK) prefix = cand;
                if (cnt == TOPK) break; }
#pragma unroll
            for (int j8 = 0; j8 < 8; ++j8) {
                if (j8 * 8 < nw) {
#pragma unroll
                    for (int jj = 0; jj < 8; ++jj) { const unsigned long long w = __ballot(u[j8 * 8 + jj] >= prefix); if (lane == 0) sm[j8 * 8 + jj] = w; }
                } else if (lane < 8) sm[j8 * 8 + lane] = 0ull; }
            myword = sm[lane];
        }
        MASK[(size_t)q * 64 + lane] = myword;
        q = qn; it = itn; nw = nwn; row = rown;
    }
#undef SEL_Q
}

__device__ __forceinline__ void phase_hgrn_naive(KP P, int layer, LAS unsigned char* lds) {
    unsigned char* ws = as_global(P->ws);
    const bf16_t* QA = (const bf16_t*)(ws + WS_QA); const bf16_t* KA = (const bf16_t*)(ws + WS_KA); const bf16_t* VA = (const bf16_t*)(ws + WS_VA); const bf16_t* GA = (const bf16_t*)(ws + WS_GA);
    const float* LF = (const float*)(ws + WS_LF); bf16_t* YA = (bf16_t*)(ws + WS_YA);
    const int tid = tid_(), bh = bid_(), b = bh >> 3, h = bh & 7, v = tid & 127; const bool act = (bh < 32) && (tid < 128);
    if (bh >= 32) return;
    LAS float* sf = (LAS float*)lds; LAS float* sk = sf + 16 * 128; LAS float* sq = sk + 16 * 128; LAS float* red = sq + 16 * 128;
    float S[128];
#pragma unroll
    for (int k = 0; k < 128; ++k) S[k] = 0.f;
    const float ng = as_global(P->hnorm_g)[layer * 128 + v];
    for (int t0 = 0; t0 < SEQ; t0 += 16) {
        if (act) for (int i = 0; i < 16; ++i) { const size_t idx = ((size_t)(b * SEQ + t0 + i)) * 1024 + h * 128 + v; sf[i * 128 + v] = expf(LF[idx]); sk[i * 128 + v] = bf2f(KA[idx]); sq[i * 128 + v] = bf2f(QA[idx]); }
        __syncthreads();
        for (int i = 0; i < 16; ++i) { const size_t idx = ((size_t)(b * SEQ + t0 + i)) * 1024 + h * 128 + v; float o = 0.f;
            if (act) { const float vt = bf2f(VA[idx]);
#pragma unroll
                for (int k = 0; k < 128; ++k) { S[k] = sf[i * 128 + k] * S[k] + sk[i * 128 + k] * vt; o += S[k] * sq[i * 128 + k]; } }
            float ss = o * o;
#pragma unroll
            for (int m = 32; m >= 1; m >>= 1) ss += __shfl_xor(ss, m);
            if (act && (v & 63) == 0) red[v >> 6] = ss;
            __syncthreads();
            if (act) { const float tot = red[0] + red[1]; YA[idx] = f2bf(o * (1.0f / sqrtf(tot * (1.0f / 128.0f) + RMS_EPS)) * ng * bf2f(GA[idx])); }
            __syncthreads(); }
    }
}
__device__ __forceinline__ void phase_idx_naive(KP P, LAS unsigned char* lds) {
    unsigned char* ws = as_global(P->ws);
    const bf16_t* QI = (const bf16_t*)(ws + WS_QI); const bf16_t* KI = (const bf16_t*)(ws + WS_KI); const float* WI = (const float*)(ws + WS_WI); float* Sc = (float*)(ws + WS_S);
    const int tid = tid_(), G = nblk_();
    LAS float* qs = (LAS float*)lds; LAS float* wsh = qs + 1024;
    for (int q = bid_(); q < TOK; q += G) {
        const int b = q >> 12, s = q & 4095, c = s >> 6, nw = c + 1, nk = nw * 64;
        if (nw <= TOPK / 64) continue;
        __syncthreads();
        for (int i = tid; i < 1024; i += 512) qs[i] = bf2f(QI[(size_t)q * 1024 + i]);
        if (tid < 16) wsh[tid] = WI[(size_t)q * 16 + tid];
        __syncthreads();
        float* row = Sc + (size_t)b * SCORE_B + (size_t)2048 * c * (c + 1) + (size_t)(s & 63) * nk;
        for (int key = tid; key < nk; key += 512) {
            float kf[64]; const pg8::u32x4* kp = (const pg8::u32x4*)(KI + ((size_t)b * SEQ + key) * 64);
#pragma unroll
            for (int d8 = 0; d8 < 8; ++d8) { const pg8::u32x4 w = kp[d8]; pg8::f32x4 a, bb; pg8::unpack8(w, a, bb);
#pragma unroll
                for (int j = 0; j < 4; ++j) { kf[d8 * 8 + j] = a[j]; kf[d8 * 8 + 4 + j] = bb[j]; } }
            float sc = 0.f;
            for (int h = 0; h < 16; ++h) { float dot = 0.f;
#pragma unroll
                for (int d = 0; d < 64; ++d) dot += qs[h * 64 + d] * kf[d];
                sc += wsh[h] * fmaxf(dot, 0.f); }
            row[key] = sc;
        }
    }
}
__device__ __forceinline__ void phase_attn_naive(KP P, LAS unsigned char* lds) {
    unsigned char* ws = as_global(P->ws);
    const bf16_t* QB = (const bf16_t*)(ws + WS_QB); const bf16_t* KB = (const bf16_t*)(ws + WS_KB); const bf16_t* VB = (const bf16_t*)(ws + WS_VB);
    const unsigned long long* MASK = (const unsigned long long*)(ws + WS_MASK); bf16_t* YB = (bf16_t*)(ws + WS_YB);
    const int tid = tid_(), h = tid >> 6, lane = tid & 63, G = nblk_();
    LAS float* qs = (LAS float*)lds + h * 128; LAS int* keys = (LAS int*)((LAS float*)lds + 1024) + h * 320; LAS float* lg = (LAS float*)lds + 1024 + 8 * 320 + h * 320;
    for (int q = bid_(); q < TOK; q += G) {
        const int b = q >> 12, s = q & 4095, nw = (s >> 6) + 1;
        qs[lane] = bf2f(QB[(size_t)q * 1024 + h * 128 + lane]); qs[lane + 64] = bf2f(QB[(size_t)q * 1024 + h * 128 + 64 + lane]);
        int cnt = 0;
        for (int j = 0; j < nw; ++j) { const unsigned long long w = MASK[(size_t)q * 64 + j]; const bool on = (w >> lane) & 1ull; const int key = j * 64 + lane;
            if (on) { const pg8::u32x4* kp = (const pg8::u32x4*)(KB + ((size_t)b * SEQ + key) * 1024 + h * 128); float dot = 0.f;
                for (int d8 = 0; d8 < 16; ++d8) { pg8::f32x4 a, bb; pg8::unpack8(kp[d8], a, bb);
#pragma unroll
                    for (int j2 = 0; j2 < 4; ++j2) dot += qs[d8 * 8 + j2] * a[j2] + qs[d8 * 8 + 4 + j2] * bb[j2]; }
                const int pos = cnt + __popcll(w & ((1ull << lane) - 1ull));
                if (pos < 320) { keys[pos] = key; lg[pos] = dot * ATTN_SCALE; } }
            cnt += __popcll(w); }
        if (cnt > 320) cnt = 320;
        float mx = -1e30f; for (int e = lane; e < cnt; e += 64) mx = fmaxf(mx, lg[e]);
#pragma unroll
        for (int m = 32; m >= 1; m >>= 1) mx = fmaxf(mx, __shfl_xor(mx, m));
        float sum = 0.f; for (int e = lane; e < cnt; e += 64) { const float pe = expf(lg[e] - mx); lg[e] = pe; sum += pe; }
#pragma unroll
        for (int m = 32; m >= 1; m >>= 1) sum += __shfl_xor(sum, m);
        float a0 = 0.f, a1 = 0.f;
        for (int e = 0; e < cnt; ++e) { const float pe = lg[e]; const bf16_t* vp = VB + ((size_t)b * SEQ + keys[e]) * 1024 + h * 128 + 2 * lane; a0 += pe * bf2f(vp[0]); a1 += pe * bf2f(vp[1]); }
        const float inv = 1.0f / sum;
        *(unsigned*)(YB + (size_t)q * 1024 + h * 128 + 2 * lane) = pg8::cvt_pk_bf16(a0 * inv, a1 * inv);
    }
}

constexpr int IXK = 512, IX_LD = 144;
__device__ __forceinline__ void idx_unit(const bf16_t* QI, const bf16_t* KI, const float* WI, float* Sc, int b, int c, int half, int tid, LAS unsigned char* lds) {
    const int lane = tid & 63, wave = __builtin_amdgcn_readfirstlane(tid >> 6), r = lane & 31, hh = lane >> 5, nk = 64 * (c + 1);
    const int s0 = c * 64 + half * 32 + wave * 4;
    const int aq = (r >> 2) & 1, ahead = (r & 3) + 4 * (r >> 3);
    bf16x8_t A[2][4]; float wv[2][16];
#pragma unroll
    for (int rt = 0; rt < 2; ++rt) { const size_t qrow = (size_t)b * SEQ + s0 + 2 * rt + aq;
#pragma unroll
        for (int ks = 0; ks < 4; ++ks) A[rt][ks] = *(const bf16x8_t*)(QI + qrow * 1024 + ahead * 64 + 16 * ks + 8 * hh);
        const float* wp = WI + ((size_t)b * SEQ + s0 + 2 * rt + hh) * 16;
#pragma unroll
        for (int i4 = 0; i4 < 4; ++i4) { const pg8::f32x4 w4 = *(const pg8::f32x4*)(wp + 4 * i4); wv[rt][4 * i4] = w4[0]; wv[rt][4 * i4 + 1] = w4[1]; wv[rt][4 * i4 + 2] = w4[2]; wv[rt][4 * i4 + 3] = w4[3]; } }
    float* srow[2];
#pragma unroll
    for (int rt = 0; rt < 2; ++rt) srow[rt] = Sc + (size_t)b * SCORE_B + (size_t)2048 * c * (c + 1) + (size_t)((s0 + 2 * rt + hh) & 63) * nk + r;
    const bf16_t* kbase = KI + (size_t)b * SEQ * 64;
    const int nblk = (nk + IXK - 1) / IXK;
    pg8::u32x4 stg[8];
#define IX_LOAD(kb) do { _Pragma("unroll") for (int i = 0; i < 8; ++i) { const int p = tid + 512 * i; int key = (kb) * IXK + (p >> 3); key = key < nk ? key : nk - 1; \
        stg[i] = *(const pg8::u32x4*)(kbase + (size_t)key * 64 + (p & 7) * 8); } } while (0)
#define IX_STORE() do { _Pragma("unroll") for (int i = 0; i < 8; ++i) { const int p = tid + 512 * i; *(LAS pg8::u32x4*)(lds + (p >> 3) * IX_LD + (p & 7) * 16) = stg[i]; } } while (0)
    IX_LOAD(0);
    for (int kb = 0; kb < nblk; ++kb) {
        __syncthreads();
        IX_STORE();
        __syncthreads();
        if (kb + 1 < nblk) IX_LOAD(kb + 1);
        const int ntile = (nk - kb * IXK < IXK ? nk - kb * IXK : IXK) / 32;
        for (int t = 0; t < ntile; ++t) { bf16x8_t Bc[4];
#pragma unroll
            for (int ks = 0; ks < 4; ++ks) Bc[ks] = *(const LAS bf16x8_t*)(lds + (32 * t + r) * IX_LD + (16 * ks + 8 * hh) * 2);
#pragma unroll
            for (int rt = 0; rt < 2; ++rt) { f32x16_t acc;
#pragma unroll
                for (int i = 0; i < 16; ++i) acc[i] = 0.f;
#pragma unroll
                for (int ks = 0; ks < 4; ++ks) acc = __builtin_amdgcn_mfma_f32_32x32x16_bf16(A[rt][ks], Bc[ks], acc, 0, 0, 0);
                pg8::f32x2 sc2 = {0.f, 0.f};
#pragma unroll
                for (int i = 0; i < 16; i += 2) { pg8::f32x2 rl, wq; rl[0] = __int_as_float(max(__float_as_int(acc[i]), 0)); rl[1] = __int_as_float(max(__float_as_int(acc[i + 1]), 0));
                    wq[0] = wv[rt][i]; wq[1] = wv[rt][i + 1]; sc2 = __builtin_elementwise_fma(wq, rl, sc2); }
                srow[rt][kb * IXK + t * 32] = sc2[0] + sc2[1]; } }
    }
#undef IX_LOAD
#undef IX_STORE
}
__device__ __forceinline__ void phase_idx(KP P, LAS unsigned char* lds) {
    unsigned char* ws = as_global(P->ws);
    const bf16_t* QI = (const bf16_t*)(ws + WS_QI); const bf16_t* KI = (const bf16_t*)(ws + WS_KI); const float* WI = (const float*)(ws + WS_WI); float* Sc = (float*)(ws + WS_S);
    const int G = nblk_();
    for (int item = bid_(); item < 240; item += G) {
        const int pi = item % 30, combo = item / 30, b = combo >> 1, half = combo & 1;
        idx_unit(QI, KI, WI, Sc, b, 4 + pi, half, tid_(), lds); __syncthreads();
        idx_unit(QI, KI, WI, Sc, b, 63 - pi, half, tid_(), lds); __syncthreads();
    }
}

__device__ __forceinline__ void sel_unit(const float* S, unsigned long long* MASK, int b, int c, int half, int tid, LAS unsigned char* lds) {
    const int lane = tid & 63, wave = __builtin_amdgcn_readfirstlane(tid >> 6), nw = c + 1;
    LAS unsigned long long* sm = (LAS unsigned long long*)lds + wave * 64;
    float f[64]; const int s0 = c * 64 + half * 32 + wave * 4;
    const float* rowbase = S + (size_t)b * SCORE_B + (size_t)2048 * c * (c + 1);
#pragma unroll 1
    for (int i = 0; i < 4; ++i) {
        unsigned u[64];
        sel_load(rowbase + (size_t)((s0 + i) & 63) * (nw * 64), nw, lane, f);
#pragma unroll
        for (int j = 0; j < 64; ++j) { const unsigned bits = __float_as_uint(f[j]); const unsigned v = (bits & 0x80000000u) ? ~bits : (bits | 0x80000000u); u[j] = (j < nw) ? v : 0u; }
        unsigned prefix = 0u;
        for (int bit = 31; bit >= 0; --bit) { const unsigned cand = prefix | (1u << bit); int cnt = 0;
#pragma unroll
            for (int j8 = 0; j8 < 8; ++j8) if (j8 * 8 < nw) { unsigned long long bl[8];
#pragma unroll
                for (int jj = 0; jj < 8; ++jj) bl[jj] = __ballot(u[j8 * 8 + jj] >= cand);
                asm volatile("" : "+s"(bl[0]), "+s"(bl[1]), "+s"(bl[2]), "+s"(bl[3]), "+s"(bl[4]), "+s"(bl[5]), "+s"(bl[6]), "+s"(bl[7]));
#pragma unroll
                for (int jj = 0; jj < 8; ++jj) cnt += __popcll(bl[jj]); }
            if (cnt >= TOPK) prefix = cand; }
#pragma unroll
        for (int j = 0; j < 64; ++j) { const unsigned long long w = __ballot(u[j] >= prefix); if (lane == 0) sm[j] = w; }
        MASK[((size_t)b * SEQ + s0 + i) * 64 + lane] = sm[lane];
    }
}
__device__ __forceinline__ void phase_idxsel(KP P, LAS unsigned char* lds) {
    unsigned char* ws = as_global(P->ws);
    const bf16_t* QI = (const bf16_t*)(ws + WS_QI); const bf16_t* KI = (const bf16_t*)(ws + WS_KI); const float* WI = (const float*)(ws + WS_WI); float* Sc = (float*)(ws + WS_S);
    unsigned long long* MASK = (unsigned long long*)(ws + WS_MASK);
    const int G = nblk_();
    { const int tid = tid_(), lane = tid & 63, gw = bid_() * 8 + __builtin_amdgcn_readfirstlane(tid >> 6);
      for (int qq = gw; qq < NBATCH * 256; qq += G * 8) { const int b = qq >> 8, s = qq & 255, nw = (s >> 6) + 1; MASK[((size_t)b * SEQ + s) * 64 + lane] = (lane < nw) ? ~0ull : 0ull; } }
    for (int item = bid_(); item < 240; item += G) {
        const int pi = item % 30, combo = item / 30, b = combo >> 1, half = combo & 1;
#pragma unroll 1
        for (int which = 0; which < 2; ++which) { const int c = which ? 63 - pi : 4 + pi;
            idx_unit(QI, KI, WI, Sc, b, c, half, tid_(), lds);
            asm volatile("s_waitcnt vmcnt(0)" ::: "memory"); __syncthreads();
            sel_unit(Sc, MASK, b, c, half, tid_(), lds);
            __syncthreads(); }
    }
}
__device__ __forceinline__ void ixs_unit(const bf16_t* QI, const bf16_t* KI, const float* WI, unsigned long long* MASK, int b, int u8, int tid, LAS unsigned char* lds) {
    const int lane = tid & 63, wave = __builtin_amdgcn_readfirstlane(tid >> 6), r = lane & 31, hh = lane >> 5;
    const int s0 = 8 * u8, c = s0 >> 6, nw = c + 1, nk = 64 * nw;
    LAS float* SC = (LAS float*)lds;
    unsigned long long myword;
    if (nw > TOPK / 64) {
        { const int aq = (r >> 2) & 1, ahead = (r & 3) + 4 * (r >> 3);
          bf16x8_t A[4][4]; float wv[4][16];
#pragma unroll
          for (int rt = 0; rt < 4; ++rt) { const size_t qrow = (size_t)b * SEQ + s0 + 2 * rt + aq;
#pragma unroll
              for (int ks = 0; ks < 4; ++ks) A[rt][ks] = *(const bf16x8_t*)(QI + qrow * 1024 + ahead * 64 + 16 * ks + 8 * hh);
              const float* wp = WI + ((size_t)b * SEQ + s0 + 2 * rt + hh) * 16;
#pragma unroll
              for (int i4 = 0; i4 < 4; ++i4) { const pg8::f32x4 w4 = *(const pg8::f32x4*)(wp + 4 * i4); wv[rt][4 * i4] = w4[0]; wv[rt][4 * i4 + 1] = w4[1]; wv[rt][4 * i4 + 2] = w4[2]; wv[rt][4 * i4 + 3] = w4[3]; } }
          const bf16_t* kp = KI + ((size_t)b * SEQ + r) * 64 + 8 * hh;
          const int ntile = nk / 32;
          bf16x8_t Ca[4], Cb[4];
#define IXS_LOAD(t0_) do { const int ta = (t0_) < ntile ? (t0_) : ntile - 1, tb_ = (t0_) + 8 < ntile ? (t0_) + 8 : ntile - 1; \
              _Pragma("unroll") for (int ks = 0; ks < 4; ++ks) { Ca[ks] = *(const bf16x8_t*)(kp + (size_t)ta * 2048 + 16 * ks); Cb[ks] = *(const bf16x8_t*)(kp + (size_t)tb_ * 2048 + 16 * ks); } } while (0)
#define IXS_TILE(BUF, tt) do { _Pragma("unroll") for (int rt = 0; rt < 4; ++rt) { f32x16_t acc; _Pragma("unroll") for (int i = 0; i < 16; ++i) acc[i] = 0.f; \
              _Pragma("unroll") for (int ks = 0; ks < 4; ++ks) acc = __builtin_amdgcn_mfma_f32_32x32x16_bf16(A[rt][ks], BUF[ks], acc, 0, 0, 0); \
              pg8::f32x2 sc2 = {0.f, 0.f}; _Pragma("unroll") for (int i = 0; i < 16; i += 2) { pg8::f32x2 rl, wq; \
                  rl[0] = __int_as_float(max(__float_as_int(acc[i]), 0)); rl[1] = __int_as_float(max(__float_as_int(acc[i + 1]), 0)); wq[0] = wv[rt][i]; wq[1] = wv[rt][i + 1]; \
                  sc2 = __builtin_elementwise_fma(wq, rl, sc2); } const float sc = sc2[0] + sc2[1];     \
              SC[(2 * rt + hh) * 4096 + 32 * (tt) + r] = sc; } } while (0)
          IXS_LOAD(wave);
          for (int t = wave; t < ntile; t += 16) {
              bf16x8_t Ba[4], Bb[4];
#pragma unroll
              for (int ks = 0; ks < 4; ++ks) { Ba[ks] = Ca[ks]; Bb[ks] = Cb[ks]; }
              IXS_LOAD(t + 16);
              IXS_TILE(Ba, t);
              if (t + 8 < ntile) IXS_TILE(Bb, t + 8);
          }
#undef IXS_LOAD
#undef IXS_TILE
        }
        __syncthreads();
        unsigned u[64];
        { const LAS float* row = SC + wave * 4096 + lane;
#pragma unroll
          for (int j = 0; j < 64; ++j) { const int jc = j < nw ? j : nw - 1; const unsigned bits = __float_as_uint(row[jc * 64]); const unsigned v = (bits & 0x80000000u) ? ~bits : (bits | 0x80000000u); u[j] = (j < nw) ? v : 0u; } }
        unsigned prefix = 0u;
#ifdef IXS_DUP_SEARCH
        for (int rep_s = 0; rep_s < 2; ++rep_s) { prefix = 0u;
#else
        {
#endif
        for (int bit = 31; bit >= 0; --bit) { const unsigned cand = prefix | (1u << bit); int cnt = 0;
            unsigned cl = 0u;
#pragma unroll
            for (int j8 = 0; j8 < 8; ++j8) if (j8 * 8 < nw) {
#pragma unroll
                for (int jj = 0; jj < 8; ++jj) cl += (u[j8 * 8 + jj] >= cand) ? 1u : 0u; }
#pragma unroll
            for (int bb = 0; bb < 7; ++bb) cnt += __popcll(__ballot((cl >> bb) & 1u)) << bb;
            if (cnt >= TOPK) prefix = cand; }
        }
        LAS unsigned long long* sm = (LAS unsigned long long*)(SC + wave * 4096);
#pragma unroll
        for (int j = 0; j < 64; ++j) { const unsigned long long w = __ballot(u[j] >= prefix); if (lane == 0) sm[j] = w; }
        myword = sm[lane];
    } else {
        myword = (lane < nw) ? ~0ull : 0ull;
    }
    MASK[((size_t)b * SEQ + s0 + wave) * 64 + lane] = myword;
    __syncthreads();
}
__device__ __forceinline__ void phase_ixs(KP P, LAS unsigned char* lds) {
    unsigned char* ws = as_global(P->ws);
    const bf16_t* QI = (const bf16_t*)(ws + WS_QI); const bf16_t* KI = (const bf16_t*)(ws + WS_KI); const float* WI = (const float*)(ws + WS_WI); unsigned long long* MASK = (unsigned long long*)(ws + WS_MASK);
    const int G = nblk_();
    for (int W = bid_(); W < 256; W += G)
        for (int kk = 0; kk < 8; ++kk) ixs_unit(QI, KI, WI, MASK, W & 3, (W >> 2) + 64 * kk, tid_(), lds);
}
#ifndef OPT_HGRN
#define OPT_HGRN 1
#endif
#ifndef OPT_IDX
#define OPT_IDX 1
#endif
#ifndef OPT_ATT
#define OPT_ATT 1
#endif
#ifndef OPT_IXS
#define OPT_IXS 0
#endif
#ifndef PHM
#define PHM 0x3fff
#endif
#ifndef DUP_MASK
#define DUP_MASK 0
#endif

__global__ void __launch_bounds__(512, 2) mega(Params P_unused) {
    extern __shared__ __attribute__((aligned(16))) unsigned char lds[];
    LAS unsigned char* L = (LAS unsigned char*)lds;
    volatile LAS unsigned* misc = (volatile LAS unsigned*)(L + MISC_OFF);
    if (threadIdx.x < 4) misc[threadIdx.x] = 0u;
    __syncthreads();
    int lo, hi; unsigned char* ws0; { KP P0 = kparams(); lo = P0->ph_lo; hi = P0->ph_hi; ws0 = as_global(P0->ws); }
    XcdBarrier bar; bar.bar = (unsigned*)(ws0 + WS_CTL); bar.x = 0; bar.st = misc;
    if (hi - lo > 1) bar = xcd_barrier_post((unsigned*)(ws0 + WS_CTL), misc);
#define WSP(T_, off) ((T_*)(ws + (off)))
#define WSL KP P = kparams(); unsigned char* ws = as_global(P->ws); const int G = nblk_(), bid = bid_(); (void)G; (void)bid

    for (int layer = 0; layer < DEPTH; ++layer) {
        const int base = layer * NPH_LAYER;
#define IN(k) (((PHM >> (k)) & 1) && lo <= base + (k) && base + (k) < hi)
#define SEAM(k) do { if (rep + 1 == ((((DUP_MASK >> (k)) & 1) ? 2 : 1)) && base + (k) + 1 < hi) xcd_barrier(bar); } while (0)
        if (layer == 0 && IN(0)) for (int rep = 0; rep < (((DUP_MASK >> 0) & 1) ? 2 : 1); ++rep) { WSL; phase_prologue(P); phase_wconv(P, 0, L); SEAM(0); }
        if (IN(1)) for (int rep = 0; rep < (((DUP_MASK >> 1) & 1) ? 2 : 1); ++rep) { WSL;
            pg8::Gemm g{WSP(const bf16_t, WS_XB), WSP(const bf16_t, WS_WIN), TOK, INP, DM}; pg8::StaticOrder S; S.init(TOK, INP, G, bid);
            pg8::EpiIn E{ws, layer};
            pg8::gemm_phase<pg8::EpiIn, pg8::StaticOrder, true, true>(L, g, S, E); SEAM(1);
        }
        if (IN(2)) for (int rep = 0; rep < (((DUP_MASK >> 2) & 1) ? 2 : 1); ++rep) { WSL; phase_ikprep(P, layer);
#if OPT_HGRN
            phase_hgrn_h1(P, L);
#ifdef DUP_H1
            phase_hgrn_h1(P, L);
#endif
#endif
            SEAM(2); }
        if (IN(3)) for (int rep = 0; rep < (((DUP_MASK >> 3) & 1) ? 2 : 1); ++rep) { WSL;
#if !OPT_HGRN
            phase_hgrn_naive(P, layer, L); __syncthreads();
#else
            phase_hgrn_h2(P);
#ifdef DUP_H2
            phase_hgrn_h2(P);
#endif
#endif
#if !OPT_IDX
            phase_idx_naive(P, L);
#else
#if OPT_IXS == 2
            __syncthreads(); phase_idxsel(P, L);
#elif OPT_IXS == 1
            __syncthreads(); phase_ixs(P, L);
#ifdef DUP_IXS
            __syncthreads(); phase_ixs(P, L);
#endif
#else
            __syncthreads(); phase_idx(P, L);
#endif
#endif
            SEAM(3); }
#if OPT_IXS == 2 && OPT_HGRN && OPT_ATT
#else
        if (IN(4)) for (int rep = 0; rep < (((DUP_MASK >> 4) & 1) ? 2 : 1); ++rep) { WSL;
#if OPT_IXS == 0
            phase_select(P, L);
#endif
#if OPT_HGRN
            __syncthreads(); phase_hgrn_h3(P, layer, L);
#ifdef DUP_H3
            __syncthreads(); phase_hgrn_h3(P, layer, L);
#endif
#endif
            SEAM(4); }
#endif
        if (IN(5)) for (int rep = 0; rep < (((DUP_MASK >> 5) & 1) ? 2 : 1); ++rep) { WSL;
#if !OPT_ATT
            phase_attn_naive(P, L);
#else
#if OPT_IXS == 2 && OPT_HGRN
            phase_hgrn_h3(P, layer, L); __syncthreads();
#endif
            phase_attn(P, L);
#endif
            SEAM(5); }
        if (IN(6)) for (int rep = 0; rep < (((DUP_MASK >> 6) & 1) ? 2 : 1); ++rep) { WSL;
            { pg8::Gemm g{WSP(const bf16_t, WS_YA), WSP(const bf16_t, WS_WA), TOK, DM, AW}; pg8::StaticOrder S; S.init(TOK, DM, G, bid);
              pg8::EpiGateA E{ws}; pg8::gemm_phase<pg8::EpiGateA, pg8::StaticOrder, true, true>(L, g, S, E); }
            { pg8::Gemm g{WSP(const bf16_t, WS_YB), WSP(const bf16_t, WS_WB), TOK, DM, BW}; pg8::StaticOrder S; S.init(TOK, DM, G, bid);
              pg8::EpiGateB E{ws}; pg8::gemm_phase<pg8::EpiGateB, pg8::StaticOrder, true, true>(L, g, S, E); }
            { pg8::Gemm g{WSP(const bf16_t, WS_PB), WSP(const bf16_t, WS_WPP), TOK, DM, PLE}; pg8::StaticOrder S; S.init(TOK, DM, G, bid);
              pg8::EpiF32P E{ws}; pg8::gemm_phase<pg8::EpiF32P, pg8::StaticOrder, true, true>(L, g, S, E); }
            SEAM(6);
        }
        if (IN(7)) for (int rep = 0; rep < (((DUP_MASK >> 7) & 1) ? 2 : 1); ++rep) { WSL;
            pg8::Gemm g{WSP(const bf16_t, WS_MG), WSP(const bf16_t, WS_WO), TOK, DM, DM}; pg8::StaticOrder S; S.init(TOK, DM, G, bid);
            if (layer == 0) { pg8::EpiRes<true> E{as_global(P->x), nullptr, nullptr, ws}; pg8::gemm_phase<pg8::EpiRes<true>, pg8::StaticOrder, true, true>(L, g, S, E); }
            else { pg8::EpiRes<false> E{nullptr, P->lnp_g + (layer - 1) * DM, P->lnp_b + (layer - 1) * DM, ws}; pg8::gemm_phase<pg8::EpiRes<false>, pg8::StaticOrder, true, true>(L, g, S, E); }
            SEAM(7);
        }
        if (IN(8)) for (int rep = 0; rep < (((DUP_MASK >> 8) & 1) ? 2 : 1); ++rep) { WSL; phase_ln(WSP(const float, WS_XPRE), nullptr, WSP(bf16_t, WS_XB), WSP(float, WS_STATS), as_global(P->lnm_g) + layer * DM, as_global(P->lnm_b) + layer * DM); SEAM(8); }
        if (IN(9)) for (int rep = 0; rep < (((DUP_MASK >> 9) & 1) ? 2 : 1); ++rep) { WSL;
            pg8::Gemm g{WSP(const bf16_t, WS_XB), WSP(const bf16_t, WS_WGU), TOK, 2 * DFF, DM}; pg8::StaticOrder S; S.init(TOK, 2 * DFF, G, bid);
            pg8::EpiSwiGLU E{ws}; pg8::gemm_phase<pg8::EpiSwiGLU, pg8::StaticOrder, true, true>(L, g, S, E); SEAM(9);
        }
        if (IN(10)) for (int rep = 0; rep < (((DUP_MASK >> 10) & 1) ? 2 : 1); ++rep) { WSL;
            pg8::Gemm g{WSP(const bf16_t, WS_H), WSP(const bf16_t, WS_WDN), TOK, DM, DFF}; pg8::StaticOrder S; S.init(TOK, DM, G, bid);
            pg8::EpiRes<false> E{nullptr, P->lnm_g + layer * DM, P->lnm_b + layer * DM, ws}; pg8::gemm_phase<pg8::EpiRes<false>, pg8::StaticOrder, true, true>(L, g, S, E); SEAM(10);
        }
        if (IN(11)) for (int rep = 0; rep < (((DUP_MASK >> 11) & 1) ? 2 : 1); ++rep) { WSL; phase_ln(WSP(const float, WS_XPRE), nullptr, WSP(bf16_t, WS_XB), WSP(float, WS_STATS), as_global(P->lnf_g) + layer * DM, as_global(P->lnf_b) + layer * DM); SEAM(11); }
        if (IN(12)) for (int rep = 0; rep < (((DUP_MASK >> 12) & 1) ? 2 : 1); ++rep) { WSL;
            pg8::Gemm g{WSP(const bf16_t, WS_XB), WSP(const bf16_t, WS_WPG), TOK, DM, DM}; pg8::StaticOrder S; S.init(TOK, DM, G, bid);
            pg8::EpiPle E{P->lnf_g + layer * DM, P->lnf_b + layer * DM, ws}; pg8::gemm_phase<pg8::EpiPle, pg8::StaticOrder, true, true>(L, g, S, E); SEAM(12);
        }
        if (IN(13)) for (int rep = 0; rep < (((DUP_MASK >> 13) & 1) ? 2 : 1); ++rep) { WSL; phase_ln(WSP(const float, WS_XPRE), layer == DEPTH - 1 ? as_global(P->out) : nullptr, WSP(bf16_t, WS_XB), WSP(float, WS_STATS), as_global(P->lnp_g) + layer * DM, as_global(P->lnp_b) + layer * DM);
            if (layer + 1 < DEPTH) { __syncthreads(); phase_wconv(P, layer + 1, L); }
            SEAM(13); }
#undef IN
#undef SEAM
    }
}

extern "C" void kernel_launch(void* const* d_in, const int* in_sizes, int n_in, void* d_out, int out_size, void* d_ws, size_t ws_size, hipStream_t stream) {
    static int grid = 0;
    if (grid == 0) {
        if (n_in != 22 || out_size != TOK * DM || ws_size < WS_END) { fprintf(stderr, "kernel_launch: unexpected shapes: n_in %d out %d ws %zu (need %zu)\n", n_in, out_size, ws_size, (size_t)WS_END); grid = -1; return; }
        int dev = 0, cus = 0, per_cu = 0;
        if (hipGetDevice(&dev) != hipSuccess || hipDeviceGetAttribute(&cus, hipDeviceAttributeMultiprocessorCount, dev) != hipSuccess) { grid = -1; return; }
        if (hipFuncSetAttribute((const void*)mega, hipFuncAttributeMaxDynamicSharedMemorySize, LDS_BYTES) != hipSuccess) { fprintf(stderr, "kernel_launch: hipFuncSetAttribute failed\n"); grid = -1; return; }
        if (hipOccupancyMaxActiveBlocksPerMultiprocessor(&per_cu, (const void*)mega, 512, LDS_BYTES) != hipSuccess || per_cu < 1) { fprintf(stderr, "kernel_launch: occupancy query says %d\n", per_cu); (void)hipGetLastError(); }
        grid = cus;
    }
    if (grid < 0) return;
    (void)hipMemsetAsync((char*)d_ws + WS_CTL, 0, 65536, stream);
    Params P{};
    P.x = (const float*)d_in[0]; P.p = (const float*)d_in[1]; P.pos = (const int*)d_in[2];
    P.w_in = (const float*)d_in[3]; P.w_a = (const float*)d_in[4]; P.w_b = (const float*)d_in[5]; P.w_out = (const float*)d_in[6];
    P.lbraw = (const float*)d_in[7]; P.hnorm_g = (const float*)d_in[8]; P.ikn_g = (const float*)d_in[9]; P.ikn_b = (const float*)d_in[10];
    P.lnm_g = (const float*)d_in[11]; P.lnm_b = (const float*)d_in[12]; P.w_fg = (const float*)d_in[13]; P.w_fu = (const float*)d_in[14]; P.w_fd = (const float*)d_in[15];
    P.lnf_g = (const float*)d_in[16]; P.lnf_b = (const float*)d_in[17]; P.w_pg = (const float*)d_in[18]; P.w_pp = (const float*)d_in[19];
    P.lnp_g = (const float*)d_in[20]; P.lnp_b = (const float*)d_in[21];
    P.out = (float*)d_out; P.ws = (unsigned char*)d_ws;
    for (int j = 0; j < 64; ++j) P.invf_h[j] = pow(10000.0, -(double)j / 64.0) / 6.283185307179586476925286766559;
    for (int j = 0; j < 32; ++j) P.invf_i[j] = pow(10000.0, -(double)j / 32.0) / 6.283185307179586476925286766559;
    P.ph_lo = 0; P.ph_hi = NPH;
    hipLaunchKernelGGL(mega, dim3(grid), dim3(512), LDS_BYTES, stream, P);
    const hipError_t le = hipPeekAtLastError();
    if (le != hipSuccess) fprintf(stderr, "kernel_launch: launch failed: %s\n", hipGetErrorName(le));
}
```

```cpp
#include <hip/hip_runtime.h>
#include <cstdio>
#include <cstdint>

constexpr int DM = 2048, NBATCH = 4, SEQ = 4096, TOK = NBATCH * SEQ, DEPTH = 4, CHUNK = 64, PLE = 256;
constexpr int AH = 8, AD = 128, AW = 1024, BH = 8, BD = 128, BW = 1024, IH = 16, IDIM = 64, TOPK = 256;
constexpr int DFF = 5632, INW = 12368, INP = 12544;
constexpr float ALPHA = 1.6817928305074290861f;
constexpr float LN_EPS = 1e-5f, RMS_EPS = 1e-6f;
constexpr float ATTN_SCALE = 0.088388347648318440f;
constexpr float IDX_SCALE = 0.03125f;

typedef unsigned short bf16_t;
__device__ __forceinline__ float bf2f(bf16_t b) { return __uint_as_float(((unsigned)b) << 16); }
__device__ __forceinline__ bf16_t f2bf(float f) { unsigned u = __float_as_uint(f); u += 0x7FFFu + ((u >> 16) & 1u); return (bf16_t)(u >> 16); }
__device__ __forceinline__ float sigmoid_f(float x) { return __builtin_amdgcn_rcpf(1.0f + __expf(-x)); }
__device__ __forceinline__ float silu_f(float x) { return x * sigmoid_f(x); }

__device__ __forceinline__ int tid_() { int t = (int)threadIdx.x; asm volatile("" : "+v"(t)); return t; }
__device__ __forceinline__ int bid_() { int b = (int)blockIdx.x; asm volatile("" : "+s"(b)); return b; }
__device__ __forceinline__ int nblk_() { int g = (int)gridDim.x; asm volatile("" : "+s"(g)); return g; }

template <class T> __device__ __forceinline__ T* as_global(T* p) { return (T*)(__attribute__((address_space(1))) T*)p; }

constexpr size_t MiB = 1048576;
constexpr size_t WS_CTL  = 0;
constexpr size_t WS_LB   = WS_CTL + 65536;
constexpr size_t WS_STATS = WS_CTL + 131072;
constexpr size_t WS_COSH = 1 * MiB;
constexpr size_t WS_SINH = WS_COSH + 4 * MiB;
constexpr size_t WS_COSI = WS_SINH + 4 * MiB;
constexpr size_t WS_SINI = WS_COSI + 2 * MiB;
constexpr size_t WS_WIN  = WS_SINI + 2 * MiB;
constexpr size_t WS_WA   = WS_WIN + 49 * MiB;
constexpr size_t WS_WB   = WS_WA + 4 * MiB;
constexpr size_t WS_WO   = WS_WB + 4 * MiB;
constexpr size_t WS_WGU  = WS_WO + 8 * MiB;
constexpr size_t WS_WDN  = WS_WGU + 44 * MiB;
constexpr size_t WS_WPG  = WS_WDN + 22 * MiB;
constexpr size_t WS_WPP  = WS_WPG + 8 * MiB;
constexpr size_t WS_S    = WS_WPP + 1 * MiB;
constexpr size_t WS_XB   = WS_S + 130 * MiB;
constexpr size_t WS_XPRE = WS_XB + 64 * MiB;
constexpr size_t WS_R1   = WS_XPRE + 130 * MiB;
constexpr size_t WS_QA   = WS_R1;
constexpr size_t WS_LF   = WS_QA + 32 * MiB;
constexpr size_t WS_KA   = WS_LF + 64 * MiB;
constexpr size_t WS_VA   = WS_KA + 32 * MiB;
constexpr size_t WS_GA   = WS_VA + 32 * MiB;
constexpr size_t WS_QB   = WS_GA + 32 * MiB;
constexpr size_t WS_KB   = WS_QB + 32 * MiB;
constexpr size_t WS_VB   = WS_KB + 32 * MiB;
constexpr size_t WS_QI   = WS_VB + 32 * MiB;
constexpr size_t WS_SGA  = WS_QI + 32 * MiB;
constexpr size_t WS_SGB  = WS_SGA + 64 * MiB;
constexpr size_t WS_IKW  = WS_SGB + 64 * MiB;
constexpr size_t WS_H    = WS_R1;
constexpr size_t WS_PP   = WS_R1 + 176 * MiB;
constexpr size_t WS_R2   = WS_IKW + 8 * MiB;
constexpr size_t WS_LT   = WS_R2;
constexpr size_t WS_MG   = WS_R2;
constexpr size_t WS_AF   = WS_R2 + 64 * MiB;
constexpr size_t WS_PT   = WS_LT + 128 * MiB;
constexpr size_t WS_DEC  = WS_PT + 64 * MiB;
constexpr size_t WS_MASK = WS_DEC + 1 * MiB;
constexpr size_t WS_YA   = WS_MASK + 8 * MiB;
constexpr size_t WS_YB   = WS_YA + 32 * MiB;
constexpr size_t WS_KI   = WS_YB + 32 * MiB;
constexpr size_t WS_WI   = WS_KI + 2 * MiB;
constexpr size_t WS_PB   = WS_WI + 1 * MiB;
constexpr size_t WS_END  = WS_PB + 8 * MiB;
static_assert(WS_END < 1360000000ull, "workspace budget");
constexpr size_t SCORE_B = (size_t)4096 * 2080;

namespace pg8 {
#define PG8_LAS __attribute__((address_space(3)))
typedef unsigned short bf16_t;
typedef short bf16x8 __attribute__((ext_vector_type(8)));
typedef float f32x4 __attribute__((ext_vector_type(4)));
typedef unsigned u32x4 __attribute__((ext_vector_type(4)));
constexpr int BM = 256, BK = 64, HALF = 128, HTB = HALF * BK * 2  , STAGE_BYTES = 8 * HTB, NXCD = 8, WGM = 8;

__host__ __device__ __forceinline__ int lds_byte(int r, int c) { const int st = (r >> 4) * 2 + (c >> 5), rr = r & 15, cc = c & 31, ob = rr * 64 + cc * 2; return st * 1024 + (ob ^ (((ob >> 9) & 1) << 5)); }
__host__ __device__ __forceinline__ void stage_rc(int b, int& R, int& C) { const int st = b / 1024, sb = b % 1024, swz = sb ^ (((sb >> 9) & 1) << 5); R = (st >> 1) * 16 + swz / 64; C = (st & 1) * 32 + (swz % 64) / 2; }
__host__ __device__ __forceinline__ int perm32(int rho) { const int n = rho >> 4, i = rho & 15; return 8 * (i >> 2) + 4 * n + (i & 3); }

struct Unit { int pm, pn; };
struct Gemm { const bf16_t* A; const bf16_t* Bt; int M, N, K; };

struct StaticOrder {
    int nM, nN, nwg, G, c;
    __host__ __device__ void init(int M, int N, int G_, int c_) { nM = M / BM; nN = N / BM; nwg = nM * nN; G = G_; c = c_; }
    __host__ __device__ bool next(int i, Unit& u) const {
        const long L = (long)i * G + c; if (L >= nwg) return false;
        int wgid = (int)L; { const int q = nwg / NXCD, r = nwg % NXCD, xcd = wgid % NXCD, off = wgid / NXCD; wgid = (xcd < r ? xcd * (q + 1) : r * (q + 1) + (xcd - r) * q) + off; }
        const int nig = WGM * nN, gid = wgid / nig, fm = gid * WGM, gsz = (nM - fm) < WGM ? (nM - fm) : WGM;
        u.pm = fm + ((wgid % nig) % gsz); u.pn = (wgid % nig) / gsz; return true;
    }
    __device__ __forceinline__ void a_ready(const Unit&) const {}
    __device__ __forceinline__ void done(const Unit&) const {}
};

typedef float pk_f32x2 __attribute__((ext_vector_type(2)));
typedef __bf16 pk_bf16x2 __attribute__((ext_vector_type(2)));
__device__ __forceinline__ unsigned cvt_pk_bf16(float lo, float hi) { const pk_f32x2 v = {lo, hi}; const pk_bf16x2 b = __builtin_convertvector(v, pk_bf16x2); return __builtin_bit_cast(unsigned, b); }
struct PanelOrder8 : StaticOrder {
    __host__ __device__ bool next(int i, Unit& u) const {
        if (G != 256 || nN != 8 || nM != 64) return StaticOrder::next(i, u);
        if (i >= 2) return false;
        const int xcd = c & 7, j = c >> 3; u.pm = 8 * xcd + 4 * i + (j & 3); u.pn = j >> 2; return true;
    }
};
typedef unsigned u32x2 __attribute__((ext_vector_type(2)));
typedef float f32x2 __attribute__((ext_vector_type(2)));
__device__ __forceinline__ u32x4 pack8(const f32x4 a, const f32x4 b) { u32x4 w; w.x = cvt_pk_bf16(a[0], a[1]); w.y = cvt_pk_bf16(a[2], a[3]); w.z = cvt_pk_bf16(b[0], b[1]); w.w = cvt_pk_bf16(b[2], b[3]); return w; }
__device__ __forceinline__ void unpack8(const u32x4 w, f32x4& a, f32x4& b) {
    a[0] = __uint_as_float(w.x << 16); a[1] = __uint_as_float(w.x & 0xffff0000u); a[2] = __uint_as_float(w.y << 16); a[3] = __uint_as_float(w.y & 0xffff0000u);
    b[0] = __uint_as_float(w.z << 16); b[1] = __uint_as_float(w.z & 0xffff0000u); b[2] = __uint_as_float(w.w << 16); b[3] = __uint_as_float(w.w & 0xffff0000u); }
__device__ __forceinline__ float sigm(float x) { return __builtin_amdgcn_rcpf(1.0f + __expf(-x)); }
__device__ __forceinline__ f32x4 sigm4(const f32x4 x) { f32x4 r; r[0] = sigm(x[0]); r[1] = sigm(x[1]); r[2] = sigm(x[2]); r[3] = sigm(x[3]); return r; }
__device__ __forceinline__ f32x4 silu4(const f32x4 x) { return x * sigm4(x); }

#define PG8_GAS __attribute__((address_space(1)))
struct EpiIn {
    static constexpr bool PERM = true, AFTER_DRAIN = false;
    unsigned char* ws0; int layer;
    __device__ __forceinline__ void operator()(const f32x4 (&acc)[2][2][4][2], const Unit& u, int wr, int wc, int fr, int fq) const {
        unsigned char* wsq = ws0; asm volatile("" : "+s"(wsq)); PG8_GAS unsigned char* const ws = (PG8_GAS unsigned char*)wsq;
        const int pn = u.pn, row0 = u.pm * BM + wr * 64 + fr, cw = wc * 32 + 8 * fq;
        PG8_GAS bf16_t* const QA = (PG8_GAS bf16_t*)(ws + WS_QA); PG8_GAS bf16_t* const KA = (PG8_GAS bf16_t*)(ws + WS_KA); PG8_GAS bf16_t* const VA = (PG8_GAS bf16_t*)(ws + WS_VA); PG8_GAS bf16_t* const GA = (PG8_GAS bf16_t*)(ws + WS_GA);
        PG8_GAS bf16_t* const QB = (PG8_GAS bf16_t*)(ws + WS_QB); PG8_GAS bf16_t* const KB = (PG8_GAS bf16_t*)(ws + WS_KB); PG8_GAS bf16_t* const VB = (PG8_GAS bf16_t*)(ws + WS_VB); PG8_GAS bf16_t* const QI = (PG8_GAS bf16_t*)(ws + WS_QI);
        PG8_GAS bf16_t* const SGA = (PG8_GAS bf16_t*)(ws + WS_SGA); PG8_GAS bf16_t* const SGB = (PG8_GAS bf16_t*)(ws + WS_SGB); PG8_GAS float* const LF = (PG8_GAS float*)(ws + WS_LF); PG8_GAS float* const IKW = (PG8_GAS float*)(ws + WS_IKW);
        const PG8_GAS float* const lb = (const PG8_GAS float*)(ws + WS_LB) + layer * 1024; const PG8_GAS float* const cosh = (const PG8_GAS float*)(ws + WS_COSH); const PG8_GAS float* const sinh = (const PG8_GAS float*)(ws + WS_SINH);
        const PG8_GAS float* const cosi = (const PG8_GAS float*)(ws + WS_COSI); const PG8_GAS float* const sini = (const PG8_GAS float*)(ws + WS_SINI);
        if (pn < 32) {
            const int seg = pn >> 2, cb = (pn & 3) * 256;
            if (seg == 4 || seg == 5) {
                PG8_GAS bf16_t* O = (seg == 4) ? QB : KB; const int head = (pn & 3) * 2 + (wc >> 1), i0 = (wc & 1) * 32 + 8 * fq;
#pragma unroll
                for (int ai = 0; ai < 2; ++ai)
#pragma unroll
                    for (int m = 0; m < 4; ++m) { const int row = row0 + ai * HALF + m * 16;
                        const PG8_GAS float* cp = cosh + (size_t)row * 64 + i0; const PG8_GAS float* sp = sinh + (size_t)row * 64 + i0;
                        const f32x4 c0 = *(const PG8_GAS f32x4*)cp, c1 = *(const PG8_GAS f32x4*)(cp + 4), s0 = *(const PG8_GAS f32x4*)sp, s1 = *(const PG8_GAS f32x4*)(sp + 4);
                        const f32x4 xa = acc[ai][0][m][0], xb = acc[ai][0][m][1], ya = acc[ai][1][m][0], yb = acc[ai][1][m][1];
                        PG8_GAS bf16_t* rp = O + (size_t)row * 1024 + head * 128 + i0;
                        *(PG8_GAS u32x4*)rp = pack8(xa * c0 - ya * s0, xb * c1 - yb * s1);
                        *(PG8_GAS u32x4*)(rp + 64) = pack8(xa * s0 + ya * c0, xb * s1 + yb * c1); asm volatile("" ::: "memory"); }
            } else if (seg == 7) {
                const int head = (pn & 3) * 4 + wc, i0 = 8 * fq;
#pragma unroll
                for (int ai = 0; ai < 2; ++ai)
#pragma unroll
                    for (int m = 0; m < 4; ++m) { const int row = row0 + ai * HALF + m * 16;
                        const PG8_GAS float* cp = cosi + (size_t)row * 32 + i0; const PG8_GAS float* sp = sini + (size_t)row * 32 + i0;
                        const f32x4 c0 = *(const PG8_GAS f32x4*)cp, c1 = *(const PG8_GAS f32x4*)(cp + 4), s0 = *(const PG8_GAS f32x4*)sp, s1 = *(const PG8_GAS f32x4*)(sp + 4);
                        const f32x4 xa = acc[ai][0][m][0], xb = acc[ai][0][m][1], ya = acc[ai][1][m][0], yb = acc[ai][1][m][1];
                        PG8_GAS bf16_t* rp = QI + (size_t)row * 1024 + head * 64 + i0;
                        *(PG8_GAS u32x4*)rp = pack8(xa * c0 - ya * s0, xb * c1 - yb * s1);
                        *(PG8_GAS u32x4*)(rp + 32) = pack8(xa * s0 + ya * c0, xb * s1 + yb * c1); asm volatile("" ::: "memory"); }
            } else if (seg == 1) {
#pragma unroll
                for (int bj = 0; bj < 2; ++bj) { const int col = cb + bj * HALF + cw;
                    const f32x4 l0 = *(const PG8_GAS f32x4*)(lb + col), l1 = *(const PG8_GAS f32x4*)(lb + col + 4);
#pragma unroll
                    for (int ai = 0; ai < 2; ++ai)
#pragma unroll
                        for (int m = 0; m < 4; ++m) { const int row = row0 + ai * HALF + m * 16; f32x4 lf[2], kk[2];
#pragma unroll
                            for (int n = 0; n < 2; ++n) { const f32x4 x = acc[ai][bj][m][n]; const f32x4 lv = n ? l1 : l0;
#pragma unroll
                                for (int j = 0; j < 4; ++j) { const float xe = fminf(fmaxf(x[j], -80.f), 80.f), e = __expf(-xe), r = __builtin_amdgcn_rcpf(1.0f + e);
                                    const float om = 1.0f - lv[j]; lf[n][j] = logf(lv[j] + om * r); kk[n][j] = om * (e * r); } }
                            PG8_GAS float* lp = LF + (size_t)row * 1024 + col; *(PG8_GAS f32x4*)lp = lf[0]; *(PG8_GAS f32x4*)(lp + 4) = lf[1];
                            *(PG8_GAS u32x4*)(KA + (size_t)row * 1024 + col) = pack8(kk[0], kk[1]); asm volatile("" ::: "memory"); } }
            } else {
                PG8_GAS bf16_t* O = (seg == 0) ? QA : (seg == 2) ? VA : (seg == 3) ? GA : VB; const bool act = (seg == 0 || seg == 3);
#pragma unroll
                for (int ai = 0; ai < 2; ++ai)
#pragma unroll
                    for (int m = 0; m < 4; ++m) { const int row = row0 + ai * HALF + m * 16;
#pragma unroll
                        for (int bj = 0; bj < 2; ++bj) { f32x4 v0 = acc[ai][bj][m][0], v1 = acc[ai][bj][m][1];
                            if (act) { v0 = silu4(v0); v1 = silu4(v1); }
                            *(PG8_GAS u32x4*)(O + (size_t)row * 1024 + cb + bj * HALF + cw) = pack8(v0, v1); } }
            }
        } else if (pn < 48) {
            PG8_GAS bf16_t* O = (pn < 40) ? SGA : SGB; const int cb = ((pn - 32) & 7) * 256;
#pragma unroll
            for (int ai = 0; ai < 2; ++ai)
#pragma unroll
                for (int m = 0; m < 4; ++m) { const int row = row0 + ai * HALF + m * 16;
#pragma unroll
                    for (int bj = 0; bj < 2; ++bj)
                        *(PG8_GAS u32x4*)(O + (size_t)row * DM + cb + bj * HALF + cw) = pack8(sigm4(acc[ai][bj][m][0]), sigm4(acc[ai][bj][m][1])); }
        } else {
#pragma unroll
            for (int ai = 0; ai < 2; ++ai)
#pragma unroll
                for (int m = 0; m < 4; ++m) { PG8_GAS float* p = IKW + (size_t)(row0 + ai * HALF + m * 16) * 128 + cw; *(PG8_GAS f32x4*)p = acc[ai][0][m][0]; *(PG8_GAS f32x4*)(p + 4) = acc[ai][0][m][1]; }
        }
    }
};
struct EpiGateA {
    static constexpr bool PERM = true, AFTER_DRAIN = false;
    unsigned char* ws;
    __device__ __forceinline__ void operator()(const f32x4 (&acc)[2][2][4][2], const Unit& u, int wr, int wc, int fr, int fq) const {
        unsigned char* const wg = as_global(ws); const bf16_t* const SG = (const bf16_t*)(wg + WS_SGA); bf16_t* const AF = (bf16_t*)(wg + WS_AF);
        const int row0 = u.pm * BM + wr * 64 + fr, col0 = u.pn * BM + wc * 32 + 8 * fq;
#pragma unroll
        for (int ai = 0; ai < 2; ++ai)
#pragma unroll
            for (int m = 0; m < 4; ++m) { const size_t off = (size_t)(row0 + ai * HALF + m * 16) * DM + col0;
#pragma unroll
                for (int bj = 0; bj < 2; ++bj) { f32x4 g0, g1; unpack8(*(const u32x4*)(SG + off + bj * HALF), g0, g1);
                    *(u32x4*)(AF + off + bj * HALF) = pack8(g0 * acc[ai][bj][m][0], g1 * acc[ai][bj][m][1]); } asm volatile("" ::: "memory"); }
    }
};
struct EpiGateB {
    static constexpr bool PERM = true, AFTER_DRAIN = false;
    unsigned char* ws;
    __device__ __forceinline__ void operator()(const f32x4 (&acc)[2][2][4][2], const Unit& u, int wr, int wc, int fr, int fq) const {
        unsigned char* const wg = as_global(ws); const bf16_t* const SG = (const bf16_t*)(wg + WS_SGB); const bf16_t* const AF = (const bf16_t*)(wg + WS_AF); bf16_t* const MG = (bf16_t*)(wg + WS_MG);
        const int row0 = u.pm * BM + wr * 64 + fr, col0 = u.pn * BM + wc * 32 + 8 * fq;
#pragma unroll
        for (int ai = 0; ai < 2; ++ai)
#pragma unroll
            for (int m = 0; m < 4; ++m) { const size_t off = (size_t)(row0 + ai * HALF + m * 16) * DM + col0;
#pragma unroll
                for (int bj = 0; bj < 2; ++bj) { f32x4 g0, g1; unpack8(*(const u32x4*)(SG + off + bj * HALF), g0, g1);
                    f32x4 a0, a1; unpack8(*(const u32x4*)(AF + off + bj * HALF), a0, a1);
                    *(u32x4*)(MG + off + bj * HALF) = pack8(a0 + g0 * acc[ai][bj][m][0], a1 + g1 * acc[ai][bj][m][1]); } asm volatile("" ::: "memory"); }
    }
};
template <bool PLAIN> struct EpiRes {
    static constexpr bool PERM = true, AFTER_DRAIN = false;
    const float* X; const float* g; const float* b; unsigned char* ws;
    __device__ __forceinline__ void operator()(const f32x4 (&acc)[2][2][4][2], const Unit& u, int wr, int wc, int fr, int fq) const {
        unsigned char* const wg = as_global(ws); float* const XP = (float*)(wg + WS_XPRE); const float* const ST = (const float*)(wg + WS_STATS); const float* const Xg = as_global(X);
        const int row0 = u.pm * BM + wr * 64 + fr, col0 = u.pn * BM + wc * 32 + 8 * fq;
        f32x4 gv[2][2], bv[2][2];
        if (!PLAIN) { const float* gg = as_global(g); const float* bb = as_global(b);
#pragma unroll
            for (int bj = 0; bj < 2; ++bj)
#pragma unroll
                for (int n = 0; n < 2; ++n) { gv[bj][n] = *(const f32x4*)(gg + col0 + bj * HALF + 4 * n); bv[bj][n] = *(const f32x4*)(bb + col0 + bj * HALF + 4 * n); } }
#pragma unroll
        for (int ai = 0; ai < 2; ++ai)
#pragma unroll
            for (int m = 0; m < 4; ++m) { const int row = row0 + ai * HALF + m * 16; const size_t off = (size_t)row * DM + col0;
                float mean = 0.f, rstd = 1.f; if (!PLAIN) { const f32x2 s2 = *(const f32x2*)(ST + 2 * (size_t)row); mean = s2[0]; rstd = s2[1]; }
#pragma unroll
                for (int bj = 0; bj < 2; ++bj) { float* p = XP + off + bj * HALF; f32x4 x0, x1;
                    if (PLAIN) { const float* xp = Xg + off + bj * HALF; x0 = *(const f32x4*)xp; x1 = *(const f32x4*)(xp + 4); }
                    else { x0 = (*(const f32x4*)p - mean) * rstd * gv[bj][0] + bv[bj][0]; x1 = (*(const f32x4*)(p + 4) - mean) * rstd * gv[bj][1] + bv[bj][1]; }
                    *(f32x4*)p = x0 * ALPHA + acc[ai][bj][m][0]; *(f32x4*)(p + 4) = x1 * ALPHA + acc[ai][bj][m][1]; } asm volatile("" ::: "memory"); }
    }
};
struct EpiSwiGLU {
    static constexpr bool PERM = true, AFTER_DRAIN = false;
    unsigned char* ws;
    __device__ __forceinline__ void operator()(const f32x4 (&acc)[2][2][4][2], const Unit& u, int wr, int wc, int fr, int fq) const {
        bf16_t* const H = (bf16_t*)(as_global(ws) + WS_H);
        const int row0 = u.pm * BM + wr * 64 + fr, col0 = u.pn * HALF + wc * 32 + 8 * fq;
#pragma unroll
        for (int ai = 0; ai < 2; ++ai)
#pragma unroll
            for (int m = 0; m < 4; ++m)
                *(u32x4*)(H + (size_t)(row0 + ai * HALF + m * 16) * DFF + col0) = pack8(silu4(acc[ai][0][m][0]) * acc[ai][1][m][0], silu4(acc[ai][0][m][1]) * acc[ai][1][m][1]);
    }
};
struct EpiF32P {
    static constexpr bool PERM = true, AFTER_DRAIN = false;
    unsigned char* ws;
    __device__ __forceinline__ void operator()(const f32x4 (&acc)[2][2][4][2], const Unit& u, int wr, int wc, int fr, int fq) const {
        bf16_t* const C = (bf16_t*)(as_global(ws) + WS_PP);
        const int row0 = u.pm * BM + wr * 64 + fr, col0 = u.pn * BM + wc * 32 + 8 * fq;
#pragma unroll
        for (int ai = 0; ai < 2; ++ai)
#pragma unroll
            for (int m = 0; m < 4; ++m) { const size_t off = (size_t)(row0 + ai * HALF + m * 16) * DM + col0;
#pragma unroll
                for (int bj = 0; bj < 2; ++bj) *(u32x4*)(C + off + bj * HALF) = pack8(acc[ai][bj][m][0], acc[ai][bj][m][1]); }
    }
};
struct EpiPle {
    static constexpr bool PERM = true, AFTER_DRAIN = false;
    const float* g; const float* b; unsigned char* ws;
    __device__ __forceinline__ void operator()(const f32x4 (&acc)[2][2][4][2], const Unit& u, int wr, int wc, int fr, int fq) const {
        unsigned char* const wg = as_global(ws); const bf16_t* const PP = (const bf16_t*)(wg + WS_PP); float* const XP = (float*)(wg + WS_XPRE); const float* const ST = (const float*)(wg + WS_STATS);
        const int row0 = u.pm * BM + wr * 64 + fr, col0 = u.pn * BM + wc * 32 + 8 * fq;
        f32x4 gv[2][2], bv[2][2]; { const float* gg = as_global(g); const float* bb = as_global(b);
#pragma unroll
            for (int bj = 0; bj < 2; ++bj)
#pragma unroll
                for (int n = 0; n < 2; ++n) { gv[bj][n] = *(const f32x4*)(gg + col0 + bj * HALF + 4 * n); bv[bj][n] = *(const f32x4*)(bb + col0 + bj * HALF + 4 * n); } }
#pragma unroll
        for (int ai = 0; ai < 2; ++ai)
#pragma unroll
            for (int m = 0; m < 4; ++m) { const int row = row0 + ai * HALF + m * 16; const size_t off = (size_t)row * DM + col0;
                const f32x2 s2 = *(const f32x2*)(ST + 2 * (size_t)row); const float mean = s2[0], rstd = s2[1];
#pragma unroll
                for (int bj = 0; bj < 2; ++bj) { float* p = XP + off + bj * HALF; f32x4 p0, p1; unpack8(*(const u32x4*)(PP + off + bj * HALF), p0, p1);
                    const f32x4 x0 = (*(const f32x4*)p - mean) * rstd * gv[bj][0] + bv[bj][0], x1 = (*(const f32x4*)(p + 4) - mean) * rstd * gv[bj][1] + bv[bj][1];
                    *(f32x4*)p = x0 * ALPHA + sigm4(acc[ai][bj][m][0]) * p0; *(f32x4*)(p + 4) = x1 * ALPHA + sigm4(acc[ai][bj][m][1]) * p1; } asm volatile("" ::: "memory"); }
    }
};

template <class Epi, class Sched, bool ALIGN_EPI = false, bool SP2 = false>
__device__ __forceinline__ void gemm_phase(PG8_LAS unsigned char* lds, const Gemm g, const Sched& S, const Epi& E) {
    const int tid = tid_(), wid = __builtin_amdgcn_readfirstlane(tid >> 6), lane = tid & 63, wr = wid >> 2, wc = wid & 3, fr = lane & 15, fq = lane >> 4;
    int Kq = g.K; asm volatile("" : "+s"(Kq)); const int K = Kq, nt = K / BK;
    unsigned voffA[2], voffB[2];
#pragma unroll
    for (int i = 0; i < 2; ++i) { int R, C; stage_rc(tid * 16 + i * 8192, R, C); const int Rb = Epi::PERM ? ((R & ~31) + perm32(R & 31)) : R;
        voffA[i] = (unsigned)(R * K + C) * 2u; voffB[i] = (unsigned)(Rb * K + C) * 2u; }
    const size_t kstep = (size_t)(BK * 2);
    const size_t hstep = (size_t)HALF * K * 2;
    const size_t tstep = 2 * hstep;
    const unsigned ldsw = (unsigned)wid * 1024u;
    const int aoff = lds_byte(wr * 64 + fr, fq * 8), boff = lds_byte(wc * 32 + fr, fq * 8);
#define PG8_SA(b, h) (((b) * 2 + (h)) * HTB)
#define PG8_SB(b, h) ((4 + (b) * 2 + (h)) * HTB)
#define PG8_STAGE(bufoff, gbase, voff) do { _Pragma("unroll") for (int _i = 0; _i < 2; ++_i) \
        __builtin_amdgcn_global_load_lds((const unsigned*)((const char*)(gbase) + (voff)[_i]), (PG8_LAS unsigned*)(lds + (bufoff) + ldsw + _i * 8192), 16, 0, 0); } while (0)
#define PG8_LDA(dst, b, h) do { _Pragma("unroll") for (int m = 0; m < 4; ++m) _Pragma("unroll") for (int k = 0; k < 2; ++k) dst[m][k] = *(const PG8_LAS bf16x8*)(lds + PG8_SA(b, h) + aoff + m * 2048 + k * 1024); } while (0)
#define PG8_LDB(dst, b, h) do { _Pragma("unroll") for (int n = 0; n < 2; ++n) _Pragma("unroll") for (int k = 0; k < 2; ++k) dst[n][k] = *(const PG8_LAS bf16x8*)(lds + PG8_SB(b, h) + boff + n * 2048 + k * 1024); } while (0)
#define PG8_MMA(ai, bj, At, Bt) do { __builtin_amdgcn_s_setprio(1); _Pragma("unroll") for (int m = 0; m < 4; ++m) _Pragma("unroll") for (int n = 0; n < 2; ++n) _Pragma("unroll") for (int k = 0; k < 2; ++k) \
        acc[ai][bj][m][n] = __builtin_amdgcn_mfma_f32_16x16x32_bf16(Bt[n][k], At[m][k], acc[ai][bj][m][n], 0, 0, 0); __builtin_amdgcn_s_setprio(0); } while (0)
#define PG8_WAIT_V(n) asm volatile("s_waitcnt vmcnt(" #n ")" ::: "memory")
#define PG8_WAIT_L(n) asm volatile("s_waitcnt lgkmcnt(" #n ")" ::: "memory")
#define PG8_BAR __builtin_amdgcn_s_barrier()
#define PG8_SCHED __builtin_amdgcn_sched_barrier(0)
    Unit cur, nxt; int ui = 0;
    if (!S.next(0, cur)) return;
    f32x4 acc[2][2][4][2];
#pragma unroll
    for (int a = 0; a < 2; ++a)
#pragma unroll
        for (int b = 0; b < 2; ++b)
#pragma unroll
            for (int m = 0; m < 4; ++m)
#pragma unroll
                for (int n = 0; n < 2; ++n) acc[a][b][m][n] = (f32x4){0.f, 0.f, 0.f, 0.f};
    bf16x8 At[4][2], B0[2][2], B1[2][2];
    const char* cA = (const char*)g.A + (size_t)cur.pm * tstep; const char* cB = (const char*)g.Bt + (size_t)cur.pn * tstep;
    S.a_ready(cur);
    if constexpr (SP2) {
        PG8_STAGE(PG8_SB(0, 0), cB, voffB); PG8_STAGE(PG8_SB(0, 1), cB + hstep, voffB); PG8_STAGE(PG8_SA(0, 0), cA, voffA); PG8_STAGE(PG8_SA(0, 1), cA + hstep, voffA);
        if (wr == 1) PG8_BAR;
        PG8_WAIT_V(2); PG8_BAR;
        PG8_STAGE(PG8_SB(1, 0), cB + kstep, voffB); PG8_STAGE(PG8_SA(1, 0), cA + kstep, voffA); PG8_STAGE(PG8_SB(1, 1), cB + hstep + kstep, voffB);
        PG8_WAIT_V(6); PG8_BAR;
    } else {
        PG8_STAGE(PG8_SB(0, 0), cB, voffB); PG8_STAGE(PG8_SA(0, 0), cA, voffA); PG8_STAGE(PG8_SB(0, 1), cB + hstep, voffB); PG8_STAGE(PG8_SA(0, 1), cA + hstep, voffA);
        if (wr == 1) PG8_BAR;
        PG8_WAIT_V(4); PG8_BAR;
        PG8_STAGE(PG8_SB(1, 0), cB + kstep, voffB); PG8_STAGE(PG8_SA(1, 0), cA + kstep, voffA); PG8_STAGE(PG8_SB(1, 1), cB + hstep + kstep, voffB);
        PG8_WAIT_V(6); PG8_BAR;
    }
    for (;;) {
        const bool has_next = S.next(ui + 1, nxt);
        const char* nA = has_next ? (const char*)g.A + (size_t)nxt.pm * tstep : cA; const char* nB = has_next ? (const char*)g.Bt + (size_t)nxt.pn * tstep : cB;
        for (int t = 0; t < nt; t += 2) {
            const bool last = (t == nt - 2);
            const char* a1 = cA + (size_t)(t + 1) * kstep;
            const char* a2 = last ? nA : cA + (size_t)(t + 2) * kstep; const char* b2 = last ? nB : cB + (size_t)(t + 2) * kstep;
            const char* a3 = a2 + kstep; const char* b3 = b2 + kstep;
            if (last && has_next) S.a_ready(nxt);
            if constexpr (SP2) {
            PG8_LDB(B0, 0, 0); PG8_LDB(B1, 0, 1); PG8_SCHED; PG8_LDA(At, 0, 0); PG8_STAGE(PG8_SA(1, 1), a1 + hstep, voffA);
            PG8_WAIT_V(8); PG8_WAIT_L(0); PG8_BAR; PG8_MMA(0, 0, At, B0); PG8_MMA(0, 1, At, B1); PG8_BAR; PG8_SCHED;
            PG8_LDA(At, 0, 1); PG8_STAGE(PG8_SB(0, 0), b2, voffB); PG8_STAGE(PG8_SB(0, 1), b2 + hstep, voffB); PG8_STAGE(PG8_SA(0, 0), a2, voffA);
            PG8_WAIT_V(8); PG8_WAIT_L(0); PG8_BAR; PG8_MMA(1, 0, At, B0); PG8_MMA(1, 1, At, B1); PG8_BAR; PG8_SCHED;
            PG8_LDB(B0, 1, 0); PG8_LDB(B1, 1, 1); PG8_SCHED; PG8_LDA(At, 1, 0); PG8_STAGE(PG8_SA(0, 1), a2 + hstep, voffA);
            PG8_WAIT_V(8); PG8_WAIT_L(0); PG8_BAR; PG8_MMA(0, 0, At, B0); PG8_MMA(0, 1, At, B1); PG8_BAR; PG8_SCHED;
            PG8_LDA(At, 1, 1); PG8_STAGE(PG8_SB(1, 0), b3, voffB); PG8_STAGE(PG8_SB(1, 1), b3 + hstep, voffB); PG8_STAGE(PG8_SA(1, 0), a3, voffA);
            PG8_WAIT_V(8); PG8_WAIT_L(0); PG8_BAR; PG8_MMA(1, 0, At, B0); PG8_MMA(1, 1, At, B1); PG8_BAR; PG8_SCHED;
            } else {
            PG8_LDB(B0, 0, 0); PG8_SCHED; PG8_LDA(At, 0, 0); PG8_STAGE(PG8_SA(1, 1), a1 + hstep, voffA);
            PG8_WAIT_L(8); PG8_BAR; PG8_WAIT_L(0); PG8_MMA(0, 0, At, B0); PG8_BAR; PG8_SCHED;
            PG8_LDB(B1, 0, 1); PG8_STAGE(PG8_SB(0, 0), b2, voffB);
            PG8_BAR; PG8_WAIT_L(0); PG8_MMA(0, 1, At, B1); PG8_BAR;
            PG8_LDA(At, 0, 1); PG8_STAGE(PG8_SA(0, 0), a2, voffA);
            PG8_BAR; PG8_WAIT_L(0); PG8_MMA(1, 0, At, B0); PG8_BAR; PG8_SCHED;
            PG8_STAGE(PG8_SB(0, 1), b2 + hstep, voffB);
            PG8_WAIT_V(6); PG8_BAR; PG8_MMA(1, 1, At, B1); PG8_BAR;
            PG8_LDB(B0, 1, 0); PG8_SCHED; PG8_LDA(At, 1, 0); PG8_STAGE(PG8_SA(0, 1), a2 + hstep, voffA);
            PG8_WAIT_L(8); PG8_BAR; PG8_WAIT_L(0); PG8_MMA(0, 0, At, B0); PG8_BAR; PG8_SCHED;
            PG8_LDB(B1, 1, 1); PG8_STAGE(PG8_SB(1, 0), b3, voffB);
            PG8_BAR; PG8_WAIT_L(0); PG8_MMA(0, 1, At, B1); PG8_BAR;
            PG8_LDA(At, 1, 1); PG8_STAGE(PG8_SA(1, 0), a3, voffA);
            PG8_BAR; PG8_WAIT_L(0); PG8_MMA(1, 0, At, B0); PG8_BAR; PG8_SCHED;
            PG8_STAGE(PG8_SB(1, 1), b3 + hstep, voffB);
            PG8_WAIT_V(6); PG8_BAR; PG8_MMA(1, 1, At, B1); PG8_BAR;
            }
        }
        if constexpr (ALIGN_EPI) { if (wr == 0) PG8_BAR; }
        if constexpr (!Epi::AFTER_DRAIN) { E(acc, cur, wr, wc, fr, fq); S.done(cur); }
        if (!has_next) break;
#pragma unroll
        for (int a = 0; a < 2; ++a)
#pragma unroll
            for (int b = 0; b < 2; ++b)
#pragma unroll
                for (int m = 0; m < 4; ++m)
#pragma unroll
                    for (int n = 0; n < 2; ++n) acc[a][b][m][n] = (f32x4){0.f, 0.f, 0.f, 0.f};
        cur = nxt; cA = nA; cB = nB; ++ui;
        if constexpr (ALIGN_EPI) { if (wr == 1) PG8_BAR; }
    }
    PG8_WAIT_V(0);
    if constexpr (!ALIGN_EPI) { if (wr == 0) PG8_BAR; }
    PG8_BAR;
    if constexpr (Epi::AFTER_DRAIN) { E.fused(acc, cur, wr, wc, fr, fq, lds, wid, lane); S.done(cur); }
#undef PG8_SA
#undef PG8_SB
#undef PG8_STAGE
#undef PG8_LDA
#undef PG8_LDB
#undef PG8_MMA
#undef PG8_WAIT_V
#undef PG8_WAIT_L
#undef PG8_BAR
#undef PG8_SCHED
}
}
#define XB_TMO      128
#define XB_XCNT(j)  (256  + 64 * (j))
#define XB_XSUB(j)  (1280 + 64 * (j))
#define XB_XGEN(j)  (2304 + 64 * (j))
#define XB_TOP      3328
#define XB_TOPGEN   3392
#define XCD_BAR_WORDS 3456
#define XB_SPIN_CAP (1u << 18)
#define LAS __attribute__((address_space(3)))

__device__ __forceinline__ unsigned xb_ld(unsigned* p)              { return __hip_atomic_load(p, __ATOMIC_RELAXED, __HIP_MEMORY_SCOPE_AGENT); }
__device__ __forceinline__ unsigned xb_add(unsigned* p, unsigned v) { return __hip_atomic_fetch_add(p, v, __ATOMIC_RELAXED, __HIP_MEMORY_SCOPE_AGENT); }
__device__ __forceinline__ unsigned xb_xcc_id() { return (unsigned)__builtin_amdgcn_s_getreg((3 << 11) | 20) & 0xFu; }
#define XB_SPIN(cond, bar) do { unsigned _sp = 0; while (cond) { __builtin_amdgcn_s_sleep(1); \
    if ((++_sp & 255u) == 0u) { if (xb_ld(&(bar)[XB_TMO])) break; if (_sp > XB_SPIN_CAP) { atomicAdd(&(bar)[XB_TMO], 1u); break; } } } } while (0)

struct XcdBarrier {
    unsigned* bar; unsigned x;
    volatile LAS unsigned* st;
};

__device__ __forceinline__ XcdBarrier xcd_barrier_post(unsigned* bar, volatile LAS unsigned* st) {
    XcdBarrier b; b.bar = bar; b.x = xb_xcc_id(); b.st = st;
    if (threadIdx.x == 0) (void)xb_add(&bar[XB_XCNT(b.x)], 1u);
    return b;
}
__device__ __forceinline__ void xcd_barrier_complete(unsigned* bar, unsigned x, unsigned& nloc, unsigned& nx) {
    const unsigned G = gridDim.x * gridDim.y * gridDim.z;
    unsigned sum, cnt, mine, sp = 0u;
    for (;;) {
        sum = 0u; cnt = 0u; mine = 0u;
#pragma unroll
        for (unsigned j = 0; j < 16; ++j) { const unsigned c = xb_ld(&bar[XB_XCNT(j)]); sum += c; cnt += (c > 0u) ? 1u : 0u; mine = (j == x) ? c : mine; }
        if (sum == G) break;
        __builtin_amdgcn_s_sleep(1);
        if ((++sp & 255u) == 0u) { if (xb_ld(&bar[XB_TMO])) break; if (sp > XB_SPIN_CAP) { atomicAdd(&bar[XB_TMO], 1u); break; } }
    }
    nloc = mine > 0u ? mine : 1u; nx = cnt > 0u ? cnt : 1u;
}

__device__ __forceinline__ void xcd_barrier(const XcdBarrier& b) {
    asm volatile("s_waitcnt vmcnt(0)" ::: "memory");
    __syncthreads();
    if (threadIdx.x == 0) {
        unsigned* bar = b.bar;
        __builtin_amdgcn_s_waitcnt(0);
        const unsigned bx = xb_xcc_id();
        unsigned nloc = b.st[0], nx = b.st[1];
        if (nloc == 0u) { xcd_barrier_complete(bar, bx, nloc, nx); b.st[0] = nloc; b.st[1] = nx; }
        const unsigned old = xb_add(&bar[XB_XSUB(bx)], 1u);
        const unsigned gen = old / nloc;
        if (old + 1u == (gen + 1u) * nloc) {
            __builtin_amdgcn_fence(__ATOMIC_RELEASE, "agent");
            asm volatile("s_waitcnt vmcnt(0)" ::: "memory");
            const unsigned og = xb_add(&bar[XB_TOP], 1u);
            const unsigned tg = og / nx;
            if (og + 1u == (tg + 1u) * nx) xb_add(&bar[XB_TOPGEN], 1u);
            else XB_SPIN(xb_ld(&bar[XB_TOPGEN]) == tg, bar);
            __builtin_amdgcn_fence(__ATOMIC_ACQUIRE, "agent");
            xb_add(&bar[XB_XGEN(bx)], 1u);
            asm volatile("s_waitcnt vmcnt(0)" ::: "memory");
        } else {
            XB_SPIN(xb_ld(&bar[XB_XGEN(bx)]) == gen, bar);
            __builtin_amdgcn_fence(__ATOMIC_ACQUIRE, "agent");
            asm volatile("s_waitcnt vmcnt(0)" ::: "memory");
        }
    }
    __syncthreads();
}

struct Params {
    const float* x; const float* p; const int* pos;
    const float *w_in, *w_a, *w_b, *w_out, *lbraw, *hnorm_g, *ikn_g, *ikn_b, *lnm_g, *lnm_b, *w_fg, *w_fu, *w_fd, *lnf_g, *lnf_b, *w_pg, *w_pp, *lnp_g, *lnp_b;
    float* out; unsigned char* ws;
    double invf_h[64]; double invf_i[32];
    int ph_lo, ph_hi;
};
typedef const __attribute__((address_space(4))) Params* KP;
__device__ __forceinline__ KP kparams() { KP p = (KP)__builtin_amdgcn_kernarg_segment_ptr(); asm volatile("" : "+s"(p)); return p; }
constexpr int NPH_LAYER = 14, NPH = DEPTH * NPH_LAYER;
constexpr int LDS_BYTES = 131072 + 1024;
constexpr int MISC_OFF = 131072;

__device__ __forceinline__ int wsrc_col_in(int n) {
    const int tile = n >> 8, t = n & 255;
    if (tile < 16) return n;
    if (tile < 24) { const int bj = t >> 7, u = t & 127, head = u >> 6, i = u & 63; return tile * 256 + 128 * head + 64 * bj + i; }
    if (tile < 28) return n;
    if (tile < 32) { const int bj = t >> 7, u = t & 127, head = u >> 5, i = u & 31; return tile * 256 + 64 * head + 32 * bj + i; }
    if (tile < 40) return 8272 + (n - 32 * 256);
    if (tile < 48) return 10320 + (n - 40 * 256);
    return t < 80 ? 8192 + t : -1;
}
constexpr int WC_LD = 144;
template <int KIND>
__device__ __forceinline__ void wconv_wave_tile(const float* src, const float* src2, int nsrc, int K, bf16_t* dst, int n0, int k0, int lane, LAS unsigned char* img) {
    const int n = n0 + lane; int c; const float* s = src;
    if (KIND == 0) c = n;
    else if (KIND == 1) c = wsrc_col_in(n);
    else { const int tl = n >> 8, t = n & 255; c = tl * 128 + (t & 127); if (t >= 128) s = src2; }
    float f[64];
    const float* sp = s + (size_t)k0 * nsrc + (c >= 0 ? c : 0);
#pragma unroll
    for (int kk = 0; kk < 64; ++kk) f[kk] = sp[(size_t)kk * nsrc];
#pragma unroll
    for (int i = 0; i < 8; ++i) { pg8::u32x4 w;
        w.x = pg8::cvt_pk_bf16(f[8 * i], f[8 * i + 1]); w.y = pg8::cvt_pk_bf16(f[8 * i + 2], f[8 * i + 3]); w.z = pg8::cvt_pk_bf16(f[8 * i + 4], f[8 * i + 5]); w.w = pg8::cvt_pk_bf16(f[8 * i + 6], f[8 * i + 7]);
        if (c < 0) w = (pg8::u32x4){0u, 0u, 0u, 0u};
        *(LAS pg8::u32x4*)(img + lane * WC_LD + 16 * i) = w; }
#pragma unroll
    for (int i = 0; i < 8; ++i) { const int p = lane + 64 * i, row = p >> 3, seg = p & 7;
        const pg8::u32x4 w = *(const LAS pg8::u32x4*)(img + row * WC_LD + 16 * seg);
        *(pg8::u32x4*)(dst + (size_t)(n0 + row) * K + k0 + 8 * seg) = w; }
}
template <int KIND>
__device__ __forceinline__ void wconv_job(const float* src, const float* src2, int nsrc, int K, bf16_t* dst, int ndst, int W, int NWV, int lane, LAS unsigned char* img, int& tcount) {
    const int kt = K / 64, ntiles = (ndst / 64) * kt;
    const int nb = ndst / 64; int first = (W - tcount % NWV + NWV) % NWV;
    for (int t = first; t < ntiles; t += NWV) wconv_wave_tile<KIND>(src, src2, nsrc, K, dst, (t % nb) * 64, (t / nb) * 64, lane, img);
    tcount += ntiles;
}
__device__ __forceinline__ void phase_wconv(KP P, int layer, LAS unsigned char* lds) {
    unsigned char* ws = as_global(P->ws); int tc = 0;
    const int tid0 = tid_(), lane = tid0 & 63, wv0 = __builtin_amdgcn_readfirstlane(tid0 >> 6), W = bid_() * 8 + wv0, NWV = nblk_() * 8;
    LAS unsigned char* img = lds + wv0 * (64 * WC_LD);
    wconv_job<1>(as_global(P->w_in) + (size_t)layer * DM * INW, nullptr, INW, DM, (bf16_t*)(ws + WS_WIN), INP, W, NWV, lane, img, tc);
    wconv_job<0>(as_global(P->w_a) + (size_t)layer * AW * DM, nullptr, DM, AW, (bf16_t*)(ws + WS_WA), DM, W, NWV, lane, img, tc);
    wconv_job<0>(as_global(P->w_b) + (size_t)layer * BW * DM, nullptr, DM, BW, (bf16_t*)(ws + WS_WB), DM, W, NWV, lane, img, tc);
    wconv_job<0>(as_global(P->w_out) + (size_t)layer * DM * DM, nullptr, DM, DM, (bf16_t*)(ws + WS_WO), DM, W, NWV, lane, img, tc);
    wconv_job<2>(as_global(P->w_fg) + (size_t)layer * DM * DFF, as_global(P->w_fu) + (size_t)layer * DM * DFF, DFF, DM, (bf16_t*)(ws + WS_WGU), 2 * DFF, W, NWV, lane, img, tc);
    wconv_job<0>(as_global(P->w_fd) + (size_t)layer * DFF * DM, nullptr, DM, DFF, (bf16_t*)(ws + WS_WDN), DM, W, NWV, lane, img, tc);
    wconv_job<0>(as_global(P->w_pg) + (size_t)layer * DM * DM, nullptr, DM, DM, (bf16_t*)(ws + WS_WPG), DM, W, NWV, lane, img, tc);
    wconv_job<0>(as_global(P->w_pp) + (size_t)layer * PLE * DM, nullptr, DM, PLE, (bf16_t*)(ws + WS_WPP), DM, W, NWV, lane, img, tc);
    const float* ps = as_global(P->p) + (size_t)layer * TOK * PLE; bf16_t* pb = (bf16_t*)(ws + WS_PB);
    for (size_t i = ((size_t)bid_() * 512 + tid_()) * 8; i < (size_t)TOK * PLE; i += (size_t)nblk_() * 512 * 8)
        *(pg8::u32x4*)(pb + i) = pg8::pack8(*(const pg8::f32x4*)(ps + i), *(const pg8::f32x4*)(ps + i + 4));
}
__device__ __forceinline__ void phase_prologue(KP P) {
    unsigned char* ws = as_global(P->ws); const size_t gtid = (size_t)bid_() * 512 + tid_(), gsz = (size_t)nblk_() * 512;
    bf16_t* xb = (bf16_t*)(ws + WS_XB); const float* xin = as_global(P->x); const int* posg = as_global(P->pos); const float* lbr = as_global(P->lbraw);
    for (size_t i = gtid * 8; i < (size_t)TOK * DM; i += gsz * 8) *(pg8::u32x4*)(xb + i) = pg8::pack8(*(const pg8::f32x4*)(xin + i), *(const pg8::f32x4*)(xin + i + 4));
    float* ch = (float*)(ws + WS_COSH); float* sh = (float*)(ws + WS_SINH); float* ci = (float*)(ws + WS_COSI); float* si = (float*)(ws + WS_SINI);
    for (size_t i = gtid; i < (size_t)TOK * 64; i += gsz) { const int t = (int)(i >> 6), j = (int)(i & 63); const double rev = (double)posg[t] * P->invf_h[j]; const float fr = (float)(rev - rint(rev));
        ch[i] = __builtin_amdgcn_cosf(fr); sh[i] = __builtin_amdgcn_sinf(fr); }
    for (size_t i = gtid; i < (size_t)TOK * 32; i += gsz) { const int t = (int)(i >> 5), j = (int)(i & 31); const double rev = (double)posg[t] * P->invf_i[j]; const float fr = (float)(rev - rint(rev));
        ci[i] = __builtin_amdgcn_cosf(fr); si[i] = __builtin_amdgcn_sinf(fr); }
    float* lb = (float*)(ws + WS_LB);
    for (size_t c = gtid; c < 1024; c += gsz) { float v[4], mx = -1e30f; for (int l = 0; l < 4; ++l) { v[l] = lbr[l * 1024 + c]; mx = fmaxf(mx, v[l]); }
        float s = 0.f; for (int l = 0; l < 4; ++l) { v[l] = expf(v[l] - mx); s += v[l]; }
        float cum = 0.f; const float inv = 1.0f / s; for (int l = 0; l < 4; ++l) { cum += v[l] * inv; lb[l * 1024 + c] = cum - v[0] * inv; } }
}
__device__ __forceinline__ void phase_ln(const float* XP, float* OUT, bf16_t* XB, float* ST, const float* g, const float* b) {
    const int tid = tid_(), wave = __builtin_amdgcn_readfirstlane(tid >> 6), lane = tid & 63, nb16 = nblk_() * 16;
    for (int row0 = bid_() * 16 + 2 * wave; row0 < TOK; row0 += nb16) {
        pg8::f32x4 v[2][8]; float s[2] = {0.f, 0.f};
#pragma unroll
        for (int rr = 0; rr < 2; ++rr)
#pragma unroll
            for (int c = 0; c < 8; ++c) v[rr][c] = *(const pg8::f32x4*)(XP + (size_t)(row0 + rr) * DM + c * 256 + lane * 4);
#pragma unroll
        for (int rr = 0; rr < 2; ++rr) {
#pragma unroll
            for (int c = 0; c < 8; ++c) s[rr] += (v[rr][c][0] + v[rr][c][1]) + (v[rr][c][2] + v[rr][c][3]);
#pragma unroll
            for (int o = 32; o >= 1; o >>= 1) s[rr] += __shfl_xor(s[rr], o); }
#pragma unroll
        for (int rr = 0; rr < 2; ++rr) { const int row = row0 + rr;
            const float mean = s[rr] * (1.0f / DM); float q = 0.f;
#pragma unroll
            for (int c = 0; c < 8; ++c) { v[rr][c] = v[rr][c] - mean; q += (v[rr][c][0] * v[rr][c][0] + v[rr][c][1] * v[rr][c][1]) + (v[rr][c][2] * v[rr][c][2] + v[rr][c][3] * v[rr][c][3]); }
#pragma unroll
            for (int o = 32; o >= 1; o >>= 1) q += __shfl_xor(q, o);
            const float rstd = 1.0f / sqrtf(q * (1.0f / DM) + LN_EPS);
            if (lane == 0) { pg8::f32x2 s2; s2[0] = mean; s2[1] = rstd; *(pg8::f32x2*)(ST + 2 * (size_t)row) = s2; }
#pragma unroll
            for (int c = 0; c < 8; ++c) { const int col = c * 256 + lane * 4; const pg8::f32x4 gg = *(const pg8::f32x4*)(g + col), bb = *(const pg8::f32x4*)(b + col);
                const pg8::f32x4 y = v[rr][c] * rstd * gg + bb; if (OUT) *(pg8::f32x4*)(OUT + (size_t)row * DM + col) = y;
                pg8::u32x2 w; w.x = pg8::cvt_pk_bf16(y[0], y[1]); w.y = pg8::cvt_pk_bf16(y[2], y[3]); *(pg8::u32x2*)(XB + (size_t)row * DM + col) = w; } }
    }
}
__device__ __forceinline__ void phase_ikprep(KP P, int layer) {
    unsigned char* ws = as_global(P->ws); const float* ikw = (const float*)(ws + WS_IKW); bf16_t* ki = (bf16_t*)(ws + WS_KI); float* wi = (float*)(ws + WS_WI);
    const float* ci = (const float*)(ws + WS_COSI); const float* si = (const float*)(ws + WS_SINI);
    const int tid = tid_(), wave = __builtin_amdgcn_readfirstlane(tid >> 6), lane = tid & 63, nb8 = nblk_() * 8;
    const float g = as_global(P->ikn_g)[layer * 64 + lane], b = as_global(P->ikn_b)[layer * 64 + lane];
    for (int t = bid_() * 8 + wave; t < TOK; t += nb8) {
        const float x = ikw[(size_t)t * 128 + lane]; float s = x;
#pragma unroll
        for (int o = 32; o >= 1; o >>= 1) s += __shfl_xor(s, o);
        const float mean = s * (1.0f / 64.0f), xc = x - mean; float q = xc * xc;
#pragma unroll
        for (int o = 32; o >= 1; o >>= 1) q += __shfl_xor(q, o);
        const float y = xc * (1.0f / sqrtf(q * (1.0f / 64.0f) + LN_EPS)) * g + b;
        const float other = __shfl_xor(y, 32); const int j = lane & 31; const float c = ci[(size_t)t * 32 + j], sn = si[(size_t)t * 32 + j];
        const float r = (lane < 32) ? (y * c - other * sn) : (other * sn + y * c);
        ki[(size_t)t * 64 + lane] = f2bf(r);
        if (lane < 16) wi[(size_t)t * 16 + lane] = ikw[(size_t)t * 128 + 64 + lane] * IDX_SCALE;
    }
}
typedef short bf16x8_t __attribute__((ext_vector_type(8)));
typedef short bf16x4_t __attribute__((ext_vector_type(4)));
typedef float f32x16_t __attribute__((ext_vector_type(16)));
constexpr int CUM_LD = 132;
constexpr int OPK_LD = 136;
constexpr int OPS_LD = 72;

__device__ __forceinline__ void hgrn_scan_load(const float* LF, int tok0, int h, int tid, float (&v)[16]) {
    const int k = tid & 127, qd = tid >> 7;
#pragma unroll
    for (int i = 0; i < 16; ++i) v[i] = LF[(size_t)(tok0 + qd * 16 + i) * 1024 + h * 128 + k];
}
__device__ __forceinline__ void hgrn_scan_cum(float (&v)[16], LAS float* cum, LAS float* tot, int tid) {
    const int k = tid & 127, qd = tid >> 7;
    float run = 0.f;
#pragma unroll
    for (int i = 0; i < 16; ++i) { run += v[i]; v[i] = run; }
    tot[qd * 128 + k] = run;
    __syncthreads();
    float off = 0.f;
#pragma unroll
    for (int q = 0; q < 3; ++q) off += (q < qd) ? tot[q * 128 + k] : 0.f;
#pragma unroll
    for (int i = 0; i < 16; ++i) cum[(qd * 16 + i) * CUM_LD + k] = v[i] + off;
    __syncthreads();
}

struct H1Pre { float lf[16]; unsigned ka[8], va[8]; };
__device__ __forceinline__ void h1_load(const bf16_t* KA, const bf16_t* VA, const float* LF, int unit, int tid, H1Pre& p) {
    const int c = unit & 63, h = (unit >> 6) & 7, b = unit >> 9, tok0 = b * SEQ + c * 64;
    hgrn_scan_load(LF, tok0, h, tid, p.lf);
#pragma unroll
    for (int it = 0; it < 8; ++it) { const int idx = tid + 512 * it, k = idx & 127, s = 2 * (idx >> 7); const size_t g0 = (size_t)(tok0 + s) * 1024 + h * 128 + k;
        p.ka[it] = (unsigned)KA[g0] | ((unsigned)KA[g0 + 1024] << 16); p.va[it] = (unsigned)VA[g0] | ((unsigned)VA[g0 + 1024] << 16); }
}
__device__ __forceinline__ void phase_hgrn_h1(KP P, LAS unsigned char* lds) {
    unsigned char* ws = as_global(P->ws);
    const bf16_t* KA = (const bf16_t*)(ws + WS_KA); const bf16_t* VA = (const bf16_t*)(ws + WS_VA); const float* LF = (const float*)(ws + WS_LF);
    bf16_t* LT = (bf16_t*)(ws + WS_LT); float* DEC = (float*)(ws + WS_DEC);
    const int tid = tid_(), lane = tid & 63, wave = __builtin_amdgcn_readfirstlane(tid >> 6), r = lane & 31, hh = lane >> 5, G = nblk_();
    LAS float* cum = (LAS float*)lds; LAS float* tot = cum + 64 * CUM_LD;
    LAS bf16_t* kdT = (LAS bf16_t*)(tot + 512); LAS bf16_t* vT = kdT + 128 * OPS_LD;
    constexpr int NU = NBATCH * AH * 64;
    H1Pre pre; int unit = bid_();
    if (unit < NU) h1_load(KA, VA, LF, unit, tid, pre);
    for (; unit < NU; unit += G) {
        hgrn_scan_cum(pre.lf, cum, tot, tid);
#pragma unroll
        for (int it = 0; it < 8; ++it) { const int idx = tid + 512 * it, k = idx & 127, sp = idx >> 7, s = 2 * sp;
            const float last = cum[63 * CUM_LD + k];
            const float k0 = __uint_as_float(pre.ka[it] << 16) * __expf(last - cum[s * CUM_LD + k]), k1 = __uint_as_float(pre.ka[it] & 0xffff0000u) * __expf(last - cum[(s + 1) * CUM_LD + k]);
            *(LAS unsigned*)(kdT + k * OPS_LD + s) = pg8::cvt_pk_bf16(k0, k1);
            *(LAS unsigned*)(vT + k * OPS_LD + s) = pre.va[it]; }
        if (tid < 128) DEC[(size_t)unit * 128 + tid] = __expf(cum[63 * CUM_LD + tid]);
        if (unit + G < NU) h1_load(KA, VA, LF, unit + G, tid, pre);
        __syncthreads();
        const int mb = wave >> 1, nb0 = (wave & 1) * 2;
        f32x16_t acc[2];
#pragma unroll
        for (int n = 0; n < 2; ++n)
#pragma unroll
            for (int i = 0; i < 16; ++i) acc[n][i] = 0.f;
#pragma unroll
        for (int ks = 0; ks < 4; ++ks) { const bf16x8_t a = *(const LAS bf16x8_t*)(kdT + (32 * mb + r) * OPS_LD + 16 * ks + 8 * hh);
#pragma unroll
            for (int n = 0; n < 2; ++n) { const bf16x8_t bb = *(const LAS bf16x8_t*)(vT + (32 * (nb0 + n) + r) * OPS_LD + 16 * ks + 8 * hh);
                acc[n] = __builtin_amdgcn_mfma_f32_32x32x16_bf16(a, bb, acc[n], 0, 0, 0); } }
#pragma unroll
        for (int n = 0; n < 2; ++n) { bf16_t* dst = LT + (size_t)unit * 16384 + (size_t)(32 * (nb0 + n) + r) * 128 + 32 * mb + 4 * hh;
#pragma unroll
            for (int g = 0; g < 4; ++g) { pg8::u32x2 o; o.x = pg8::cvt_pk_bf16(acc[n][4 * g], acc[n][4 * g + 1]); o.y = pg8::cvt_pk_bf16(acc[n][4 * g + 2], acc[n][4 * g + 3]); *(pg8::u32x2*)(dst + 8 * g) = o; } }
        __syncthreads();
    }
}

__device__ __forceinline__ void phase_hgrn_h2(KP P) {
    unsigned char* ws = as_global(P->ws);
    const bf16_t* LT = (const bf16_t*)(ws + WS_LT); const float* DEC = (const float*)(ws + WS_DEC); bf16_t* PT = (bf16_t*)(ws + WS_PT);
    const int tid = tid_(), G = nblk_();
    for (int oct = bid_() * 512 + tid; oct < NBATCH * AH * 2048; oct += G * 512) {
        const int bh = oct >> 11, rem = oct & 2047, v = rem >> 4, k0 = (rem & 15) * 8;
        const size_t e0 = (size_t)bh * 64 * 16384 + (size_t)v * 128 + k0; const size_t d0 = (size_t)bh * 64 * 128 + k0;
        pg8::f32x4 S0 = {0.f, 0.f, 0.f, 0.f}, S1 = {0.f, 0.f, 0.f, 0.f};
        for (int c0 = 0; c0 < 64; c0 += 4) { pg8::u32x4 Lc[4]; pg8::f32x4 Da[4], Db[4];
#pragma unroll
            for (int j = 0; j < 4; ++j) { Lc[j] = *(const pg8::u32x4*)(LT + e0 + (size_t)(c0 + j) * 16384); Da[j] = *(const pg8::f32x4*)(DEC + d0 + (size_t)(c0 + j) * 128); Db[j] = *(const pg8::f32x4*)(DEC + d0 + (size_t)(c0 + j) * 128 + 4); }
#pragma unroll
            for (int j = 0; j < 4; ++j) { *(pg8::u32x4*)(PT + e0 + (size_t)(c0 + j) * 16384) = pg8::pack8(S0, S1);
                pg8::f32x4 l0, l1; pg8::unpack8(Lc[j], l0, l1); S0 = Da[j] * S0 + l0; S1 = Db[j] * S1 + l1; } }
    }
}

struct H3Pre { float lf[16]; unsigned qw[8], kw[8], vv[8]; bf16x8_t pt[8]; pg8::u32x2 ga[4]; };
__device__ __forceinline__ void h3_load(const bf16_t* QA, const bf16_t* KA, const bf16_t* VA, const bf16_t* GA, const float* LF, const bf16_t* PT, int unit, int tid, H3Pre& p) {
    const int c = unit & 63, h = (unit >> 6) & 7, b = unit >> 9, tok0 = b * SEQ + c * 64;
    const int lane = tid & 63, wave = __builtin_amdgcn_readfirstlane(tid >> 6), r = lane & 31, hh = lane >> 5, mb = wave >> 1, tb = wave & 1;
    hgrn_scan_load(LF, tok0, h, tid, p.lf);
#pragma unroll
    for (int it = 0; it < 8; ++it) { const int idx = tid + 512 * it, kp = (idx & 63) * 2, t = idx >> 6; const size_t g0 = (size_t)(tok0 + t) * 1024 + h * 128 + kp;
        p.qw[it] = *(const unsigned*)(QA + g0); p.kw[it] = *(const unsigned*)(KA + g0); }
#pragma unroll
    for (int it = 0; it < 8; ++it) { const int idx = tid + 512 * it, v = idx & 127, s = 2 * (idx >> 7); const size_t g0 = (size_t)(tok0 + s) * 1024 + h * 128 + v;
        p.vv[it] = (unsigned)VA[g0] | ((unsigned)VA[g0 + 1024] << 16); }
    const bf16_t* prow = PT + (size_t)unit * 16384 + (size_t)(32 * mb + r) * 128 + 8 * hh;
#pragma unroll
    for (int k8 = 0; k8 < 8; ++k8) p.pt[k8] = *(const bf16x8_t*)(prow + 16 * k8);
    const size_t orow = (size_t)(tok0 + 32 * tb + r) * 1024 + h * 128;
#pragma unroll
    for (int g = 0; g < 4; ++g) p.ga[g] = *(const pg8::u32x2*)(GA + orow + 32 * mb + 8 * g + 4 * hh);
}
__device__ __forceinline__ void phase_hgrn_h3(KP P, int layer, LAS unsigned char* lds) {
    unsigned char* ws = as_global(P->ws);
    const bf16_t* QA = (const bf16_t*)(ws + WS_QA); const bf16_t* KA = (const bf16_t*)(ws + WS_KA); const bf16_t* VA = (const bf16_t*)(ws + WS_VA); const bf16_t* GA = (const bf16_t*)(ws + WS_GA);
    const float* LF = (const float*)(ws + WS_LF); const bf16_t* PT = (const bf16_t*)(ws + WS_PT); bf16_t* YA = (bf16_t*)(ws + WS_YA);
    const float* ng = as_global(P->hnorm_g) + layer * 128;
    const int tid = tid_(), lane = tid & 63, wave = __builtin_amdgcn_readfirstlane(tid >> 6), r = lane & 31, hh = lane >> 5, G = nblk_();
    LAS float* cum = (LAS float*)lds; LAS float* tot = cum + 64 * CUM_LD; LAS float* ssq = tot + 512;
    LAS bf16_t* qd = (LAS bf16_t*)(ssq + 256); LAS bf16_t* qs = qd + 64 * OPK_LD; LAS bf16_t* ks = qs + 64 * OPK_LD; LAS bf16_t* vT = ks + 64 * OPK_LD;
    constexpr int NU = NBATCH * AH * 64;
    const int mb = wave >> 1, tb = wave & 1;
    H3Pre pre; int unit = bid_();
    if (unit < NU) h3_load(QA, KA, VA, GA, LF, PT, unit, tid, pre);
    for (; unit < NU; unit += G) {
        const int c = unit & 63, h = (unit >> 6) & 7, b = unit >> 9, tok0 = b * SEQ + c * 64;
#ifdef H3_DUP_SCAN
        { float tmp[16];
#pragma unroll
          for (int i = 0; i < 16; ++i) tmp[i] = pre.lf[i];
          hgrn_scan_cum(tmp, cum, tot, tid); }
#endif
        hgrn_scan_cum(pre.lf, cum, tot, tid);
#ifdef H3_DUP_BUILD
        for (int rep_b = 0; rep_b < 2; ++rep_b) {
#else
        {
#endif
#pragma unroll
        for (int it = 0; it < 8; ++it) { const int idx = tid + 512 * it, kp = (idx & 63) * 2, t = idx >> 6;
            const unsigned qw = pre.qw[it], kw = pre.kw[it];
            const float c0 = cum[t * CUM_LD + kp], c1 = cum[t * CUM_LD + kp + 1], r0 = cum[31 * CUM_LD + kp], r1 = cum[31 * CUM_LD + kp + 1];
            const float q0 = __uint_as_float(qw << 16), q1 = __uint_as_float(qw & 0xffff0000u), k0 = __uint_as_float(kw << 16), k1 = __uint_as_float(kw & 0xffff0000u);
            *(LAS unsigned*)(qd + t * OPK_LD + kp) = pg8::cvt_pk_bf16(q0 * __expf(c0), q1 * __expf(c1));
            *(LAS unsigned*)(qs + t * OPK_LD + kp) = pg8::cvt_pk_bf16(q0 * __expf(c0 - r0), q1 * __expf(c1 - r1));
            *(LAS unsigned*)(ks + t * OPK_LD + kp) = pg8::cvt_pk_bf16(k0 * __expf(r0 - c0), k1 * __expf(r1 - c1)); }
#pragma unroll
        for (int it = 0; it < 8; ++it) { const int idx = tid + 512 * it, v = idx & 127, s = 2 * (idx >> 7); *(LAS unsigned*)(vT + v * OPS_LD + s) = pre.vv[it]; }
        }
        bf16x8_t ptc[8]; pg8::u32x2 gac[4];
#pragma unroll
        for (int k8 = 0; k8 < 8; ++k8) ptc[k8] = pre.pt[k8];
#pragma unroll
        for (int g = 0; g < 4; ++g) gac[g] = pre.ga[g];
        if (unit + G < NU) h3_load(QA, KA, VA, GA, LF, PT, unit + G, tid, pre);
        __syncthreads();
        f32x16_t acc;
#ifdef H3_DUP_MMA
        for (int rep_m = 0; rep_m < 2; ++rep_m) {
#else
        {
#endif
#pragma unroll
        for (int i = 0; i < 16; ++i) acc[i] = 0.f;
#pragma unroll
        for (int k8 = 0; k8 < 8; ++k8) { const bf16x8_t bq = *(const LAS bf16x8_t*)(qd + (32 * tb + r) * OPK_LD + 16 * k8 + 8 * hh);
            acc = __builtin_amdgcn_mfma_f32_32x32x16_bf16(ptc[k8], bq, acc, 0, 0, 0); }
#pragma unroll
        for (int sb = 0; sb < 2; ++sb) if (sb <= tb) {
            f32x16_t sc;
#pragma unroll
            for (int i = 0; i < 16; ++i) sc[i] = 0.f;
#pragma unroll
            for (int k8 = 0; k8 < 8; ++k8) { const bf16x8_t a = *(const LAS bf16x8_t*)(ks + (32 * sb + r) * OPK_LD + 16 * k8 + 8 * hh); const bf16x8_t bq = *(const LAS bf16x8_t*)(qs + (32 * tb + r) * OPK_LD + 16 * k8 + 8 * hh);
                sc = __builtin_amdgcn_mfma_f32_32x32x16_bf16(a, bq, sc, 0, 0, 0); }
            if (sb == tb) {
#pragma unroll
                for (int i = 0; i < 16; ++i) { const int sl = 8 * (i >> 2) + 4 * hh + (i & 3); sc[i] = (sl <= r) ? sc[i] : 0.f; } }
#pragma unroll
            for (int u = 0; u < 2; ++u) {
                pg8::u32x4 pw; pw.x = pg8::cvt_pk_bf16(sc[8 * u], sc[8 * u + 1]); pw.y = pg8::cvt_pk_bf16(sc[8 * u + 2], sc[8 * u + 3]); pw.z = pg8::cvt_pk_bf16(sc[8 * u + 4], sc[8 * u + 5]); pw.w = pg8::cvt_pk_bf16(sc[8 * u + 6], sc[8 * u + 7]);
                const bf16x8_t pb = __builtin_bit_cast(bf16x8_t, pw);
                const LAS bf16_t* vrow = vT + (32 * mb + r) * OPS_LD + 32 * sb + 16 * u + 4 * hh;
                const bf16x4_t lo = *(const LAS bf16x4_t*)vrow, hi4 = *(const LAS bf16x4_t*)(vrow + 8);
                const bf16x8_t va = {lo[0], lo[1], lo[2], lo[3], hi4[0], hi4[1], hi4[2], hi4[3]};
                acc = __builtin_amdgcn_mfma_f32_32x32x16_bf16(va, pb, acc, 0, 0, 0); }
        }
        }
        float ss = 0.f;
#pragma unroll
        for (int i = 0; i < 16; ++i) ss += acc[i] * acc[i];
        ss += __shfl_xor(ss, 32);
        if (hh == 0) ssq[mb * 64 + 32 * tb + r] = ss;
        __syncthreads();
        const int t = 32 * tb + r;
        const float tot2 = (ssq[t] + ssq[64 + t]) + (ssq[128 + t] + ssq[192 + t]);
        const float rs = 1.0f / sqrtf(tot2 * (1.0f / 128.0f) + RMS_EPS);
        const size_t orow = (size_t)(tok0 + t) * 1024 + h * 128;
#pragma unroll
        for (int g = 0; g < 4; ++g) { const int v0 = 32 * mb + 8 * g + 4 * hh;
            const pg8::u32x2 gw = gac[g]; const pg8::f32x4 nv = *(const pg8::f32x4*)(ng + v0);
            const float y0 = acc[4 * g] * rs * nv[0] * __uint_as_float(gw.x << 16), y1 = acc[4 * g + 1] * rs * nv[1] * __uint_as_float(gw.x & 0xffff0000u);
            const float y2 = acc[4 * g + 2] * rs * nv[2] * __uint_as_float(gw.y << 16), y3 = acc[4 * g + 3] * rs * nv[3] * __uint_as_float(gw.y & 0xffff0000u);
            pg8::u32x2 w; w.x = pg8::cvt_pk_bf16(y0, y1); w.y = pg8::cvt_pk_bf16(y2, y3); *(pg8::u32x2*)(YA + orow + v0) = w; }
        __syncthreads();
    }
}
namespace at {
constexpr int D = 128, NW = 8, QBLK = 32, KVBLK = 64, LDQ = 1024, LDK = 1024;
constexpr float SCALE = ATTN_SCALE, THR = 8.f;
constexpr size_t SHM_V = KVBLK * D * 2, SHM_K = KVBLK * D * 2, SHM_ATTN = 2 * SHM_V + 2 * SHM_K + NW * 64 * 4;
using bf16x8 = __attribute__((ext_vector_type(8))) short;
using s16x4  = __attribute__((ext_vector_type(4))) short;
using f32x16 = __attribute__((ext_vector_type(16))) float;
using u32x4  = __attribute__((ext_vector_type(4))) unsigned;
#define AT_KSWZ(row, colB) ((row) * 256 + ((colB) ^ (((row) & 7) << 4)))
#define AT_SBAR() __builtin_amdgcn_sched_barrier(0)
__device__ __forceinline__ int crow(int r, int hi) { return (r & 3) + 8 * (r >> 2) + 4 * hi; }
__device__ __forceinline__ unsigned cvtpk(float lo, float hi) { return pg8::cvt_pk_bf16(lo, hi); }

__device__ __forceinline__ void partialSM(f32x16& p0, f32x16& p1, float& m_reg, float& mn, float& alpha) {
  constexpr float C = SCALE * 1.4426950408889634f;
  float pmax = p0[0];
#pragma unroll
  for (int r = 1; r < 16; ++r) pmax = fmaxf(pmax, p0[r]);
#pragma unroll
  for (int r = 0; r < 16; ++r) pmax = fmaxf(pmax, p1[r]);
  { auto rr = __builtin_amdgcn_permlane32_swap(__float_as_uint(pmax), __float_as_uint(pmax), false, false);
    pmax = fmaxf(__uint_as_float(rr[0]), __uint_as_float(rr[1])); }
  if (__builtin_expect(__all(pmax - m_reg <= THR / SCALE), 1)) { mn = m_reg; alpha = 1.f; }
  else { mn = fmaxf(m_reg, pmax); alpha = __builtin_amdgcn_exp2f((m_reg - mn) * C); m_reg = mn; }
  float mnC = -mn * C;
#pragma unroll
  for (int r = 0; r < 16; ++r) p0[r] = fmaf(p0[r], C, mnC);
#pragma unroll
  for (int r = 0; r < 16; ++r) p1[r] = fmaf(p1[r], C, mnC);
#pragma unroll
  for (int r = 0; r < 16; ++r) p0[r] = __builtin_amdgcn_exp2f(p0[r]);
}
__device__ __forceinline__ void finishSM(f32x16& p0, f32x16& p1, float alpha, float& l_reg, int mlo, int mhi, bf16x8& pa0, bf16x8& pa1, bf16x8& pa2, bf16x8& pa3) {
#pragma unroll
  for (int r = 0; r < 16; ++r) p1[r] = __builtin_amdgcn_exp2f(p1[r]);
#pragma unroll
  for (int r = 0; r < 16; ++r) { const int bit = (r & 3) + 8 * (r >> 2);
    p0[r] = __uint_as_float(__float_as_uint(p0[r]) & (unsigned)__builtin_amdgcn_sbfe(mlo, bit, 1));
    p1[r] = __uint_as_float(__float_as_uint(p1[r]) & (unsigned)__builtin_amdgcn_sbfe(mhi, bit, 1)); }
  float ps = 0;
#pragma unroll
  for (int r = 0; r < 16; ++r) ps += p0[r];
#pragma unroll
  for (int r = 0; r < 16; ++r) ps += p1[r];
  { auto rr = __builtin_amdgcn_permlane32_swap(__float_as_uint(ps), __float_as_uint(ps), false, false);
    ps = __uint_as_float(rr[0]) + __uint_as_float(rr[1]); }
  l_reg = l_reg * alpha + ps;
#define AT_PK4(P, BASE, OUT) do { unsigned a0 = cvtpk(P[BASE + 0], P[BASE + 1]), a1 = cvtpk(P[BASE + 2], P[BASE + 3]);   \
    unsigned b0 = cvtpk(P[BASE + 4], P[BASE + 5]), b1 = cvtpk(P[BASE + 6], P[BASE + 7]);                              \
    auto r0 = __builtin_amdgcn_permlane32_swap(a0, b0, false, false); auto r1 = __builtin_amdgcn_permlane32_swap(a1, b1, false, false); \
    u32x4 w = {r0[0], r1[0], r0[1], r1[1]}; OUT = *reinterpret_cast<bf16x8*>(&w); } while (0)
  AT_PK4(p0, 0, pa0); AT_PK4(p0, 8, pa1); AT_PK4(p1, 0, pa2); AT_PK4(p1, 8, pa3);
#undef AT_PK4
}
__device__ __forceinline__ void qkt(f32x16& p0, f32x16& p1, const LAS char* Ks, const bf16x8* qr, int r32, int hi) {
  p0 = f32x16{}; p1 = f32x16{};
#pragma unroll
  for (int d0 = 0; d0 < 8; ++d0) { int cb = (d0 * 16 + hi * 8) * 2;
    bf16x8 b0 = *reinterpret_cast<const LAS bf16x8*>(Ks + AT_KSWZ(r32, cb));
    bf16x8 b1 = *reinterpret_cast<const LAS bf16x8*>(Ks + AT_KSWZ(32 + r32, cb));
    p0 = __builtin_amdgcn_mfma_f32_32x32x16_bf16(b0, qr[d0], p0, 0, 0, 0);
    p1 = __builtin_amdgcn_mfma_f32_32x32x16_bf16(b1, qr[d0], p1, 0, 0, 0); }
}
__device__ __forceinline__ int v_st(int k, int c) { const int kk = (k & ~0xC) | ((k & 4) << 1) | ((k & 8) >> 1); return ((kk >> 3) * 4 + (c >> 5)) * 512 + ((kk & 7) * 32 + (c & 31)) * 2; }
__device__ __forceinline__ int v_rd_base(int lane) { return ((lane & 3) << 3) | (((lane >> 2) & 3) << 6) | (((lane >> 4) & 1) << 5) | (((lane >> 5) & 1) << 8); }
constexpr int v_rd_off(int d0, int ks, int half) { return d0 * 512 + ks * 4096 + half * 2048; }
template <int OFF> __device__ __forceinline__ s16x4 tr_read(int vb) {
  s16x4 r; asm volatile("ds_read_b64_tr_b16 %0, %1 offset:%2" : "=&v"(r) : "v"(vb), "i"(OFF) : "memory"); return r;
}
template <int D0> __device__ __forceinline__ void pv_one(f32x16& od, int vb, bf16x8 pa0, bf16x8 pa1, bf16x8 pa2, bf16x8 pa3) {
  const s16x4 l0 = tr_read<v_rd_off(D0, 0, 0)>(vb), h0 = tr_read<v_rd_off(D0, 0, 1)>(vb), l1 = tr_read<v_rd_off(D0, 1, 0)>(vb), h1 = tr_read<v_rd_off(D0, 1, 1)>(vb);
  const s16x4 l2 = tr_read<v_rd_off(D0, 2, 0)>(vb), h2 = tr_read<v_rd_off(D0, 2, 1)>(vb), l3 = tr_read<v_rd_off(D0, 3, 0)>(vb), h3 = tr_read<v_rd_off(D0, 3, 1)>(vb);
  asm volatile("s_waitcnt lgkmcnt(0)" ::: "memory"); AT_SBAR();
#define AT_PK(L_, H_) (bf16x8){L_[0], L_[1], L_[2], L_[3], H_[0], H_[1], H_[2], H_[3]}
  od = __builtin_amdgcn_mfma_f32_32x32x16_bf16(pa0, AT_PK(l0, h0), od, 0, 0, 0);
  od = __builtin_amdgcn_mfma_f32_32x32x16_bf16(pa1, AT_PK(l1, h1), od, 0, 0, 0);
  od = __builtin_amdgcn_mfma_f32_32x32x16_bf16(pa2, AT_PK(l2, h2), od, 0, 0, 0);
  od = __builtin_amdgcn_mfma_f32_32x32x16_bf16(pa3, AT_PK(l3, h3), od, 0, 0, 0);
#undef AT_PK
}
__device__ __forceinline__ void pv_d0(f32x16* o, int vb, bf16x8 pa0, bf16x8 pa1, bf16x8 pa2, bf16x8 pa3) {
  pv_one<0>(o[0], vb, pa0, pa1, pa2, pa3); pv_one<1>(o[1], vb, pa0, pa1, pa2, pa3); pv_one<2>(o[2], vb, pa0, pa1, pa2, pa3); pv_one<3>(o[3], vb, pa0, pa1, pa2, pa3);
}

__device__ __forceinline__ void attn_masked_body(const bf16_t* __restrict__ Qb, const bf16_t* __restrict__ Kh, const bf16_t* __restrict__ Vh, const unsigned long long* __restrict__ Mq,
                                                 bf16_t* __restrict__ Ob, int seq, LAS char* lds, int tid) {
  const int wid = __builtin_amdgcn_readfirstlane(tid >> 6), lane = tid & 63, r32 = lane & 31, hi = lane >> 5;
  LAS char* V_lds = lds; LAS char* K_lds = lds + 2 * SHM_V;
  LAS float* wsf = (LAS float*)(lds + 2 * SHM_V + 2 * SHM_K) + wid * 64; LAS float* li_l = wsf; LAS float* al_l = wsf + 32;
  float m_reg = -1e30f, l_reg = 0; f32x16 o[4] = {}; bf16x8 qr[8];
  const bf16_t* Qw = Qb + (long)(wid * QBLK + r32) * LDQ + hi * 8;
#pragma unroll
  for (int d0 = 0; d0 < 8; ++d0) qr[d0] = *reinterpret_cast<const bf16x8*>(Qw + d0 * 16);
  const unsigned long long* mrow = Mq + (size_t)(wid * QBLK + r32) * 64;
  const int sr = tid >> 4, sc = (tid & 15) * 8, vst0 = v_st(sr, sc), vst1 = v_st(32 + sr, sc);
  const int vb0 = (int)(uintptr_t)V_lds + v_rd_base(lane);
  struct { bf16x8 vs0, vs1, ks0, ks1; } sr_[2];
#define AT_SLOAD(i, k0) do { sr_[i].vs0 = *reinterpret_cast<const bf16x8*>(&Vh[(long)((k0) + sr) * LDK + sc]); sr_[i].vs1 = *reinterpret_cast<const bf16x8*>(&Vh[(long)((k0) + 32 + sr) * LDK + sc]); \
    sr_[i].ks0 = *reinterpret_cast<const bf16x8*>(&Kh[(long)((k0) + sr) * LDK + sc]); sr_[i].ks1 = *reinterpret_cast<const bf16x8*>(&Kh[(long)((k0) + 32 + sr) * LDK + sc]); } while (0)
#define AT_SWRITE(b, i) do { *(LAS bf16x8*)(V_lds + (b) * SHM_V + vst0) = sr_[i].vs0;          \
    *(LAS bf16x8*)(V_lds + (b) * SHM_V + vst1) = sr_[i].vs1; int kc = sc * 2;               \
    *(LAS bf16x8*)(K_lds + (b) * SHM_K + AT_KSWZ(sr, kc)) = sr_[i].ks0;                       \
    *(LAS bf16x8*)(K_lds + (b) * SHM_K + AT_KSWZ(32 + sr, kc)) = sr_[i].ks1; } while (0)
#define AT_SWAIT() asm volatile("s_waitcnt vmcnt(4)" ::: "memory")
#define AT_RESC(a) do { if (__any((a) < 1.f)) { if (hi == 0) al_l[r32] = (a); asm volatile("s_waitcnt lgkmcnt(0)" ::: "memory"); \
    _Pragma("unroll") for (int d = 0; d < 4; ++d) _Pragma("unroll") for (int r = 0; r < 16; ++r) o[d][r] *= al_l[crow(r, hi)]; } } while (0)
#define AT_MLOAD(mw, j) do { const unsigned long long _w = mrow[(j)]; (mw##lo) = (int)((unsigned)_w >> (4 * hi)); (mw##hi) = (int)((unsigned)(_w >> 32) >> (4 * hi)); } while (0)
  f32x16 pA0, pA1, pB0, pB1; float mnA, mnB, alA, alB; bf16x8 pa0, pa1, pa2, pa3; const int NT = seq / KVBLK;
  int mAlo, mAhi, mBlo, mBhi;
  constexpr int SE = 0, SO = 1;
  AT_SLOAD(SE, 0); AT_MLOAD(mA, 0); asm volatile("s_waitcnt vmcnt(0)" ::: "memory"); AT_SWRITE(0, SE); __syncthreads();
  qkt(pA0, pA1, K_lds, qr, r32, hi); partialSM(pA0, pA1, m_reg, mnA, alA);
  AT_SLOAD(SO, KVBLK); if (2 < NT) AT_SLOAD(SE, 2 * KVBLK);
  AT_SWAIT(); AT_SWRITE(1, SO); __syncthreads();
  for (int j = 1; j + 1 < NT; j += 2) {
    AT_SBAR(); AT_MLOAD(mB, j); qkt(pB0, pB1, K_lds + SHM_K, qr, r32, hi);
    finishSM(pA0, pA1, alA, l_reg, mAlo, mAhi, pa0, pa1, pa2, pa3); AT_SBAR();
    AT_SLOAD(SO, (j + 2) * KVBLK); AT_SBAR();
    pv_d0(o, vb0, pa0, pa1, pa2, pa3); partialSM(pB0, pB1, m_reg, mnB, alB);
    __syncthreads(); AT_SWAIT(); AT_SWRITE(0, SE);
    AT_RESC(alB); __syncthreads();
    AT_SBAR(); AT_MLOAD(mA, j + 1); qkt(pA0, pA1, K_lds, qr, r32, hi);
    finishSM(pB0, pB1, alB, l_reg, mBlo, mBhi, pa0, pa1, pa2, pa3); AT_SBAR();
    if (j + 3 < NT) AT_SLOAD(SE, (j + 3) * KVBLK); AT_SBAR();
    pv_d0(o, vb0 + (int)SHM_V, pa0, pa1, pa2, pa3); partialSM(pA0, pA1, m_reg, mnA, alA);
    __syncthreads(); AT_SWAIT(); AT_SWRITE(1, SO);
    AT_RESC(alA); __syncthreads();
  }
  AT_SBAR(); AT_MLOAD(mB, NT - 1); qkt(pB0, pB1, K_lds + SHM_K, qr, r32, hi);
  finishSM(pA0, pA1, alA, l_reg, mAlo, mAhi, pa0, pa1, pa2, pa3); AT_SBAR();
  pv_d0(o, vb0, pa0, pa1, pa2, pa3); partialSM(pB0, pB1, m_reg, mnB, alB);
  __syncthreads(); AT_RESC(alB);
  finishSM(pB0, pB1, alB, l_reg, mBlo, mBhi, pa0, pa1, pa2, pa3); AT_SBAR();
  pv_d0(o, vb0 + (int)SHM_V, pa0, pa1, pa2, pa3);
  if (hi == 0) li_l[r32] = l_reg; asm volatile("s_waitcnt lgkmcnt(0)" ::: "memory");
  float rli[16];
#pragma unroll
  for (int r = 0; r < 16; ++r) rli[r] = __builtin_amdgcn_rcpf(li_l[crow(r, hi)]);
  bf16_t* Ow = Ob + (long)(wid * QBLK) * LDQ;
#pragma unroll
  for (int r = 0; r < 16; ++r) { const int orow = crow(r, hi);
#pragma unroll
    for (int d0 = 0; d0 < 4; ++d0) Ow[(long)orow * LDQ + d0 * 32 + r32] = f2bf(o[d0][r] * rli[r]); }
#undef AT_SLOAD
#undef AT_SWRITE
#undef AT_SWAIT
#undef AT_RESC
#undef AT_MLOAD
}
}

__device__ __forceinline__ void phase_attn(KP P, LAS unsigned char* lds) {
    unsigned char* ws = as_global(P->ws);
    const bf16_t* QB = (const bf16_t*)(ws + WS_QB); const bf16_t* KB = (const bf16_t*)(ws + WS_KB); const bf16_t* VB = (const bf16_t*)(ws + WS_VB);
    const unsigned long long* MASK = (const unsigned long long*)(ws + WS_MASK); bf16_t* YB = (bf16_t*)(ws + WS_YB);
    const int G = nblk_();
    for (int p = bid_(); p < 256; p += G) {
        const int bh = p >> 3, b = bh >> 3, h = bh & 7, x = p & 7;
#pragma unroll 1
        for (int half = 0; half < 2; ++half) { const int qb = half ? 15 - x : x; const size_t row0 = (size_t)b * SEQ + (size_t)qb * 256;
            at::attn_masked_body(QB + row0 * 1024 + h * 128, KB + (size_t)b * SEQ * 1024 + h * 128, VB + (size_t)b * SEQ * 1024 + h * 128, MASK + row0 * 64,
                                 YB + row0 * 1024 + h * 128, 256 * (qb + 1), (LAS char*)lds, tid_());
            __syncthreads(); }
    }
}
__device__ __forceinline__ const float* sel_row(const float* S, int q, int& nw) {
    const int b = q >> 12, s = q & 4095, c = s >> 6; nw = c + 1;
    return S + (size_t)b * SCORE_B + (size_t)2048 * c * (c + 1) + (size_t)(s & 63) * (nw * 64);
}
__device__ __forceinline__ void sel_load(const float* row, int nw, int lane, float (&f)[64]) {
    if (nw > 32) {
#pragma unroll
        for (int j = 0; j < 64; ++j) { const int jc = j < nw ? j : nw - 1; f[j] = row[jc * 64 + lane]; }
    } else {
#pragma unroll
        for (int j = 0; j < 32; ++j) { const int jc = j < nw ? j : nw - 1; f[j] = row[jc * 64 + lane]; }
#pragma unroll
        for (int j = 32; j < 64; ++j) f[j] = 0.f;
    }
}
__device__ __forceinline__ void phase_select(KP P, LAS unsigned char* lds) {
    unsigned char* ws = as_global(P->ws); const float* S = (const float*)(ws + WS_S); unsigned long long* MASK = (unsigned long long*)(ws + WS_MASK);
    const int tid = tid_(), wave = __builtin_amdgcn_readfirstlane(tid >> 6), lane = tid & 63, nb8 = nblk_() * 8;
    LAS unsigned long long* sm = (LAS unsigned long long*)lds + wave * 64;
    float f[64]; int it = (bid_() * 8 + wave) * 8, nw = 0; const float* row = nullptr;
    const int itstep = nb8 * 8 - 7;
#define SEL_Q(it_) ((((it_) >> 3) & 3) * 4096 + ((it_) >> 5) + 512 * ((it_) & 7))
    int q = it < TOK ? SEL_Q(it) : TOK;
    if (q < TOK) { row = sel_row(S, q, nw); if (nw > TOPK / 64) sel_load(row, nw, lane, f); }
    while (q < TOK) {
        unsigned long long myword = 0ull;
        const int itn = ((it & 7) == 7) ? it + itstep : it + 1; const int qn = itn < TOK ? SEL_Q(itn) : TOK; int nwn = 0; const float* rown = nullptr;
        if (nw <= TOPK / 64) {
            myword = (lane < nw) ? ~0ull : 0ull;
            if (qn < TOK) { rown = sel_row(S, qn, nwn); if (nwn > TOPK / 64) sel_load(rown, nwn, lane, f); }
        } else {
            unsigned u[64];
#pragma unroll
            for (int j = 0; j < 64; ++j) { const unsigned bits = __float_as_uint(f[j]); const unsigned v = (bits & 0x80000000u) ? ~bits : (bits | 0x80000000u); u[j] = (j < nw) ? v : 0u; }
            if (qn < TOK) { rown = sel_row(S, qn, nwn); if (nwn > TOPK / 64) sel_load(rown, nwn, lane, f); }
            unsigned prefix = 0u;
            for (int bit = 31; bit >= 0; --bit) { const unsigned cand = prefix | (1u << bit); int cnt = 0;
#pragma unroll
                for (int j8 = 0; j8 < 8; ++j8) if (j8 * 8 < nw) { unsigned long long bl[8];
#pragma unroll
                    for (int jj = 0; jj < 8; ++jj) bl[jj] = __ballot(u[j8 * 8 + jj] >= cand);
                    asm volatile("" : "+s"(bl[0]), "+s"(bl[1]), "+s"(bl[2]), "+s"(bl[3]), "+s"(bl[4]), "+s"(bl[5]), "+s"(bl[6]), "+s"(bl[7]));
#pragma unroll
                    for (int jj = 0; jj < 8; ++jj) cnt += __popcll(bl[jj]); }
                if (cnt >= TOPK) prefix = cand;
                if (cnt == TOPK) break; }
#pragma unroll
            for (int j8 = 0; j8 < 8; ++j8) {
                if (j8 * 8 < nw) {
#pragma unroll
                    for (int jj = 0; jj < 8; ++jj) { const unsigned long long w = __ballot(u[j8 * 8 + jj] >= prefix); if (lane == 0) sm[j8 * 8 + jj] = w; }
                } else if (lane < 8) sm[j8 * 8 + lane] = 0ull; }
            myword = sm[lane];
        }
        MASK[(size_t)q * 64 + lane] = myword;
        q = qn; it = itn; nw = nwn; row = rown;
    }
#undef SEL_Q
}

__device__ __forceinline__ void phase_hgrn_naive(KP P, int layer, LAS unsigned char* lds) {
    unsigned char* ws = as_global(P->ws);
    const bf16_t* QA = (const bf16_t*)(ws + WS_QA); const bf16_t* KA = (const bf16_t*)(ws + WS_KA); const bf16_t* VA = (const bf16_t*)(ws + WS_VA); const bf16_t* GA = (const bf16_t*)(ws + WS_GA);
    const float* LF = (const float*)(ws + WS_LF); bf16_t* YA = (bf16_t*)(ws + WS_YA);
    const int tid = tid_(), bh = bid_(), b = bh >> 3, h = bh & 7, v = tid & 127; const bool act = (bh < 32) && (tid < 128);
    if (bh >= 32) return;
    LAS float* sf = (LAS float*)lds; LAS float* sk = sf + 16 * 128; LAS float* sq = sk + 16 * 128; LAS float* red = sq + 16 * 128;
    float S[128];
#pragma unroll
    for (int k = 0; k < 128; ++k) S[k] = 0.f;
    const float ng = as_global(P->hnorm_g)[layer * 128 + v];
    for (int t0 = 0; t0 < SEQ; t0 += 16) {
        if (act) for (int i = 0; i < 16; ++i) { const size_t idx = ((size_t)(b * SEQ + t0 + i)) * 1024 + h * 128 + v; sf[i * 128 + v] = expf(LF[idx]); sk[i * 128 + v] = bf2f(KA[idx]); sq[i * 128 + v] = bf2f(QA[idx]); }
        __syncthreads();
        for (int i = 0; i < 16; ++i) { const size_t idx = ((size_t)(b * SEQ + t0 + i)) * 1024 + h * 128 + v; float o = 0.f;
            if (act) { const float vt = bf2f(VA[idx]);
#pragma unroll
                for (int k = 0; k < 128; ++k) { S[k] = sf[i * 128 + k] * S[k] + sk[i * 128 + k] * vt; o += S[k] * sq[i * 128 + k]; } }
            float ss = o * o;
#pragma unroll
            for (int m = 32; m >= 1; m >>= 1) ss += __shfl_xor(ss, m);
            if (act && (v & 63) == 0) red[v >> 6] = ss;
            __syncthreads();
            if (act) { const float tot = red[0] + red[1]; YA[idx] = f2bf(o * (1.0f / sqrtf(tot * (1.0f / 128.0f) + RMS_EPS)) * ng * bf2f(GA[idx])); }
            __syncthreads(); }
    }
}
__device__ __forceinline__ void phase_idx_naive(KP P, LAS unsigned char* lds) {
    unsigned char* ws = as_global(P->ws);
    const bf16_t* QI = (const bf16_t*)(ws + WS_QI); const bf16_t* KI = (const bf16_t*)(ws + WS_KI); const float* WI = (const float*)(ws + WS_WI); float* Sc = (float*)(ws + WS_S);
    const int tid = tid_(), G = nblk_();
    LAS float* qs = (LAS float*)lds; LAS float* wsh = qs + 1024;
    for (int q = bid_(); q < TOK; q += G) {
        const int b = q >> 12, s = q & 4095, c = s >> 6, nw = c + 1, nk = nw * 64;
        if (nw <= TOPK / 64) continue;
        __syncthreads();
        for (int i = tid; i < 1024; i += 512) qs[i] = bf2f(QI[(size_t)q * 1024 + i]);
        if (tid < 16) wsh[tid] = WI[(size_t)q * 16 + tid];
        __syncthreads();
        float* row = Sc + (size_t)b * SCORE_B + (size_t)2048 * c * (c + 1) + (size_t)(s & 63) * nk;
        for (int key = tid; key < nk; key += 512) {
            float kf[64]; const pg8::u32x4* kp = (const pg8::u32x4*)(KI + ((size_t)b * SEQ + key) * 64);
#pragma unroll
            for (int d8 = 0; d8 < 8; ++d8) { const pg8::u32x4 w = kp[d8]; pg8::f32x4 a, bb; pg8::unpack8(w, a, bb);
#pragma unroll
                for (int j = 0; j < 4; ++j) { kf[d8 * 8 + j] = a[j]; kf[d8 * 8 + 4 + j] = bb[j]; } }
            float sc = 0.f;
            for (int h = 0; h < 16; ++h) { float dot = 0.f;
#pragma unroll
                for (int d = 0; d < 64; ++d) dot += qs[h * 64 + d] * kf[d];
                sc += wsh[h] * fmaxf(dot, 0.f); }
            row[key] = sc;
        }
    }
}
__device__ __forceinline__ void phase_attn_naive(KP P, LAS unsigned char* lds) {
    unsigned char* ws = as_global(P->ws);
    const bf16_t* QB = (const bf16_t*)(ws + WS_QB); const bf16_t* KB = (const bf16_t*)(ws + WS_KB); const bf16_t* VB = (const bf16_t*)(ws + WS_VB);
    const unsigned long long* MASK = (const unsigned long long*)(ws + WS_MASK); bf16_t* YB = (bf16_t*)(ws + WS_YB);
    const int tid = tid_(), h = tid >> 6, lane = tid & 63, G = nblk_();
    LAS float* qs = (LAS float*)lds + h * 128; LAS int* keys = (LAS int*)((LAS float*)lds + 1024) + h * 320; LAS float* lg = (LAS float*)lds + 1024 + 8 * 320 + h * 320;
    for (int q = bid_(); q < TOK; q += G) {
        const int b = q >> 12, s = q & 4095, nw = (s >> 6) + 1;
        qs[lane] = bf2f(QB[(size_t)q * 1024 + h * 128 + lane]); qs[lane + 64] = bf2f(QB[(size_t)q * 1024 + h * 128 + 64 + lane]);
        int cnt = 0;
        for (int j = 0; j < nw; ++j) { const unsigned long long w = MASK[(size_t)q * 64 + j]; const bool on = (w >> lane) & 1ull; const int key = j * 64 + lane;
            if (on) { const pg8::u32x4* kp = (const pg8::u32x4*)(KB + ((size_t)b * SEQ + key) * 1024 + h * 128); float dot = 0.f;
                for (int d8 = 0; d8 < 16; ++d8) { pg8::f32x4 a, bb; pg8::unpack8(kp[d8], a, bb);
#pragma unroll
                    for (int j2 = 0; j2 < 4; ++j2) dot += qs[d8 * 8 + j2] * a[j2] + qs[d8 * 8 + 4 + j2] * bb[j2]; }
                const int pos = cnt + __popcll(w & ((1ull << lane) - 1ull));
                if (pos < 320) { keys[pos] = key; lg[pos] = dot * ATTN_SCALE; } }
            cnt += __popcll(w); }
        if (cnt > 320) cnt = 320;
        float mx = -1e30f; for (int e = lane; e < cnt; e += 64) mx = fmaxf(mx, lg[e]);
#pragma unroll
        for (int m = 32; m >= 1; m >>= 1) mx = fmaxf(mx, __shfl_xor(mx, m));
        float sum = 0.f; for (int e = lane; e < cnt; e += 64) { const float pe = expf(lg[e] - mx); lg[e] = pe; sum += pe; }
#pragma unroll
        for (int m = 32; m >= 1; m >>= 1) sum += __shfl_xor(sum, m);
        float a0 = 0.f, a1 = 0.f;
        for (int e = 0; e < cnt; ++e) { const float pe = lg[e]; const bf16_t* vp = VB + ((size_t)b * SEQ + keys[e]) * 1024 + h * 128 + 2 * lane; a0 += pe * bf2f(vp[0]); a1 += pe * bf2f(vp[1]); }
        const float inv = 1.0f / sum;
        *(unsigned*)(YB + (size_t)q * 1024 + h * 128 + 2 * lane) = pg8::cvt_pk_bf16(a0 * inv, a1 * inv);
    }
}

constexpr int IXK = 512, IX_LD = 144;
__device__ __forceinline__ void idx_unit(const bf16_t* QI, const bf16_t* KI, const float* WI, float* Sc, int b, int c, int half, int tid, LAS unsigned char* lds) {
    const int lane = tid & 63, wave = __builtin_amdgcn_readfirstlane(tid >> 6), r = lane & 31, hh = lane >> 5, nk = 64 * (c + 1);
    const int s0 = c * 64 + half * 32 + wave * 4;
    const int aq = (r >> 2) & 1, ahead = (r & 3) + 4 * (r >> 3);
    bf16x8_t A[2][4]; float wv[2][16];
#pragma unroll
    for (int rt = 0; rt < 2; ++rt) { const size_t qrow = (size_t)b * SEQ + s0 + 2 * rt + aq;
#pragma unroll
        for (int ks = 0; ks < 4; ++ks) A[rt][ks] = *(const bf16x8_t*)(QI + qrow * 1024 + ahead * 64 + 16 * ks + 8 * hh);
        const float* wp = WI + ((size_t)b * SEQ + s0 + 2 * rt + hh) * 16;
#pragma unroll
        for (int i4 = 0; i4 < 4; ++i4) { const pg8::f32x4 w4 = *(const pg8::f32x4*)(wp + 4 * i4); wv[rt][4 * i4] = w4[0]; wv[rt][4 * i4 + 1] = w4[1]; wv[rt][4 * i4 + 2] = w4[2]; wv[rt][4 * i4 + 3] = w4[3]; } }
    float* srow[2];
#pragma unroll
    for (int rt = 0; rt < 2; ++rt) srow[rt] = Sc + (size_t)b * SCORE_B + (size_t)2048 * c * (c + 1) + (size_t)((s0 + 2 * rt + hh) & 63) * nk + r;
    const bf16_t* kbase = KI + (size_t)b * SEQ * 64;
    const int nblk = (nk + IXK - 1) / IXK;
    pg8::u32x4 stg[8];
#define IX_LOAD(kb) do { _Pragma("unroll") for (int i = 0; i < 8; ++i) { const int p = tid + 512 * i; int key = (kb) * IXK + (p >> 3); key = key < nk ? key : nk - 1; \
        stg[i] = *(const pg8::u32x4*)(kbase + (size_t)key * 64 + (p & 7) * 8); } } while (0)
#define IX_STORE() do { _Pragma("unroll") for (int i = 0; i < 8; ++i) { const int p = tid + 512 * i; *(LAS pg8::u32x4*)(lds + (p >> 3) * IX_LD + (p & 7) * 16) = stg[i]; } } while (0)
    IX_LOAD(0);
    for (int kb = 0; kb < nblk; ++kb) {
        __syncthreads();
        IX_STORE();
        __syncthreads();
        if (kb + 1 < nblk) IX_LOAD(kb + 1);
        const int ntile = (nk - kb * IXK < IXK ? nk - kb * IXK : IXK) / 32;
        for (int t = 0; t < ntile; ++t) { bf16x8_t Bc[4];
#pragma unroll
            for (int ks = 0; ks < 4; ++ks) Bc[ks] = *(const LAS bf16x8_t*)(lds + (32 * t + r) * IX_LD + (16 * ks + 8 * hh) * 2);
#pragma unroll
            for (int rt = 0; rt < 2; ++rt) { f32x16_t acc;
#pragma unroll
                for (int i = 0; i < 16; ++i) acc[i] = 0.f;
#pragma unroll
                for (int ks = 0; ks < 4; ++ks) acc = __builtin_amdgcn_mfma_f32_32x32x16_bf16(A[rt][ks], Bc[ks], acc, 0, 0, 0);
                pg8::f32x2 sc2 = {0.f, 0.f};
#pragma unroll
                for (int i = 0; i < 16; i += 2) { pg8::f32x2 rl, wq; rl[0] = __int_as_float(max(__float_as_int(acc[i]), 0)); rl[1] = __int_as_float(max(__float_as_int(acc[i + 1]), 0));
                    wq[0] = wv[rt][i]; wq[1] = wv[rt][i + 1]; sc2 = __builtin_elementwise_fma(wq, rl, sc2); }
                srow[rt][kb * IXK + t * 32] = sc2[0] + sc2[1]; } }
    }
#undef IX_LOAD
#undef IX_STORE
}
__device__ __forceinline__ void phase_idx(KP P, LAS unsigned char* lds) {
    unsigned char* ws = as_global(P->ws);
    const bf16_t* QI = (const bf16_t*)(ws + WS_QI); const bf16_t* KI = (const bf16_t*)(ws + WS_KI); const float* WI = (const float*)(ws + WS_WI); float* Sc = (float*)(ws + WS_S);
    const int G = nblk_();
    for (int item = bid_(); item < 240; item += G) {
        const int pi = item % 30, combo = item / 30, b = combo >> 1, half = combo & 1;
        idx_unit(QI, KI, WI, Sc, b, 4 + pi, half, tid_(), lds); __syncthreads();
        idx_unit(QI, KI, WI, Sc, b, 63 - pi, half, tid_(), lds); __syncthreads();
    }
}

__device__ __forceinline__ void sel_unit(const float* S, unsigned long long* MASK, int b, int c, int half, int tid, LAS unsigned char* lds) {
    const int lane = tid & 63, wave = __builtin_amdgcn_readfirstlane(tid >> 6), nw = c + 1;
    LAS unsigned long long* sm = (LAS unsigned long long*)lds + wave * 64;
    float f[64]; const int s0 = c * 64 + half * 32 + wave * 4;
    const float* rowbase = S + (size_t)b * SCORE_B + (size_t)2048 * c * (c + 1);
#pragma unroll 1
    for (int i = 0; i < 4; ++i) {
        unsigned u[64];
        sel_load(rowbase + (size_t)((s0 + i) & 63) * (nw * 64), nw, lane, f);
#pragma unroll
        for (int j = 0; j < 64; ++j) { const unsigned bits = __float_as_uint(f[j]); const unsigned v = (bits & 0x80000000u) ? ~bits : (bits | 0x80000000u); u[j] = (j < nw) ? v : 0u; }
        unsigned prefix = 0u;
        for (int bit = 31; bit >= 0; --bit) { const unsigned cand = prefix | (1u << bit); int cnt = 0;
#pragma unroll
            for (int j8 = 0; j8 < 8; ++j8) if (j8 * 8 < nw) { unsigned long long bl[8];
#pragma unroll
                for (int jj = 0; jj < 8; ++jj) bl[jj] = __ballot(u[j8 * 8 + jj] >= cand);
                asm volatile("" : "+s"(bl[0]), "+s"(bl[1]), "+s"(bl[2]), "+s"(bl[3]), "+s"(bl[4]), "+s"(bl[5]), "+s"(bl[6]), "+s"(bl[7]));
#pragma unroll
                for (int jj = 0; jj < 8; ++jj) cnt += __popcll(bl[jj]); }
            if (cnt >= TOPK) prefix = cand; }
#pragma unroll
        for (int j = 0; j < 64; ++j) { const unsigned long long w = __ballot(u[j] >= prefix); if (lane == 0) sm[j] = w; }
        MASK[((size_t)b * SEQ + s0 + i) * 64 + lane] = sm[lane];
    }
}
__device__ __forceinline__ void phase_idxsel(KP P, LAS unsigned char* lds) {
    unsigned char* ws = as_global(P->ws);
    const bf16_t* QI = (const bf16_t*)(ws + WS_QI); const bf16_t* KI = (const bf16_t*)(ws + WS_KI); const float* WI = (const float*)(ws + WS_WI); float* Sc = (float*)(ws + WS_S);
    unsigned long long* MASK = (unsigned long long*)(ws + WS_MASK);
    const int G = nblk_();
    { const int tid = tid_(), lane = tid & 63, gw = bid_() * 8 + __builtin_amdgcn_readfirstlane(tid >> 6);
      for (int qq = gw; qq < NBATCH * 256; qq += G * 8) { const int b = qq >> 8, s = qq & 255, nw = (s >> 6) + 1; MASK[((size_t)b * SEQ + s) * 64 + lane] = (lane < nw) ? ~0ull : 0ull; } }
    for (int item = bid_(); item < 240; item += G) {
        const int pi = item % 30, combo = item / 30, b = combo >> 1, half = combo & 1;
#pragma unroll 1
        for (int which = 0; which < 2; ++which) { const int c = which ? 63 - pi : 4 + pi;
            idx_unit(QI, KI, WI, Sc, b, c, half, tid_(), lds);
            asm volatile("s_waitcnt vmcnt(0)" ::: "memory"); __syncthreads();
            sel_unit(Sc, MASK, b, c, half, tid_(), lds);
            __syncthreads(); }
    }
}
__device__ __forceinline__ void ixs_unit(const bf16_t* QI, const bf16_t* KI, const float* WI, unsigned long long* MASK, int b, int u8, int tid, LAS unsigned char* lds) {
    const int lane = tid & 63, wave = __builtin_amdgcn_readfirstlane(tid >> 6), r = lane & 31, hh = lane >> 5;
    const int s0 = 8 * u8, c = s0 >> 6, nw = c + 1, nk = 64 * nw;
    LAS float* SC = (LAS float*)lds;
    unsigned long long myword;
    if (nw > TOPK / 64) {
        { const int aq = (r >> 2) & 1, ahead = (r & 3) + 4 * (r >> 3);
          bf16x8_t A[4][4]; float wv[4][16];
#pragma unroll
          for (int rt = 0; rt < 4; ++rt) { const size_t qrow = (size_t)b * SEQ + s0 + 2 * rt + aq;
#pragma unroll
              for (int ks = 0; ks < 4; ++ks) A[rt][ks] = *(const bf16x8_t*)(QI + qrow * 1024 + ahead * 64 + 16 * ks + 8 * hh);
              const float* wp = WI + ((size_t)b * SEQ + s0 + 2 * rt + hh) * 16;
#pragma unroll
              for (int i4 = 0; i4 < 4; ++i4) { const pg8::f32x4 w4 = *(const pg8::f32x4*)(wp + 4 * i4); wv[rt][4 * i4] = w4[0]; wv[rt][4 * i4 + 1] = w4[1]; wv[rt][4 * i4 + 2] = w4[2]; wv[rt][4 * i4 + 3] = w4[3]; } }
          const bf16_t* kp = KI + ((size_t)b * SEQ + r) * 64 + 8 * hh;
          const int ntile = nk / 32;
          bf16x8_t Ca[4], Cb[4];
#define IXS_LOAD(t0_) do { const int ta = (t0_) < ntile ? (t0_) : ntile - 1, tb_ = (t0_) + 8 < ntile ? (t0_) + 8 : ntile - 1; \
              _Pragma("unroll") for (int ks = 0; ks < 4; ++ks) { Ca[ks] = *(const bf16x8_t*)(kp + (size_t)ta * 2048 + 16 * ks); Cb[ks] = *(const bf16x8_t*)(kp + (size_t)tb_ * 2048 + 16 * ks); } } while (0)
#define IXS_TILE(BUF, tt) do { _Pragma("unroll") for (int rt = 0; rt < 4; ++rt) { f32x16_t acc; _Pragma("unroll") for (int i = 0; i < 16; ++i) acc[i] = 0.f; \
              _Pragma("unroll") for (int ks = 0; ks < 4; ++ks) acc = __builtin_amdgcn_mfma_f32_32x32x16_bf16(A[rt][ks], BUF[ks], acc, 0, 0, 0); \
              pg8::f32x2 sc2 = {0.f, 0.f}; _Pragma("unroll") for (int i = 0; i < 16; i += 2) { pg8::f32x2 rl, wq; \
                  rl[0] = __int_as_float(max(__float_as_int(acc[i]), 0)); rl[1] = __int_as_float(max(__float_as_int(acc[i + 1]), 0)); wq[0] = wv[rt][i]; wq[1] = wv[rt][i + 1]; \
                  sc2 = __builtin_elementwise_fma(wq, rl, sc2); } const float sc = sc2[0] + sc2[1];     \
              SC[(2 * rt + hh) * 4096 + 32 * (tt) + r] = sc; } } while (0)
          IXS_LOAD(wave);
          for (int t = wave; t < ntile; t += 16) {
              bf16x8_t Ba[4], Bb[4];
#pragma unroll
              for (int ks = 0; ks < 4; ++ks) { Ba[ks] = Ca[ks]; Bb[ks] = Cb[ks]; }
              IXS_LOAD(t + 16);
              IXS_TILE(Ba, t);
              if (t + 8 < ntile) IXS_TILE(Bb, t + 8);
          }
#undef IXS_LOAD
#undef IXS_TILE
        }
        __syncthreads();
        unsigned u[64];
        { const LAS float* row = SC + wave * 4096 + lane;
#pragma unroll
          for (int j = 0; j < 64; ++j) { const int jc = j < nw ? j : nw - 1; const unsigned bits = __float_as_uint(row[jc * 64]); const unsigned v = (bits & 0x80000000u) ? ~bits : (bits | 0x80000000u); u[j] = (j < nw) ? v : 0u; } }
        unsigned prefix = 0u;
#ifdef IXS_DUP_SEARCH
        for (int rep_s = 0; rep_s < 2; ++rep_s) { prefix = 0u;
#else
        {
#endif
        for (int bit = 31; bit >= 0; --bit) { const unsigned cand = prefix | (1u << bit); int cnt = 0;
            unsigned cl = 0u;
#pragma unroll
            for (int j8 = 0; j8 < 8; ++j8) if (j8 * 8 < nw) {
#pragma unroll
                for (int jj = 0; jj < 8; ++jj) cl += (u[j8 * 8 + jj] >= cand) ? 1u : 0u; }
#pragma unroll
            for (int bb = 0; bb < 7; ++bb) cnt += __popcll(__ballot((cl >> bb) & 1u)) << bb;
            if (cnt >= TOPK) prefix = cand; }
        }
        LAS unsigned long long* sm = (LAS unsigned long long*)(SC + wave * 4096);
#pragma unroll
        for (int j = 0; j < 64; ++j) { const unsigned long long w = __ballot(u[j] >= prefix); if (lane == 0) sm[j] = w; }
        myword = sm[lane];
    } else {
        myword = (lane < nw) ? ~0ull : 0ull;
    }
    MASK[((size_t)b * SEQ + s0 + wave) * 64 + lane] = myword;
    __syncthreads();
}
__device__ __forceinline__ void phase_ixs(KP P, LAS unsigned char* lds) {
    unsigned char* ws = as_global(P->ws);
    const bf16_t* QI = (const bf16_t*)(ws + WS_QI); const bf16_t* KI = (const bf16_t*)(ws + WS_KI); const float* WI = (const float*)(ws + WS_WI); unsigned long long* MASK = (unsigned long long*)(ws + WS_MASK);
    const int G = nblk_();
    for (int W = bid_(); W < 256; W += G)
        for (int kk = 0; kk < 8; ++kk) ixs_unit(QI, KI, WI, MASK, W & 3, (W >> 2) + 64 * kk, tid_(), lds);
}
#ifndef OPT_HGRN
#define OPT_HGRN 1
#endif
#ifndef OPT_IDX
#define OPT_IDX 1
#endif
#ifndef OPT_ATT
#define OPT_ATT 1
#endif
#ifndef OPT_IXS
#define OPT_IXS 0
#endif
#ifndef PHM
#define PHM 0x3fff
#endif
#ifndef DUP_MASK
#define DUP_MASK 0
#endif

__global__ void __launch_bounds__(512, 2) mega(Params P_unused) {
    extern __shared__ __attribute__((aligned(16))) unsigned char lds[];
    LAS unsigned char* L = (LAS unsigned char*)lds;
    volatile LAS unsigned* misc = (volatile LAS unsigned*)(L + MISC_OFF);
    if (threadIdx.x < 4) misc[threadIdx.x] = 0u;
    __syncthreads();
    int lo, hi; unsigned char* ws0; { KP P0 = kparams(); lo = P0->ph_lo; hi = P0->ph_hi; ws0 = as_global(P0->ws); }
    XcdBarrier bar; bar.bar = (unsigned*)(ws0 + WS_CTL); bar.x = 0; bar.st = misc;
    if (hi - lo > 1) bar = xcd_barrier_post((unsigned*)(ws0 + WS_CTL), misc);
#define WSP(T_, off) ((T_*)(ws + (off)))
#define WSL KP P = kparams(); unsigned char* ws = as_global(P->ws); const int G = nblk_(), bid = bid_(); (void)G; (void)bid

    for (int layer = 0; layer < DEPTH; ++layer) {
        const int base = layer * NPH_LAYER;
#define IN(k) (((PHM >> (k)) & 1) && lo <= base + (k) && base + (k) < hi)
#define SEAM(k) do { if (rep + 1 == ((((DUP_MASK >> (k)) & 1) ? 2 : 1)) && base + (k) + 1 < hi) xcd_barrier(bar); } while (0)
        if (layer == 0 && IN(0)) for (int rep = 0; rep < (((DUP_MASK >> 0) & 1) ? 2 : 1); ++rep) { WSL; phase_prologue(P); phase_wconv(P, 0, L); SEAM(0); }
        if (IN(1)) for (int rep = 0; rep < (((DUP_MASK >> 1) & 1) ? 2 : 1); ++rep) { WSL;
            pg8::Gemm g{WSP(const bf16_t, WS_XB), WSP(const bf16_t, WS_WIN), TOK, INP, DM}; pg8::StaticOrder S; S.init(TOK, INP, G, bid);
            pg8::EpiIn E{ws, layer};
            pg8::gemm_phase<pg8::EpiIn, pg8::StaticOrder, true, true>(L, g, S, E); SEAM(1);
        }
        if (IN(2)) for (int rep = 0; rep < (((DUP_MASK >> 2) & 1) ? 2 : 1); ++rep) { WSL; phase_ikprep(P, layer);
#if OPT_HGRN
            phase_hgrn_h1(P, L);
#ifdef DUP_H1
            phase_hgrn_h1(P, L);
#endif
#endif
            SEAM(2); }
        if (IN(3)) for (int rep = 0; rep < (((DUP_MASK >> 3) & 1) ? 2 : 1); ++rep) { WSL;
#if !OPT_HGRN
            phase_hgrn_naive(P, layer, L); __syncthreads();
#else
            phase_hgrn_h2(P);
#ifdef DUP_H2
            phase_hgrn_h2(P);
#endif
#endif
#if !OPT_IDX
            phase_idx_naive(P, L);
#else
#if OPT_IXS == 2
            __syncthreads(); phase_idxsel(P, L);
#elif OPT_IXS == 1
            __syncthreads(); phase_ixs(P, L);
#ifdef DUP_IXS
            __syncthreads(); phase_ixs(P, L);
#endif
#else
            __syncthreads(); phase_idx(P, L);
#endif
#endif
            SEAM(3); }
#if OPT_IXS == 2 && OPT_HGRN && OPT_ATT
#else
        if (IN(4)) for (int rep = 0; rep < (((DUP_MASK >> 4) & 1) ? 2 : 1); ++rep) { WSL;
#if OPT_IXS == 0
            phase_select(P, L);
#endif
#if OPT_HGRN
            __syncthreads(); phase_hgrn_h3(P, layer, L);
#ifdef DUP_H3
            __syncthreads(); phase_hgrn_h3(P, layer, L);
#endif
#endif
            SEAM(4); }
#endif
        if (IN(5)) for (int rep = 0; rep < (((DUP_MASK >> 5) & 1) ? 2 : 1); ++rep) { WSL;
#if !OPT_ATT
            phase_attn_naive(P, L);
#else
#if OPT_IXS == 2 && OPT_HGRN
            phase_hgrn_h3(P, layer, L); __syncthreads();
#endif
            phase_attn(P, L);
#endif
            SEAM(5); }
        if (IN(6)) for (int rep = 0; rep < (((DUP_MASK >> 6) & 1) ? 2 : 1); ++rep) { WSL;
            { pg8::Gemm g{WSP(const bf16_t, WS_YA), WSP(const bf16_t, WS_WA), TOK, DM, AW}; pg8::PanelOrder8 S; S.init(TOK, DM, G, bid);
              pg8::EpiGateA E{ws}; pg8::gemm_phase<pg8::EpiGateA, pg8::PanelOrder8, true, true>(L, g, S, E); }
            { pg8::Gemm g{WSP(const bf16_t, WS_YB), WSP(const bf16_t, WS_WB), TOK, DM, BW}; pg8::PanelOrder8 S; S.init(TOK, DM, G, bid);
              pg8::EpiGateB E{ws}; pg8::gemm_phase<pg8::EpiGateB, pg8::PanelOrder8, true, true>(L, g, S, E); }
            { pg8::Gemm g{WSP(const bf16_t, WS_PB), WSP(const bf16_t, WS_WPP), TOK, DM, PLE}; pg8::PanelOrder8 S; S.init(TOK, DM, G, bid);
              pg8::EpiF32P E{ws}; pg8::gemm_phase<pg8::EpiF32P, pg8::PanelOrder8, true, true>(L, g, S, E); }
            SEAM(6);
        }
        if (IN(7)) for (int rep = 0; rep < (((DUP_MASK >> 7) & 1) ? 2 : 1); ++rep) { WSL;
            pg8::Gemm g{WSP(const bf16_t, WS_MG), WSP(const bf16_t, WS_WO), TOK, DM, DM}; pg8::PanelOrder8 S; S.init(TOK, DM, G, bid);
            if (layer == 0) { pg8::EpiRes<true> E{as_global(P->x), nullptr, nullptr, ws}; pg8::gemm_phase<pg8::EpiRes<true>, pg8::PanelOrder8, true, true>(L, g, S, E); }
            else { pg8::EpiRes<false> E{nullptr, P->lnp_g + (layer - 1) * DM, P->lnp_b + (layer - 1) * DM, ws}; pg8::gemm_phase<pg8::EpiRes<false>, pg8::PanelOrder8, true, true>(L, g, S, E); }
            SEAM(7);
        }
        if (IN(8)) for (int rep = 0; rep < (((DUP_MASK >> 8) & 1) ? 2 : 1); ++rep) { WSL; phase_ln(WSP(const float, WS_XPRE), nullptr, WSP(bf16_t, WS_XB), WSP(float, WS_STATS), as_global(P->lnm_g) + layer * DM, as_global(P->lnm_b) + layer * DM); SEAM(8); }
        if (IN(9)) for (int rep = 0; rep < (((DUP_MASK >> 9) & 1) ? 2 : 1); ++rep) { WSL;
            pg8::Gemm g{WSP(const bf16_t, WS_XB), WSP(const bf16_t, WS_WGU), TOK, 2 * DFF, DM}; pg8::StaticOrder S; S.init(TOK, 2 * DFF, G, bid);
            pg8::EpiSwiGLU E{ws}; pg8::gemm_phase<pg8::EpiSwiGLU, pg8::StaticOrder, true, true>(L, g, S, E); SEAM(9);
        }
        if (IN(10)) for (int rep = 0; rep < (((DUP_MASK >> 10) & 1) ? 2 : 1); ++rep) { WSL;
            pg8::Gemm g{WSP(const bf16_t, WS_H), WSP(const bf16_t, WS_WDN), TOK, DM, DFF}; pg8::PanelOrder8 S; S.init(TOK, DM, G, bid);
            pg8::EpiRes<false> E{nullptr, P->lnm_g + layer * DM, P->lnm_b + layer * DM, ws}; pg8::gemm_phase<pg8::EpiRes<false>, pg8::PanelOrder8, true, true>(L, g, S, E); SEAM(10);
        }
        if (IN(11)) for (int rep = 0; rep < (((DUP_MASK >> 11) & 1) ? 2 : 1); ++rep) { WSL; phase_ln(WSP(const float, WS_XPRE), nullptr, WSP(bf16_t, WS_XB), WSP(float, WS_STATS), as_global(P->lnf_g) + layer * DM, as_global(P->lnf_b) + layer * DM); SEAM(11); }
        if (IN(12)) for (int rep = 0; rep < (((DUP_MASK >> 12) & 1) ? 2 : 1); ++rep) { WSL;
            pg8::Gemm g{WSP(const bf16_t, WS_XB), WSP(const bf16_t, WS_WPG), TOK, DM, DM}; pg8::PanelOrder8 S; S.init(TOK, DM, G, bid);
            pg8::EpiPle E{P->lnf_g + layer * DM, P->lnf_b + layer * DM, ws}; pg8::gemm_phase<pg8::EpiPle, pg8::PanelOrder8, true, true>(L, g, S, E); SEAM(12);
        }
        if (IN(13)) for (int rep = 0; rep < (((DUP_MASK >> 13) & 1) ? 2 : 1); ++rep) { WSL; phase_ln(WSP(const float, WS_XPRE), layer == DEPTH - 1 ? as_global(P->out) : nullptr, WSP(bf16_t, WS_XB), WSP(float, WS_STATS), as_global(P->lnp_g) + layer * DM, as_global(P->lnp_b) + layer * DM);
            if (layer + 1 < DEPTH) { __syncthreads(); phase_wconv(P, layer + 1, L); }
            SEAM(13); }
#undef IN
#undef SEAM
    }
}

extern "C" void kernel_launch(void* const* d_in, const int* in_sizes, int n_in, void* d_out, int out_size, void* d_ws, size_t ws_size, hipStream_t stream) {
    static int grid = 0;
    if (grid == 0) {
        if (n_in != 22 || out_size != TOK * DM || ws_size < WS_END) { fprintf(stderr, "kernel_launch: unexpected shapes: n_in %d out %d ws %zu (need %zu)\n", n_in, out_size, ws_size, (size_t)WS_END); grid = -1; return; }
        int dev = 0, cus = 0, per_cu = 0;
        if (hipGetDevice(&dev) != hipSuccess || hipDeviceGetAttribute(&cus, hipDeviceAttributeMultiprocessorCount, dev) != hipSuccess) { grid = -1; return; }
        if (hipFuncSetAttribute((const void*)mega, hipFuncAttributeMaxDynamicSharedMemorySize, LDS_BYTES) != hipSuccess) { fprintf(stderr, "kernel_launch: hipFuncSetAttribute failed\n"); grid = -1; return; }
        if (hipOccupancyMaxActiveBlocksPerMultiprocessor(&per_cu, (const void*)mega, 512, LDS_BYTES) != hipSuccess || per_cu < 1) { fprintf(stderr, "kernel_launch: occupancy query says %d\n", per_cu); (void)hipGetLastError(); }
        grid = cus;
    }
    if (grid < 0) return;
    (void)hipMemsetAsync((char*)d_ws + WS_CTL, 0, 65536, stream);
    Params P{};
    P.x = (const float*)d_in[0]; P.p = (const float*)d_in[1]; P.pos = (const int*)d_in[2];
    P.w_in = (const float*)d_in[3]; P.w_a = (const float*)d_in[4]; P.w_b = (const float*)d_in[5]; P.w_out = (const float*)d_in[6];
    P.lbraw = (const float*)d_in[7]; P.hnorm_g = (const float*)d_in[8]; P.ikn_g = (const float*)d_in[9]; P.ikn_b = (const float*)d_in[10];
    P.lnm_g = (const float*)d_in[11]; P.lnm_b = (const float*)d_in[12]; P.w_fg = (const float*)d_in[13]; P.w_fu = (const float*)d_in[14]; P.w_fd = (const float*)d_in[15];
    P.lnf_g = (const float*)d_in[16]; P.lnf_b = (const float*)d_in[17]; P.w_pg = (const float*)d_in[18]; P.w_pp = (const float*)d_in[19];
    P.lnp_g = (const float*)d_in[20]; P.lnp_b = (const float*)d_in[21];
    P.out = (float*)d_out; P.ws = (unsigned char*)d_ws;
    for (int j = 0; j < 64; ++j) P.invf_h[j] = pow(10000.0, -(double)j / 64.0) / 6.283185307179586476925286766559;
    for (int j = 0; j < 32; ++j) P.invf_i[j] = pow(10000.0, -(double)j / 32.0) / 6.283185307179586476925286766559;
    P.ph_lo = 0; P.ph_hi = NPH;
    hipLaunchKernelGGL(mega, dim3(grid), dim3(512), LDS_BYTES, stream, P);
    const hipError_t le = hipPeekAtLastError();
    if (le != hipSuccess) fprintf(stderr, "kernel_launch: launch failed: %s\n", hipGetErrorName(le));
}
```
